# Optimizing an MI355X kernel written in HIP

```python
import jax, jax.numpy as jnp
from jax import lax
import numpy as np

D_MODEL = 1024
BATCH = 32
SEQ = 2048
DEPTH = 4
DEC_BATCH = 32
DEC_SEQ = 16
PAST_LEN = 1024

CHUNK = 64
N_A_LAYERS = DEPTH // 2
N_B_LAYERS = DEPTH - N_A_LAYERS
CONV_WIDTH = 3
CONV_DIM = D_MODEL
SB_HEADS = 16
SB_HEAD_DIM = D_MODEL // SB_HEADS
Q_BLOCK = 128
PEER_HEADS = 8
PEER_N_KEYS = 128
PEER_N_EXPERTS = PEER_N_KEYS * PEER_N_KEYS
PEER_TOPK = 16
PEER_QDIM = 256
PEER_HALF = PEER_QDIM // 2
PEER_BLOCK = 256
LN_EPS = 1e-5
DEEPNORM_ALPHA = (2.0 * DEPTH) ** 0.25
DEEPNORM_BETA = (8.0 * DEPTH) ** -0.25

kernel_name = "yoco_shortconv_stickbreaking_peer_step"


def _layernorm(x, g, b):
    xf = x.astype(jnp.float32)
    mu = jnp.mean(xf, axis=-1, keepdims=True)
    var = jnp.mean(jnp.square(xf - mu), axis=-1, keepdims=True)
    y = (xf - mu) * lax.rsqrt(var + LN_EPS)
    return (y * g.astype(jnp.float32) + b.astype(jnp.float32)).astype(x.dtype)


def _short_conv_mixer(x, conv_prev, w_in, w_dw, w_out):
    S = x.shape[1]
    b_gate, c_gate, xt = jnp.split(x @ w_in, 3, axis=-1)
    u = c_gate * xt
    up = jnp.concatenate([conv_prev.astype(u.dtype), u], axis=1)
    acc = w_dw[0] * up[:, 0:S]
    for w in range(1, CONV_WIDTH):
        acc = acc + w_dw[w] * up[:, w:w + S]
    y = (b_gate * acc) @ w_out
    return y, up[:, -(CONV_WIDTH - 1):]


def _sb_block(q, k, v, q_pos):
    scale = SB_HEAD_DIM ** -0.5
    z = jnp.einsum("bqhd,bkhd->bhqk", q, k).astype(jnp.float32) * scale
    k_pos = jnp.arange(k.shape[1])
    causal = k_pos[None, :] < q_pos[:, None]
    log_not = jnp.where(causal, jax.nn.log_sigmoid(-z), 0.0)
    suffix = lax.cumsum(log_not, axis=3, reverse=True) - log_not
    a = jnp.where(causal, jnp.exp(jax.nn.log_sigmoid(z) + suffix), 0.0)
    return jnp.einsum("bhqk,bkhd->bqhd", a.astype(v.dtype), v)


def _sb_mixer(x, k_all, v_all, w_q, w_o, q_pos0):
    B, S, _ = x.shape
    q = (x @ w_q).reshape(B, S, SB_HEADS, SB_HEAD_DIM)
    q_pos = q_pos0 + jnp.arange(S)
    if S % Q_BLOCK == 0:
        nb = S // Q_BLOCK
        qb = q.reshape(B, nb, Q_BLOCK, SB_HEADS, SB_HEAD_DIM).transpose(1, 0, 2, 3, 4)
        pb = q_pos.reshape(nb, Q_BLOCK)
        ob = lax.map(lambda a: _sb_block(a[0], k_all, v_all, a[1]), (qb, pb))
        o = ob.transpose(1, 0, 2, 3, 4).reshape(B, S, SB_HEADS * SB_HEAD_DIM)
    else:
        o = _sb_block(q, k_all, v_all, q_pos).reshape(B, S, SB_HEADS * SB_HEAD_DIM)
    return o @ w_o


def _peer(x, w_q, subkeys, u_tab, v_tab):
    B, S, D = x.shape
    T = B * S
    n_blk = -(-T // PEER_BLOCK)
    pad = n_blk * PEER_BLOCK - T
    xp = jnp.pad(x.reshape(T, D), ((0, pad), (0, 0))).reshape(n_blk, PEER_BLOCK, D)
    K = PEER_TOPK

    def block(xb):
        q = (xb @ w_q).reshape(PEER_BLOCK, PEER_HEADS, 2, PEER_HALF).astype(jnp.float32)
        s = jnp.einsum("thpc,hpnc->thpn", q, subkeys.astype(jnp.float32))
        s_top, i_top = lax.top_k(s, K)
        cand = s_top[:, :, 0, :, None] + s_top[:, :, 1, None, :]
        cand_idx = i_top[:, :, 0, :, None] * PEER_N_KEYS + i_top[:, :, 1, None, :]
        best, pos = lax.top_k(cand.reshape(PEER_BLOCK, PEER_HEADS, K * K), K)
        expert = jnp.take_along_axis(cand_idx.reshape(PEER_BLOCK, PEER_HEADS, K * K), pos, axis=-1)
        g = jax.nn.softmax(best, axis=-1)
        act = jax.nn.gelu(jnp.einsum("td,thkd->thk", xb, u_tab[expert]), approximate=False)
        wgt = (g * act.astype(jnp.float32)).astype(xb.dtype)
        return jnp.einsum("thk,thkd->td", wgt, v_tab[expert])

    out = lax.map(block, xp).reshape(n_blk * PEER_BLOCK, D)[:T]
    return out.reshape(B, S, D)


def _trunk(x, conv_prev, k_past, v_past, q_pos0, conv_w_in, conv_w_dw, conv_w_out,
           sb_w_q, sb_w_o, kv_w_k, kv_w_v, peer_w_q, peer_subkeys, peer_u, peer_v, ln_g, ln_b):
    B, S, _ = x.shape
    h = x
    new_conv = []
    k_all = v_all = k_new = v_new = None
    for layer in range(DEPTH):
        if layer < N_A_LAYERS:
            mix, st = _short_conv_mixer(h, conv_prev[layer], conv_w_in[layer],
                                        conv_w_dw[layer], conv_w_out[layer])
            new_conv.append(st)
        else:
            if layer == N_A_LAYERS:
                k_new = (h @ kv_w_k).reshape(B, S, SB_HEADS, SB_HEAD_DIM)
                v_new = (h @ kv_w_v).reshape(B, S, SB_HEADS, SB_HEAD_DIM)
                if k_past is None:
                    k_all, v_all = k_new, v_new
                else:
                    k_all = jnp.concatenate([k_past.astype(k_new.dtype), k_new], axis=1)
                    v_all = jnp.concatenate([v_past.astype(v_new.dtype), v_new], axis=1)
            j = layer - N_A_LAYERS
            mix = _sb_mixer(h, k_all, v_all, sb_w_q[j], sb_w_o[j], q_pos0)
        h = _layernorm(DEEPNORM_ALPHA * h + mix, ln_g[layer, 0], ln_b[layer, 0])
        ff = _peer(h, peer_w_q[layer], peer_subkeys[layer], peer_u[layer], peer_v[layer])
        h = _layernorm(DEEPNORM_ALPHA * h + ff, ln_g[layer, 1], ln_b[layer, 1])
    return h, jnp.stack(new_conv, axis=0), k_new, v_new


def setup_inputs(seed: int = 0) -> dict:
    key = jax.random.key(seed)
    ks = jax.random.split(key, 20)
    f32 = jnp.float32
    HD = SB_HEADS * SB_HEAD_DIM
    nrm = lambda k, shape, s: jax.random.normal(k, shape, f32) * s
    return {
        "x_prompt": nrm(ks[0], (BATCH, SEQ, D_MODEL), 1.0),
        "x_sample": nrm(ks[1], (DEC_BATCH, DEC_SEQ, D_MODEL), 1.0),
        "state_conv": nrm(ks[2], (N_A_LAYERS, DEC_BATCH, CONV_WIDTH - 1, CONV_DIM), 1.0),
        "cache_k": nrm(ks[3], (DEC_BATCH, PAST_LEN, SB_HEADS, SB_HEAD_DIM), 1.0),
        "cache_v": nrm(ks[4], (DEC_BATCH, PAST_LEN, SB_HEADS, SB_HEAD_DIM), DEEPNORM_BETA),
        "conv_w_in": nrm(ks[5], (N_A_LAYERS, D_MODEL, 3 * CONV_DIM), D_MODEL ** -0.5),
        "conv_w_dw": nrm(ks[6], (N_A_LAYERS, CONV_WIDTH, CONV_DIM), CONV_WIDTH ** -0.5),
        "conv_w_out": nrm(ks[7], (N_A_LAYERS, CONV_DIM, D_MODEL), DEEPNORM_BETA * CONV_DIM ** -0.5),
        "sb_w_q": nrm(ks[8], (N_B_LAYERS, D_MODEL, HD), D_MODEL ** -0.5),
        "sb_w_o": nrm(ks[9], (N_B_LAYERS, HD, D_MODEL), DEEPNORM_BETA * HD ** -0.5),
        "kv_w_k": nrm(ks[10], (D_MODEL, HD), D_MODEL ** -0.5),
        "kv_w_v": nrm(ks[11], (D_MODEL, HD), DEEPNORM_BETA * D_MODEL ** -0.5),
        "peer_w_q": nrm(ks[12], (DEPTH, D_MODEL, PEER_HEADS * PEER_QDIM), D_MODEL ** -0.5),
        "peer_subkeys": nrm(ks[13], (DEPTH, PEER_HEADS, 2, PEER_N_KEYS, PEER_HALF), PEER_HALF ** -0.5),
        "peer_u": nrm(ks[14], (DEPTH, PEER_N_EXPERTS, D_MODEL), D_MODEL ** -0.5),
        "peer_v": nrm(ks[15], (DEPTH, PEER_N_EXPERTS, D_MODEL), DEEPNORM_BETA * PEER_HEADS ** -0.5),
        "ln_g": 1.0 + nrm(ks[16], (DEPTH, 2, D_MODEL), 0.02),
        "ln_b": nrm(ks[17], (DEPTH, 2, D_MODEL), 0.02),
    }


def reference(x_prompt, x_sample, state_conv, cache_k, cache_v, conv_w_in, conv_w_dw, conv_w_out,
              sb_w_q, sb_w_o, kv_w_k, kv_w_v, peer_w_q, peer_subkeys, peer_u, peer_v, ln_g, ln_b):
    zero_conv = jnp.zeros((N_A_LAYERS, x_prompt.shape[0], CONV_WIDTH - 1, CONV_DIM), x_prompt.dtype)
    y_prompt, new_conv_prompt, new_k_prompt, new_v_prompt = _trunk(
        x_prompt, zero_conv, None, None, 0, conv_w_in, conv_w_dw, conv_w_out,
        sb_w_q, sb_w_o, kv_w_k, kv_w_v, peer_w_q, peer_subkeys, peer_u, peer_v, ln_g, ln_b)
    y_sample, new_conv_sample, new_k_sample, new_v_sample = _trunk(
        x_sample, state_conv, cache_k, cache_v, cache_k.shape[1], conv_w_in, conv_w_dw, conv_w_out,
        sb_w_q, sb_w_o, kv_w_k, kv_w_v, peer_w_q, peer_subkeys, peer_u, peer_v, ln_g, ln_b)
    return (y_prompt, y_sample, new_conv_prompt, new_k_prompt, new_v_prompt,
            new_conv_sample, new_k_sample, new_v_sample)
```

```cpp
#include <hip/hip_runtime.h>
#include <cstdio>
#include <cstdint>
namespace pg8 {
#define PG8_LAS __attribute__((address_space(3)))
typedef unsigned short bf16_t;
typedef short bf16x8 __attribute__((ext_vector_type(8)));
typedef float f32x4 __attribute__((ext_vector_type(4)));
typedef unsigned u32x4 __attribute__((ext_vector_type(4)));
constexpr int BM = 256, BK = 64, HALF = 128, HTB = HALF * BK * 2  , STAGE_BYTES = 8 * HTB, NXCD = 8, WGM = 8;

__host__ __device__ __forceinline__ int lds_byte(int r, int c) { const int st = (r >> 4) * 2 + (c >> 5), rr = r & 15, cc = c & 31, ob = rr * 64 + cc * 2; return st * 1024 + (ob ^ (((ob >> 9) & 1) << 5)); }
__host__ __device__ __forceinline__ void stage_rc(int b, int& R, int& C) { const int st = b / 1024, sb = b % 1024, swz = sb ^ (((sb >> 9) & 1) << 5); R = (st >> 1) * 16 + swz / 64; C = (st & 1) * 32 + (swz % 64) / 2; }
__host__ __device__ __forceinline__ int perm32(int rho) { const int n = rho >> 4, i = rho & 15; return 8 * (i >> 2) + 4 * n + (i & 3); }

struct Unit { int pm, pn; };
struct Gemm { const bf16_t* A; const bf16_t* Bt; int M, N, K; };

struct StaticOrder {
    int nM, nN, nwg, G, c;
    __host__ __device__ void init(int M, int N, int G_, int c_) { nM = M / BM; nN = N / BM; nwg = nM * nN; G = G_; c = c_; }
    __host__ __device__ bool next(int i, Unit& u) const {
        const long L = (long)i * G + c; if (L >= nwg) return false;
        int wgid = (int)L; { const int q = nwg / NXCD, r = nwg % NXCD, xcd = wgid % NXCD, off = wgid / NXCD; wgid = (xcd < r ? xcd * (q + 1) : r * (q + 1) + (xcd - r) * q) + off; }
        const int nig = WGM * nN, gid = wgid / nig, fm = gid * WGM, gsz = (nM - fm) < WGM ? (nM - fm) : WGM;
        u.pm = fm + ((wgid % nig) % gsz); u.pn = (wgid % nig) / gsz; return true;
    }
    __device__ __forceinline__ void a_ready(const Unit&) const {}
    __device__ __forceinline__ void done(const Unit&) const {}
};

typedef float f32x2 __attribute__((ext_vector_type(2)));
typedef __bf16 bf16x2v __attribute__((ext_vector_type(2)));
typedef unsigned u32x2 __attribute__((ext_vector_type(2)));
__device__ __forceinline__ unsigned pk2(float lo, float hi) { const bf16x2v v = __builtin_convertvector((f32x2){lo, hi}, bf16x2v); return __builtin_bit_cast(unsigned, v); }
__device__ __forceinline__ u32x4 pk8(const f32x4 a, const f32x4 b) { u32x4 w; w.x = pk2(a[0], a[1]); w.y = pk2(a[2], a[3]); w.z = pk2(b[0], b[1]); w.w = pk2(b[2], b[3]); return w; }

typedef int i32x4 __attribute__((ext_vector_type(4)));
template <bool I8> struct AccT { typedef f32x4 type; static __device__ __forceinline__ type zero() { return (f32x4){0.f, 0.f, 0.f, 0.f}; } };
template <> struct AccT<true> { typedef i32x4 type; static __device__ __forceinline__ type zero() { return (i32x4){0, 0, 0, 0}; } };
__device__ __forceinline__ f32x4 mma16(const bf16x8 b, const bf16x8 a, const f32x4 c) { return __builtin_amdgcn_mfma_f32_16x16x32_bf16(b, a, c, 0, 0, 0); }
__device__ __forceinline__ i32x4 mma16(const bf16x8 b, const bf16x8 a, const i32x4 c) { return __builtin_amdgcn_mfma_i32_16x16x64_i8(__builtin_bit_cast(i32x4, b), __builtin_bit_cast(i32x4, a), c, 0, 0, 0); }
__device__ __forceinline__ f32x4 dq4(const f32x4 a, const float, const f32x4) { return a; }
__device__ __forceinline__ f32x4 dq4(const i32x4 a, const float ra, const f32x4 cb) { return (f32x4){(float)a[0], (float)a[1], (float)a[2], (float)a[3]} * ra * cb; }
constexpr int TOK_P = 65536;

template <bool I8> struct EpiBf16P {
    static constexpr bool PERM = true, AFTER_DRAIN = false;
    bf16_t* O; int ldc; const float* sa; const float* sb;
    __device__ __forceinline__ void operator()(const typename AccT<I8>::type (&acc)[2][2][4][2], const Unit& u, int wr, int wc, int fr, int fq) const {
        const int row0 = u.pm * BM + wr * 64 + fr, col0 = u.pn * BM + wc * 32 + 8 * fq;
        f32x4 cb[2][2];
#pragma unroll
        for (int bj = 0; bj < 2; ++bj)
#pragma unroll
            for (int n = 0; n < 2; ++n) cb[bj][n] = I8 ? *(const f32x4*)(sb + col0 + bj * HALF + 4 * n) : (f32x4){1.f, 1.f, 1.f, 1.f};
#pragma unroll
        for (int ai = 0; ai < 2; ++ai)
#pragma unroll
            for (int m = 0; m < 4; ++m) { const int row = row0 + ai * HALF + m * 16; const float ra = I8 ? sa[row] : 1.f; bf16_t* rowp = O + (size_t)row * ldc + col0;
#pragma unroll
                for (int bj = 0; bj < 2; ++bj) *(u32x4*)(rowp + bj * HALF) = pk8(dq4(acc[ai][bj][m][0], ra, cb[bj][0]), dq4(acc[ai][bj][m][1], ra, cb[bj][1])); }
    }
};
template <bool I8> struct EpiGate {
    static constexpr bool PERM = true, AFTER_DRAIN = false;
    bf16_t* U; bf16_t* Bg; const float* sa; const float* sb;
    __device__ __forceinline__ void operator()(const typename AccT<I8>::type (&acc)[2][2][4][2], const Unit& u, int wr, int wc, int fr, int fq) const {
        const int row0 = u.pm * BM + wr * 64 + fr, scol0 = u.pn * BM + wc * 32 + 8 * fq;
        f32x4 cb[2][2];
#pragma unroll
        for (int bj = 0; bj < 2; ++bj)
#pragma unroll
            for (int n = 0; n < 2; ++n) cb[bj][n] = I8 ? *(const f32x4*)(sb + scol0 + bj * HALF + 4 * n) : (f32x4){1.f, 1.f, 1.f, 1.f};
        if (u.pn < 8) {
            const int col0 = u.pn * HALF + wc * 32 + 8 * fq;
#pragma unroll
            for (int ai = 0; ai < 2; ++ai)
#pragma unroll
                for (int m = 0; m < 4; ++m) { const int row = row0 + ai * HALF + m * 16; const float ra = I8 ? sa[row] : 1.f;
                    const f32x4 v0 = dq4(acc[ai][0][m][0], ra, cb[0][0]) * dq4(acc[ai][1][m][0], ra, cb[1][0]), v1 = dq4(acc[ai][0][m][1], ra, cb[0][1]) * dq4(acc[ai][1][m][1], ra, cb[1][1]);
                    *(u32x4*)(U + (size_t)row * 1024 + col0) = pk8(v0, v1); }
        } else {
            const int col0 = (u.pn - 8) * BM + wc * 32 + 8 * fq;
#pragma unroll
            for (int ai = 0; ai < 2; ++ai)
#pragma unroll
                for (int m = 0; m < 4; ++m) { const int row = row0 + ai * HALF + m * 16; const float ra = I8 ? sa[row] : 1.f; bf16_t* rowp = Bg + (size_t)row * 1024 + col0;
#pragma unroll
                    for (int bj = 0; bj < 2; ++bj) *(u32x4*)(rowp + bj * HALF) = pk8(dq4(acc[ai][bj][m][0], ra, cb[bj][0]), dq4(acc[ai][bj][m][1], ra, cb[bj][1])); }
        }
    }
};
template <bool I8> struct EpiRes {
    static constexpr bool PERM = true, AFTER_DRAIN = false;
    const bf16_t* H; bf16_t* R; float alpha; const float* sa; const float* sb;
    __device__ __forceinline__ void operator()(const typename AccT<I8>::type (&acc)[2][2][4][2], const Unit& u, int wr, int wc, int fr, int fq) const {
        const int row0 = u.pm * BM + wr * 64 + fr, col0 = u.pn * BM + wc * 32 + 8 * fq;
        f32x4 cb[2][2];
#pragma unroll
        for (int bj = 0; bj < 2; ++bj)
#pragma unroll
            for (int n = 0; n < 2; ++n) cb[bj][n] = I8 ? *(const f32x4*)(sb + col0 + bj * HALF + 4 * n) : (f32x4){1.f, 1.f, 1.f, 1.f};
#pragma unroll
        for (int ai = 0; ai < 2; ++ai)
#pragma unroll
            for (int m = 0; m < 4; ++m) { const int row = row0 + ai * HALF + m * 16; const float ra = I8 ? sa[row] : 1.f; const size_t off = (size_t)row * 1024 + col0;
#pragma unroll
                for (int bj = 0; bj < 2; ++bj) { const u32x4 h = *(const u32x4*)(H + off + bj * HALF);
                    f32x4 h0, h1; h0[0] = __uint_as_float(h.x << 16); h0[1] = __uint_as_float(h.x & 0xffff0000u); h0[2] = __uint_as_float(h.y << 16); h0[3] = __uint_as_float(h.y & 0xffff0000u);
                    h1[0] = __uint_as_float(h.z << 16); h1[1] = __uint_as_float(h.z & 0xffff0000u); h1[2] = __uint_as_float(h.w << 16); h1[3] = __uint_as_float(h.w & 0xffff0000u);
                    *(u32x4*)(R + off + bj * HALF) = pk8(h0 * alpha + dq4(acc[ai][bj][m][0], ra, cb[bj][0]), h1 * alpha + dq4(acc[ai][bj][m][1], ra, cb[bj][1])); } }
    }
};
template <bool I8> struct EpiKV {
    static constexpr bool PERM = true, AFTER_DRAIN = false;
    bf16_t* Kb; bf16_t* Vb; float* kp; float* vp; float* ks; float* vs; const float* sa; const float* sb;
    __device__ __forceinline__ void operator()(const typename AccT<I8>::type (&acc)[2][2][4][2], const Unit& u, int wr, int wc, int fr, int fq) const {
        const bool isv = u.pn >= 4; const int colt = (isv ? u.pn - 4 : u.pn) * BM;
        bf16_t* ob = isv ? Vb : Kb; const bool samp = u.pm * BM >= TOK_P;
        float* of = samp ? (isv ? vs : ks) - (size_t)TOK_P * 1024 : (isv ? vp : kp);
        const int row0 = u.pm * BM + wr * 64 + fr, col0 = colt + wc * 32 + 8 * fq, scol0 = u.pn * BM + wc * 32 + 8 * fq;
        f32x4 cb[2][2];
#pragma unroll
        for (int bj = 0; bj < 2; ++bj)
#pragma unroll
            for (int n = 0; n < 2; ++n) cb[bj][n] = I8 ? *(const f32x4*)(sb + scol0 + bj * HALF + 4 * n) : (f32x4){1.f, 1.f, 1.f, 1.f};
#pragma unroll
        for (int ai = 0; ai < 2; ++ai)
#pragma unroll
            for (int m = 0; m < 4; ++m) { const int row = row0 + ai * HALF + m * 16; const float ra = I8 ? sa[row] : 1.f; const size_t off = (size_t)row * 1024 + col0;
#pragma unroll
                for (int bj = 0; bj < 2; ++bj) { const f32x4 v0 = dq4(acc[ai][bj][m][0], ra, cb[bj][0]), v1 = dq4(acc[ai][bj][m][1], ra, cb[bj][1]);
                    *(u32x4*)(ob + off + bj * HALF) = pk8(v0, v1); *(f32x4*)(of + off + bj * HALF) = v0; *(f32x4*)(of + off + bj * HALF + 4) = v1; } }
    }
};

struct EpiScoreI8 {
    static constexpr bool PERM = true, AFTER_DRAIN = false;
    bf16_t* O; int ldc; const float* sa; const float* sb;
    __device__ __forceinline__ void operator()(const i32x4 (&acc)[2][2][4][2], const Unit& u, int wr, int wc, int fr, int fq) const {
        const int row0 = u.pm * BM + wr * 64 + fr, col0 = u.pn * BM + wc * 32 + 8 * fq;
        f32x4 cb[2][2];
#pragma unroll
        for (int bj = 0; bj < 2; ++bj)
#pragma unroll
            for (int n = 0; n < 2; ++n) cb[bj][n] = *(const f32x4*)(sb + col0 + bj * HALF + 4 * n);
#pragma unroll
        for (int ai = 0; ai < 2; ++ai)
#pragma unroll
            for (int m = 0; m < 4; ++m) { const int row = row0 + ai * HALF + m * 16; const float ra = sa[row]; bf16_t* rowp = O + (size_t)row * ldc + col0;
#pragma unroll
                for (int bj = 0; bj < 2; ++bj) { f32x4 v0, v1;
#pragma unroll
                    for (int i = 0; i < 4; ++i) { v0[i] = (float)acc[ai][bj][m][0][i] * ra * cb[bj][0][i]; v1[i] = (float)acc[ai][bj][m][1][i] * ra * cb[bj][1][i]; }
                    *(u32x4*)(rowp + bj * HALF) = pk8(v0, v1); } }
    }
};

template <class Epi, class Sched, bool ALIGN_EPI = false, bool SP2 = false, bool I8 = false>
__device__ __forceinline__ void gemm_phase(PG8_LAS unsigned char* lds, const Gemm g, const Sched& S, const Epi& E, const int tid_in) {
    int tid_ = tid_in; asm volatile("" : "+v"(tid_));
    const int tid = tid_, wid = __builtin_amdgcn_readfirstlane(tid >> 6), lane = tid & 63, wr = wid >> 2, wc = wid & 3, fr = lane & 15, fq = lane >> 4;
    const int K = g.K, nt = K / BK;
    unsigned voffA[2], voffB[2];
#pragma unroll
    for (int i = 0; i < 2; ++i) { int R, C; stage_rc(tid * 16 + i * 8192, R, C); const int Rb = Epi::PERM ? ((R & ~31) + perm32(R & 31)) : R;
        voffA[i] = (unsigned)(R * K + C) * 2u; voffB[i] = (unsigned)(Rb * K + C) * 2u; }
    const size_t kstep = (size_t)(BK * 2);
    const size_t hstep = (size_t)HALF * K * 2;
    const size_t tstep = 2 * hstep;
    const unsigned ldsw = (unsigned)wid * 1024u;
    const int aoff = lds_byte(wr * 64 + fr, fq * 8), boff = lds_byte(wc * 32 + fr, fq * 8);
#define PG8_SA(b, h) (((b) * 2 + (h)) * HTB)
#define PG8_SB(b, h) ((4 + (b) * 2 + (h)) * HTB)
#define PG8_STAGE(bufoff, gbase, voff) do { _Pragma("unroll") for (int _i = 0; _i < 2; ++_i) \
        __builtin_amdgcn_global_load_lds((const unsigned*)((const char*)(gbase) + (voff)[_i]), (PG8_LAS unsigned*)(lds + (bufoff) + ldsw + _i * 8192), 16, 0, 0); } while (0)
#define PG8_LDA(dst, b, h) do { _Pragma("unroll") for (int m = 0; m < 4; ++m) _Pragma("unroll") for (int k = 0; k < 2; ++k) dst[m][k] = *(const PG8_LAS bf16x8*)(lds + PG8_SA(b, h) + aoff + m * 2048 + k * 1024); } while (0)
#define PG8_LDB(dst, b, h) do { _Pragma("unroll") for (int n = 0; n < 2; ++n) _Pragma("unroll") for (int k = 0; k < 2; ++k) dst[n][k] = *(const PG8_LAS bf16x8*)(lds + PG8_SB(b, h) + boff + n * 2048 + k * 1024); } while (0)
#define PG8_MMA(ai, bj, At, Bt) do { __builtin_amdgcn_s_setprio(1); _Pragma("unroll") for (int m = 0; m < 4; ++m) _Pragma("unroll") for (int n = 0; n < 2; ++n) _Pragma("unroll") for (int k = 0; k < 2; ++k) \
        acc[ai][bj][m][n] = mma16(Bt[n][k], At[m][k], acc[ai][bj][m][n]); __builtin_amdgcn_s_setprio(0); } while (0)
#define PG8_WAIT_V(n) asm volatile("s_waitcnt vmcnt(" #n ")" ::: "memory")
#define PG8_WAIT_L(n) asm volatile("s_waitcnt lgkmcnt(" #n ")" ::: "memory")
#define PG8_BAR __builtin_amdgcn_s_barrier()
#define PG8_SCHED __builtin_amdgcn_sched_barrier(0)
    Unit cur, nxt; int ui = 0;
    if (!S.next(0, cur)) return;
    typename AccT<I8>::type acc[2][2][4][2];
#pragma unroll
    for (int a = 0; a < 2; ++a)
#pragma unroll
        for (int b = 0; b < 2; ++b)
#pragma unroll
            for (int m = 0; m < 4; ++m)
#pragma unroll
                for (int n = 0; n < 2; ++n) acc[a][b][m][n] = AccT<I8>::zero();
    bf16x8 At[4][2], B0[2][2], B1[2][2];
    const char* cA = (const char*)g.A + (size_t)cur.pm * tstep; const char* cB = (const char*)g.Bt + (size_t)cur.pn * tstep;
    S.a_ready(cur);
    if constexpr (SP2) {
        PG8_STAGE(PG8_SB(0, 0), cB, voffB); PG8_STAGE(PG8_SB(0, 1), cB + hstep, voffB); PG8_STAGE(PG8_SA(0, 0), cA, voffA); PG8_STAGE(PG8_SA(0, 1), cA + hstep, voffA);
        if (wr == 1) PG8_BAR;
        PG8_WAIT_V(2); PG8_BAR;
        PG8_STAGE(PG8_SB(1, 0), cB + kstep, voffB); PG8_STAGE(PG8_SA(1, 0), cA + kstep, voffA); PG8_STAGE(PG8_SB(1, 1), cB + hstep + kstep, voffB);
        PG8_WAIT_V(6); PG8_BAR;
    } else {
        PG8_STAGE(PG8_SB(0, 0), cB, voffB); PG8_STAGE(PG8_SA(0, 0), cA, voffA); PG8_STAGE(PG8_SB(0, 1), cB + hstep, voffB); PG8_STAGE(PG8_SA(0, 1), cA + hstep, voffA);
        if (wr == 1) PG8_BAR;
        PG8_WAIT_V(4); PG8_BAR;
        PG8_STAGE(PG8_SB(1, 0), cB + kstep, voffB); PG8_STAGE(PG8_SA(1, 0), cA + kstep, voffA); PG8_STAGE(PG8_SB(1, 1), cB + hstep + kstep, voffB);
        PG8_WAIT_V(6); PG8_BAR;
    }
    for (;;) {
        const bool has_next = S.next(ui + 1, nxt);
        const char* nA = has_next ? (const char*)g.A + (size_t)nxt.pm * tstep : cA; const char* nB = has_next ? (const char*)g.Bt + (size_t)nxt.pn * tstep : cB;
        for (int t = 0; t < nt; t += 2) {
            const bool last = (t == nt - 2);
            const char* a1 = cA + (size_t)(t + 1) * kstep;
            const char* a2 = last ? nA : cA + (size_t)(t + 2) * kstep; const char* b2 = last ? nB : cB + (size_t)(t + 2) * kstep;
            const char* a3 = a2 + kstep; const char* b3 = b2 + kstep;
            if (last && has_next) S.a_ready(nxt);
            if constexpr (SP2) {
            PG8_LDB(B0, 0, 0); PG8_LDB(B1, 0, 1); PG8_SCHED; PG8_LDA(At, 0, 0); PG8_STAGE(PG8_SA(1, 1), a1 + hstep, voffA);
            PG8_WAIT_V(8); PG8_WAIT_L(0); PG8_BAR; PG8_MMA(0, 0, At, B0); PG8_MMA(0, 1, At, B1); PG8_BAR; PG8_SCHED;
            PG8_LDA(At, 0, 1); PG8_STAGE(PG8_SB(0, 0), b2, voffB); PG8_STAGE(PG8_SB(0, 1), b2 + hstep, voffB); PG8_STAGE(PG8_SA(0, 0), a2, voffA);
            PG8_WAIT_V(8); PG8_WAIT_L(0); PG8_BAR; PG8_MMA(1, 0, At, B0); PG8_MMA(1, 1, At, B1); PG8_BAR; PG8_SCHED;
            PG8_LDB(B0, 1, 0); PG8_LDB(B1, 1, 1); PG8_SCHED; PG8_LDA(At, 1, 0); PG8_STAGE(PG8_SA(0, 1), a2 + hstep, voffA);
            PG8_WAIT_V(8); PG8_WAIT_L(0); PG8_BAR; PG8_MMA(0, 0, At, B0); PG8_MMA(0, 1, At, B1); PG8_BAR; PG8_SCHED;
            PG8_LDA(At, 1, 1); PG8_STAGE(PG8_SB(1, 0), b3, voffB); PG8_STAGE(PG8_SB(1, 1), b3 + hstep, voffB); PG8_STAGE(PG8_SA(1, 0), a3, voffA);
            PG8_WAIT_V(8); PG8_WAIT_L(0); PG8_BAR; PG8_MMA(1, 0, At, B0); PG8_MMA(1, 1, At, B1); PG8_BAR; PG8_SCHED;
            } else {
            PG8_LDB(B0, 0, 0); PG8_SCHED; PG8_LDA(At, 0, 0); PG8_STAGE(PG8_SA(1, 1), a1 + hstep, voffA);
            PG8_WAIT_L(8); PG8_BAR; PG8_WAIT_L(0); PG8_MMA(0, 0, At, B0); PG8_BAR; PG8_SCHED;
            PG8_LDB(B1, 0, 1); PG8_STAGE(PG8_SB(0, 0), b2, voffB);
            PG8_BAR; PG8_WAIT_L(0); PG8_MMA(0, 1, At, B1); PG8_BAR;
            PG8_LDA(At, 0, 1); PG8_STAGE(PG8_SA(0, 0), a2, voffA);
            PG8_BAR; PG8_WAIT_L(0); PG8_MMA(1, 0, At, B0); PG8_BAR; PG8_SCHED;
            PG8_STAGE(PG8_SB(0, 1), b2 + hstep, voffB);
            PG8_WAIT_V(6); PG8_BAR; PG8_MMA(1, 1, At, B1); PG8_BAR;
            PG8_LDB(B0, 1, 0); PG8_SCHED; PG8_LDA(At, 1, 0); PG8_STAGE(PG8_SA(0, 1), a2 + hstep, voffA);
            PG8_WAIT_L(8); PG8_BAR; PG8_WAIT_L(0); PG8_MMA(0, 0, At, B0); PG8_BAR; PG8_SCHED;
            PG8_LDB(B1, 1, 1); PG8_STAGE(PG8_SB(1, 0), b3, voffB);
            PG8_BAR; PG8_WAIT_L(0); PG8_MMA(0, 1, At, B1); PG8_BAR;
            PG8_LDA(At, 1, 1); PG8_STAGE(PG8_SA(1, 0), a3, voffA);
            PG8_BAR; PG8_WAIT_L(0); PG8_MMA(1, 0, At, B0); PG8_BAR; PG8_SCHED;
            PG8_STAGE(PG8_SB(1, 1), b3 + hstep, voffB);
            PG8_WAIT_V(6); PG8_BAR; PG8_MMA(1, 1, At, B1); PG8_BAR;
            }
        }
        if constexpr (ALIGN_EPI) { if (wr == 0) PG8_BAR; }
        if constexpr (!Epi::AFTER_DRAIN) { E(acc, cur, wr, wc, fr, fq); S.done(cur); }
        if (!has_next) break;
#pragma unroll
        for (int a = 0; a < 2; ++a)
#pragma unroll
            for (int b = 0; b < 2; ++b)
#pragma unroll
                for (int m = 0; m < 4; ++m)
#pragma unroll
                    for (int n = 0; n < 2; ++n) acc[a][b][m][n] = AccT<I8>::zero();
        cur = nxt; cA = nA; cB = nB; ++ui;
        if constexpr (ALIGN_EPI) { if (wr == 1) PG8_BAR; }
    }
    PG8_WAIT_V(0);
    if constexpr (!ALIGN_EPI) { if (wr == 0) PG8_BAR; }
    PG8_BAR;
    if constexpr (Epi::AFTER_DRAIN) { E.fused(acc, cur, wr, wc, fr, fq, lds, wid, lane); S.done(cur); }
#undef PG8_SA
#undef PG8_SB
#undef PG8_STAGE
#undef PG8_LDA
#undef PG8_LDB
#undef PG8_MMA
#undef PG8_WAIT_V
#undef PG8_WAIT_L
#undef PG8_BAR
#undef PG8_SCHED
}
}

#define GAS __attribute__((address_space(1)))
#define LAS __attribute__((address_space(3)))
#define DI __device__ __forceinline__
typedef unsigned short bf16;
typedef unsigned v4u __attribute__((ext_vector_type(4)));
typedef unsigned v2u __attribute__((ext_vector_type(2)));
typedef float f32x4 __attribute__((ext_vector_type(4)));
typedef float f32x16 __attribute__((ext_vector_type(16)));
typedef short bf16x8 __attribute__((ext_vector_type(8)));
using pg8::pk2;
#define LDS_WAIT() asm volatile("s_waitcnt lgkmcnt(0)" ::: "memory")
#define MFMA32(a, b, c) __builtin_amdgcn_mfma_f32_32x32x16_bf16((a), (b), (c), 0, 0, 0)

constexpr int D = 1024, NB = 32, SEQ = 2048, DSEQ = 16, PAST = 1024, NH = 16, DH = 64;
constexpr int TP = NB * SEQ, TS = NB * DSEQ, T = TP + TS;
constexpr int NEXP = 16384, PH = 8, PK = 16;
constexpr int NLAYER = 4;
constexpr float LN_EPS = 1e-5f;
constexpr float ALPHA = 1.6817928305074292f;
constexpr float LOG2E = 1.4426950408889634f, LN2 = 0.6931471805599453f;
static_assert(T % 256 == 0 && pg8::TOK_P == TP, "row panels");
constexpr size_t O_Y = 0, O_YS = (size_t)TP * D, O_CONVP = O_YS + (size_t)TS * D, O_KP = O_CONVP + 2 * NB * 2 * D, O_VP = O_KP + (size_t)TP * D,
                 O_CONVS = O_VP + (size_t)TP * D, O_KS = O_CONVS + 2 * NB * 2 * D, O_VS = O_KS + (size_t)TS * D, O_END = O_VS + (size_t)TS * D;
static_assert(O_END == 203161600ull, "output size");
constexpr size_t MiB = 1u << 20;
constexpr size_t WS_CTL = 0, CTL_BYTES = 2 * MiB;
constexpr size_t WS_WIN = 2 * MiB;
constexpr size_t WS_WOUT = WS_WIN + 12 * MiB;
constexpr size_t WS_WQ = WS_WOUT + 4 * MiB;
constexpr size_t WS_WO = WS_WQ + 4 * MiB;
constexpr size_t WS_WKV = WS_WO + 4 * MiB;
constexpr size_t WS_WP = WS_WKV + 4 * MiB;
constexpr size_t WS_VSN = WS_WP + 16 * MiB;
constexpr size_t WS_H = WS_VSN + 1 * MiB;
constexpr size_t WS_KB = WS_H + 129 * MiB;
constexpr size_t WS_VT = WS_KB + 129 * MiB;
constexpr size_t WS_IDS = WS_VT + 128 * MiB;
constexpr size_t WS_GATE = WS_IDS + 17 * MiB;
constexpr size_t WS_TU = WS_GATE + 33 * MiB;
constexpr size_t WS_TV = WS_TU + 64 * MiB;
constexpr size_t WS_SU = WS_TV + 64 * MiB;
constexpr size_t WS_W8 = WS_SU + 1 * MiB;
constexpr size_t WS_SX = WS_W8 + 9 * MiB;
constexpr size_t WS_X8 = WS_SX + 1 * MiB;
constexpr size_t WS_W8A = WS_X8 + 65 * MiB;
constexpr size_t WS_SWA = WS_W8A + 22 * MiB;
constexpr int W8_ROWS = (int)((WS_VSN - WS_WIN) / 2048);
static_assert(W8_ROWS == 22528, "weight rows");
constexpr size_t WS_A = WS_SWA + 1 * MiB;
constexpr size_t WS_END = WS_A + 258 * MiB;
static_assert((size_t)T * D * 2 == 129 * MiB && (size_t)1024 * T * 4 == 258 * MiB, "sizes");
constexpr int CW_Q = 1024;
constexpr int CW_BAR = 16384;

constexpr int RING_BYTES = 131072, MISC_OFF = RING_BYTES + 320, LDS_BYTES = 147456;

#define XB_TMO      128
#define XB_XCNT(j)  (256  + 64 * (j))
#define XB_XSUB(j)  (1280 + 64 * (j))
#define XB_XGEN(j)  (2304 + 64 * (j))
#define XB_TOP      3328
#define XB_TOPGEN   3392
#define XCD_BAR_WORDS 3456
#define XB_SPIN_CAP (1u << 18)

__device__ __forceinline__ unsigned xb_ld(unsigned* p)              { return __hip_atomic_load(p, __ATOMIC_RELAXED, __HIP_MEMORY_SCOPE_AGENT); }
__device__ __forceinline__ unsigned xb_add(unsigned* p, unsigned v) { return __hip_atomic_fetch_add(p, v, __ATOMIC_RELAXED, __HIP_MEMORY_SCOPE_AGENT); }
__device__ __forceinline__ unsigned xb_xcc_id() { return (unsigned)__builtin_amdgcn_s_getreg((3 << 11) | 20) & 0xFu; }
#define XB_SPIN(cond, bar) do { unsigned _sp = 0; while (cond) { __builtin_amdgcn_s_sleep(1); \
    if ((++_sp & 255u) == 0u) { if (xb_ld(&(bar)[XB_TMO])) break; if (_sp > XB_SPIN_CAP) { atomicAdd(&(bar)[XB_TMO], 1u); break; } } } } while (0)

__device__ __forceinline__ int xb_lane_id() { int l; asm volatile("v_mbcnt_lo_u32_b32 %0, -1, 0\n\tv_mbcnt_hi_u32_b32 %0, -1, %0" : "=v"(l)); return l; }
__device__ __forceinline__ bool xb_is_thread0(unsigned w0) { return w0 != 0u && xb_lane_id() == 0; }
struct XcdBarrier {
    unsigned w0;
    unsigned* bar; unsigned x;
    volatile LAS unsigned* st;
};

__device__ __forceinline__ XcdBarrier xcd_barrier_post(unsigned* bar, volatile LAS unsigned* st, unsigned w0) {
    XcdBarrier b; b.w0 = w0; b.bar = bar; b.x = xb_xcc_id(); b.st = st;
    if (xb_is_thread0(b.w0)) (void)xb_add(&bar[XB_XCNT(b.x)], 1u);
    return b;
}
__device__ __forceinline__ void xcd_barrier_complete(unsigned* bar, unsigned x, unsigned& nloc, unsigned& nx) {
    const unsigned G = gridDim.x * gridDim.y * gridDim.z;
    unsigned sum, cnt, mine, sp = 0u;
    for (;;) {
        sum = 0u; cnt = 0u; mine = 0u;
#pragma unroll
        for (unsigned j = 0; j < 16; ++j) { const unsigned c = xb_ld(&bar[XB_XCNT(j)]); sum += c; cnt += (c > 0u) ? 1u : 0u; mine = (j == x) ? c : mine; }
        if (sum == G) break;
        __builtin_amdgcn_s_sleep(1);
        if ((++sp & 255u) == 0u) { if (xb_ld(&bar[XB_TMO])) break; if (sp > XB_SPIN_CAP) { atomicAdd(&bar[XB_TMO], 1u); break; } }
    }
    nloc = mine > 0u ? mine : 1u; nx = cnt > 0u ? cnt : 1u;
}

__device__ __forceinline__ void xcd_barrier(const XcdBarrier& b) {
    asm volatile("s_waitcnt vmcnt(0)" ::: "memory");
    __syncthreads();
    if (xb_is_thread0(b.w0)) {
        unsigned* bar = b.bar;
        __builtin_amdgcn_s_waitcnt(0);
        unsigned nloc = b.st[0], nx = b.st[1];
        if (nloc == 0u) { xcd_barrier_complete(bar, b.x, nloc, nx); b.st[0] = nloc; b.st[1] = nx; }
        const unsigned old = xb_add(&bar[XB_XSUB(b.x)], 1u);
        const unsigned gen = old / nloc;
        if (old + 1u == (gen + 1u) * nloc) {
            __builtin_amdgcn_fence(__ATOMIC_RELEASE, "agent");
            asm volatile("s_waitcnt vmcnt(0)" ::: "memory");
            const unsigned og = xb_add(&bar[XB_TOP], 1u);
            const unsigned tg = og / nx;
            if (og + 1u == (tg + 1u) * nx) xb_add(&bar[XB_TOPGEN], 1u);
            else XB_SPIN(xb_ld(&bar[XB_TOPGEN]) == tg, bar);
            __builtin_amdgcn_fence(__ATOMIC_ACQUIRE, "agent");
            xb_add(&bar[XB_XGEN(b.x)], 1u);
            asm volatile("s_waitcnt vmcnt(0)" ::: "memory");
        } else {
            XB_SPIN(xb_ld(&bar[XB_XGEN(b.x)]) == gen, bar);
            __builtin_amdgcn_fence(__ATOMIC_ACQUIRE, "agent");
            asm volatile("s_waitcnt vmcnt(0)" ::: "memory");
        }
    }
    __syncthreads();
}


DI float bflo(unsigned w) { return __uint_as_float(w << 16); }
DI float bfhi(unsigned w) { return __uint_as_float(w & 0xffff0000u); }
DI float shx(const int lane, const float v, const int o) { return __int_as_float(__builtin_amdgcn_ds_bpermute((lane ^ o) << 2, __float_as_int(v))); }
DI int shx(const int lane, const int v, const int o) { return __builtin_amdgcn_ds_bpermute((lane ^ o) << 2, v); }
DI float wave_sum(const int lane, float v) {
#pragma unroll
    for (int o = 1; o < 64; o <<= 1) v += shx(lane, v, o);
    return v;
}
DI bf16x8 pack8(float a0, float a1, float a2, float a3, float a4, float a5, float a6, float a7) {
    v4u p; p.x = pk2(a0, a1); p.y = pk2(a2, a3); p.z = pk2(a4, a5); p.w = pk2(a6, a7); return __builtin_bit_cast(bf16x8, p);
}
DI float gelu_erf(float v) {
    const float av = __builtin_fabsf(v), d = av * 0.2316418882f + 1.0f, t = __builtin_amdgcn_rcpf(d);
    float q = t * 0.5307027145f + (-0.7265760135f); q = q * t + 0.7107068705f; q = q * t + (-0.142248368f); q = q * t + 0.127414796f; q = q * t;
    const float e = __builtin_amdgcn_exp2f((v * v) * (-0.72134752044f));
    const float m = v * (q * e), r = v - m;
    return v < 0.f ? m : r;
}

struct Ctx {
    int tid, lane, wave, vcu, G;
};

DI void p0_transpose_item(const float* W, int K, int N, bf16* WT, int out_row0, float scale, LAS float* scr, int k0, int n0, int lane) {
#pragma unroll 8
    for (int i = 0; i < 32; ++i) { const int kk = 2 * i + (lane >> 5); scr[kk * 33 + (lane & 31)] = W[(size_t)(k0 + kk) * N + n0 + (lane & 31)]; }
    LDS_WAIT(); asm volatile("" ::: "memory");
    const int c = lane & 7;
#pragma unroll
    for (int j = 0; j < 4; ++j) { const int n = (lane >> 3) + 8 * j; const LAS float* s = scr + (8 * c) * 33 + n;
        v4u o; o.x = pk2(s[0 * 33] * scale, s[1 * 33] * scale); o.y = pk2(s[2 * 33] * scale, s[3 * 33] * scale); o.z = pk2(s[4 * 33] * scale, s[5 * 33] * scale); o.w = pk2(s[6 * 33] * scale, s[7 * 33] * scale);
        *(v4u*)(WT + (size_t)(out_row0 + n) * K + k0 + 8 * c) = o; }
    LDS_WAIT(); asm volatile("" ::: "memory");
}
DI void cvt_stream(const float* src, bf16* dst, size_t n8, size_t gtid, size_t NT) {
    size_t i = gtid;
    for (; i + 3 * NT < n8; i += 4 * NT) {
        f32x4 a[4], b[4];
#pragma unroll
        for (int u = 0; u < 4; ++u) { a[u] = *(const f32x4*)(src + (i + u * NT) * 8); b[u] = *(const f32x4*)(src + (i + u * NT) * 8 + 4); }
#pragma unroll
        for (int u = 0; u < 4; ++u) *(v4u*)(dst + (i + u * NT) * 8) = pg8::pk8(a[u], b[u]);
    }
    for (; i < n8; i += NT) { const f32x4 a = *(const f32x4*)(src + i * 8), b = *(const f32x4*)(src + i * 8 + 4); *(v4u*)(dst + i * 8) = pg8::pk8(a, b); }
}
DI unsigned q4_i8(const f32x4 v, const float k) {
    const int a = (int)__builtin_rintf(v[0] * k), b = (int)__builtin_rintf(v[1] * k), c = (int)__builtin_rintf(v[2] * k), d = (int)__builtin_rintf(v[3] * k);
    return ((unsigned)a & 0xffu) | (((unsigned)b & 0xffu) << 8) | (((unsigned)c & 0xffu) << 16) | ((unsigned)d << 24);
}
DI void cvt_table_rows(const float* src, unsigned char* dst, float* scl, int nrows, int gw, int NGW, int lane) {
    f32x4 nx[4];
#pragma unroll
    for (int j = 0; j < 4; ++j) nx[j] = *(const f32x4*)(src + (size_t)(gw < nrows ? gw : 0) * D + 4 * lane + 256 * j);
    for (int row = gw; row < nrows; row += NGW) {
        f32x4 v[4]; float m = 0.f; const int rn = row + NGW < nrows ? row + NGW : row;
#pragma unroll
        for (int j = 0; j < 4; ++j) { v[j] = nx[j]; nx[j] = *(const f32x4*)(src + (size_t)rn * D + 4 * lane + 256 * j);
            m = __builtin_fmaxf(m, __builtin_fmaxf(__builtin_fmaxf(__builtin_fabsf(v[j][0]), __builtin_fabsf(v[j][1])), __builtin_fmaxf(__builtin_fabsf(v[j][2]), __builtin_fabsf(v[j][3])))); }
#pragma unroll
        for (int o = 1; o < 64; o <<= 1) m = __builtin_fmaxf(m, shx(lane, m, o));
        const float k = m > 0.f ? 127.0f / m : 0.f;
#pragma unroll
        for (int j = 0; j < 4; ++j)
            *(unsigned*)(dst + ((size_t)(row >> 14) * NEXP * D) + ((size_t)(2 * j + (lane >> 5)) * NEXP + (row & (NEXP - 1))) * 128 + ((4 * lane) & 127)) = q4_i8(v[j], k);
        if (lane == 0) scl[row] = m * (1.0f / 127.0f);
    }
}
struct P0Args { const float *x_p, *x_s, *w_in, *w_out, *wq, *wo, *wk, *wv, *pwq, *psk, *pu, *pv; bf16 *WinT, *WoutT, *WqT, *WoT, *WkvT, *WP, *H; unsigned char *TU, *TV; float *SU, *SV; unsigned char* X8; float* SX; };
DI void p0_prologue(const Ctx c, LAS unsigned char* lds, const P0Args a) {
    { LAS float* scr = (LAS float*)(lds + c.wave * 16384);
      const int gw = c.vcu * 8 + c.wave, NGW = c.G * 8;
      constexpr int IT_WIN = 16 * 96, IT_SQ = 16 * 32, NITEMS = 2 * IT_WIN + 8 * IT_SQ;
      for (int it = gw; it < NITEMS; it += NGW) {
          int r = it;
          if (r < 2 * IT_WIN) { const int l = r / IT_WIN; r -= l * IT_WIN; const int kb = r / 96, nb = r % 96, n0 = 32 * nb; int orow;
              if (n0 < 1024) orow = 2048 + n0; else if (n0 < 2048) { const int d = n0 - 1024; orow = 256 * (d >> 7) + (d & 127); } else { const int d = n0 - 2048; orow = 256 * (d >> 7) + 128 + (d & 127); }
              p0_transpose_item(a.w_in + (size_t)l * 1024 * 3072, 1024, 3072, a.WinT + (size_t)l * 3072 * 1024, orow, 1.f, scr, 64 * kb, n0, c.lane); continue; }
          r -= 2 * IT_WIN; const int m = r / IT_SQ; r -= m * IT_SQ; const int kb = r >> 5, nb = r & 31;
          const float* src; bf16* dst; float sc = 1.f; const size_t SQ = (size_t)1024 * 1024;
          if (m < 2) { src = a.w_out + m * SQ; dst = a.WoutT + m * SQ; }
          else if (m < 4) { src = a.wq + (m - 2) * SQ; dst = a.WqT + (m - 2) * SQ; sc = 0.125f * LOG2E; }
          else if (m < 6) { src = a.wo + (m - 4) * SQ; dst = a.WoT + (m - 4) * SQ; }
          else if (m == 6) { src = a.wk; dst = a.WkvT; }
          else { src = a.wv; dst = a.WkvT + SQ; }
          p0_transpose_item(src, 1024, 1024, dst, 32 * nb, sc, scr, 64 * kb, 32 * nb, c.lane);
      }
    }
    __syncthreads();
    { LAS float* skT = (LAS float*)lds; LAS float* wqT = skT + 128 * 132;
      for (int u = c.vcu; u < 4 * 16 * 16; u += c.G) {
          const int l = u >> 8, hp = (u >> 4) & 15, dblk = u & 15;
          for (int i = c.tid; i < 16384; i += 512) skT[(i & 127) * 132 + (i >> 7)] = a.psk[(size_t)(l * 16 + hp) * 16384 + i];
          for (int i = c.tid; i < 8192; i += 512) wqT[(i & 127) * 68 + (i >> 7)] = a.pwq[((size_t)l * 1024 + dblk * 64 + (i >> 7)) * 2048 + hp * 128 + (i & 127)];
          __syncthreads();
          const int ng = c.tid & 31, dg = c.tid >> 5; f32x4 acc[4];
#pragma unroll
          for (int i = 0; i < 4; ++i) acc[i] = (f32x4){0.f, 0.f, 0.f, 0.f};
#pragma unroll 4
          for (int cc = 0; cc < 128; ++cc) { const f32x4 s = *(const LAS f32x4*)(skT + cc * 132 + 4 * ng), w = *(const LAS f32x4*)(wqT + cc * 68 + 4 * dg);
#pragma unroll
              for (int i = 0; i < 4; ++i) acc[i] = acc[i] + w * s[i]; }
#pragma unroll
          for (int i = 0; i < 4; ++i) { v2u o; o.x = pk2(acc[i][0], acc[i][1]); o.y = pk2(acc[i][2], acc[i][3]);
              *(v2u*)(a.WP + ((size_t)l * 2048 + hp * 128 + 4 * ng + i) * 1024 + dblk * 64 + 4 * dg) = o; }
          __syncthreads();
      }
    }
    { const size_t gtid = (size_t)c.vcu * 512 + c.tid, NT = (size_t)c.G * 512;
      cvt_table_rows(a.pu, a.TU, a.SU, NLAYER * NEXP, c.vcu * 8 + c.wave, c.G * 8, c.lane);
      cvt_table_rows(a.pv, a.TV, a.SV, NLAYER * NEXP, c.vcu * 8 + c.wave, c.G * 8, c.lane);
      (void)gtid; (void)NT;
      for (int m = c.vcu * 8 + c.wave; m < T; m += c.G * 8) {
          const float* xr = (m < TP ? a.x_p + (size_t)m * D : a.x_s + (size_t)(m - TP) * D) + 4 * c.lane;
          f32x4 v[4]; float am = 0.f;
#pragma unroll
          for (int j = 0; j < 4; ++j) { v[j] = *(const f32x4*)(xr + 256 * j); v2u w; w.x = pk2(v[j][0], v[j][1]); w.y = pk2(v[j][2], v[j][3]); ((v2u*)(a.H + (size_t)m * D) + c.lane)[64 * j] = w;
              am = __builtin_fmaxf(am, __builtin_fmaxf(__builtin_fmaxf(__builtin_fabsf(v[j][0]), __builtin_fabsf(v[j][1])), __builtin_fmaxf(__builtin_fabsf(v[j][2]), __builtin_fabsf(v[j][3])))); }
#pragma unroll
          for (int o = 1; o < 64; o <<= 1) am = __builtin_fmaxf(am, shx(c.lane, am, o));
          const float k = am > 0.f ? 127.0f / am : 0.f;
#pragma unroll
          for (int j = 0; j < 4; ++j) *(unsigned*)(a.X8 + (size_t)m * D + 4 * c.lane + 256 * j) = q4_i8(v[j], k);
          if (c.lane == 0) a.SX[m] = am * (1.0f / 127.0f);
      }
    }
}

DI void wp_quant_phase(const Ctx c, const bf16* WPb, unsigned char* WP8q, float* swp) {
    for (int row = c.vcu * 8 + c.wave; row < W8_ROWS; row += c.G * 8) {
        const v4u a = *(const v4u*)(WPb + (size_t)row * D + 16 * c.lane), b = *(const v4u*)(WPb + (size_t)row * D + 16 * c.lane + 8);
        const f32x4 v0 = {bflo(a.x), bfhi(a.x), bflo(a.y), bfhi(a.y)}, v1 = {bflo(a.z), bfhi(a.z), bflo(a.w), bfhi(a.w)}, v2 = {bflo(b.x), bfhi(b.x), bflo(b.y), bfhi(b.y)}, v3 = {bflo(b.z), bfhi(b.z), bflo(b.w), bfhi(b.w)};
        float m = 0.f;
#pragma unroll
        for (int i = 0; i < 4; ++i) m = __builtin_fmaxf(m, __builtin_fmaxf(__builtin_fmaxf(__builtin_fabsf(v0[i]), __builtin_fabsf(v1[i])), __builtin_fmaxf(__builtin_fabsf(v2[i]), __builtin_fabsf(v3[i]))));
#pragma unroll
        for (int o = 1; o < 64; o <<= 1) m = __builtin_fmaxf(m, shx(c.lane, m, o));
        const float k = m > 0.f ? 127.0f / m : 0.f;
        v4u o; o.x = q4_i8(v0, k); o.y = q4_i8(v1, k); o.z = q4_i8(v2, k); o.w = q4_i8(v3, k);
        *(v4u*)(WP8q + (size_t)row * D + 16 * c.lane) = o;
        if (c.lane == 0) swp[row] = m * (1.0f / 127.0f);
    }
}

DI void ld8_bf16(const bf16* p, float (&o)[8]) { const v4u w = *(const v4u*)p; o[0] = bflo(w.x); o[1] = bfhi(w.x); o[2] = bflo(w.y); o[3] = bfhi(w.y); o[4] = bflo(w.z); o[5] = bfhi(w.z); o[6] = bflo(w.w); o[7] = bfhi(w.w); }
DI void ld8_f32(const float* p, float (&o)[8]) { const f32x4 a = *(const f32x4*)p, b = *(const f32x4*)(p + 4); o[0] = a[0]; o[1] = a[1]; o[2] = a[2]; o[3] = a[3]; o[4] = b[0]; o[5] = b[1]; o[6] = b[2]; o[7] = b[3]; }
DI void conv_gate_phase(const Ctx c, const bf16* U, bf16* Bg, const float* wdw  , const float* st  , float* convp, float* convs  ,
                        unsigned char* z8, float* sz  ) {
    const int gw = c.vcu * 8 + c.wave, NGW = c.G * 8, dc = 16 * c.lane;
    float w0[16], w1[16], w2[16];
    { float t8[8]; ld8_f32(wdw + dc, t8);
#pragma unroll
      for (int i = 0; i < 8; ++i) w0[i] = t8[i]; ld8_f32(wdw + dc + 8, t8);
#pragma unroll
      for (int i = 0; i < 8; ++i) w0[8 + i] = t8[i]; ld8_f32(wdw + D + dc, t8);
#pragma unroll
      for (int i = 0; i < 8; ++i) w1[i] = t8[i]; ld8_f32(wdw + D + dc + 8, t8);
#pragma unroll
      for (int i = 0; i < 8; ++i) w1[8 + i] = t8[i]; ld8_f32(wdw + 2 * D + dc, t8);
#pragma unroll
      for (int i = 0; i < 8; ++i) w2[i] = t8[i]; ld8_f32(wdw + 2 * D + dc + 8, t8);
#pragma unroll
      for (int i = 0; i < 8; ++i) w2[8 + i] = t8[i]; }
    for (int t = gw; t < T; t += NGW) {
        const bool samp = t >= TP; const int s = samp ? ((t - TP) & 15) : (t & 2047); const int b = samp ? ((t - TP) >> 4) : 0;
        float z[16]; float am = 0.f;
#pragma unroll
        for (int hf = 0; hf < 2; ++hf) { const int d0 = dc + 8 * hf;
            float u0[8], u1[8], u2[8], g[8];
            ld8_bf16(U + (size_t)t * D + d0, u2);
            { float* cdst = nullptr;
              (void)convp;
              if (samp && s >= DSEQ - 2) cdst = convs + ((size_t)b * 2 + (s - (DSEQ - 2))) * D + d0;
              if (cdst) { *(f32x4*)cdst = (f32x4){u2[0], u2[1], u2[2], u2[3]}; *(f32x4*)(cdst + 4) = (f32x4){u2[4], u2[5], u2[6], u2[7]}; } }
            if (s >= 1) ld8_bf16(U + (size_t)(t - 1) * D + d0, u1);
            else if (samp) ld8_f32(st + ((size_t)b * 2 + 1) * D + d0, u1);
            else {
#pragma unroll
                for (int i = 0; i < 8; ++i) u1[i] = 0.f; }
            if (s >= 2) ld8_bf16(U + (size_t)(t - 2) * D + d0, u0);
            else if (samp) ld8_f32(st + ((size_t)b * 2 + (s == 1 ? 1 : 0)) * D + d0, u0);
            else {
#pragma unroll
                for (int i = 0; i < 8; ++i) u0[i] = 0.f; }
            ld8_bf16(Bg + (size_t)t * D + d0, g);
#pragma unroll
            for (int i = 0; i < 8; ++i) { const float zz = g[i] * (w0[8 * hf + i] * u0[i] + w1[8 * hf + i] * u1[i] + w2[8 * hf + i] * u2[i]); z[8 * hf + i] = zz; am = __builtin_fmaxf(am, __builtin_fabsf(zz)); }
        }
        if (samp) {
            v4u o0, o1; o0.x = pk2(z[0], z[1]); o0.y = pk2(z[2], z[3]); o0.z = pk2(z[4], z[5]); o0.w = pk2(z[6], z[7]); o1.x = pk2(z[8], z[9]); o1.y = pk2(z[10], z[11]); o1.z = pk2(z[12], z[13]); o1.w = pk2(z[14], z[15]);
            *(v4u*)(Bg + (size_t)t * D + dc) = o0; *(v4u*)(Bg + (size_t)t * D + dc + 8) = o1; }
#pragma unroll
        for (int o = 1; o < 64; o <<= 1) am = __builtin_fmaxf(am, shx(c.lane, am, o));
        const float k = am > 0.f ? 127.0f / am : 0.f;
        v4u q; q.x = q4_i8((f32x4){z[0], z[1], z[2], z[3]}, k); q.y = q4_i8((f32x4){z[4], z[5], z[6], z[7]}, k); q.z = q4_i8((f32x4){z[8], z[9], z[10], z[11]}, k); q.w = q4_i8((f32x4){z[12], z[13], z[14], z[15]}, k);
        *(v4u*)(z8 + (size_t)t * D + dc) = q;
        if (c.lane == 0) sz[t] = am * (1.0f / 127.0f);
    }
}

DI void ln_phase(const Ctx c, const bf16* R, bf16* H, const float* g, const float* bb, float* yout = nullptr, const bf16* Hres = nullptr, unsigned char* x8 = nullptr, float* sx = nullptr) {
    const int gw = c.vcu * 8 + c.wave, NGW = c.G * 8;
    float gv[2][8], bv[2][8];
#pragma unroll
    for (int j = 0; j < 2; ++j) { ld8_f32(g + 8 * c.lane + 512 * j, gv[j]); ld8_f32(bb + 8 * c.lane + 512 * j, bv[j]); }
    v4u rw[2], hw[2];
#pragma unroll
    for (int j = 0; j < 2; ++j) { const int m0 = gw < T ? gw : 0; rw[j] = *(const v4u*)(R + (size_t)m0 * D + 8 * c.lane + 512 * j); hw[j] = Hres ? *(const v4u*)(Hres + (size_t)m0 * D + 8 * c.lane + 512 * j) : (v4u){0u, 0u, 0u, 0u}; }
    for (int m = gw; m < T; m += NGW) {
        float v[2][8]; float s = 0.f;
#pragma unroll
        for (int j = 0; j < 2; ++j) { const unsigned w[4] = {rw[j].x, rw[j].y, rw[j].z, rw[j].w}, hq[4] = {hw[j].x, hw[j].y, hw[j].z, hw[j].w};
#pragma unroll
            for (int i = 0; i < 4; ++i) { v[j][2 * i] = bflo(w[i]); v[j][2 * i + 1] = bfhi(w[i]); if (Hres) { v[j][2 * i] += bflo(hq[i]) * ALPHA; v[j][2 * i + 1] += bfhi(hq[i]) * ALPHA; } }
#pragma unroll
            for (int i = 0; i < 8; ++i) s += v[j][i]; }
        { const int mn = m + NGW < T ? m + NGW : m;
#pragma unroll
          for (int j = 0; j < 2; ++j) { rw[j] = *(const v4u*)(R + (size_t)mn * D + 8 * c.lane + 512 * j); if (Hres) hw[j] = *(const v4u*)(Hres + (size_t)mn * D + 8 * c.lane + 512 * j); } }
        const float mean = wave_sum(c.lane, s) * (1.f / D); float s2 = 0.f;
#pragma unroll
        for (int j = 0; j < 2; ++j)
#pragma unroll
            for (int i = 0; i < 8; ++i) { v[j][i] -= mean; s2 += v[j][i] * v[j][i]; }
        const float rstd = __builtin_amdgcn_rsqf(wave_sum(c.lane, s2) * (1.f / D) + LN_EPS);
        float am = 0.f;
#pragma unroll
        for (int j = 0; j < 2; ++j)
#pragma unroll
            for (int i = 0; i < 8; ++i) { v[j][i] = v[j][i] * rstd * gv[j][i] + bv[j][i]; am = __builtin_fmaxf(am, __builtin_fabsf(v[j][i])); }
        if (yout) {
#pragma unroll
            for (int j = 0; j < 2; ++j) { float* o = yout + (size_t)m * D + 8 * c.lane + 512 * j; *(f32x4*)o = (f32x4){v[j][0], v[j][1], v[j][2], v[j][3]}; *(f32x4*)(o + 4) = (f32x4){v[j][4], v[j][5], v[j][6], v[j][7]}; }
        } else {
#pragma unroll
            for (int j = 0; j < 2; ++j) { v4u w; w.x = pk2(v[j][0], v[j][1]); w.y = pk2(v[j][2], v[j][3]); w.z = pk2(v[j][4], v[j][5]); w.w = pk2(v[j][6], v[j][7]); *(v4u*)(H + (size_t)m * D + 8 * c.lane + 512 * j) = w; }
            if (x8) {
#pragma unroll
                for (int o = 1; o < 64; o <<= 1) am = __builtin_fmaxf(am, shx(c.lane, am, o));
                const float k = am > 0.f ? 127.0f / am : 0.f;
#pragma unroll
                for (int j = 0; j < 2; ++j) { v2u q; q.x = q4_i8((f32x4){v[j][0], v[j][1], v[j][2], v[j][3]}, k); q.y = q4_i8((f32x4){v[j][4], v[j][5], v[j][6], v[j][7]}, k); *(v2u*)(x8 + (size_t)m * D + 8 * c.lane + 512 * j) = q; }
                if (c.lane == 0) sx[m] = am * (1.0f / 127.0f);
            } }
    }
}

DI int ordi(float x) { const int b = __float_as_int(x); return b ^ ((b >> 31) & 0x7fffffff); }
DI float unordi(int o) { return __int_as_float(o ^ ((o >> 31) & 0x7fffffff)); }
#define TK_CE(a, b) do { const int _hi = (a) > (b) ? (a) : (b), _lo = (a) > (b) ? (b) : (a); (a) = _hi; (b) = _lo; } while (0)
#define TK_CPK(i, j) ((ordi(va[i] + vb[j]) & ~255) | (255 - ((i) * 16 + (j))))
#define TK_SORT16(v) do { TK_CE(v[0], v[1]); TK_CE(v[2], v[3]); TK_CE(v[0], v[2]); TK_CE(v[1], v[3]); TK_CE(v[1], v[2]); TK_CE(v[4], v[5]); TK_CE(v[6], v[7]); TK_CE(v[4], v[6]); TK_CE(v[5], v[7]); TK_CE(v[5], v[6]); TK_CE(v[0], v[4]); TK_CE(v[2], v[6]); TK_CE(v[2], v[4]); TK_CE(v[1], v[5]); TK_CE(v[3], v[7]); TK_CE(v[3], v[5]); TK_CE(v[1], v[2]); TK_CE(v[3], v[4]); TK_CE(v[5], v[6]); TK_CE(v[8], v[9]); TK_CE(v[10], v[11]); TK_CE(v[8], v[10]); TK_CE(v[9], v[11]); TK_CE(v[9], v[10]); TK_CE(v[12], v[13]); TK_CE(v[14], v[15]); TK_CE(v[12], v[14]); TK_CE(v[13], v[15]); TK_CE(v[13], v[14]); TK_CE(v[8], v[12]); TK_CE(v[10], v[14]); TK_CE(v[10], v[12]); TK_CE(v[9], v[13]); TK_CE(v[11], v[15]); TK_CE(v[11], v[13]); TK_CE(v[9], v[10]); TK_CE(v[11], v[12]); TK_CE(v[13], v[14]); TK_CE(v[0], v[8]); TK_CE(v[4], v[12]); TK_CE(v[4], v[8]); TK_CE(v[2], v[10]); TK_CE(v[6], v[14]); TK_CE(v[6], v[10]); TK_CE(v[2], v[4]); TK_CE(v[6], v[8]); TK_CE(v[10], v[12]); TK_CE(v[1], v[9]); TK_CE(v[5], v[13]); TK_CE(v[5], v[9]); TK_CE(v[3], v[11]); TK_CE(v[7], v[15]); TK_CE(v[7], v[11]); TK_CE(v[3], v[5]); TK_CE(v[7], v[9]); TK_CE(v[11], v[13]); TK_CE(v[1], v[2]); TK_CE(v[3], v[4]); TK_CE(v[5], v[6]); TK_CE(v[7], v[8]); TK_CE(v[9], v[10]); TK_CE(v[11], v[12]); TK_CE(v[13], v[14]); } while (0)
#define TK_BMERGE16(v) do { TK_CE(v[0], v[8]); TK_CE(v[1], v[9]); TK_CE(v[2], v[10]); TK_CE(v[3], v[11]); TK_CE(v[4], v[12]); TK_CE(v[5], v[13]); TK_CE(v[6], v[14]); TK_CE(v[7], v[15]); TK_CE(v[0], v[4]); TK_CE(v[1], v[5]); TK_CE(v[2], v[6]); TK_CE(v[3], v[7]); TK_CE(v[8], v[12]); TK_CE(v[9], v[13]); TK_CE(v[10], v[14]); TK_CE(v[11], v[15]); TK_CE(v[0], v[2]); TK_CE(v[1], v[3]); TK_CE(v[4], v[6]); TK_CE(v[5], v[7]); TK_CE(v[8], v[10]); TK_CE(v[9], v[11]); TK_CE(v[12], v[14]); TK_CE(v[13], v[15]); TK_CE(v[0], v[1]); TK_CE(v[2], v[3]); TK_CE(v[4], v[5]); TK_CE(v[6], v[7]); TK_CE(v[8], v[9]); TK_CE(v[10], v[11]); TK_CE(v[12], v[13]); TK_CE(v[14], v[15]); } while (0)
#define TK_CAND0(B) do { B[0] = TK_CPK(0, 0); B[1] = TK_CPK(0, 1); B[2] = TK_CPK(0, 2); B[3] = TK_CPK(0, 3); B[4] = TK_CPK(0, 4); B[5] = TK_CPK(0, 5); B[6] = TK_CPK(0, 6); B[7] = TK_CPK(0, 7); B[8] = TK_CPK(0, 8); B[9] = TK_CPK(0, 9); B[10] = TK_CPK(0, 10); B[11] = TK_CPK(0, 11); B[12] = TK_CPK(0, 12); B[13] = TK_CPK(0, 13); B[14] = TK_CPK(0, 14); B[15] = TK_CPK(0, 15); } while (0)
#define TK_CAND1(B) do { B[0] = TK_CPK(1, 0); B[1] = TK_CPK(1, 1); B[2] = TK_CPK(1, 2); B[3] = TK_CPK(1, 3); B[4] = TK_CPK(1, 4); B[5] = TK_CPK(1, 5); B[6] = TK_CPK(1, 6); B[7] = TK_CPK(1, 7); B[8] = TK_CPK(2, 0); B[9] = TK_CPK(2, 1); B[10] = TK_CPK(2, 2); B[11] = TK_CPK(2, 3); B[12] = TK_CPK(2, 4); B[13] = TK_CPK(3, 0); B[14] = TK_CPK(3, 1); B[15] = TK_CPK(3, 2); } while (0)
#define TK_CAND2(B) do { B[0] = TK_CPK(3, 3); B[1] = TK_CPK(4, 0); B[2] = TK_CPK(4, 1); B[3] = TK_CPK(4, 2); B[4] = TK_CPK(5, 0); B[5] = TK_CPK(5, 1); B[6] = TK_CPK(6, 0); B[7] = TK_CPK(6, 1); B[8] = TK_CPK(7, 0); B[9] = TK_CPK(7, 1); B[10] = TK_CPK(8, 0); B[11] = TK_CPK(9, 0); B[12] = TK_CPK(10, 0); B[13] = TK_CPK(11, 0); B[14] = TK_CPK(12, 0); B[15] = TK_CPK(13, 0); } while (0)
#define TK_CAND3(B) do { B[0] = TK_CPK(14, 0); B[1] = TK_CPK(15, 0); B[2] = (int)0x80000000; B[3] = (int)0x80000000; B[4] = (int)0x80000000; B[5] = (int)0x80000000; B[6] = (int)0x80000000; B[7] = (int)0x80000000; B[8] = (int)0x80000000; B[9] = (int)0x80000000; B[10] = (int)0x80000000; B[11] = (int)0x80000000; B[12] = (int)0x80000000; B[13] = (int)0x80000000; B[14] = (int)0x80000000; B[15] = (int)0x80000000; } while (0)
DI void tk_merge(int (&L)[16], const int (&B)[16]) {
#pragma unroll
    for (int i = 0; i < 16; ++i) L[i] = L[i] > B[15 - i] ? L[i] : B[15 - i];
    TK_BMERGE16(L);
}
DI void tk_feed32(int (&L)[16], const v4u (&x)[4], const int rb) {
#pragma unroll
    for (int hf = 0; hf < 2; ++hf) { int B[16]; const unsigned w[8] = {x[2 * hf].x, x[2 * hf].y, x[2 * hf].z, x[2 * hf].w, x[2 * hf + 1].x, x[2 * hf + 1].y, x[2 * hf + 1].z, x[2 * hf + 1].w};
#pragma unroll
        for (int j = 0; j < 16; ++j) B[j] = (ordi(__uint_as_float((j & 1) ? (w[j >> 1] & 0xffff0000u) : (w[j >> 1] << 16))) & ~127) | (127 - ((rb + 16 * hf + j) & 127));
        TK_SORT16(B); tk_merge(L, B); }
}
DI unsigned byte_of(unsigned a0, unsigned a1, unsigned a2, unsigned a3, int i) { const unsigned lo = i < 4 ? a0 : a1, hi = i < 12 ? a2 : a3, w = i < 8 ? lo : hi; return (w >> ((i & 3) * 8)) & 0xffu; }
DI void topk_phase(const Ctx c, const bf16* Sc  , unsigned short* ids, float* gates) {
    const int gw = c.wave * c.G + c.vcu, NGW = c.G * 8, NU = 8 * (T / 64);
    v4u bufA[4], bufB[4];
    if (gw < NU) { const v4u* sc = (const v4u*)(Sc + (size_t)((gw % (T / 64)) * 64 + c.lane) * 2048 + (gw / (T / 64)) * 256);
#pragma unroll
        for (int j = 0; j < 4; ++j) bufA[j] = sc[j]; }
#pragma unroll 1
    for (int wu = gw; wu < NU; wu += NGW) {
        const int h = wu / (T / 64), t = (wu % (T / 64)) * 64 + c.lane;
        const v4u* sc = (const v4u*)(Sc + (size_t)t * 2048 + h * 256);
        const int wn = wu + NGW < NU ? wu + NGW : wu;
        const v4u* scn = (const v4u*)(Sc + (size_t)((wn % (T / 64)) * 64 + c.lane) * 2048 + (wn / (T / 64)) * 256);
        int Lw[16], La[16];
#pragma unroll
        for (int i = 0; i < 16; ++i) { Lw[i] = (int)0x80000000; La[i] = 0; }
#pragma unroll 1
        for (int it = 0; it < 4; ++it) {
#pragma unroll
            for (int j = 0; j < 4; ++j) bufB[j] = sc[8 * it + 4 + j];
            tk_feed32(Lw, bufA, 64 * it);
            { const v4u* nx = it < 3 ? sc + 8 * (it + 1) : scn;
#pragma unroll
              for (int j = 0; j < 4; ++j) bufA[j] = nx[j]; }
            tk_feed32(Lw, bufB, 64 * it + 32);
            if (it == 1) {
#pragma unroll
                for (int i = 0; i < 16; ++i) { La[i] = Lw[i]; Lw[i] = (int)0x80000000; } }
        }
        float va[16], vb[16]; unsigned IA0 = 0u, IA1 = 0u, IA2 = 0u, IA3 = 0u, IB0 = 0u, IB1 = 0u, IB2 = 0u, IB3 = 0u;
#pragma unroll
        for (int i = 0; i < 16; ++i) { va[i] = unordi(La[i] & ~127); vb[i] = unordi(Lw[i] & ~127);
            const unsigned ea = (unsigned)(127 - (La[i] & 127)) << ((i & 3) * 8), eb = (unsigned)(127 - (Lw[i] & 127)) << ((i & 3) * 8);
            if ((i >> 2) == 0) { IA0 |= ea; IB0 |= eb; } else if ((i >> 2) == 1) { IA1 |= ea; IB1 |= eb; } else if ((i >> 2) == 2) { IA2 |= ea; IB2 |= eb; } else { IA3 |= ea; IB3 |= eb; } }
        int F[16];
        { int B[16]; TK_CAND0(B); TK_SORT16(B);
#pragma unroll
          for (int i = 0; i < 16; ++i) F[i] = B[i]; }
        { int B[16]; TK_CAND1(B); TK_SORT16(B); tk_merge(F, B); }
        { int B[16]; TK_CAND2(B); TK_SORT16(B); tk_merge(F, B); }
        { int B[16]; TK_CAND3(B); TK_SORT16(B); tk_merge(F, B); }
        float sc_[16], den = 0.f; unsigned ex[16];
        const float mx = unordi(F[0] & ~255);
#pragma unroll
        for (int k = 0; k < 16; ++k) { const int code = 255 - (F[k] & 255); sc_[k] = __builtin_amdgcn_exp2f((unordi(F[k] & ~255) - mx) * LOG2E); den += sc_[k];
            ex[k] = byte_of(IA0, IA1, IA2, IA3, code >> 4) * 128u + byte_of(IB0, IB1, IB2, IB3, code & 15); }
        const float inv = 1.0f / den;
        v4u e0, e1; e0.x = ex[0] | (ex[1] << 16); e0.y = ex[2] | (ex[3] << 16); e0.z = ex[4] | (ex[5] << 16); e0.w = ex[6] | (ex[7] << 16);
        e1.x = ex[8] | (ex[9] << 16); e1.y = ex[10] | (ex[11] << 16); e1.z = ex[12] | (ex[13] << 16); e1.w = ex[14] | (ex[15] << 16);
        v4u* ip = (v4u*)(ids + (size_t)t * 128 + h * 16); ip[0] = e0; ip[1] = e1;
        f32x4* gp = (f32x4*)(gates + (size_t)t * 128 + h * 16);
#pragma unroll
        for (int k = 0; k < 4; ++k) gp[k] = (f32x4){sc_[4 * k] * inv, sc_[4 * k + 1] * inv, sc_[4 * k + 2] * inv, sc_[4 * k + 3] * inv};
    }
}

typedef float f2 __attribute__((ext_vector_type(2)));
constexpr int QCH = 16, QN = T / QCH;
static_assert(T % QCH == 0, "queue chunks");
struct ChunkQ { int xme, s; unsigned pend; unsigned* q; };
struct Chunk { int base, xs; };
DI unsigned cq_ticket(unsigned* qw, int lane) { unsigned v = 0u; if (lane == 0) v = __hip_atomic_fetch_add(qw, 1u, __ATOMIC_RELAXED, __HIP_MEMORY_SCOPE_AGENT); return v; }
DI void cq_init(ChunkQ& g, unsigned* q, int lane) { g.xme = (int)(xb_xcc_id() & 7u); g.s = 0; g.q = q; g.pend = cq_ticket(q + g.xme * 64, lane); }
DI Chunk cq_next(ChunkQ& g, int lane) {
    for (;;) {
        if (g.s >= 8) return Chunk{-1, 0};
        const unsigned chunk = (unsigned)__builtin_amdgcn_readfirstlane((int)g.pend); const int xs = (g.xme + g.s) & 7;
        if (chunk < (unsigned)QN) { g.pend = cq_ticket(g.q + xs * 64, lane); return Chunk{(int)chunk * QCH, xs}; }
        ++g.s; if (g.s < 8) g.pend = cq_ticket(g.q + ((g.xme + g.s) & 7) * 64, lane);
    }
}
struct SliceIds { v4u ia, ib; int t, xs; };
struct SliceAux { v4u a0; float s; };
DI SliceIds slice_load_ids(const int t, const int xs, const int lane, const unsigned short* ids) {
    const int j = lane >> 3, tc = t < 0 ? 0 : t; SliceIds r; r.t = t; r.xs = xs;
    r.ia = *(const v4u*)(ids + (size_t)tc * 128 + 16 * j); r.ib = *(const v4u*)(ids + (size_t)tc * 128 + 16 * j + 8); return r;
}
template <int MODE>
DI SliceAux slice_load_aux(const int t, const int xs, const int lane, const unsigned char* x8, const unsigned char* w8, const float* sw) {
    const int j = lane >> 3, i = lane & 7, tc = t < 0 ? 0 : t; SliceAux r;
    if (MODE == 0) { r.a0 = *(const v4u*)(x8 + (size_t)tc * D + 128 * xs + 16 * i); r.s = 0.f; }
    else { r.a0 = *(const v4u*)(w8 + (size_t)tc * 128 + 16 * j); r.s = sw[tc]; }
    return r;
}
template <int VAR>
DI void slice_issue(v4u (&vr)[16], const SliceIds& n, const unsigned char* T8, const int lane) {
    const unsigned char* base = T8 + (size_t)n.xs * NEXP * 128 + 16 * (lane & 7);
    const unsigned idv[8] = {n.ia.x, n.ia.y, n.ia.z, n.ia.w, n.ib.x, n.ib.y, n.ib.z, n.ib.w};
#pragma unroll
    for (int g = 0; g < 16; ++g) { unsigned e = (g & 1) ? (idv[g >> 1] >> 16) : (idv[g >> 1] & 0xffffu); if (VAR == 2) e &= 15u; vr[g] = *(const v4u*)(base + (size_t)e * 128); }
}
DI int dot16_i8(const v4u a, const v4u b, int acc) {
    acc = __builtin_amdgcn_sdot4((int)a.x, (int)b.x, acc, false); acc = __builtin_amdgcn_sdot4((int)a.y, (int)b.y, acc, false);
    acc = __builtin_amdgcn_sdot4((int)a.z, (int)b.z, acc, false); acc = __builtin_amdgcn_sdot4((int)a.w, (int)b.w, acc, false); return acc;
}
DI void tr4_dot(int& c0, int& c1, int& c2, int& c3, const unsigned a, const unsigned b, const unsigned cc, const unsigned d, const int w) {
    const unsigned p = __builtin_amdgcn_perm(b, a, 0x05010400u), q = __builtin_amdgcn_perm(b, a, 0x07030602u), r = __builtin_amdgcn_perm(d, cc, 0x05010400u), s = __builtin_amdgcn_perm(d, cc, 0x07030602u);
    c0 = __builtin_amdgcn_sdot4((int)__builtin_amdgcn_perm(r, p, 0x05040100u), w, c0, false); c1 = __builtin_amdgcn_sdot4((int)__builtin_amdgcn_perm(r, p, 0x07060302u), w, c1, false);
    c2 = __builtin_amdgcn_sdot4((int)__builtin_amdgcn_perm(s, q, 0x05040100u), w, c2, false); c3 = __builtin_amdgcn_sdot4((int)__builtin_amdgcn_perm(s, q, 0x07060302u), w, c3, false);
}
template <int MODE, int VAR>
DI void slice_compute(const int lane, const v4u (&vr)[16], const int t, const int xs, const SliceAux& n, float* OUT) {
    const int j = lane >> 3, i = lane & 7;
    if (VAR == 1) {
        unsigned x = n.a0.x ^ n.a0.y;
#pragma unroll
        for (int g = 0; g < 16; ++g) x ^= vr[g].x ^ vr[g].y ^ vr[g].z ^ vr[g].w;
        *(unsigned*)((bf16*)OUT + (size_t)t * D + 128 * xs + 2 * lane) = x;
    } else if (MODE == 0) {
        int d[16];
#pragma unroll
        for (int g = 0; g < 16; ++g) d[g] = dot16_i8(vr[g], n.a0, 0);
        int r8[8], r4[4], r2[2];
#pragma unroll
        for (int q = 0; q < 8; ++q) { const bool od = lane & 1; const int keep = od ? d[8 + q] : d[q], send = od ? d[q] : d[8 + q]; r8[q] = keep + shx(lane, send, 1); }
#pragma unroll
        for (int q = 0; q < 4; ++q) { const bool od = lane & 2; const int keep = od ? r8[4 + q] : r8[q], send = od ? r8[q] : r8[4 + q]; r4[q] = keep + shx(lane, send, 2); }
#pragma unroll
        for (int q = 0; q < 2; ++q) { const bool od = lane & 4; const int keep = od ? r4[2 + q] : r4[q], send = od ? r4[q] : r4[2 + q]; r2[q] = keep + shx(lane, send, 4); }
        const int g0 = 8 * (i & 1) + 4 * ((i >> 1) & 1) + 2 * (i >> 2);
        *((unsigned*)OUT + ((size_t)xs * T + t) * 64 + 8 * j + (g0 >> 1)) = ((unsigned)((r2[0] + 32) >> 6) & 0xffffu) | ((unsigned)((r2[1] + 32) >> 6) << 16);
    } else {
        int acc[16];
#pragma unroll
        for (int q = 0; q < 16; ++q) acc[q] = 0;
        const int w4[4] = {(int)n.a0.x, (int)n.a0.y, (int)n.a0.z, (int)n.a0.w};
#pragma unroll
        for (int gq = 0; gq < 4; ++gq) {
            tr4_dot(acc[0], acc[1], acc[2], acc[3], vr[4 * gq].x, vr[4 * gq + 1].x, vr[4 * gq + 2].x, vr[4 * gq + 3].x, w4[gq]);
            tr4_dot(acc[4], acc[5], acc[6], acc[7], vr[4 * gq].y, vr[4 * gq + 1].y, vr[4 * gq + 2].y, vr[4 * gq + 3].y, w4[gq]);
            tr4_dot(acc[8], acc[9], acc[10], acc[11], vr[4 * gq].z, vr[4 * gq + 1].z, vr[4 * gq + 2].z, vr[4 * gq + 3].z, w4[gq]);
            tr4_dot(acc[12], acc[13], acc[14], acc[15], vr[4 * gq].w, vr[4 * gq + 1].w, vr[4 * gq + 2].w, vr[4 * gq + 3].w, w4[gq]);
        }
        int r8[8], r4[4], r2[2];
#pragma unroll
        for (int q = 0; q < 8; ++q) { const bool od = lane & 8; const int keep = od ? acc[8 + q] : acc[q], send = od ? acc[q] : acc[8 + q]; r8[q] = keep + shx(lane, send, 8); }
#pragma unroll
        for (int q = 0; q < 4; ++q) { const bool od = lane & 16; const int keep = od ? r8[4 + q] : r8[q], send = od ? r8[q] : r8[4 + q]; r4[q] = keep + shx(lane, send, 16); }
#pragma unroll
        for (int q = 0; q < 2; ++q) { const bool od = lane & 32; const int keep = od ? r4[2 + q] : r4[q], send = od ? r4[q] : r4[2 + q]; r2[q] = keep + shx(lane, send, 32); }
        const int dim = 128 * xs + 16 * i + 8 * (j & 1) + 4 * ((j >> 1) & 1) + 2 * (j >> 2);
        const float s = n.s;
        *(unsigned*)((bf16*)OUT + (size_t)t * D + dim) = pk2((float)r2[0] * s, (float)r2[1] * s);
    }
}
template <int MODE, int VAR = 0>
DI void slice_pass(const Ctx c, const unsigned char* x8, const unsigned short* ids, const unsigned char* w8, const float* sw, const unsigned char* T8, float* OUT, unsigned* q) {
    ChunkQ g; cq_init(g, q, c.lane);
    Chunk cur = cq_next(g, c.lane); if (cur.base < 0) return;
    Chunk nxt = cq_next(g, c.lane);
#define SLICE_TOK_T(p) ((p) < QCH ? cur.base + (p) : (nxt.base >= 0 ? nxt.base + (p) - QCH : -1))
#define SLICE_TOK_X(p) ((p) < QCH ? cur.xs : nxt.xs)
    SliceIds i0 = slice_load_ids(SLICE_TOK_T(0), SLICE_TOK_X(0), c.lane, ids), i1 = slice_load_ids(SLICE_TOK_T(1), SLICE_TOK_X(1), c.lane, ids),
             i2 = slice_load_ids(SLICE_TOK_T(2), SLICE_TOK_X(2), c.lane, ids), i3 = slice_load_ids(SLICE_TOK_T(3), SLICE_TOK_X(3), c.lane, ids);
    SliceAux x0 = slice_load_aux<MODE>(i0.t, i0.xs, c.lane, x8, w8, sw), x1 = slice_load_aux<MODE>(i1.t, i1.xs, c.lane, x8, w8, sw);
    v4u A[16], B[16];
    slice_issue<VAR>(A, i0, T8, c.lane);
#define SLICE_STEP(K, CUR, NXT, IK, IK1, XK) do { slice_issue<VAR>(NXT, IK1, T8, c.lane); \
        slice_compute<MODE, VAR>(c.lane, CUR, IK.t, IK.xs, XK, OUT); \
        XK = slice_load_aux<MODE>(SLICE_TOK_T(pg + (K) + 2), SLICE_TOK_X(pg + (K) + 2), c.lane, x8, w8, sw); \
        IK = slice_load_ids(SLICE_TOK_T(pg + (K) + 4), SLICE_TOK_X(pg + (K) + 4), c.lane, ids); } while (0)
    for (;;) {
#pragma unroll 2
        for (int pg = 0; pg < QCH; pg += 4) {
            SLICE_STEP(0, A, B, i0, i1, x0);
            SLICE_STEP(1, B, A, i1, i2, x1);
            SLICE_STEP(2, A, B, i2, i3, x0);
            SLICE_STEP(3, B, A, i3, i0, x1);
        }
        cur = nxt; if (cur.base < 0) break;
        nxt = cq_next(g, c.lane);
    }
#undef SLICE_STEP
#undef SLICE_TOK_T
#undef SLICE_TOK_X
}
struct WpA { f32x4 s; v2u iw; f32x4 g; float st; };
struct WpB { f32x4 su, sv; };
DI WpA wp_load_a(const size_t idx, const float* part, const unsigned short* ids, const float* gates, const float* sx) {
    WpA a; v2u p[8];
#pragma unroll
    for (int x = 0; x < 8; ++x) p[x] = *(const v2u*)((const unsigned short*)part + (size_t)x * T * 128 + idx * 4);
    a.iw = *(const v2u*)(ids + idx * 4); a.g = *(const f32x4*)(gates + idx * 4); a.st = sx[idx >> 5] * 64.0f;
    int s0 = 0, s1 = 0, s2 = 0, s3 = 0;
#pragma unroll
    for (int x = 0; x < 8; ++x) { s0 += (int)(short)(p[x].x & 0xffffu); s1 += (int)p[x].x >> 16; s2 += (int)(short)(p[x].y & 0xffffu); s3 += (int)p[x].y >> 16; }
    a.s = (f32x4){(float)s0, (float)s1, (float)s2, (float)s3}; return a;
}
DI WpB wp_load_b(const WpA& a, const float* SU, const float* SV) {
    const unsigned e[4] = {a.iw.x & 0xffffu, a.iw.x >> 16, a.iw.y & 0xffffu, a.iw.y >> 16}; WpB b;
#pragma unroll
    for (int k = 0; k < 4; ++k) { b.su[k] = SU[e[k]]; b.sv[k] = SV[e[k]]; }
    return b;
}
DI void peer_w_phase(const Ctx c, const float* part, const unsigned short* ids, const float* gates, unsigned char* w8, float* sw, const float* sx, const float* SU, const float* SV) {
    const size_t NT = (size_t)c.G * 512, NI = (size_t)T * 32, i0 = (size_t)c.vcu * 512 + c.tid;
    WpA a0 = wp_load_a(i0 < NI ? i0 : 0, part, ids, gates, sx), a1 = wp_load_a(i0 + NT < NI ? i0 + NT : 0, part, ids, gates, sx);
    WpB b0 = wp_load_b(a0, SU, SV);
    for (size_t idx = i0; idx < NI; idx += NT) {
        const WpA a2 = wp_load_a(idx + 2 * NT < NI ? idx + 2 * NT : 0, part, ids, gates, sx);
        const WpB b1 = wp_load_b(a1, SU, SV);
        f32x4 g = a0.g; float am = 0.f;
#pragma unroll
        for (int k = 0; k < 4; ++k) { g[k] = g[k] * gelu_erf(a0.s[k] * (a0.st * b0.su[k])) * b0.sv[k]; am = __builtin_fmaxf(am, __builtin_fabsf(g[k])); }
#pragma unroll
        for (int o = 1; o < 32; o <<= 1) am = __builtin_fmaxf(am, shx(c.lane, am, o));
        *(unsigned*)(w8 + idx * 4) = q4_i8(g, am > 0.f ? 127.0f / am : 0.f);
        if ((c.tid & 31) == 0) sw[idx >> 5] = am * (1.0f / 127.0f);
        a0 = a1; a1 = a2; b0 = b1;
    }
}

DI int pi_row(int m) { return 16 * (m >> 4) + 8 * ((m >> 2) & 1) + 4 * ((m >> 3) & 1) + (m & 3); }
struct AttnT { const bf16* Q; bf16* O; const bf16* Kb; const bf16* VT; const bf16* Vsn; const float* ck; const float* cv; };
template <int MODE>
DI void attn_load(const AttnT A, const int b, const int h, const int kt, const int q, const int hh, const int piq, bf16x8 (&kf)[4], bf16x8 (&vf)[2][2]) {
    if (MODE == 0) {
        const bf16* kr = A.Kb + ((size_t)b * SEQ + kt * 32 + piq) * D + h * DH + 8 * hh;
#pragma unroll
        for (int s = 0; s < 4; ++s) kf[s] = *(const bf16x8*)(kr + 16 * s);
        const bf16* vr = A.VT + (((size_t)b * NH + h) * (SEQ / 32) + kt) * (DH * 32) + q * 32 + 8 * hh;
#pragma unroll
        for (int mt = 0; mt < 2; ++mt)
#pragma unroll
            for (int s = 0; s < 2; ++s) vf[mt][s] = *(const bf16x8*)(vr + mt * 32 * 32 + 16 * s);
    } else if (kt == PAST / 32) {
        const int ko = piq < 16 ? piq : 15;
        const bf16* kr = A.Kb + ((size_t)TP + b * DSEQ + ko) * D + h * DH + 8 * hh;
#pragma unroll
        for (int s = 0; s < 4; ++s) kf[s] = *(const bf16x8*)(kr + 16 * s);
#pragma unroll
        for (int mt = 0; mt < 2; ++mt)
#pragma unroll
            for (int s = 0; s < 2; ++s) { bf16x8 v;
#pragma unroll
                for (int j = 0; j < 8; ++j) { const int kk = 16 * s + 8 * hh + j; v[j] = (short)A.Vsn[((size_t)b * DSEQ + (kk < 16 ? kk : 15)) * D + h * DH + 32 * mt + q]; }
                vf[mt][s] = v; }
    } else {
        const float* kr = A.ck + (((size_t)b * PAST + kt * 32 + piq) * NH + h) * DH + 8 * hh;
#pragma unroll
        for (int s = 0; s < 4; ++s) { const f32x4 x0 = *(const f32x4*)(kr + 16 * s), x1 = *(const f32x4*)(kr + 16 * s + 4); kf[s] = pack8(x0[0], x0[1], x0[2], x0[3], x1[0], x1[1], x1[2], x1[3]); }
#pragma unroll
        for (int mt = 0; mt < 2; ++mt)
#pragma unroll
            for (int s = 0; s < 2; ++s) { float x[8];
#pragma unroll
                for (int j = 0; j < 8; ++j) x[j] = A.cv[(((size_t)b * PAST + kt * 32 + 16 * s + 8 * hh + j) * NH + h) * DH + 32 * mt + q];
                vf[mt][s] = pack8(x[0], x[1], x[2], x[3], x[4], x[5], x[6], x[7]); }
    }
}
template <int MODE>
DI void attn_qtile(const AttnT A, int b, int h, int qi, int lane, const bf16x8 (&ut)[2]) {
    const int q = lane & 31, hh = lane >> 5, piq = pi_row(q);
    const size_t qrow = MODE == 0 ? (size_t)b * SEQ + qi * 32 + q : (size_t)TP + b * DSEQ + (q < 16 ? q : 15);
    const int qpos = MODE == 0 ? qi * 32 + q : (q < 16 ? PAST + q : 0);
    bf16x8 qf[4];
#pragma unroll
    for (int s = 0; s < 4; ++s) qf[s] = *(const bf16x8*)(A.Q + qrow * D + h * DH + 16 * s + 8 * hh);
    f32x16 o0, o1;
#pragma unroll
    for (int i = 0; i < 16; ++i) { o0[i] = 0.f; o1[i] = 0.f; }
    float carry = 0.f;
    const int kt0 = MODE == 0 ? qi : PAST / 32;
    bf16x8 kf[4], vf[2][2];
    attn_load<MODE>(A, b, h, kt0, q, hh, piq, kf, vf);
    for (int kt = kt0; kt >= 0; --kt) {
        bf16x8 kn[4], vn[2][2];
        attn_load<MODE>(A, b, h, kt > 0 ? kt - 1 : 0, q, hh, piq, kn, vn);
        f32x16 S;
#pragma unroll
        for (int i = 0; i < 16; ++i) S[i] = 0.f;
#pragma unroll
        for (int s = 0; s < 4; ++s) S = MFMA32(kf[s], qf[s], S);
        const int kbase = kt * 32 + 8 * hh;
        float L[16], lw[16];
#pragma unroll
        for (int r = 0; r < 16; ++r) {
            const bool valid = (kbase + 16 * (r >> 3) + (r & 7)) < qpos;
            const float z = S[r], sp = __builtin_fmaxf(z, 0.f) + __builtin_amdgcn_logf(1.0f + __builtin_amdgcn_exp2f(-__builtin_fabsf(z)));
            L[r] = valid ? -sp : 0.f; lw[r] = valid ? (z - sp) : -1e30f;
        }
        f32x16 suf;
#pragma unroll
        for (int i = 0; i < 16; ++i) suf[i] = 0.f;
        suf = MFMA32(ut[0], pack8(L[0], L[1], L[2], L[3], L[4], L[5], L[6], L[7]), suf);
        suf = MFMA32(ut[1], pack8(L[8], L[9], L[10], L[11], L[12], L[13], L[14], L[15]), suf);
        float a[16];
#pragma unroll
        for (int r = 0; r < 16; ++r) a[r] = __builtin_amdgcn_exp2f(lw[r] + suf[r] + carry);
        carry += __int_as_float(__builtin_amdgcn_ds_bpermute(q << 2, __float_as_int(suf[0] + L[0])));
        const bf16x8 p0 = pack8(a[0], a[1], a[2], a[3], a[4], a[5], a[6], a[7]), p1 = pack8(a[8], a[9], a[10], a[11], a[12], a[13], a[14], a[15]);
        o0 = MFMA32(vf[0][0], p0, o0); o0 = MFMA32(vf[0][1], p1, o0);
        o1 = MFMA32(vf[1][0], p0, o1); o1 = MFMA32(vf[1][1], p1, o1);
        if (__builtin_amdgcn_ballot_w64(qpos > 0 && carry > -24.0f * LOG2E) == 0ull) break;
#pragma unroll
        for (int s = 0; s < 4; ++s) kf[s] = kn[s];
#pragma unroll
        for (int mt = 0; mt < 2; ++mt)
#pragma unroll
            for (int s = 0; s < 2; ++s) vf[mt][s] = vn[mt][s];
    }
    if (MODE == 0 || q < 16) {
        bf16* orow = A.O + qrow * D + h * DH + 4 * hh;
#pragma unroll
        for (int g = 0; g < 4; ++g) {
            v2u w0, w1; w0.x = pk2(o0[4 * g], o0[4 * g + 1]); w0.y = pk2(o0[4 * g + 2], o0[4 * g + 3]); w1.x = pk2(o1[4 * g], o1[4 * g + 1]); w1.y = pk2(o1[4 * g + 2], o1[4 * g + 3]);
            *(v2u*)(orow + 8 * g) = w0; *(v2u*)(orow + 32 + 8 * g) = w1; }
    }
}
DI void attn_phase(const Ctx c, const AttnT A) {
    const int q = c.lane & 31, hh = c.lane >> 5, piq = pi_row(q);
    bf16x8 ut[2];
#pragma unroll
    for (int s = 0; s < 2; ++s)
#pragma unroll
        for (int j = 0; j < 8; ++j) ut[s][j] = (16 * s + 8 * hh + j > piq) ? (short)0x3f80 : (short)0;
    for (int bu = c.vcu; bu < NB * NH * 4; bu += c.G) {
        const int bh = bu >> 2, b = bh >> 4, h = bh & 15, p = (bu & 3) * 8 + c.wave;
        attn_qtile<0>(A, b, h, 63 - p, c.lane, ut);
        attn_qtile<0>(A, b, h, p, c.lane, ut);
    }
    for (int su = c.wave * c.G + c.vcu; su < NB * NH; su += c.G * 8) attn_qtile<1>(A, su >> 4, su & 15, 0, c.lane, ut);
}

DI void vt_phase(const Ctx c, LAS unsigned char* lds, const bf16* Vb, bf16* VT, bf16* Vsn) {
    LAS unsigned char* scr = lds + c.wave * 16384;
    const int gw = c.vcu * 8 + c.wave, NGW = c.G * 8;
    for (int wt = gw; wt < (TP / 64) * 16; wt += NGW) {
        const int tt = wt >> 4, ht = wt & 15;
#pragma unroll
        for (int j = 0; j < 8; ++j) { const int row = (c.lane >> 3) + 8 * j, ch = c.lane & 7;
            const v4u v = *(const v4u*)(Vb + (size_t)(tt * 64 + row) * D + ht * 64 + ch * 8);
            LAS unsigned* d = (LAS unsigned*)(scr + row * 132 + ch * 16); d[0] = v.x; d[1] = v.y; d[2] = v.z; d[3] = v.w; }
        LDS_WAIT(); asm volatile("" ::: "memory");
#pragma unroll
        for (int j = 0; j < 8; ++j) { const int orow = (c.lane >> 3) + 8 * j, ch = c.lane & 7;
            unsigned short e[8];
#pragma unroll
            for (int i = 0; i < 8; ++i) e[i] = *(const LAS unsigned short*)(scr + (ch * 8 + i) * 132 + orow * 2);
            v4u o; o.x = e[0] | ((unsigned)e[1] << 16); o.y = e[2] | ((unsigned)e[3] << 16); o.z = e[4] | ((unsigned)e[5] << 16); o.w = e[6] | ((unsigned)e[7] << 16);
            { const int bb = tt >> 5, kt = 2 * (tt & 31) + (ch >> 2);
              *(v4u*)(VT + (((size_t)bb * NH + ht) * (SEQ / 32) + kt) * (DH * 32) + orow * 32 + 8 * (ch & 3)) = o; } }
        LDS_WAIT(); asm volatile("" ::: "memory");
    }
    const size_t NT = (size_t)c.G * 512;
    for (size_t i = (size_t)c.vcu * 512 + c.tid; i < (size_t)TS * D / 8; i += NT) *(v4u*)(Vsn + i * 8) = *(const v4u*)(Vb + (size_t)TP * D + i * 8);
}

DI f32x16 sg_tile(const bf16* wr  , const bf16* xr  ) {
    f32x16 acc;
#pragma unroll
    for (int i = 0; i < 16; ++i) acc[i] = 0.f;
#pragma unroll 16
    for (int k = 0; k < 64; ++k) acc = MFMA32(*(const bf16x8*)(wr + 16 * k), *(const bf16x8*)(xr + 16 * k), acc);
    return acc;
}
DI void sg_gate(const Ctx c, const bf16* Hall  , const bf16* Wl  , bf16* U, bf16* Bg, float* convp  ) {
    const int q = c.lane & 31, hh = c.lane >> 5;
    for (int tile = c.wave * c.G + c.vcu; tile < 18 * 32; tile += c.G * 8) {
        const int tt = tile % 18, dt = tile / 18, d = 32 * dt + q, crow = 256 * (d >> 7) + (d & 127);
        const bool cs = tt >= 16; const int kk = (tt - 16) * 32 + q;
        const size_t row = cs ? (size_t)(kk >> 1) * SEQ + (SEQ - 2) + (kk & 1) : (size_t)TP + tt * 32 + q;
        const bf16* xr = Hall + row * D + 8 * hh;
        const bf16* wc = Wl + (size_t)crow * D + 8 * hh; const bf16* wx = wc + (size_t)128 * D; const bf16* wb = Wl + (size_t)(2048 + d) * D + 8 * hh;
        f32x16 ac, ax, ab;
#pragma unroll
        for (int i = 0; i < 16; ++i) { ac[i] = 0.f; ax[i] = 0.f; ab[i] = 0.f; }
#pragma unroll 8
        for (int k = 0; k < 64; ++k) { const bf16x8 xf = *(const bf16x8*)(xr + 16 * k);
            ac = MFMA32(*(const bf16x8*)(wc + 16 * k), xf, ac); ax = MFMA32(*(const bf16x8*)(wx + 16 * k), xf, ax); ab = MFMA32(*(const bf16x8*)(wb + 16 * k), xf, ab); }
        if (cs) {
            float* cd = convp + (size_t)kk * D + 32 * dt + 4 * hh;
#pragma unroll
            for (int g = 0; g < 4; ++g) *(f32x4*)(cd + 8 * g) = (f32x4){ac[4 * g] * ax[4 * g], ac[4 * g + 1] * ax[4 * g + 1], ac[4 * g + 2] * ax[4 * g + 2], ac[4 * g + 3] * ax[4 * g + 3]};
        } else {
            const size_t ro = row * D + 32 * dt + 4 * hh;
#pragma unroll
            for (int g = 0; g < 4; ++g) { v2u wu, wb2; wu.x = pk2(ac[4 * g] * ax[4 * g], ac[4 * g + 1] * ax[4 * g + 1]); wu.y = pk2(ac[4 * g + 2] * ax[4 * g + 2], ac[4 * g + 3] * ax[4 * g + 3]);
                wb2.x = pk2(ab[4 * g], ab[4 * g + 1]); wb2.y = pk2(ab[4 * g + 2], ab[4 * g + 3]);
                *(v2u*)(U + ro + 8 * g) = wu; *(v2u*)(Bg + ro + 8 * g) = wb2; }
        }
    }
}
template <int MODE>
DI void sg_plain(const Ctx c, const bf16* Xs, const bf16* Wt, const int N, bf16* O, const bf16* Hres, bf16* O2, float* f0, float* f1) {
    const int q = c.lane & 31, hh = c.lane >> 5;
    for (int tile = c.wave * c.G + c.vcu; tile < 16 * (N / 32); tile += c.G * 8) {
        const int tt = tile & 15, ft = tile >> 4;
        const f32x16 acc = sg_tile(Wt + (size_t)(ft * 32 + q) * D + 8 * hh, Xs + (size_t)(tt * 32 + q) * D + 8 * hh);
        const int tl = tt * 32 + q;
#pragma unroll
        for (int g = 0; g < 4; ++g) { const int f = 32 * ft + 8 * g + 4 * hh; const f32x4 v = {acc[4 * g], acc[4 * g + 1], acc[4 * g + 2], acc[4 * g + 3]};
            if (MODE == 0) { v2u w; w.x = pk2(v[0], v[1]); w.y = pk2(v[2], v[3]); *(v2u*)(O + (size_t)(TP + tl) * D + f) = w; }
            else if (MODE == 1) { const v2u hw = *(const v2u*)(Hres + (size_t)(TP + tl) * D + f); const f32x4 r = (f32x4){bflo(hw.x), bfhi(hw.x), bflo(hw.y), bfhi(hw.y)} * ALPHA + v;
                v2u w; w.x = pk2(r[0], r[1]); w.y = pk2(r[2], r[3]); *(v2u*)(O + (size_t)(TP + tl) * D + f) = w; }
            else if (MODE == 2) { const bool isv = f >= 1024; const int fc = isv ? f - 1024 : f; v2u w; w.x = pk2(v[0], v[1]); w.y = pk2(v[2], v[3]);
                *(v2u*)((isv ? O2 : O) + (size_t)(TP + tl) * D + fc) = w; *(f32x4*)((isv ? f1 : f0) + (size_t)tl * D + fc) = v; }
            else { v2u w; w.x = pk2(v[0], v[1]); w.y = pk2(v[2], v[3]); *(v2u*)(O + (size_t)(TP + tl) * 2048 + f) = w; }
        }
    }
}

struct Args { const float* in[18]; float* out; unsigned char* ws; int ph_lo, ph_hi, li, pad; };
constexpr int N_PHASES = 2 + 2 * 10 + 12 + 10;
__global__ void __launch_bounds__(512, 2) fwd(Args args) {
    extern __shared__ __attribute__((aligned(16))) unsigned char lds_raw[];
    LAS unsigned char* lds = (LAS unsigned char*)lds_raw;
    Ctx c0; c0.tid = threadIdx.x; c0.lane = 0; c0.wave = __builtin_amdgcn_readfirstlane(c0.tid >> 6); c0.G = gridDim.x;
    { const int bx = blockIdx.x; c0.vcu = (c0.G % 8 == 0) ? (bx % 8) * (c0.G / 8) + bx / 8 : bx; }
    volatile LAS unsigned* MISC = (volatile LAS unsigned*)(lds + MISC_OFF);
    for (int u = c0.tid; u < (LDS_BYTES - RING_BYTES) / 4; u += 512) ((LAS unsigned*)(lds + RING_BYTES))[u] = 0u;
    __syncthreads();
    unsigned char* ws = args.ws; float* out = args.out;
    XcdBarrier bar = xcd_barrier_post((unsigned*)(ws + WS_CTL) + CW_BAR + args.li * XCD_BAR_WORDS, MISC + 8, c0.wave == 0 ? 1u : 0u);
#define WinT ((bf16*)(wsl + WS_WIN))
#define WoutT ((bf16*)(wsl + WS_WOUT))
#define WqT ((bf16*)(wsl + WS_WQ))
#define WoT ((bf16*)(wsl + WS_WO))
#define WkvT ((bf16*)(wsl + WS_WKV))
#define WP ((bf16*)(wsl + WS_WP))
#define W8A (wsl + WS_W8A)
#define SWA ((float*)(wsl + WS_SWA))
#define W8R(off) ((int)(((off) - WS_WIN) / 2048))
#define Vsn ((bf16*)(wsl + WS_VSN))
#define H ((bf16*)(wsl + WS_H))
#define Kb ((bf16*)(wsl + WS_KB))
#define VT ((bf16*)(wsl + WS_VT))
#define ids ((unsigned short*)(wsl + WS_IDS))
#define gates ((float*)(wsl + WS_GATE))
#define W8 (wsl + WS_W8)
#define SX ((float*)(wsl + WS_SX))
#define SW (SX + T)
#define X8 (wsl + WS_X8)
#define TU (wsl + WS_TU)
#define TV (wsl + WS_TV)
#define SU ((float*)(wsl + WS_SU))
#define SV (SU + NLAYER * NEXP)
#define A0 ((bf16*)(wsl + WS_A))
#define A1 ((bf16*)(wsl + WS_A + 129 * MiB))
#define ScT ((float*)(wsl + WS_A))
#define R A0
    const float* ln_g = args.in[16]; const float* ln_b = args.in[17];
    const int lo = args.ph_lo, hi = args.ph_hi; int ph = 0;
#ifndef PROBE_REPEAT
#define PROBE_REPEAT 0
#endif
#define PHASE_R(bit, body) do { const int nrep = 1 + ((PROBE_REPEAT >> (bit)) & 1); for (int rep = 0; rep < nrep; ++rep) { if (ph >= lo && ph < hi) { Ctx c = c0; c.lane = xb_lane_id(); c.tid = c0.wave * 64 + c.lane; unsigned long long wsi_ = (unsigned long long)ws; asm volatile("" : "+s"(wsi_)); unsigned char* wsl = (unsigned char*)(GAS unsigned char*)wsi_; body; if (ph + 1 < hi) { xcd_barrier(bar); if ((PROBE_REPEAT >> 20) & 1) xcd_barrier(bar); } } ++ph; } } while (0)
#define PHASE(body) PHASE_R(31, body)

    PHASE_R(4, ({ P0Args a{args.in[0], args.in[1], args.in[5], args.in[7], args.in[8], args.in[9], args.in[10], args.in[11], args.in[12], args.in[13], args.in[14], args.in[15],
                      WinT, WoutT, WqT, WoT, WkvT, WP, H, TU, TV, SU, SV, X8, SX}; p0_prologue(c, lds, a); }));

    PHASE(({ wp_quant_phase(c, WinT, W8A, SWA); }));

#pragma unroll 1
    for (int l = 0; l < NLAYER; ++l) {
        if (l < 2) {
            PHASE_R(8, ({ pg8::Gemm g{(const bf16*)X8, (const bf16*)(W8A + ((size_t)W8R(WS_WIN) + (size_t)l * 3072) * 1024), TP, 3072, 512}; pg8::StaticOrder S; S.init(TP, 3072, c.G, (int)blockIdx.x);
                     pg8::EpiGate<true> E{A0, A1, SX, SWA + W8R(WS_WIN) + l * 3072};
                     pg8::gemm_phase<pg8::EpiGate<true>, pg8::StaticOrder, true, true, true>(lds, g, S, E, c.tid);
                     sg_gate(c, H, WinT + (size_t)l * 3072 * 1024, A0, A1, out + O_CONVP + (size_t)l * NB * 2 * D); }));
            PHASE(({ conv_gate_phase(c, A0, A1, args.in[6] + (size_t)l * 3 * D, args.in[2] + (size_t)l * NB * 2 * D, out + O_CONVP + (size_t)l * NB * 2 * D, out + O_CONVS + (size_t)l * NB * 2 * D, X8, SX); }));
        } else {
            if (l == 2) {
                PHASE_R(10, ({ pg8::Gemm g{(const bf16*)X8, (const bf16*)(W8A + (size_t)W8R(WS_WKV) * 1024), TP, 2048, 512}; pg8::StaticOrder S; S.init(TP, 2048, c.G, (int)blockIdx.x);
                         pg8::EpiKV<true> E{Kb, A1, out + O_KP, out + O_VP, out + O_KS, out + O_VS, SX, SWA + W8R(WS_WKV)};
                         pg8::gemm_phase<pg8::EpiKV<true>, pg8::StaticOrder, true, true, true>(lds, g, S, E, c.tid);
                         sg_plain<2>(c, H + (size_t)TP * D, WkvT, 2048, Kb, nullptr, A1, out + O_KS, out + O_VS); }));
                PHASE_R(14, ({ vt_phase(c, lds, A1, VT, Vsn); }));
            }
            PHASE_R(9, ({ pg8::Gemm g{(const bf16*)X8, (const bf16*)(W8A + ((size_t)W8R(WS_WQ) + (size_t)(l - 2) * 1024) * 1024), TP, 1024, 512}; pg8::StaticOrder S; S.init(TP, 1024, c.G, (int)blockIdx.x);
                     pg8::EpiBf16P<true> E{A0, 1024, SX, SWA + W8R(WS_WQ) + (l - 2) * 1024};
                     pg8::gemm_phase<pg8::EpiBf16P<true>, pg8::StaticOrder, true, true, true>(lds, g, S, E, c.tid);
                     sg_plain<0>(c, H + (size_t)TP * D, WqT + (size_t)(l - 2) * 1024 * 1024, 1024, A0, nullptr, nullptr, nullptr, nullptr); }));
            PHASE_R(11, ({ AttnT A{A0, A1, Kb, VT, Vsn, args.in[3], args.in[4]}; attn_phase(c, A); }));
        }
        if (l < 2) {
            PHASE_R(7, ({ pg8::Gemm g{(const bf16*)X8, (const bf16*)(W8A + ((size_t)W8R(WS_WOUT) + (size_t)l * 1024) * 1024), TP, 1024, 512}; pg8::StaticOrder S; S.init(TP, 1024, c.G, (int)blockIdx.x);
                     pg8::EpiRes<true> E{H, R, ALPHA, SX, SWA + W8R(WS_WOUT) + l * 1024};
                     pg8::gemm_phase<pg8::EpiRes<true>, pg8::StaticOrder, true, true, true>(lds, g, S, E, c.tid);
                     sg_plain<1>(c, A1 + (size_t)TP * D, WoutT + (size_t)l * 1024 * 1024, 1024, R, H, nullptr, nullptr, nullptr); }));
        } else {
            PHASE_R(7, ({ pg8::Gemm g{A1, WoT + (size_t)(l - 2) * 1024 * 1024, TP, 1024, 1024}; pg8::StaticOrder S; S.init(TP, 1024, c.G, (int)blockIdx.x);
                     pg8::EpiRes<false> E{H, R, ALPHA, nullptr, nullptr};
                     pg8::gemm_phase<pg8::EpiRes<false>, pg8::StaticOrder, true, true>(lds, g, S, E, c.tid);
                     sg_plain<1>(c, A1 + (size_t)TP * D, WoT + (size_t)(l - 2) * 1024 * 1024, 1024, R, H, nullptr, nullptr, nullptr); }));
        }
        PHASE_R(5, ({ ln_phase(c, R, H, ln_g + (size_t)(l * 2) * D, ln_b + (size_t)(l * 2) * D, nullptr, nullptr, X8, SX); }));
        PHASE_R(6, ({ pg8::Gemm g{(const bf16*)X8, (const bf16*)(W8A + ((size_t)W8R(WS_WP) + (size_t)l * 2048) * 1024), TP, 2048, 512}; pg8::StaticOrder S; S.init(TP, 2048, c.G, (int)blockIdx.x);
                 pg8::EpiScoreI8 E{(bf16*)ScT, 2048, SX, SWA + W8R(WS_WP) + l * 2048};
                 pg8::gemm_phase<pg8::EpiScoreI8, pg8::StaticOrder, true, true, true>(lds, g, S, E, c.tid);
                 sg_plain<3>(c, H + (size_t)TP * D, WP + (size_t)l * 2048 * 1024, 2048, (bf16*)ScT, nullptr, nullptr, nullptr, nullptr); }));
        PHASE_R(3, ({ topk_phase(c, (const bf16*)ScT, ids, gates); }));
        PHASE_R(0, ({ slice_pass<0>(c, X8, ids, W8, SW, TU + (size_t)l * NEXP * D, ScT  , (unsigned*)(ws + WS_CTL) + CW_Q + ((l * 2) * 2 + rep) * 512); }));
        PHASE_R(12, ({ peer_w_phase(c, ScT, ids, gates, W8, SW, SX, SU + (size_t)l * NEXP, SV + (size_t)l * NEXP); }));
        PHASE_R(1, ({ slice_pass<1>(c, X8, ids, W8, SW, TV + (size_t)l * NEXP * D, (float*)A0, (unsigned*)(ws + WS_CTL) + CW_Q + ((l * 2 + 1) * 2 + rep) * 512); }));
        PHASE(({ ln_phase(c, A0, H, ln_g + (size_t)(l * 2 + 1) * D, ln_b + (size_t)(l * 2 + 1) * D, l == NLAYER - 1 ? out : nullptr, H, X8, SX); }));
#if defined(PROBE_SLICE) && PROBE_SLICE == 1
        PHASE(({ slice_pass<0, 1>(c, X8, ids, W8, SW, TU + (size_t)l * NEXP * D, ScT, (unsigned*)(ws + WS_CTL) + CW_Q + ((l * 2) * 2 + 1) * 512); }));
#elif defined(PROBE_SLICE) && PROBE_SLICE == 2
        PHASE(({ slice_pass<0, 2>(c, X8, ids, W8, SW, TU + (size_t)l * NEXP * D, ScT, (unsigned*)(ws + WS_CTL) + CW_Q + ((l * 2) * 2 + 1) * 512); }));
#elif defined(PROBE_SLICE) && PROBE_SLICE == 3
        PHASE(({ slice_pass<1, 1>(c, X8, ids, W8, SW, TV + (size_t)l * NEXP * D, ScT, (unsigned*)(ws + WS_CTL) + CW_Q + ((l * 2) * 2 + 1) * 512); }));
#elif defined(PROBE_SLICE) && PROBE_SLICE == 4
        PHASE(({ slice_pass<1, 2>(c, X8, ids, W8, SW, TV + (size_t)l * NEXP * D, ScT, (unsigned*)(ws + WS_CTL) + CW_Q + ((l * 2) * 2 + 1) * 512); }));
#endif
    }
#undef PHASE
#undef PHASE_R
#undef WinT
#undef WoutT
#undef WqT
#undef WoT
#undef WkvT
#undef WP
#undef W8A
#undef SWA
#undef W8R
#undef Vsn
#undef H
#undef Kb
#undef VT
#undef ids
#undef gates
#undef W8
#undef SX
#undef SW
#undef X8
#undef TU
#undef TV
#undef SU
#undef SV
#undef A0
#undef A1
#undef ScT
#undef R
}

#ifndef N_LAUNCH_MODE
#define N_LAUNCH_MODE 1
#endif
extern "C" void kernel_launch(void* const* d_in, const int* in_sizes, int n_in, void* d_out, int out_size, void* d_ws, size_t ws_size, hipStream_t stream) {
    static int grid = 0;
    if (grid == 0) {
        if (n_in != 18 || in_sizes[0] != TP * D || (size_t)out_size != O_END || ws_size < WS_END) {
            fprintf(stderr, "kernel_launch: shape mismatch: n_in %d in0 %d out %d ws %zu (need %zu)\n", n_in, n_in > 0 ? in_sizes[0] : -1, out_size, ws_size, (size_t)WS_END); grid = -1; return; }
        int dev = 0, cus = 0, per_cu = 0;
        if (hipGetDevice(&dev) != hipSuccess || hipDeviceGetAttribute(&cus, hipDeviceAttributeMultiprocessorCount, dev) != hipSuccess) { grid = -1; return; }
        if (hipFuncSetAttribute((const void*)fwd, hipFuncAttributeMaxDynamicSharedMemorySize, LDS_BYTES) != hipSuccess) { fprintf(stderr, "kernel_launch: hipFuncSetAttribute failed\n"); grid = -1; return; }
        if (hipOccupancyMaxActiveBlocksPerMultiprocessor(&per_cu, (const void*)fwd, 512, LDS_BYTES) != hipSuccess || per_cu < 1) { fprintf(stderr, "kernel_launch: occupancy query says %d\n", per_cu); }
        (void)hipGetLastError();
        grid = cus;
    }
    if (grid < 0) return;
    (void)hipMemsetAsync((char*)d_ws + WS_CTL, 0, CTL_BYTES, stream);
    Args a{};
    for (int i = 0; i < 18; ++i) a.in[i] = (const float*)d_in[i];
    a.out = (float*)d_out; a.ws = (unsigned char*)d_ws; a.pad = 0;
#if N_LAUNCH_MODE == 1
    a.ph_lo = 0; a.ph_hi = 1 << 30; a.li = 0;
    hipLaunchKernelGGL(fwd, dim3(grid), dim3(512), LDS_BYTES, stream, a);
#else
    for (int p = 0; p < N_PHASES; ++p) { a.ph_lo = p; a.ph_hi = p + 1; a.li = p; hipLaunchKernelGGL(fwd, dim3(grid), dim3(512), LDS_BYTES, stream, a); }
#endif
}
```

```cpp
#include <hip/hip_runtime.h>
#include <cstdio>
#include <cstdint>
namespace pg8 {
#define PG8_LAS __attribute__((address_space(3)))
typedef unsigned short bf16_t;
typedef short bf16x8 __attribute__((ext_vector_type(8)));
typedef float f32x4 __attribute__((ext_vector_type(4)));
typedef unsigned u32x4 __attribute__((ext_vector_type(4)));
constexpr int BM = 256, BK = 64, HALF = 128, HTB = HALF * BK * 2  , STAGE_BYTES = 8 * HTB, NXCD = 8, WGM = 8;

__host__ __device__ __forceinline__ int lds_byte(int r, int c) { const int st = (r >> 4) * 2 + (c >> 5), rr = r & 15, cc = c & 31, ob = rr * 64 + cc * 2; return st * 1024 + (ob ^ (((ob >> 9) & 1) << 5)); }
__host__ __device__ __forceinline__ void stage_rc(int b, int& R, int& C) { const int st = b / 1024, sb = b % 1024, swz = sb ^ (((sb >> 9) & 1) << 5); R = (st >> 1) * 16 + swz / 64; C = (st & 1) * 32 + (swz % 64) / 2; }
__host__ __device__ __forceinline__ int perm32(int rho) { const int n = rho >> 4, i = rho & 15; return 8 * (i >> 2) + 4 * n + (i & 3); }

struct Unit { int pm, pn; };
struct Gemm { const bf16_t* A; const bf16_t* Bt; int M, N, K; };

struct StaticOrder {
    int nM, nN, nwg, G, c;
    __host__ __device__ void init(int M, int N, int G_, int c_) { nM = M / BM; nN = N / BM; nwg = nM * nN; G = G_; c = c_; }
    __host__ __device__ bool next(int i, Unit& u) const {
        const long L = (long)i * G + c; if (L >= nwg) return false;
        int wgid = (int)L; { const int q = nwg / NXCD, r = nwg % NXCD, xcd = wgid % NXCD, off = wgid / NXCD; wgid = (xcd < r ? xcd * (q + 1) : r * (q + 1) + (xcd - r) * q) + off; }
        const int nig = WGM * nN, gid = wgid / nig, fm = gid * WGM, gsz = (nM - fm) < WGM ? (nM - fm) : WGM;
        u.pm = fm + ((wgid % nig) % gsz); u.pn = (wgid % nig) / gsz; return true;
    }
    __device__ __forceinline__ void a_ready(const Unit&) const {}
    __device__ __forceinline__ void done(const Unit&) const {}
};

typedef float f32x2 __attribute__((ext_vector_type(2)));
typedef __bf16 bf16x2v __attribute__((ext_vector_type(2)));
typedef unsigned u32x2 __attribute__((ext_vector_type(2)));
__device__ __forceinline__ unsigned pk2(float lo, float hi) { const bf16x2v v = __builtin_convertvector((f32x2){lo, hi}, bf16x2v); return __builtin_bit_cast(unsigned, v); }
__device__ __forceinline__ u32x4 pk8(const f32x4 a, const f32x4 b) { u32x4 w; w.x = pk2(a[0], a[1]); w.y = pk2(a[2], a[3]); w.z = pk2(b[0], b[1]); w.w = pk2(b[2], b[3]); return w; }

typedef int i32x4 __attribute__((ext_vector_type(4)));
template <bool I8> struct AccT { typedef f32x4 type; static __device__ __forceinline__ type zero() { return (f32x4){0.f, 0.f, 0.f, 0.f}; } };
template <> struct AccT<true> { typedef i32x4 type; static __device__ __forceinline__ type zero() { return (i32x4){0, 0, 0, 0}; } };
__device__ __forceinline__ f32x4 mma16(const bf16x8 b, const bf16x8 a, const f32x4 c) { return __builtin_amdgcn_mfma_f32_16x16x32_bf16(b, a, c, 0, 0, 0); }
__device__ __forceinline__ i32x4 mma16(const bf16x8 b, const bf16x8 a, const i32x4 c) { return __builtin_amdgcn_mfma_i32_16x16x64_i8(__builtin_bit_cast(i32x4, b), __builtin_bit_cast(i32x4, a), c, 0, 0, 0); }
__device__ __forceinline__ f32x4 dq4(const f32x4 a, const float, const f32x4) { return a; }
__device__ __forceinline__ f32x4 dq4(const i32x4 a, const float ra, const f32x4 cb) { return (f32x4){(float)a[0], (float)a[1], (float)a[2], (float)a[3]} * ra * cb; }
constexpr int TOK_P = 65536;

template <bool I8> struct EpiBf16P {
    static constexpr bool PERM = true, AFTER_DRAIN = false;
    bf16_t* O; int ldc; const float* sa; const float* sb;
    __device__ __forceinline__ void operator()(const typename AccT<I8>::type (&acc)[2][2][4][2], const Unit& u, int wr, int wc, int fr, int fq) const {
        const int row0 = u.pm * BM + wr * 64 + fr, col0 = u.pn * BM + wc * 32 + 8 * fq;
        f32x4 cb[2][2];
#pragma unroll
        for (int bj = 0; bj < 2; ++bj)
#pragma unroll
            for (int n = 0; n < 2; ++n) cb[bj][n] = I8 ? *(const f32x4*)(sb + col0 + bj * HALF + 4 * n) : (f32x4){1.f, 1.f, 1.f, 1.f};
#pragma unroll
        for (int ai = 0; ai < 2; ++ai)
#pragma unroll
            for (int m = 0; m < 4; ++m) { const int row = row0 + ai * HALF + m * 16; const float ra = I8 ? sa[row] : 1.f; bf16_t* rowp = O + (size_t)row * ldc + col0;
#pragma unroll
                for (int bj = 0; bj < 2; ++bj) *(u32x4*)(rowp + bj * HALF) = pk8(dq4(acc[ai][bj][m][0], ra, cb[bj][0]), dq4(acc[ai][bj][m][1], ra, cb[bj][1])); }
    }
};
template <bool I8> struct EpiGate {
    static constexpr bool PERM = true, AFTER_DRAIN = false;
    bf16_t* U; bf16_t* Bg; const float* sa; const float* sb;
    __device__ __forceinline__ void operator()(const typename AccT<I8>::type (&acc)[2][2][4][2], const Unit& u, int wr, int wc, int fr, int fq) const {
        const int row0 = u.pm * BM + wr * 64 + fr, scol0 = u.pn * BM + wc * 32 + 8 * fq;
        f32x4 cb[2][2];
#pragma unroll
        for (int bj = 0; bj < 2; ++bj)
#pragma unroll
            for (int n = 0; n < 2; ++n) cb[bj][n] = I8 ? *(const f32x4*)(sb + scol0 + bj * HALF + 4 * n) : (f32x4){1.f, 1.f, 1.f, 1.f};
        if (u.pn < 8) {
            const int col0 = u.pn * HALF + wc * 32 + 8 * fq;
#pragma unroll
            for (int ai = 0; ai < 2; ++ai)
#pragma unroll
                for (int m = 0; m < 4; ++m) { const int row = row0 + ai * HALF + m * 16; const float ra = I8 ? sa[row] : 1.f;
                    const f32x4 v0 = dq4(acc[ai][0][m][0], ra, cb[0][0]) * dq4(acc[ai][1][m][0], ra, cb[1][0]), v1 = dq4(acc[ai][0][m][1], ra, cb[0][1]) * dq4(acc[ai][1][m][1], ra, cb[1][1]);
                    *(u32x4*)(U + (size_t)row * 1024 + col0) = pk8(v0, v1); }
        } else {
            const int col0 = (u.pn - 8) * BM + wc * 32 + 8 * fq;
#pragma unroll
            for (int ai = 0; ai < 2; ++ai)
#pragma unroll
                for (int m = 0; m < 4; ++m) { const int row = row0 + ai * HALF + m * 16; const float ra = I8 ? sa[row] : 1.f; bf16_t* rowp = Bg + (size_t)row * 1024 + col0;
#pragma unroll
                    for (int bj = 0; bj < 2; ++bj) *(u32x4*)(rowp + bj * HALF) = pk8(dq4(acc[ai][bj][m][0], ra, cb[bj][0]), dq4(acc[ai][bj][m][1], ra, cb[bj][1])); }
        }
    }
};
template <bool I8> struct EpiRes {
    static constexpr bool PERM = true, AFTER_DRAIN = false;
    const bf16_t* H; bf16_t* R; float alpha; const float* sa; const float* sb;
    __device__ __forceinline__ void operator()(const typename AccT<I8>::type (&acc)[2][2][4][2], const Unit& u, int wr, int wc, int fr, int fq) const {
        const int row0 = u.pm * BM + wr * 64 + fr, col0 = u.pn * BM + wc * 32 + 8 * fq;
        f32x4 cb[2][2];
#pragma unroll
        for (int bj = 0; bj < 2; ++bj)
#pragma unroll
            for (int n = 0; n < 2; ++n) cb[bj][n] = I8 ? *(const f32x4*)(sb + col0 + bj * HALF + 4 * n) : (f32x4){1.f, 1.f, 1.f, 1.f};
#pragma unroll
        for (int ai = 0; ai < 2; ++ai)
#pragma unroll
            for (int m = 0; m < 4; ++m) { const int row = row0 + ai * HALF + m * 16; const float ra = I8 ? sa[row] : 1.f; const size_t off = (size_t)row * 1024 + col0;
#pragma unroll
                for (int bj = 0; bj < 2; ++bj) { const u32x4 h = *(const u32x4*)(H + off + bj * HALF);
                    f32x4 h0, h1; h0[0] = __uint_as_float(h.x << 16); h0[1] = __uint_as_float(h.x & 0xffff0000u); h0[2] = __uint_as_float(h.y << 16); h0[3] = __uint_as_float(h.y & 0xffff0000u);
                    h1[0] = __uint_as_float(h.z << 16); h1[1] = __uint_as_float(h.z & 0xffff0000u); h1[2] = __uint_as_float(h.w << 16); h1[3] = __uint_as_float(h.w & 0xffff0000u);
                    *(u32x4*)(R + off + bj * HALF) = pk8(h0 * alpha + dq4(acc[ai][bj][m][0], ra, cb[bj][0]), h1 * alpha + dq4(acc[ai][bj][m][1], ra, cb[bj][1])); } }
    }
};
template <bool I8> struct EpiKV {
    static constexpr bool PERM = true, AFTER_DRAIN = false;
    bf16_t* Kb; bf16_t* Vb; float* kp; float* vp; float* ks; float* vs; const float* sa; const float* sb;
    __device__ __forceinline__ void operator()(const typename AccT<I8>::type (&acc)[2][2][4][2], const Unit& u, int wr, int wc, int fr, int fq) const {
        const bool isv = u.pn >= 4; const int colt = (isv ? u.pn - 4 : u.pn) * BM;
        bf16_t* ob = isv ? Vb : Kb; const bool samp = u.pm * BM >= TOK_P;
        float* of = samp ? (isv ? vs : ks) - (size_t)TOK_P * 1024 : (isv ? vp : kp);
        const int row0 = u.pm * BM + wr * 64 + fr, col0 = colt + wc * 32 + 8 * fq, scol0 = u.pn * BM + wc * 32 + 8 * fq;
        f32x4 cb[2][2];
#pragma unroll
        for (int bj = 0; bj < 2; ++bj)
#pragma unroll
            for (int n = 0; n < 2; ++n) cb[bj][n] = I8 ? *(const f32x4*)(sb + scol0 + bj * HALF + 4 * n) : (f32x4){1.f, 1.f, 1.f, 1.f};
#pragma unroll
        for (int ai = 0; ai < 2; ++ai)
#pragma unroll
            for (int m = 0; m < 4; ++m) { const int row = row0 + ai * HALF + m * 16; const float ra = I8 ? sa[row] : 1.f; const size_t off = (size_t)row * 1024 + col0;
#pragma unroll
                for (int bj = 0; bj < 2; ++bj) { const f32x4 v0 = dq4(acc[ai][bj][m][0], ra, cb[bj][0]), v1 = dq4(acc[ai][bj][m][1], ra, cb[bj][1]);
                    *(u32x4*)(ob + off + bj * HALF) = pk8(v0, v1); *(f32x4*)(of + off + bj * HALF) = v0; *(f32x4*)(of + off + bj * HALF + 4) = v1; } }
    }
};

struct EpiScoreI8 {
    static constexpr bool PERM = true, AFTER_DRAIN = false;
    bf16_t* O; int ldc; const float* sa; const float* sb;
    __device__ __forceinline__ void operator()(const i32x4 (&acc)[2][2][4][2], const Unit& u, int wr, int wc, int fr, int fq) const {
        const int row0 = u.pm * BM + wr * 64 + fr, col0 = u.pn * BM + wc * 32 + 8 * fq;
        f32x4 cb[2][2];
#pragma unroll
        for (int bj = 0; bj < 2; ++bj)
#pragma unroll
            for (int n = 0; n < 2; ++n) cb[bj][n] = *(const f32x4*)(sb + col0 + bj * HALF + 4 * n);
#pragma unroll
        for (int ai = 0; ai < 2; ++ai)
#pragma unroll
            for (int m = 0; m < 4; ++m) { const int row = row0 + ai * HALF + m * 16; const float ra = sa[row]; bf16_t* rowp = O + (size_t)row * ldc + col0;
#pragma unroll
                for (int bj = 0; bj < 2; ++bj) { f32x4 v0, v1;
#pragma unroll
                    for (int i = 0; i < 4; ++i) { v0[i] = (float)acc[ai][bj][m][0][i] * ra * cb[bj][0][i]; v1[i] = (float)acc[ai][bj][m][1][i] * ra * cb[bj][1][i]; }
                    *(u32x4*)(rowp + bj * HALF) = pk8(v0, v1); } }
    }
};

template <class Epi, class Sched, bool ALIGN_EPI = false, bool SP2 = false, bool I8 = false>
__device__ __forceinline__ void gemm_phase(PG8_LAS unsigned char* lds, const Gemm g, const Sched& S, const Epi& E, const int tid_in) {
    int tid_ = tid_in; asm volatile("" : "+v"(tid_));
    const int tid = tid_, wid = __builtin_amdgcn_readfirstlane(tid >> 6), lane = tid & 63, wr = wid >> 2, wc = wid & 3, fr = lane & 15, fq = lane >> 4;
    const int K = g.K, nt = K / BK;
    unsigned voffA[2], voffB[2];
#pragma unroll
    for (int i = 0; i < 2; ++i) { int R, C; stage_rc(tid * 16 + i * 8192, R, C); const int Rb = Epi::PERM ? ((R & ~31) + perm32(R & 31)) : R;
        voffA[i] = (unsigned)(R * K + C) * 2u; voffB[i] = (unsigned)(Rb * K + C) * 2u; }
    const size_t kstep = (size_t)(BK * 2);
    const size_t hstep = (size_t)HALF * K * 2;
    const size_t tstep = 2 * hstep;
    const unsigned ldsw = (unsigned)wid * 1024u;
    const int aoff = lds_byte(wr * 64 + fr, fq * 8), boff = lds_byte(wc * 32 + fr, fq * 8);
#define PG8_SA(b, h) (((b) * 2 + (h)) * HTB)
#define PG8_SB(b, h) ((4 + (b) * 2 + (h)) * HTB)
#define PG8_STAGE(bufoff, gbase, voff) do { _Pragma("unroll") for (int _i = 0; _i < 2; ++_i) \
        __builtin_amdgcn_global_load_lds((const unsigned*)((const char*)(gbase) + (voff)[_i]), (PG8_LAS unsigned*)(lds + (bufoff) + ldsw + _i * 8192), 16, 0, 0); } while (0)
#define PG8_LDA(dst, b, h) do { _Pragma("unroll") for (int m = 0; m < 4; ++m) _Pragma("unroll") for (int k = 0; k < 2; ++k) dst[m][k] = *(const PG8_LAS bf16x8*)(lds + PG8_SA(b, h) + aoff + m * 2048 + k * 1024); } while (0)
#define PG8_LDB(dst, b, h) do { _Pragma("unroll") for (int n = 0; n < 2; ++n) _Pragma("unroll") for (int k = 0; k < 2; ++k) dst[n][k] = *(const PG8_LAS bf16x8*)(lds + PG8_SB(b, h) + boff + n * 2048 + k * 1024); } while (0)
#define PG8_MMA(ai, bj, At, Bt) do { __builtin_amdgcn_s_setprio(1); _Pragma("unroll") for (int m = 0; m < 4; ++m) _Pragma("unroll") for (int n = 0; n < 2; ++n) _Pragma("unroll") for (int k = 0; k < 2; ++k) \
        acc[ai][bj][m][n] = mma16(Bt[n][k], At[m][k], acc[ai][bj][m][n]); __builtin_amdgcn_s_setprio(0); } while (0)
#define PG8_WAIT_V(n) asm volatile("s_waitcnt vmcnt(" #n ")" ::: "memory")
#define PG8_WAIT_L(n) asm volatile("s_waitcnt lgkmcnt(" #n ")" ::: "memory")
#define PG8_BAR __builtin_amdgcn_s_barrier()
#define PG8_SCHED __builtin_amdgcn_sched_barrier(0)
    Unit cur, nxt; int ui = 0;
    if (!S.next(0, cur)) return;
    typename AccT<I8>::type acc[2][2][4][2];
#pragma unroll
    for (int a = 0; a < 2; ++a)
#pragma unroll
        for (int b = 0; b < 2; ++b)
#pragma unroll
            for (int m = 0; m < 4; ++m)
#pragma unroll
                for (int n = 0; n < 2; ++n) acc[a][b][m][n] = AccT<I8>::zero();
    bf16x8 At[4][2], B0[2][2], B1[2][2];
    const char* cA = (const char*)g.A + (size_t)cur.pm * tstep; const char* cB = (const char*)g.Bt + (size_t)cur.pn * tstep;
    S.a_ready(cur);
    if constexpr (SP2) {
        PG8_STAGE(PG8_SB(0, 0), cB, voffB); PG8_STAGE(PG8_SB(0, 1), cB + hstep, voffB); PG8_STAGE(PG8_SA(0, 0), cA, voffA); PG8_STAGE(PG8_SA(0, 1), cA + hstep, voffA);
        if (wr == 1) PG8_BAR;
        PG8_WAIT_V(2); PG8_BAR;
        PG8_STAGE(PG8_SB(1, 0), cB + kstep, voffB); PG8_STAGE(PG8_SA(1, 0), cA + kstep, voffA); PG8_STAGE(PG8_SB(1, 1), cB + hstep + kstep, voffB);
        PG8_WAIT_V(6); PG8_BAR;
    } else {
        PG8_STAGE(PG8_SB(0, 0), cB, voffB); PG8_STAGE(PG8_SA(0, 0), cA, voffA); PG8_STAGE(PG8_SB(0, 1), cB + hstep, voffB); PG8_STAGE(PG8_SA(0, 1), cA + hstep, voffA);
        if (wr == 1) PG8_BAR;
        PG8_WAIT_V(4); PG8_BAR;
        PG8_STAGE(PG8_SB(1, 0), cB + kstep, voffB); PG8_STAGE(PG8_SA(1, 0), cA + kstep, voffA); PG8_STAGE(PG8_SB(1, 1), cB + hstep + kstep, voffB);
        PG8_WAIT_V(6); PG8_BAR;
    }
    for (;;) {
        const bool has_next = S.next(ui + 1, nxt);
        const char* nA = has_next ? (const char*)g.A + (size_t)nxt.pm * tstep : cA; const char* nB = has_next ? (const char*)g.Bt + (size_t)nxt.pn * tstep : cB;
        for (int t = 0; t < nt; t += 2) {
            const bool last = (t == nt - 2);
            const char* a1 = cA + (size_t)(t + 1) * kstep;
            const char* a2 = last ? nA : cA + (size_t)(t + 2) * kstep; const char* b2 = last ? nB : cB + (size_t)(t + 2) * kstep;
            const char* a3 = a2 + kstep; const char* b3 = b2 + kstep;
            if (last && has_next) S.a_ready(nxt);
            if constexpr (SP2) {
            PG8_LDB(B0, 0, 0); PG8_LDB(B1, 0, 1); PG8_SCHED; PG8_LDA(At, 0, 0); PG8_STAGE(PG8_SA(1, 1), a1 + hstep, voffA);
            PG8_WAIT_V(8); PG8_WAIT_L(0); PG8_BAR; PG8_MMA(0, 0, At, B0); PG8_MMA(0, 1, At, B1); PG8_BAR; PG8_SCHED;
            PG8_LDA(At, 0, 1); PG8_STAGE(PG8_SB(0, 0), b2, voffB); PG8_STAGE(PG8_SB(0, 1), b2 + hstep, voffB); PG8_STAGE(PG8_SA(0, 0), a2, voffA);
            PG8_WAIT_V(8); PG8_WAIT_L(0); PG8_BAR; PG8_MMA(1, 0, At, B0); PG8_MMA(1, 1, At, B1); PG8_BAR; PG8_SCHED;
            PG8_LDB(B0, 1, 0); PG8_LDB(B1, 1, 1); PG8_SCHED; PG8_LDA(At, 1, 0); PG8_STAGE(PG8_SA(0, 1), a2 + hstep, voffA);
            PG8_WAIT_V(8); PG8_WAIT_L(0); PG8_BAR; PG8_MMA(0, 0, At, B0); PG8_MMA(0, 1, At, B1); PG8_BAR; PG8_SCHED;
            PG8_LDA(At, 1, 1); PG8_STAGE(PG8_SB(1, 0), b3, voffB); PG8_STAGE(PG8_SB(1, 1), b3 + hstep, voffB); PG8_STAGE(PG8_SA(1, 0), a3, voffA);
            PG8_WAIT_V(8); PG8_WAIT_L(0); PG8_BAR; PG8_MMA(1, 0, At, B0); PG8_MMA(1, 1, At, B1); PG8_BAR; PG8_SCHED;
            } else {
            PG8_LDB(B0, 0, 0); PG8_SCHED; PG8_LDA(At, 0, 0); PG8_STAGE(PG8_SA(1, 1), a1 + hstep, voffA);
            PG8_WAIT_L(8); PG8_BAR; PG8_WAIT_L(0); PG8_MMA(0, 0, At, B0); PG8_BAR; PG8_SCHED;
            PG8_LDB(B1, 0, 1); PG8_STAGE(PG8_SB(0, 0), b2, voffB);
            PG8_BAR; PG8_WAIT_L(0); PG8_MMA(0, 1, At, B1); PG8_BAR;
            PG8_LDA(At, 0, 1); PG8_STAGE(PG8_SA(0, 0), a2, voffA);
            PG8_BAR; PG8_WAIT_L(0); PG8_MMA(1, 0, At, B0); PG8_BAR; PG8_SCHED;
            PG8_STAGE(PG8_SB(0, 1), b2 + hstep, voffB);
            PG8_WAIT_V(6); PG8_BAR; PG8_MMA(1, 1, At, B1); PG8_BAR;
            PG8_LDB(B0, 1, 0); PG8_SCHED; PG8_LDA(At, 1, 0); PG8_STAGE(PG8_SA(0, 1), a2 + hstep, voffA);
            PG8_WAIT_L(8); PG8_BAR; PG8_WAIT_L(0); PG8_MMA(0, 0, At, B0); PG8_BAR; PG8_SCHED;
            PG8_LDB(B1, 1, 1); PG8_STAGE(PG8_SB(1, 0), b3, voffB);
            PG8_BAR; PG8_WAIT_L(0); PG8_MMA(0, 1, At, B1); PG8_BAR;
            PG8_LDA(At, 1, 1); PG8_STAGE(PG8_SA(1, 0), a3, voffA);
            PG8_BAR; PG8_WAIT_L(0); PG8_MMA(1, 0, At, B0); PG8_BAR; PG8_SCHED;
            PG8_STAGE(PG8_SB(1, 1), b3 + hstep, voffB);
            PG8_WAIT_V(6); PG8_BAR; PG8_MMA(1, 1, At, B1); PG8_BAR;
            }
        }
        if constexpr (ALIGN_EPI) { if (wr == 0) PG8_BAR; }
        if constexpr (!Epi::AFTER_DRAIN) { E(acc, cur, wr, wc, fr, fq); S.done(cur); }
        if (!has_next) break;
#pragma unroll
        for (int a = 0; a < 2; ++a)
#pragma unroll
            for (int b = 0; b < 2; ++b)
#pragma unroll
                for (int m = 0; m < 4; ++m)
#pragma unroll
                    for (int n = 0; n < 2; ++n) acc[a][b][m][n] = AccT<I8>::zero();
        cur = nxt; cA = nA; cB = nB; ++ui;
        if constexpr (ALIGN_EPI) { if (wr == 1) PG8_BAR; }
    }
    PG8_WAIT_V(0);
    if constexpr (!ALIGN_EPI) { if (wr == 0) PG8_BAR; }
    PG8_BAR;
    if constexpr (Epi::AFTER_DRAIN) { E.fused(acc, cur, wr, wc, fr, fq, lds, wid, lane); S.done(cur); }
#undef PG8_SA
#undef PG8_SB
#undef PG8_STAGE
#undef PG8_LDA
#undef PG8_LDB
#undef PG8_MMA
#undef PG8_WAIT_V
#undef PG8_WAIT_L
#undef PG8_BAR
#undef PG8_SCHED
}
}

#define GAS __attribute__((address_space(1)))
#define LAS __attribute__((address_space(3)))
#define DI __device__ __forceinline__
typedef unsigned short bf16;
typedef unsigned v4u __attribute__((ext_vector_type(4)));
typedef unsigned v2u __attribute__((ext_vector_type(2)));
typedef float f32x4 __attribute__((ext_vector_type(4)));
typedef float f32x16 __attribute__((ext_vector_type(16)));
typedef short bf16x8 __attribute__((ext_vector_type(8)));
using pg8::pk2;
#define LDS_WAIT() asm volatile("s_waitcnt lgkmcnt(0)" ::: "memory")
#define MFMA32(a, b, c) __builtin_amdgcn_mfma_f32_32x32x16_bf16((a), (b), (c), 0, 0, 0)

constexpr int D = 1024, NB = 32, SEQ = 2048, DSEQ = 16, PAST = 1024, NH = 16, DH = 64;
constexpr int TP = NB * SEQ, TS = NB * DSEQ, T = TP + TS;
constexpr int NEXP = 16384, PH = 8, PK = 16;
constexpr int NLAYER = 4;
constexpr float LN_EPS = 1e-5f;
constexpr float ALPHA = 1.6817928305074292f;
constexpr float LOG2E = 1.4426950408889634f, LN2 = 0.6931471805599453f;
static_assert(T % 256 == 0 && pg8::TOK_P == TP, "row panels");
constexpr size_t O_Y = 0, O_YS = (size_t)TP * D, O_CONVP = O_YS + (size_t)TS * D, O_KP = O_CONVP + 2 * NB * 2 * D, O_VP = O_KP + (size_t)TP * D,
                 O_CONVS = O_VP + (size_t)TP * D, O_KS = O_CONVS + 2 * NB * 2 * D, O_VS = O_KS + (size_t)TS * D, O_END = O_VS + (size_t)TS * D;
static_assert(O_END == 203161600ull, "output size");
constexpr size_t MiB = 1u << 20;
constexpr size_t WS_CTL = 0, CTL_BYTES = 2 * MiB;
constexpr size_t WS_WIN = 2 * MiB;
constexpr size_t WS_WOUT = WS_WIN + 12 * MiB;
constexpr size_t WS_WQ = WS_WOUT + 4 * MiB;
constexpr size_t WS_WO = WS_WQ + 4 * MiB;
constexpr size_t WS_WKV = WS_WO + 4 * MiB;
constexpr size_t WS_WP = WS_WKV + 4 * MiB;
constexpr size_t WS_VSN = WS_WP + 16 * MiB;
constexpr size_t WS_H = WS_VSN + 1 * MiB;
constexpr size_t WS_KB = WS_H + 129 * MiB;
constexpr size_t WS_VT = WS_KB + 129 * MiB;
constexpr size_t WS_IDS = WS_VT + 128 * MiB;
constexpr size_t WS_GATE = WS_IDS + 17 * MiB;
constexpr size_t WS_TU = WS_GATE + 33 * MiB;
constexpr size_t WS_TV = WS_TU + 64 * MiB;
constexpr size_t WS_SU = WS_TV + 64 * MiB;
constexpr size_t WS_W8 = WS_SU + 1 * MiB;
constexpr size_t WS_SX = WS_W8 + 9 * MiB;
constexpr size_t WS_X8 = WS_SX + 1 * MiB;
constexpr size_t WS_W8A = WS_X8 + 65 * MiB;
constexpr size_t WS_SWA = WS_W8A + 22 * MiB;
constexpr int W8_ROWS = (int)((WS_VSN - WS_WIN) / 2048);
static_assert(W8_ROWS == 22528, "weight rows");
constexpr size_t WS_A = WS_SWA + 1 * MiB;
constexpr size_t WS_END = WS_A + 258 * MiB;
static_assert((size_t)T * D * 2 == 129 * MiB && (size_t)1024 * T * 4 == 258 * MiB, "sizes");
constexpr int CW_Q = 1024;
constexpr int CW_BAR = 16384;

constexpr int RING_BYTES = 131072, MISC_OFF = RING_BYTES + 320, LDS_BYTES = 147456;

#define XB_TMO      128
#define XB_XCNT(j)  (256  + 64 * (j))
#define XB_XSUB(j)  (1280 + 64 * (j))
#define XB_XGEN(j)  (2304 + 64 * (j))
#define XB_TOP      3328
#define XB_TOPGEN   3392
#define XCD_BAR_WORDS 3456
#define XB_SPIN_CAP (1u << 18)

__device__ __forceinline__ unsigned xb_ld(unsigned* p)              { return __hip_atomic_load(p, __ATOMIC_RELAXED, __HIP_MEMORY_SCOPE_AGENT); }
__device__ __forceinline__ unsigned xb_add(unsigned* p, unsigned v) { return __hip_atomic_fetch_add(p, v, __ATOMIC_RELAXED, __HIP_MEMORY_SCOPE_AGENT); }
__device__ __forceinline__ unsigned xb_xcc_id() { return (unsigned)__builtin_amdgcn_s_getreg((3 << 11) | 20) & 0xFu; }
#define XB_SPIN(cond, bar) do { unsigned _sp = 0; while (cond) { __builtin_amdgcn_s_sleep(1); \
    if ((++_sp & 255u) == 0u) { if (xb_ld(&(bar)[XB_TMO])) break; if (_sp > XB_SPIN_CAP) { atomicAdd(&(bar)[XB_TMO], 1u); break; } } } } while (0)

__device__ __forceinline__ int xb_lane_id() { int l; asm volatile("v_mbcnt_lo_u32_b32 %0, -1, 0\n\tv_mbcnt_hi_u32_b32 %0, -1, %0" : "=v"(l)); return l; }
__device__ __forceinline__ bool xb_is_thread0(unsigned w0) { return w0 != 0u && xb_lane_id() == 0; }
struct XcdBarrier {
    unsigned w0;
    unsigned* bar; unsigned x;
    volatile LAS unsigned* st;
};

__device__ __forceinline__ XcdBarrier xcd_barrier_post(unsigned* bar, volatile LAS unsigned* st, unsigned w0) {
    XcdBarrier b; b.w0 = w0; b.bar = bar; b.x = xb_xcc_id(); b.st = st;
    if (xb_is_thread0(b.w0)) (void)xb_add(&bar[XB_XCNT(b.x)], 1u);
    return b;
}
__device__ __forceinline__ void xcd_barrier_complete(unsigned* bar, unsigned x, unsigned& nloc, unsigned& nx) {
    const unsigned G = gridDim.x * gridDim.y * gridDim.z;
    unsigned sum, cnt, mine, sp = 0u;
    for (;;) {
        sum = 0u; cnt = 0u; mine = 0u;
#pragma unroll
        for (unsigned j = 0; j < 16; ++j) { const unsigned c = xb_ld(&bar[XB_XCNT(j)]); sum += c; cnt += (c > 0u) ? 1u : 0u; mine = (j == x) ? c : mine; }
        if (sum == G) break;
        __builtin_amdgcn_s_sleep(1);
        if ((++sp & 255u) == 0u) { if (xb_ld(&bar[XB_TMO])) break; if (sp > XB_SPIN_CAP) { atomicAdd(&bar[XB_TMO], 1u); break; } }
    }
    nloc = mine > 0u ? mine : 1u; nx = cnt > 0u ? cnt : 1u;
}

__device__ __forceinline__ void xcd_barrier(const XcdBarrier& b) {
    asm volatile("s_waitcnt vmcnt(0)" ::: "memory");
    __syncthreads();
    if (xb_is_thread0(b.w0)) {
        unsigned* bar = b.bar;
        __builtin_amdgcn_s_waitcnt(0);
        unsigned nloc = b.st[0], nx = b.st[1];
        if (nloc == 0u) { xcd_barrier_complete(bar, b.x, nloc, nx); b.st[0] = nloc; b.st[1] = nx; }
        const unsigned old = xb_add(&bar[XB_XSUB(b.x)], 1u);
        const unsigned gen = old / nloc;
        if (old + 1u == (gen + 1u) * nloc) {
            __builtin_amdgcn_fence(__ATOMIC_RELEASE, "agent");
            asm volatile("s_waitcnt vmcnt(0)" ::: "memory");
            const unsigned og = xb_add(&bar[XB_TOP], 1u);
            const unsigned tg = og / nx;
            if (og + 1u == (tg + 1u) * nx) xb_add(&bar[XB_TOPGEN], 1u);
            else XB_SPIN(xb_ld(&bar[XB_TOPGEN]) == tg, bar);
            __builtin_amdgcn_fence(__ATOMIC_ACQUIRE, "agent");
            xb_add(&bar[XB_XGEN(b.x)], 1u);
            asm volatile("s_waitcnt vmcnt(0)" ::: "memory");
        } else {
            XB_SPIN(xb_ld(&bar[XB_XGEN(b.x)]) == gen, bar);
            __builtin_amdgcn_fence(__ATOMIC_ACQUIRE, "agent");
            asm volatile("s_waitcnt vmcnt(0)" ::: "memory");
        }
    }
    __syncthreads();
}


DI float bflo(unsigned w) { return __uint_as_float(w << 16); }
DI float bfhi(unsigned w) { return __uint_as_float(w & 0xffff0000u); }
DI float shx(const int lane, const float v, const int o) { return __int_as_float(__builtin_amdgcn_ds_bpermute((lane ^ o) << 2, __float_as_int(v))); }
DI int shx(const int lane, const int v, const int o) { return __builtin_amdgcn_ds_bpermute((lane ^ o) << 2, v); }
DI float wave_sum(const int lane, float v) {
#pragma unroll
    for (int o = 1; o < 64; o <<= 1) v += shx(lane, v, o);
    return v;
}
DI bf16x8 pack8(float a0, float a1, float a2, float a3, float a4, float a5, float a6, float a7) {
    v4u p; p.x = pk2(a0, a1); p.y = pk2(a2, a3); p.z = pk2(a4, a5); p.w = pk2(a6, a7); return __builtin_bit_cast(bf16x8, p);
}
DI float gelu_erf(float v) {
    const float av = __builtin_fabsf(v), d = av * 0.2316418882f + 1.0f, t = __builtin_amdgcn_rcpf(d);
    float q = t * 0.5307027145f + (-0.7265760135f); q = q * t + 0.7107068705f; q = q * t + (-0.142248368f); q = q * t + 0.127414796f; q = q * t;
    const float e = __builtin_amdgcn_exp2f((v * v) * (-0.72134752044f));
    const float m = v * (q * e), r = v - m;
    return v < 0.f ? m : r;
}

struct Ctx {
    int tid, lane, wave, vcu, G;
};

DI void p0_transpose_item(const float* W, int K, int N, bf16* WT, int out_row0, float scale, LAS float* scr, int k0, int n0, int lane) {
#pragma unroll 8
    for (int i = 0; i < 32; ++i) { const int kk = 2 * i + (lane >> 5); scr[kk * 33 + (lane & 31)] = W[(size_t)(k0 + kk) * N + n0 + (lane & 31)]; }
    LDS_WAIT(); asm volatile("" ::: "memory");
    const int c = lane & 7;
#pragma unroll
    for (int j = 0; j < 4; ++j) { const int n = (lane >> 3) + 8 * j; const LAS float* s = scr + (8 * c) * 33 + n;
        v4u o; o.x = pk2(s[0 * 33] * scale, s[1 * 33] * scale); o.y = pk2(s[2 * 33] * scale, s[3 * 33] * scale); o.z = pk2(s[4 * 33] * scale, s[5 * 33] * scale); o.w = pk2(s[6 * 33] * scale, s[7 * 33] * scale);
        *(v4u*)(WT + (size_t)(out_row0 + n) * K + k0 + 8 * c) = o; }
    LDS_WAIT(); asm volatile("" ::: "memory");
}
DI void cvt_stream(const float* src, bf16* dst, size_t n8, size_t gtid, size_t NT) {
    size_t i = gtid;
    for (; i + 3 * NT < n8; i += 4 * NT) {
        f32x4 a[4], b[4];
#pragma unroll
        for (int u = 0; u < 4; ++u) { a[u] = *(const f32x4*)(src + (i + u * NT) * 8); b[u] = *(const f32x4*)(src + (i + u * NT) * 8 + 4); }
#pragma unroll
        for (int u = 0; u < 4; ++u) *(v4u*)(dst + (i + u * NT) * 8) = pg8::pk8(a[u], b[u]);
    }
    for (; i < n8; i += NT) { const f32x4 a = *(const f32x4*)(src + i * 8), b = *(const f32x4*)(src + i * 8 + 4); *(v4u*)(dst + i * 8) = pg8::pk8(a, b); }
}
DI unsigned q4_i8(const f32x4 v, const float k) {
    const int a = (int)__builtin_rintf(v[0] * k), b = (int)__builtin_rintf(v[1] * k), c = (int)__builtin_rintf(v[2] * k), d = (int)__builtin_rintf(v[3] * k);
    return ((unsigned)a & 0xffu) | (((unsigned)b & 0xffu) << 8) | (((unsigned)c & 0xffu) << 16) | ((unsigned)d << 24);
}
DI void cvt_table_rows(const float* src, unsigned char* dst, float* scl  , int nrows, int gw, int NGW, int lane) {
    f32x4 nx[4];
#pragma unroll
    for (int j = 0; j < 4; ++j) nx[j] = *(const f32x4*)(src + (size_t)(gw < nrows ? gw : 0) * D + 4 * lane + 256 * j);
    for (int row = gw; row < nrows; row += NGW) {
        f32x4 v[4]; float m = 0.f; const int rn = row + NGW < nrows ? row + NGW : row;
#pragma unroll
        for (int j = 0; j < 4; ++j) { v[j] = nx[j]; nx[j] = *(const f32x4*)(src + (size_t)rn * D + 4 * lane + 256 * j);
            m = __builtin_fmaxf(m, __builtin_fmaxf(__builtin_fmaxf(__builtin_fabsf(v[j][0]), __builtin_fabsf(v[j][1])), __builtin_fmaxf(__builtin_fabsf(v[j][2]), __builtin_fabsf(v[j][3])))); }
#pragma unroll
        for (int o = 1; o < 64; o <<= 1) m = __builtin_fmaxf(m, shx(lane, m, o));
        const float k = m > 0.f ? 127.0f / m : 0.f;
#pragma unroll
        for (int j = 0; j < 4; ++j)
            *(unsigned*)(dst + ((size_t)(row >> 14) * NEXP * D) + ((size_t)(2 * j + (lane >> 5)) * NEXP + (row & (NEXP - 1))) * 128 + ((4 * lane) & 127)) = q4_i8(v[j], k);
        if (lane == 0) scl[2 * row] = m * (1.0f / 127.0f);
    }
}
struct P0Args { const float *x_p, *x_s, *w_in, *w_out, *wq, *wo, *wk, *wv, *pwq, *psk, *pu, *pv; bf16 *WinT, *WoutT, *WqT, *WoT, *WkvT, *WP, *H; unsigned char *TU, *TV; float *SU, *SV; unsigned char* X8; float* SX; };
DI void p0_prologue(const Ctx c, LAS unsigned char* lds, const P0Args a) {
    { LAS float* scr = (LAS float*)(lds + c.wave * 16384);
      const int gw = c.vcu * 8 + c.wave, NGW = c.G * 8;
      constexpr int IT_WIN = 16 * 96, IT_SQ = 16 * 32, NITEMS = 2 * IT_WIN + 8 * IT_SQ;
      for (int it = gw; it < NITEMS; it += NGW) {
          int r = it;
          if (r < 2 * IT_WIN) { const int l = r / IT_WIN; r -= l * IT_WIN; const int kb = r / 96, nb = r % 96, n0 = 32 * nb; int orow;
              if (n0 < 1024) orow = 2048 + n0; else if (n0 < 2048) { const int d = n0 - 1024; orow = 256 * (d >> 7) + (d & 127); } else { const int d = n0 - 2048; orow = 256 * (d >> 7) + 128 + (d & 127); }
              p0_transpose_item(a.w_in + (size_t)l * 1024 * 3072, 1024, 3072, a.WinT + (size_t)l * 3072 * 1024, orow, 1.f, scr, 64 * kb, n0, c.lane); continue; }
          r -= 2 * IT_WIN; const int m = r / IT_SQ; r -= m * IT_SQ; const int kb = r >> 5, nb = r & 31;
          const float* src; bf16* dst; float sc = 1.f; const size_t SQ = (size_t)1024 * 1024;
          if (m < 2) { src = a.w_out + m * SQ; dst = a.WoutT + m * SQ; }
          else if (m < 4) { src = a.wq + (m - 2) * SQ; dst = a.WqT + (m - 2) * SQ; sc = 0.125f * LOG2E; }
          else if (m < 6) { src = a.wo + (m - 4) * SQ; dst = a.WoT + (m - 4) * SQ; }
          else if (m == 6) { src = a.wk; dst = a.WkvT; }
          else { src = a.wv; dst = a.WkvT + SQ; }
          p0_transpose_item(src, 1024, 1024, dst, 32 * nb, sc, scr, 64 * kb, 32 * nb, c.lane);
      }
    }
    __syncthreads();
    { LAS float* skT = (LAS float*)lds; LAS float* wqT = skT + 128 * 132;
      for (int u = c.vcu; u < 4 * 16 * 16; u += c.G) {
          const int l = u >> 8, hp = (u >> 4) & 15, dblk = u & 15;
          for (int i = c.tid; i < 16384; i += 512) skT[(i & 127) * 132 + (i >> 7)] = a.psk[(size_t)(l * 16 + hp) * 16384 + i];
          for (int i = c.tid; i < 8192; i += 512) wqT[(i & 127) * 68 + (i >> 7)] = a.pwq[((size_t)l * 1024 + dblk * 64 + (i >> 7)) * 2048 + hp * 128 + (i & 127)];
          __syncthreads();
          const int ng = c.tid & 31, dg = c.tid >> 5; f32x4 acc[4];
#pragma unroll
          for (int i = 0; i < 4; ++i) acc[i] = (f32x4){0.f, 0.f, 0.f, 0.f};
#pragma unroll 4
          for (int cc = 0; cc < 128; ++cc) { const f32x4 s = *(const LAS f32x4*)(skT + cc * 132 + 4 * ng), w = *(const LAS f32x4*)(wqT + cc * 68 + 4 * dg);
#pragma unroll
              for (int i = 0; i < 4; ++i) acc[i] = acc[i] + w * s[i]; }
#pragma unroll
          for (int i = 0; i < 4; ++i) { v2u o; o.x = pk2(acc[i][0], acc[i][1]); o.y = pk2(acc[i][2], acc[i][3]);
              *(v2u*)(a.WP + ((size_t)l * 2048 + hp * 128 + 4 * ng + i) * 1024 + dblk * 64 + 4 * dg) = o; }
          __syncthreads();
      }
    }
    { const size_t gtid = (size_t)c.vcu * 512 + c.tid, NT = (size_t)c.G * 512;
      cvt_table_rows(a.pu, a.TU, a.SU, NLAYER * NEXP, c.vcu * 8 + c.wave, c.G * 8, c.lane);
      cvt_table_rows(a.pv, a.TV, a.SV, NLAYER * NEXP, c.vcu * 8 + c.wave, c.G * 8, c.lane);
      (void)gtid; (void)NT;
      for (int m = c.vcu * 8 + c.wave; m < T; m += c.G * 8) {
          const float* xr = (m < TP ? a.x_p + (size_t)m * D : a.x_s + (size_t)(m - TP) * D) + 4 * c.lane;
          f32x4 v[4]; float am = 0.f;
#pragma unroll
          for (int j = 0; j < 4; ++j) { v[j] = *(const f32x4*)(xr + 256 * j); v2u w; w.x = pk2(v[j][0], v[j][1]); w.y = pk2(v[j][2], v[j][3]); ((v2u*)(a.H + (size_t)m * D) + c.lane)[64 * j] = w;
              am = __builtin_fmaxf(am, __builtin_fmaxf(__builtin_fmaxf(__builtin_fabsf(v[j][0]), __builtin_fabsf(v[j][1])), __builtin_fmaxf(__builtin_fabsf(v[j][2]), __builtin_fabsf(v[j][3])))); }
#pragma unroll
          for (int o = 1; o < 64; o <<= 1) am = __builtin_fmaxf(am, shx(c.lane, am, o));
          const float k = am > 0.f ? 127.0f / am : 0.f;
#pragma unroll
          for (int j = 0; j < 4; ++j) *(unsigned*)(a.X8 + (size_t)m * D + 4 * c.lane + 256 * j) = q4_i8(v[j], k);
          if (c.lane == 0) a.SX[m] = am * (1.0f / 127.0f);
      }
    }
}

DI void wp_quant_phase(const Ctx c, const bf16* WPb, unsigned char* WP8q, float* swp) {
    for (int row = c.vcu * 8 + c.wave; row < W8_ROWS; row += c.G * 8) {
        const v4u a = *(const v4u*)(WPb + (size_t)row * D + 16 * c.lane), b = *(const v4u*)(WPb + (size_t)row * D + 16 * c.lane + 8);
        const f32x4 v0 = {bflo(a.x), bfhi(a.x), bflo(a.y), bfhi(a.y)}, v1 = {bflo(a.z), bfhi(a.z), bflo(a.w), bfhi(a.w)}, v2 = {bflo(b.x), bfhi(b.x), bflo(b.y), bfhi(b.y)}, v3 = {bflo(b.z), bfhi(b.z), bflo(b.w), bfhi(b.w)};
        float m = 0.f;
#pragma unroll
        for (int i = 0; i < 4; ++i) m = __builtin_fmaxf(m, __builtin_fmaxf(__builtin_fmaxf(__builtin_fabsf(v0[i]), __builtin_fabsf(v1[i])), __builtin_fmaxf(__builtin_fabsf(v2[i]), __builtin_fabsf(v3[i]))));
#pragma unroll
        for (int o = 1; o < 64; o <<= 1) m = __builtin_fmaxf(m, shx(c.lane, m, o));
        const float k = m > 0.f ? 127.0f / m : 0.f;
        v4u o; o.x = q4_i8(v0, k); o.y = q4_i8(v1, k); o.z = q4_i8(v2, k); o.w = q4_i8(v3, k);
        *(v4u*)(WP8q + (size_t)row * D + 16 * c.lane) = o;
        if (c.lane == 0) swp[row] = m * (1.0f / 127.0f);
    }
}

DI void ld8_bf16(const bf16* p, float (&o)[8]) { const v4u w = *(const v4u*)p; o[0] = bflo(w.x); o[1] = bfhi(w.x); o[2] = bflo(w.y); o[3] = bfhi(w.y); o[4] = bflo(w.z); o[5] = bfhi(w.z); o[6] = bflo(w.w); o[7] = bfhi(w.w); }
DI void ld8_f32(const float* p, float (&o)[8]) { const f32x4 a = *(const f32x4*)p, b = *(const f32x4*)(p + 4); o[0] = a[0]; o[1] = a[1]; o[2] = a[2]; o[3] = a[3]; o[4] = b[0]; o[5] = b[1]; o[6] = b[2]; o[7] = b[3]; }
DI void conv_gate_phase(const Ctx c, const bf16* U, bf16* Bg, const float* wdw  , const float* st  , float* convp, float* convs  ,
                        unsigned char* z8, float* sz  , const bool skip_samp = false  ) {
    const int gw = c.vcu * 8 + c.wave, NGW = c.G * 8, dc = 16 * c.lane;
    float w0[16], w1[16], w2[16];
    { float t8[8]; ld8_f32(wdw + dc, t8);
#pragma unroll
      for (int i = 0; i < 8; ++i) w0[i] = t8[i]; ld8_f32(wdw + dc + 8, t8);
#pragma unroll
      for (int i = 0; i < 8; ++i) w0[8 + i] = t8[i]; ld8_f32(wdw + D + dc, t8);
#pragma unroll
      for (int i = 0; i < 8; ++i) w1[i] = t8[i]; ld8_f32(wdw + D + dc + 8, t8);
#pragma unroll
      for (int i = 0; i < 8; ++i) w1[8 + i] = t8[i]; ld8_f32(wdw + 2 * D + dc, t8);
#pragma unroll
      for (int i = 0; i < 8; ++i) w2[i] = t8[i]; ld8_f32(wdw + 2 * D + dc + 8, t8);
#pragma unroll
      for (int i = 0; i < 8; ++i) w2[8 + i] = t8[i]; }
    { v4u ng[2], n2[2], n1[2], n0[2];
#define CG_LOAD(tt_) do { const int t_ = (tt_), s_ = t_ & 2047, t1_ = s_ >= 1 ? t_ - 1 : t_, t0_ = s_ >= 2 ? t_ - 2 : t_; \
        _Pragma("unroll") for (int hf = 0; hf < 2; ++hf) { ng[hf] = *(const v4u*)(Bg + (size_t)t_ * D + dc + 8 * hf); n2[hf] = *(const v4u*)(U + (size_t)t_ * D + dc + 8 * hf); \
            n1[hf] = *(const v4u*)(U + (size_t)t1_ * D + dc + 8 * hf); n0[hf] = *(const v4u*)(U + (size_t)t0_ * D + dc + 8 * hf); } } while (0)
      if (gw < TP) CG_LOAD(gw);
      for (int t = gw; t < TP; t += NGW) {
          const int s = t & 2047; const float f1 = s >= 1 ? 1.f : 0.f, f0 = s >= 2 ? 1.f : 0.f;
          v4u cg[2], c2[2], c1[2], c0[2];
#pragma unroll
          for (int hf = 0; hf < 2; ++hf) { cg[hf] = ng[hf]; c2[hf] = n2[hf]; c1[hf] = n1[hf]; c0[hf] = n0[hf]; }
          CG_LOAD(t + NGW < TP ? t + NGW : t);
          float z[16]; float am = 0.f;
#pragma unroll
          for (int hf = 0; hf < 2; ++hf) { const unsigned wg[4] = {cg[hf].x, cg[hf].y, cg[hf].z, cg[hf].w}, w2_[4] = {c2[hf].x, c2[hf].y, c2[hf].z, c2[hf].w}, w1_[4] = {c1[hf].x, c1[hf].y, c1[hf].z, c1[hf].w}, w0_[4] = {c0[hf].x, c0[hf].y, c0[hf].z, c0[hf].w};
#pragma unroll
              for (int i = 0; i < 8; ++i) { const bool hi = i & 1; const int k = i >> 1;
                  const float g = hi ? bfhi(wg[k]) : bflo(wg[k]), u2 = hi ? bfhi(w2_[k]) : bflo(w2_[k]), u1 = (hi ? bfhi(w1_[k]) : bflo(w1_[k])) * f1, u0 = (hi ? bfhi(w0_[k]) : bflo(w0_[k])) * f0;
                  const float zz = g * (w0[8 * hf + i] * u0 + w1[8 * hf + i] * u1 + w2[8 * hf + i] * u2); z[8 * hf + i] = zz; am = __builtin_fmaxf(am, __builtin_fabsf(zz)); } }
#pragma unroll
          for (int o = 1; o < 64; o <<= 1) am = __builtin_fmaxf(am, shx(c.lane, am, o));
          const float k = am > 0.f ? 127.0f / am : 0.f;
          v4u q; q.x = q4_i8((f32x4){z[0], z[1], z[2], z[3]}, k); q.y = q4_i8((f32x4){z[4], z[5], z[6], z[7]}, k); q.z = q4_i8((f32x4){z[8], z[9], z[10], z[11]}, k); q.w = q4_i8((f32x4){z[12], z[13], z[14], z[15]}, k);
          *(v4u*)(z8 + (size_t)t * D + dc) = q;
          if (c.lane == 0) sz[t] = am * (1.0f / 127.0f);
      }
#undef CG_LOAD
    }
    for (int t = TP + gw; t < (skip_samp ? TP : T); t += NGW) {
        const bool samp = true; const int s = (t - TP) & 15; const int b = (t - TP) >> 4;
        float z[16]; float am = 0.f;
#pragma unroll
        for (int hf = 0; hf < 2; ++hf) { const int d0 = dc + 8 * hf;
            float u0[8], u1[8], u2[8], g[8];
            ld8_bf16(U + (size_t)t * D + d0, u2);
            { float* cdst = nullptr;
              (void)convp;
              if (samp && s >= DSEQ - 2) cdst = convs + ((size_t)b * 2 + (s - (DSEQ - 2))) * D + d0;
              if (cdst) { *(f32x4*)cdst = (f32x4){u2[0], u2[1], u2[2], u2[3]}; *(f32x4*)(cdst + 4) = (f32x4){u2[4], u2[5], u2[6], u2[7]}; } }
            if (s >= 1) ld8_bf16(U + (size_t)(t - 1) * D + d0, u1);
            else if (samp) ld8_f32(st + ((size_t)b * 2 + 1) * D + d0, u1);
            else {
#pragma unroll
                for (int i = 0; i < 8; ++i) u1[i] = 0.f; }
            if (s >= 2) ld8_bf16(U + (size_t)(t - 2) * D + d0, u0);
            else if (samp) ld8_f32(st + ((size_t)b * 2 + (s == 1 ? 1 : 0)) * D + d0, u0);
            else {
#pragma unroll
                for (int i = 0; i < 8; ++i) u0[i] = 0.f; }
            ld8_bf16(Bg + (size_t)t * D + d0, g);
#pragma unroll
            for (int i = 0; i < 8; ++i) { const float zz = g[i] * (w0[8 * hf + i] * u0[i] + w1[8 * hf + i] * u1[i] + w2[8 * hf + i] * u2[i]); z[8 * hf + i] = zz; am = __builtin_fmaxf(am, __builtin_fabsf(zz)); }
        }
        if (samp) {
            v4u o0, o1; o0.x = pk2(z[0], z[1]); o0.y = pk2(z[2], z[3]); o0.z = pk2(z[4], z[5]); o0.w = pk2(z[6], z[7]); o1.x = pk2(z[8], z[9]); o1.y = pk2(z[10], z[11]); o1.z = pk2(z[12], z[13]); o1.w = pk2(z[14], z[15]);
            *(v4u*)(Bg + (size_t)t * D + dc) = o0; *(v4u*)(Bg + (size_t)t * D + dc + 8) = o1; }
#pragma unroll
        for (int o = 1; o < 64; o <<= 1) am = __builtin_fmaxf(am, shx(c.lane, am, o));
        const float k = am > 0.f ? 127.0f / am : 0.f;
        v4u q; q.x = q4_i8((f32x4){z[0], z[1], z[2], z[3]}, k); q.y = q4_i8((f32x4){z[4], z[5], z[6], z[7]}, k); q.z = q4_i8((f32x4){z[8], z[9], z[10], z[11]}, k); q.w = q4_i8((f32x4){z[12], z[13], z[14], z[15]}, k);
        *(v4u*)(z8 + (size_t)t * D + dc) = q;
        if (c.lane == 0) sz[t] = am * (1.0f / 127.0f);
    }
}

DI void ln_phase(const Ctx c, const bf16* R, bf16* H, const float* g, const float* bb, float* yout = nullptr, const bf16* Hres = nullptr, unsigned char* x8 = nullptr, float* sx = nullptr) {
    const int gw = c.vcu * 8 + c.wave, NGW = c.G * 8;
    float gv[2][8], bv[2][8];
#pragma unroll
    for (int j = 0; j < 2; ++j) { ld8_f32(g + 8 * c.lane + 512 * j, gv[j]); ld8_f32(bb + 8 * c.lane + 512 * j, bv[j]); }
    v4u rw[2], hw[2];
#pragma unroll
    for (int j = 0; j < 2; ++j) { const int m0 = gw < T ? gw : 0; rw[j] = *(const v4u*)(R + (size_t)m0 * D + 8 * c.lane + 512 * j); hw[j] = Hres ? *(const v4u*)(Hres + (size_t)m0 * D + 8 * c.lane + 512 * j) : (v4u){0u, 0u, 0u, 0u}; }
    for (int m = gw; m < T; m += NGW) {
        float v[2][8]; float s = 0.f;
#pragma unroll
        for (int j = 0; j < 2; ++j) { const unsigned w[4] = {rw[j].x, rw[j].y, rw[j].z, rw[j].w}, hq[4] = {hw[j].x, hw[j].y, hw[j].z, hw[j].w};
#pragma unroll
            for (int i = 0; i < 4; ++i) { v[j][2 * i] = bflo(w[i]); v[j][2 * i + 1] = bfhi(w[i]); if (Hres) { v[j][2 * i] += bflo(hq[i]) * ALPHA; v[j][2 * i + 1] += bfhi(hq[i]) * ALPHA; } }
#pragma unroll
            for (int i = 0; i < 8; ++i) s += v[j][i]; }
        { const int mn = m + NGW < T ? m + NGW : m;
#pragma unroll
          for (int j = 0; j < 2; ++j) { rw[j] = *(const v4u*)(R + (size_t)mn * D + 8 * c.lane + 512 * j); if (Hres) hw[j] = *(const v4u*)(Hres + (size_t)mn * D + 8 * c.lane + 512 * j); } }
        const float mean = wave_sum(c.lane, s) * (1.f / D); float s2 = 0.f;
#pragma unroll
        for (int j = 0; j < 2; ++j)
#pragma unroll
            for (int i = 0; i < 8; ++i) { v[j][i] -= mean; s2 += v[j][i] * v[j][i]; }
        const float rstd = __builtin_amdgcn_rsqf(wave_sum(c.lane, s2) * (1.f / D) + LN_EPS);
        float am = 0.f;
#pragma unroll
        for (int j = 0; j < 2; ++j)
#pragma unroll
            for (int i = 0; i < 8; ++i) { v[j][i] = v[j][i] * rstd * gv[j][i] + bv[j][i]; am = __builtin_fmaxf(am, __builtin_fabsf(v[j][i])); }
        if (yout) {
#pragma unroll
            for (int j = 0; j < 2; ++j) { float* o = yout + (size_t)m * D + 8 * c.lane + 512 * j; *(f32x4*)o = (f32x4){v[j][0], v[j][1], v[j][2], v[j][3]}; *(f32x4*)(o + 4) = (f32x4){v[j][4], v[j][5], v[j][6], v[j][7]}; }
        } else {
#pragma unroll
            for (int j = 0; j < 2; ++j) { v4u w; w.x = pk2(v[j][0], v[j][1]); w.y = pk2(v[j][2], v[j][3]); w.z = pk2(v[j][4], v[j][5]); w.w = pk2(v[j][6], v[j][7]); *(v4u*)(H + (size_t)m * D + 8 * c.lane + 512 * j) = w; }
            if (x8) {
#pragma unroll
                for (int o = 1; o < 64; o <<= 1) am = __builtin_fmaxf(am, shx(c.lane, am, o));
                const float k = am > 0.f ? 127.0f / am : 0.f;
#pragma unroll
                for (int j = 0; j < 2; ++j) { v2u q; q.x = q4_i8((f32x4){v[j][0], v[j][1], v[j][2], v[j][3]}, k); q.y = q4_i8((f32x4){v[j][4], v[j][5], v[j][6], v[j][7]}, k); *(v2u*)(x8 + (size_t)m * D + 8 * c.lane + 512 * j) = q; }
                if (c.lane == 0) sx[m] = am * (1.0f / 127.0f);
            } }
    }
}

DI int ordi(float x) { const int b = __float_as_int(x); return b ^ ((b >> 31) & 0x7fffffff); }
DI float unordi(int o) { return __int_as_float(o ^ ((o >> 31) & 0x7fffffff)); }
#define TK_CE(a, b) do { const int _hi = (a) > (b) ? (a) : (b), _lo = (a) > (b) ? (b) : (a); (a) = _hi; (b) = _lo; } while (0)
#define TK_CPK(i, j) ((ordi(va[i] + vb[j]) & ~255) | (255 - ((i) * 16 + (j))))
#define TK_SORT16(v) do { TK_CE(v[0], v[1]); TK_CE(v[2], v[3]); TK_CE(v[0], v[2]); TK_CE(v[1], v[3]); TK_CE(v[1], v[2]); TK_CE(v[4], v[5]); TK_CE(v[6], v[7]); TK_CE(v[4], v[6]); TK_CE(v[5], v[7]); TK_CE(v[5], v[6]); TK_CE(v[0], v[4]); TK_CE(v[2], v[6]); TK_CE(v[2], v[4]); TK_CE(v[1], v[5]); TK_CE(v[3], v[7]); TK_CE(v[3], v[5]); TK_CE(v[1], v[2]); TK_CE(v[3], v[4]); TK_CE(v[5], v[6]); TK_CE(v[8], v[9]); TK_CE(v[10], v[11]); TK_CE(v[8], v[10]); TK_CE(v[9], v[11]); TK_CE(v[9], v[10]); TK_CE(v[12], v[13]); TK_CE(v[14], v[15]); TK_CE(v[12], v[14]); TK_CE(v[13], v[15]); TK_CE(v[13], v[14]); TK_CE(v[8], v[12]); TK_CE(v[10], v[14]); TK_CE(v[10], v[12]); TK_CE(v[9], v[13]); TK_CE(v[11], v[15]); TK_CE(v[11], v[13]); TK_CE(v[9], v[10]); TK_CE(v[11], v[12]); TK_CE(v[13], v[14]); TK_CE(v[0], v[8]); TK_CE(v[4], v[12]); TK_CE(v[4], v[8]); TK_CE(v[2], v[10]); TK_CE(v[6], v[14]); TK_CE(v[6], v[10]); TK_CE(v[2], v[4]); TK_CE(v[6], v[8]); TK_CE(v[10], v[12]); TK_CE(v[1], v[9]); TK_CE(v[5], v[13]); TK_CE(v[5], v[9]); TK_CE(v[3], v[11]); TK_CE(v[7], v[15]); TK_CE(v[7], v[11]); TK_CE(v[3], v[5]); TK_CE(v[7], v[9]); TK_CE(v[11], v[13]); TK_CE(v[1], v[2]); TK_CE(v[3], v[4]); TK_CE(v[5], v[6]); TK_CE(v[7], v[8]); TK_CE(v[9], v[10]); TK_CE(v[11], v[12]); TK_CE(v[13], v[14]); } while (0)
#define TK_BMERGE16(v) do { TK_CE(v[0], v[8]); TK_CE(v[1], v[9]); TK_CE(v[2], v[10]); TK_CE(v[3], v[11]); TK_CE(v[4], v[12]); TK_CE(v[5], v[13]); TK_CE(v[6], v[14]); TK_CE(v[7], v[15]); TK_CE(v[0], v[4]); TK_CE(v[1], v[5]); TK_CE(v[2], v[6]); TK_CE(v[3], v[7]); TK_CE(v[8], v[12]); TK_CE(v[9], v[13]); TK_CE(v[10], v[14]); TK_CE(v[11], v[15]); TK_CE(v[0], v[2]); TK_CE(v[1], v[3]); TK_CE(v[4], v[6]); TK_CE(v[5], v[7]); TK_CE(v[8], v[10]); TK_CE(v[9], v[11]); TK_CE(v[12], v[14]); TK_CE(v[13], v[15]); TK_CE(v[0], v[1]); TK_CE(v[2], v[3]); TK_CE(v[4], v[5]); TK_CE(v[6], v[7]); TK_CE(v[8], v[9]); TK_CE(v[10], v[11]); TK_CE(v[12], v[13]); TK_CE(v[14], v[15]); } while (0)
#define TK_CAND0(B) do { B[0] = TK_CPK(0, 0); B[1] = TK_CPK(0, 1); B[2] = TK_CPK(0, 2); B[3] = TK_CPK(0, 3); B[4] = TK_CPK(0, 4); B[5] = TK_CPK(0, 5); B[6] = TK_CPK(0, 6); B[7] = TK_CPK(0, 7); B[8] = TK_CPK(0, 8); B[9] = TK_CPK(0, 9); B[10] = TK_CPK(0, 10); B[11] = TK_CPK(0, 11); B[12] = TK_CPK(0, 12); B[13] = TK_CPK(0, 13); B[14] = TK_CPK(0, 14); B[15] = TK_CPK(0, 15); } while (0)
#define TK_CAND1(B) do { B[0] = TK_CPK(1, 0); B[1] = TK_CPK(1, 1); B[2] = TK_CPK(1, 2); B[3] = TK_CPK(1, 3); B[4] = TK_CPK(1, 4); B[5] = TK_CPK(1, 5); B[6] = TK_CPK(1, 6); B[7] = TK_CPK(1, 7); B[8] = TK_CPK(2, 0); B[9] = TK_CPK(2, 1); B[10] = TK_CPK(2, 2); B[11] = TK_CPK(2, 3); B[12] = TK_CPK(2, 4); B[13] = TK_CPK(3, 0); B[14] = TK_CPK(3, 1); B[15] = TK_CPK(3, 2); } while (0)
#define TK_CAND2(B) do { B[0] = TK_CPK(3, 3); B[1] = TK_CPK(4, 0); B[2] = TK_CPK(4, 1); B[3] = TK_CPK(4, 2); B[4] = TK_CPK(5, 0); B[5] = TK_CPK(5, 1); B[6] = TK_CPK(6, 0); B[7] = TK_CPK(6, 1); B[8] = TK_CPK(7, 0); B[9] = TK_CPK(7, 1); B[10] = TK_CPK(8, 0); B[11] = TK_CPK(9, 0); B[12] = TK_CPK(10, 0); B[13] = TK_CPK(11, 0); B[14] = TK_CPK(12, 0); B[15] = TK_CPK(13, 0); } while (0)
#define TK_CAND3(B) do { B[0] = TK_CPK(14, 0); B[1] = TK_CPK(15, 0); B[2] = (int)0x80000000; B[3] = (int)0x80000000; B[4] = (int)0x80000000; B[5] = (int)0x80000000; B[6] = (int)0x80000000; B[7] = (int)0x80000000; B[8] = (int)0x80000000; B[9] = (int)0x80000000; B[10] = (int)0x80000000; B[11] = (int)0x80000000; B[12] = (int)0x80000000; B[13] = (int)0x80000000; B[14] = (int)0x80000000; B[15] = (int)0x80000000; } while (0)
DI void tk_merge(int (&L)[16], const int (&B)[16]) {
#pragma unroll
    for (int i = 0; i < 16; ++i) L[i] = L[i] > B[15 - i] ? L[i] : B[15 - i];
    TK_BMERGE16(L);
}
DI void tk_feed32(int (&L)[16], const v4u (&x)[4], const int rb) {
#pragma unroll
    for (int hf = 0; hf < 2; ++hf) { int B[16]; const unsigned w[8] = {x[2 * hf].x, x[2 * hf].y, x[2 * hf].z, x[2 * hf].w, x[2 * hf + 1].x, x[2 * hf + 1].y, x[2 * hf + 1].z, x[2 * hf + 1].w};
#pragma unroll
        for (int j = 0; j < 16; ++j) B[j] = (ordi(__uint_as_float((j & 1) ? (w[j >> 1] & 0xffff0000u) : (w[j >> 1] << 16))) & ~127) | (127 - ((rb + 16 * hf + j) & 127));
        TK_SORT16(B); tk_merge(L, B); }
}
DI unsigned byte_of(unsigned a0, unsigned a1, unsigned a2, unsigned a3, int i) { const unsigned lo = i < 4 ? a0 : a1, hi = i < 12 ? a2 : a3, w = i < 8 ? lo : hi; return (w >> ((i & 3) * 8)) & 0xffu; }
DI void topk_phase(const Ctx c, const bf16* Sc  , unsigned short* ids, float* gates) {
    const int gw = c.wave * c.G + c.vcu, NGW = c.G * 8, NU = 8 * (T / 64);
    v4u bufA[4], bufB[4];
    if (gw < NU) { const v4u* sc = (const v4u*)(Sc + (size_t)((gw % (T / 64)) * 64 + c.lane) * 2048 + (gw / (T / 64)) * 256);
#pragma unroll
        for (int j = 0; j < 4; ++j) bufA[j] = sc[j]; }
#pragma unroll 1
    for (int wu = gw; wu < NU; wu += NGW) {
        const int h = wu / (T / 64), t = (wu % (T / 64)) * 64 + c.lane;
        const v4u* sc = (const v4u*)(Sc + (size_t)t * 2048 + h * 256);
        const int wn = wu + NGW < NU ? wu + NGW : wu;
        const v4u* scn = (const v4u*)(Sc + (size_t)((wn % (T / 64)) * 64 + c.lane) * 2048 + (wn / (T / 64)) * 256);
        int Lw[16], La[16];
#pragma unroll
        for (int i = 0; i < 16; ++i) { Lw[i] = (int)0x80000000; La[i] = 0; }
#pragma unroll 1
        for (int it = 0; it < 4; ++it) {
#pragma unroll
            for (int j = 0; j < 4; ++j) bufB[j] = sc[8 * it + 4 + j];
            tk_feed32(Lw, bufA, 64 * it);
            { const v4u* nx = it < 3 ? sc + 8 * (it + 1) : scn;
#pragma unroll
              for (int j = 0; j < 4; ++j) bufA[j] = nx[j]; }
            tk_feed32(Lw, bufB, 64 * it + 32);
            if (it == 1) {
#pragma unroll
                for (int i = 0; i < 16; ++i) { La[i] = Lw[i]; Lw[i] = (int)0x80000000; } }
        }
        float va[16], vb[16]; unsigned IA0 = 0u, IA1 = 0u, IA2 = 0u, IA3 = 0u, IB0 = 0u, IB1 = 0u, IB2 = 0u, IB3 = 0u;
#pragma unroll
        for (int i = 0; i < 16; ++i) { va[i] = unordi(La[i] & ~127); vb[i] = unordi(Lw[i] & ~127);
            const unsigned ea = (unsigned)(127 - (La[i] & 127)) << ((i & 3) * 8), eb = (unsigned)(127 - (Lw[i] & 127)) << ((i & 3) * 8);
            if ((i >> 2) == 0) { IA0 |= ea; IB0 |= eb; } else if ((i >> 2) == 1) { IA1 |= ea; IB1 |= eb; } else if ((i >> 2) == 2) { IA2 |= ea; IB2 |= eb; } else { IA3 |= ea; IB3 |= eb; } }
        int F[16];
        { int B[16]; TK_CAND0(B); TK_SORT16(B);
#pragma unroll
          for (int i = 0; i < 16; ++i) F[i] = B[i]; }
        { int B[16]; TK_CAND1(B); TK_SORT16(B); tk_merge(F, B); }
        { int B[16]; TK_CAND2(B); TK_SORT16(B); tk_merge(F, B); }
        { int B[16]; TK_CAND3(B); TK_SORT16(B); tk_merge(F, B); }
        float sc_[16], den = 0.f; unsigned ex[16];
        const float mx = unordi(F[0] & ~255);
#pragma unroll
        for (int k = 0; k < 16; ++k) { const int code = 255 - (F[k] & 255); sc_[k] = __builtin_amdgcn_exp2f((unordi(F[k] & ~255) - mx) * LOG2E); den += sc_[k];
            ex[k] = byte_of(IA0, IA1, IA2, IA3, code >> 4) * 128u + byte_of(IB0, IB1, IB2, IB3, code & 15); }
        const float inv = 1.0f / den;
        v4u e0, e1; e0.x = ex[0] | (ex[1] << 16); e0.y = ex[2] | (ex[3] << 16); e0.z = ex[4] | (ex[5] << 16); e0.w = ex[6] | (ex[7] << 16);
        e1.x = ex[8] | (ex[9] << 16); e1.y = ex[10] | (ex[11] << 16); e1.z = ex[12] | (ex[13] << 16); e1.w = ex[14] | (ex[15] << 16);
        v4u* ip = (v4u*)(ids + (size_t)t * 128 + h * 16); ip[0] = e0; ip[1] = e1;
        f32x4* gp = (f32x4*)(gates + (size_t)t * 128 + h * 16);
#pragma unroll
        for (int k = 0; k < 4; ++k) gp[k] = (f32x4){sc_[4 * k] * inv, sc_[4 * k + 1] * inv, sc_[4 * k + 2] * inv, sc_[4 * k + 3] * inv};
    }
}

typedef float f2 __attribute__((ext_vector_type(2)));
constexpr int QCH = 16, QN = T / QCH;
static_assert(T % QCH == 0, "queue chunks");
struct ChunkQ { int xme, s; unsigned pend; unsigned* q; };
struct Chunk { int base, xs; };
DI unsigned cq_ticket(unsigned* qw, int lane) { unsigned v = 0u; if (lane == 0) v = __hip_atomic_fetch_add(qw, 1u, __ATOMIC_RELAXED, __HIP_MEMORY_SCOPE_AGENT); return v; }
DI void cq_init(ChunkQ& g, unsigned* q, int lane) { g.xme = (int)(xb_xcc_id() & 7u); g.s = 0; g.q = q; g.pend = cq_ticket(q + g.xme * 64, lane); }
DI Chunk cq_next(ChunkQ& g, int lane) {
    for (;;) {
        if (g.s >= 8) return Chunk{-1, 0};
        const unsigned chunk = (unsigned)__builtin_amdgcn_readfirstlane((int)g.pend); const int xs = (g.xme + g.s) & 7;
        if (chunk < (unsigned)QN) { g.pend = cq_ticket(g.q + xs * 64, lane); return Chunk{(int)chunk * QCH, xs}; }
        ++g.s; if (g.s < 8) g.pend = cq_ticket(g.q + ((g.xme + g.s) & 7) * 64, lane);
    }
}
struct SliceIds { v4u ia, ib; int t, xs; };
struct SliceAux { v4u a0; float s; };
DI SliceIds slice_load_ids(const int t, const int xs, const int lane, const unsigned short* ids) {
    const int j = lane >> 3, tc = t < 0 ? 0 : t; SliceIds r; r.t = t; r.xs = xs;
    r.ia = *(const v4u*)(ids + (size_t)tc * 128 + 16 * j); r.ib = *(const v4u*)(ids + (size_t)tc * 128 + 16 * j + 8); return r;
}
template <int MODE>
DI SliceAux slice_load_aux(const int t, const int xs, const int lane, const unsigned char* x8, const unsigned char* w8, const float* sw) {
    const int j = lane >> 3, i = lane & 7, tc = t < 0 ? 0 : t; SliceAux r;
    if (MODE == 0) { r.a0 = *(const v4u*)(x8 + (size_t)tc * D + 128 * xs + 16 * i); r.s = 0.f; }
    else { r.a0 = *(const v4u*)(w8 + (size_t)tc * 128 + 16 * j); r.s = sw[tc]; }
    return r;
}
template <int VAR>
DI void slice_issue(v4u (&vr)[16], const SliceIds& n, const unsigned char* T8, const int lane) {
    const unsigned char* base = T8 + (size_t)n.xs * NEXP * 128 + 16 * (lane & 7);
    const unsigned idv[8] = {n.ia.x, n.ia.y, n.ia.z, n.ia.w, n.ib.x, n.ib.y, n.ib.z, n.ib.w};
#pragma unroll
    for (int g = 0; g < 16; ++g) { unsigned e = (g & 1) ? (idv[g >> 1] >> 16) : (idv[g >> 1] & 0xffffu); if (VAR == 2) e &= 15u; vr[g] = *(const v4u*)(base + (size_t)e * 128); }
}
DI int dot16_i8(const v4u a, const v4u b, int acc) {
    acc = __builtin_amdgcn_sdot4((int)a.x, (int)b.x, acc, false); acc = __builtin_amdgcn_sdot4((int)a.y, (int)b.y, acc, false);
    acc = __builtin_amdgcn_sdot4((int)a.z, (int)b.z, acc, false); acc = __builtin_amdgcn_sdot4((int)a.w, (int)b.w, acc, false); return acc;
}
DI void tr4_dot(int& c0, int& c1, int& c2, int& c3, const unsigned a, const unsigned b, const unsigned cc, const unsigned d, const int w) {
    const unsigned p = __builtin_amdgcn_perm(b, a, 0x05010400u), q = __builtin_amdgcn_perm(b, a, 0x07030602u), r = __builtin_amdgcn_perm(d, cc, 0x05010400u), s = __builtin_amdgcn_perm(d, cc, 0x07030602u);
    c0 = __builtin_amdgcn_sdot4((int)__builtin_amdgcn_perm(r, p, 0x05040100u), w, c0, false); c1 = __builtin_amdgcn_sdot4((int)__builtin_amdgcn_perm(r, p, 0x07060302u), w, c1, false);
    c2 = __builtin_amdgcn_sdot4((int)__builtin_amdgcn_perm(s, q, 0x05040100u), w, c2, false); c3 = __builtin_amdgcn_sdot4((int)__builtin_amdgcn_perm(s, q, 0x07060302u), w, c3, false);
}
template <int MODE, int VAR>
DI void slice_compute(const int lane, const v4u (&vr)[16], const int t, const int xs, const SliceAux& n, float* OUT) {
    const int j = lane >> 3, i = lane & 7;
    if (VAR == 1) {
        unsigned x = n.a0.x ^ n.a0.y;
#pragma unroll
        for (int g = 0; g < 16; ++g) x ^= vr[g].x ^ vr[g].y ^ vr[g].z ^ vr[g].w;
        *(unsigned*)((bf16*)OUT + (size_t)t * D + 128 * xs + 2 * lane) = x;
    } else if (MODE == 0) {
        int d[16];
#pragma unroll
        for (int g = 0; g < 16; ++g) d[g] = dot16_i8(vr[g], n.a0, 0);
        int r8[8], r4[4], r2[2];
#pragma unroll
        for (int q = 0; q < 8; ++q) { const bool od = lane & 1; const int keep = od ? d[8 + q] : d[q], send = od ? d[q] : d[8 + q]; r8[q] = keep + shx(lane, send, 1); }
#pragma unroll
        for (int q = 0; q < 4; ++q) { const bool od = lane & 2; const int keep = od ? r8[4 + q] : r8[q], send = od ? r8[q] : r8[4 + q]; r4[q] = keep + shx(lane, send, 2); }
#pragma unroll
        for (int q = 0; q < 2; ++q) { const bool od = lane & 4; const int keep = od ? r4[2 + q] : r4[q], send = od ? r4[q] : r4[2 + q]; r2[q] = keep + shx(lane, send, 4); }
        const int g0 = 8 * (i & 1) + 4 * ((i >> 1) & 1) + 2 * (i >> 2);
        *((unsigned*)OUT + ((size_t)xs * T + t) * 64 + 8 * j + (g0 >> 1)) = ((unsigned)((r2[0] + 32) >> 6) & 0xffffu) | ((unsigned)((r2[1] + 32) >> 6) << 16);
    } else {
        int acc[16];
#pragma unroll
        for (int q = 0; q < 16; ++q) acc[q] = 0;
        const int w4[4] = {(int)n.a0.x, (int)n.a0.y, (int)n.a0.z, (int)n.a0.w};
#pragma unroll
        for (int gq = 0; gq < 4; ++gq) {
            tr4_dot(acc[0], acc[1], acc[2], acc[3], vr[4 * gq].x, vr[4 * gq + 1].x, vr[4 * gq + 2].x, vr[4 * gq + 3].x, w4[gq]);
            tr4_dot(acc[4], acc[5], acc[6], acc[7], vr[4 * gq].y, vr[4 * gq + 1].y, vr[4 * gq + 2].y, vr[4 * gq + 3].y, w4[gq]);
            tr4_dot(acc[8], acc[9], acc[10], acc[11], vr[4 * gq].z, vr[4 * gq + 1].z, vr[4 * gq + 2].z, vr[4 * gq + 3].z, w4[gq]);
            tr4_dot(acc[12], acc[13], acc[14], acc[15], vr[4 * gq].w, vr[4 * gq + 1].w, vr[4 * gq + 2].w, vr[4 * gq + 3].w, w4[gq]);
        }
        int r8[8], r4[4], r2[2];
#pragma unroll
        for (int q = 0; q < 8; ++q) { const bool od = lane & 8; const int keep = od ? acc[8 + q] : acc[q], send = od ? acc[q] : acc[8 + q]; r8[q] = keep + shx(lane, send, 8); }
#pragma unroll
        for (int q = 0; q < 4; ++q) { const bool od = lane & 16; const int keep = od ? r8[4 + q] : r8[q], send = od ? r8[q] : r8[4 + q]; r4[q] = keep + shx(lane, send, 16); }
#pragma unroll
        for (int q = 0; q < 2; ++q) { const bool od = lane & 32; const int keep = od ? r4[2 + q] : r4[q], send = od ? r4[q] : r4[2 + q]; r2[q] = keep + shx(lane, send, 32); }
        const int dim = 128 * xs + 16 * i + 8 * (j & 1) + 4 * ((j >> 1) & 1) + 2 * (j >> 2);
        const float s = n.s;
        *(unsigned*)((bf16*)OUT + (size_t)t * D + dim) = pk2((float)r2[0] * s, (float)r2[1] * s);
    }
}
template <int MODE, int VAR = 0>
DI void slice_pass(const Ctx c, const unsigned char* x8, const unsigned short* ids, const unsigned char* w8, const float* sw, const unsigned char* T8, float* OUT, unsigned* q) {
    ChunkQ g; cq_init(g, q, c.lane);
    Chunk cur = cq_next(g, c.lane); if (cur.base < 0) return;
    Chunk nxt = cq_next(g, c.lane);
#define SLICE_TOK_T(p) ((p) < QCH ? cur.base + (p) : (nxt.base >= 0 ? nxt.base + (p) - QCH : -1))
#define SLICE_TOK_X(p) ((p) < QCH ? cur.xs : nxt.xs)
    SliceIds i0 = slice_load_ids(SLICE_TOK_T(0), SLICE_TOK_X(0), c.lane, ids), i1 = slice_load_ids(SLICE_TOK_T(1), SLICE_TOK_X(1), c.lane, ids),
             i2 = slice_load_ids(SLICE_TOK_T(2), SLICE_TOK_X(2), c.lane, ids), i3 = slice_load_ids(SLICE_TOK_T(3), SLICE_TOK_X(3), c.lane, ids);
    SliceAux x0 = slice_load_aux<MODE>(i0.t, i0.xs, c.lane, x8, w8, sw), x1 = slice_load_aux<MODE>(i1.t, i1.xs, c.lane, x8, w8, sw);
    v4u A[16], B[16];
    slice_issue<VAR>(A, i0, T8, c.lane);
#define SLICE_STEP(K, CUR, NXT, IK, IK1, XK) do { slice_issue<VAR>(NXT, IK1, T8, c.lane); \
        slice_compute<MODE, VAR>(c.lane, CUR, IK.t, IK.xs, XK, OUT); \
        XK = slice_load_aux<MODE>(SLICE_TOK_T(pg + (K) + 2), SLICE_TOK_X(pg + (K) + 2), c.lane, x8, w8, sw); \
        IK = slice_load_ids(SLICE_TOK_T(pg + (K) + 4), SLICE_TOK_X(pg + (K) + 4), c.lane, ids); } while (0)
    for (;;) {
#pragma unroll 2
        for (int pg = 0; pg < QCH; pg += 4) {
            SLICE_STEP(0, A, B, i0, i1, x0);
            SLICE_STEP(1, B, A, i1, i2, x1);
            SLICE_STEP(2, A, B, i2, i3, x0);
            SLICE_STEP(3, B, A, i3, i0, x1);
        }
        cur = nxt; if (cur.base < 0) break;
        nxt = cq_next(g, c.lane);
    }
#undef SLICE_STEP
#undef SLICE_TOK_T
#undef SLICE_TOK_X
}
struct WpA { f32x4 s; v2u iw; f32x4 g; float st; };
struct WpB { f32x4 su, sv; };
DI WpA wp_load_a(const size_t idx, const float* part, const unsigned short* ids, const float* gates, const float* sx) {
    WpA a; v2u p[8];
#pragma unroll
    for (int x = 0; x < 8; ++x) p[x] = *(const v2u*)((const unsigned short*)part + (size_t)x * T * 128 + idx * 4);
    a.iw = *(const v2u*)(ids + idx * 4); a.g = *(const f32x4*)(gates + idx * 4); a.st = sx[idx >> 5] * 64.0f;
    int s0 = 0, s1 = 0, s2 = 0, s3 = 0;
#pragma unroll
    for (int x = 0; x < 8; ++x) { s0 += (int)(short)(p[x].x & 0xffffu); s1 += (int)p[x].x >> 16; s2 += (int)(short)(p[x].y & 0xffffu); s3 += (int)p[x].y >> 16; }
    a.s = (f32x4){(float)s0, (float)s1, (float)s2, (float)s3}; return a;
}
DI WpB wp_load_b(const WpA& a, const float* SU, const float* SV) {
    const unsigned e[4] = {a.iw.x & 0xffffu, a.iw.x >> 16, a.iw.y & 0xffffu, a.iw.y >> 16}; WpB b;
#pragma unroll
    for (int k = 0; k < 4; ++k) { const f2 p = *(const f2*)(SU + 2 * e[k]); b.su[k] = p.x; b.sv[k] = p.y; }
    (void)SV;
    return b;
}
DI void peer_w_phase(const Ctx c, const float* part, const unsigned short* ids, const float* gates, unsigned char* w8, float* sw, const float* sx, const float* SU, const float* SV) {
    const size_t NT = (size_t)c.G * 512, NI = (size_t)T * 32, i0 = (size_t)c.vcu * 512 + c.tid;
    WpA a0 = wp_load_a(i0 < NI ? i0 : 0, part, ids, gates, sx), a1 = wp_load_a(i0 + NT < NI ? i0 + NT : 0, part, ids, gates, sx);
    WpB b0 = wp_load_b(a0, SU, SV);
    for (size_t idx = i0; idx < NI; idx += NT) {
        const WpA a2 = wp_load_a(idx + 2 * NT < NI ? idx + 2 * NT : 0, part, ids, gates, sx);
        const WpB b1 = wp_load_b(a1, SU, SV);
        f32x4 g = a0.g; float am = 0.f;
#pragma unroll
        for (int k = 0; k < 4; ++k) { g[k] = g[k] * gelu_erf(a0.s[k] * (a0.st * b0.su[k])) * b0.sv[k]; am = __builtin_fmaxf(am, __builtin_fabsf(g[k])); }
#pragma unroll
        for (int o = 1; o < 32; o <<= 1) am = __builtin_fmaxf(am, shx(c.lane, am, o));
        *(unsigned*)(w8 + idx * 4) = q4_i8(g, am > 0.f ? 127.0f / am : 0.f);
        if ((c.tid & 31) == 0) sw[idx >> 5] = am * (1.0f / 127.0f);
        a0 = a1; a1 = a2; b0 = b1;
    }
}

DI int pi_row(int m) { return 16 * (m >> 4) + 8 * ((m >> 2) & 1) + 4 * ((m >> 3) & 1) + (m & 3); }
struct AttnT { const bf16* Q; bf16* O; const bf16* Kb; const bf16* VT; const bf16* Vsn; const float* ck; const float* cv; };
template <int MODE>
DI void attn_load(const AttnT A, const int b, const int h, const int kt, const int q, const int hh, const int piq, bf16x8 (&kf)[4], bf16x8 (&vf)[2][2]) {
    if (MODE == 0) {
        const bf16* kr = A.Kb + ((size_t)b * SEQ + kt * 32 + piq) * D + h * DH + 8 * hh;
#pragma unroll
        for (int s = 0; s < 4; ++s) kf[s] = *(const bf16x8*)(kr + 16 * s);
        const bf16* vr = A.VT + (((size_t)b * NH + h) * (SEQ / 32) + kt) * (DH * 32) + q * 32 + 8 * hh;
#pragma unroll
        for (int mt = 0; mt < 2; ++mt)
#pragma unroll
            for (int s = 0; s < 2; ++s) vf[mt][s] = *(const bf16x8*)(vr + mt * 32 * 32 + 16 * s);
    } else if (kt == PAST / 32) {
        const int ko = piq < 16 ? piq : 15;
        const bf16* kr = A.Kb + ((size_t)TP + b * DSEQ + ko) * D + h * DH + 8 * hh;
#pragma unroll
        for (int s = 0; s < 4; ++s) kf[s] = *(const bf16x8*)(kr + 16 * s);
#pragma unroll
        for (int mt = 0; mt < 2; ++mt)
#pragma unroll
            for (int s = 0; s < 2; ++s) { bf16x8 v;
#pragma unroll
                for (int j = 0; j < 8; ++j) { const int kk = 16 * s + 8 * hh + j; v[j] = (short)A.Vsn[((size_t)b * DSEQ + (kk < 16 ? kk : 15)) * D + h * DH + 32 * mt + q]; }
                vf[mt][s] = v; }
    } else {
        const float* kr = A.ck + (((size_t)b * PAST + kt * 32 + piq) * NH + h) * DH + 8 * hh;
#pragma unroll
        for (int s = 0; s < 4; ++s) { const f32x4 x0 = *(const f32x4*)(kr + 16 * s), x1 = *(const f32x4*)(kr + 16 * s + 4); kf[s] = pack8(x0[0], x0[1], x0[2], x0[3], x1[0], x1[1], x1[2], x1[3]); }
#pragma unroll
        for (int mt = 0; mt < 2; ++mt)
#pragma unroll
            for (int s = 0; s < 2; ++s) { float x[8];
#pragma unroll
                for (int j = 0; j < 8; ++j) x[j] = A.cv[(((size_t)b * PAST + kt * 32 + 16 * s + 8 * hh + j) * NH + h) * DH + 32 * mt + q];
                vf[mt][s] = pack8(x[0], x[1], x[2], x[3], x[4], x[5], x[6], x[7]); }
    }
}
template <int MODE>
DI void attn_qtile(const AttnT A, int b, int h, int qi, int lane, const bf16x8 (&ut)[2]) {
    const int q = lane & 31, hh = lane >> 5, piq = pi_row(q);
    const size_t qrow = MODE == 0 ? (size_t)b * SEQ + qi * 32 + q : (size_t)TP + b * DSEQ + (q < 16 ? q : 15);
    const int qpos = MODE == 0 ? qi * 32 + q : (q < 16 ? PAST + q : 0);
    bf16x8 qf[4];
#pragma unroll
    for (int s = 0; s < 4; ++s) qf[s] = *(const bf16x8*)(A.Q + qrow * D + h * DH + 16 * s + 8 * hh);
    f32x16 o0, o1;
#pragma unroll
    for (int i = 0; i < 16; ++i) { o0[i] = 0.f; o1[i] = 0.f; }
    float carry = 0.f;
    const int kt0 = MODE == 0 ? qi : PAST / 32;
    bf16x8 kf[4], vf[2][2];
    attn_load<MODE>(A, b, h, kt0, q, hh, piq, kf, vf);
    for (int kt = kt0; kt >= 0; --kt) {
        bf16x8 kn[4], vn[2][2];
        attn_load<MODE>(A, b, h, kt > 0 ? kt - 1 : 0, q, hh, piq, kn, vn);
        f32x16 S;
#pragma unroll
        for (int i = 0; i < 16; ++i) S[i] = 0.f;
#pragma unroll
        for (int s = 0; s < 4; ++s) S = MFMA32(kf[s], qf[s], S);
        const int kbase = kt * 32 + 8 * hh;
        float L[16], lw[16];
#pragma unroll
        for (int r = 0; r < 16; ++r) {
            const bool valid = (kbase + 16 * (r >> 3) + (r & 7)) < qpos;
            const float z = S[r], sp = __builtin_fmaxf(z, 0.f) + __builtin_amdgcn_logf(1.0f + __builtin_amdgcn_exp2f(-__builtin_fabsf(z)));
            L[r] = valid ? -sp : 0.f; lw[r] = valid ? (z - sp) : -1e30f;
        }
        f32x16 suf;
#pragma unroll
        for (int i = 0; i < 16; ++i) suf[i] = 0.f;
        suf = MFMA32(ut[0], pack8(L[0], L[1], L[2], L[3], L[4], L[5], L[6], L[7]), suf);
        suf = MFMA32(ut[1], pack8(L[8], L[9], L[10], L[11], L[12], L[13], L[14], L[15]), suf);
        float a[16];
#pragma unroll
        for (int r = 0; r < 16; ++r) a[r] = __builtin_amdgcn_exp2f(lw[r] + suf[r] + carry);
        carry += __int_as_float(__builtin_amdgcn_ds_bpermute(q << 2, __float_as_int(suf[0] + L[0])));
        const bf16x8 p0 = pack8(a[0], a[1], a[2], a[3], a[4], a[5], a[6], a[7]), p1 = pack8(a[8], a[9], a[10], a[11], a[12], a[13], a[14], a[15]);
        o0 = MFMA32(vf[0][0], p0, o0); o0 = MFMA32(vf[0][1], p1, o0);
        o1 = MFMA32(vf[1][0], p0, o1); o1 = MFMA32(vf[1][1], p1, o1);
        if (__builtin_amdgcn_ballot_w64(qpos > 0 && carry > -24.0f * LOG2E) == 0ull) break;
#pragma unroll
        for (int s = 0; s < 4; ++s) kf[s] = kn[s];
#pragma unroll
        for (int mt = 0; mt < 2; ++mt)
#pragma unroll
            for (int s = 0; s < 2; ++s) vf[mt][s] = vn[mt][s];
    }
    if (MODE == 0 || q < 16) {
        bf16* orow = A.O + qrow * D + h * DH + 4 * hh;
#pragma unroll
        for (int g = 0; g < 4; ++g) {
            v2u w0, w1; w0.x = pk2(o0[4 * g], o0[4 * g + 1]); w0.y = pk2(o0[4 * g + 2], o0[4 * g + 3]); w1.x = pk2(o1[4 * g], o1[4 * g + 1]); w1.y = pk2(o1[4 * g + 2], o1[4 * g + 3]);
            *(v2u*)(orow + 8 * g) = w0; *(v2u*)(orow + 32 + 8 * g) = w1; }
    }
}
DI void attn_phase(const Ctx c, const AttnT A) {
    const int q = c.lane & 31, hh = c.lane >> 5, piq = pi_row(q);
    bf16x8 ut[2];
#pragma unroll
    for (int s = 0; s < 2; ++s)
#pragma unroll
        for (int j = 0; j < 8; ++j) ut[s][j] = (16 * s + 8 * hh + j > piq) ? (short)0x3f80 : (short)0;
    for (int bu = c.vcu; bu < NB * NH * 4; bu += c.G) {
        const int bh = bu >> 2, b = bh >> 4, h = bh & 15, p = (bu & 3) * 8 + c.wave;
        attn_qtile<0>(A, b, h, 63 - p, c.lane, ut);
        attn_qtile<0>(A, b, h, p, c.lane, ut);
    }
    for (int su = c.wave * c.G + c.vcu; su < NB * NH; su += c.G * 8) attn_qtile<1>(A, su >> 4, su & 15, 0, c.lane, ut);
}

DI void vt_phase(const Ctx c, LAS unsigned char* lds, const bf16* Vb, bf16* VT, bf16* Vsn) {
    LAS unsigned char* scr = lds + c.wave * 16384;
    const int gw = c.vcu * 8 + c.wave, NGW = c.G * 8;
    for (int wt = gw; wt < (TP / 64) * 16; wt += NGW) {
        const int tt = wt >> 4, ht = wt & 15;
#pragma unroll
        for (int j = 0; j < 8; ++j) { const int row = (c.lane >> 3) + 8 * j, ch = c.lane & 7;
            const v4u v = *(const v4u*)(Vb + (size_t)(tt * 64 + row) * D + ht * 64 + ch * 8);
            LAS unsigned* d = (LAS unsigned*)(scr + row * 132 + ch * 16); d[0] = v.x; d[1] = v.y; d[2] = v.z; d[3] = v.w; }
        LDS_WAIT(); asm volatile("" ::: "memory");
#pragma unroll
        for (int j = 0; j < 8; ++j) { const int orow = (c.lane >> 3) + 8 * j, ch = c.lane & 7;
            unsigned short e[8];
#pragma unroll
            for (int i = 0; i < 8; ++i) e[i] = *(const LAS unsigned short*)(scr + (ch * 8 + i) * 132 + orow * 2);
            v4u o; o.x = e[0] | ((unsigned)e[1] << 16); o.y = e[2] | ((unsigned)e[3] << 16); o.z = e[4] | ((unsigned)e[5] << 16); o.w = e[6] | ((unsigned)e[7] << 16);
            { const int bb = tt >> 5, kt = 2 * (tt & 31) + (ch >> 2);
              *(v4u*)(VT + (((size_t)bb * NH + ht) * (SEQ / 32) + kt) * (DH * 32) + orow * 32 + 8 * (ch & 3)) = o; } }
        LDS_WAIT(); asm volatile("" ::: "memory");
    }
    const size_t NT = (size_t)c.G * 512;
    for (size_t i = (size_t)c.vcu * 512 + c.tid; i < (size_t)TS * D / 8; i += NT) *(v4u*)(Vsn + i * 8) = *(const v4u*)(Vb + (size_t)TP * D + i * 8);
}

DI f32x16 sg_tile(const bf16* wr  , const bf16* xr  ) {
    f32x16 acc;
#pragma unroll
    for (int i = 0; i < 16; ++i) acc[i] = 0.f;
#pragma unroll 16
    for (int k = 0; k < 64; ++k) acc = MFMA32(*(const bf16x8*)(wr + 16 * k), *(const bf16x8*)(xr + 16 * k), acc);
    return acc;
}
DI void sg_gate(const Ctx c, const bf16* Hall  , const bf16* Wl  , bf16* U, bf16* Bg, float* convp  ) {
    const int q = c.lane & 31, hh = c.lane >> 5;
    for (int tile = c.wave * c.G + c.vcu; tile < 18 * 32; tile += c.G * 8) {
        const int tt = tile % 18, dt = tile / 18, d = 32 * dt + q, crow = 256 * (d >> 7) + (d & 127);
        const bool cs = tt >= 16; const int kk = (tt - 16) * 32 + q;
        const size_t row = cs ? (size_t)(kk >> 1) * SEQ + (SEQ - 2) + (kk & 1) : (size_t)TP + tt * 32 + q;
        const bf16* xr = Hall + row * D + 8 * hh;
        const bf16* wc = Wl + (size_t)crow * D + 8 * hh; const bf16* wx = wc + (size_t)128 * D; const bf16* wb = Wl + (size_t)(2048 + d) * D + 8 * hh;
        f32x16 ac, ax, ab;
#pragma unroll
        for (int i = 0; i < 16; ++i) { ac[i] = 0.f; ax[i] = 0.f; ab[i] = 0.f; }
#pragma unroll 8
        for (int k = 0; k < 64; ++k) { const bf16x8 xf = *(const bf16x8*)(xr + 16 * k);
            ac = MFMA32(*(const bf16x8*)(wc + 16 * k), xf, ac); ax = MFMA32(*(const bf16x8*)(wx + 16 * k), xf, ax); ab = MFMA32(*(const bf16x8*)(wb + 16 * k), xf, ab); }
        if (cs) {
            float* cd = convp + (size_t)kk * D + 32 * dt + 4 * hh;
#pragma unroll
            for (int g = 0; g < 4; ++g) *(f32x4*)(cd + 8 * g) = (f32x4){ac[4 * g] * ax[4 * g], ac[4 * g + 1] * ax[4 * g + 1], ac[4 * g + 2] * ax[4 * g + 2], ac[4 * g + 3] * ax[4 * g + 3]};
        } else {
            const size_t ro = row * D + 32 * dt + 4 * hh;
#pragma unroll
            for (int g = 0; g < 4; ++g) { v2u wu, wb2; wu.x = pk2(ac[4 * g] * ax[4 * g], ac[4 * g + 1] * ax[4 * g + 1]); wu.y = pk2(ac[4 * g + 2] * ax[4 * g + 2], ac[4 * g + 3] * ax[4 * g + 3]);
                wb2.x = pk2(ab[4 * g], ab[4 * g + 1]); wb2.y = pk2(ab[4 * g + 2], ab[4 * g + 3]);
                *(v2u*)(U + ro + 8 * g) = wu; *(v2u*)(Bg + ro + 8 * g) = wb2; }
        }
    }
}
template <int MODE>
DI void sg_plain(const Ctx c, const bf16* Xs, const bf16* Wt, const int N, bf16* O, const bf16* Hres, bf16* O2, float* f0, float* f1) {
    const int q = c.lane & 31, hh = c.lane >> 5;
    for (int tile = c.wave * c.G + c.vcu; tile < 16 * (N / 32); tile += c.G * 8) {
        const int tt = tile & 15, ft = tile >> 4;
        const f32x16 acc = sg_tile(Wt + (size_t)(ft * 32 + q) * D + 8 * hh, Xs + (size_t)(tt * 32 + q) * D + 8 * hh);
        const int tl = tt * 32 + q;
#pragma unroll
        for (int g = 0; g < 4; ++g) { const int f = 32 * ft + 8 * g + 4 * hh; const f32x4 v = {acc[4 * g], acc[4 * g + 1], acc[4 * g + 2], acc[4 * g + 3]};
            if (MODE == 0) { v2u w; w.x = pk2(v[0], v[1]); w.y = pk2(v[2], v[3]); *(v2u*)(O + (size_t)(TP + tl) * D + f) = w; }
            else if (MODE == 1) { const v2u hw = *(const v2u*)(Hres + (size_t)(TP + tl) * D + f); const f32x4 r = (f32x4){bflo(hw.x), bfhi(hw.x), bflo(hw.y), bfhi(hw.y)} * ALPHA + v;
                v2u w; w.x = pk2(r[0], r[1]); w.y = pk2(r[2], r[3]); *(v2u*)(O + (size_t)(TP + tl) * D + f) = w; }
            else if (MODE == 2) { const bool isv = f >= 1024; const int fc = isv ? f - 1024 : f; v2u w; w.x = pk2(v[0], v[1]); w.y = pk2(v[2], v[3]);
                *(v2u*)((isv ? O2 : O) + (size_t)(TP + tl) * D + fc) = w; *(f32x4*)((isv ? f1 : f0) + (size_t)tl * D + fc) = v; }
            else { v2u w; w.x = pk2(v[0], v[1]); w.y = pk2(v[2], v[3]); *(v2u*)(O + (size_t)(TP + tl) * 2048 + f) = w; }
        }
    }
}

struct Args { const float* in[18]; float* out; unsigned char* ws; int ph_lo, ph_hi, li, pad; };
constexpr int N_PHASES = 2 + 2 * 10 + 12 + 10;
__global__ void __launch_bounds__(512, 2) fwd(Args args) {
    extern __shared__ __attribute__((aligned(16))) unsigned char lds_raw[];
    LAS unsigned char* lds = (LAS unsigned char*)lds_raw;
    Ctx c0; c0.tid = threadIdx.x; c0.lane = 0; c0.wave = __builtin_amdgcn_readfirstlane(c0.tid >> 6); c0.G = gridDim.x;
    { const int bx = blockIdx.x; c0.vcu = (c0.G % 8 == 0) ? (bx % 8) * (c0.G / 8) + bx / 8 : bx; }
    volatile LAS unsigned* MISC = (volatile LAS unsigned*)(lds + MISC_OFF);
    for (int u = c0.tid; u < (LDS_BYTES - RING_BYTES) / 4; u += 512) ((LAS unsigned*)(lds + RING_BYTES))[u] = 0u;
    __syncthreads();
    unsigned char* ws = args.ws; float* out = args.out;
    XcdBarrier bar = xcd_barrier_post((unsigned*)(ws + WS_CTL) + CW_BAR + args.li * XCD_BAR_WORDS, MISC + 8, c0.wave == 0 ? 1u : 0u);
#define WinT ((bf16*)(wsl + WS_WIN))
#define WoutT ((bf16*)(wsl + WS_WOUT))
#define WqT ((bf16*)(wsl + WS_WQ))
#define WoT ((bf16*)(wsl + WS_WO))
#define WkvT ((bf16*)(wsl + WS_WKV))
#define WP ((bf16*)(wsl + WS_WP))
#define W8A (wsl + WS_W8A)
#define SWA ((float*)(wsl + WS_SWA))
#define W8R(off) ((int)(((off) - WS_WIN) / 2048))
#define Vsn ((bf16*)(wsl + WS_VSN))
#define H ((bf16*)(wsl + WS_H))
#define Kb ((bf16*)(wsl + WS_KB))
#define VT ((bf16*)(wsl + WS_VT))
#define ids ((unsigned short*)(wsl + WS_IDS))
#define gates ((float*)(wsl + WS_GATE))
#define W8 (wsl + WS_W8)
#define SX ((float*)(wsl + WS_SX))
#define SW (SX + T)
#define X8 (wsl + WS_X8)
#define TU (wsl + WS_TU)
#define TV (wsl + WS_TV)
#define SU ((float*)(wsl + WS_SU))
#define SV (SU + 1)
#define A0 ((bf16*)(wsl + WS_A))
#define A1 ((bf16*)(wsl + WS_A + 129 * MiB))
#define ScT ((float*)(wsl + WS_A))
#define R A0
    const float* ln_g = args.in[16]; const float* ln_b = args.in[17];
    const int lo = args.ph_lo, hi = args.ph_hi; int ph = 0;
#ifndef PROBE_REPEAT
#define PROBE_REPEAT 0
#endif
#define PHASE_R(bit, body) do { const int nrep = 1 + ((PROBE_REPEAT >> (bit)) & 1); for (int rep = 0; rep < nrep; ++rep) { if (ph >= lo && ph < hi) { Ctx c = c0; c.lane = xb_lane_id(); c.tid = c0.wave * 64 + c.lane; unsigned long long wsi_ = (unsigned long long)ws; asm volatile("" : "+s"(wsi_)); unsigned char* wsl = (unsigned char*)(GAS unsigned char*)wsi_; body; if (ph + 1 < hi) { xcd_barrier(bar); if ((PROBE_REPEAT >> 20) & 1) xcd_barrier(bar); } } ++ph; } } while (0)
#define PHASE(body) PHASE_R(31, body)

    PHASE_R(4, ({ P0Args a{args.in[0], args.in[1], args.in[5], args.in[7], args.in[8], args.in[9], args.in[10], args.in[11], args.in[12], args.in[13], args.in[14], args.in[15],
                      WinT, WoutT, WqT, WoT, WkvT, WP, H, TU, TV, SU, SV, X8, SX}; p0_prologue(c, lds, a); }));

    PHASE(({ wp_quant_phase(c, WinT, W8A, SWA); }));

#pragma unroll 1
    for (int l = 0; l < NLAYER; ++l) {
        if (l < 2) {
            PHASE_R(8, ({ pg8::Gemm g{(const bf16*)X8, (const bf16*)(W8A + ((size_t)W8R(WS_WIN) + (size_t)l * 3072) * 1024), TP, 3072, 512}; pg8::StaticOrder S; S.init(TP, 3072, c.G, (int)blockIdx.x);
                     pg8::EpiGate<true> E{A0, A1, SX, SWA + W8R(WS_WIN) + l * 3072};
                     pg8::gemm_phase<pg8::EpiGate<true>, pg8::StaticOrder, true, true, true>(lds, g, S, E, c.tid);
                     sg_gate(c, H, WinT + (size_t)l * 3072 * 1024, A0, A1, out + O_CONVP + (size_t)l * NB * 2 * D); }));
            PHASE_R(13, ({ conv_gate_phase(c, A0, A1, args.in[6] + (size_t)l * 3 * D, args.in[2] + (size_t)l * NB * 2 * D, out + O_CONVP + (size_t)l * NB * 2 * D, out + O_CONVS + (size_t)l * NB * 2 * D, X8, SX, rep > 0); }));
        } else {
            if (l == 2) {
                PHASE_R(10, ({ pg8::Gemm g{(const bf16*)X8, (const bf16*)(W8A + (size_t)W8R(WS_WKV) * 1024), TP, 2048, 512}; pg8::StaticOrder S; S.init(TP, 2048, c.G, (int)blockIdx.x);
                         pg8::EpiKV<true> E{Kb, A1, out + O_KP, out + O_VP, out + O_KS, out + O_VS, SX, SWA + W8R(WS_WKV)};
                         pg8::gemm_phase<pg8::EpiKV<true>, pg8::StaticOrder, true, true, true>(lds, g, S, E, c.tid);
                         sg_plain<2>(c, H + (size_t)TP * D, WkvT, 2048, Kb, nullptr, A1, out + O_KS, out + O_VS); }));
                PHASE_R(14, ({ vt_phase(c, lds, A1, VT, Vsn); }));
            }
            PHASE_R(9, ({ pg8::Gemm g{(const bf16*)X8, (const bf16*)(W8A + ((size_t)W8R(WS_WQ) + (size_t)(l - 2) * 1024) * 1024), TP, 1024, 512}; pg8::StaticOrder S; S.init(TP, 1024, c.G, (int)blockIdx.x);
                     pg8::EpiBf16P<true> E{A0, 1024, SX, SWA + W8R(WS_WQ) + (l - 2) * 1024};
                     pg8::gemm_phase<pg8::EpiBf16P<true>, pg8::StaticOrder, true, true, true>(lds, g, S, E, c.tid);
                     sg_plain<0>(c, H + (size_t)TP * D, WqT + (size_t)(l - 2) * 1024 * 1024, 1024, A0, nullptr, nullptr, nullptr, nullptr); }));
            PHASE_R(11, ({ AttnT A{A0, A1, Kb, VT, Vsn, args.in[3], args.in[4]}; attn_phase(c, A); }));
        }
        if (l < 2) {
            PHASE_R(7, ({ pg8::Gemm g{(const bf16*)X8, (const bf16*)(W8A + ((size_t)W8R(WS_WOUT) + (size_t)l * 1024) * 1024), TP, 1024, 512}; pg8::StaticOrder S; S.init(TP, 1024, c.G, (int)blockIdx.x);
                     pg8::EpiRes<true> E{H, R, ALPHA, SX, SWA + W8R(WS_WOUT) + l * 1024};
                     pg8::gemm_phase<pg8::EpiRes<true>, pg8::StaticOrder, true, true, true>(lds, g, S, E, c.tid);
                     sg_plain<1>(c, A1 + (size_t)TP * D, WoutT + (size_t)l * 1024 * 1024, 1024, R, H, nullptr, nullptr, nullptr); }));
        } else {
            PHASE_R(7, ({ pg8::Gemm g{A1, WoT + (size_t)(l - 2) * 1024 * 1024, TP, 1024, 1024}; pg8::StaticOrder S; S.init(TP, 1024, c.G, (int)blockIdx.x);
                     pg8::EpiRes<false> E{H, R, ALPHA, nullptr, nullptr};
                     pg8::gemm_phase<pg8::EpiRes<false>, pg8::StaticOrder, true, true>(lds, g, S, E, c.tid);
                     sg_plain<1>(c, A1 + (size_t)TP * D, WoT + (size_t)(l - 2) * 1024 * 1024, 1024, R, H, nullptr, nullptr, nullptr); }));
        }
        PHASE_R(5, ({ ln_phase(c, R, H, ln_g + (size_t)(l * 2) * D, ln_b + (size_t)(l * 2) * D, nullptr, nullptr, X8, SX); }));
        PHASE_R(6, ({ pg8::Gemm g{(const bf16*)X8, (const bf16*)(W8A + ((size_t)W8R(WS_WP) + (size_t)l * 2048) * 1024), TP, 2048, 512}; pg8::StaticOrder S; S.init(TP, 2048, c.G, (int)blockIdx.x);
                 pg8::EpiScoreI8 E{(bf16*)ScT, 2048, SX, SWA + W8R(WS_WP) + l * 2048};
                 pg8::gemm_phase<pg8::EpiScoreI8, pg8::StaticOrder, true, true, true>(lds, g, S, E, c.tid);
                 sg_plain<3>(c, H + (size_t)TP * D, WP + (size_t)l * 2048 * 1024, 2048, (bf16*)ScT, nullptr, nullptr, nullptr, nullptr); }));
        PHASE_R(3, ({ topk_phase(c, (const bf16*)ScT, ids, gates); }));
        PHASE_R(0, ({ slice_pass<0>(c, X8, ids, W8, SW, TU + (size_t)l * NEXP * D, ScT  , (unsigned*)(ws + WS_CTL) + CW_Q + ((l * 2) * 2 + rep) * 512); }));
        PHASE_R(12, ({ peer_w_phase(c, ScT, ids, gates, W8, SW, SX, SU + (size_t)l * NEXP * 2, SV + (size_t)l * NEXP * 2); }));
        PHASE_R(1, ({ slice_pass<1>(c, X8, ids, W8, SW, TV + (size_t)l * NEXP * D, (float*)A0, (unsigned*)(ws + WS_CTL) + CW_Q + ((l * 2 + 1) * 2 + rep) * 512); }));
        PHASE(({ ln_phase(c, A0, H, ln_g + (size_t)(l * 2 + 1) * D, ln_b + (size_t)(l * 2 + 1) * D, l == NLAYER - 1 ? out : nullptr, H, X8, SX); }));
#if defined(PROBE_SLICE) && PROBE_SLICE == 1
        PHASE(({ slice_pass<0, 1>(c, X8, ids, W8, SW, TU + (size_t)l * NEXP * D, ScT, (unsigned*)(ws + WS_CTL) + CW_Q + ((l * 2) * 2 + 1) * 512); }));
#elif defined(PROBE_SLICE) && PROBE_SLICE == 2
        PHASE(({ slice_pass<0, 2>(c, X8, ids, W8, SW, TU + (size_t)l * NEXP * D, ScT, (unsigned*)(ws + WS_CTL) + CW_Q + ((l * 2) * 2 + 1) * 512); }));
#elif defined(PROBE_SLICE) && PROBE_SLICE == 3
        PHASE(({ slice_pass<1, 1>(c, X8, ids, W8, SW, TV + (size_t)l * NEXP * D, ScT, (unsigned*)(ws + WS_CTL) + CW_Q + ((l * 2) * 2 + 1) * 512); }));
#elif defined(PROBE_SLICE) && PROBE_SLICE == 4
        PHASE(({ slice_pass<1, 2>(c, X8, ids, W8, SW, TV + (size_t)l * NEXP * D, ScT, (unsigned*)(ws + WS_CTL) + CW_Q + ((l * 2) * 2 + 1) * 512); }));
#endif
    }
#undef PHASE
#undef PHASE_R
#undef WinT
#undef WoutT
#undef WqT
#undef WoT
#undef WkvT
#undef WP
#undef W8A
#undef SWA
#undef W8R
#undef Vsn
#undef H
#undef Kb
#undef VT
#undef ids
#undef gates
#undef W8
#undef SX
#undef SW
#undef X8
#undef TU
#undef TV
#undef SU
#undef SV
#undef A0
#undef A1
#undef ScT
#undef R
}

#ifndef N_LAUNCH_MODE
#define N_LAUNCH_MODE 1
#endif
extern "C" void kernel_launch(void* const* d_in, const int* in_sizes, int n_in, void* d_out, int out_size, void* d_ws, size_t ws_size, hipStream_t stream) {
    static int grid = 0;
    if (grid == 0) {
        if (n_in != 18 || in_sizes[0] != TP * D || (size_t)out_size != O_END || ws_size < WS_END) {
            fprintf(stderr, "kernel_launch: shape mismatch: n_in %d in0 %d out %d ws %zu (need %zu)\n", n_in, n_in > 0 ? in_sizes[0] : -1, out_size, ws_size, (size_t)WS_END); grid = -1; return; }
        int dev = 0, cus = 0, per_cu = 0;
        if (hipGetDevice(&dev) != hipSuccess || hipDeviceGetAttribute(&cus, hipDeviceAttributeMultiprocessorCount, dev) != hipSuccess) { grid = -1; return; }
        if (hipFuncSetAttribute((const void*)fwd, hipFuncAttributeMaxDynamicSharedMemorySize, LDS_BYTES) != hipSuccess) { fprintf(stderr, "kernel_launch: hipFuncSetAttribute failed\n"); grid = -1; return; }
        if (hipOccupancyMaxActiveBlocksPerMultiprocessor(&per_cu, (const void*)fwd, 512, LDS_BYTES) != hipSuccess || per_cu < 1) { fprintf(stderr, "kernel_launch: occupancy query says %d\n", per_cu); }
        (void)hipGetLastError();
        grid = cus;
    }
    if (grid < 0) return;
    (void)hipMemsetAsync((char*)d_ws + WS_CTL, 0, CTL_BYTES, stream);
    Args a{};
    for (int i = 0; i < 18; ++i) a.in[i] = (const float*)d_in[i];
    a.out = (float*)d_out; a.ws = (unsigned char*)d_ws; a.pad = 0;
#if N_LAUNCH_MODE == 1
    a.ph_lo = 0; a.ph_hi = 1 << 30; a.li = 0;
    hipLaunchKernelGGL(fwd, dim3(grid), dim3(512), LDS_BYTES, stream, a);
#else
    for (int p = 0; p < N_PHASES; ++p) { a.ph_lo = p; a.ph_hi = p + 1; a.li = p; hipLaunchKernelGGL(fwd, dim3(grid), dim3(512), LDS_BYTES, stream, a); }
#endif
}
```

```cpp
#include <hip/hip_runtime.h>
#include <cstdio>
#include <cstdint>
namespace pg8 {
#define PG8_LAS __attribute__((address_space(3)))
typedef unsigned short bf16_t;
typedef short bf16x8 __attribute__((ext_vector_type(8)));
typedef float f32x4 __attribute__((ext_vector_type(4)));
typedef unsigned u32x4 __attribute__((ext_vector_type(4)));
constexpr int BM = 256, BK = 64, HALF = 128, HTB = HALF * BK * 2  , STAGE_BYTES = 8 * HTB, NXCD = 8, WGM = 8;

__host__ __device__ __forceinline__ int lds_byte(int r, int c) { const int st = (r >> 4) * 2 + (c >> 5), rr = r & 15, cc = c & 31, ob = rr * 64 + cc * 2; return st * 1024 + (ob ^ (((ob >> 9) & 1) << 5)); }
__host__ __device__ __forceinline__ void stage_rc(int b, int& R, int& C) { const int st = b / 1024, sb = b % 1024, swz = sb ^ (((sb >> 9) & 1) << 5); R = (st >> 1) * 16 + swz / 64; C = (st & 1) * 32 + (swz % 64) / 2; }
__host__ __device__ __forceinline__ int perm32(int rho) { const int n = rho >> 4, i = rho & 15; return 8 * (i >> 2) + 4 * n + (i & 3); }

struct Unit { int pm, pn; };
struct Gemm { const bf16_t* A; const bf16_t* Bt; int M, N, K; };

struct StaticOrder {
    int nM, nN, nwg, G, c;
    __host__ __device__ void init(int M, int N, int G_, int c_) { nM = M / BM; nN = N / BM; nwg = nM * nN; G = G_; c = c_; }
    __host__ __device__ bool next(int i, Unit& u) const {
        const long L = (long)i * G + c; if (L >= nwg) return false;
        int wgid = (int)L; { const int q = nwg / NXCD, r = nwg % NXCD, xcd = wgid % NXCD, off = wgid / NXCD; wgid = (xcd < r ? xcd * (q + 1) : r * (q + 1) + (xcd - r) * q) + off; }
        const int nig = WGM * nN, gid = wgid / nig, fm = gid * WGM, gsz = (nM - fm) < WGM ? (nM - fm) : WGM;
        u.pm = fm + ((wgid % nig) % gsz); u.pn = (wgid % nig) / gsz; return true;
    }
    __device__ __forceinline__ void a_ready(const Unit&) const {}
    __device__ __forceinline__ void done(const Unit&) const {}
};

typedef float f32x2 __attribute__((ext_vector_type(2)));
typedef __bf16 bf16x2v __attribute__((ext_vector_type(2)));
typedef unsigned u32x2 __attribute__((ext_vector_type(2)));
__device__ __forceinline__ unsigned pk2(float lo, float hi) { const bf16x2v v = __builtin_convertvector((f32x2){lo, hi}, bf16x2v); return __builtin_bit_cast(unsigned, v); }
__device__ __forceinline__ u32x4 pk8(const f32x4 a, const f32x4 b) { u32x4 w; w.x = pk2(a[0], a[1]); w.y = pk2(a[2], a[3]); w.z = pk2(b[0], b[1]); w.w = pk2(b[2], b[3]); return w; }

typedef int i32x4 __attribute__((ext_vector_type(4)));
template <bool I8> struct AccT { typedef f32x4 type; static __device__ __forceinline__ type zero() { return (f32x4){0.f, 0.f, 0.f, 0.f}; } };
template <> struct AccT<true> { typedef i32x4 type; static __device__ __forceinline__ type zero() { return (i32x4){0, 0, 0, 0}; } };
__device__ __forceinline__ f32x4 mma16(const bf16x8 b, const bf16x8 a, const f32x4 c) { return __builtin_amdgcn_mfma_f32_16x16x32_bf16(b, a, c, 0, 0, 0); }
__device__ __forceinline__ i32x4 mma16(const bf16x8 b, const bf16x8 a, const i32x4 c) { return __builtin_amdgcn_mfma_i32_16x16x64_i8(__builtin_bit_cast(i32x4, b), __builtin_bit_cast(i32x4, a), c, 0, 0, 0); }
__device__ __forceinline__ f32x4 dq4(const f32x4 a, const float, const f32x4) { return a; }
__device__ __forceinline__ f32x4 dq4(const i32x4 a, const float ra, const f32x4 cb) { return (f32x4){(float)a[0], (float)a[1], (float)a[2], (float)a[3]} * ra * cb; }
constexpr int TOK_P = 65536;

template <bool I8> struct EpiBf16P {
    static constexpr bool PERM = true, AFTER_DRAIN = false;
    bf16_t* O; int ldc; const float* sa; const float* sb;
    __device__ __forceinline__ void operator()(const typename AccT<I8>::type (&acc)[2][2][4][2], const Unit& u, int wr, int wc, int fr, int fq) const {
        const int row0 = u.pm * BM + wr * 64 + fr, col0 = u.pn * BM + wc * 32 + 8 * fq;
        f32x4 cb[2][2];
#pragma unroll
        for (int bj = 0; bj < 2; ++bj)
#pragma unroll
            for (int n = 0; n < 2; ++n) cb[bj][n] = I8 ? *(const f32x4*)(sb + col0 + bj * HALF + 4 * n) : (f32x4){1.f, 1.f, 1.f, 1.f};
        float rs[2][4];
#pragma unroll
        for (int ai = 0; ai < 2; ++ai)
#pragma unroll
            for (int m = 0; m < 4; ++m) rs[ai][m] = I8 ? sa[row0 + ai * HALF + m * 16] : 1.f;
        __builtin_amdgcn_sched_barrier(0);
#pragma unroll
        for (int ai = 0; ai < 2; ++ai)
#pragma unroll
            for (int m = 0; m < 4; ++m) { const int row = row0 + ai * HALF + m * 16; const float ra = rs[ai][m]; bf16_t* rowp = O + (size_t)row * ldc + col0;
#pragma unroll
                for (int bj = 0; bj < 2; ++bj) *(u32x4*)(rowp + bj * HALF) = pk8(dq4(acc[ai][bj][m][0], ra, cb[bj][0]), dq4(acc[ai][bj][m][1], ra, cb[bj][1])); }
    }
};
template <bool I8> struct EpiGate {
    static constexpr bool PERM = true, AFTER_DRAIN = false;
    bf16_t* U; bf16_t* Bg; const float* sa; const float* sb;
    __device__ __forceinline__ void operator()(const typename AccT<I8>::type (&acc)[2][2][4][2], const Unit& u, int wr, int wc, int fr, int fq) const {
        const int row0 = u.pm * BM + wr * 64 + fr, scol0 = u.pn * BM + wc * 32 + 8 * fq;
        f32x4 cb[2][2];
#pragma unroll
        for (int bj = 0; bj < 2; ++bj)
#pragma unroll
            for (int n = 0; n < 2; ++n) cb[bj][n] = I8 ? *(const f32x4*)(sb + scol0 + bj * HALF + 4 * n) : (f32x4){1.f, 1.f, 1.f, 1.f};
        float rs[2][4];
#pragma unroll
        for (int ai = 0; ai < 2; ++ai)
#pragma unroll
            for (int m = 0; m < 4; ++m) rs[ai][m] = I8 ? sa[row0 + ai * HALF + m * 16] : 1.f;
        __builtin_amdgcn_sched_barrier(0);
        if (u.pn < 8) {
            const int col0 = u.pn * HALF + wc * 32 + 8 * fq;
#pragma unroll
            for (int ai = 0; ai < 2; ++ai)
#pragma unroll
                for (int m = 0; m < 4; ++m) { const int row = row0 + ai * HALF + m * 16; const float ra = rs[ai][m];
                    const f32x4 v0 = dq4(acc[ai][0][m][0], ra, cb[0][0]) * dq4(acc[ai][1][m][0], ra, cb[1][0]), v1 = dq4(acc[ai][0][m][1], ra, cb[0][1]) * dq4(acc[ai][1][m][1], ra, cb[1][1]);
                    *(u32x4*)(U + (size_t)row * 1024 + col0) = pk8(v0, v1); }
        } else {
            const int col0 = (u.pn - 8) * BM + wc * 32 + 8 * fq;
#pragma unroll
            for (int ai = 0; ai < 2; ++ai)
#pragma unroll
                for (int m = 0; m < 4; ++m) { const int row = row0 + ai * HALF + m * 16; const float ra = rs[ai][m]; bf16_t* rowp = Bg + (size_t)row * 1024 + col0;
#pragma unroll
                    for (int bj = 0; bj < 2; ++bj) *(u32x4*)(rowp + bj * HALF) = pk8(dq4(acc[ai][bj][m][0], ra, cb[bj][0]), dq4(acc[ai][bj][m][1], ra, cb[bj][1])); }
        }
    }
};
template <bool I8> struct EpiRes {
    static constexpr bool PERM = true, AFTER_DRAIN = false;
    const bf16_t* H; bf16_t* R; float alpha; const float* sa; const float* sb;
    __device__ __forceinline__ void operator()(const typename AccT<I8>::type (&acc)[2][2][4][2], const Unit& u, int wr, int wc, int fr, int fq) const {
        const int row0 = u.pm * BM + wr * 64 + fr, col0 = u.pn * BM + wc * 32 + 8 * fq;
        f32x4 cb[2][2];
#pragma unroll
        for (int bj = 0; bj < 2; ++bj)
#pragma unroll
            for (int n = 0; n < 2; ++n) cb[bj][n] = I8 ? *(const f32x4*)(sb + col0 + bj * HALF + 4 * n) : (f32x4){1.f, 1.f, 1.f, 1.f};
        float rs[2][4];
#pragma unroll
        for (int ai = 0; ai < 2; ++ai)
#pragma unroll
            for (int m = 0; m < 4; ++m) rs[ai][m] = I8 ? sa[row0 + ai * HALF + m * 16] : 1.f;
        __builtin_amdgcn_sched_barrier(0);
#pragma unroll
        for (int ai = 0; ai < 2; ++ai) {
            u32x4 hq[4][2];
#pragma unroll
            for (int m = 0; m < 4; ++m)
#pragma unroll
                for (int bj = 0; bj < 2; ++bj) hq[m][bj] = *(const u32x4*)(H + (size_t)(row0 + ai * HALF + m * 16) * 1024 + col0 + bj * HALF);
            __builtin_amdgcn_sched_barrier(0);
#pragma unroll
            for (int m = 0; m < 4; ++m) { const int row = row0 + ai * HALF + m * 16; const float ra = rs[ai][m]; const size_t off = (size_t)row * 1024 + col0;
#pragma unroll
                for (int bj = 0; bj < 2; ++bj) { const u32x4 h = hq[m][bj];
                    f32x4 h0, h1; h0[0] = __uint_as_float(h.x << 16); h0[1] = __uint_as_float(h.x & 0xffff0000u); h0[2] = __uint_as_float(h.y << 16); h0[3] = __uint_as_float(h.y & 0xffff0000u);
                    h1[0] = __uint_as_float(h.z << 16); h1[1] = __uint_as_float(h.z & 0xffff0000u); h1[2] = __uint_as_float(h.w << 16); h1[3] = __uint_as_float(h.w & 0xffff0000u);
                    *(u32x4*)(R + off + bj * HALF) = pk8(h0 * alpha + dq4(acc[ai][bj][m][0], ra, cb[bj][0]), h1 * alpha + dq4(acc[ai][bj][m][1], ra, cb[bj][1])); } } }
    }
};
template <bool I8> struct EpiKV {
    static constexpr bool PERM = true, AFTER_DRAIN = false;
    bf16_t* Kb; bf16_t* Vb; float* kp; float* vp; float* ks; float* vs; const float* sa; const float* sb;
    __device__ __forceinline__ void operator()(const typename AccT<I8>::type (&acc)[2][2][4][2], const Unit& u, int wr, int wc, int fr, int fq) const {
        const bool isv = u.pn >= 4; const int colt = (isv ? u.pn - 4 : u.pn) * BM;
        bf16_t* ob = isv ? Vb : Kb; const bool samp = u.pm * BM >= TOK_P;
        float* of = samp ? (isv ? vs : ks) - (size_t)TOK_P * 1024 : (isv ? vp : kp);
        const int row0 = u.pm * BM + wr * 64 + fr, col0 = colt + wc * 32 + 8 * fq, scol0 = u.pn * BM + wc * 32 + 8 * fq;
        float rs[2][4];
#pragma unroll
        for (int ai = 0; ai < 2; ++ai)
#pragma unroll
            for (int m = 0; m < 4; ++m) rs[ai][m] = I8 ? sa[row0 + ai * HALF + m * 16] : 1.f;
        f32x4 cb[2][2];
#pragma unroll
        for (int bj = 0; bj < 2; ++bj)
#pragma unroll
            for (int n = 0; n < 2; ++n) cb[bj][n] = I8 ? *(const f32x4*)(sb + scol0 + bj * HALF + 4 * n) : (f32x4){1.f, 1.f, 1.f, 1.f};
#pragma unroll
        for (int ai = 0; ai < 2; ++ai)
#pragma unroll
            for (int m = 0; m < 4; ++m) { const int row = row0 + ai * HALF + m * 16; const float ra = rs[ai][m]; const size_t off = (size_t)row * 1024 + col0;
#pragma unroll
                for (int bj = 0; bj < 2; ++bj) { const f32x4 v0 = dq4(acc[ai][bj][m][0], ra, cb[bj][0]), v1 = dq4(acc[ai][bj][m][1], ra, cb[bj][1]);
                    *(u32x4*)(ob + off + bj * HALF) = pk8(v0, v1); *(f32x4*)(of + off + bj * HALF) = v0; *(f32x4*)(of + off + bj * HALF + 4) = v1; } }
    }
};

struct EpiScoreI8 {
    static constexpr bool PERM = true, AFTER_DRAIN = false;
    bf16_t* O; int ldc; const float* sa; const float* sb;
    __device__ __forceinline__ void operator()(const i32x4 (&acc)[2][2][4][2], const Unit& u, int wr, int wc, int fr, int fq) const {
        const int row0 = u.pm * BM + wr * 64 + fr, col0 = u.pn * BM + wc * 32 + 8 * fq;
        f32x4 cb[2][2];
#pragma unroll
        for (int bj = 0; bj < 2; ++bj)
#pragma unroll
            for (int n = 0; n < 2; ++n) cb[bj][n] = *(const f32x4*)(sb + col0 + bj * HALF + 4 * n);
        float rs[2][4];
#pragma unroll
        for (int ai = 0; ai < 2; ++ai)
#pragma unroll
            for (int m = 0; m < 4; ++m) rs[ai][m] = sa[row0 + ai * HALF + m * 16];
        __builtin_amdgcn_sched_barrier(0);
#pragma unroll
        for (int ai = 0; ai < 2; ++ai)
#pragma unroll
            for (int m = 0; m < 4; ++m) { const int row = row0 + ai * HALF + m * 16; const float ra = rs[ai][m]; bf16_t* rowp = O + (size_t)row * ldc + col0;
#pragma unroll
                for (int bj = 0; bj < 2; ++bj) { f32x4 v0, v1;
#pragma unroll
                    for (int i = 0; i < 4; ++i) { v0[i] = (float)acc[ai][bj][m][0][i] * ra * cb[bj][0][i]; v1[i] = (float)acc[ai][bj][m][1][i] * ra * cb[bj][1][i]; }
                    *(u32x4*)(rowp + bj * HALF) = pk8(v0, v1); } }
    }
};

template <class Epi, class Sched, bool ALIGN_EPI = false, bool SP2 = false, bool I8 = false>
__device__ __forceinline__ void gemm_phase(PG8_LAS unsigned char* lds, const Gemm g, const Sched& S, const Epi& E, const int tid_in) {
    int tid_ = tid_in; asm volatile("" : "+v"(tid_));
    const int tid = tid_, wid = __builtin_amdgcn_readfirstlane(tid >> 6), lane = tid & 63, wr = wid >> 2, wc = wid & 3, fr = lane & 15, fq = lane >> 4;
    const int K = g.K, nt = K / BK;
    unsigned voffA[2], voffB[2];
#pragma unroll
    for (int i = 0; i < 2; ++i) { int R, C; stage_rc(tid * 16 + i * 8192, R, C); const int Rb = Epi::PERM ? ((R & ~31) + perm32(R & 31)) : R;
        voffA[i] = (unsigned)(R * K + C) * 2u; voffB[i] = (unsigned)(Rb * K + C) * 2u; }
    const size_t kstep = (size_t)(BK * 2);
    const size_t hstep = (size_t)HALF * K * 2;
    const size_t tstep = 2 * hstep;
    const unsigned ldsw = (unsigned)wid * 1024u;
    const int aoff = lds_byte(wr * 64 + fr, fq * 8), boff = lds_byte(wc * 32 + fr, fq * 8);
#define PG8_SA(b, h) (((b) * 2 + (h)) * HTB)
#define PG8_SB(b, h) ((4 + (b) * 2 + (h)) * HTB)
#define PG8_STAGE(bufoff, gbase, voff) do { _Pragma("unroll") for (int _i = 0; _i < 2; ++_i) \
        __builtin_amdgcn_global_load_lds((const unsigned*)((const char*)(gbase) + (voff)[_i]), (PG8_LAS unsigned*)(lds + (bufoff) + ldsw + _i * 8192), 16, 0, 0); } while (0)
#define PG8_LDA(dst, b, h) do { _Pragma("unroll") for (int m = 0; m < 4; ++m) _Pragma("unroll") for (int k = 0; k < 2; ++k) dst[m][k] = *(const PG8_LAS bf16x8*)(lds + PG8_SA(b, h) + aoff + m * 2048 + k * 1024); } while (0)
#define PG8_LDB(dst, b, h) do { _Pragma("unroll") for (int n = 0; n < 2; ++n) _Pragma("unroll") for (int k = 0; k < 2; ++k) dst[n][k] = *(const PG8_LAS bf16x8*)(lds + PG8_SB(b, h) + boff + n * 2048 + k * 1024); } while (0)
#define PG8_MMA(ai, bj, At, Bt) do { __builtin_amdgcn_s_setprio(1); _Pragma("unroll") for (int m = 0; m < 4; ++m) _Pragma("unroll") for (int n = 0; n < 2; ++n) _Pragma("unroll") for (int k = 0; k < 2; ++k) \
        acc[ai][bj][m][n] = mma16(Bt[n][k], At[m][k], acc[ai][bj][m][n]); __builtin_amdgcn_s_setprio(0); } while (0)
#define PG8_WAIT_V(n) asm volatile("s_waitcnt vmcnt(" #n ")" ::: "memory")
#define PG8_WAIT_L(n) asm volatile("s_waitcnt lgkmcnt(" #n ")" ::: "memory")
#define PG8_BAR __builtin_amdgcn_s_barrier()
#define PG8_SCHED __builtin_amdgcn_sched_barrier(0)
    Unit cur, nxt; int ui = 0;
    if (!S.next(0, cur)) return;
    typename AccT<I8>::type acc[2][2][4][2];
#pragma unroll
    for (int a = 0; a < 2; ++a)
#pragma unroll
        for (int b = 0; b < 2; ++b)
#pragma unroll
            for (int m = 0; m < 4; ++m)
#pragma unroll
                for (int n = 0; n < 2; ++n) acc[a][b][m][n] = AccT<I8>::zero();
    bf16x8 At[4][2], B0[2][2], B1[2][2];
    const char* cA = (const char*)g.A + (size_t)cur.pm * tstep; const char* cB = (const char*)g.Bt + (size_t)cur.pn * tstep;
    S.a_ready(cur);
    if constexpr (SP2) {
        PG8_STAGE(PG8_SB(0, 0), cB, voffB); PG8_STAGE(PG8_SB(0, 1), cB + hstep, voffB); PG8_STAGE(PG8_SA(0, 0), cA, voffA); PG8_STAGE(PG8_SA(0, 1), cA + hstep, voffA);
        if (wr == 1) PG8_BAR;
        PG8_WAIT_V(2); PG8_BAR;
        PG8_STAGE(PG8_SB(1, 0), cB + kstep, voffB); PG8_STAGE(PG8_SA(1, 0), cA + kstep, voffA); PG8_STAGE(PG8_SB(1, 1), cB + hstep + kstep, voffB);
        PG8_WAIT_V(6); PG8_BAR;
    } else {
        PG8_STAGE(PG8_SB(0, 0), cB, voffB); PG8_STAGE(PG8_SA(0, 0), cA, voffA); PG8_STAGE(PG8_SB(0, 1), cB + hstep, voffB); PG8_STAGE(PG8_SA(0, 1), cA + hstep, voffA);
        if (wr == 1) PG8_BAR;
        PG8_WAIT_V(4); PG8_BAR;
        PG8_STAGE(PG8_SB(1, 0), cB + kstep, voffB); PG8_STAGE(PG8_SA(1, 0), cA + kstep, voffA); PG8_STAGE(PG8_SB(1, 1), cB + hstep + kstep, voffB);
        PG8_WAIT_V(6); PG8_BAR;
    }
    for (;;) {
        const bool has_next = S.next(ui + 1, nxt);
        const char* nA = has_next ? (const char*)g.A + (size_t)nxt.pm * tstep : cA; const char* nB = has_next ? (const char*)g.Bt + (size_t)nxt.pn * tstep : cB;
        for (int t = 0; t < nt; t += 2) {
            const bool last = (t == nt - 2);
            const char* a1 = cA + (size_t)(t + 1) * kstep;
            const char* a2 = last ? nA : cA + (size_t)(t + 2) * kstep; const char* b2 = last ? nB : cB + (size_t)(t + 2) * kstep;
            const char* a3 = a2 + kstep; const char* b3 = b2 + kstep;
            if (last && has_next) S.a_ready(nxt);
            if constexpr (SP2) {
            PG8_LDB(B0, 0, 0); PG8_LDB(B1, 0, 1); PG8_SCHED; PG8_LDA(At, 0, 0); PG8_STAGE(PG8_SA(1, 1), a1 + hstep, voffA);
            PG8_WAIT_V(8); PG8_WAIT_L(0); PG8_BAR; PG8_MMA(0, 0, At, B0); PG8_MMA(0, 1, At, B1); PG8_BAR; PG8_SCHED;
            PG8_LDA(At, 0, 1); PG8_STAGE(PG8_SB(0, 0), b2, voffB); PG8_STAGE(PG8_SB(0, 1), b2 + hstep, voffB); PG8_STAGE(PG8_SA(0, 0), a2, voffA);
            PG8_WAIT_V(8); PG8_WAIT_L(0); PG8_BAR; PG8_MMA(1, 0, At, B0); PG8_MMA(1, 1, At, B1); PG8_BAR; PG8_SCHED;
            PG8_LDB(B0, 1, 0); PG8_LDB(B1, 1, 1); PG8_SCHED; PG8_LDA(At, 1, 0); PG8_STAGE(PG8_SA(0, 1), a2 + hstep, voffA);
            PG8_WAIT_V(8); PG8_WAIT_L(0); PG8_BAR; PG8_MMA(0, 0, At, B0); PG8_MMA(0, 1, At, B1); PG8_BAR; PG8_SCHED;
            PG8_LDA(At, 1, 1); PG8_STAGE(PG8_SB(1, 0), b3, voffB); PG8_STAGE(PG8_SB(1, 1), b3 + hstep, voffB); PG8_STAGE(PG8_SA(1, 0), a3, voffA);
            PG8_WAIT_V(8); PG8_WAIT_L(0); PG8_BAR; PG8_MMA(1, 0, At, B0); PG8_MMA(1, 1, At, B1); PG8_BAR; PG8_SCHED;
            } else {
            PG8_LDB(B0, 0, 0); PG8_SCHED; PG8_LDA(At, 0, 0); PG8_STAGE(PG8_SA(1, 1), a1 + hstep, voffA);
            PG8_WAIT_L(8); PG8_BAR; PG8_WAIT_L(0); PG8_MMA(0, 0, At, B0); PG8_BAR; PG8_SCHED;
            PG8_LDB(B1, 0, 1); PG8_STAGE(PG8_SB(0, 0), b2, voffB);
            PG8_BAR; PG8_WAIT_L(0); PG8_MMA(0, 1, At, B1); PG8_BAR;
            PG8_LDA(At, 0, 1); PG8_STAGE(PG8_SA(0, 0), a2, voffA);
            PG8_BAR; PG8_WAIT_L(0); PG8_MMA(1, 0, At, B0); PG8_BAR; PG8_SCHED;
            PG8_STAGE(PG8_SB(0, 1), b2 + hstep, voffB);
            PG8_WAIT_V(6); PG8_BAR; PG8_MMA(1, 1, At, B1); PG8_BAR;
            PG8_LDB(B0, 1, 0); PG8_SCHED; PG8_LDA(At, 1, 0); PG8_STAGE(PG8_SA(0, 1), a2 + hstep, voffA);
            PG8_WAIT_L(8); PG8_BAR; PG8_WAIT_L(0); PG8_MMA(0, 0, At, B0); PG8_BAR; PG8_SCHED;
            PG8_LDB(B1, 1, 1); PG8_STAGE(PG8_SB(1, 0), b3, voffB);
            PG8_BAR; PG8_WAIT_L(0); PG8_MMA(0, 1, At, B1); PG8_BAR;
            PG8_LDA(At, 1, 1); PG8_STAGE(PG8_SA(1, 0), a3, voffA);
            PG8_BAR; PG8_WAIT_L(0); PG8_MMA(1, 0, At, B0); PG8_BAR; PG8_SCHED;
            PG8_STAGE(PG8_SB(1, 1), b3 + hstep, voffB);
            PG8_WAIT_V(6); PG8_BAR; PG8_MMA(1, 1, At, B1); PG8_BAR;
            }
        }
        if constexpr (ALIGN_EPI) { if (wr == 0) PG8_BAR; }
        if constexpr (!Epi::AFTER_DRAIN) { E(acc, cur, wr, wc, fr, fq); S.done(cur); }
        if (!has_next) break;
#pragma unroll
        for (int a = 0; a < 2; ++a)
#pragma unroll
            for (int b = 0; b < 2; ++b)
#pragma unroll
                for (int m = 0; m < 4; ++m)
#pragma unroll
                    for (int n = 0; n < 2; ++n) acc[a][b][m][n] = AccT<I8>::zero();
        cur = nxt; cA = nA; cB = nB; ++ui;
        if constexpr (ALIGN_EPI) { if (wr == 1) PG8_BAR; }
    }
    PG8_WAIT_V(0);
    if constexpr (!ALIGN_EPI) { if (wr == 0) PG8_BAR; }
    PG8_BAR;
    if constexpr (Epi::AFTER_DRAIN) { E.fused(acc, cur, wr, wc, fr, fq, lds, wid, lane); S.done(cur); }
#undef PG8_SA
#undef PG8_SB
#undef PG8_STAGE
#undef PG8_LDA
#undef PG8_LDB
#undef PG8_MMA
#undef PG8_WAIT_V
#undef PG8_WAIT_L
#undef PG8_BAR
#undef PG8_SCHED
}
}

#define GAS __attribute__((address_space(1)))
#define LAS __attribute__((address_space(3)))
#define DI __device__ __forceinline__
typedef unsigned short bf16;
typedef unsigned v4u __attribute__((ext_vector_type(4)));
typedef unsigned v2u __attribute__((ext_vector_type(2)));
typedef float f32x4 __attribute__((ext_vector_type(4)));
typedef float f32x16 __attribute__((ext_vector_type(16)));
typedef short bf16x8 __attribute__((ext_vector_type(8)));
using pg8::pk2;
#define LDS_WAIT() asm volatile("s_waitcnt lgkmcnt(0)" ::: "memory")
#define MFMA32(a, b, c) __builtin_amdgcn_mfma_f32_32x32x16_bf16((a), (b), (c), 0, 0, 0)

constexpr int D = 1024, NB = 32, SEQ = 2048, DSEQ = 16, PAST = 1024, NH = 16, DH = 64;
constexpr int TP = NB * SEQ, TS = NB * DSEQ, T = TP + TS;
constexpr int NEXP = 16384, PH = 8, PK = 16;
constexpr int NLAYER = 4;
constexpr float LN_EPS = 1e-5f;
constexpr float ALPHA = 1.6817928305074292f;
constexpr float LOG2E = 1.4426950408889634f, LN2 = 0.6931471805599453f;
static_assert(T % 256 == 0 && pg8::TOK_P == TP, "row panels");
constexpr size_t O_Y = 0, O_YS = (size_t)TP * D, O_CONVP = O_YS + (size_t)TS * D, O_KP = O_CONVP + 2 * NB * 2 * D, O_VP = O_KP + (size_t)TP * D,
                 O_CONVS = O_VP + (size_t)TP * D, O_KS = O_CONVS + 2 * NB * 2 * D, O_VS = O_KS + (size_t)TS * D, O_END = O_VS + (size_t)TS * D;
static_assert(O_END == 203161600ull, "output size");
constexpr size_t MiB = 1u << 20;
constexpr size_t WS_CTL = 0, CTL_BYTES = 2 * MiB;
constexpr size_t WS_WIN = 2 * MiB;
constexpr size_t WS_WOUT = WS_WIN + 12 * MiB;
constexpr size_t WS_WQ = WS_WOUT + 4 * MiB;
constexpr size_t WS_WO = WS_WQ + 4 * MiB;
constexpr size_t WS_WKV = WS_WO + 4 * MiB;
constexpr size_t WS_WP = WS_WKV + 4 * MiB;
constexpr size_t WS_VSN = WS_WP + 16 * MiB;
constexpr size_t WS_H = WS_VSN + 1 * MiB;
constexpr size_t WS_KB = WS_H + 129 * MiB;
constexpr size_t WS_VT = WS_KB + 129 * MiB;
constexpr size_t WS_IDS = WS_VT + 128 * MiB;
constexpr size_t WS_GATE = WS_IDS + 17 * MiB;
constexpr size_t WS_TU = WS_GATE + 33 * MiB;
constexpr size_t WS_TV = WS_TU + 64 * MiB;
constexpr size_t WS_SU = WS_TV + 64 * MiB;
constexpr size_t WS_W8 = WS_SU + 1 * MiB;
constexpr size_t WS_SX = WS_W8 + 9 * MiB;
constexpr size_t WS_X8 = WS_SX + 1 * MiB;
constexpr size_t WS_W8A = WS_X8 + 65 * MiB;
constexpr size_t WS_SWA = WS_W8A + 22 * MiB;
constexpr int W8_ROWS = (int)((WS_VSN - WS_WIN) / 2048);
static_assert(W8_ROWS == 22528, "weight rows");
constexpr size_t WS_A = WS_SWA + 1 * MiB;
constexpr size_t WS_END = WS_A + 258 * MiB;
static_assert((size_t)T * D * 2 == 129 * MiB && (size_t)1024 * T * 4 == 258 * MiB, "sizes");
constexpr int CW_Q = 1024;
constexpr int CW_BAR = 16384;

constexpr int RING_BYTES = 131072, MISC_OFF = RING_BYTES + 320, LDS_BYTES = 147456;

#define XB_TMO      128
#define XB_XCNT(j)  (256  + 64 * (j))
#define XB_XSUB(j)  (1280 + 64 * (j))
#define XB_XGEN(j)  (2304 + 64 * (j))
#define XB_TOP      3328
#define XB_TOPGEN   3392
#define XCD_BAR_WORDS 3456
#define XB_SPIN_CAP (1u << 18)

__device__ __forceinline__ unsigned xb_ld(unsigned* p)              { return __hip_atomic_load(p, __ATOMIC_RELAXED, __HIP_MEMORY_SCOPE_AGENT); }
__device__ __forceinline__ unsigned xb_add(unsigned* p, unsigned v) { return __hip_atomic_fetch_add(p, v, __ATOMIC_RELAXED, __HIP_MEMORY_SCOPE_AGENT); }
__device__ __forceinline__ unsigned xb_xcc_id() { return (unsigned)__builtin_amdgcn_s_getreg((3 << 11) | 20) & 0xFu; }
#define XB_SPIN(cond, bar) do { unsigned _sp = 0; while (cond) { __builtin_amdgcn_s_sleep(1); \
    if ((++_sp & 255u) == 0u) { if (xb_ld(&(bar)[XB_TMO])) break; if (_sp > XB_SPIN_CAP) { atomicAdd(&(bar)[XB_TMO], 1u); break; } } } } while (0)

__device__ __forceinline__ int xb_lane_id() { int l; asm volatile("v_mbcnt_lo_u32_b32 %0, -1, 0\n\tv_mbcnt_hi_u32_b32 %0, -1, %0" : "=v"(l)); return l; }
__device__ __forceinline__ bool xb_is_thread0(unsigned w0) { return w0 != 0u && xb_lane_id() == 0; }
struct XcdBarrier {
    unsigned w0;
    unsigned* bar; unsigned x;
    volatile LAS unsigned* st;
};

__device__ __forceinline__ XcdBarrier xcd_barrier_post(unsigned* bar, volatile LAS unsigned* st, unsigned w0) {
    XcdBarrier b; b.w0 = w0; b.bar = bar; b.x = xb_xcc_id(); b.st = st;
    if (xb_is_thread0(b.w0)) (void)xb_add(&bar[XB_XCNT(b.x)], 1u);
    return b;
}
__device__ __forceinline__ void xcd_barrier_complete(unsigned* bar, unsigned x, unsigned& nloc, unsigned& nx) {
    const unsigned G = gridDim.x * gridDim.y * gridDim.z;
    unsigned sum, cnt, mine, sp = 0u;
    for (;;) {
        sum = 0u; cnt = 0u; mine = 0u;
#pragma unroll
        for (unsigned j = 0; j < 16; ++j) { const unsigned c = xb_ld(&bar[XB_XCNT(j)]); sum += c; cnt += (c > 0u) ? 1u : 0u; mine = (j == x) ? c : mine; }
        if (sum == G) break;
        __builtin_amdgcn_s_sleep(1);
        if ((++sp & 255u) == 0u) { if (xb_ld(&bar[XB_TMO])) break; if (sp > XB_SPIN_CAP) { atomicAdd(&bar[XB_TMO], 1u); break; } }
    }
    nloc = mine > 0u ? mine : 1u; nx = cnt > 0u ? cnt : 1u;
}

__device__ __forceinline__ void xcd_barrier(const XcdBarrier& b) {
    asm volatile("s_waitcnt vmcnt(0)" ::: "memory");
    __syncthreads();
    if (xb_is_thread0(b.w0)) {
        unsigned* bar = b.bar;
        __builtin_amdgcn_s_waitcnt(0);
        unsigned nloc = b.st[0], nx = b.st[1];
        if (nloc == 0u) { xcd_barrier_complete(bar, b.x, nloc, nx); b.st[0] = nloc; b.st[1] = nx; }
        const unsigned old = xb_add(&bar[XB_XSUB(b.x)], 1u);
        const unsigned gen = old / nloc;
        if (old + 1u == (gen + 1u) * nloc) {
            __builtin_amdgcn_fence(__ATOMIC_RELEASE, "agent");
            asm volatile("s_waitcnt vmcnt(0)" ::: "memory");
            const unsigned og = xb_add(&bar[XB_TOP], 1u);
            const unsigned tg = og / nx;
            if (og + 1u == (tg + 1u) * nx) xb_add(&bar[XB_TOPGEN], 1u);
            else XB_SPIN(xb_ld(&bar[XB_TOPGEN]) == tg, bar);
            __builtin_amdgcn_fence(__ATOMIC_ACQUIRE, "agent");
            xb_add(&bar[XB_XGEN(b.x)], 1u);
            asm volatile("s_waitcnt vmcnt(0)" ::: "memory");
        } else {
            XB_SPIN(xb_ld(&bar[XB_XGEN(b.x)]) == gen, bar);
            __builtin_amdgcn_fence(__ATOMIC_ACQUIRE, "agent");
            asm volatile("s_waitcnt vmcnt(0)" ::: "memory");
        }
    }
    __syncthreads();
}


DI float bflo(unsigned w) { return __uint_as_float(w << 16); }
DI float bfhi(unsigned w) { return __uint_as_float(w & 0xffff0000u); }
DI float shx(const int lane, const float v, const int o) { return __int_as_float(__builtin_amdgcn_ds_bpermute((lane ^ o) << 2, __float_as_int(v))); }
DI int shx(const int lane, const int v, const int o) { return __builtin_amdgcn_ds_bpermute((lane ^ o) << 2, v); }
DI float wave_sum(const int lane, float v) {
#pragma unroll
    for (int o = 1; o < 64; o <<= 1) v += shx(lane, v, o);
    return v;
}
DI bf16x8 pack8(float a0, float a1, float a2, float a3, float a4, float a5, float a6, float a7) {
    v4u p; p.x = pk2(a0, a1); p.y = pk2(a2, a3); p.z = pk2(a4, a5); p.w = pk2(a6, a7); return __builtin_bit_cast(bf16x8, p);
}
DI float gelu_erf(float v) {
    const float av = __builtin_fabsf(v), d = av * 0.2316418882f + 1.0f, t = __builtin_amdgcn_rcpf(d);
    float q = t * 0.5307027145f + (-0.7265760135f); q = q * t + 0.7107068705f; q = q * t + (-0.142248368f); q = q * t + 0.127414796f; q = q * t;
    const float e = __builtin_amdgcn_exp2f((v * v) * (-0.72134752044f));
    const float m = v * (q * e), r = v - m;
    return v < 0.f ? m : r;
}

struct Ctx {
    int tid, lane, wave, vcu, G;
};

DI void p0_transpose_item(const float* W, int K, int N, bf16* WT, int out_row0, float scale, LAS float* scr, int k0, int n0, int lane) {
#pragma unroll 8
    for (int i = 0; i < 32; ++i) { const int kk = 2 * i + (lane >> 5); scr[kk * 33 + (lane & 31)] = W[(size_t)(k0 + kk) * N + n0 + (lane & 31)]; }
    LDS_WAIT(); asm volatile("" ::: "memory");
    const int c = lane & 7;
#pragma unroll
    for (int j = 0; j < 4; ++j) { const int n = (lane >> 3) + 8 * j; const LAS float* s = scr + (8 * c) * 33 + n;
        v4u o; o.x = pk2(s[0 * 33] * scale, s[1 * 33] * scale); o.y = pk2(s[2 * 33] * scale, s[3 * 33] * scale); o.z = pk2(s[4 * 33] * scale, s[5 * 33] * scale); o.w = pk2(s[6 * 33] * scale, s[7 * 33] * scale);
        *(v4u*)(WT + (size_t)(out_row0 + n) * K + k0 + 8 * c) = o; }
    LDS_WAIT(); asm volatile("" ::: "memory");
}
DI void cvt_stream(const float* src, bf16* dst, size_t n8, size_t gtid, size_t NT) {
    size_t i = gtid;
    for (; i + 3 * NT < n8; i += 4 * NT) {
        f32x4 a[4], b[4];
#pragma unroll
        for (int u = 0; u < 4; ++u) { a[u] = *(const f32x4*)(src + (i + u * NT) * 8); b[u] = *(const f32x4*)(src + (i + u * NT) * 8 + 4); }
#pragma unroll
        for (int u = 0; u < 4; ++u) *(v4u*)(dst + (i + u * NT) * 8) = pg8::pk8(a[u], b[u]);
    }
    for (; i < n8; i += NT) { const f32x4 a = *(const f32x4*)(src + i * 8), b = *(const f32x4*)(src + i * 8 + 4); *(v4u*)(dst + i * 8) = pg8::pk8(a, b); }
}
DI unsigned q4_i8(const f32x4 v, const float k) {
    const int a = (int)__builtin_rintf(v[0] * k), b = (int)__builtin_rintf(v[1] * k), c = (int)__builtin_rintf(v[2] * k), d = (int)__builtin_rintf(v[3] * k);
    return ((unsigned)a & 0xffu) | (((unsigned)b & 0xffu) << 8) | (((unsigned)c & 0xffu) << 16) | ((unsigned)d << 24);
}
DI void cvt_table_rows(const float* src, unsigned char* dst, float* scl  , int nrows, int gw, int NGW, int lane) {
    f32x4 nx[4];
#pragma unroll
    for (int j = 0; j < 4; ++j) nx[j] = *(const f32x4*)(src + (size_t)(gw < nrows ? gw : 0) * D + 4 * lane + 256 * j);
    for (int row = gw; row < nrows; row += NGW) {
        f32x4 v[4]; float m = 0.f; const int rn = row + NGW < nrows ? row + NGW : row;
#pragma unroll
        for (int j = 0; j < 4; ++j) { v[j] = nx[j]; nx[j] = *(const f32x4*)(src + (size_t)rn * D + 4 * lane + 256 * j);
            m = __builtin_fmaxf(m, __builtin_fmaxf(__builtin_fmaxf(__builtin_fabsf(v[j][0]), __builtin_fabsf(v[j][1])), __builtin_fmaxf(__builtin_fabsf(v[j][2]), __builtin_fabsf(v[j][3])))); }
#pragma unroll
        for (int o = 1; o < 64; o <<= 1) m = __builtin_fmaxf(m, shx(lane, m, o));
        const float k = m > 0.f ? 127.0f / m : 0.f;
#pragma unroll
        for (int j = 0; j < 4; ++j)
            *(unsigned*)(dst + ((size_t)(row >> 14) * NEXP * D) + ((size_t)(2 * j + (lane >> 5)) * NEXP + (row & (NEXP - 1))) * 128 + ((4 * lane) & 127)) = q4_i8(v[j], k);
        if (lane == 0) scl[2 * row] = m * (1.0f / 127.0f);
    }
}
struct P0Args { const float *x_p, *x_s, *w_in, *w_out, *wq, *wo, *wk, *wv, *pwq, *psk, *pu, *pv; bf16 *WinT, *WoutT, *WqT, *WoT, *WkvT, *WP, *H; unsigned char *TU, *TV; float *SU, *SV; unsigned char* X8; float* SX; };
DI void p0_prologue(const Ctx c, LAS unsigned char* lds, const P0Args a) {
    { LAS float* scr = (LAS float*)(lds + c.wave * 16384);
      const int gw = c.vcu * 8 + c.wave, NGW = c.G * 8;
      constexpr int IT_WIN = 16 * 96, IT_SQ = 16 * 32, NITEMS = 2 * IT_WIN + 8 * IT_SQ;
      for (int it = gw; it < NITEMS; it += NGW) {
          int r = it;
          if (r < 2 * IT_WIN) { const int l = r / IT_WIN; r -= l * IT_WIN; const int kb = r / 96, nb = r % 96, n0 = 32 * nb; int orow;
              if (n0 < 1024) orow = 2048 + n0; else if (n0 < 2048) { const int d = n0 - 1024; orow = 256 * (d >> 7) + (d & 127); } else { const int d = n0 - 2048; orow = 256 * (d >> 7) + 128 + (d & 127); }
              p0_transpose_item(a.w_in + (size_t)l * 1024 * 3072, 1024, 3072, a.WinT + (size_t)l * 3072 * 1024, orow, 1.f, scr, 64 * kb, n0, c.lane); continue; }
          r -= 2 * IT_WIN; const int m = r / IT_SQ; r -= m * IT_SQ; const int kb = r >> 5, nb = r & 31;
          const float* src; bf16* dst; float sc = 1.f; const size_t SQ = (size_t)1024 * 1024;
          if (m < 2) { src = a.w_out + m * SQ; dst = a.WoutT + m * SQ; }
          else if (m < 4) { src = a.wq + (m - 2) * SQ; dst = a.WqT + (m - 2) * SQ; sc = 0.125f * LOG2E; }
          else if (m < 6) { src = a.wo + (m - 4) * SQ; dst = a.WoT + (m - 4) * SQ; }
          else if (m == 6) { src = a.wk; dst = a.WkvT; }
          else { src = a.wv; dst = a.WkvT + SQ; }
          p0_transpose_item(src, 1024, 1024, dst, 32 * nb, sc, scr, 64 * kb, 32 * nb, c.lane);
      }
    }
    __syncthreads();
    { LAS float* skT = (LAS float*)lds; LAS float* wqT = skT + 128 * 132;
      for (int u = c.vcu; u < 4 * 16 * 16; u += c.G) {
          const int l = u >> 8, hp = (u >> 4) & 15, dblk = u & 15;
          for (int i = c.tid; i < 16384; i += 512) skT[(i & 127) * 132 + (i >> 7)] = a.psk[(size_t)(l * 16 + hp) * 16384 + i];
          for (int i = c.tid; i < 8192; i += 512) wqT[(i & 127) * 68 + (i >> 7)] = a.pwq[((size_t)l * 1024 + dblk * 64 + (i >> 7)) * 2048 + hp * 128 + (i & 127)];
          __syncthreads();
          const int ng = c.tid & 31, dg = c.tid >> 5; f32x4 acc[4];
#pragma unroll
          for (int i = 0; i < 4; ++i) acc[i] = (f32x4){0.f, 0.f, 0.f, 0.f};
#pragma unroll 4
          for (int cc = 0; cc < 128; ++cc) { const f32x4 s = *(const LAS f32x4*)(skT + cc * 132 + 4 * ng), w = *(const LAS f32x4*)(wqT + cc * 68 + 4 * dg);
#pragma unroll
              for (int i = 0; i < 4; ++i) acc[i] = acc[i] + w * s[i]; }
#pragma unroll
          for (int i = 0; i < 4; ++i) { v2u o; o.x = pk2(acc[i][0], acc[i][1]); o.y = pk2(acc[i][2], acc[i][3]);
              *(v2u*)(a.WP + ((size_t)l * 2048 + hp * 128 + 4 * ng + i) * 1024 + dblk * 64 + 4 * dg) = o; }
          __syncthreads();
      }
    }
    { const size_t gtid = (size_t)c.vcu * 512 + c.tid, NT = (size_t)c.G * 512;
      cvt_table_rows(a.pu, a.TU, a.SU, NLAYER * NEXP, c.vcu * 8 + c.wave, c.G * 8, c.lane);
      cvt_table_rows(a.pv, a.TV, a.SV, NLAYER * NEXP, c.vcu * 8 + c.wave, c.G * 8, c.lane);
      (void)gtid; (void)NT;
      for (int m = c.vcu * 8 + c.wave; m < T; m += c.G * 8) {
          const float* xr = (m < TP ? a.x_p + (size_t)m * D : a.x_s + (size_t)(m - TP) * D) + 4 * c.lane;
          f32x4 v[4]; float am = 0.f;
#pragma unroll
          for (int j = 0; j < 4; ++j) { v[j] = *(const f32x4*)(xr + 256 * j); v2u w; w.x = pk2(v[j][0], v[j][1]); w.y = pk2(v[j][2], v[j][3]); ((v2u*)(a.H + (size_t)m * D) + c.lane)[64 * j] = w;
              am = __builtin_fmaxf(am, __builtin_fmaxf(__builtin_fmaxf(__builtin_fabsf(v[j][0]), __builtin_fabsf(v[j][1])), __builtin_fmaxf(__builtin_fabsf(v[j][2]), __builtin_fabsf(v[j][3])))); }
#pragma unroll
          for (int o = 1; o < 64; o <<= 1) am = __builtin_fmaxf(am, shx(c.lane, am, o));
          const float k = am > 0.f ? 127.0f / am : 0.f;
#pragma unroll
          for (int j = 0; j < 4; ++j) *(unsigned*)(a.X8 + (size_t)m * D + 4 * c.lane + 256 * j) = q4_i8(v[j], k);
          if (c.lane == 0) a.SX[m] = am * (1.0f / 127.0f);
      }
    }
}

DI void wp_quant_phase(const Ctx c, const bf16* WPb, unsigned char* WP8q, float* swp) {
    for (int row = c.vcu * 8 + c.wave; row < W8_ROWS; row += c.G * 8) {
        const v4u a = *(const v4u*)(WPb + (size_t)row * D + 16 * c.lane), b = *(const v4u*)(WPb + (size_t)row * D + 16 * c.lane + 8);
        const f32x4 v0 = {bflo(a.x), bfhi(a.x), bflo(a.y), bfhi(a.y)}, v1 = {bflo(a.z), bfhi(a.z), bflo(a.w), bfhi(a.w)}, v2 = {bflo(b.x), bfhi(b.x), bflo(b.y), bfhi(b.y)}, v3 = {bflo(b.z), bfhi(b.z), bflo(b.w), bfhi(b.w)};
        float m = 0.f;
#pragma unroll
        for (int i = 0; i < 4; ++i) m = __builtin_fmaxf(m, __builtin_fmaxf(__builtin_fmaxf(__builtin_fabsf(v0[i]), __builtin_fabsf(v1[i])), __builtin_fmaxf(__builtin_fabsf(v2[i]), __builtin_fabsf(v3[i]))));
#pragma unroll
        for (int o = 1; o < 64; o <<= 1) m = __builtin_fmaxf(m, shx(c.lane, m, o));
        const float k = m > 0.f ? 127.0f / m : 0.f;
        v4u o; o.x = q4_i8(v0, k); o.y = q4_i8(v1, k); o.z = q4_i8(v2, k); o.w = q4_i8(v3, k);
        *(v4u*)(WP8q + (size_t)row * D + 16 * c.lane) = o;
        if (c.lane == 0) swp[row] = m * (1.0f / 127.0f);
    }
}

DI void ld8_bf16(const bf16* p, float (&o)[8]) { const v4u w = *(const v4u*)p; o[0] = bflo(w.x); o[1] = bfhi(w.x); o[2] = bflo(w.y); o[3] = bfhi(w.y); o[4] = bflo(w.z); o[5] = bfhi(w.z); o[6] = bflo(w.w); o[7] = bfhi(w.w); }
DI void ld8_f32(const float* p, float (&o)[8]) { const f32x4 a = *(const f32x4*)p, b = *(const f32x4*)(p + 4); o[0] = a[0]; o[1] = a[1]; o[2] = a[2]; o[3] = a[3]; o[4] = b[0]; o[5] = b[1]; o[6] = b[2]; o[7] = b[3]; }
DI void conv_gate_phase(const Ctx c, const bf16* U, bf16* Bg, const float* wdw  , const float* st  , float* convp, float* convs  ,
                        unsigned char* z8, float* sz  , const bool skip_samp = false  ) {
    const int gw = c.vcu * 8 + c.wave, NGW = c.G * 8, dc = 16 * c.lane;
    float w0[16], w1[16], w2[16];
    { float t8[8]; ld8_f32(wdw + dc, t8);
#pragma unroll
      for (int i = 0; i < 8; ++i) w0[i] = t8[i]; ld8_f32(wdw + dc + 8, t8);
#pragma unroll
      for (int i = 0; i < 8; ++i) w0[8 + i] = t8[i]; ld8_f32(wdw + D + dc, t8);
#pragma unroll
      for (int i = 0; i < 8; ++i) w1[i] = t8[i]; ld8_f32(wdw + D + dc + 8, t8);
#pragma unroll
      for (int i = 0; i < 8; ++i) w1[8 + i] = t8[i]; ld8_f32(wdw + 2 * D + dc, t8);
#pragma unroll
      for (int i = 0; i < 8; ++i) w2[i] = t8[i]; ld8_f32(wdw + 2 * D + dc + 8, t8);
#pragma unroll
      for (int i = 0; i < 8; ++i) w2[8 + i] = t8[i]; }
    { v4u ng[2], n2[2], n1[2], n0[2];
#define CG_LOAD(tt_) do { const int t_ = (tt_), s_ = t_ & 2047, t1_ = s_ >= 1 ? t_ - 1 : t_, t0_ = s_ >= 2 ? t_ - 2 : t_; \
        _Pragma("unroll") for (int hf = 0; hf < 2; ++hf) { ng[hf] = *(const v4u*)(Bg + (size_t)t_ * D + dc + 8 * hf); n2[hf] = *(const v4u*)(U + (size_t)t_ * D + dc + 8 * hf); \
            n1[hf] = *(const v4u*)(U + (size_t)t1_ * D + dc + 8 * hf); n0[hf] = *(const v4u*)(U + (size_t)t0_ * D + dc + 8 * hf); } } while (0)
      if (gw < TP) CG_LOAD(gw);
      for (int t = gw; t < TP; t += NGW) {
          const int s = t & 2047; const float f1 = s >= 1 ? 1.f : 0.f, f0 = s >= 2 ? 1.f : 0.f;
          v4u cg[2], c2[2], c1[2], c0[2];
#pragma unroll
          for (int hf = 0; hf < 2; ++hf) { cg[hf] = ng[hf]; c2[hf] = n2[hf]; c1[hf] = n1[hf]; c0[hf] = n0[hf]; }
          CG_LOAD(t + NGW < TP ? t + NGW : t);
          float z[16]; float am = 0.f;
#pragma unroll
          for (int hf = 0; hf < 2; ++hf) { const unsigned wg[4] = {cg[hf].x, cg[hf].y, cg[hf].z, cg[hf].w}, w2_[4] = {c2[hf].x, c2[hf].y, c2[hf].z, c2[hf].w}, w1_[4] = {c1[hf].x, c1[hf].y, c1[hf].z, c1[hf].w}, w0_[4] = {c0[hf].x, c0[hf].y, c0[hf].z, c0[hf].w};
#pragma unroll
              for (int i = 0; i < 8; ++i) { const bool hi = i & 1; const int k = i >> 1;
                  const float g = hi ? bfhi(wg[k]) : bflo(wg[k]), u2 = hi ? bfhi(w2_[k]) : bflo(w2_[k]), u1 = (hi ? bfhi(w1_[k]) : bflo(w1_[k])) * f1, u0 = (hi ? bfhi(w0_[k]) : bflo(w0_[k])) * f0;
                  const float zz = g * (w0[8 * hf + i] * u0 + w1[8 * hf + i] * u1 + w2[8 * hf + i] * u2); z[8 * hf + i] = zz; am = __builtin_fmaxf(am, __builtin_fabsf(zz)); } }
#pragma unroll
          for (int o = 1; o < 64; o <<= 1) am = __builtin_fmaxf(am, shx(c.lane, am, o));
          const float k = am > 0.f ? 127.0f / am : 0.f;
          v4u q; q.x = q4_i8((f32x4){z[0], z[1], z[2], z[3]}, k); q.y = q4_i8((f32x4){z[4], z[5], z[6], z[7]}, k); q.z = q4_i8((f32x4){z[8], z[9], z[10], z[11]}, k); q.w = q4_i8((f32x4){z[12], z[13], z[14], z[15]}, k);
          *(v4u*)(z8 + (size_t)t * D + dc) = q;
          if (c.lane == 0) sz[t] = am * (1.0f / 127.0f);
      }
#undef CG_LOAD
    }
    for (int t = TP + gw; t < (skip_samp ? TP : T); t += NGW) {
        const bool samp = true; const int s = (t - TP) & 15; const int b = (t - TP) >> 4;
        float z[16]; float am = 0.f;
#pragma unroll
        for (int hf = 0; hf < 2; ++hf) { const int d0 = dc + 8 * hf;
            float u0[8], u1[8], u2[8], g[8];
            ld8_bf16(U + (size_t)t * D + d0, u2);
            { float* cdst = nullptr;
              (void)convp;
              if (samp && s >= DSEQ - 2) cdst = convs + ((size_t)b * 2 + (s - (DSEQ - 2))) * D + d0;
              if (cdst) { *(f32x4*)cdst = (f32x4){u2[0], u2[1], u2[2], u2[3]}; *(f32x4*)(cdst + 4) = (f32x4){u2[4], u2[5], u2[6], u2[7]}; } }
            if (s >= 1) ld8_bf16(U + (size_t)(t - 1) * D + d0, u1);
            else if (samp) ld8_f32(st + ((size_t)b * 2 + 1) * D + d0, u1);
            else {
#pragma unroll
                for (int i = 0; i < 8; ++i) u1[i] = 0.f; }
            if (s >= 2) ld8_bf16(U + (size_t)(t - 2) * D + d0, u0);
            else if (samp) ld8_f32(st + ((size_t)b * 2 + (s == 1 ? 1 : 0)) * D + d0, u0);
            else {
#pragma unroll
                for (int i = 0; i < 8; ++i) u0[i] = 0.f; }
            ld8_bf16(Bg + (size_t)t * D + d0, g);
#pragma unroll
            for (int i = 0; i < 8; ++i) { const float zz = g[i] * (w0[8 * hf + i] * u0[i] + w1[8 * hf + i] * u1[i] + w2[8 * hf + i] * u2[i]); z[8 * hf + i] = zz; am = __builtin_fmaxf(am, __builtin_fabsf(zz)); }
        }
        if (samp) {
            v4u o0, o1; o0.x = pk2(z[0], z[1]); o0.y = pk2(z[2], z[3]); o0.z = pk2(z[4], z[5]); o0.w = pk2(z[6], z[7]); o1.x = pk2(z[8], z[9]); o1.y = pk2(z[10], z[11]); o1.z = pk2(z[12], z[13]); o1.w = pk2(z[14], z[15]);
            *(v4u*)(Bg + (size_t)t * D + dc) = o0; *(v4u*)(Bg + (size_t)t * D + dc + 8) = o1; }
#pragma unroll
        for (int o = 1; o < 64; o <<= 1) am = __builtin_fmaxf(am, shx(c.lane, am, o));
        const float k = am > 0.f ? 127.0f / am : 0.f;
        v4u q; q.x = q4_i8((f32x4){z[0], z[1], z[2], z[3]}, k); q.y = q4_i8((f32x4){z[4], z[5], z[6], z[7]}, k); q.z = q4_i8((f32x4){z[8], z[9], z[10], z[11]}, k); q.w = q4_i8((f32x4){z[12], z[13], z[14], z[15]}, k);
        *(v4u*)(z8 + (size_t)t * D + dc) = q;
        if (c.lane == 0) sz[t] = am * (1.0f / 127.0f);
    }
}

DI void ln_phase(const Ctx c, const bf16* R, bf16* H, const float* g, const float* bb, float* yout = nullptr, const bf16* Hres = nullptr, unsigned char* x8 = nullptr, float* sx = nullptr) {
    const int gw = c.vcu * 8 + c.wave, NGW = c.G * 8;
    float gv[2][8], bv[2][8];
#pragma unroll
    for (int j = 0; j < 2; ++j) { ld8_f32(g + 8 * c.lane + 512 * j, gv[j]); ld8_f32(bb + 8 * c.lane + 512 * j, bv[j]); }
    v4u rw[2], hw[2];
#pragma unroll
    for (int j = 0; j < 2; ++j) { const int m0 = gw < T ? gw : 0; rw[j] = *(const v4u*)(R + (size_t)m0 * D + 8 * c.lane + 512 * j); hw[j] = Hres ? *(const v4u*)(Hres + (size_t)m0 * D + 8 * c.lane + 512 * j) : (v4u){0u, 0u, 0u, 0u}; }
    for (int m = gw; m < T; m += NGW) {
        float v[2][8]; float s = 0.f;
#pragma unroll
        for (int j = 0; j < 2; ++j) { const unsigned w[4] = {rw[j].x, rw[j].y, rw[j].z, rw[j].w}, hq[4] = {hw[j].x, hw[j].y, hw[j].z, hw[j].w};
#pragma unroll
            for (int i = 0; i < 4; ++i) { v[j][2 * i] = bflo(w[i]); v[j][2 * i + 1] = bfhi(w[i]); if (Hres) { v[j][2 * i] += bflo(hq[i]) * ALPHA; v[j][2 * i + 1] += bfhi(hq[i]) * ALPHA; } }
#pragma unroll
            for (int i = 0; i < 8; ++i) s += v[j][i]; }
        { const int mn = m + NGW < T ? m + NGW : m;
#pragma unroll
          for (int j = 0; j < 2; ++j) { rw[j] = *(const v4u*)(R + (size_t)mn * D + 8 * c.lane + 512 * j); if (Hres) hw[j] = *(const v4u*)(Hres + (size_t)mn * D + 8 * c.lane + 512 * j); } }
        const float mean = wave_sum(c.lane, s) * (1.f / D); float s2 = 0.f;
#pragma unroll
        for (int j = 0; j < 2; ++j)
#pragma unroll
            for (int i = 0; i < 8; ++i) { v[j][i] -= mean; s2 += v[j][i] * v[j][i]; }
        const float rstd = __builtin_amdgcn_rsqf(wave_sum(c.lane, s2) * (1.f / D) + LN_EPS);
        float am = 0.f;
#pragma unroll
        for (int j = 0; j < 2; ++j)
#pragma unroll
            for (int i = 0; i < 8; ++i) { v[j][i] = v[j][i] * rstd * gv[j][i] + bv[j][i]; am = __builtin_fmaxf(am, __builtin_fabsf(v[j][i])); }
        if (yout) {
#pragma unroll
            for (int j = 0; j < 2; ++j) { float* o = yout + (size_t)m * D + 8 * c.lane + 512 * j; *(f32x4*)o = (f32x4){v[j][0], v[j][1], v[j][2], v[j][3]}; *(f32x4*)(o + 4) = (f32x4){v[j][4], v[j][5], v[j][6], v[j][7]}; }
        } else {
#pragma unroll
            for (int j = 0; j < 2; ++j) { v4u w; w.x = pk2(v[j][0], v[j][1]); w.y = pk2(v[j][2], v[j][3]); w.z = pk2(v[j][4], v[j][5]); w.w = pk2(v[j][6], v[j][7]); *(v4u*)(H + (size_t)m * D + 8 * c.lane + 512 * j) = w; }
            if (x8) {
#pragma unroll
                for (int o = 1; o < 64; o <<= 1) am = __builtin_fmaxf(am, shx(c.lane, am, o));
                const float k = am > 0.f ? 127.0f / am : 0.f;
#pragma unroll
                for (int j = 0; j < 2; ++j) { v2u q; q.x = q4_i8((f32x4){v[j][0], v[j][1], v[j][2], v[j][3]}, k); q.y = q4_i8((f32x4){v[j][4], v[j][5], v[j][6], v[j][7]}, k); *(v2u*)(x8 + (size_t)m * D + 8 * c.lane + 512 * j) = q; }
                if (c.lane == 0) sx[m] = am * (1.0f / 127.0f);
            } }
    }
}

DI int ordi(float x) { const int b = __float_as_int(x); return b ^ ((b >> 31) & 0x7fffffff); }
DI float unordi(int o) { return __int_as_float(o ^ ((o >> 31) & 0x7fffffff)); }
#define TK_CE(a, b) do { const int _hi = (a) > (b) ? (a) : (b), _lo = (a) > (b) ? (b) : (a); (a) = _hi; (b) = _lo; } while (0)
#define TK_CPK(i, j) ((ordi(va[i] + vb[j]) & ~255) | (255 - ((i) * 16 + (j))))
#define TK_SORT16(v) do { TK_CE(v[0], v[1]); TK_CE(v[2], v[3]); TK_CE(v[0], v[2]); TK_CE(v[1], v[3]); TK_CE(v[1], v[2]); TK_CE(v[4], v[5]); TK_CE(v[6], v[7]); TK_CE(v[4], v[6]); TK_CE(v[5], v[7]); TK_CE(v[5], v[6]); TK_CE(v[0], v[4]); TK_CE(v[2], v[6]); TK_CE(v[2], v[4]); TK_CE(v[1], v[5]); TK_CE(v[3], v[7]); TK_CE(v[3], v[5]); TK_CE(v[1], v[2]); TK_CE(v[3], v[4]); TK_CE(v[5], v[6]); TK_CE(v[8], v[9]); TK_CE(v[10], v[11]); TK_CE(v[8], v[10]); TK_CE(v[9], v[11]); TK_CE(v[9], v[10]); TK_CE(v[12], v[13]); TK_CE(v[14], v[15]); TK_CE(v[12], v[14]); TK_CE(v[13], v[15]); TK_CE(v[13], v[14]); TK_CE(v[8], v[12]); TK_CE(v[10], v[14]); TK_CE(v[10], v[12]); TK_CE(v[9], v[13]); TK_CE(v[11], v[15]); TK_CE(v[11], v[13]); TK_CE(v[9], v[10]); TK_CE(v[11], v[12]); TK_CE(v[13], v[14]); TK_CE(v[0], v[8]); TK_CE(v[4], v[12]); TK_CE(v[4], v[8]); TK_CE(v[2], v[10]); TK_CE(v[6], v[14]); TK_CE(v[6], v[10]); TK_CE(v[2], v[4]); TK_CE(v[6], v[8]); TK_CE(v[10], v[12]); TK_CE(v[1], v[9]); TK_CE(v[5], v[13]); TK_CE(v[5], v[9]); TK_CE(v[3], v[11]); TK_CE(v[7], v[15]); TK_CE(v[7], v[11]); TK_CE(v[3], v[5]); TK_CE(v[7], v[9]); TK_CE(v[11], v[13]); TK_CE(v[1], v[2]); TK_CE(v[3], v[4]); TK_CE(v[5], v[6]); TK_CE(v[7], v[8]); TK_CE(v[9], v[10]); TK_CE(v[11], v[12]); TK_CE(v[13], v[14]); } while (0)
#define TK_BMERGE16(v) do { TK_CE(v[0], v[8]); TK_CE(v[1], v[9]); TK_CE(v[2], v[10]); TK_CE(v[3], v[11]); TK_CE(v[4], v[12]); TK_CE(v[5], v[13]); TK_CE(v[6], v[14]); TK_CE(v[7], v[15]); TK_CE(v[0], v[4]); TK_CE(v[1], v[5]); TK_CE(v[2], v[6]); TK_CE(v[3], v[7]); TK_CE(v[8], v[12]); TK_CE(v[9], v[13]); TK_CE(v[10], v[14]); TK_CE(v[11], v[15]); TK_CE(v[0], v[2]); TK_CE(v[1], v[3]); TK_CE(v[4], v[6]); TK_CE(v[5], v[7]); TK_CE(v[8], v[10]); TK_CE(v[9], v[11]); TK_CE(v[12], v[14]); TK_CE(v[13], v[15]); TK_CE(v[0], v[1]); TK_CE(v[2], v[3]); TK_CE(v[4], v[5]); TK_CE(v[6], v[7]); TK_CE(v[8], v[9]); TK_CE(v[10], v[11]); TK_CE(v[12], v[13]); TK_CE(v[14], v[15]); } while (0)
#define TK_CAND0(B) do { B[0] = TK_CPK(0, 0); B[1] = TK_CPK(0, 1); B[2] = TK_CPK(0, 2); B[3] = TK_CPK(0, 3); B[4] = TK_CPK(0, 4); B[5] = TK_CPK(0, 5); B[6] = TK_CPK(0, 6); B[7] = TK_CPK(0, 7); B[8] = TK_CPK(0, 8); B[9] = TK_CPK(0, 9); B[10] = TK_CPK(0, 10); B[11] = TK_CPK(0, 11); B[12] = TK_CPK(0, 12); B[13] = TK_CPK(0, 13); B[14] = TK_CPK(0, 14); B[15] = TK_CPK(0, 15); } while (0)
#define TK_CAND1(B) do { B[0] = TK_CPK(1, 0); B[1] = TK_CPK(1, 1); B[2] = TK_CPK(1, 2); B[3] = TK_CPK(1, 3); B[4] = TK_CPK(1, 4); B[5] = TK_CPK(1, 5); B[6] = TK_CPK(1, 6); B[7] = TK_CPK(1, 7); B[8] = TK_CPK(2, 0); B[9] = TK_CPK(2, 1); B[10] = TK_CPK(2, 2); B[11] = TK_CPK(2, 3); B[12] = TK_CPK(2, 4); B[13] = TK_CPK(3, 0); B[14] = TK_CPK(3, 1); B[15] = TK_CPK(3, 2); } while (0)
#define TK_CAND2(B) do { B[0] = TK_CPK(3, 3); B[1] = TK_CPK(4, 0); B[2] = TK_CPK(4, 1); B[3] = TK_CPK(4, 2); B[4] = TK_CPK(5, 0); B[5] = TK_CPK(5, 1); B[6] = TK_CPK(6, 0); B[7] = TK_CPK(6, 1); B[8] = TK_CPK(7, 0); B[9] = TK_CPK(7, 1); B[10] = TK_CPK(8, 0); B[11] = TK_CPK(9, 0); B[12] = TK_CPK(10, 0); B[13] = TK_CPK(11, 0); B[14] = TK_CPK(12, 0); B[15] = TK_CPK(13, 0); } while (0)
#define TK_CAND3(B) do { B[0] = TK_CPK(14, 0); B[1] = TK_CPK(15, 0); B[2] = (int)0x80000000; B[3] = (int)0x80000000; B[4] = (int)0x80000000; B[5] = (int)0x80000000; B[6] = (int)0x80000000; B[7] = (int)0x80000000; B[8] = (int)0x80000000; B[9] = (int)0x80000000; B[10] = (int)0x80000000; B[11] = (int)0x80000000; B[12] = (int)0x80000000; B[13] = (int)0x80000000; B[14] = (int)0x80000000; B[15] = (int)0x80000000; } while (0)
DI void tk_merge(int (&L)[16], const int (&B)[16]) {
#pragma unroll
    for (int i = 0; i < 16; ++i) L[i] = L[i] > B[15 - i] ? L[i] : B[15 - i];
    TK_BMERGE16(L);
}
DI void tk_feed32(int (&L)[16], const v4u (&x)[4], const int rb) {
#pragma unroll
    for (int hf = 0; hf < 2; ++hf) { int B[16]; const unsigned w[8] = {x[2 * hf].x, x[2 * hf].y, x[2 * hf].z, x[2 * hf].w, x[2 * hf + 1].x, x[2 * hf + 1].y, x[2 * hf + 1].z, x[2 * hf + 1].w};
#pragma unroll
        for (int j = 0; j < 16; ++j) B[j] = (ordi(__uint_as_float((j & 1) ? (w[j >> 1] & 0xffff0000u) : (w[j >> 1] << 16))) & ~127) | (127 - ((rb + 16 * hf + j) & 127));
        TK_SORT16(B); tk_merge(L, B); }
}
DI unsigned byte_of(unsigned a0, unsigned a1, unsigned a2, unsigned a3, int i) { const unsigned lo = i < 4 ? a0 : a1, hi = i < 12 ? a2 : a3, w = i < 8 ? lo : hi; return (w >> ((i & 3) * 8)) & 0xffu; }
DI void topk_phase(const Ctx c, const bf16* Sc  , unsigned short* ids, float* gates) {
    const int gw = c.wave * c.G + c.vcu, NGW = c.G * 8, NU = 8 * (T / 64);
    v4u bufA[4], bufB[4];
    if (gw < NU) { const v4u* sc = (const v4u*)(Sc + (size_t)((gw % (T / 64)) * 64 + c.lane) * 2048 + (gw / (T / 64)) * 256);
#pragma unroll
        for (int j = 0; j < 4; ++j) bufA[j] = sc[j]; }
#pragma unroll 1
    for (int wu = gw; wu < NU; wu += NGW) {
        const int h = wu / (T / 64), t = (wu % (T / 64)) * 64 + c.lane;
        const v4u* sc = (const v4u*)(Sc + (size_t)t * 2048 + h * 256);
        const int wn = wu + NGW < NU ? wu + NGW : wu;
        const v4u* scn = (const v4u*)(Sc + (size_t)((wn % (T / 64)) * 64 + c.lane) * 2048 + (wn / (T / 64)) * 256);
        int Lw[16], La[16];
#pragma unroll
        for (int i = 0; i < 16; ++i) { Lw[i] = (int)0x80000000; La[i] = 0; }
#pragma unroll 1
        for (int it = 0; it < 4; ++it) {
#pragma unroll
            for (int j = 0; j < 4; ++j) bufB[j] = sc[8 * it + 4 + j];
            tk_feed32(Lw, bufA, 64 * it);
            { const v4u* nx = it < 3 ? sc + 8 * (it + 1) : scn;
#pragma unroll
              for (int j = 0; j < 4; ++j) bufA[j] = nx[j]; }
            tk_feed32(Lw, bufB, 64 * it + 32);
            if (it == 1) {
#pragma unroll
                for (int i = 0; i < 16; ++i) { La[i] = Lw[i]; Lw[i] = (int)0x80000000; } }
        }
        float va[16], vb[16]; unsigned IA0 = 0u, IA1 = 0u, IA2 = 0u, IA3 = 0u, IB0 = 0u, IB1 = 0u, IB2 = 0u, IB3 = 0u;
#pragma unroll
        for (int i = 0; i < 16; ++i) { va[i] = unordi(La[i] & ~127); vb[i] = unordi(Lw[i] & ~127);
            const unsigned ea = (unsigned)(127 - (La[i] & 127)) << ((i & 3) * 8), eb = (unsigned)(127 - (Lw[i] & 127)) << ((i & 3) * 8);
            if ((i >> 2) == 0) { IA0 |= ea; IB0 |= eb; } else if ((i >> 2) == 1) { IA1 |= ea; IB1 |= eb; } else if ((i >> 2) == 2) { IA2 |= ea; IB2 |= eb; } else { IA3 |= ea; IB3 |= eb; } }
        int F[16];
        { int B[16]; TK_CAND0(B); TK_SORT16(B);
#pragma unroll
          for (int i = 0; i < 16; ++i) F[i] = B[i]; }
        { int B[16]; TK_CAND1(B); TK_SORT16(B); tk_merge(F, B); }
        { int B[16]; TK_CAND2(B); TK_SORT16(B); tk_merge(F, B); }
        { int B[16]; TK_CAND3(B); TK_SORT16(B); tk_merge(F, B); }
        float sc_[16], den = 0.f; unsigned ex[16];
        const float mx = unordi(F[0] & ~255);
#pragma unroll
        for (int k = 0; k < 16; ++k) { const int code = 255 - (F[k] & 255); sc_[k] = __builtin_amdgcn_exp2f((unordi(F[k] & ~255) - mx) * LOG2E); den += sc_[k];
            ex[k] = byte_of(IA0, IA1, IA2, IA3, code >> 4) * 128u + byte_of(IB0, IB1, IB2, IB3, code & 15); }
        const float inv = 1.0f / den;
        v4u e0, e1; e0.x = ex[0] | (ex[1] << 16); e0.y = ex[2] | (ex[3] << 16); e0.z = ex[4] | (ex[5] << 16); e0.w = ex[6] | (ex[7] << 16);
        e1.x = ex[8] | (ex[9] << 16); e1.y = ex[10] | (ex[11] << 16); e1.z = ex[12] | (ex[13] << 16); e1.w = ex[14] | (ex[15] << 16);
        v4u* ip = (v4u*)(ids + (size_t)t * 128 + h * 16); ip[0] = e0; ip[1] = e1;
        f32x4* gp = (f32x4*)(gates + (size_t)t * 128 + h * 16);
#pragma unroll
        for (int k = 0; k < 4; ++k) gp[k] = (f32x4){sc_[4 * k] * inv, sc_[4 * k + 1] * inv, sc_[4 * k + 2] * inv, sc_[4 * k + 3] * inv};
    }
}

typedef float f2 __attribute__((ext_vector_type(2)));
constexpr int QCH = 16, QN = T / QCH;
static_assert(T % QCH == 0, "queue chunks");
struct ChunkQ { int xme, s; unsigned pend; unsigned* q; };
struct Chunk { int base, xs; };
DI unsigned cq_ticket(unsigned* qw, int lane) { unsigned v = 0u; if (lane == 0) v = __hip_atomic_fetch_add(qw, 1u, __ATOMIC_RELAXED, __HIP_MEMORY_SCOPE_AGENT); return v; }
DI void cq_init(ChunkQ& g, unsigned* q, int lane) { g.xme = (int)(xb_xcc_id() & 7u); g.s = 0; g.q = q; g.pend = cq_ticket(q + g.xme * 64, lane); }
DI Chunk cq_next(ChunkQ& g, int lane) {
    for (;;) {
        if (g.s >= 8) return Chunk{-1, 0};
        const unsigned chunk = (unsigned)__builtin_amdgcn_readfirstlane((int)g.pend); const int xs = (g.xme + g.s) & 7;
        if (chunk < (unsigned)QN) { g.pend = cq_ticket(g.q + xs * 64, lane); return Chunk{(int)chunk * QCH, xs}; }
        ++g.s; if (g.s < 8) g.pend = cq_ticket(g.q + ((g.xme + g.s) & 7) * 64, lane);
    }
}
struct SliceIds { v4u ia, ib; int t, xs; };
struct SliceAux { v4u a0; float s; };
DI SliceIds slice_load_ids(const int t, const int xs, const int lane, const unsigned short* ids) {
    const int j = lane >> 3, tc = t < 0 ? 0 : t; SliceIds r; r.t = t; r.xs = xs;
    r.ia = *(const v4u*)(ids + (size_t)tc * 128 + 16 * j); r.ib = *(const v4u*)(ids + (size_t)tc * 128 + 16 * j + 8); return r;
}
template <int MODE>
DI SliceAux slice_load_aux(const int t, const int xs, const int lane, const unsigned char* x8, const unsigned char* w8, const float* sw) {
    const int j = lane >> 3, i = lane & 7, tc = t < 0 ? 0 : t; SliceAux r;
    if (MODE == 0) { r.a0 = *(const v4u*)(x8 + (size_t)tc * D + 128 * xs + 16 * i); r.s = 0.f; }
    else { r.a0 = *(const v4u*)(w8 + (size_t)tc * 128 + 16 * j); r.s = sw[tc]; }
    return r;
}
template <int VAR>
DI void slice_issue(v4u (&vr)[16], const SliceIds& n, const unsigned char* T8, const int lane) {
    const unsigned char* base = T8 + (size_t)n.xs * NEXP * 128 + 16 * (lane & 7);
    const unsigned idv[8] = {n.ia.x, n.ia.y, n.ia.z, n.ia.w, n.ib.x, n.ib.y, n.ib.z, n.ib.w};
#pragma unroll
    for (int g = 0; g < 16; ++g) { unsigned e = (g & 1) ? (idv[g >> 1] >> 16) : (idv[g >> 1] & 0xffffu); if (VAR == 2) e &= 15u; vr[g] = *(const v4u*)(base + (size_t)e * 128); }
}
DI int dot16_i8(const v4u a, const v4u b, int acc) {
    acc = __builtin_amdgcn_sdot4((int)a.x, (int)b.x, acc, false); acc = __builtin_amdgcn_sdot4((int)a.y, (int)b.y, acc, false);
    acc = __builtin_amdgcn_sdot4((int)a.z, (int)b.z, acc, false); acc = __builtin_amdgcn_sdot4((int)a.w, (int)b.w, acc, false); return acc;
}
DI void tr4_dot(int& c0, int& c1, int& c2, int& c3, const unsigned a, const unsigned b, const unsigned cc, const unsigned d, const int w) {
    const unsigned p = __builtin_amdgcn_perm(b, a, 0x05010400u), q = __builtin_amdgcn_perm(b, a, 0x07030602u), r = __builtin_amdgcn_perm(d, cc, 0x05010400u), s = __builtin_amdgcn_perm(d, cc, 0x07030602u);
    c0 = __builtin_amdgcn_sdot4((int)__builtin_amdgcn_perm(r, p, 0x05040100u), w, c0, false); c1 = __builtin_amdgcn_sdot4((int)__builtin_amdgcn_perm(r, p, 0x07060302u), w, c1, false);
    c2 = __builtin_amdgcn_sdot4((int)__builtin_amdgcn_perm(s, q, 0x05040100u), w, c2, false); c3 = __builtin_amdgcn_sdot4((int)__builtin_amdgcn_perm(s, q, 0x07060302u), w, c3, false);
}
template <int MODE, int VAR>
DI void slice_compute(const int lane, const v4u (&vr)[16], const int t, const int xs, const SliceAux& n, float* OUT) {
    const int j = lane >> 3, i = lane & 7;
    if (VAR == 1) {
        unsigned x = n.a0.x ^ n.a0.y;
#pragma unroll
        for (int g = 0; g < 16; ++g) x ^= vr[g].x ^ vr[g].y ^ vr[g].z ^ vr[g].w;
        *(unsigned*)((bf16*)OUT + (size_t)t * D + 128 * xs + 2 * lane) = x;
    } else if (MODE == 0) {
        int d[16];
#pragma unroll
        for (int g = 0; g < 16; ++g) d[g] = dot16_i8(vr[g], n.a0, 0);
        int r8[8], r4[4], r2[2];
#pragma unroll
        for (int q = 0; q < 8; ++q) { const bool od = lane & 1; const int keep = od ? d[8 + q] : d[q], send = od ? d[q] : d[8 + q]; r8[q] = keep + shx(lane, send, 1); }
#pragma unroll
        for (int q = 0; q < 4; ++q) { const bool od = lane & 2; const int keep = od ? r8[4 + q] : r8[q], send = od ? r8[q] : r8[4 + q]; r4[q] = keep + shx(lane, send, 2); }
#pragma unroll
        for (int q = 0; q < 2; ++q) { const bool od = lane & 4; const int keep = od ? r4[2 + q] : r4[q], send = od ? r4[q] : r4[2 + q]; r2[q] = keep + shx(lane, send, 4); }
        const int g0 = 8 * (i & 1) + 4 * ((i >> 1) & 1) + 2 * (i >> 2);
        *((unsigned*)OUT + ((size_t)xs * T + t) * 64 + 8 * j + (g0 >> 1)) = ((unsigned)((r2[0] + 32) >> 6) & 0xffffu) | ((unsigned)((r2[1] + 32) >> 6) << 16);
    } else {
        int acc[16];
#pragma unroll
        for (int q = 0; q < 16; ++q) acc[q] = 0;
        const int w4[4] = {(int)n.a0.x, (int)n.a0.y, (int)n.a0.z, (int)n.a0.w};
#pragma unroll
        for (int gq = 0; gq < 4; ++gq) {
            tr4_dot(acc[0], acc[1], acc[2], acc[3], vr[4 * gq].x, vr[4 * gq + 1].x, vr[4 * gq + 2].x, vr[4 * gq + 3].x, w4[gq]);
            tr4_dot(acc[4], acc[5], acc[6], acc[7], vr[4 * gq].y, vr[4 * gq + 1].y, vr[4 * gq + 2].y, vr[4 * gq + 3].y, w4[gq]);
            tr4_dot(acc[8], acc[9], acc[10], acc[11], vr[4 * gq].z, vr[4 * gq + 1].z, vr[4 * gq + 2].z, vr[4 * gq + 3].z, w4[gq]);
            tr4_dot(acc[12], acc[13], acc[14], acc[15], vr[4 * gq].w, vr[4 * gq + 1].w, vr[4 * gq + 2].w, vr[4 * gq + 3].w, w4[gq]);
        }
        int r8[8], r4[4], r2[2];
#pragma unroll
        for (int q = 0; q < 8; ++q) { const bool od = lane & 8; const int keep = od ? acc[8 + q] : acc[q], send = od ? acc[q] : acc[8 + q]; r8[q] = keep + shx(lane, send, 8); }
#pragma unroll
        for (int q = 0; q < 4; ++q) { const bool od = lane & 16; const int keep = od ? r8[4 + q] : r8[q], send = od ? r8[q] : r8[4 + q]; r4[q] = keep + shx(lane, send, 16); }
#pragma unroll
        for (int q = 0; q < 2; ++q) { const bool od = lane & 32; const int keep = od ? r4[2 + q] : r4[q], send = od ? r4[q] : r4[2 + q]; r2[q] = keep + shx(lane, send, 32); }
        const int dim = 128 * xs + 16 * i + 8 * (j & 1) + 4 * ((j >> 1) & 1) + 2 * (j >> 2);
        const float s = n.s;
        *(unsigned*)((bf16*)OUT + (size_t)t * D + dim) = pk2((float)r2[0] * s, (float)r2[1] * s);
    }
}
template <int MODE, int VAR = 0>
DI void slice_pass(const Ctx c, const unsigned char* x8, const unsigned short* ids, const unsigned char* w8, const float* sw, const unsigned char* T8, float* OUT, unsigned* q) {
    ChunkQ g; cq_init(g, q, c.lane);
    Chunk cur = cq_next(g, c.lane); if (cur.base < 0) return;
    Chunk nxt = cq_next(g, c.lane);
#define SLICE_TOK_T(p) ((p) < QCH ? cur.base + (p) : (nxt.base >= 0 ? nxt.base + (p) - QCH : -1))
#define SLICE_TOK_X(p) ((p) < QCH ? cur.xs : nxt.xs)
    SliceIds i0 = slice_load_ids(SLICE_TOK_T(0), SLICE_TOK_X(0), c.lane, ids), i1 = slice_load_ids(SLICE_TOK_T(1), SLICE_TOK_X(1), c.lane, ids),
             i2 = slice_load_ids(SLICE_TOK_T(2), SLICE_TOK_X(2), c.lane, ids), i3 = slice_load_ids(SLICE_TOK_T(3), SLICE_TOK_X(3), c.lane, ids);
    SliceAux x0 = slice_load_aux<MODE>(i0.t, i0.xs, c.lane, x8, w8, sw), x1 = slice_load_aux<MODE>(i1.t, i1.xs, c.lane, x8, w8, sw);
    v4u A[16], B[16];
    slice_issue<VAR>(A, i0, T8, c.lane);
#define SLICE_STEP(K, CUR, NXT, IK, IK1, XK) do { slice_issue<VAR>(NXT, IK1, T8, c.lane); \
        slice_compute<MODE, VAR>(c.lane, CUR, IK.t, IK.xs, XK, OUT); \
        XK = slice_load_aux<MODE>(SLICE_TOK_T(pg + (K) + 2), SLICE_TOK_X(pg + (K) + 2), c.lane, x8, w8, sw); \
        IK = slice_load_ids(SLICE_TOK_T(pg + (K) + 4), SLICE_TOK_X(pg + (K) + 4), c.lane, ids); } while (0)
    for (;;) {
#pragma unroll 2
        for (int pg = 0; pg < QCH; pg += 4) {
            SLICE_STEP(0, A, B, i0, i1, x0);
            SLICE_STEP(1, B, A, i1, i2, x1);
            SLICE_STEP(2, A, B, i2, i3, x0);
            SLICE_STEP(3, B, A, i3, i0, x1);
        }
        cur = nxt; if (cur.base < 0) break;
        nxt = cq_next(g, c.lane);
    }
#undef SLICE_STEP
#undef SLICE_TOK_T
#undef SLICE_TOK_X
}
struct WpA { f32x4 s; v2u iw; f32x4 g; float st; };
struct WpB { f32x4 su, sv; };
DI WpA wp_load_a(const size_t idx, const float* part, const unsigned short* ids, const float* gates, const float* sx) {
    WpA a; v2u p[8];
#pragma unroll
    for (int x = 0; x < 8; ++x) p[x] = *(const v2u*)((const unsigned short*)part + (size_t)x * T * 128 + idx * 4);
    a.iw = *(const v2u*)(ids + idx * 4); a.g = *(const f32x4*)(gates + idx * 4); a.st = sx[idx >> 5] * 64.0f;
    int s0 = 0, s1 = 0, s2 = 0, s3 = 0;
#pragma unroll
    for (int x = 0; x < 8; ++x) { s0 += (int)(short)(p[x].x & 0xffffu); s1 += (int)p[x].x >> 16; s2 += (int)(short)(p[x].y & 0xffffu); s3 += (int)p[x].y >> 16; }
    a.s = (f32x4){(float)s0, (float)s1, (float)s2, (float)s3}; return a;
}
DI WpB wp_load_b(const WpA& a, const float* SU, const float* SV) {
    const unsigned e[4] = {a.iw.x & 0xffffu, a.iw.x >> 16, a.iw.y & 0xffffu, a.iw.y >> 16}; WpB b;
#pragma unroll
    for (int k = 0; k < 4; ++k) { const f2 p = *(const f2*)(SU + 2 * e[k]); b.su[k] = p.x; b.sv[k] = p.y; }
    (void)SV;
    return b;
}
DI void peer_w_phase(const Ctx c, const float* part, const unsigned short* ids, const float* gates, unsigned char* w8, float* sw, const float* sx, const float* SU, const float* SV) {
    const size_t NT = (size_t)c.G * 512, NI = (size_t)T * 32, i0 = (size_t)c.vcu * 512 + c.tid;
    WpA a0 = wp_load_a(i0 < NI ? i0 : 0, part, ids, gates, sx), a1 = wp_load_a(i0 + NT < NI ? i0 + NT : 0, part, ids, gates, sx);
    WpB b0 = wp_load_b(a0, SU, SV);
    for (size_t idx = i0; idx < NI; idx += NT) {
        const WpA a2 = wp_load_a(idx + 2 * NT < NI ? idx + 2 * NT : 0, part, ids, gates, sx);
        const WpB b1 = wp_load_b(a1, SU, SV);
        f32x4 g = a0.g; float am = 0.f;
#pragma unroll
        for (int k = 0; k < 4; ++k) { g[k] = g[k] * gelu_erf(a0.s[k] * (a0.st * b0.su[k])) * b0.sv[k]; am = __builtin_fmaxf(am, __builtin_fabsf(g[k])); }
#pragma unroll
        for (int o = 1; o < 32; o <<= 1) am = __builtin_fmaxf(am, shx(c.lane, am, o));
        *(unsigned*)(w8 + idx * 4) = q4_i8(g, am > 0.f ? 127.0f / am : 0.f);
        if ((c.tid & 31) == 0) sw[idx >> 5] = am * (1.0f / 127.0f);
        a0 = a1; a1 = a2; b0 = b1;
    }
}

DI int pi_row(int m) { return 16 * (m >> 4) + 8 * ((m >> 2) & 1) + 4 * ((m >> 3) & 1) + (m & 3); }
struct AttnT { const bf16* Q; bf16* O; const bf16* Kb; const bf16* VT; const bf16* Vsn; const float* ck; const float* cv; };
template <int MODE>
DI void attn_load(const AttnT A, const int b, const int h, const int kt, const int q, const int hh, const int piq, bf16x8 (&kf)[4], bf16x8 (&vf)[2][2]) {
    if (MODE == 0) {
        const bf16* kr = A.Kb + ((size_t)b * SEQ + kt * 32 + piq) * D + h * DH + 8 * hh;
#pragma unroll
        for (int s = 0; s < 4; ++s) kf[s] = *(const bf16x8*)(kr + 16 * s);
        const bf16* vr = A.VT + (((size_t)b * NH + h) * (SEQ / 32) + kt) * (DH * 32) + q * 32 + 8 * hh;
#pragma unroll
        for (int mt = 0; mt < 2; ++mt)
#pragma unroll
            for (int s = 0; s < 2; ++s) vf[mt][s] = *(const bf16x8*)(vr + mt * 32 * 32 + 16 * s);
    } else if (kt == PAST / 32) {
        const int ko = piq < 16 ? piq : 15;
        const bf16* kr = A.Kb + ((size_t)TP + b * DSEQ + ko) * D + h * DH + 8 * hh;
#pragma unroll
        for (int s = 0; s < 4; ++s) kf[s] = *(const bf16x8*)(kr + 16 * s);
#pragma unroll
        for (int mt = 0; mt < 2; ++mt)
#pragma unroll
            for (int s = 0; s < 2; ++s) { bf16x8 v;
#pragma unroll
                for (int j = 0; j < 8; ++j) { const int kk = 16 * s + 8 * hh + j; v[j] = (short)A.Vsn[((size_t)b * DSEQ + (kk < 16 ? kk : 15)) * D + h * DH + 32 * mt + q]; }
                vf[mt][s] = v; }
    } else {
        const float* kr = A.ck + (((size_t)b * PAST + kt * 32 + piq) * NH + h) * DH + 8 * hh;
#pragma unroll
        for (int s = 0; s < 4; ++s) { const f32x4 x0 = *(const f32x4*)(kr + 16 * s), x1 = *(const f32x4*)(kr + 16 * s + 4); kf[s] = pack8(x0[0], x0[1], x0[2], x0[3], x1[0], x1[1], x1[2], x1[3]); }
#pragma unroll
        for (int mt = 0; mt < 2; ++mt)
#pragma unroll
            for (int s = 0; s < 2; ++s) { float x[8];
#pragma unroll
                for (int j = 0; j < 8; ++j) x[j] = A.cv[(((size_t)b * PAST + kt * 32 + 16 * s + 8 * hh + j) * NH + h) * DH + 32 * mt + q];
                vf[mt][s] = pack8(x[0], x[1], x[2], x[3], x[4], x[5], x[6], x[7]); }
    }
}
template <int MODE>
DI void attn_qtile(const AttnT A, int b, int h, int qi, int lane, const bf16x8 (&ut)[2]) {
    const int q = lane & 31, hh = lane >> 5, piq = pi_row(q);
    const size_t qrow = MODE == 0 ? (size_t)b * SEQ + qi * 32 + q : (size_t)TP + b * DSEQ + (q < 16 ? q : 15);
    const int qpos = MODE == 0 ? qi * 32 + q : (q < 16 ? PAST + q : 0);
    bf16x8 qf[4];
#pragma unroll
    for (int s = 0; s < 4; ++s) qf[s] = *(const bf16x8*)(A.Q + qrow * D + h * DH + 16 * s + 8 * hh);
    f32x16 o0, o1;
#pragma unroll
    for (int i = 0; i < 16; ++i) { o0[i] = 0.f; o1[i] = 0.f; }
    float carry = 0.f;
    const int kt0 = MODE == 0 ? qi : PAST / 32;
    bf16x8 kf[4], vf[2][2];
    attn_load<MODE>(A, b, h, kt0, q, hh, piq, kf, vf);
    for (int kt = kt0; kt >= 0; --kt) {
        bf16x8 kn[4], vn[2][2];
        attn_load<MODE>(A, b, h, kt > 0 ? kt - 1 : 0, q, hh, piq, kn, vn);
        f32x16 S;
#pragma unroll
        for (int i = 0; i < 16; ++i) S[i] = 0.f;
#pragma unroll
        for (int s = 0; s < 4; ++s) S = MFMA32(kf[s], qf[s], S);
        const int kbase = kt * 32 + 8 * hh;
        float L[16], lw[16];
#pragma unroll
        for (int r = 0; r < 16; ++r) {
            const bool valid = (kbase + 16 * (r >> 3) + (r & 7)) < qpos;
            const float z = S[r], sp = __builtin_fmaxf(z, 0.f) + __builtin_amdgcn_logf(1.0f + __builtin_amdgcn_exp2f(-__builtin_fabsf(z)));
            L[r] = valid ? -sp : 0.f; lw[r] = valid ? (z - sp) : -1e30f;
        }
        f32x16 suf;
#pragma unroll
        for (int i = 0; i < 16; ++i) suf[i] = 0.f;
        suf = MFMA32(ut[0], pack8(L[0], L[1], L[2], L[3], L[4], L[5], L[6], L[7]), suf);
        suf = MFMA32(ut[1], pack8(L[8], L[9], L[10], L[11], L[12], L[13], L[14], L[15]), suf);
        float a[16];
#pragma unroll
        for (int r = 0; r < 16; ++r) a[r] = __builtin_amdgcn_exp2f(lw[r] + suf[r] + carry);
        carry += __int_as_float(__builtin_amdgcn_ds_bpermute(q << 2, __float_as_int(suf[0] + L[0])));
        const bf16x8 p0 = pack8(a[0], a[1], a[2], a[3], a[4], a[5], a[6], a[7]), p1 = pack8(a[8], a[9], a[10], a[11], a[12], a[13], a[14], a[15]);
        o0 = MFMA32(vf[0][0], p0, o0); o0 = MFMA32(vf[0][1], p1, o0);
        o1 = MFMA32(vf[1][0], p0, o1); o1 = MFMA32(vf[1][1], p1, o1);
        if (__builtin_amdgcn_ballot_w64(qpos > 0 && carry > -24.0f * LOG2E) == 0ull) break;
#pragma unroll
        for (int s = 0; s < 4; ++s) kf[s] = kn[s];
#pragma unroll
        for (int mt = 0; mt < 2; ++mt)
#pragma unroll
            for (int s = 0; s < 2; ++s) vf[mt][s] = vn[mt][s];
    }
    if (MODE == 0 || q < 16) {
        bf16* orow = A.O + qrow * D + h * DH + 4 * hh;
#pragma unroll
        for (int g = 0; g < 4; ++g) {
            v2u w0, w1; w0.x = pk2(o0[4 * g], o0[4 * g + 1]); w0.y = pk2(o0[4 * g + 2], o0[4 * g + 3]); w1.x = pk2(o1[4 * g], o1[4 * g + 1]); w1.y = pk2(o1[4 * g + 2], o1[4 * g + 3]);
            *(v2u*)(orow + 8 * g) = w0; *(v2u*)(orow + 32 + 8 * g) = w1; }
    }
}
DI void attn_phase(const Ctx c, const AttnT A) {
    const int q = c.lane & 31, hh = c.lane >> 5, piq = pi_row(q);
    bf16x8 ut[2];
#pragma unroll
    for (int s = 0; s < 2; ++s)
#pragma unroll
        for (int j = 0; j < 8; ++j) ut[s][j] = (16 * s + 8 * hh + j > piq) ? (short)0x3f80 : (short)0;
    for (int bu = c.vcu; bu < NB * NH * 4; bu += c.G) {
        const int bh = bu >> 2, b = bh >> 4, h = bh & 15, p = (bu & 3) * 8 + c.wave;
        attn_qtile<0>(A, b, h, 63 - p, c.lane, ut);
        attn_qtile<0>(A, b, h, p, c.lane, ut);
    }
    for (int su = c.wave * c.G + c.vcu; su < NB * NH; su += c.G * 8) attn_qtile<1>(A, su >> 4, su & 15, 0, c.lane, ut);
}

DI void vt_phase(const Ctx c, LAS unsigned char* lds, const bf16* Vb, bf16* VT, bf16* Vsn) {
    LAS unsigned char* scr = lds + c.wave * 16384;
    const int gw = c.vcu * 8 + c.wave, NGW = c.G * 8;
    for (int wt = gw; wt < (TP / 64) * 16; wt += NGW) {
        const int tt = wt >> 4, ht = wt & 15;
        v4u vin[8];
#pragma unroll
        for (int j = 0; j < 8; ++j) vin[j] = *(const v4u*)(Vb + (size_t)(tt * 64 + (c.lane >> 3) + 8 * j) * D + ht * 64 + (c.lane & 7) * 8);
        __builtin_amdgcn_sched_barrier(0);
#pragma unroll
        for (int j = 0; j < 8; ++j) { const int row = (c.lane >> 3) + 8 * j, ch = c.lane & 7;
            LAS unsigned* d = (LAS unsigned*)(scr + row * 132 + ch * 16); d[0] = vin[j].x; d[1] = vin[j].y; d[2] = vin[j].z; d[3] = vin[j].w; }
        LDS_WAIT(); asm volatile("" ::: "memory");
#pragma unroll
        for (int j = 0; j < 8; ++j) { const int orow = (c.lane >> 3) + 8 * j, ch = c.lane & 7;
            unsigned short e[8];
#pragma unroll
            for (int i = 0; i < 8; ++i) e[i] = *(const LAS unsigned short*)(scr + (ch * 8 + i) * 132 + orow * 2);
            v4u o; o.x = e[0] | ((unsigned)e[1] << 16); o.y = e[2] | ((unsigned)e[3] << 16); o.z = e[4] | ((unsigned)e[5] << 16); o.w = e[6] | ((unsigned)e[7] << 16);
            { const int bb = tt >> 5, kt = 2 * (tt & 31) + (ch >> 2);
              *(v4u*)(VT + (((size_t)bb * NH + ht) * (SEQ / 32) + kt) * (DH * 32) + orow * 32 + 8 * (ch & 3)) = o; } }
        LDS_WAIT(); asm volatile("" ::: "memory");
    }
    const size_t NT = (size_t)c.G * 512;
    for (size_t i = (size_t)c.vcu * 512 + c.tid; i < (size_t)TS * D / 8; i += NT) *(v4u*)(Vsn + i * 8) = *(const v4u*)(Vb + (size_t)TP * D + i * 8);
}

DI f32x16 sg_tile(const bf16* wr  , const bf16* xr  ) {
    f32x16 acc;
#pragma unroll
    for (int i = 0; i < 16; ++i) acc[i] = 0.f;
    bf16x8 wa[8], xa[8], wb[8], xb[8];
#pragma unroll
    for (int j = 0; j < 8; ++j) { wa[j] = *(const bf16x8*)(wr + 16 * j); xa[j] = *(const bf16x8*)(xr + 16 * j); }
#pragma unroll 1
    for (int k0 = 0; k0 < 64; k0 += 16) {
#pragma unroll
        for (int j = 0; j < 8; ++j) { wb[j] = *(const bf16x8*)(wr + 16 * (k0 + 8 + j)); xb[j] = *(const bf16x8*)(xr + 16 * (k0 + 8 + j)); }
        __builtin_amdgcn_sched_barrier(0);
#pragma unroll
        for (int j = 0; j < 8; ++j) acc = MFMA32(wa[j], xa[j], acc);
        __builtin_amdgcn_sched_barrier(0);
        { const int kn = k0 + 16 < 64 ? k0 + 16 : 0;
#pragma unroll
          for (int j = 0; j < 8; ++j) { wa[j] = *(const bf16x8*)(wr + 16 * (kn + j)); xa[j] = *(const bf16x8*)(xr + 16 * (kn + j)); } }
        __builtin_amdgcn_sched_barrier(0);
#pragma unroll
        for (int j = 0; j < 8; ++j) acc = MFMA32(wb[j], xb[j], acc);
        __builtin_amdgcn_sched_barrier(0);
    }
    return acc;
}
DI void sg_gate(const Ctx c, const bf16* Hall  , const bf16* Wl  , bf16* U, bf16* Bg, float* convp  ) {
    const int q = c.lane & 31, hh = c.lane >> 5;
    for (int tile = c.wave * c.G + c.vcu; tile < 18 * 32; tile += c.G * 8) {
        const int tt = tile % 18, dt = tile / 18, d = 32 * dt + q, crow = 256 * (d >> 7) + (d & 127);
        const bool cs = tt >= 16; const int kk = (tt - 16) * 32 + q;
        const size_t row = cs ? (size_t)(kk >> 1) * SEQ + (SEQ - 2) + (kk & 1) : (size_t)TP + tt * 32 + q;
        const bf16* xr = Hall + row * D + 8 * hh;
        const bf16* wc = Wl + (size_t)crow * D + 8 * hh; const bf16* wx = wc + (size_t)128 * D; const bf16* wb = Wl + (size_t)(2048 + d) * D + 8 * hh;
        f32x16 ac, ax, ab;
#pragma unroll
        for (int i = 0; i < 16; ++i) { ac[i] = 0.f; ax[i] = 0.f; ab[i] = 0.f; }
        { bf16x8 fx[4], fc[4], fxx[4], fb[4], gx[4], gc[4], gxx[4], gb[4];
#pragma unroll
          for (int j = 0; j < 4; ++j) { fx[j] = *(const bf16x8*)(xr + 16 * j); fc[j] = *(const bf16x8*)(wc + 16 * j); fxx[j] = *(const bf16x8*)(wx + 16 * j); fb[j] = *(const bf16x8*)(wb + 16 * j); }
#pragma unroll 1
          for (int k0 = 0; k0 < 64; k0 += 8) {
#pragma unroll
              for (int j = 0; j < 4; ++j) { gx[j] = *(const bf16x8*)(xr + 16 * (k0 + 4 + j)); gc[j] = *(const bf16x8*)(wc + 16 * (k0 + 4 + j)); gxx[j] = *(const bf16x8*)(wx + 16 * (k0 + 4 + j)); gb[j] = *(const bf16x8*)(wb + 16 * (k0 + 4 + j)); }
              __builtin_amdgcn_sched_barrier(0);
#pragma unroll
              for (int j = 0; j < 4; ++j) { ac = MFMA32(fc[j], fx[j], ac); ax = MFMA32(fxx[j], fx[j], ax); ab = MFMA32(fb[j], fx[j], ab); }
              __builtin_amdgcn_sched_barrier(0);
              { const int kn = k0 + 8 < 64 ? k0 + 8 : 0;
#pragma unroll
                for (int j = 0; j < 4; ++j) { fx[j] = *(const bf16x8*)(xr + 16 * (kn + j)); fc[j] = *(const bf16x8*)(wc + 16 * (kn + j)); fxx[j] = *(const bf16x8*)(wx + 16 * (kn + j)); fb[j] = *(const bf16x8*)(wb + 16 * (kn + j)); } }
              __builtin_amdgcn_sched_barrier(0);
#pragma unroll
              for (int j = 0; j < 4; ++j) { ac = MFMA32(gc[j], gx[j], ac); ax = MFMA32(gxx[j], gx[j], ax); ab = MFMA32(gb[j], gx[j], ab); }
              __builtin_amdgcn_sched_barrier(0);
          } }
        if (cs) {
            float* cd = convp + (size_t)kk * D + 32 * dt + 4 * hh;
#pragma unroll
            for (int g = 0; g < 4; ++g) *(f32x4*)(cd + 8 * g) = (f32x4){ac[4 * g] * ax[4 * g], ac[4 * g + 1] * ax[4 * g + 1], ac[4 * g + 2] * ax[4 * g + 2], ac[4 * g + 3] * ax[4 * g + 3]};
        } else {
            const size_t ro = row * D + 32 * dt + 4 * hh;
#pragma unroll
            for (int g = 0; g < 4; ++g) { v2u wu, wb2; wu.x = pk2(ac[4 * g] * ax[4 * g], ac[4 * g + 1] * ax[4 * g + 1]); wu.y = pk2(ac[4 * g + 2] * ax[4 * g + 2], ac[4 * g + 3] * ax[4 * g + 3]);
                wb2.x = pk2(ab[4 * g], ab[4 * g + 1]); wb2.y = pk2(ab[4 * g + 2], ab[4 * g + 3]);
                *(v2u*)(U + ro + 8 * g) = wu; *(v2u*)(Bg + ro + 8 * g) = wb2; }
        }
    }
}
template <int MODE>
DI void sg_plain(const Ctx c, const bf16* Xs, const bf16* Wt, const int N, bf16* O, const bf16* Hres, bf16* O2, float* f0, float* f1) {
    const int q = c.lane & 31, hh = c.lane >> 5;
    for (int tile = c.wave * c.G + c.vcu; tile < 16 * (N / 32); tile += c.G * 8) {
        const int tt = tile & 15, ft = tile >> 4;
        const f32x16 acc = sg_tile(Wt + (size_t)(ft * 32 + q) * D + 8 * hh, Xs + (size_t)(tt * 32 + q) * D + 8 * hh);
        const int tl = tt * 32 + q;
#pragma unroll
        for (int g = 0; g < 4; ++g) { const int f = 32 * ft + 8 * g + 4 * hh; const f32x4 v = {acc[4 * g], acc[4 * g + 1], acc[4 * g + 2], acc[4 * g + 3]};
            if (MODE == 0) { v2u w; w.x = pk2(v[0], v[1]); w.y = pk2(v[2], v[3]); *(v2u*)(O + (size_t)(TP + tl) * D + f) = w; }
            else if (MODE == 1) { const v2u hw = *(const v2u*)(Hres + (size_t)(TP + tl) * D + f); const f32x4 r = (f32x4){bflo(hw.x), bfhi(hw.x), bflo(hw.y), bfhi(hw.y)} * ALPHA + v;
                v2u w; w.x = pk2(r[0], r[1]); w.y = pk2(r[2], r[3]); *(v2u*)(O + (size_t)(TP + tl) * D + f) = w; }
            else if (MODE == 2) { const bool isv = f >= 1024; const int fc = isv ? f - 1024 : f; v2u w; w.x = pk2(v[0], v[1]); w.y = pk2(v[2], v[3]);
                *(v2u*)((isv ? O2 : O) + (size_t)(TP + tl) * D + fc) = w; *(f32x4*)((isv ? f1 : f0) + (size_t)tl * D + fc) = v; }
            else { v2u w; w.x = pk2(v[0], v[1]); w.y = pk2(v[2], v[3]); *(v2u*)(O + (size_t)(TP + tl) * 2048 + f) = w; }
        }
    }
}

struct Args { const float* in[18]; float* out; unsigned char* ws; int ph_lo, ph_hi, li, pad; };
constexpr int N_PHASES = 2 + 2 * 10 + 12 + 10;
__global__ void __launch_bounds__(512, 2) fwd(Args args) {
    extern __shared__ __attribute__((aligned(16))) unsigned char lds_raw[];
    LAS unsigned char* lds = (LAS unsigned char*)lds_raw;
    Ctx c0; c0.tid = threadIdx.x; c0.lane = 0; c0.wave = __builtin_amdgcn_readfirstlane(c0.tid >> 6); c0.G = gridDim.x;
    { const int bx = blockIdx.x; c0.vcu = (c0.G % 8 == 0) ? (bx % 8) * (c0.G / 8) + bx / 8 : bx; }
    volatile LAS unsigned* MISC = (volatile LAS unsigned*)(lds + MISC_OFF);
    for (int u = c0.tid; u < (LDS_BYTES - RING_BYTES) / 4; u += 512) ((LAS unsigned*)(lds + RING_BYTES))[u] = 0u;
    __syncthreads();
    unsigned char* ws = args.ws; float* out = args.out;
    XcdBarrier bar = xcd_barrier_post((unsigned*)(ws + WS_CTL) + CW_BAR + args.li * XCD_BAR_WORDS, MISC + 8, c0.wave == 0 ? 1u : 0u);
#define WinT ((bf16*)(wsl + WS_WIN))
#define WoutT ((bf16*)(wsl + WS_WOUT))
#define WqT ((bf16*)(wsl + WS_WQ))
#define WoT ((bf16*)(wsl + WS_WO))
#define WkvT ((bf16*)(wsl + WS_WKV))
#define WP ((bf16*)(wsl + WS_WP))
#define W8A (wsl + WS_W8A)
#define SWA ((float*)(wsl + WS_SWA))
#define W8R(off) ((int)(((off) - WS_WIN) / 2048))
#define Vsn ((bf16*)(wsl + WS_VSN))
#define H ((bf16*)(wsl + WS_H))
#define Kb ((bf16*)(wsl + WS_KB))
#define VT ((bf16*)(wsl + WS_VT))
#define ids ((unsigned short*)(wsl + WS_IDS))
#define gates ((float*)(wsl + WS_GATE))
#define W8 (wsl + WS_W8)
#define SX ((float*)(wsl + WS_SX))
#define SW (SX + T)
#define X8 (wsl + WS_X8)
#define TU (wsl + WS_TU)
#define TV (wsl + WS_TV)
#define SU ((float*)(wsl + WS_SU))
#define SV (SU + 1)
#define A0 ((bf16*)(wsl + WS_A))
#define A1 ((bf16*)(wsl + WS_A + 129 * MiB))
#define ScT ((float*)(wsl + WS_A))
#define R A0
    const float* ln_g = args.in[16]; const float* ln_b = args.in[17];
    const int lo = args.ph_lo, hi = args.ph_hi; int ph = 0;
#ifndef PROBE_REPEAT
#define PROBE_REPEAT 0
#endif
#define PHASE_R(bit, body) do { const int nrep = 1 + ((PROBE_REPEAT >> (bit)) & 1); for (int rep = 0; rep < nrep; ++rep) { if (ph >= lo && ph < hi) { Ctx c = c0; c.lane = xb_lane_id(); c.tid = c0.wave * 64 + c.lane; unsigned long long wsi_ = (unsigned long long)ws; asm volatile("" : "+s"(wsi_)); unsigned char* wsl = (unsigned char*)(GAS unsigned char*)wsi_; body; if (ph + 1 < hi) { xcd_barrier(bar); if ((PROBE_REPEAT >> 20) & 1) xcd_barrier(bar); } } ++ph; } } while (0)
#define PHASE(body) PHASE_R(31, body)

    PHASE_R(4, ({ P0Args a{args.in[0], args.in[1], args.in[5], args.in[7], args.in[8], args.in[9], args.in[10], args.in[11], args.in[12], args.in[13], args.in[14], args.in[15],
                      WinT, WoutT, WqT, WoT, WkvT, WP, H, TU, TV, SU, SV, X8, SX}; p0_prologue(c, lds, a); }));

    PHASE(({ wp_quant_phase(c, WinT, W8A, SWA); }));

#pragma unroll 1
    for (int l = 0; l < NLAYER; ++l) {
        if (l < 2) {
            PHASE_R(8, ({ pg8::Gemm g{(const bf16*)X8, (const bf16*)(W8A + ((size_t)W8R(WS_WIN) + (size_t)l * 3072) * 1024), TP, 3072, 512}; pg8::StaticOrder S; S.init(TP, 3072, c.G, (int)blockIdx.x);
                     pg8::EpiGate<true> E{A0, A1, SX, SWA + W8R(WS_WIN) + l * 3072};
                     pg8::gemm_phase<pg8::EpiGate<true>, pg8::StaticOrder, true, true, true>(lds, g, S, E, c.tid);
                     sg_gate(c, H, WinT + (size_t)l * 3072 * 1024, A0, A1, out + O_CONVP + (size_t)l * NB * 2 * D); }));
            PHASE_R(13, ({ conv_gate_phase(c, A0, A1, args.in[6] + (size_t)l * 3 * D, args.in[2] + (size_t)l * NB * 2 * D, out + O_CONVP + (size_t)l * NB * 2 * D, out + O_CONVS + (size_t)l * NB * 2 * D, X8, SX, rep > 0); }));
        } else {
            if (l == 2) {
                PHASE_R(10, ({ pg8::Gemm g{(const bf16*)X8, (const bf16*)(W8A + (size_t)W8R(WS_WKV) * 1024), TP, 2048, 512}; pg8::StaticOrder S; S.init(TP, 2048, c.G, (int)blockIdx.x);
                         pg8::EpiKV<true> E{Kb, A1, out + O_KP, out + O_VP, out + O_KS, out + O_VS, SX, SWA + W8R(WS_WKV)};
                         pg8::gemm_phase<pg8::EpiKV<true>, pg8::StaticOrder, true, true, true>(lds, g, S, E, c.tid);
                         sg_plain<2>(c, H + (size_t)TP * D, WkvT, 2048, Kb, nullptr, A1, out + O_KS, out + O_VS); }));
                PHASE_R(14, ({ vt_phase(c, lds, A1, VT, Vsn); }));
            }
            PHASE_R(9, ({ pg8::Gemm g{(const bf16*)X8, (const bf16*)(W8A + ((size_t)W8R(WS_WQ) + (size_t)(l - 2) * 1024) * 1024), TP, 1024, 512}; pg8::StaticOrder S; S.init(TP, 1024, c.G, (int)blockIdx.x);
                     pg8::EpiBf16P<true> E{A0, 1024, SX, SWA + W8R(WS_WQ) + (l - 2) * 1024};
                     pg8::gemm_phase<pg8::EpiBf16P<true>, pg8::StaticOrder, true, true, true>(lds, g, S, E, c.tid);
                     sg_plain<0>(c, H + (size_t)TP * D, WqT + (size_t)(l - 2) * 1024 * 1024, 1024, A0, nullptr, nullptr, nullptr, nullptr); }));
            PHASE_R(11, ({ AttnT A{A0, A1, Kb, VT, Vsn, args.in[3], args.in[4]}; attn_phase(c, A); }));
        }
        if (l < 2) {
            PHASE_R(7, ({ pg8::Gemm g{(const bf16*)X8, (const bf16*)(W8A + ((size_t)W8R(WS_WOUT) + (size_t)l * 1024) * 1024), TP, 1024, 512}; pg8::StaticOrder S; S.init(TP, 1024, c.G, (int)blockIdx.x);
                     pg8::EpiRes<true> E{H, R, ALPHA, SX, SWA + W8R(WS_WOUT) + l * 1024};
                     pg8::gemm_phase<pg8::EpiRes<true>, pg8::StaticOrder, true, true, true>(lds, g, S, E, c.tid);
                     sg_plain<1>(c, A1 + (size_t)TP * D, WoutT + (size_t)l * 1024 * 1024, 1024, R, H, nullptr, nullptr, nullptr); }));
        } else {
            PHASE_R(7, ({ pg8::Gemm g{A1, WoT + (size_t)(l - 2) * 1024 * 1024, TP, 1024, 1024}; pg8::StaticOrder S; S.init(TP, 1024, c.G, (int)blockIdx.x);
                     pg8::EpiRes<false> E{H, R, ALPHA, nullptr, nullptr};
                     pg8::gemm_phase<pg8::EpiRes<false>, pg8::StaticOrder, true, true>(lds, g, S, E, c.tid);
                     sg_plain<1>(c, A1 + (size_t)TP * D, WoT + (size_t)(l - 2) * 1024 * 1024, 1024, R, H, nullptr, nullptr, nullptr); }));
        }
        PHASE_R(5, ({ ln_phase(c, R, H, ln_g + (size_t)(l * 2) * D, ln_b + (size_t)(l * 2) * D, nullptr, nullptr, X8, SX); }));
        PHASE_R(6, ({ pg8::Gemm g{(const bf16*)X8, (const bf16*)(W8A + ((size_t)W8R(WS_WP) + (size_t)l * 2048) * 1024), TP, 2048, 512}; pg8::StaticOrder S; S.init(TP, 2048, c.G, (int)blockIdx.x);
                 pg8::EpiScoreI8 E{(bf16*)ScT, 2048, SX, SWA + W8R(WS_WP) + l * 2048};
                 pg8::gemm_phase<pg8::EpiScoreI8, pg8::StaticOrder, true, true, true>(lds, g, S, E, c.tid);
                 sg_plain<3>(c, H + (size_t)TP * D, WP + (size_t)l * 2048 * 1024, 2048, (bf16*)ScT, nullptr, nullptr, nullptr, nullptr); }));
        PHASE_R(3, ({ topk_phase(c, (const bf16*)ScT, ids, gates); }));
        PHASE_R(0, ({ slice_pass<0>(c, X8, ids, W8, SW, TU + (size_t)l * NEXP * D, ScT  , (unsigned*)(ws + WS_CTL) + CW_Q + ((l * 2) * 2 + rep) * 512); }));
        PHASE_R(12, ({ peer_w_phase(c, ScT, ids, gates, W8, SW, SX, SU + (size_t)l * NEXP * 2, SV + (size_t)l * NEXP * 2); }));
        PHASE_R(1, ({ slice_pass<1>(c, X8, ids, W8, SW, TV + (size_t)l * NEXP * D, (float*)A0, (unsigned*)(ws + WS_CTL) + CW_Q + ((l * 2 + 1) * 2 + rep) * 512); }));
        PHASE(({ ln_phase(c, A0, H, ln_g + (size_t)(l * 2 + 1) * D, ln_b + (size_t)(l * 2 + 1) * D, l == NLAYER - 1 ? out : nullptr, H, X8, SX); }));
#if defined(PROBE_SLICE) && PROBE_SLICE == 1
        PHASE(({ slice_pass<0, 1>(c, X8, ids, W8, SW, TU + (size_t)l * NEXP * D, ScT, (unsigned*)(ws + WS_CTL) + CW_Q + ((l * 2) * 2 + 1) * 512); }));
#elif defined(PROBE_SLICE) && PROBE_SLICE == 2
        PHASE(({ slice_pass<0, 2>(c, X8, ids, W8, SW, TU + (size_t)l * NEXP * D, ScT, (unsigned*)(ws + WS_CTL) + CW_Q + ((l * 2) * 2 + 1) * 512); }));
#elif defined(PROBE_SLICE) && PROBE_SLICE == 3
        PHASE(({ slice_pass<1, 1>(c, X8, ids, W8, SW, TV + (size_t)l * NEXP * D, ScT, (unsigned*)(ws + WS_CTL) + CW_Q + ((l * 2) * 2 + 1) * 512); }));
#elif defined(PROBE_SLICE) && PROBE_SLICE == 4
        PHASE(({ slice_pass<1, 2>(c, X8, ids, W8, SW, TV + (size_t)l * NEXP * D, ScT, (unsigned*)(ws + WS_CTL) + CW_Q + ((l * 2) * 2 + 1) * 512); }));
#endif
    }
#undef PHASE
#undef PHASE_R
#undef WinT
#undef WoutT
#undef WqT
#undef WoT
#undef WkvT
#undef WP
#undef W8A
#undef SWA
#undef W8R
#undef Vsn
#undef H
#undef Kb
#undef VT
#undef ids
#undef gates
#undef W8
#undef SX
#undef SW
#undef X8
#undef TU
#undef TV
#undef SU
#undef SV
#undef A0
#undef A1
#undef ScT
#undef R
}

#ifndef N_LAUNCH_MODE
#define N_LAUNCH_MODE 1
#endif
extern "C" void kernel_launch(void* const* d_in, const int* in_sizes, int n_in, void* d_out, int out_size, void* d_ws, size_t ws_size, hipStream_t stream) {
    static int grid = 0;
    if (grid == 0) {
        if (n_in != 18 || in_sizes[0] != TP * D || (size_t)out_size != O_END || ws_size < WS_END) {
            fprintf(stderr, "kernel_launch: shape mismatch: n_in %d in0 %d out %d ws %zu (need %zu)\n", n_in, n_in > 0 ? in_sizes[0] : -1, out_size, ws_size, (size_t)WS_END); grid = -1; return; }
        int dev = 0, cus = 0, per_cu = 0;
        if (hipGetDevice(&dev) != hipSuccess || hipDeviceGetAttribute(&cus, hipDeviceAttributeMultiprocessorCount, dev) != hipSuccess) { grid = -1; return; }
        if (hipFuncSetAttribute((const void*)fwd, hipFuncAttributeMaxDynamicSharedMemorySize, LDS_BYTES) != hipSuccess) { fprintf(stderr, "kernel_launch: hipFuncSetAttribute failed\n"); grid = -1; return; }
        if (hipOccupancyMaxActiveBlocksPerMultiprocessor(&per_cu, (const void*)fwd, 512, LDS_BYTES) != hipSuccess || per_cu < 1) { fprintf(stderr, "kernel_launch: occupancy query says %d\n", per_cu); }
        (void)hipGetLastError();
        grid = cus;
    }
    if (grid < 0) return;
    (void)hipMemsetAsync((char*)d_ws + WS_CTL, 0, CTL_BYTES, stream);
    Args a{};
    for (int i = 0; i < 18; ++i) a.in[i] = (const float*)d_in[i];
    a.out = (float*)d_out; a.ws = (unsigned char*)d_ws; a.pad = 0;
#if N_LAUNCH_MODE == 1
    a.ph_lo = 0; a.ph_hi = 1 << 30; a.li = 0;
    hipLaunchKernelGGL(fwd, dim3(grid), dim3(512), LDS_BYTES, stream, a);
#else
    for (int p = 0; p < N_PHASES; ++p) { a.ph_lo = p; a.ph_hi = p + 1; a.li = p; hipLaunchKernelGGL(fwd, dim3(grid), dim3(512), LDS_BYTES, stream, a); }
#endif
}
```

```cpp
#include <hip/hip_runtime.h>
#include <cstdio>
#include <cstdint>
namespace pg8 {
#define PG8_LAS __attribute__((address_space(3)))
typedef unsigned short bf16_t;
typedef short bf16x8 __attribute__((ext_vector_type(8)));
typedef float f32x4 __attribute__((ext_vector_type(4)));
typedef unsigned u32x4 __attribute__((ext_vector_type(4)));
constexpr int BM = 256, BK = 64, HALF = 128, HTB = HALF * BK * 2  , STAGE_BYTES = 8 * HTB, NXCD = 8, WGM = 8;

__host__ __device__ __forceinline__ int lds_byte(int r, int c) { const int st = (r >> 4) * 2 + (c >> 5), rr = r & 15, cc = c & 31, ob = rr * 64 + cc * 2; return st * 1024 + (ob ^ (((ob >> 9) & 1) << 5)); }
__host__ __device__ __forceinline__ void stage_rc(int b, int& R, int& C) { const int st = b / 1024, sb = b % 1024, swz = sb ^ (((sb >> 9) & 1) << 5); R = (st >> 1) * 16 + swz / 64; C = (st & 1) * 32 + (swz % 64) / 2; }
__host__ __device__ __forceinline__ int perm32(int rho) { const int n = rho >> 4, i = rho & 15; return 8 * (i >> 2) + 4 * n + (i & 3); }

struct Unit { int pm, pn; };
struct Gemm { const bf16_t* A; const bf16_t* Bt; int M, N, K; };

struct StaticOrder {
    int nM, nN, nwg, G, c;
    __host__ __device__ void init(int M, int N, int G_, int c_) { nM = M / BM; nN = N / BM; nwg = nM * nN; G = G_; c = c_; }
    __host__ __device__ bool next(int i, Unit& u) const {
        const long L = (long)i * G + c; if (L >= nwg) return false;
        int wgid = (int)L; { const int q = nwg / NXCD, r = nwg % NXCD, xcd = wgid % NXCD, off = wgid / NXCD; wgid = (xcd < r ? xcd * (q + 1) : r * (q + 1) + (xcd - r) * q) + off; }
        const int nig = WGM * nN, gid = wgid / nig, fm = gid * WGM, gsz = (nM - fm) < WGM ? (nM - fm) : WGM;
        u.pm = fm + ((wgid % nig) % gsz); u.pn = (wgid % nig) / gsz; return true;
    }
    __device__ __forceinline__ void a_ready(const Unit&) const {}
    __device__ __forceinline__ void done(const Unit&) const {}
};

typedef float f32x2 __attribute__((ext_vector_type(2)));
typedef __bf16 bf16x2v __attribute__((ext_vector_type(2)));
typedef unsigned u32x2 __attribute__((ext_vector_type(2)));
__device__ __forceinline__ unsigned pk2(float lo, float hi) { const bf16x2v v = __builtin_convertvector((f32x2){lo, hi}, bf16x2v); return __builtin_bit_cast(unsigned, v); }
__device__ __forceinline__ u32x4 pk8(const f32x4 a, const f32x4 b) { u32x4 w; w.x = pk2(a[0], a[1]); w.y = pk2(a[2], a[3]); w.z = pk2(b[0], b[1]); w.w = pk2(b[2], b[3]); return w; }

typedef int i32x4 __attribute__((ext_vector_type(4)));
template <bool I8> struct AccT { typedef f32x4 type; static __device__ __forceinline__ type zero() { return (f32x4){0.f, 0.f, 0.f, 0.f}; } };
template <> struct AccT<true> { typedef i32x4 type; static __device__ __forceinline__ type zero() { return (i32x4){0, 0, 0, 0}; } };
__device__ __forceinline__ f32x4 mma16(const bf16x8 b, const bf16x8 a, const f32x4 c) { return __builtin_amdgcn_mfma_f32_16x16x32_bf16(b, a, c, 0, 0, 0); }
__device__ __forceinline__ i32x4 mma16(const bf16x8 b, const bf16x8 a, const i32x4 c) { return __builtin_amdgcn_mfma_i32_16x16x64_i8(__builtin_bit_cast(i32x4, b), __builtin_bit_cast(i32x4, a), c, 0, 0, 0); }
__device__ __forceinline__ f32x4 dq4(const f32x4 a, const float, const f32x4) { return a; }
__device__ __forceinline__ f32x4 dq4(const i32x4 a, const float ra, const f32x4 cb) { return (f32x4){(float)a[0], (float)a[1], (float)a[2], (float)a[3]} * ra * cb; }
constexpr int TOK_P = 65536;

template <bool I8> struct EpiBf16P {
    static constexpr bool PERM = true, AFTER_DRAIN = false;
    bf16_t* O; int ldc; const float* sa; const float* sb;
    __device__ __forceinline__ void operator()(const typename AccT<I8>::type (&acc)[2][2][4][2], const Unit& u, int wr, int wc, int fr, int fq) const {
        const int row0 = u.pm * BM + wr * 64 + fr, col0 = u.pn * BM + wc * 32 + 8 * fq;
        f32x4 cb[2][2];
#pragma unroll
        for (int bj = 0; bj < 2; ++bj)
#pragma unroll
            for (int n = 0; n < 2; ++n) cb[bj][n] = I8 ? *(const f32x4*)(sb + col0 + bj * HALF + 4 * n) : (f32x4){1.f, 1.f, 1.f, 1.f};
        float rs[2][4];
#pragma unroll
        for (int ai = 0; ai < 2; ++ai)
#pragma unroll
            for (int m = 0; m < 4; ++m) rs[ai][m] = I8 ? sa[row0 + ai * HALF + m * 16] : 1.f;
        __builtin_amdgcn_sched_barrier(0);
#pragma unroll
        for (int ai = 0; ai < 2; ++ai)
#pragma unroll
            for (int m = 0; m < 4; ++m) { const int row = row0 + ai * HALF + m * 16; const float ra = rs[ai][m]; bf16_t* rowp = O + (size_t)row * ldc + col0;
#pragma unroll
                for (int bj = 0; bj < 2; ++bj) *(u32x4*)(rowp + bj * HALF) = pk8(dq4(acc[ai][bj][m][0], ra, cb[bj][0]), dq4(acc[ai][bj][m][1], ra, cb[bj][1])); }
    }
};
template <bool I8> struct EpiGate {
    static constexpr bool PERM = true, AFTER_DRAIN = false;
    bf16_t* U; bf16_t* Bg; const float* sa; const float* sb;
    __device__ __forceinline__ void operator()(const typename AccT<I8>::type (&acc)[2][2][4][2], const Unit& u, int wr, int wc, int fr, int fq) const {
        const int row0 = u.pm * BM + wr * 64 + fr, scol0 = u.pn * BM + wc * 32 + 8 * fq;
        f32x4 cb[2][2];
#pragma unroll
        for (int bj = 0; bj < 2; ++bj)
#pragma unroll
            for (int n = 0; n < 2; ++n) cb[bj][n] = I8 ? *(const f32x4*)(sb + scol0 + bj * HALF + 4 * n) : (f32x4){1.f, 1.f, 1.f, 1.f};
        float rs[2][4];
#pragma unroll
        for (int ai = 0; ai < 2; ++ai)
#pragma unroll
            for (int m = 0; m < 4; ++m) rs[ai][m] = I8 ? sa[row0 + ai * HALF + m * 16] : 1.f;
        __builtin_amdgcn_sched_barrier(0);
        if (u.pn < 8) {
            const int col0 = u.pn * HALF + wc * 32 + 8 * fq;
#pragma unroll
            for (int ai = 0; ai < 2; ++ai)
#pragma unroll
                for (int m = 0; m < 4; ++m) { const int row = row0 + ai * HALF + m * 16; const float ra = rs[ai][m];
                    const f32x4 v0 = dq4(acc[ai][0][m][0], ra, cb[0][0]) * dq4(acc[ai][1][m][0], ra, cb[1][0]), v1 = dq4(acc[ai][0][m][1], ra, cb[0][1]) * dq4(acc[ai][1][m][1], ra, cb[1][1]);
                    *(u32x4*)(U + (size_t)row * 1024 + col0) = pk8(v0, v1); }
        } else {
            const int col0 = (u.pn - 8) * BM + wc * 32 + 8 * fq;
#pragma unroll
            for (int ai = 0; ai < 2; ++ai)
#pragma unroll
                for (int m = 0; m < 4; ++m) { const int row = row0 + ai * HALF + m * 16; const float ra = rs[ai][m]; bf16_t* rowp = Bg + (size_t)row * 1024 + col0;
#pragma unroll
                    for (int bj = 0; bj < 2; ++bj) *(u32x4*)(rowp + bj * HALF) = pk8(dq4(acc[ai][bj][m][0], ra, cb[bj][0]), dq4(acc[ai][bj][m][1], ra, cb[bj][1])); }
        }
    }
};
template <bool I8> struct EpiRes {
    static constexpr bool PERM = true, AFTER_DRAIN = false;
    const bf16_t* H; bf16_t* R; float alpha; const float* sa; const float* sb;
    __device__ __forceinline__ void operator()(const typename AccT<I8>::type (&acc)[2][2][4][2], const Unit& u, int wr, int wc, int fr, int fq) const {
        const int row0 = u.pm * BM + wr * 64 + fr, col0 = u.pn * BM + wc * 32 + 8 * fq;
        f32x4 cb[2][2];
#pragma unroll
        for (int bj = 0; bj < 2; ++bj)
#pragma unroll
            for (int n = 0; n < 2; ++n) cb[bj][n] = I8 ? *(const f32x4*)(sb + col0 + bj * HALF + 4 * n) : (f32x4){1.f, 1.f, 1.f, 1.f};
        float rs[2][4];
#pragma unroll
        for (int ai = 0; ai < 2; ++ai)
#pragma unroll
            for (int m = 0; m < 4; ++m) rs[ai][m] = I8 ? sa[row0 + ai * HALF + m * 16] : 1.f;
        __builtin_amdgcn_sched_barrier(0);
#pragma unroll
        for (int ai = 0; ai < 2; ++ai) {
            u32x4 hq[4][2];
#pragma unroll
            for (int m = 0; m < 4; ++m)
#pragma unroll
                for (int bj = 0; bj < 2; ++bj) hq[m][bj] = *(const u32x4*)(H + (size_t)(row0 + ai * HALF + m * 16) * 1024 + col0 + bj * HALF);
            __builtin_amdgcn_sched_barrier(0);
#pragma unroll
            for (int m = 0; m < 4; ++m) { const int row = row0 + ai * HALF + m * 16; const float ra = rs[ai][m]; const size_t off = (size_t)row * 1024 + col0;
#pragma unroll
                for (int bj = 0; bj < 2; ++bj) { const u32x4 h = hq[m][bj];
                    f32x4 h0, h1; h0[0] = __uint_as_float(h.x << 16); h0[1] = __uint_as_float(h.x & 0xffff0000u); h0[2] = __uint_as_float(h.y << 16); h0[3] = __uint_as_float(h.y & 0xffff0000u);
                    h1[0] = __uint_as_float(h.z << 16); h1[1] = __uint_as_float(h.z & 0xffff0000u); h1[2] = __uint_as_float(h.w << 16); h1[3] = __uint_as_float(h.w & 0xffff0000u);
                    *(u32x4*)(R + off + bj * HALF) = pk8(h0 * alpha + dq4(acc[ai][bj][m][0], ra, cb[bj][0]), h1 * alpha + dq4(acc[ai][bj][m][1], ra, cb[bj][1])); } } }
    }
};
template <bool I8> struct EpiKV {
    static constexpr bool PERM = true, AFTER_DRAIN = false;
    bf16_t* Kb; bf16_t* Vb; float* kp; float* vp; float* ks; float* vs; const float* sa; const float* sb;
    __device__ __forceinline__ void operator()(const typename AccT<I8>::type (&acc)[2][2][4][2], const Unit& u, int wr, int wc, int fr, int fq) const {
        const bool isv = u.pn >= 4; const int colt = (isv ? u.pn - 4 : u.pn) * BM;
        bf16_t* ob = isv ? Vb : Kb; const bool samp = u.pm * BM >= TOK_P;
        float* of = samp ? (isv ? vs : ks) - (size_t)TOK_P * 1024 : (isv ? vp : kp);
        const int row0 = u.pm * BM + wr * 64 + fr, col0 = colt + wc * 32 + 8 * fq, scol0 = u.pn * BM + wc * 32 + 8 * fq;
        float rs[2][4];
#pragma unroll
        for (int ai = 0; ai < 2; ++ai)
#pragma unroll
            for (int m = 0; m < 4; ++m) rs[ai][m] = I8 ? sa[row0 + ai * HALF + m * 16] : 1.f;
        f32x4 cb[2][2];
#pragma unroll
        for (int bj = 0; bj < 2; ++bj)
#pragma unroll
            for (int n = 0; n < 2; ++n) cb[bj][n] = I8 ? *(const f32x4*)(sb + scol0 + bj * HALF + 4 * n) : (f32x4){1.f, 1.f, 1.f, 1.f};
#pragma unroll
        for (int ai = 0; ai < 2; ++ai)
#pragma unroll
            for (int m = 0; m < 4; ++m) { const int row = row0 + ai * HALF + m * 16; const float ra = rs[ai][m]; const size_t off = (size_t)row * 1024 + col0;
#pragma unroll
                for (int bj = 0; bj < 2; ++bj) { const f32x4 v0 = dq4(acc[ai][bj][m][0], ra, cb[bj][0]), v1 = dq4(acc[ai][bj][m][1], ra, cb[bj][1]);
                    *(u32x4*)(ob + off + bj * HALF) = pk8(v0, v1); *(f32x4*)(of + off + bj * HALF) = v0; *(f32x4*)(of + off + bj * HALF + 4) = v1; } }
    }
};

struct EpiScoreI8 {
    static constexpr bool PERM = true, AFTER_DRAIN = false;
    bf16_t* O; int ldc; const float* sa; const float* sb;
    __device__ __forceinline__ void operator()(const i32x4 (&acc)[2][2][4][2], const Unit& u, int wr, int wc, int fr, int fq) const {
        const int row0 = u.pm * BM + wr * 64 + fr, col0 = u.pn * BM + wc * 32 + 8 * fq;
        f32x4 cb[2][2];
#pragma unroll
        for (int bj = 0; bj < 2; ++bj)
#pragma unroll
            for (int n = 0; n < 2; ++n) cb[bj][n] = *(const f32x4*)(sb + col0 + bj * HALF + 4 * n);
        float rs[2][4];
#pragma unroll
        for (int ai = 0; ai < 2; ++ai)
#pragma unroll
            for (int m = 0; m < 4; ++m) rs[ai][m] = sa[row0 + ai * HALF + m * 16];
        __builtin_amdgcn_sched_barrier(0);
#pragma unroll
        for (int ai = 0; ai < 2; ++ai)
#pragma unroll
            for (int m = 0; m < 4; ++m) { const int row = row0 + ai * HALF + m * 16; const float ra = rs[ai][m]; bf16_t* rowp = O + (size_t)row * ldc + col0;
#pragma unroll
                for (int bj = 0; bj < 2; ++bj) { f32x4 v0, v1;
#pragma unroll
                    for (int i = 0; i < 4; ++i) { v0[i] = (float)acc[ai][bj][m][0][i] * ra * cb[bj][0][i]; v1[i] = (float)acc[ai][bj][m][1][i] * ra * cb[bj][1][i]; }
                    *(u32x4*)(rowp + bj * HALF) = pk8(v0, v1); } }
    }
};

template <class Epi, class Sched, bool ALIGN_EPI = false, bool SP2 = false, bool I8 = false>
__device__ __forceinline__ void gemm_phase(PG8_LAS unsigned char* lds, const Gemm g, const Sched& S, const Epi& E, const int tid_in) {
    int tid_ = tid_in; asm volatile("" : "+v"(tid_));
    const int tid = tid_, wid = __builtin_amdgcn_readfirstlane(tid >> 6), lane = tid & 63, wr = wid >> 2, wc = wid & 3, fr = lane & 15, fq = lane >> 4;
    const int K = g.K, nt = K / BK;
    unsigned voffA[2], voffB[2];
#pragma unroll
    for (int i = 0; i < 2; ++i) { int R, C; stage_rc(tid * 16 + i * 8192, R, C); const int Rb = Epi::PERM ? ((R & ~31) + perm32(R & 31)) : R;
        voffA[i] = (unsigned)(R * K + C) * 2u; voffB[i] = (unsigned)(Rb * K + C) * 2u; }
    const size_t kstep = (size_t)(BK * 2);
    const size_t hstep = (size_t)HALF * K * 2;
    const size_t tstep = 2 * hstep;
    const unsigned ldsw = (unsigned)wid * 1024u;
    const int aoff = lds_byte(wr * 64 + fr, fq * 8), boff = lds_byte(wc * 32 + fr, fq * 8);
#define PG8_SA(b, h) (((b) * 2 + (h)) * HTB)
#define PG8_SB(b, h) ((4 + (b) * 2 + (h)) * HTB)
#define PG8_STAGE(bufoff, gbase, voff) do { _Pragma("unroll") for (int _i = 0; _i < 2; ++_i) \
        __builtin_amdgcn_global_load_lds((const unsigned*)((const char*)(gbase) + (voff)[_i]), (PG8_LAS unsigned*)(lds + (bufoff) + ldsw + _i * 8192), 16, 0, 0); } while (0)
#define PG8_LDA(dst, b, h) do { _Pragma("unroll") for (int m = 0; m < 4; ++m) _Pragma("unroll") for (int k = 0; k < 2; ++k) dst[m][k] = *(const PG8_LAS bf16x8*)(lds + PG8_SA(b, h) + aoff + m * 2048 + k * 1024); } while (0)
#define PG8_LDB(dst, b, h) do { _Pragma("unroll") for (int n = 0; n < 2; ++n) _Pragma("unroll") for (int k = 0; k < 2; ++k) dst[n][k] = *(const PG8_LAS bf16x8*)(lds + PG8_SB(b, h) + boff + n * 2048 + k * 1024); } while (0)
#define PG8_MMA(ai, bj, At, Bt) do { __builtin_amdgcn_s_setprio(1); _Pragma("unroll") for (int m = 0; m < 4; ++m) _Pragma("unroll") for (int n = 0; n < 2; ++n) _Pragma("unroll") for (int k = 0; k < 2; ++k) \
        acc[ai][bj][m][n] = mma16(Bt[n][k], At[m][k], acc[ai][bj][m][n]); __builtin_amdgcn_s_setprio(0); } while (0)
#define PG8_WAIT_V(n) asm volatile("s_waitcnt vmcnt(" #n ")" ::: "memory")
#define PG8_WAIT_L(n) asm volatile("s_waitcnt lgkmcnt(" #n ")" ::: "memory")
#define PG8_BAR __builtin_amdgcn_s_barrier()
#define PG8_SCHED __builtin_amdgcn_sched_barrier(0)
    Unit cur, nxt; int ui = 0;
    if (!S.next(0, cur)) return;
    typename AccT<I8>::type acc[2][2][4][2];
#pragma unroll
    for (int a = 0; a < 2; ++a)
#pragma unroll
        for (int b = 0; b < 2; ++b)
#pragma unroll
            for (int m = 0; m < 4; ++m)
#pragma unroll
                for (int n = 0; n < 2; ++n) acc[a][b][m][n] = AccT<I8>::zero();
    bf16x8 At[4][2], B0[2][2], B1[2][2];
    const char* cA = (const char*)g.A + (size_t)cur.pm * tstep; const char* cB = (const char*)g.Bt + (size_t)cur.pn * tstep;
    S.a_ready(cur);
    if constexpr (SP2) {
        PG8_STAGE(PG8_SB(0, 0), cB, voffB); PG8_STAGE(PG8_SB(0, 1), cB + hstep, voffB); PG8_STAGE(PG8_SA(0, 0), cA, voffA); PG8_STAGE(PG8_SA(0, 1), cA + hstep, voffA);
        if (wr == 1) PG8_BAR;
        PG8_WAIT_V(2); PG8_BAR;
        PG8_STAGE(PG8_SB(1, 0), cB + kstep, voffB); PG8_STAGE(PG8_SA(1, 0), cA + kstep, voffA); PG8_STAGE(PG8_SB(1, 1), cB + hstep + kstep, voffB);
        PG8_WAIT_V(6); PG8_BAR;
    } else {
        PG8_STAGE(PG8_SB(0, 0), cB, voffB); PG8_STAGE(PG8_SA(0, 0), cA, voffA); PG8_STAGE(PG8_SB(0, 1), cB + hstep, voffB); PG8_STAGE(PG8_SA(0, 1), cA + hstep, voffA);
        if (wr == 1) PG8_BAR;
        PG8_WAIT_V(4); PG8_BAR;
        PG8_STAGE(PG8_SB(1, 0), cB + kstep, voffB); PG8_STAGE(PG8_SA(1, 0), cA + kstep, voffA); PG8_STAGE(PG8_SB(1, 1), cB + hstep + kstep, voffB);
        PG8_WAIT_V(6); PG8_BAR;
    }
    for (;;) {
        const bool has_next = S.next(ui + 1, nxt);
        const char* nA = has_next ? (const char*)g.A + (size_t)nxt.pm * tstep : cA; const char* nB = has_next ? (const char*)g.Bt + (size_t)nxt.pn * tstep : cB;
        for (int t = 0; t < nt; t += 2) {
            const bool last = (t == nt - 2);
            const char* a1 = cA + (size_t)(t + 1) * kstep;
            const char* a2 = last ? nA : cA + (size_t)(t + 2) * kstep; const char* b2 = last ? nB : cB + (size_t)(t + 2) * kstep;
            const char* a3 = a2 + kstep; const char* b3 = b2 + kstep;
            if (last && has_next) S.a_ready(nxt);
            if constexpr (SP2) {
            PG8_LDB(B0, 0, 0); PG8_LDB(B1, 0, 1); PG8_SCHED; PG8_LDA(At, 0, 0); PG8_STAGE(PG8_SA(1, 1), a1 + hstep, voffA);
            PG8_WAIT_V(8); PG8_WAIT_L(0); PG8_BAR; PG8_MMA(0, 0, At, B0); PG8_MMA(0, 1, At, B1); PG8_BAR; PG8_SCHED;
            PG8_LDA(At, 0, 1); PG8_STAGE(PG8_SB(0, 0), b2, voffB); PG8_STAGE(PG8_SB(0, 1), b2 + hstep, voffB); PG8_STAGE(PG8_SA(0, 0), a2, voffA);
            PG8_WAIT_V(8); PG8_WAIT_L(0); PG8_BAR; PG8_MMA(1, 0, At, B0); PG8_MMA(1, 1, At, B1); PG8_BAR; PG8_SCHED;
            PG8_LDB(B0, 1, 0); PG8_LDB(B1, 1, 1); PG8_SCHED; PG8_LDA(At, 1, 0); PG8_STAGE(PG8_SA(0, 1), a2 + hstep, voffA);
            PG8_WAIT_V(8); PG8_WAIT_L(0); PG8_BAR; PG8_MMA(0, 0, At, B0); PG8_MMA(0, 1, At, B1); PG8_BAR; PG8_SCHED;
            PG8_LDA(At, 1, 1); PG8_STAGE(PG8_SB(1, 0), b3, voffB); PG8_STAGE(PG8_SB(1, 1), b3 + hstep, voffB); PG8_STAGE(PG8_SA(1, 0), a3, voffA);
            PG8_WAIT_V(8); PG8_WAIT_L(0); PG8_BAR; PG8_MMA(1, 0, At, B0); PG8_MMA(1, 1, At, B1); PG8_BAR; PG8_SCHED;
            } else {
            PG8_LDB(B0, 0, 0); PG8_SCHED; PG8_LDA(At, 0, 0); PG8_STAGE(PG8_SA(1, 1), a1 + hstep, voffA);
            PG8_WAIT_L(8); PG8_BAR; PG8_WAIT_L(0); PG8_MMA(0, 0, At, B0); PG8_BAR; PG8_SCHED;
            PG8_LDB(B1, 0, 1); PG8_STAGE(PG8_SB(0, 0), b2, voffB);
            PG8_BAR; PG8_WAIT_L(0); PG8_MMA(0, 1, At, B1); PG8_BAR;
            PG8_LDA(At, 0, 1); PG8_STAGE(PG8_SA(0, 0), a2, voffA);
            PG8_BAR; PG8_WAIT_L(0); PG8_MMA(1, 0, At, B0); PG8_BAR; PG8_SCHED;
            PG8_STAGE(PG8_SB(0, 1), b2 + hstep, voffB);
            PG8_WAIT_V(6); PG8_BAR; PG8_MMA(1, 1, At, B1); PG8_BAR;
            PG8_LDB(B0, 1, 0); PG8_SCHED; PG8_LDA(At, 1, 0); PG8_STAGE(PG8_SA(0, 1), a2 + hstep, voffA);
            PG8_WAIT_L(8); PG8_BAR; PG8_WAIT_L(0); PG8_MMA(0, 0, At, B0); PG8_BAR; PG8_SCHED;
            PG8_LDB(B1, 1, 1); PG8_STAGE(PG8_SB(1, 0), b3, voffB);
            PG8_BAR; PG8_WAIT_L(0); PG8_MMA(0, 1, At, B1); PG8_BAR;
            PG8_LDA(At, 1, 1); PG8_STAGE(PG8_SA(1, 0), a3, voffA);
            PG8_BAR; PG8_WAIT_L(0); PG8_MMA(1, 0, At, B0); PG8_BAR; PG8_SCHED;
            PG8_STAGE(PG8_SB(1, 1), b3 + hstep, voffB);
            PG8_WAIT_V(6); PG8_BAR; PG8_MMA(1, 1, At, B1); PG8_BAR;
            }
        }
        if constexpr (ALIGN_EPI) { if (wr == 0) PG8_BAR; }
        if constexpr (!Epi::AFTER_DRAIN) { E(acc, cur, wr, wc, fr, fq); S.done(cur); }
        if (!has_next) break;
#pragma unroll
        for (int a = 0; a < 2; ++a)
#pragma unroll
            for (int b = 0; b < 2; ++b)
#pragma unroll
                for (int m = 0; m < 4; ++m)
#pragma unroll
                    for (int n = 0; n < 2; ++n) acc[a][b][m][n] = AccT<I8>::zero();
        cur = nxt; cA = nA; cB = nB; ++ui;
        if constexpr (ALIGN_EPI) { if (wr == 1) PG8_BAR; }
    }
    PG8_WAIT_V(0);
    if constexpr (!ALIGN_EPI) { if (wr == 0) PG8_BAR; }
    PG8_BAR;
    if constexpr (Epi::AFTER_DRAIN) { E.fused(acc, cur, wr, wc, fr, fq, lds, wid, lane); S.done(cur); }
#undef PG8_SA
#undef PG8_SB
#undef PG8_STAGE
#undef PG8_LDA
#undef PG8_LDB
#undef PG8_MMA
#undef PG8_WAIT_V
#undef PG8_WAIT_L
#undef PG8_BAR
#undef PG8_SCHED
}
}

#define GAS __attribute__((address_space(1)))
#define LAS __attribute__((address_space(3)))
#define DI __device__ __forceinline__
typedef unsigned short bf16;
typedef unsigned v4u __attribute__((ext_vector_type(4)));
typedef unsigned v2u __attribute__((ext_vector_type(2)));
typedef float f32x4 __attribute__((ext_vector_type(4)));
typedef float f32x16 __attribute__((ext_vector_type(16)));
typedef short bf16x8 __attribute__((ext_vector_type(8)));
using pg8::pk2;
#define LDS_WAIT() asm volatile("s_waitcnt lgkmcnt(0)" ::: "memory")
#define MFMA32(a, b, c) __builtin_amdgcn_mfma_f32_32x32x16_bf16((a), (b), (c), 0, 0, 0)

constexpr int D = 1024, NB = 32, SEQ = 2048, DSEQ = 16, PAST = 1024, NH = 16, DH = 64;
constexpr int TP = NB * SEQ, TS = NB * DSEQ, T = TP + TS;
constexpr int NEXP = 16384, PH = 8, PK = 16;
constexpr int NLAYER = 4;
constexpr float LN_EPS = 1e-5f;
constexpr float ALPHA = 1.6817928305074292f;
constexpr float LOG2E = 1.4426950408889634f, LN2 = 0.6931471805599453f;
static_assert(T % 256 == 0 && pg8::TOK_P == TP, "row panels");
constexpr size_t O_Y = 0, O_YS = (size_t)TP * D, O_CONVP = O_YS + (size_t)TS * D, O_KP = O_CONVP + 2 * NB * 2 * D, O_VP = O_KP + (size_t)TP * D,
                 O_CONVS = O_VP + (size_t)TP * D, O_KS = O_CONVS + 2 * NB * 2 * D, O_VS = O_KS + (size_t)TS * D, O_END = O_VS + (size_t)TS * D;
static_assert(O_END == 203161600ull, "output size");
constexpr size_t MiB = 1u << 20;
constexpr size_t WS_CTL = 0, CTL_BYTES = 2 * MiB;
constexpr size_t WS_WIN = 2 * MiB;
constexpr size_t WS_WOUT = WS_WIN + 12 * MiB;
constexpr size_t WS_WQ = WS_WOUT + 4 * MiB;
constexpr size_t WS_WO = WS_WQ + 4 * MiB;
constexpr size_t WS_WKV = WS_WO + 4 * MiB;
constexpr size_t WS_WP = WS_WKV + 4 * MiB;
constexpr size_t WS_VSN = WS_WP + 16 * MiB;
constexpr size_t WS_H = WS_VSN + 1 * MiB;
constexpr size_t WS_KB = WS_H + 129 * MiB;
constexpr size_t WS_VT = WS_KB + 129 * MiB;
constexpr size_t WS_IDS = WS_VT + 128 * MiB;
constexpr size_t WS_GATE = WS_IDS + 17 * MiB;
constexpr size_t WS_TU = WS_GATE + 33 * MiB;
constexpr size_t WS_TV = WS_TU + 64 * MiB;
constexpr size_t WS_SU = WS_TV + 64 * MiB;
constexpr size_t WS_W8 = WS_SU + 1 * MiB;
constexpr size_t WS_SX = WS_W8 + 9 * MiB;
constexpr size_t WS_X8 = WS_SX + 1 * MiB;
constexpr size_t WS_W8A = WS_X8 + 65 * MiB;
constexpr size_t WS_SWA = WS_W8A + 22 * MiB;
constexpr int W8_ROWS = (int)((WS_VSN - WS_WIN) / 2048);
static_assert(W8_ROWS == 22528, "weight rows");
constexpr size_t WS_A = WS_SWA + 1 * MiB;
constexpr size_t WS_END = WS_A + 258 * MiB;
static_assert((size_t)T * D * 2 == 129 * MiB && (size_t)1024 * T * 4 == 258 * MiB, "sizes");
constexpr int CW_Q = 1024;
constexpr int CW_BAR = 16384;

constexpr int RING_BYTES = 131072, MISC_OFF = RING_BYTES + 320, LDS_BYTES = 147456;

#define XB_TMO      128
#define XB_XCNT(j)  (256  + 64 * (j))
#define XB_XSUB(j)  (1280 + 64 * (j))
#define XB_XGEN(j)  (2304 + 64 * (j))
#define XB_TOP      3328
#define XB_TOPGEN   3392
#define XCD_BAR_WORDS 3456
#define XB_SPIN_CAP (1u << 18)

__device__ __forceinline__ unsigned xb_ld(unsigned* p)              { return __hip_atomic_load(p, __ATOMIC_RELAXED, __HIP_MEMORY_SCOPE_AGENT); }
__device__ __forceinline__ unsigned xb_add(unsigned* p, unsigned v) { return __hip_atomic_fetch_add(p, v, __ATOMIC_RELAXED, __HIP_MEMORY_SCOPE_AGENT); }
__device__ __forceinline__ unsigned xb_xcc_id() { return (unsigned)__builtin_amdgcn_s_getreg((3 << 11) | 20) & 0xFu; }
#define XB_SPIN(cond, bar) do { unsigned _sp = 0; while (cond) { __builtin_amdgcn_s_sleep(1); \
    if ((++_sp & 255u) == 0u) { if (xb_ld(&(bar)[XB_TMO])) break; if (_sp > XB_SPIN_CAP) { atomicAdd(&(bar)[XB_TMO], 1u); break; } } } } while (0)

__device__ __forceinline__ int xb_lane_id() { int l; asm volatile("v_mbcnt_lo_u32_b32 %0, -1, 0\n\tv_mbcnt_hi_u32_b32 %0, -1, %0" : "=v"(l)); return l; }
__device__ __forceinline__ bool xb_is_thread0(unsigned w0) { return w0 != 0u && xb_lane_id() == 0; }
struct XcdBarrier {
    unsigned w0;
    unsigned* bar; unsigned x;
    volatile LAS unsigned* st;
};

__device__ __forceinline__ XcdBarrier xcd_barrier_post(unsigned* bar, volatile LAS unsigned* st, unsigned w0) {
    XcdBarrier b; b.w0 = w0; b.bar = bar; b.x = xb_xcc_id(); b.st = st;
    if (xb_is_thread0(b.w0)) (void)xb_add(&bar[XB_XCNT(b.x)], 1u);
    return b;
}
__device__ __forceinline__ void xcd_barrier_complete(unsigned* bar, unsigned x, unsigned& nloc, unsigned& nx) {
    const unsigned G = gridDim.x * gridDim.y * gridDim.z;
    unsigned sum, cnt, mine, sp = 0u;
    for (;;) {
        sum = 0u; cnt = 0u; mine = 0u;
#pragma unroll
        for (unsigned j = 0; j < 16; ++j) { const unsigned c = xb_ld(&bar[XB_XCNT(j)]); sum += c; cnt += (c > 0u) ? 1u : 0u; mine = (j == x) ? c : mine; }
        if (sum == G) break;
        __builtin_amdgcn_s_sleep(1);
        if ((++sp & 255u) == 0u) { if (xb_ld(&bar[XB_TMO])) break; if (sp > XB_SPIN_CAP) { atomicAdd(&bar[XB_TMO], 1u); break; } }
    }
    nloc = mine > 0u ? mine : 1u; nx = cnt > 0u ? cnt : 1u;
}

__device__ __forceinline__ void xcd_barrier(const XcdBarrier& b) {
    asm volatile("s_waitcnt vmcnt(0)" ::: "memory");
    __syncthreads();
    if (xb_is_thread0(b.w0)) {
        unsigned* bar = b.bar;
        __builtin_amdgcn_s_waitcnt(0);
        unsigned nloc = b.st[0], nx = b.st[1];
        if (nloc == 0u) { xcd_barrier_complete(bar, b.x, nloc, nx); b.st[0] = nloc; b.st[1] = nx; }
        const unsigned old = xb_add(&bar[XB_XSUB(b.x)], 1u);
        const unsigned gen = old / nloc;
        if (old + 1u == (gen + 1u) * nloc) {
            __builtin_amdgcn_fence(__ATOMIC_RELEASE, "agent");
            asm volatile("s_waitcnt vmcnt(0)" ::: "memory");
            const unsigned og = xb_add(&bar[XB_TOP], 1u);
            const unsigned tg = og / nx;
            if (og + 1u == (tg + 1u) * nx) xb_add(&bar[XB_TOPGEN], 1u);
            else XB_SPIN(xb_ld(&bar[XB_TOPGEN]) == tg, bar);
            __builtin_amdgcn_fence(__ATOMIC_ACQUIRE, "agent");
            xb_add(&bar[XB_XGEN(b.x)], 1u);
            asm volatile("s_waitcnt vmcnt(0)" ::: "memory");
        } else {
            XB_SPIN(xb_ld(&bar[XB_XGEN(b.x)]) == gen, bar);
            __builtin_amdgcn_fence(__ATOMIC_ACQUIRE, "agent");
            asm volatile("s_waitcnt vmcnt(0)" ::: "memory");
        }
    }
    __syncthreads();
}


DI float bflo(unsigned w) { return __uint_as_float(w << 16); }
DI float bfhi(unsigned w) { return __uint_as_float(w & 0xffff0000u); }
DI float shx(const int lane, const float v, const int o) { return __int_as_float(__builtin_amdgcn_ds_bpermute((lane ^ o) << 2, __float_as_int(v))); }
DI int shx(const int lane, const int v, const int o) { return __builtin_amdgcn_ds_bpermute((lane ^ o) << 2, v); }
DI float wave_sum(const int lane, float v) {
#pragma unroll
    for (int o = 1; o < 64; o <<= 1) v += shx(lane, v, o);
    return v;
}
DI bf16x8 pack8(float a0, float a1, float a2, float a3, float a4, float a5, float a6, float a7) {
    v4u p; p.x = pk2(a0, a1); p.y = pk2(a2, a3); p.z = pk2(a4, a5); p.w = pk2(a6, a7); return __builtin_bit_cast(bf16x8, p);
}
DI float gelu_erf(float v) {
    const float av = __builtin_fabsf(v), d = av * 0.2316418882f + 1.0f, t = __builtin_amdgcn_rcpf(d);
    float q = t * 0.5307027145f + (-0.7265760135f); q = q * t + 0.7107068705f; q = q * t + (-0.142248368f); q = q * t + 0.127414796f; q = q * t;
    const float e = __builtin_amdgcn_exp2f((v * v) * (-0.72134752044f));
    const float m = v * (q * e), r = v - m;
    return v < 0.f ? m : r;
}

struct Ctx {
    int tid, lane, wave, vcu, G;
};

DI void p0_transpose_item(const float* W, int K, int N, bf16* WT, int out_row0, float scale, LAS float* scr, int k0, int n0, int lane) {
#pragma unroll 8
    for (int i = 0; i < 32; ++i) { const int kk = 2 * i + (lane >> 5); scr[kk * 33 + (lane & 31)] = W[(size_t)(k0 + kk) * N + n0 + (lane & 31)]; }
    LDS_WAIT(); asm volatile("" ::: "memory");
    const int c = lane & 7;
#pragma unroll
    for (int j = 0; j < 4; ++j) { const int n = (lane >> 3) + 8 * j; const LAS float* s = scr + (8 * c) * 33 + n;
        v4u o; o.x = pk2(s[0 * 33] * scale, s[1 * 33] * scale); o.y = pk2(s[2 * 33] * scale, s[3 * 33] * scale); o.z = pk2(s[4 * 33] * scale, s[5 * 33] * scale); o.w = pk2(s[6 * 33] * scale, s[7 * 33] * scale);
        *(v4u*)(WT + (size_t)(out_row0 + n) * K + k0 + 8 * c) = o; }
    LDS_WAIT(); asm volatile("" ::: "memory");
}
DI void cvt_stream(const float* src, bf16* dst, size_t n8, size_t gtid, size_t NT) {
    size_t i = gtid;
    for (; i + 3 * NT < n8; i += 4 * NT) {
        f32x4 a[4], b[4];
#pragma unroll
        for (int u = 0; u < 4; ++u) { a[u] = *(const f32x4*)(src + (i + u * NT) * 8); b[u] = *(const f32x4*)(src + (i + u * NT) * 8 + 4); }
#pragma unroll
        for (int u = 0; u < 4; ++u) *(v4u*)(dst + (i + u * NT) * 8) = pg8::pk8(a[u], b[u]);
    }
    for (; i < n8; i += NT) { const f32x4 a = *(const f32x4*)(src + i * 8), b = *(const f32x4*)(src + i * 8 + 4); *(v4u*)(dst + i * 8) = pg8::pk8(a, b); }
}
DI unsigned q4_i8(const f32x4 v, const float k) {
    const int a = (int)__builtin_rintf(v[0] * k), b = (int)__builtin_rintf(v[1] * k), c = (int)__builtin_rintf(v[2] * k), d = (int)__builtin_rintf(v[3] * k);
    return ((unsigned)a & 0xffu) | (((unsigned)b & 0xffu) << 8) | (((unsigned)c & 0xffu) << 16) | ((unsigned)d << 24);
}
DI void cvt_table_rows(const float* src, unsigned char* dst, float* scl  , int nrows, int gw, int NGW, int lane) {
    f32x4 nx[4];
#pragma unroll
    for (int j = 0; j < 4; ++j) nx[j] = *(const f32x4*)(src + (size_t)(gw < nrows ? gw : 0) * D + 4 * lane + 256 * j);
    for (int row = gw; row < nrows; row += NGW) {
        f32x4 v[4]; float m = 0.f; const int rn = row + NGW < nrows ? row + NGW : row;
#pragma unroll
        for (int j = 0; j < 4; ++j) { v[j] = nx[j]; nx[j] = *(const f32x4*)(src + (size_t)rn * D + 4 * lane + 256 * j);
            m = __builtin_fmaxf(m, __builtin_fmaxf(__builtin_fmaxf(__builtin_fabsf(v[j][0]), __builtin_fabsf(v[j][1])), __builtin_fmaxf(__builtin_fabsf(v[j][2]), __builtin_fabsf(v[j][3])))); }
#pragma unroll
        for (int o = 1; o < 64; o <<= 1) m = __builtin_fmaxf(m, shx(lane, m, o));
        const float k = m > 0.f ? 127.0f / m : 0.f;
#pragma unroll
        for (int j = 0; j < 4; ++j)
            *(unsigned*)(dst + ((size_t)(row >> 14) * NEXP * D) + ((size_t)(2 * j + (lane >> 5)) * NEXP + (row & (NEXP - 1))) * 128 + ((4 * lane) & 127)) = q4_i8(v[j], k);
        if (lane == 0) scl[2 * row] = m * (1.0f / 127.0f);
    }
}
struct P0Args { const float *x_p, *x_s, *w_in, *w_out, *wq, *wo, *wk, *wv, *pwq, *psk, *pu, *pv; bf16 *WinT, *WoutT, *WqT, *WoT, *WkvT, *WP, *H; unsigned char *TU, *TV; float *SU, *SV; unsigned char* X8; float* SX; };
DI void p0_prologue(const Ctx c, LAS unsigned char* lds, const P0Args a) {
    { LAS float* scr = (LAS float*)(lds + c.wave * 16384);
      const int gw = c.vcu * 8 + c.wave, NGW = c.G * 8;
      constexpr int IT_WIN = 16 * 96, IT_SQ = 16 * 32, NITEMS = 2 * IT_WIN + 8 * IT_SQ;
      for (int it = gw; it < NITEMS; it += NGW) {
          int r = it;
          if (r < 2 * IT_WIN) { const int l = r / IT_WIN; r -= l * IT_WIN; const int kb = r / 96, nb = r % 96, n0 = 32 * nb; int orow;
              if (n0 < 1024) orow = 2048 + n0; else if (n0 < 2048) { const int d = n0 - 1024; orow = 256 * (d >> 7) + (d & 127); } else { const int d = n0 - 2048; orow = 256 * (d >> 7) + 128 + (d & 127); }
              p0_transpose_item(a.w_in + (size_t)l * 1024 * 3072, 1024, 3072, a.WinT + (size_t)l * 3072 * 1024, orow, 1.f, scr, 64 * kb, n0, c.lane); continue; }
          r -= 2 * IT_WIN; const int m = r / IT_SQ; r -= m * IT_SQ; const int kb = r >> 5, nb = r & 31;
          const float* src; bf16* dst; float sc = 1.f; const size_t SQ = (size_t)1024 * 1024;
          if (m < 2) { src = a.w_out + m * SQ; dst = a.WoutT + m * SQ; }
          else if (m < 4) { src = a.wq + (m - 2) * SQ; dst = a.WqT + (m - 2) * SQ; sc = 0.125f * LOG2E; }
          else if (m < 6) { src = a.wo + (m - 4) * SQ; dst = a.WoT + (m - 4) * SQ; }
          else if (m == 6) { src = a.wk; dst = a.WkvT; }
          else { src = a.wv; dst = a.WkvT + SQ; }
          p0_transpose_item(src, 1024, 1024, dst, 32 * nb, sc, scr, 64 * kb, 32 * nb, c.lane);
      }
    }
    __syncthreads();
    { LAS float* skT = (LAS float*)lds; LAS float* wqT = skT + 128 * 132;
      for (int u = c.vcu; u < 4 * 16 * 16; u += c.G) {
          const int l = u >> 8, hp = (u >> 4) & 15, dblk = u & 15;
          for (int i = c.tid; i < 16384; i += 512) skT[(i & 127) * 132 + (i >> 7)] = a.psk[(size_t)(l * 16 + hp) * 16384 + i];
          for (int i = c.tid; i < 8192; i += 512) wqT[(i & 127) * 68 + (i >> 7)] = a.pwq[((size_t)l * 1024 + dblk * 64 + (i >> 7)) * 2048 + hp * 128 + (i & 127)];
          __syncthreads();
          const int ng = c.tid & 31, dg = c.tid >> 5; f32x4 acc[4];
#pragma unroll
          for (int i = 0; i < 4; ++i) acc[i] = (f32x4){0.f, 0.f, 0.f, 0.f};
#pragma unroll 4
          for (int cc = 0; cc < 128; ++cc) { const f32x4 s = *(const LAS f32x4*)(skT + cc * 132 + 4 * ng), w = *(const LAS f32x4*)(wqT + cc * 68 + 4 * dg);
#pragma unroll
              for (int i = 0; i < 4; ++i) acc[i] = acc[i] + w * s[i]; }
#pragma unroll
          for (int i = 0; i < 4; ++i) { v2u o; o.x = pk2(acc[i][0], acc[i][1]); o.y = pk2(acc[i][2], acc[i][3]);
              *(v2u*)(a.WP + ((size_t)l * 2048 + hp * 128 + 4 * ng + i) * 1024 + dblk * 64 + 4 * dg) = o; }
          __syncthreads();
      }
    }
    { const size_t gtid = (size_t)c.vcu * 512 + c.tid, NT = (size_t)c.G * 512;
      cvt_table_rows(a.pu, a.TU, a.SU, NLAYER * NEXP, c.vcu * 8 + c.wave, c.G * 8, c.lane);
      cvt_table_rows(a.pv, a.TV, a.SV, NLAYER * NEXP, c.vcu * 8 + c.wave, c.G * 8, c.lane);
      (void)gtid; (void)NT;
      for (int m = c.vcu * 8 + c.wave; m < T; m += c.G * 8) {
          const float* xr = (m < TP ? a.x_p + (size_t)m * D : a.x_s + (size_t)(m - TP) * D) + 4 * c.lane;
          f32x4 v[4]; float am = 0.f;
#pragma unroll
          for (int j = 0; j < 4; ++j) { v[j] = *(const f32x4*)(xr + 256 * j); v2u w; w.x = pk2(v[j][0], v[j][1]); w.y = pk2(v[j][2], v[j][3]); ((v2u*)(a.H + (size_t)m * D) + c.lane)[64 * j] = w;
              am = __builtin_fmaxf(am, __builtin_fmaxf(__builtin_fmaxf(__builtin_fabsf(v[j][0]), __builtin_fabsf(v[j][1])), __builtin_fmaxf(__builtin_fabsf(v[j][2]), __builtin_fabsf(v[j][3])))); }
#pragma unroll
          for (int o = 1; o < 64; o <<= 1) am = __builtin_fmaxf(am, shx(c.lane, am, o));
          const float k = am > 0.f ? 127.0f / am : 0.f;
#pragma unroll
          for (int j = 0; j < 4; ++j) *(unsigned*)(a.X8 + (size_t)m * D + 4 * c.lane + 256 * j) = q4_i8(v[j], k);
          if (c.lane == 0) a.SX[m] = am * (1.0f / 127.0f);
      }
    }
}

DI void wp_quant_phase(const Ctx c, const bf16* WPb, unsigned char* WP8q, float* swp) {
    for (int row = c.vcu * 8 + c.wave; row < W8_ROWS; row += c.G * 8) {
        const v4u a = *(const v4u*)(WPb + (size_t)row * D + 16 * c.lane), b = *(const v4u*)(WPb + (size_t)row * D + 16 * c.lane + 8);
        const f32x4 v0 = {bflo(a.x), bfhi(a.x), bflo(a.y), bfhi(a.y)}, v1 = {bflo(a.z), bfhi(a.z), bflo(a.w), bfhi(a.w)}, v2 = {bflo(b.x), bfhi(b.x), bflo(b.y), bfhi(b.y)}, v3 = {bflo(b.z), bfhi(b.z), bflo(b.w), bfhi(b.w)};
        float m = 0.f;
#pragma unroll
        for (int i = 0; i < 4; ++i) m = __builtin_fmaxf(m, __builtin_fmaxf(__builtin_fmaxf(__builtin_fabsf(v0[i]), __builtin_fabsf(v1[i])), __builtin_fmaxf(__builtin_fabsf(v2[i]), __builtin_fabsf(v3[i]))));
#pragma unroll
        for (int o = 1; o < 64; o <<= 1) m = __builtin_fmaxf(m, shx(c.lane, m, o));
        const float k = m > 0.f ? 127.0f / m : 0.f;
        v4u o; o.x = q4_i8(v0, k); o.y = q4_i8(v1, k); o.z = q4_i8(v2, k); o.w = q4_i8(v3, k);
        *(v4u*)(WP8q + (size_t)row * D + 16 * c.lane) = o;
        if (c.lane == 0) swp[row] = m * (1.0f / 127.0f);
    }
}

DI void ld8_bf16(const bf16* p, float (&o)[8]) { const v4u w = *(const v4u*)p; o[0] = bflo(w.x); o[1] = bfhi(w.x); o[2] = bflo(w.y); o[3] = bfhi(w.y); o[4] = bflo(w.z); o[5] = bfhi(w.z); o[6] = bflo(w.w); o[7] = bfhi(w.w); }
DI void ld8_f32(const float* p, float (&o)[8]) { const f32x4 a = *(const f32x4*)p, b = *(const f32x4*)(p + 4); o[0] = a[0]; o[1] = a[1]; o[2] = a[2]; o[3] = a[3]; o[4] = b[0]; o[5] = b[1]; o[6] = b[2]; o[7] = b[3]; }
DI void conv_gate_phase(const Ctx c, const bf16* U, bf16* Bg, const float* wdw  , const float* st  , float* convp, float* convs  ,
                        unsigned char* z8, float* sz  , const bool skip_samp = false  ) {
    const int gw = c.vcu * 8 + c.wave, NGW = c.G * 8, dc = 16 * c.lane;
    float w0[16], w1[16], w2[16];
    { float t8[8]; ld8_f32(wdw + dc, t8);
#pragma unroll
      for (int i = 0; i < 8; ++i) w0[i] = t8[i]; ld8_f32(wdw + dc + 8, t8);
#pragma unroll
      for (int i = 0; i < 8; ++i) w0[8 + i] = t8[i]; ld8_f32(wdw + D + dc, t8);
#pragma unroll
      for (int i = 0; i < 8; ++i) w1[i] = t8[i]; ld8_f32(wdw + D + dc + 8, t8);
#pragma unroll
      for (int i = 0; i < 8; ++i) w1[8 + i] = t8[i]; ld8_f32(wdw + 2 * D + dc, t8);
#pragma unroll
      for (int i = 0; i < 8; ++i) w2[i] = t8[i]; ld8_f32(wdw + 2 * D + dc + 8, t8);
#pragma unroll
      for (int i = 0; i < 8; ++i) w2[8 + i] = t8[i]; }
    { v4u ng[2], n2[2], n1[2], n0[2];
#define CG_LOAD(tt_) do { const int t_ = (tt_), s_ = t_ & 2047, t1_ = s_ >= 1 ? t_ - 1 : t_, t0_ = s_ >= 2 ? t_ - 2 : t_; \
        _Pragma("unroll") for (int hf = 0; hf < 2; ++hf) { ng[hf] = *(const v4u*)(Bg + (size_t)t_ * D + dc + 8 * hf); n2[hf] = *(const v4u*)(U + (size_t)t_ * D + dc + 8 * hf); \
            n1[hf] = *(const v4u*)(U + (size_t)t1_ * D + dc + 8 * hf); n0[hf] = *(const v4u*)(U + (size_t)t0_ * D + dc + 8 * hf); } } while (0)
      if (gw < TP) CG_LOAD(gw);
      for (int t = gw; t < TP; t += NGW) {
          const int s = t & 2047; const float f1 = s >= 1 ? 1.f : 0.f, f0 = s >= 2 ? 1.f : 0.f;
          v4u cg[2], c2[2], c1[2], c0[2];
#pragma unroll
          for (int hf = 0; hf < 2; ++hf) { cg[hf] = ng[hf]; c2[hf] = n2[hf]; c1[hf] = n1[hf]; c0[hf] = n0[hf]; }
          CG_LOAD(t + NGW < TP ? t + NGW : t);
          float z[16]; float am = 0.f;
#pragma unroll
          for (int hf = 0; hf < 2; ++hf) { const unsigned wg[4] = {cg[hf].x, cg[hf].y, cg[hf].z, cg[hf].w}, w2_[4] = {c2[hf].x, c2[hf].y, c2[hf].z, c2[hf].w}, w1_[4] = {c1[hf].x, c1[hf].y, c1[hf].z, c1[hf].w}, w0_[4] = {c0[hf].x, c0[hf].y, c0[hf].z, c0[hf].w};
#pragma unroll
              for (int i = 0; i < 8; ++i) { const bool hi = i & 1; const int k = i >> 1;
                  const float g = hi ? bfhi(wg[k]) : bflo(wg[k]), u2 = hi ? bfhi(w2_[k]) : bflo(w2_[k]), u1 = (hi ? bfhi(w1_[k]) : bflo(w1_[k])) * f1, u0 = (hi ? bfhi(w0_[k]) : bflo(w0_[k])) * f0;
                  const float zz = g * (w0[8 * hf + i] * u0 + w1[8 * hf + i] * u1 + w2[8 * hf + i] * u2); z[8 * hf + i] = zz; am = __builtin_fmaxf(am, __builtin_fabsf(zz)); } }
#pragma unroll
          for (int o = 1; o < 64; o <<= 1) am = __builtin_fmaxf(am, shx(c.lane, am, o));
          const float k = am > 0.f ? 127.0f / am : 0.f;
          v4u q; q.x = q4_i8((f32x4){z[0], z[1], z[2], z[3]}, k); q.y = q4_i8((f32x4){z[4], z[5], z[6], z[7]}, k); q.z = q4_i8((f32x4){z[8], z[9], z[10], z[11]}, k); q.w = q4_i8((f32x4){z[12], z[13], z[14], z[15]}, k);
          *(v4u*)(z8 + (size_t)t * D + dc) = q;
          if (c.lane == 0) sz[t] = am * (1.0f / 127.0f);
      }
#undef CG_LOAD
    }
    for (int t = TP + gw; t < (skip_samp ? TP : T); t += NGW) {
        const bool samp = true; const int s = (t - TP) & 15; const int b = (t - TP) >> 4;
        float z[16]; float am = 0.f;
#pragma unroll
        for (int hf = 0; hf < 2; ++hf) { const int d0 = dc + 8 * hf;
            float u0[8], u1[8], u2[8], g[8];
            ld8_bf16(U + (size_t)t * D + d0, u2);
            { float* cdst = nullptr;
              (void)convp;
              if (samp && s >= DSEQ - 2) cdst = convs + ((size_t)b * 2 + (s - (DSEQ - 2))) * D + d0;
              if (cdst) { *(f32x4*)cdst = (f32x4){u2[0], u2[1], u2[2], u2[3]}; *(f32x4*)(cdst + 4) = (f32x4){u2[4], u2[5], u2[6], u2[7]}; } }
            if (s >= 1) ld8_bf16(U + (size_t)(t - 1) * D + d0, u1);
            else if (samp) ld8_f32(st + ((size_t)b * 2 + 1) * D + d0, u1);
            else {
#pragma unroll
                for (int i = 0; i < 8; ++i) u1[i] = 0.f; }
            if (s >= 2) ld8_bf16(U + (size_t)(t - 2) * D + d0, u0);
            else if (samp) ld8_f32(st + ((size_t)b * 2 + (s == 1 ? 1 : 0)) * D + d0, u0);
            else {
#pragma unroll
                for (int i = 0; i < 8; ++i) u0[i] = 0.f; }
            ld8_bf16(Bg + (size_t)t * D + d0, g);
#pragma unroll
            for (int i = 0; i < 8; ++i) { const float zz = g[i] * (w0[8 * hf + i] * u0[i] + w1[8 * hf + i] * u1[i] + w2[8 * hf + i] * u2[i]); z[8 * hf + i] = zz; am = __builtin_fmaxf(am, __builtin_fabsf(zz)); }
        }
        if (samp) {
            v4u o0, o1; o0.x = pk2(z[0], z[1]); o0.y = pk2(z[2], z[3]); o0.z = pk2(z[4], z[5]); o0.w = pk2(z[6], z[7]); o1.x = pk2(z[8], z[9]); o1.y = pk2(z[10], z[11]); o1.z = pk2(z[12], z[13]); o1.w = pk2(z[14], z[15]);
            *(v4u*)(Bg + (size_t)t * D + dc) = o0; *(v4u*)(Bg + (size_t)t * D + dc + 8) = o1; }
#pragma unroll
        for (int o = 1; o < 64; o <<= 1) am = __builtin_fmaxf(am, shx(c.lane, am, o));
        const float k = am > 0.f ? 127.0f / am : 0.f;
        v4u q; q.x = q4_i8((f32x4){z[0], z[1], z[2], z[3]}, k); q.y = q4_i8((f32x4){z[4], z[5], z[6], z[7]}, k); q.z = q4_i8((f32x4){z[8], z[9], z[10], z[11]}, k); q.w = q4_i8((f32x4){z[12], z[13], z[14], z[15]}, k);
        *(v4u*)(z8 + (size_t)t * D + dc) = q;
        if (c.lane == 0) sz[t] = am * (1.0f / 127.0f);
    }
}

DI void ln_phase(const Ctx c, const bf16* R, bf16* H, const float* g, const float* bb, float* yout = nullptr, const bf16* Hres = nullptr, unsigned char* x8 = nullptr, float* sx = nullptr) {
    const int gw = c.vcu * 8 + c.wave, NGW = c.G * 8;
    float gv[2][8], bv[2][8];
#pragma unroll
    for (int j = 0; j < 2; ++j) { ld8_f32(g + 8 * c.lane + 512 * j, gv[j]); ld8_f32(bb + 8 * c.lane + 512 * j, bv[j]); }
    v4u rw[2], hw[2];
#pragma unroll
    for (int j = 0; j < 2; ++j) { const int m0 = gw < T ? gw : 0; rw[j] = *(const v4u*)(R + (size_t)m0 * D + 8 * c.lane + 512 * j); hw[j] = Hres ? *(const v4u*)(Hres + (size_t)m0 * D + 8 * c.lane + 512 * j) : (v4u){0u, 0u, 0u, 0u}; }
    for (int m = gw; m < T; m += NGW) {
        float v[2][8]; float s = 0.f;
#pragma unroll
        for (int j = 0; j < 2; ++j) { const unsigned w[4] = {rw[j].x, rw[j].y, rw[j].z, rw[j].w}, hq[4] = {hw[j].x, hw[j].y, hw[j].z, hw[j].w};
#pragma unroll
            for (int i = 0; i < 4; ++i) { v[j][2 * i] = bflo(w[i]); v[j][2 * i + 1] = bfhi(w[i]); if (Hres) { v[j][2 * i] += bflo(hq[i]) * ALPHA; v[j][2 * i + 1] += bfhi(hq[i]) * ALPHA; } }
#pragma unroll
            for (int i = 0; i < 8; ++i) s += v[j][i]; }
        { const int mn = m + NGW < T ? m + NGW : m;
#pragma unroll
          for (int j = 0; j < 2; ++j) { rw[j] = *(const v4u*)(R + (size_t)mn * D + 8 * c.lane + 512 * j); if (Hres) hw[j] = *(const v4u*)(Hres + (size_t)mn * D + 8 * c.lane + 512 * j); } }
        const float mean = wave_sum(c.lane, s) * (1.f / D); float s2 = 0.f;
#pragma unroll
        for (int j = 0; j < 2; ++j)
#pragma unroll
            for (int i = 0; i < 8; ++i) { v[j][i] -= mean; s2 += v[j][i] * v[j][i]; }
        const float rstd = __builtin_amdgcn_rsqf(wave_sum(c.lane, s2) * (1.f / D) + LN_EPS);
        float am = 0.f;
#pragma unroll
        for (int j = 0; j < 2; ++j)
#pragma unroll
            for (int i = 0; i < 8; ++i) { v[j][i] = v[j][i] * rstd * gv[j][i] + bv[j][i]; am = __builtin_fmaxf(am, __builtin_fabsf(v[j][i])); }
        if (yout) {
#pragma unroll
            for (int j = 0; j < 2; ++j) { float* o = yout + (size_t)m * D + 8 * c.lane + 512 * j; *(f32x4*)o = (f32x4){v[j][0], v[j][1], v[j][2], v[j][3]}; *(f32x4*)(o + 4) = (f32x4){v[j][4], v[j][5], v[j][6], v[j][7]}; }
        } else {
#pragma unroll
            for (int j = 0; j < 2; ++j) { v4u w; w.x = pk2(v[j][0], v[j][1]); w.y = pk2(v[j][2], v[j][3]); w.z = pk2(v[j][4], v[j][5]); w.w = pk2(v[j][6], v[j][7]); *(v4u*)(H + (size_t)m * D + 8 * c.lane + 512 * j) = w; }
            if (x8) {
#pragma unroll
                for (int o = 1; o < 64; o <<= 1) am = __builtin_fmaxf(am, shx(c.lane, am, o));
                const float k = am > 0.f ? 127.0f / am : 0.f;
#pragma unroll
                for (int j = 0; j < 2; ++j) { v2u q; q.x = q4_i8((f32x4){v[j][0], v[j][1], v[j][2], v[j][3]}, k); q.y = q4_i8((f32x4){v[j][4], v[j][5], v[j][6], v[j][7]}, k); *(v2u*)(x8 + (size_t)m * D + 8 * c.lane + 512 * j) = q; }
                if (c.lane == 0) sx[m] = am * (1.0f / 127.0f);
            } }
    }
}

DI int ordi(float x) { const int b = __float_as_int(x); return b ^ ((b >> 31) & 0x7fffffff); }
DI float unordi(int o) { return __int_as_float(o ^ ((o >> 31) & 0x7fffffff)); }
#define TK_CE(a, b) do { const int _hi = (a) > (b) ? (a) : (b), _lo = (a) > (b) ? (b) : (a); (a) = _hi; (b) = _lo; } while (0)
#define TK_CPK(i, j) ((ordi(va[i] + vb[j]) & ~255) | (255 - ((i) * 16 + (j))))
#define TK_SORT16(v) do { TK_CE(v[0], v[1]); TK_CE(v[2], v[3]); TK_CE(v[0], v[2]); TK_CE(v[1], v[3]); TK_CE(v[1], v[2]); TK_CE(v[4], v[5]); TK_CE(v[6], v[7]); TK_CE(v[4], v[6]); TK_CE(v[5], v[7]); TK_CE(v[5], v[6]); TK_CE(v[0], v[4]); TK_CE(v[2], v[6]); TK_CE(v[2], v[4]); TK_CE(v[1], v[5]); TK_CE(v[3], v[7]); TK_CE(v[3], v[5]); TK_CE(v[1], v[2]); TK_CE(v[3], v[4]); TK_CE(v[5], v[6]); TK_CE(v[8], v[9]); TK_CE(v[10], v[11]); TK_CE(v[8], v[10]); TK_CE(v[9], v[11]); TK_CE(v[9], v[10]); TK_CE(v[12], v[13]); TK_CE(v[14], v[15]); TK_CE(v[12], v[14]); TK_CE(v[13], v[15]); TK_CE(v[13], v[14]); TK_CE(v[8], v[12]); TK_CE(v[10], v[14]); TK_CE(v[10], v[12]); TK_CE(v[9], v[13]); TK_CE(v[11], v[15]); TK_CE(v[11], v[13]); TK_CE(v[9], v[10]); TK_CE(v[11], v[12]); TK_CE(v[13], v[14]); TK_CE(v[0], v[8]); TK_CE(v[4], v[12]); TK_CE(v[4], v[8]); TK_CE(v[2], v[10]); TK_CE(v[6], v[14]); TK_CE(v[6], v[10]); TK_CE(v[2], v[4]); TK_CE(v[6], v[8]); TK_CE(v[10], v[12]); TK_CE(v[1], v[9]); TK_CE(v[5], v[13]); TK_CE(v[5], v[9]); TK_CE(v[3], v[11]); TK_CE(v[7], v[15]); TK_CE(v[7], v[11]); TK_CE(v[3], v[5]); TK_CE(v[7], v[9]); TK_CE(v[11], v[13]); TK_CE(v[1], v[2]); TK_CE(v[3], v[4]); TK_CE(v[5], v[6]); TK_CE(v[7], v[8]); TK_CE(v[9], v[10]); TK_CE(v[11], v[12]); TK_CE(v[13], v[14]); } while (0)
#define TK_BMERGE16(v) do { TK_CE(v[0], v[8]); TK_CE(v[1], v[9]); TK_CE(v[2], v[10]); TK_CE(v[3], v[11]); TK_CE(v[4], v[12]); TK_CE(v[5], v[13]); TK_CE(v[6], v[14]); TK_CE(v[7], v[15]); TK_CE(v[0], v[4]); TK_CE(v[1], v[5]); TK_CE(v[2], v[6]); TK_CE(v[3], v[7]); TK_CE(v[8], v[12]); TK_CE(v[9], v[13]); TK_CE(v[10], v[14]); TK_CE(v[11], v[15]); TK_CE(v[0], v[2]); TK_CE(v[1], v[3]); TK_CE(v[4], v[6]); TK_CE(v[5], v[7]); TK_CE(v[8], v[10]); TK_CE(v[9], v[11]); TK_CE(v[12], v[14]); TK_CE(v[13], v[15]); TK_CE(v[0], v[1]); TK_CE(v[2], v[3]); TK_CE(v[4], v[5]); TK_CE(v[6], v[7]); TK_CE(v[8], v[9]); TK_CE(v[10], v[11]); TK_CE(v[12], v[13]); TK_CE(v[14], v[15]); } while (0)
#define TK_CAND0(B) do { B[0] = TK_CPK(0, 0); B[1] = TK_CPK(0, 1); B[2] = TK_CPK(0, 2); B[3] = TK_CPK(0, 3); B[4] = TK_CPK(0, 4); B[5] = TK_CPK(0, 5); B[6] = TK_CPK(0, 6); B[7] = TK_CPK(0, 7); B[8] = TK_CPK(0, 8); B[9] = TK_CPK(0, 9); B[10] = TK_CPK(0, 10); B[11] = TK_CPK(0, 11); B[12] = TK_CPK(0, 12); B[13] = TK_CPK(0, 13); B[14] = TK_CPK(0, 14); B[15] = TK_CPK(0, 15); } while (0)
#define TK_CAND1(B) do { B[0] = TK_CPK(1, 0); B[1] = TK_CPK(1, 1); B[2] = TK_CPK(1, 2); B[3] = TK_CPK(1, 3); B[4] = TK_CPK(1, 4); B[5] = TK_CPK(1, 5); B[6] = TK_CPK(1, 6); B[7] = TK_CPK(1, 7); B[8] = TK_CPK(2, 0); B[9] = TK_CPK(2, 1); B[10] = TK_CPK(2, 2); B[11] = TK_CPK(2, 3); B[12] = TK_CPK(2, 4); B[13] = TK_CPK(3, 0); B[14] = TK_CPK(3, 1); B[15] = TK_CPK(3, 2); } while (0)
#define TK_CAND2(B) do { B[0] = TK_CPK(3, 3); B[1] = TK_CPK(4, 0); B[2] = TK_CPK(4, 1); B[3] = TK_CPK(4, 2); B[4] = TK_CPK(5, 0); B[5] = TK_CPK(5, 1); B[6] = TK_CPK(6, 0); B[7] = TK_CPK(6, 1); B[8] = TK_CPK(7, 0); B[9] = TK_CPK(7, 1); B[10] = TK_CPK(8, 0); B[11] = TK_CPK(9, 0); B[12] = TK_CPK(10, 0); B[13] = TK_CPK(11, 0); B[14] = TK_CPK(12, 0); B[15] = TK_CPK(13, 0); } while (0)
#define TK_CAND3(B) do { B[0] = TK_CPK(14, 0); B[1] = TK_CPK(15, 0); B[2] = (int)0x80000000; B[3] = (int)0x80000000; B[4] = (int)0x80000000; B[5] = (int)0x80000000; B[6] = (int)0x80000000; B[7] = (int)0x80000000; B[8] = (int)0x80000000; B[9] = (int)0x80000000; B[10] = (int)0x80000000; B[11] = (int)0x80000000; B[12] = (int)0x80000000; B[13] = (int)0x80000000; B[14] = (int)0x80000000; B[15] = (int)0x80000000; } while (0)
DI void tk_merge(int (&L)[16], const int (&B)[16]) {
#pragma unroll
    for (int i = 0; i < 16; ++i) L[i] = L[i] > B[15 - i] ? L[i] : B[15 - i];
    TK_BMERGE16(L);
}
DI void tk_feed32(int (&L)[16], const v4u (&x)[4], const int rb) {
#pragma unroll
    for (int hf = 0; hf < 2; ++hf) { int B[16]; const unsigned w[8] = {x[2 * hf].x, x[2 * hf].y, x[2 * hf].z, x[2 * hf].w, x[2 * hf + 1].x, x[2 * hf + 1].y, x[2 * hf + 1].z, x[2 * hf + 1].w};
#pragma unroll
        for (int j = 0; j < 16; ++j) B[j] = (ordi(__uint_as_float((j & 1) ? (w[j >> 1] & 0xffff0000u) : (w[j >> 1] << 16))) & ~127) | (127 - ((rb + 16 * hf + j) & 127));
        TK_SORT16(B); tk_merge(L, B); }
}
DI unsigned byte_of(unsigned a0, unsigned a1, unsigned a2, unsigned a3, int i) { const unsigned lo = i < 4 ? a0 : a1, hi = i < 12 ? a2 : a3, w = i < 8 ? lo : hi; return (w >> ((i & 3) * 8)) & 0xffu; }
DI void topk_phase(const Ctx c, const bf16* Sc  , unsigned short* ids, float* gates) {
    const int gw = c.wave * c.G + c.vcu, NGW = c.G * 8, NU = 8 * (T / 64);
    v4u bufA[4], bufB[4];
    if (gw < NU) { const v4u* sc = (const v4u*)(Sc + (size_t)((gw % (T / 64)) * 64 + c.lane) * 2048 + (gw / (T / 64)) * 256);
#pragma unroll
        for (int j = 0; j < 4; ++j) bufA[j] = sc[j]; }
#pragma unroll 1
    for (int wu = gw; wu < NU; wu += NGW) {
        const int h = wu / (T / 64), t = (wu % (T / 64)) * 64 + c.lane;
        const v4u* sc = (const v4u*)(Sc + (size_t)t * 2048 + h * 256);
        const int wn = wu + NGW < NU ? wu + NGW : wu;
        const v4u* scn = (const v4u*)(Sc + (size_t)((wn % (T / 64)) * 64 + c.lane) * 2048 + (wn / (T / 64)) * 256);
        int Lw[16], La[16];
#pragma unroll
        for (int i = 0; i < 16; ++i) { Lw[i] = (int)0x80000000; La[i] = 0; }
#pragma unroll 1
        for (int it = 0; it < 4; ++it) {
#pragma unroll
            for (int j = 0; j < 4; ++j) bufB[j] = sc[8 * it + 4 + j];
            tk_feed32(Lw, bufA, 64 * it);
            { const v4u* nx = it < 3 ? sc + 8 * (it + 1) : scn;
#pragma unroll
              for (int j = 0; j < 4; ++j) bufA[j] = nx[j]; }
            tk_feed32(Lw, bufB, 64 * it + 32);
            if (it == 1) {
#pragma unroll
                for (int i = 0; i < 16; ++i) { La[i] = Lw[i]; Lw[i] = (int)0x80000000; } }
        }
        float va[16], vb[16]; unsigned IA0 = 0u, IA1 = 0u, IA2 = 0u, IA3 = 0u, IB0 = 0u, IB1 = 0u, IB2 = 0u, IB3 = 0u;
#pragma unroll
        for (int i = 0; i < 16; ++i) { va[i] = unordi(La[i] & ~127); vb[i] = unordi(Lw[i] & ~127);
            const unsigned ea = (unsigned)(127 - (La[i] & 127)) << ((i & 3) * 8), eb = (unsigned)(127 - (Lw[i] & 127)) << ((i & 3) * 8);
            if ((i >> 2) == 0) { IA0 |= ea; IB0 |= eb; } else if ((i >> 2) == 1) { IA1 |= ea; IB1 |= eb; } else if ((i >> 2) == 2) { IA2 |= ea; IB2 |= eb; } else { IA3 |= ea; IB3 |= eb; } }
        int F[16];
        { int B[16]; TK_CAND0(B); TK_SORT16(B);
#pragma unroll
          for (int i = 0; i < 16; ++i) F[i] = B[i]; }
        { int B[16]; TK_CAND1(B); TK_SORT16(B); tk_merge(F, B); }
        { int B[16]; TK_CAND2(B); TK_SORT16(B); tk_merge(F, B); }
        { int B[16]; TK_CAND3(B); TK_SORT16(B); tk_merge(F, B); }
        float sc_[16], den = 0.f; unsigned ex[16];
        const float mx = unordi(F[0] & ~255);
#pragma unroll
        for (int k = 0; k < 16; ++k) { const int code = 255 - (F[k] & 255); sc_[k] = __builtin_amdgcn_exp2f((unordi(F[k] & ~255) - mx) * LOG2E); den += sc_[k];
            ex[k] = byte_of(IA0, IA1, IA2, IA3, code >> 4) * 128u + byte_of(IB0, IB1, IB2, IB3, code & 15); }
        const float inv = 1.0f / den;
        v4u e0, e1; e0.x = ex[0] | (ex[1] << 16); e0.y = ex[2] | (ex[3] << 16); e0.z = ex[4] | (ex[5] << 16); e0.w = ex[6] | (ex[7] << 16);
        e1.x = ex[8] | (ex[9] << 16); e1.y = ex[10] | (ex[11] << 16); e1.z = ex[12] | (ex[13] << 16); e1.w = ex[14] | (ex[15] << 16);
        v4u* ip = (v4u*)(ids + (size_t)t * 128 + h * 16); ip[0] = e0; ip[1] = e1;
        f32x4* gp = (f32x4*)(gates + (size_t)t * 128 + h * 16);
#pragma unroll
        for (int k = 0; k < 4; ++k) gp[k] = (f32x4){sc_[4 * k] * inv, sc_[4 * k + 1] * inv, sc_[4 * k + 2] * inv, sc_[4 * k + 3] * inv};
    }
}

typedef float f2 __attribute__((ext_vector_type(2)));
constexpr int QCH = 16, QN = T / QCH;
static_assert(T % QCH == 0, "queue chunks");
struct ChunkQ { int xme, s; unsigned pend; unsigned* q; };
struct Chunk { int base, xs; };
DI unsigned cq_ticket(unsigned* qw, int lane) { unsigned v = 0u; if (lane == 0) v = __hip_atomic_fetch_add(qw, 1u, __ATOMIC_RELAXED, __HIP_MEMORY_SCOPE_AGENT); return v; }
DI void cq_init(ChunkQ& g, unsigned* q, int lane) { g.xme = (int)(xb_xcc_id() & 7u); g.s = 0; g.q = q; g.pend = cq_ticket(q + g.xme * 64, lane); }
DI Chunk cq_next(ChunkQ& g, int lane) {
    for (;;) {
        if (g.s >= 8) return Chunk{-1, 0};
        const unsigned chunk = (unsigned)__builtin_amdgcn_readfirstlane((int)g.pend); const int xs = (g.xme + g.s) & 7;
        if (chunk < (unsigned)QN) { g.pend = cq_ticket(g.q + xs * 64, lane); return Chunk{(int)chunk * QCH, xs}; }
        ++g.s; if (g.s < 8) g.pend = cq_ticket(g.q + ((g.xme + g.s) & 7) * 64, lane);
    }
}
struct SliceIds { v4u ia, ib; int t, xs; };
struct SliceAux { v4u a0; float s; };
DI SliceIds slice_load_ids(const int t, const int xs, const int lane, const unsigned short* ids) {
    const int j = lane >> 3, tc = t < 0 ? 0 : t; SliceIds r; r.t = t; r.xs = xs;
    r.ia = *(const v4u*)(ids + (size_t)tc * 128 + 16 * j); r.ib = *(const v4u*)(ids + (size_t)tc * 128 + 16 * j + 8); return r;
}
template <int MODE>
DI SliceAux slice_load_aux(const int t, const int xs, const int lane, const unsigned char* x8, const unsigned char* w8, const float* sw) {
    const int j = lane >> 3, i = lane & 7, tc = t < 0 ? 0 : t; SliceAux r;
    if (MODE == 0) { r.a0 = *(const v4u*)(x8 + (size_t)tc * D + 128 * xs + 16 * i); r.s = 0.f; }
    else { r.a0 = *(const v4u*)(w8 + (size_t)tc * 128 + 16 * j); r.s = sw[tc]; }
    return r;
}
template <int VAR>
DI void slice_issue(v4u (&vr)[16], const SliceIds& n, const unsigned char* T8, const int lane) {
    const unsigned char* base = T8 + (size_t)n.xs * NEXP * 128 + 16 * (lane & 7);
    const unsigned idv[8] = {n.ia.x, n.ia.y, n.ia.z, n.ia.w, n.ib.x, n.ib.y, n.ib.z, n.ib.w};
#pragma unroll
    for (int g = 0; g < 16; ++g) { unsigned e = (g & 1) ? (idv[g >> 1] >> 16) : (idv[g >> 1] & 0xffffu); if (VAR == 2) e &= 15u; vr[g] = *(const v4u*)(base + (size_t)e * 128); }
}
DI int dot16_i8(const v4u a, const v4u b, int acc) {
    acc = __builtin_amdgcn_sdot4((int)a.x, (int)b.x, acc, false); acc = __builtin_amdgcn_sdot4((int)a.y, (int)b.y, acc, false);
    acc = __builtin_amdgcn_sdot4((int)a.z, (int)b.z, acc, false); acc = __builtin_amdgcn_sdot4((int)a.w, (int)b.w, acc, false); return acc;
}
DI void tr4_dot(int& c0, int& c1, int& c2, int& c3, const unsigned a, const unsigned b, const unsigned cc, const unsigned d, const int w) {
    const unsigned p = __builtin_amdgcn_perm(b, a, 0x05010400u), q = __builtin_amdgcn_perm(b, a, 0x07030602u), r = __builtin_amdgcn_perm(d, cc, 0x05010400u), s = __builtin_amdgcn_perm(d, cc, 0x07030602u);
    c0 = __builtin_amdgcn_sdot4((int)__builtin_amdgcn_perm(r, p, 0x05040100u), w, c0, false); c1 = __builtin_amdgcn_sdot4((int)__builtin_amdgcn_perm(r, p, 0x07060302u), w, c1, false);
    c2 = __builtin_amdgcn_sdot4((int)__builtin_amdgcn_perm(s, q, 0x05040100u), w, c2, false); c3 = __builtin_amdgcn_sdot4((int)__builtin_amdgcn_perm(s, q, 0x07060302u), w, c3, false);
}
template <int MODE, int VAR>
DI void slice_compute(const int lane, const v4u (&vr)[16], const int t, const int xs, const SliceAux& n, float* OUT) {
    const int j = lane >> 3, i = lane & 7;
    if (VAR == 1) {
        unsigned x = n.a0.x ^ n.a0.y;
#pragma unroll
        for (int g = 0; g < 16; ++g) x ^= vr[g].x ^ vr[g].y ^ vr[g].z ^ vr[g].w;
        *(unsigned*)((bf16*)OUT + (size_t)t * D + 128 * xs + 2 * lane) = x;
    } else if (MODE == 0) {
        int d[16];
#pragma unroll
        for (int g = 0; g < 16; ++g) d[g] = dot16_i8(vr[g], n.a0, 0);
        int r8[8], r4[4], r2[2];
#pragma unroll
        for (int q = 0; q < 8; ++q) { const bool od = lane & 1; const int keep = od ? d[8 + q] : d[q], send = od ? d[q] : d[8 + q]; r8[q] = keep + shx(lane, send, 1); }
#pragma unroll
        for (int q = 0; q < 4; ++q) { const bool od = lane & 2; const int keep = od ? r8[4 + q] : r8[q], send = od ? r8[q] : r8[4 + q]; r4[q] = keep + shx(lane, send, 2); }
#pragma unroll
        for (int q = 0; q < 2; ++q) { const bool od = lane & 4; const int keep = od ? r4[2 + q] : r4[q], send = od ? r4[q] : r4[2 + q]; r2[q] = keep + shx(lane, send, 4); }
        const int g0 = 8 * (i & 1) + 4 * ((i >> 1) & 1) + 2 * (i >> 2);
        *((unsigned*)OUT + ((size_t)xs * T + t) * 64 + 8 * j + (g0 >> 1)) = ((unsigned)((r2[0] + 32) >> 6) & 0xffffu) | ((unsigned)((r2[1] + 32) >> 6) << 16);
    } else {
        int acc[16];
#pragma unroll
        for (int q = 0; q < 16; ++q) acc[q] = 0;
        const int w4[4] = {(int)n.a0.x, (int)n.a0.y, (int)n.a0.z, (int)n.a0.w};
#pragma unroll
        for (int gq = 0; gq < 4; ++gq) {
            tr4_dot(acc[0], acc[1], acc[2], acc[3], vr[4 * gq].x, vr[4 * gq + 1].x, vr[4 * gq + 2].x, vr[4 * gq + 3].x, w4[gq]);
            tr4_dot(acc[4], acc[5], acc[6], acc[7], vr[4 * gq].y, vr[4 * gq + 1].y, vr[4 * gq + 2].y, vr[4 * gq + 3].y, w4[gq]);
            tr4_dot(acc[8], acc[9], acc[10], acc[11], vr[4 * gq].z, vr[4 * gq + 1].z, vr[4 * gq + 2].z, vr[4 * gq + 3].z, w4[gq]);
            tr4_dot(acc[12], acc[13], acc[14], acc[15], vr[4 * gq].w, vr[4 * gq + 1].w, vr[4 * gq + 2].w, vr[4 * gq + 3].w, w4[gq]);
        }
        int r8[8], r4[4], r2[2];
#pragma unroll
        for (int q = 0; q < 8; ++q) { const bool od = lane & 8; const int keep = od ? acc[8 + q] : acc[q], send = od ? acc[q] : acc[8 + q]; r8[q] = keep + shx(lane, send, 8); }
#pragma unroll
        for (int q = 0; q < 4; ++q) { const bool od = lane & 16; const int keep = od ? r8[4 + q] : r8[q], send = od ? r8[q] : r8[4 + q]; r4[q] = keep + shx(lane, send, 16); }
#pragma unroll
        for (int q = 0; q < 2; ++q) { const bool od = lane & 32; const int keep = od ? r4[2 + q] : r4[q], send = od ? r4[q] : r4[2 + q]; r2[q] = keep + shx(lane, send, 32); }
        const int dim = 128 * xs + 16 * i + 8 * (j & 1) + 4 * ((j >> 1) & 1) + 2 * (j >> 2);
        const float s = n.s;
        *(unsigned*)((bf16*)OUT + (size_t)t * D + dim) = pk2((float)r2[0] * s, (float)r2[1] * s);
    }
}
template <int MODE, int VAR = 0>
DI void slice_pass(const Ctx c, const unsigned char* x8, const unsigned short* ids, const unsigned char* w8, const float* sw, const unsigned char* T8, float* OUT, unsigned* q) {
    ChunkQ g; cq_init(g, q, c.lane);
    Chunk cur = cq_next(g, c.lane); if (cur.base < 0) return;
    Chunk nxt = cq_next(g, c.lane);
#define SLICE_TOK_T(p) ((p) < QCH ? cur.base + (p) : (nxt.base >= 0 ? nxt.base + (p) - QCH : -1))
#define SLICE_TOK_X(p) ((p) < QCH ? cur.xs : nxt.xs)
    SliceIds i0 = slice_load_ids(SLICE_TOK_T(0), SLICE_TOK_X(0), c.lane, ids), i1 = slice_load_ids(SLICE_TOK_T(1), SLICE_TOK_X(1), c.lane, ids),
             i2 = slice_load_ids(SLICE_TOK_T(2), SLICE_TOK_X(2), c.lane, ids), i3 = slice_load_ids(SLICE_TOK_T(3), SLICE_TOK_X(3), c.lane, ids);
    SliceAux x0 = slice_load_aux<MODE>(i0.t, i0.xs, c.lane, x8, w8, sw), x1 = slice_load_aux<MODE>(i1.t, i1.xs, c.lane, x8, w8, sw);
    v4u A[16], B[16];
    slice_issue<VAR>(A, i0, T8, c.lane);
#define SLICE_STEP(K, CUR, NXT, IK, IK1, XK) do { slice_issue<VAR>(NXT, IK1, T8, c.lane); \
        const int ct_ = IK.t, cx_ = IK.xs; const SliceAux cxk_ = XK; \
        XK = slice_load_aux<MODE>(SLICE_TOK_T(pg + (K) + 2), SLICE_TOK_X(pg + (K) + 2), c.lane, x8, w8, sw); \
        IK = slice_load_ids(SLICE_TOK_T(pg + (K) + 4), SLICE_TOK_X(pg + (K) + 4), c.lane, ids); \
        slice_compute<MODE, VAR>(c.lane, CUR, ct_, cx_, cxk_, OUT); } while (0)
    for (;;) {
#pragma unroll 2
        for (int pg = 0; pg < QCH; pg += 4) {
            SLICE_STEP(0, A, B, i0, i1, x0);
            SLICE_STEP(1, B, A, i1, i2, x1);
            SLICE_STEP(2, A, B, i2, i3, x0);
            SLICE_STEP(3, B, A, i3, i0, x1);
        }
        cur = nxt; if (cur.base < 0) break;
        nxt = cq_next(g, c.lane);
    }
#undef SLICE_STEP
#undef SLICE_TOK_T
#undef SLICE_TOK_X
}
struct WpA { f32x4 s; v2u iw; f32x4 g; float st; };
struct WpB { f32x4 su, sv; };
DI WpA wp_load_a(const size_t idx, const float* part, const unsigned short* ids, const float* gates, const float* sx) {
    WpA a; v2u p[8];
#pragma unroll
    for (int x = 0; x < 8; ++x) p[x] = *(const v2u*)((const unsigned short*)part + (size_t)x * T * 128 + idx * 4);
    a.iw = *(const v2u*)(ids + idx * 4); a.g = *(const f32x4*)(gates + idx * 4); a.st = sx[idx >> 5] * 64.0f;
    int s0 = 0, s1 = 0, s2 = 0, s3 = 0;
#pragma unroll
    for (int x = 0; x < 8; ++x) { s0 += (int)(short)(p[x].x & 0xffffu); s1 += (int)p[x].x >> 16; s2 += (int)(short)(p[x].y & 0xffffu); s3 += (int)p[x].y >> 16; }
    a.s = (f32x4){(float)s0, (float)s1, (float)s2, (float)s3}; return a;
}
DI WpB wp_load_b(const WpA& a, const float* SU, const float* SV) {
    const unsigned e[4] = {a.iw.x & 0xffffu, a.iw.x >> 16, a.iw.y & 0xffffu, a.iw.y >> 16}; WpB b;
#pragma unroll
    for (int k = 0; k < 4; ++k) { const f2 p = *(const f2*)(SU + 2 * e[k]); b.su[k] = p.x; b.sv[k] = p.y; }
    (void)SV;
    return b;
}
DI void peer_w_phase(const Ctx c, const float* part, const unsigned short* ids, const float* gates, unsigned char* w8, float* sw, const float* sx, const float* SU, const float* SV) {
    const size_t NT = (size_t)c.G * 512, NI = (size_t)T * 32, i0 = (size_t)c.vcu * 512 + c.tid;
    WpA a0 = wp_load_a(i0 < NI ? i0 : 0, part, ids, gates, sx), a1 = wp_load_a(i0 + NT < NI ? i0 + NT : 0, part, ids, gates, sx);
    WpB b0 = wp_load_b(a0, SU, SV);
    for (size_t idx = i0; idx < NI; idx += NT) {
        const WpA a2 = wp_load_a(idx + 2 * NT < NI ? idx + 2 * NT : 0, part, ids, gates, sx);
        const WpB b1 = wp_load_b(a1, SU, SV);
        f32x4 g = a0.g; float am = 0.f;
#pragma unroll
        for (int k = 0; k < 4; ++k) { g[k] = g[k] * gelu_erf(a0.s[k] * (a0.st * b0.su[k])) * b0.sv[k]; am = __builtin_fmaxf(am, __builtin_fabsf(g[k])); }
#pragma unroll
        for (int o = 1; o < 32; o <<= 1) am = __builtin_fmaxf(am, shx(c.lane, am, o));
        *(unsigned*)(w8 + idx * 4) = q4_i8(g, am > 0.f ? 127.0f / am : 0.f);
        if ((c.tid & 31) == 0) sw[idx >> 5] = am * (1.0f / 127.0f);
        a0 = a1; a1 = a2; b0 = b1;
    }
}

DI int pi_row(int m) { return 16 * (m >> 4) + 8 * ((m >> 2) & 1) + 4 * ((m >> 3) & 1) + (m & 3); }
struct AttnT { const bf16* Q; bf16* O; const bf16* Kb; const bf16* VT; const bf16* Vsn; const float* ck; const float* cv; };
template <int MODE>
DI void attn_load(const AttnT A, const int b, const int h, const int kt, const int q, const int hh, const int piq, bf16x8 (&kf)[4], bf16x8 (&vf)[2][2]) {
    if (MODE == 0) {
        const bf16* kr = A.Kb + ((size_t)b * SEQ + kt * 32 + piq) * D + h * DH + 8 * hh;
#pragma unroll
        for (int s = 0; s < 4; ++s) kf[s] = *(const bf16x8*)(kr + 16 * s);
        const bf16* vr = A.VT + (((size_t)b * NH + h) * (SEQ / 32) + kt) * (DH * 32) + q * 32 + 8 * hh;
#pragma unroll
        for (int mt = 0; mt < 2; ++mt)
#pragma unroll
            for (int s = 0; s < 2; ++s) vf[mt][s] = *(const bf16x8*)(vr + mt * 32 * 32 + 16 * s);
    } else if (kt == PAST / 32) {
        const int ko = piq < 16 ? piq : 15;
        const bf16* kr = A.Kb + ((size_t)TP + b * DSEQ + ko) * D + h * DH + 8 * hh;
#pragma unroll
        for (int s = 0; s < 4; ++s) kf[s] = *(const bf16x8*)(kr + 16 * s);
#pragma unroll
        for (int mt = 0; mt < 2; ++mt)
#pragma unroll
            for (int s = 0; s < 2; ++s) { bf16x8 v;
#pragma unroll
                for (int j = 0; j < 8; ++j) { const int kk = 16 * s + 8 * hh + j; v[j] = (short)A.Vsn[((size_t)b * DSEQ + (kk < 16 ? kk : 15)) * D + h * DH + 32 * mt + q]; }
                vf[mt][s] = v; }
    } else {
        const float* kr = A.ck + (((size_t)b * PAST + kt * 32 + piq) * NH + h) * DH + 8 * hh;
#pragma unroll
        for (int s = 0; s < 4; ++s) { const f32x4 x0 = *(const f32x4*)(kr + 16 * s), x1 = *(const f32x4*)(kr + 16 * s + 4); kf[s] = pack8(x0[0], x0[1], x0[2], x0[3], x1[0], x1[1], x1[2], x1[3]); }
#pragma unroll
        for (int mt = 0; mt < 2; ++mt)
#pragma unroll
            for (int s = 0; s < 2; ++s) { float x[8];
#pragma unroll
                for (int j = 0; j < 8; ++j) x[j] = A.cv[(((size_t)b * PAST + kt * 32 + 16 * s + 8 * hh + j) * NH + h) * DH + 32 * mt + q];
                vf[mt][s] = pack8(x[0], x[1], x[2], x[3], x[4], x[5], x[6], x[7]); }
    }
}
template <int MODE>
DI void attn_qtile(const AttnT A, int b, int h, int qi, int lane, const bf16x8 (&ut)[2]) {
    const int q = lane & 31, hh = lane >> 5, piq = pi_row(q);
    const size_t qrow = MODE == 0 ? (size_t)b * SEQ + qi * 32 + q : (size_t)TP + b * DSEQ + (q < 16 ? q : 15);
    const int qpos = MODE == 0 ? qi * 32 + q : (q < 16 ? PAST + q : 0);
    bf16x8 qf[4];
#pragma unroll
    for (int s = 0; s < 4; ++s) qf[s] = *(const bf16x8*)(A.Q + qrow * D + h * DH + 16 * s + 8 * hh);
    f32x16 o0, o1;
#pragma unroll
    for (int i = 0; i < 16; ++i) { o0[i] = 0.f; o1[i] = 0.f; }
    float carry = 0.f;
    const int kt0 = MODE == 0 ? qi : PAST / 32;
    bf16x8 kf[4], vf[2][2];
    attn_load<MODE>(A, b, h, kt0, q, hh, piq, kf, vf);
    for (int kt = kt0; kt >= 0; --kt) {
        bf16x8 kn[4], vn[2][2];
        attn_load<MODE>(A, b, h, kt > 0 ? kt - 1 : 0, q, hh, piq, kn, vn);
        f32x16 S;
#pragma unroll
        for (int i = 0; i < 16; ++i) S[i] = 0.f;
#pragma unroll
        for (int s = 0; s < 4; ++s) S = MFMA32(kf[s], qf[s], S);
        const int kbase = kt * 32 + 8 * hh;
        float L[16], lw[16];
#pragma unroll
        for (int r = 0; r < 16; ++r) {
            const bool valid = (kbase + 16 * (r >> 3) + (r & 7)) < qpos;
            const float z = S[r], sp = __builtin_fmaxf(z, 0.f) + __builtin_amdgcn_logf(1.0f + __builtin_amdgcn_exp2f(-__builtin_fabsf(z)));
            L[r] = valid ? -sp : 0.f; lw[r] = valid ? (z - sp) : -1e30f;
        }
        f32x16 suf;
#pragma unroll
        for (int i = 0; i < 16; ++i) suf[i] = 0.f;
        suf = MFMA32(ut[0], pack8(L[0], L[1], L[2], L[3], L[4], L[5], L[6], L[7]), suf);
        suf = MFMA32(ut[1], pack8(L[8], L[9], L[10], L[11], L[12], L[13], L[14], L[15]), suf);
        float a[16];
#pragma unroll
        for (int r = 0; r < 16; ++r) a[r] = __builtin_amdgcn_exp2f(lw[r] + suf[r] + carry);
        carry += __int_as_float(__builtin_amdgcn_ds_bpermute(q << 2, __float_as_int(suf[0] + L[0])));
        const bf16x8 p0 = pack8(a[0], a[1], a[2], a[3], a[4], a[5], a[6], a[7]), p1 = pack8(a[8], a[9], a[10], a[11], a[12], a[13], a[14], a[15]);
        o0 = MFMA32(vf[0][0], p0, o0); o0 = MFMA32(vf[0][1], p1, o0);
        o1 = MFMA32(vf[1][0], p0, o1); o1 = MFMA32(vf[1][1], p1, o1);
        if (__builtin_amdgcn_ballot_w64(qpos > 0 && carry > -24.0f * LOG2E) == 0ull) break;
#pragma unroll
        for (int s = 0; s < 4; ++s) kf[s] = kn[s];
#pragma unroll
        for (int mt = 0; mt < 2; ++mt)
#pragma unroll
            for (int s = 0; s < 2; ++s) vf[mt][s] = vn[mt][s];
    }
    if (MODE == 0 || q < 16) {
        bf16* orow = A.O + qrow * D + h * DH + 4 * hh;
#pragma unroll
        for (int g = 0; g < 4; ++g) {
            v2u w0, w1; w0.x = pk2(o0[4 * g], o0[4 * g + 1]); w0.y = pk2(o0[4 * g + 2], o0[4 * g + 3]); w1.x = pk2(o1[4 * g], o1[4 * g + 1]); w1.y = pk2(o1[4 * g + 2], o1[4 * g + 3]);
            *(v2u*)(orow + 8 * g) = w0; *(v2u*)(orow + 32 + 8 * g) = w1; }
    }
}
DI void attn_phase(const Ctx c, const AttnT A) {
    const int q = c.lane & 31, hh = c.lane >> 5, piq = pi_row(q);
    bf16x8 ut[2];
#pragma unroll
    for (int s = 0; s < 2; ++s)
#pragma unroll
        for (int j = 0; j < 8; ++j) ut[s][j] = (16 * s + 8 * hh + j > piq) ? (short)0x3f80 : (short)0;
    for (int bu = c.vcu; bu < NB * NH * 4; bu += c.G) {
        const int bh = bu >> 2, b = bh >> 4, h = bh & 15, p = (bu & 3) * 8 + c.wave;
        attn_qtile<0>(A, b, h, 63 - p, c.lane, ut);
        attn_qtile<0>(A, b, h, p, c.lane, ut);
    }
    for (int su = c.wave * c.G + c.vcu; su < NB * NH; su += c.G * 8) attn_qtile<1>(A, su >> 4, su & 15, 0, c.lane, ut);
}

DI void vt_phase(const Ctx c, LAS unsigned char* lds, const bf16* Vb, bf16* VT, bf16* Vsn) {
    LAS unsigned char* scr = lds + c.wave * 16384;
    const int gw = c.vcu * 8 + c.wave, NGW = c.G * 8;
    for (int wt = gw; wt < (TP / 64) * 16; wt += NGW) {
        const int tt = wt >> 4, ht = wt & 15;
        v4u vin[8];
#pragma unroll
        for (int j = 0; j < 8; ++j) vin[j] = *(const v4u*)(Vb + (size_t)(tt * 64 + (c.lane >> 3) + 8 * j) * D + ht * 64 + (c.lane & 7) * 8);
        __builtin_amdgcn_sched_barrier(0);
#pragma unroll
        for (int j = 0; j < 8; ++j) { const int row = (c.lane >> 3) + 8 * j, ch = c.lane & 7;
            LAS unsigned* d = (LAS unsigned*)(scr + row * 132 + ch * 16); d[0] = vin[j].x; d[1] = vin[j].y; d[2] = vin[j].z; d[3] = vin[j].w; }
        LDS_WAIT(); asm volatile("" ::: "memory");
#pragma unroll
        for (int j = 0; j < 8; ++j) { const int orow = (c.lane >> 3) + 8 * j, ch = c.lane & 7;
            unsigned short e[8];
#pragma unroll
            for (int i = 0; i < 8; ++i) e[i] = *(const LAS unsigned short*)(scr + (ch * 8 + i) * 132 + orow * 2);
            v4u o; o.x = e[0] | ((unsigned)e[1] << 16); o.y = e[2] | ((unsigned)e[3] << 16); o.z = e[4] | ((unsigned)e[5] << 16); o.w = e[6] | ((unsigned)e[7] << 16);
            { const int bb = tt >> 5, kt = 2 * (tt & 31) + (ch >> 2);
              *(v4u*)(VT + (((size_t)bb * NH + ht) * (SEQ / 32) + kt) * (DH * 32) + orow * 32 + 8 * (ch & 3)) = o; } }
        LDS_WAIT(); asm volatile("" ::: "memory");
    }
    const size_t NT = (size_t)c.G * 512;
    for (size_t i = (size_t)c.vcu * 512 + c.tid; i < (size_t)TS * D / 8; i += NT) *(v4u*)(Vsn + i * 8) = *(const v4u*)(Vb + (size_t)TP * D + i * 8);
}

DI f32x16 sg_tile(const bf16* wr  , const bf16* xr  ) {
    f32x16 acc;
#pragma unroll
    for (int i = 0; i < 16; ++i) acc[i] = 0.f;
    bf16x8 wa[8], xa[8], wb[8], xb[8];
#pragma unroll
    for (int j = 0; j < 8; ++j) { wa[j] = *(const bf16x8*)(wr + 16 * j); xa[j] = *(const bf16x8*)(xr + 16 * j); }
#pragma unroll 1
    for (int k0 = 0; k0 < 64; k0 += 16) {
#pragma unroll
        for (int j = 0; j < 8; ++j) { wb[j] = *(const bf16x8*)(wr + 16 * (k0 + 8 + j)); xb[j] = *(const bf16x8*)(xr + 16 * (k0 + 8 + j)); }
        __builtin_amdgcn_sched_barrier(0);
#pragma unroll
        for (int j = 0; j < 8; ++j) acc = MFMA32(wa[j], xa[j], acc);
        __builtin_amdgcn_sched_barrier(0);
        { const int kn = k0 + 16 < 64 ? k0 + 16 : 0;
#pragma unroll
          for (int j = 0; j < 8; ++j) { wa[j] = *(const bf16x8*)(wr + 16 * (kn + j)); xa[j] = *(const bf16x8*)(xr + 16 * (kn + j)); } }
        __builtin_amdgcn_sched_barrier(0);
#pragma unroll
        for (int j = 0; j < 8; ++j) acc = MFMA32(wb[j], xb[j], acc);
        __builtin_amdgcn_sched_barrier(0);
    }
    return acc;
}
DI void sg_gate(const Ctx c, const bf16* Hall  , const bf16* Wl  , bf16* U, bf16* Bg, float* convp  ) {
    const int q = c.lane & 31, hh = c.lane >> 5;
    for (int tile = c.wave * c.G + c.vcu; tile < 18 * 32; tile += c.G * 8) {
        const int tt = tile % 18, dt = tile / 18, d = 32 * dt + q, crow = 256 * (d >> 7) + (d & 127);
        const bool cs = tt >= 16; const int kk = (tt - 16) * 32 + q;
        const size_t row = cs ? (size_t)(kk >> 1) * SEQ + (SEQ - 2) + (kk & 1) : (size_t)TP + tt * 32 + q;
        const bf16* xr = Hall + row * D + 8 * hh;
        const bf16* wc = Wl + (size_t)crow * D + 8 * hh; const bf16* wx = wc + (size_t)128 * D; const bf16* wb = Wl + (size_t)(2048 + d) * D + 8 * hh;
        f32x16 ac, ax, ab;
#pragma unroll
        for (int i = 0; i < 16; ++i) { ac[i] = 0.f; ax[i] = 0.f; ab[i] = 0.f; }
        { bf16x8 fx[4], fc[4], fxx[4], fb[4], gx[4], gc[4], gxx[4], gb[4];
#pragma unroll
          for (int j = 0; j < 4; ++j) { fx[j] = *(const bf16x8*)(xr + 16 * j); fc[j] = *(const bf16x8*)(wc + 16 * j); fxx[j] = *(const bf16x8*)(wx + 16 * j); fb[j] = *(const bf16x8*)(wb + 16 * j); }
#pragma unroll 1
          for (int k0 = 0; k0 < 64; k0 += 8) {
#pragma unroll
              for (int j = 0; j < 4; ++j) { gx[j] = *(const bf16x8*)(xr + 16 * (k0 + 4 + j)); gc[j] = *(const bf16x8*)(wc + 16 * (k0 + 4 + j)); gxx[j] = *(const bf16x8*)(wx + 16 * (k0 + 4 + j)); gb[j] = *(const bf16x8*)(wb + 16 * (k0 + 4 + j)); }
              __builtin_amdgcn_sched_barrier(0);
#pragma unroll
              for (int j = 0; j < 4; ++j) { ac = MFMA32(fc[j], fx[j], ac); ax = MFMA32(fxx[j], fx[j], ax); ab = MFMA32(fb[j], fx[j], ab); }
              __builtin_amdgcn_sched_barrier(0);
              { const int kn = k0 + 8 < 64 ? k0 + 8 : 0;
#pragma unroll
                for (int j = 0; j < 4; ++j) { fx[j] = *(const bf16x8*)(xr + 16 * (kn + j)); fc[j] = *(const bf16x8*)(wc + 16 * (kn + j)); fxx[j] = *(const bf16x8*)(wx + 16 * (kn + j)); fb[j] = *(const bf16x8*)(wb + 16 * (kn + j)); } }
              __builtin_amdgcn_sched_barrier(0);
#pragma unroll
              for (int j = 0; j < 4; ++j) { ac = MFMA32(gc[j], gx[j], ac); ax = MFMA32(gxx[j], gx[j], ax); ab = MFMA32(gb[j], gx[j], ab); }
              __builtin_amdgcn_sched_barrier(0);
          } }
        if (cs) {
            float* cd = convp + (size_t)kk * D + 32 * dt + 4 * hh;
#pragma unroll
            for (int g = 0; g < 4; ++g) *(f32x4*)(cd + 8 * g) = (f32x4){ac[4 * g] * ax[4 * g], ac[4 * g + 1] * ax[4 * g + 1], ac[4 * g + 2] * ax[4 * g + 2], ac[4 * g + 3] * ax[4 * g + 3]};
        } else {
            const size_t ro = row * D + 32 * dt + 4 * hh;
#pragma unroll
            for (int g = 0; g < 4; ++g) { v2u wu, wb2; wu.x = pk2(ac[4 * g] * ax[4 * g], ac[4 * g + 1] * ax[4 * g + 1]); wu.y = pk2(ac[4 * g + 2] * ax[4 * g + 2], ac[4 * g + 3] * ax[4 * g + 3]);
                wb2.x = pk2(ab[4 * g], ab[4 * g + 1]); wb2.y = pk2(ab[4 * g + 2], ab[4 * g + 3]);
                *(v2u*)(U + ro + 8 * g) = wu; *(v2u*)(Bg + ro + 8 * g) = wb2; }
        }
    }
}
template <int MODE>
DI void sg_plain(const Ctx c, const bf16* Xs, const bf16* Wt, const int N, bf16* O, const bf16* Hres, bf16* O2, float* f0, float* f1) {
    const int q = c.lane & 31, hh = c.lane >> 5;
    for (int tile = c.wave * c.G + c.vcu; tile < 16 * (N / 32); tile += c.G * 8) {
        const int tt = tile & 15, ft = tile >> 4;
        const f32x16 acc = sg_tile(Wt + (size_t)(ft * 32 + q) * D + 8 * hh, Xs + (size_t)(tt * 32 + q) * D + 8 * hh);
        const int tl = tt * 32 + q;
#pragma unroll
        for (int g = 0; g < 4; ++g) { const int f = 32 * ft + 8 * g + 4 * hh; const f32x4 v = {acc[4 * g], acc[4 * g + 1], acc[4 * g + 2], acc[4 * g + 3]};
            if (MODE == 0) { v2u w; w.x = pk2(v[0], v[1]); w.y = pk2(v[2], v[3]); *(v2u*)(O + (size_t)(TP + tl) * D + f) = w; }
            else if (MODE == 1) { const v2u hw = *(const v2u*)(Hres + (size_t)(TP + tl) * D + f); const f32x4 r = (f32x4){bflo(hw.x), bfhi(hw.x), bflo(hw.y), bfhi(hw.y)} * ALPHA + v;
                v2u w; w.x = pk2(r[0], r[1]); w.y = pk2(r[2], r[3]); *(v2u*)(O + (size_t)(TP + tl) * D + f) = w; }
            else if (MODE == 2) { const bool isv = f >= 1024; const int fc = isv ? f - 1024 : f; v2u w; w.x = pk2(v[0], v[1]); w.y = pk2(v[2], v[3]);
                *(v2u*)((isv ? O2 : O) + (size_t)(TP + tl) * D + fc) = w; *(f32x4*)((isv ? f1 : f0) + (size_t)tl * D + fc) = v; }
            else { v2u w; w.x = pk2(v[0], v[1]); w.y = pk2(v[2], v[3]); *(v2u*)(O + (size_t)(TP + tl) * 2048 + f) = w; }
        }
    }
}

struct Args { const float* in[18]; float* out; unsigned char* ws; int ph_lo, ph_hi, li, pad; };
constexpr int N_PHASES = 2 + 2 * 10 + 12 + 10;
__global__ void __launch_bounds__(512, 2) fwd(Args args) {
    extern __shared__ __attribute__((aligned(16))) unsigned char lds_raw[];
    LAS unsigned char* lds = (LAS unsigned char*)lds_raw;
    Ctx c0; c0.tid = threadIdx.x; c0.lane = 0; c0.wave = __builtin_amdgcn_readfirstlane(c0.tid >> 6); c0.G = gridDim.x;
    { const int bx = blockIdx.x; c0.vcu = (c0.G % 8 == 0) ? (bx % 8) * (c0.G / 8) + bx / 8 : bx; }
    volatile LAS unsigned* MISC = (volatile LAS unsigned*)(lds + MISC_OFF);
    for (int u = c0.tid; u < (LDS_BYTES - RING_BYTES) / 4; u += 512) ((LAS unsigned*)(lds + RING_BYTES))[u] = 0u;
    __syncthreads();
    unsigned char* ws = args.ws; float* out = args.out;
    XcdBarrier bar = xcd_barrier_post((unsigned*)(ws + WS_CTL) + CW_BAR + args.li * XCD_BAR_WORDS, MISC + 8, c0.wave == 0 ? 1u : 0u);
#define WinT ((bf16*)(wsl + WS_WIN))
#define WoutT ((bf16*)(wsl + WS_WOUT))
#define WqT ((bf16*)(wsl + WS_WQ))
#define WoT ((bf16*)(wsl + WS_WO))
#define WkvT ((bf16*)(wsl + WS_WKV))
#define WP ((bf16*)(wsl + WS_WP))
#define W8A (wsl + WS_W8A)
#define SWA ((float*)(wsl + WS_SWA))
#define W8R(off) ((int)(((off) - WS_WIN) / 2048))
#define Vsn ((bf16*)(wsl + WS_VSN))
#define H ((bf16*)(wsl + WS_H))
#define Kb ((bf16*)(wsl + WS_KB))
#define VT ((bf16*)(wsl + WS_VT))
#define ids ((unsigned short*)(wsl + WS_IDS))
#define gates ((float*)(wsl + WS_GATE))
#define W8 (wsl + WS_W8)
#define SX ((float*)(wsl + WS_SX))
#define SW (SX + T)
#define X8 (wsl + WS_X8)
#define TU (wsl + WS_TU)
#define TV (wsl + WS_TV)
#define SU ((float*)(wsl + WS_SU))
#define SV (SU + 1)
#define A0 ((bf16*)(wsl + WS_A))
#define A1 ((bf16*)(wsl + WS_A + 129 * MiB))
#define ScT ((float*)(wsl + WS_A))
#define R A0
    const float* ln_g = args.in[16]; const float* ln_b = args.in[17];
    const int lo = args.ph_lo, hi = args.ph_hi; int ph = 0;
#ifndef PROBE_REPEAT
#define PROBE_REPEAT 0
#endif
#define PHASE_R(bit, body) do { const int nrep = 1 + ((PROBE_REPEAT >> (bit)) & 1); for (int rep = 0; rep < nrep; ++rep) { if (ph >= lo && ph < hi) { Ctx c = c0; c.lane = xb_lane_id(); c.tid = c0.wave * 64 + c.lane; unsigned long long wsi_ = (unsigned long long)ws; asm volatile("" : "+s"(wsi_)); unsigned char* wsl = (unsigned char*)(GAS unsigned char*)wsi_; body; if (ph + 1 < hi) { xcd_barrier(bar); if ((PROBE_REPEAT >> 20) & 1) xcd_barrier(bar); } } ++ph; } } while (0)
#define PHASE(body) PHASE_R(31, body)

    PHASE_R(4, ({ P0Args a{args.in[0], args.in[1], args.in[5], args.in[7], args.in[8], args.in[9], args.in[10], args.in[11], args.in[12], args.in[13], args.in[14], args.in[15],
                      WinT, WoutT, WqT, WoT, WkvT, WP, H, TU, TV, SU, SV, X8, SX}; p0_prologue(c, lds, a); }));

    PHASE(({ wp_quant_phase(c, WinT, W8A, SWA); }));

#pragma unroll 1
    for (int l = 0; l < NLAYER; ++l) {
        if (l < 2) {
            PHASE_R(8, ({ pg8::Gemm g{(const bf16*)X8, (const bf16*)(W8A + ((size_t)W8R(WS_WIN) + (size_t)l * 3072) * 1024), TP, 3072, 512}; pg8::StaticOrder S; S.init(TP, 3072, c.G, (int)blockIdx.x);
                     pg8::EpiGate<true> E{A0, A1, SX, SWA + W8R(WS_WIN) + l * 3072};
                     pg8::gemm_phase<pg8::EpiGate<true>, pg8::StaticOrder, true, true, true>(lds, g, S, E, c.tid);
                     sg_gate(c, H, WinT + (size_t)l * 3072 * 1024, A0, A1, out + O_CONVP + (size_t)l * NB * 2 * D); }));
            PHASE_R(13, ({ conv_gate_phase(c, A0, A1, args.in[6] + (size_t)l * 3 * D, args.in[2] + (size_t)l * NB * 2 * D, out + O_CONVP + (size_t)l * NB * 2 * D, out + O_CONVS + (size_t)l * NB * 2 * D, X8, SX, rep > 0); }));
        } else {
            if (l == 2) {
                PHASE_R(10, ({ pg8::Gemm g{(const bf16*)X8, (const bf16*)(W8A + (size_t)W8R(WS_WKV) * 1024), TP, 2048, 512}; pg8::StaticOrder S; S.init(TP, 2048, c.G, (int)blockIdx.x);
                         pg8::EpiKV<true> E{Kb, A1, out + O_KP, out + O_VP, out + O_KS, out + O_VS, SX, SWA + W8R(WS_WKV)};
                         pg8::gemm_phase<pg8::EpiKV<true>, pg8::StaticOrder, true, true, true>(lds, g, S, E, c.tid);
                         sg_plain<2>(c, H + (size_t)TP * D, WkvT, 2048, Kb, nullptr, A1, out + O_KS, out + O_VS); }));
                PHASE_R(14, ({ vt_phase(c, lds, A1, VT, Vsn); }));
            }
            PHASE_R(9, ({ pg8::Gemm g{(const bf16*)X8, (const bf16*)(W8A + ((size_t)W8R(WS_WQ) + (size_t)(l - 2) * 1024) * 1024), TP, 1024, 512}; pg8::StaticOrder S; S.init(TP, 1024, c.G, (int)blockIdx.x);
                     pg8::EpiBf16P<true> E{A0, 1024, SX, SWA + W8R(WS_WQ) + (l - 2) * 1024};
                     pg8::gemm_phase<pg8::EpiBf16P<true>, pg8::StaticOrder, true, true, true>(lds, g, S, E, c.tid);
                     sg_plain<0>(c, H + (size_t)TP * D, WqT + (size_t)(l - 2) * 1024 * 1024, 1024, A0, nullptr, nullptr, nullptr, nullptr); }));
            PHASE_R(11, ({ AttnT A{A0, A1, Kb, VT, Vsn, args.in[3], args.in[4]}; attn_phase(c, A); }));
        }
        if (l < 2) {
            PHASE_R(7, ({ pg8::Gemm g{(const bf16*)X8, (const bf16*)(W8A + ((size_t)W8R(WS_WOUT) + (size_t)l * 1024) * 1024), TP, 1024, 512}; pg8::StaticOrder S; S.init(TP, 1024, c.G, (int)blockIdx.x);
                     pg8::EpiRes<true> E{H, R, ALPHA, SX, SWA + W8R(WS_WOUT) + l * 1024};
                     pg8::gemm_phase<pg8::EpiRes<true>, pg8::StaticOrder, true, true, true>(lds, g, S, E, c.tid);
                     sg_plain<1>(c, A1 + (size_t)TP * D, WoutT + (size_t)l * 1024 * 1024, 1024, R, H, nullptr, nullptr, nullptr); }));
        } else {
            PHASE_R(7, ({ pg8::Gemm g{A1, WoT + (size_t)(l - 2) * 1024 * 1024, TP, 1024, 1024}; pg8::StaticOrder S; S.init(TP, 1024, c.G, (int)blockIdx.x);
                     pg8::EpiRes<false> E{H, R, ALPHA, nullptr, nullptr};
                     pg8::gemm_phase<pg8::EpiRes<false>, pg8::StaticOrder, true, true>(lds, g, S, E, c.tid);
                     sg_plain<1>(c, A1 + (size_t)TP * D, WoT + (size_t)(l - 2) * 1024 * 1024, 1024, R, H, nullptr, nullptr, nullptr); }));
        }
        PHASE_R(5, ({ ln_phase(c, R, H, ln_g + (size_t)(l * 2) * D, ln_b + (size_t)(l * 2) * D, nullptr, nullptr, X8, SX); }));
        PHASE_R(6, ({ pg8::Gemm g{(const bf16*)X8, (const bf16*)(W8A + ((size_t)W8R(WS_WP) + (size_t)l * 2048) * 1024), TP, 2048, 512}; pg8::StaticOrder S; S.init(TP, 2048, c.G, (int)blockIdx.x);
                 pg8::EpiScoreI8 E{(bf16*)ScT, 2048, SX, SWA + W8R(WS_WP) + l * 2048};
                 pg8::gemm_phase<pg8::EpiScoreI8, pg8::StaticOrder, true, true, true>(lds, g, S, E, c.tid);
                 sg_plain<3>(c, H + (size_t)TP * D, WP + (size_t)l * 2048 * 1024, 2048, (bf16*)ScT, nullptr, nullptr, nullptr, nullptr); }));
        PHASE_R(3, ({ topk_phase(c, (const bf16*)ScT, ids, gates); }));
        PHASE_R(0, ({ slice_pass<0>(c, X8, ids, W8, SW, TU + (size_t)l * NEXP * D, ScT  , (unsigned*)(ws + WS_CTL) + CW_Q + ((l * 2) * 2 + rep) * 512); }));
        PHASE_R(12, ({ peer_w_phase(c, ScT, ids, gates, W8, SW, SX, SU + (size_t)l * NEXP * 2, SV + (size_t)l * NEXP * 2); }));
        PHASE_R(1, ({ slice_pass<1>(c, X8, ids, W8, SW, TV + (size_t)l * NEXP * D, (float*)A0, (unsigned*)(ws + WS_CTL) + CW_Q + ((l * 2 + 1) * 2 + rep) * 512); }));
        PHASE(({ ln_phase(c, A0, H, ln_g + (size_t)(l * 2 + 1) * D, ln_b + (size_t)(l * 2 + 1) * D, l == NLAYER - 1 ? out : nullptr, H, X8, SX); }));
#if defined(PROBE_SLICE) && PROBE_SLICE == 1
        PHASE(({ slice_pass<0, 1>(c, X8, ids, W8, SW, TU + (size_t)l * NEXP * D, ScT, (unsigned*)(ws + WS_CTL) + CW_Q + ((l * 2) * 2 + 1) * 512); }));
#elif defined(PROBE_SLICE) && PROBE_SLICE == 2
        PHASE(({ slice_pass<0, 2>(c, X8, ids, W8, SW, TU + (size_t)l * NEXP * D, ScT, (unsigned*)(ws + WS_CTL) + CW_Q + ((l * 2) * 2 + 1) * 512); }));
#elif defined(PROBE_SLICE) && PROBE_SLICE == 3
        PHASE(({ slice_pass<1, 1>(c, X8, ids, W8, SW, TV + (size_t)l * NEXP * D, ScT, (unsigned*)(ws + WS_CTL) + CW_Q + ((l * 2) * 2 + 1) * 512); }));
#elif defined(PROBE_SLICE) && PROBE_SLICE == 4
        PHASE(({ slice_pass<1, 2>(c, X8, ids, W8, SW, TV + (size_t)l * NEXP * D, ScT, (unsigned*)(ws + WS_CTL) + CW_Q + ((l * 2) * 2 + 1) * 512); }));
#endif
    }
#undef PHASE
#undef PHASE_R
#undef WinT
#undef WoutT
#undef WqT
#undef WoT
#undef WkvT
#undef WP
#undef W8A
#undef SWA
#undef W8R
#undef Vsn
#undef H
#undef Kb
#undef VT
#undef ids
#undef gates
#undef W8
#undef SX
#undef SW
#undef X8
#undef TU
#undef TV
#undef SU
#undef SV
#undef A0
#undef A1
#undef ScT
#undef R
}

#ifndef N_LAUNCH_MODE
#define N_LAUNCH_MODE 1
#endif
extern "C" void kernel_launch(void* const* d_in, const int* in_sizes, int n_in, void* d_out, int out_size, void* d_ws, size_t ws_size, hipStream_t stream) {
    static int grid = 0;
    if (grid == 0) {
        if (n_in != 18 || in_sizes[0] != TP * D || (size_t)out_size != O_END || ws_size < WS_END) {
            fprintf(stderr, "kernel_launch: shape mismatch: n_in %d in0 %d out %d ws %zu (need %zu)\n", n_in, n_in > 0 ? in_sizes[0] : -1, out_size, ws_size, (size_t)WS_END); grid = -1; return; }
        int dev = 0, cus = 0, per_cu = 0;
        if (hipGetDevice(&dev) != hipSuccess || hipDeviceGetAttribute(&cus, hipDeviceAttributeMultiprocessorCount, dev) != hipSuccess) { grid = -1; return; }
        if (hipFuncSetAttribute((const void*)fwd, hipFuncAttributeMaxDynamicSharedMemorySize, LDS_BYTES) != hipSuccess) { fprintf(stderr, "kernel_launch: hipFuncSetAttribute failed\n"); grid = -1; return; }
        if (hipOccupancyMaxActiveBlocksPerMultiprocessor(&per_cu, (const void*)fwd, 512, LDS_BYTES) != hipSuccess || per_cu < 1) { fprintf(stderr, "kernel_launch: occupancy query says %d\n", per_cu); }
        (void)hipGetLastError();
        grid = cus;
    }
    if (grid < 0) return;
    (void)hipMemsetAsync((char*)d_ws + WS_CTL, 0, CTL_BYTES, stream);
    Args a{};
    for (int i = 0; i < 18; ++i) a.in[i] = (const float*)d_in[i];
    a.out = (float*)d_out; a.ws = (unsigned char*)d_ws; a.pad = 0;
#if N_LAUNCH_MODE == 1
    a.ph_lo = 0; a.ph_hi = 1 << 30; a.li = 0;
    hipLaunchKernelGGL(fwd, dim3(grid), dim3(512), LDS_BYTES, stream, a);
#else
    for (int p = 0; p < N_PHASES; ++p) { a.ph_lo = p; a.ph_hi = p + 1; a.li = p; hipLaunchKernelGGL(fwd, dim3(grid), dim3(512), LDS_BYTES, stream, a); }
#endif
}
```

```cpp
#include <hip/hip_runtime.h>
#include <cstdio>
#include <cstdint>
namespace pg8 {
#define PG8_LAS __attribute__((address_space(3)))
typedef unsigned short bf16_t;
typedef short bf16x8 __attribute__((ext_vector_type(8)));
typedef float f32x4 __attribute__((ext_vector_type(4)));
typedef unsigned u32x4 __attribute__((ext_vector_type(4)));
constexpr int BM = 256, BK = 64, HALF = 128, HTB = HALF * BK * 2  , STAGE_BYTES = 8 * HTB, NXCD = 8, WGM = 8;

__host__ __device__ __forceinline__ int lds_byte(int r, int c) { const int st = (r >> 4) * 2 + (c >> 5), rr = r & 15, cc = c & 31, ob = rr * 64 + cc * 2; return st * 1024 + (ob ^ (((ob >> 9) & 1) << 5)); }
__host__ __device__ __forceinline__ void stage_rc(int b, int& R, int& C) { const int st = b / 1024, sb = b % 1024, swz = sb ^ (((sb >> 9) & 1) << 5); R = (st >> 1) * 16 + swz / 64; C = (st & 1) * 32 + (swz % 64) / 2; }
__host__ __device__ __forceinline__ int perm32(int rho) { const int n = rho >> 4, i = rho & 15; return 8 * (i >> 2) + 4 * n + (i & 3); }

struct Unit { int pm, pn; };
struct Gemm { const bf16_t* A; const bf16_t* Bt; int M, N, K; };

struct StaticOrder {
    int nM, nN, nwg, G, c;
    __host__ __device__ void init(int M, int N, int G_, int c_) { nM = M / BM; nN = N / BM; nwg = nM * nN; G = G_; c = c_; }
    __host__ __device__ bool next(int i, Unit& u) const {
        const long L = (long)i * G + c; if (L >= nwg) return false;
        int wgid = (int)L; { const int q = nwg / NXCD, r = nwg % NXCD, xcd = wgid % NXCD, off = wgid / NXCD; wgid = (xcd < r ? xcd * (q + 1) : r * (q + 1) + (xcd - r) * q) + off; }
        const int nig = WGM * nN, gid = wgid / nig, fm = gid * WGM, gsz = (nM - fm) < WGM ? (nM - fm) : WGM;
        u.pm = fm + ((wgid % nig) % gsz); u.pn = (wgid % nig) / gsz; return true;
    }
    __device__ __forceinline__ void a_ready(const Unit&) const {}
    __device__ __forceinline__ void done(const Unit&) const {}
};

typedef float f32x2 __attribute__((ext_vector_type(2)));
typedef __bf16 bf16x2v __attribute__((ext_vector_type(2)));
typedef unsigned u32x2 __attribute__((ext_vector_type(2)));
__device__ __forceinline__ unsigned pk2(float lo, float hi) { const bf16x2v v = __builtin_convertvector((f32x2){lo, hi}, bf16x2v); return __builtin_bit_cast(unsigned, v); }
__device__ __forceinline__ u32x4 pk8(const f32x4 a, const f32x4 b) { u32x4 w; w.x = pk2(a[0], a[1]); w.y = pk2(a[2], a[3]); w.z = pk2(b[0], b[1]); w.w = pk2(b[2], b[3]); return w; }

typedef int i32x4 __attribute__((ext_vector_type(4)));
template <bool I8> struct AccT { typedef f32x4 type; static __device__ __forceinline__ type zero() { return (f32x4){0.f, 0.f, 0.f, 0.f}; } };
template <> struct AccT<true> { typedef i32x4 type; static __device__ __forceinline__ type zero() { return (i32x4){0, 0, 0, 0}; } };
__device__ __forceinline__ f32x4 mma16(const bf16x8 b, const bf16x8 a, const f32x4 c) { return __builtin_amdgcn_mfma_f32_16x16x32_bf16(b, a, c, 0, 0, 0); }
__device__ __forceinline__ i32x4 mma16(const bf16x8 b, const bf16x8 a, const i32x4 c) { return __builtin_amdgcn_mfma_i32_16x16x64_i8(__builtin_bit_cast(i32x4, b), __builtin_bit_cast(i32x4, a), c, 0, 0, 0); }
__device__ __forceinline__ f32x4 dq4(const f32x4 a, const float, const f32x4) { return a; }
__device__ __forceinline__ f32x4 dq4(const i32x4 a, const float ra, const f32x4 cb) { return (f32x4){(float)a[0], (float)a[1], (float)a[2], (float)a[3]} * ra * cb; }
constexpr int TOK_P = 65536;

template <bool I8> struct EpiBf16P {
    static constexpr bool PERM = true, AFTER_DRAIN = false;
    bf16_t* O; int ldc; const float* sa; const float* sb;
    __device__ __forceinline__ void operator()(const typename AccT<I8>::type (&acc)[2][2][4][2], const Unit& u, int wr, int wc, int fr, int fq) const {
        const int row0 = u.pm * BM + wr * 64 + fr, col0 = u.pn * BM + wc * 32 + 8 * fq;
        f32x4 cb[2][2];
#pragma unroll
        for (int bj = 0; bj < 2; ++bj)
#pragma unroll
            for (int n = 0; n < 2; ++n) cb[bj][n] = I8 ? *(const f32x4*)(sb + col0 + bj * HALF + 4 * n) : (f32x4){1.f, 1.f, 1.f, 1.f};
        float rs[2][4];
#pragma unroll
        for (int ai = 0; ai < 2; ++ai)
#pragma unroll
            for (int m = 0; m < 4; ++m) rs[ai][m] = I8 ? sa[row0 + ai * HALF + m * 16] : 1.f;
        __builtin_amdgcn_sched_barrier(0);
#pragma unroll
        for (int ai = 0; ai < 2; ++ai)
#pragma unroll
            for (int m = 0; m < 4; ++m) { const int row = row0 + ai * HALF + m * 16; const float ra = rs[ai][m]; bf16_t* rowp = O + (size_t)row * ldc + col0;
#pragma unroll
                for (int bj = 0; bj < 2; ++bj) *(u32x4*)(rowp + bj * HALF) = pk8(dq4(acc[ai][bj][m][0], ra, cb[bj][0]), dq4(acc[ai][bj][m][1], ra, cb[bj][1])); }
    }
};
template <bool I8> struct EpiGate {
    static constexpr bool PERM = true, AFTER_DRAIN = false;
    bf16_t* U; bf16_t* Bg; const float* sa; const float* sb;
    __device__ __forceinline__ void operator()(const typename AccT<I8>::type (&acc)[2][2][4][2], const Unit& u, int wr, int wc, int fr, int fq) const {
        const int row0 = u.pm * BM + wr * 64 + fr, scol0 = u.pn * BM + wc * 32 + 8 * fq;
        f32x4 cb[2][2];
#pragma unroll
        for (int bj = 0; bj < 2; ++bj)
#pragma unroll
            for (int n = 0; n < 2; ++n) cb[bj][n] = I8 ? *(const f32x4*)(sb + scol0 + bj * HALF + 4 * n) : (f32x4){1.f, 1.f, 1.f, 1.f};
        float rs[2][4];
#pragma unroll
        for (int ai = 0; ai < 2; ++ai)
#pragma unroll
            for (int m = 0; m < 4; ++m) rs[ai][m] = I8 ? sa[row0 + ai * HALF + m * 16] : 1.f;
        __builtin_amdgcn_sched_barrier(0);
        if (u.pn < 8) {
            const int col0 = u.pn * HALF + wc * 32 + 8 * fq;
#pragma unroll
            for (int ai = 0; ai < 2; ++ai)
#pragma unroll
                for (int m = 0; m < 4; ++m) { const int row = row0 + ai * HALF + m * 16; const float ra = rs[ai][m];
                    const f32x4 v0 = dq4(acc[ai][0][m][0], ra, cb[0][0]) * dq4(acc[ai][1][m][0], ra, cb[1][0]), v1 = dq4(acc[ai][0][m][1], ra, cb[0][1]) * dq4(acc[ai][1][m][1], ra, cb[1][1]);
                    *(u32x4*)(U + (size_t)row * 1024 + col0) = pk8(v0, v1); }
        } else {
            const int col0 = (u.pn - 8) * BM + wc * 32 + 8 * fq;
#pragma unroll
            for (int ai = 0; ai < 2; ++ai)
#pragma unroll
                for (int m = 0; m < 4; ++m) { const int row = row0 + ai * HALF + m * 16; const float ra = rs[ai][m]; bf16_t* rowp = Bg + (size_t)row * 1024 + col0;
#pragma unroll
                    for (int bj = 0; bj < 2; ++bj) *(u32x4*)(rowp + bj * HALF) = pk8(dq4(acc[ai][bj][m][0], ra, cb[bj][0]), dq4(acc[ai][bj][m][1], ra, cb[bj][1])); }
        }
    }
};
template <bool I8> struct EpiRes {
    static constexpr bool PERM = true, AFTER_DRAIN = false;
    const bf16_t* H; bf16_t* R; float alpha; const float* sa; const float* sb;
    __device__ __forceinline__ void operator()(const typename AccT<I8>::type (&acc)[2][2][4][2], const Unit& u, int wr, int wc, int fr, int fq) const {
        const int row0 = u.pm * BM + wr * 64 + fr, col0 = u.pn * BM + wc * 32 + 8 * fq;
        f32x4 cb[2][2];
#pragma unroll
        for (int bj = 0; bj < 2; ++bj)
#pragma unroll
            for (int n = 0; n < 2; ++n) cb[bj][n] = I8 ? *(const f32x4*)(sb + col0 + bj * HALF + 4 * n) : (f32x4){1.f, 1.f, 1.f, 1.f};
        float rs[2][4];
#pragma unroll
        for (int ai = 0; ai < 2; ++ai)
#pragma unroll
            for (int m = 0; m < 4; ++m) rs[ai][m] = I8 ? sa[row0 + ai * HALF + m * 16] : 1.f;
        __builtin_amdgcn_sched_barrier(0);
#pragma unroll
        for (int ai = 0; ai < 2; ++ai) {
            u32x4 hq[4][2];
#pragma unroll
            for (int m = 0; m < 4; ++m)
#pragma unroll
                for (int bj = 0; bj < 2; ++bj) hq[m][bj] = *(const u32x4*)(H + (size_t)(row0 + ai * HALF + m * 16) * 1024 + col0 + bj * HALF);
            __builtin_amdgcn_sched_barrier(0);
#pragma unroll
            for (int m = 0; m < 4; ++m) { const int row = row0 + ai * HALF + m * 16; const float ra = rs[ai][m]; const size_t off = (size_t)row * 1024 + col0;
#pragma unroll
                for (int bj = 0; bj < 2; ++bj) { const u32x4 h = hq[m][bj];
                    f32x4 h0, h1; h0[0] = __uint_as_float(h.x << 16); h0[1] = __uint_as_float(h.x & 0xffff0000u); h0[2] = __uint_as_float(h.y << 16); h0[3] = __uint_as_float(h.y & 0xffff0000u);
                    h1[0] = __uint_as_float(h.z << 16); h1[1] = __uint_as_float(h.z & 0xffff0000u); h1[2] = __uint_as_float(h.w << 16); h1[3] = __uint_as_float(h.w & 0xffff0000u);
                    *(u32x4*)(R + off + bj * HALF) = pk8(h0 * alpha + dq4(acc[ai][bj][m][0], ra, cb[bj][0]), h1 * alpha + dq4(acc[ai][bj][m][1], ra, cb[bj][1])); } } }
    }
};
template <bool I8> struct EpiKV {
    static constexpr bool PERM = true, AFTER_DRAIN = false;
    bf16_t* Kb; bf16_t* Vb; float* kp; float* vp; float* ks; float* vs; const float* sa; const float* sb;
    __device__ __forceinline__ void operator()(const typename AccT<I8>::type (&acc)[2][2][4][2], const Unit& u, int wr, int wc, int fr, int fq) const {
        const bool isv = u.pn >= 4; const int colt = (isv ? u.pn - 4 : u.pn) * BM;
        bf16_t* ob = isv ? Vb : Kb; const bool samp = u.pm * BM >= TOK_P;
        float* of = samp ? (isv ? vs : ks) - (size_t)TOK_P * 1024 : (isv ? vp : kp);
        const int row0 = u.pm * BM + wr * 64 + fr, col0 = colt + wc * 32 + 8 * fq, scol0 = u.pn * BM + wc * 32 + 8 * fq;
        float rs[2][4];
#pragma unroll
        for (int ai = 0; ai < 2; ++ai)
#pragma unroll
            for (int m = 0; m < 4; ++m) rs[ai][m] = I8 ? sa[row0 + ai * HALF + m * 16] : 1.f;
        f32x4 cb[2][2];
#pragma unroll
        for (int bj = 0; bj < 2; ++bj)
#pragma unroll
            for (int n = 0; n < 2; ++n) cb[bj][n] = I8 ? *(const f32x4*)(sb + scol0 + bj * HALF + 4 * n) : (f32x4){1.f, 1.f, 1.f, 1.f};
#pragma unroll
        for (int ai = 0; ai < 2; ++ai)
#pragma unroll
            for (int m = 0; m < 4; ++m) { const int row = row0 + ai * HALF + m * 16; const float ra = rs[ai][m]; const size_t off = (size_t)row * 1024 + col0;
#pragma unroll
                for (int bj = 0; bj < 2; ++bj) { const f32x4 v0 = dq4(acc[ai][bj][m][0], ra, cb[bj][0]), v1 = dq4(acc[ai][bj][m][1], ra, cb[bj][1]);
                    *(u32x4*)(ob + off + bj * HALF) = pk8(v0, v1); *(f32x4*)(of + off + bj * HALF) = v0; *(f32x4*)(of + off + bj * HALF + 4) = v1; } }
    }
};

struct EpiScoreI8 {
    static constexpr bool PERM = true, AFTER_DRAIN = false;
    bf16_t* O; int ldc; const float* sa; const float* sb;
    __device__ __forceinline__ void operator()(const i32x4 (&acc)[2][2][4][2], const Unit& u, int wr, int wc, int fr, int fq) const {
        const int row0 = u.pm * BM + wr * 64 + fr, col0 = u.pn * BM + wc * 32 + 8 * fq;
        f32x4 cb[2][2];
#pragma unroll
        for (int bj = 0; bj < 2; ++bj)
#pragma unroll
            for (int n = 0; n < 2; ++n) cb[bj][n] = *(const f32x4*)(sb + col0 + bj * HALF + 4 * n);
        float rs[2][4];
#pragma unroll
        for (int ai = 0; ai < 2; ++ai)
#pragma unroll
            for (int m = 0; m < 4; ++m) rs[ai][m] = sa[row0 + ai * HALF + m * 16];
        __builtin_amdgcn_sched_barrier(0);
#pragma unroll
        for (int ai = 0; ai < 2; ++ai)
#pragma unroll
            for (int m = 0; m < 4; ++m) { const int row = row0 + ai * HALF + m * 16; const float ra = rs[ai][m]; bf16_t* rowp = O + (size_t)row * ldc + col0;
#pragma unroll
                for (int bj = 0; bj < 2; ++bj) { f32x4 v0, v1;
#pragma unroll
                    for (int i = 0; i < 4; ++i) { v0[i] = (float)acc[ai][bj][m][0][i] * ra * cb[bj][0][i]; v1[i] = (float)acc[ai][bj][m][1][i] * ra * cb[bj][1][i]; }
                    *(u32x4*)(rowp + bj * HALF) = pk8(v0, v1); } }
    }
};

template <class Epi, class Sched, bool ALIGN_EPI = false, bool SP2 = false, bool I8 = false>
__device__ __forceinline__ void gemm_phase(PG8_LAS unsigned char* lds, const Gemm g, const Sched& S, const Epi& E, const int tid_in) {
    int tid_ = tid_in; asm volatile("" : "+v"(tid_));
    const int tid = tid_, wid = __builtin_amdgcn_readfirstlane(tid >> 6), lane = tid & 63, wr = wid >> 2, wc = wid & 3, fr = lane & 15, fq = lane >> 4;
    const int K = g.K, nt = K / BK;
    unsigned voffA[2], voffB[2];
#pragma unroll
    for (int i = 0; i < 2; ++i) { int R, C; stage_rc(tid * 16 + i * 8192, R, C); const int Rb = Epi::PERM ? ((R & ~31) + perm32(R & 31)) : R;
        voffA[i] = (unsigned)(R * K + C) * 2u; voffB[i] = (unsigned)(Rb * K + C) * 2u; }
    const size_t kstep = (size_t)(BK * 2);
    const size_t hstep = (size_t)HALF * K * 2;
    const size_t tstep = 2 * hstep;
    const unsigned ldsw = (unsigned)wid * 1024u;
    const int aoff = lds_byte(wr * 64 + fr, fq * 8), boff = lds_byte(wc * 32 + fr, fq * 8);
#define PG8_SA(b, h) (((b) * 2 + (h)) * HTB)
#define PG8_SB(b, h) ((4 + (b) * 2 + (h)) * HTB)
#define PG8_STAGE(bufoff, gbase, voff) do { _Pragma("unroll") for (int _i = 0; _i < 2; ++_i) \
        __builtin_amdgcn_global_load_lds((const unsigned*)((const char*)(gbase) + (voff)[_i]), (PG8_LAS unsigned*)(lds + (bufoff) + ldsw + _i * 8192), 16, 0, 0); } while (0)
#define PG8_LDA(dst, b, h) do { _Pragma("unroll") for (int m = 0; m < 4; ++m) _Pragma("unroll") for (int k = 0; k < 2; ++k) dst[m][k] = *(const PG8_LAS bf16x8*)(lds + PG8_SA(b, h) + aoff + m * 2048 + k * 1024); } while (0)
#define PG8_LDB(dst, b, h) do { _Pragma("unroll") for (int n = 0; n < 2; ++n) _Pragma("unroll") for (int k = 0; k < 2; ++k) dst[n][k] = *(const PG8_LAS bf16x8*)(lds + PG8_SB(b, h) + boff + n * 2048 + k * 1024); } while (0)
#define PG8_MMA(ai, bj, At, Bt) do { __builtin_amdgcn_s_setprio(1); _Pragma("unroll") for (int m = 0; m < 4; ++m) _Pragma("unroll") for (int n = 0; n < 2; ++n) _Pragma("unroll") for (int k = 0; k < 2; ++k) \
        acc[ai][bj][m][n] = mma16(Bt[n][k], At[m][k], acc[ai][bj][m][n]); __builtin_amdgcn_s_setprio(0); } while (0)
#define PG8_WAIT_V(n) asm volatile("s_waitcnt vmcnt(" #n ")" ::: "memory")
#define PG8_WAIT_L(n) asm volatile("s_waitcnt lgkmcnt(" #n ")" ::: "memory")
#define PG8_BAR __builtin_amdgcn_s_barrier()
#define PG8_SCHED __builtin_amdgcn_sched_barrier(0)
    Unit cur, nxt; int ui = 0;
    if (!S.next(0, cur)) return;
    typename AccT<I8>::type acc[2][2][4][2];
#pragma unroll
    for (int a = 0; a < 2; ++a)
#pragma unroll
        for (int b = 0; b < 2; ++b)
#pragma unroll
            for (int m = 0; m < 4; ++m)
#pragma unroll
                for (int n = 0; n < 2; ++n) acc[a][b][m][n] = AccT<I8>::zero();
    bf16x8 At[4][2], B0[2][2], B1[2][2];
    const char* cA = (const char*)g.A + (size_t)cur.pm * tstep; const char* cB = (const char*)g.Bt + (size_t)cur.pn * tstep;
    S.a_ready(cur);
    if constexpr (SP2) {
        PG8_STAGE(PG8_SB(0, 0), cB, voffB); PG8_STAGE(PG8_SB(0, 1), cB + hstep, voffB); PG8_STAGE(PG8_SA(0, 0), cA, voffA); PG8_STAGE(PG8_SA(0, 1), cA + hstep, voffA);
        if (wr == 1) PG8_BAR;
        PG8_WAIT_V(2); PG8_BAR;
        PG8_STAGE(PG8_SB(1, 0), cB + kstep, voffB); PG8_STAGE(PG8_SA(1, 0), cA + kstep, voffA); PG8_STAGE(PG8_SB(1, 1), cB + hstep + kstep, voffB);
        PG8_WAIT_V(6); PG8_BAR;
    } else {
        PG8_STAGE(PG8_SB(0, 0), cB, voffB); PG8_STAGE(PG8_SA(0, 0), cA, voffA); PG8_STAGE(PG8_SB(0, 1), cB + hstep, voffB); PG8_STAGE(PG8_SA(0, 1), cA + hstep, voffA);
        if (wr == 1) PG8_BAR;
        PG8_WAIT_V(4); PG8_BAR;
        PG8_STAGE(PG8_SB(1, 0), cB + kstep, voffB); PG8_STAGE(PG8_SA(1, 0), cA + kstep, voffA); PG8_STAGE(PG8_SB(1, 1), cB + hstep + kstep, voffB);
        PG8_WAIT_V(6); PG8_BAR;
    }
    for (;;) {
        const bool has_next = S.next(ui + 1, nxt);
        const char* nA = has_next ? (const char*)g.A + (size_t)nxt.pm * tstep : cA; const char* nB = has_next ? (const char*)g.Bt + (size_t)nxt.pn * tstep : cB;
        for (int t = 0; t < nt; t += 2) {
            const bool last = (t == nt - 2);
            const char* a1 = cA + (size_t)(t + 1) * kstep;
            const char* a2 = last ? nA : cA + (size_t)(t + 2) * kstep; const char* b2 = last ? nB : cB + (size_t)(t + 2) * kstep;
            const char* a3 = a2 + kstep; const char* b3 = b2 + kstep;
            if (last && has_next) S.a_ready(nxt);
            if constexpr (SP2) {
            PG8_LDB(B0, 0, 0); PG8_LDB(B1, 0, 1); PG8_SCHED; PG8_LDA(At, 0, 0); PG8_STAGE(PG8_SA(1, 1), a1 + hstep, voffA);
            PG8_WAIT_V(8); PG8_WAIT_L(0); PG8_BAR; PG8_MMA(0, 0, At, B0); PG8_MMA(0, 1, At, B1); PG8_BAR; PG8_SCHED;
            PG8_LDA(At, 0, 1); PG8_STAGE(PG8_SB(0, 0), b2, voffB); PG8_STAGE(PG8_SB(0, 1), b2 + hstep, voffB); PG8_STAGE(PG8_SA(0, 0), a2, voffA);
            PG8_WAIT_V(8); PG8_WAIT_L(0); PG8_BAR; PG8_MMA(1, 0, At, B0); PG8_MMA(1, 1, At, B1); PG8_BAR; PG8_SCHED;
            PG8_LDB(B0, 1, 0); PG8_LDB(B1, 1, 1); PG8_SCHED; PG8_LDA(At, 1, 0); PG8_STAGE(PG8_SA(0, 1), a2 + hstep, voffA);
            PG8_WAIT_V(8); PG8_WAIT_L(0); PG8_BAR; PG8_MMA(0, 0, At, B0); PG8_MMA(0, 1, At, B1); PG8_BAR; PG8_SCHED;
            PG8_LDA(At, 1, 1); PG8_STAGE(PG8_SB(1, 0), b3, voffB); PG8_STAGE(PG8_SB(1, 1), b3 + hstep, voffB); PG8_STAGE(PG8_SA(1, 0), a3, voffA);
            PG8_WAIT_V(8); PG8_WAIT_L(0); PG8_BAR; PG8_MMA(1, 0, At, B0); PG8_MMA(1, 1, At, B1); PG8_BAR; PG8_SCHED;
            } else {
            PG8_LDB(B0, 0, 0); PG8_SCHED; PG8_LDA(At, 0, 0); PG8_STAGE(PG8_SA(1, 1), a1 + hstep, voffA);
            PG8_WAIT_L(8); PG8_BAR; PG8_WAIT_L(0); PG8_MMA(0, 0, At, B0); PG8_BAR; PG8_SCHED;
            PG8_LDB(B1, 0, 1); PG8_STAGE(PG8_SB(0, 0), b2, voffB);
            PG8_BAR; PG8_WAIT_L(0); PG8_MMA(0, 1, At, B1); PG8_BAR;
            PG8_LDA(At, 0, 1); PG8_STAGE(PG8_SA(0, 0), a2, voffA);
            PG8_BAR; PG8_WAIT_L(0); PG8_MMA(1, 0, At, B0); PG8_BAR; PG8_SCHED;
            PG8_STAGE(PG8_SB(0, 1), b2 + hstep, voffB);
            PG8_WAIT_V(6); PG8_BAR; PG8_MMA(1, 1, At, B1); PG8_BAR;
            PG8_LDB(B0, 1, 0); PG8_SCHED; PG8_LDA(At, 1, 0); PG8_STAGE(PG8_SA(0, 1), a2 + hstep, voffA);
            PG8_WAIT_L(8); PG8_BAR; PG8_WAIT_L(0); PG8_MMA(0, 0, At, B0); PG8_BAR; PG8_SCHED;
            PG8_LDB(B1, 1, 1); PG8_STAGE(PG8_SB(1, 0), b3, voffB);
            PG8_BAR; PG8_WAIT_L(0); PG8_MMA(0, 1, At, B1); PG8_BAR;
            PG8_LDA(At, 1, 1); PG8_STAGE(PG8_SA(1, 0), a3, voffA);
            PG8_BAR; PG8_WAIT_L(0); PG8_MMA(1, 0, At, B0); PG8_BAR; PG8_SCHED;
            PG8_STAGE(PG8_SB(1, 1), b3 + hstep, voffB);
            PG8_WAIT_V(6); PG8_BAR; PG8_MMA(1, 1, At, B1); PG8_BAR;
            }
        }
        if constexpr (ALIGN_EPI) { if (wr == 0) PG8_BAR; }
        if constexpr (!Epi::AFTER_DRAIN) { E(acc, cur, wr, wc, fr, fq); S.done(cur); }
        if (!has_next) break;
#pragma unroll
        for (int a = 0; a < 2; ++a)
#pragma unroll
            for (int b = 0; b < 2; ++b)
#pragma unroll
                for (int m = 0; m < 4; ++m)
#pragma unroll
                    for (int n = 0; n < 2; ++n) acc[a][b][m][n] = AccT<I8>::zero();
        cur = nxt; cA = nA; cB = nB; ++ui;
        if constexpr (ALIGN_EPI) { if (wr == 1) PG8_BAR; }
    }
    PG8_WAIT_V(0);
    if constexpr (!ALIGN_EPI) { if (wr == 0) PG8_BAR; }
    PG8_BAR;
    if constexpr (Epi::AFTER_DRAIN) { E.fused(acc, cur, wr, wc, fr, fq, lds, wid, lane); S.done(cur); }
#undef PG8_SA
#undef PG8_SB
#undef PG8_STAGE
#undef PG8_LDA
#undef PG8_LDB
#undef PG8_MMA
#undef PG8_WAIT_V
#undef PG8_WAIT_L
#undef PG8_BAR
#undef PG8_SCHED
}
}

#define GAS __attribute__((address_space(1)))
#define LAS __attribute__((address_space(3)))
#define DI __device__ __forceinline__
typedef unsigned short bf16;
typedef unsigned v4u __attribute__((ext_vector_type(4)));
typedef unsigned v2u __attribute__((ext_vector_type(2)));
typedef float f32x4 __attribute__((ext_vector_type(4)));
typedef float f32x16 __attribute__((ext_vector_type(16)));
typedef short bf16x8 __attribute__((ext_vector_type(8)));
using pg8::pk2;
#define LDS_WAIT() asm volatile("s_waitcnt lgkmcnt(0)" ::: "memory")
#define MFMA32(a, b, c) __builtin_amdgcn_mfma_f32_32x32x16_bf16((a), (b), (c), 0, 0, 0)

constexpr int D = 1024, NB = 32, SEQ = 2048, DSEQ = 16, PAST = 1024, NH = 16, DH = 64;
constexpr int TP = NB * SEQ, TS = NB * DSEQ, T = TP + TS;
constexpr int NEXP = 16384, PH = 8, PK = 16;
constexpr int NLAYER = 4;
constexpr float LN_EPS = 1e-5f;
constexpr float ALPHA = 1.6817928305074292f;
constexpr float LOG2E = 1.4426950408889634f, LN2 = 0.6931471805599453f;
static_assert(T % 256 == 0 && pg8::TOK_P == TP, "row panels");
constexpr size_t O_Y = 0, O_YS = (size_t)TP * D, O_CONVP = O_YS + (size_t)TS * D, O_KP = O_CONVP + 2 * NB * 2 * D, O_VP = O_KP + (size_t)TP * D,
                 O_CONVS = O_VP + (size_t)TP * D, O_KS = O_CONVS + 2 * NB * 2 * D, O_VS = O_KS + (size_t)TS * D, O_END = O_VS + (size_t)TS * D;
static_assert(O_END == 203161600ull, "output size");
constexpr size_t MiB = 1u << 20;
constexpr size_t WS_CTL = 0, CTL_BYTES = 2 * MiB;
constexpr size_t WS_WIN = 2 * MiB;
constexpr size_t WS_WOUT = WS_WIN + 12 * MiB;
constexpr size_t WS_WQ = WS_WOUT + 4 * MiB;
constexpr size_t WS_WO = WS_WQ + 4 * MiB;
constexpr size_t WS_WKV = WS_WO + 4 * MiB;
constexpr size_t WS_WP = WS_WKV + 4 * MiB;
constexpr size_t WS_VSN = WS_WP + 16 * MiB;
constexpr size_t WS_H = WS_VSN + 1 * MiB;
constexpr size_t WS_KB = WS_H + 129 * MiB;
constexpr size_t WS_VT = WS_KB + 129 * MiB;
constexpr size_t WS_IDS = WS_VT + 128 * MiB;
constexpr size_t WS_GATE = WS_IDS + 17 * MiB;
constexpr size_t WS_TU = WS_GATE + 33 * MiB;
constexpr size_t WS_TV = WS_TU + 64 * MiB;
constexpr size_t WS_SU = WS_TV + 64 * MiB;
constexpr size_t WS_W8 = WS_SU + 1 * MiB;
constexpr size_t WS_SX = WS_W8 + 9 * MiB;
constexpr size_t WS_X8 = WS_SX + 1 * MiB;
constexpr size_t WS_W8A = WS_X8 + 65 * MiB;
constexpr size_t WS_SWA = WS_W8A + 22 * MiB;
constexpr int W8_ROWS = (int)((WS_VSN - WS_WIN) / 2048);
static_assert(W8_ROWS == 22528, "weight rows");
constexpr size_t WS_A = WS_SWA + 1 * MiB;
constexpr size_t WS_END = WS_A + 258 * MiB;
static_assert((size_t)T * D * 2 == 129 * MiB && (size_t)1024 * T * 4 == 258 * MiB, "sizes");
constexpr int CW_Q = 1024;
constexpr int CW_BAR = 16384;

constexpr int RING_BYTES = 131072, MISC_OFF = RING_BYTES + 320, LDS_BYTES = 147456;

#define XB_TMO      128
#define XB_XCNT(j)  (256  + 64 * (j))
#define XB_XSUB(j)  (1280 + 64 * (j))
#define XB_XGEN(j)  (2304 + 64 * (j))
#define XB_TOP      3328
#define XB_TOPGEN   3392
#define XCD_BAR_WORDS 3456
#define XB_SPIN_CAP (1u << 18)

__device__ __forceinline__ unsigned xb_ld(unsigned* p)              { return __hip_atomic_load(p, __ATOMIC_RELAXED, __HIP_MEMORY_SCOPE_AGENT); }
__device__ __forceinline__ unsigned xb_add(unsigned* p, unsigned v) { return __hip_atomic_fetch_add(p, v, __ATOMIC_RELAXED, __HIP_MEMORY_SCOPE_AGENT); }
__device__ __forceinline__ unsigned xb_xcc_id() { return (unsigned)__builtin_amdgcn_s_getreg((3 << 11) | 20) & 0xFu; }
#define XB_SPIN(cond, bar) do { unsigned _sp = 0; while (cond) { __builtin_amdgcn_s_sleep(1); \
    if ((++_sp & 255u) == 0u) { if (xb_ld(&(bar)[XB_TMO])) break; if (_sp > XB_SPIN_CAP) { atomicAdd(&(bar)[XB_TMO], 1u); break; } } } } while (0)

__device__ __forceinline__ int xb_lane_id() { int l; asm volatile("v_mbcnt_lo_u32_b32 %0, -1, 0\n\tv_mbcnt_hi_u32_b32 %0, -1, %0" : "=v"(l)); return l; }
__device__ __forceinline__ bool xb_is_thread0(unsigned w0) { return w0 != 0u && xb_lane_id() == 0; }
struct XcdBarrier {
    unsigned w0;
    unsigned* bar; unsigned x;
    volatile LAS unsigned* st;
};

__device__ __forceinline__ XcdBarrier xcd_barrier_post(unsigned* bar, volatile LAS unsigned* st, unsigned w0) {
    XcdBarrier b; b.w0 = w0; b.bar = bar; b.x = xb_xcc_id(); b.st = st;
    if (xb_is_thread0(b.w0)) (void)xb_add(&bar[XB_XCNT(b.x)], 1u);
    return b;
}
__device__ __forceinline__ void xcd_barrier_complete(unsigned* bar, unsigned x, unsigned& nloc, unsigned& nx) {
    const unsigned G = gridDim.x * gridDim.y * gridDim.z;
    unsigned sum, cnt, mine, sp = 0u;
    for (;;) {
        sum = 0u; cnt = 0u; mine = 0u;
#pragma unroll
        for (unsigned j = 0; j < 16; ++j) { const unsigned c = xb_ld(&bar[XB_XCNT(j)]); sum += c; cnt += (c > 0u) ? 1u : 0u; mine = (j == x) ? c : mine; }
        if (sum == G) break;
        __builtin_amdgcn_s_sleep(1);
        if ((++sp & 255u) == 0u) { if (xb_ld(&bar[XB_TMO])) break; if (sp > XB_SPIN_CAP) { atomicAdd(&bar[XB_TMO], 1u); break; } }
    }
    nloc = mine > 0u ? mine : 1u; nx = cnt > 0u ? cnt : 1u;
}

__device__ __forceinline__ void xcd_barrier(const XcdBarrier& b) {
    asm volatile("s_waitcnt vmcnt(0)" ::: "memory");
    __syncthreads();
    if (xb_is_thread0(b.w0)) {
        unsigned* bar = b.bar;
        __builtin_amdgcn_s_waitcnt(0);
        unsigned nloc = b.st[0], nx = b.st[1];
        if (nloc == 0u) { xcd_barrier_complete(bar, b.x, nloc, nx); b.st[0] = nloc; b.st[1] = nx; }
        const unsigned old = xb_add(&bar[XB_XSUB(b.x)], 1u);
        const unsigned gen = old / nloc;
        if (old + 1u == (gen + 1u) * nloc) {
            __builtin_amdgcn_fence(__ATOMIC_RELEASE, "agent");
            asm volatile("s_waitcnt vmcnt(0)" ::: "memory");
            const unsigned og = xb_add(&bar[XB_TOP], 1u);
            const unsigned tg = og / nx;
            if (og + 1u == (tg + 1u) * nx) xb_add(&bar[XB_TOPGEN], 1u);
            else XB_SPIN(xb_ld(&bar[XB_TOPGEN]) == tg, bar);
            __builtin_amdgcn_fence(__ATOMIC_ACQUIRE, "agent");
            xb_add(&bar[XB_XGEN(b.x)], 1u);
            asm volatile("s_waitcnt vmcnt(0)" ::: "memory");
        } else {
            XB_SPIN(xb_ld(&bar[XB_XGEN(b.x)]) == gen, bar);
            __builtin_amdgcn_fence(__ATOMIC_ACQUIRE, "agent");
            asm volatile("s_waitcnt vmcnt(0)" ::: "memory");
        }
    }
    __syncthreads();
}


DI float bflo(unsigned w) { return __uint_as_float(w << 16); }
DI float bfhi(unsigned w) { return __uint_as_float(w & 0xffff0000u); }
DI int shx(const int lane, const int v, const int o) {
    if (o == 1) return __builtin_amdgcn_update_dpp(v, v, 0xB1, 0xf, 0xf, false);
    if (o == 2) return __builtin_amdgcn_update_dpp(v, v, 0x4E, 0xf, 0xf, false);
    if (o == 8) return __builtin_amdgcn_update_dpp(v, v, 0x128, 0xf, 0xf, false);
    if (o == 4) return __builtin_amdgcn_ds_swizzle(v, 0x101F);
    if (o == 16) return __builtin_amdgcn_ds_swizzle(v, 0x401F);
    return __builtin_amdgcn_ds_bpermute((lane ^ o) << 2, v);
}
DI float shx(const int lane, const float v, const int o) { return __int_as_float(shx(lane, __float_as_int(v), o)); }
DI float wave_sum(const int lane, float v) {
#pragma unroll
    for (int o = 1; o < 64; o <<= 1) v += shx(lane, v, o);
    return v;
}
DI bf16x8 pack8(float a0, float a1, float a2, float a3, float a4, float a5, float a6, float a7) {
    v4u p; p.x = pk2(a0, a1); p.y = pk2(a2, a3); p.z = pk2(a4, a5); p.w = pk2(a6, a7); return __builtin_bit_cast(bf16x8, p);
}
DI float gelu_erf(float v) {
    const float av = __builtin_fabsf(v), d = av * 0.2316418882f + 1.0f, t = __builtin_amdgcn_rcpf(d);
    float q = t * 0.5307027145f + (-0.7265760135f); q = q * t + 0.7107068705f; q = q * t + (-0.142248368f); q = q * t + 0.127414796f; q = q * t;
    const float e = __builtin_amdgcn_exp2f((v * v) * (-0.72134752044f));
    const float m = v * (q * e), r = v - m;
    return v < 0.f ? m : r;
}

struct Ctx {
    int tid, lane, wave, vcu, G;
};

DI void p0_transpose_item(const float* W, int K, int N, bf16* WT, int out_row0, float scale, LAS float* scr, int k0, int n0, int lane) {
#pragma unroll 8
    for (int i = 0; i < 32; ++i) { const int kk = 2 * i + (lane >> 5); scr[kk * 33 + (lane & 31)] = W[(size_t)(k0 + kk) * N + n0 + (lane & 31)]; }
    LDS_WAIT(); asm volatile("" ::: "memory");
    const int c = lane & 7;
#pragma unroll
    for (int j = 0; j < 4; ++j) { const int n = (lane >> 3) + 8 * j; const LAS float* s = scr + (8 * c) * 33 + n;
        v4u o; o.x = pk2(s[0 * 33] * scale, s[1 * 33] * scale); o.y = pk2(s[2 * 33] * scale, s[3 * 33] * scale); o.z = pk2(s[4 * 33] * scale, s[5 * 33] * scale); o.w = pk2(s[6 * 33] * scale, s[7 * 33] * scale);
        *(v4u*)(WT + (size_t)(out_row0 + n) * K + k0 + 8 * c) = o; }
    LDS_WAIT(); asm volatile("" ::: "memory");
}
DI void cvt_stream(const float* src, bf16* dst, size_t n8, size_t gtid, size_t NT) {
    size_t i = gtid;
    for (; i + 3 * NT < n8; i += 4 * NT) {
        f32x4 a[4], b[4];
#pragma unroll
        for (int u = 0; u < 4; ++u) { a[u] = *(const f32x4*)(src + (i + u * NT) * 8); b[u] = *(const f32x4*)(src + (i + u * NT) * 8 + 4); }
#pragma unroll
        for (int u = 0; u < 4; ++u) *(v4u*)(dst + (i + u * NT) * 8) = pg8::pk8(a[u], b[u]);
    }
    for (; i < n8; i += NT) { const f32x4 a = *(const f32x4*)(src + i * 8), b = *(const f32x4*)(src + i * 8 + 4); *(v4u*)(dst + i * 8) = pg8::pk8(a, b); }
}
DI unsigned q4_i8(const f32x4 v, const float k) {
    const int a = (int)__builtin_rintf(v[0] * k), b = (int)__builtin_rintf(v[1] * k), c = (int)__builtin_rintf(v[2] * k), d = (int)__builtin_rintf(v[3] * k);
    return ((unsigned)a & 0xffu) | (((unsigned)b & 0xffu) << 8) | (((unsigned)c & 0xffu) << 16) | ((unsigned)d << 24);
}
DI void cvt_table_rows(const float* src, unsigned char* dst, float* scl  , int nrows, int gw, int NGW, int lane) {
    f32x4 nx[4];
#pragma unroll
    for (int j = 0; j < 4; ++j) nx[j] = *(const f32x4*)(src + (size_t)(gw < nrows ? gw : 0) * D + 4 * lane + 256 * j);
    for (int row = gw; row < nrows; row += NGW) {
        f32x4 v[4]; float m = 0.f; const int rn = row + NGW < nrows ? row + NGW : row;
#pragma unroll
        for (int j = 0; j < 4; ++j) { v[j] = nx[j]; nx[j] = *(const f32x4*)(src + (size_t)rn * D + 4 * lane + 256 * j);
            m = __builtin_fmaxf(m, __builtin_fmaxf(__builtin_fmaxf(__builtin_fabsf(v[j][0]), __builtin_fabsf(v[j][1])), __builtin_fmaxf(__builtin_fabsf(v[j][2]), __builtin_fabsf(v[j][3])))); }
#pragma unroll
        for (int o = 1; o < 64; o <<= 1) m = __builtin_fmaxf(m, shx(lane, m, o));
        const float k = m > 0.f ? 127.0f / m : 0.f;
#pragma unroll
        for (int j = 0; j < 4; ++j)
            *(unsigned*)(dst + ((size_t)(row >> 14) * NEXP * D) + ((size_t)(2 * j + (lane >> 5)) * NEXP + (row & (NEXP - 1))) * 128 + ((4 * lane) & 127)) = q4_i8(v[j], k);
        if (lane == 0) scl[2 * row] = m * (1.0f / 127.0f);
    }
}
struct P0Args { const float *x_p, *x_s, *w_in, *w_out, *wq, *wo, *wk, *wv, *pwq, *psk, *pu, *pv; bf16 *WinT, *WoutT, *WqT, *WoT, *WkvT, *WP, *H; unsigned char *TU, *TV; float *SU, *SV; unsigned char* X8; float* SX; };
DI void p0_prologue(const Ctx c, LAS unsigned char* lds, const P0Args a) {
    { LAS float* scr = (LAS float*)(lds + c.wave * 16384);
      const int gw = c.vcu * 8 + c.wave, NGW = c.G * 8;
      constexpr int IT_WIN = 16 * 96, IT_SQ = 16 * 32, NITEMS = 2 * IT_WIN + 8 * IT_SQ;
      for (int it = gw; it < NITEMS; it += NGW) {
          int r = it;
          if (r < 2 * IT_WIN) { const int l = r / IT_WIN; r -= l * IT_WIN; const int kb = r / 96, nb = r % 96, n0 = 32 * nb; int orow;
              if (n0 < 1024) orow = 2048 + n0; else if (n0 < 2048) { const int d = n0 - 1024; orow = 256 * (d >> 7) + (d & 127); } else { const int d = n0 - 2048; orow = 256 * (d >> 7) + 128 + (d & 127); }
              p0_transpose_item(a.w_in + (size_t)l * 1024 * 3072, 1024, 3072, a.WinT + (size_t)l * 3072 * 1024, orow, 1.f, scr, 64 * kb, n0, c.lane); continue; }
          r -= 2 * IT_WIN; const int m = r / IT_SQ; r -= m * IT_SQ; const int kb = r >> 5, nb = r & 31;
          const float* src; bf16* dst; float sc = 1.f; const size_t SQ = (size_t)1024 * 1024;
          if (m < 2) { src = a.w_out + m * SQ; dst = a.WoutT + m * SQ; }
          else if (m < 4) { src = a.wq + (m - 2) * SQ; dst = a.WqT + (m - 2) * SQ; sc = 0.125f * LOG2E; }
          else if (m < 6) { src = a.wo + (m - 4) * SQ; dst = a.WoT + (m - 4) * SQ; }
          else if (m == 6) { src = a.wk; dst = a.WkvT; }
          else { src = a.wv; dst = a.WkvT + SQ; }
          p0_transpose_item(src, 1024, 1024, dst, 32 * nb, sc, scr, 64 * kb, 32 * nb, c.lane);
      }
    }
    __syncthreads();
    { LAS float* skT = (LAS float*)lds; LAS float* wqT = skT + 128 * 132;
      for (int u = c.vcu; u < 4 * 16 * 16; u += c.G) {
          const int l = u >> 8, hp = (u >> 4) & 15, dblk = u & 15;
          for (int i = c.tid; i < 16384; i += 512) skT[(i & 127) * 132 + (i >> 7)] = a.psk[(size_t)(l * 16 + hp) * 16384 + i];
          for (int i = c.tid; i < 8192; i += 512) wqT[(i & 127) * 68 + (i >> 7)] = a.pwq[((size_t)l * 1024 + dblk * 64 + (i >> 7)) * 2048 + hp * 128 + (i & 127)];
          __syncthreads();
          const int ng = c.tid & 31, dg = c.tid >> 5; f32x4 acc[4];
#pragma unroll
          for (int i = 0; i < 4; ++i) acc[i] = (f32x4){0.f, 0.f, 0.f, 0.f};
#pragma unroll 4
          for (int cc = 0; cc < 128; ++cc) { const f32x4 s = *(const LAS f32x4*)(skT + cc * 132 + 4 * ng), w = *(const LAS f32x4*)(wqT + cc * 68 + 4 * dg);
#pragma unroll
              for (int i = 0; i < 4; ++i) acc[i] = acc[i] + w * s[i]; }
#pragma unroll
          for (int i = 0; i < 4; ++i) { v2u o; o.x = pk2(acc[i][0], acc[i][1]); o.y = pk2(acc[i][2], acc[i][3]);
              *(v2u*)(a.WP + ((size_t)l * 2048 + hp * 128 + 4 * ng + i) * 1024 + dblk * 64 + 4 * dg) = o; }
          __syncthreads();
      }
    }
    { const size_t gtid = (size_t)c.vcu * 512 + c.tid, NT = (size_t)c.G * 512;
      cvt_table_rows(a.pu, a.TU, a.SU, NLAYER * NEXP, c.vcu * 8 + c.wave, c.G * 8, c.lane);
      cvt_table_rows(a.pv, a.TV, a.SV, NLAYER * NEXP, c.vcu * 8 + c.wave, c.G * 8, c.lane);
      (void)gtid; (void)NT;
      for (int m = c.vcu * 8 + c.wave; m < T; m += c.G * 8) {
          const float* xr = (m < TP ? a.x_p + (size_t)m * D : a.x_s + (size_t)(m - TP) * D) + 4 * c.lane;
          f32x4 v[4]; float am = 0.f;
#pragma unroll
          for (int j = 0; j < 4; ++j) { v[j] = *(const f32x4*)(xr + 256 * j); v2u w; w.x = pk2(v[j][0], v[j][1]); w.y = pk2(v[j][2], v[j][3]); ((v2u*)(a.H + (size_t)m * D) + c.lane)[64 * j] = w;
              am = __builtin_fmaxf(am, __builtin_fmaxf(__builtin_fmaxf(__builtin_fabsf(v[j][0]), __builtin_fabsf(v[j][1])), __builtin_fmaxf(__builtin_fabsf(v[j][2]), __builtin_fabsf(v[j][3])))); }
#pragma unroll
          for (int o = 1; o < 64; o <<= 1) am = __builtin_fmaxf(am, shx(c.lane, am, o));
          const float k = am > 0.f ? 127.0f / am : 0.f;
#pragma unroll
          for (int j = 0; j < 4; ++j) *(unsigned*)(a.X8 + (size_t)m * D + 4 * c.lane + 256 * j) = q4_i8(v[j], k);
          if (c.lane == 0) a.SX[m] = am * (1.0f / 127.0f);
      }
    }
}

DI void wp_quant_phase(const Ctx c, const bf16* WPb, unsigned char* WP8q, float* swp) {
    for (int row = c.vcu * 8 + c.wave; row < W8_ROWS; row += c.G * 8) {
        const v4u a = *(const v4u*)(WPb + (size_t)row * D + 16 * c.lane), b = *(const v4u*)(WPb + (size_t)row * D + 16 * c.lane + 8);
        const f32x4 v0 = {bflo(a.x), bfhi(a.x), bflo(a.y), bfhi(a.y)}, v1 = {bflo(a.z), bfhi(a.z), bflo(a.w), bfhi(a.w)}, v2 = {bflo(b.x), bfhi(b.x), bflo(b.y), bfhi(b.y)}, v3 = {bflo(b.z), bfhi(b.z), bflo(b.w), bfhi(b.w)};
        float m = 0.f;
#pragma unroll
        for (int i = 0; i < 4; ++i) m = __builtin_fmaxf(m, __builtin_fmaxf(__builtin_fmaxf(__builtin_fabsf(v0[i]), __builtin_fabsf(v1[i])), __builtin_fmaxf(__builtin_fabsf(v2[i]), __builtin_fabsf(v3[i]))));
#pragma unroll
        for (int o = 1; o < 64; o <<= 1) m = __builtin_fmaxf(m, shx(c.lane, m, o));
        const float k = m > 0.f ? 127.0f / m : 0.f;
        v4u o; o.x = q4_i8(v0, k); o.y = q4_i8(v1, k); o.z = q4_i8(v2, k); o.w = q4_i8(v3, k);
        *(v4u*)(WP8q + (size_t)row * D + 16 * c.lane) = o;
        if (c.lane == 0) swp[row] = m * (1.0f / 127.0f);
    }
}

DI void ld8_bf16(const bf16* p, float (&o)[8]) { const v4u w = *(const v4u*)p; o[0] = bflo(w.x); o[1] = bfhi(w.x); o[2] = bflo(w.y); o[3] = bfhi(w.y); o[4] = bflo(w.z); o[5] = bfhi(w.z); o[6] = bflo(w.w); o[7] = bfhi(w.w); }
DI void ld8_f32(const float* p, float (&o)[8]) { const f32x4 a = *(const f32x4*)p, b = *(const f32x4*)(p + 4); o[0] = a[0]; o[1] = a[1]; o[2] = a[2]; o[3] = a[3]; o[4] = b[0]; o[5] = b[1]; o[6] = b[2]; o[7] = b[3]; }
DI void conv_gate_phase(const Ctx c, const bf16* U, bf16* Bg, const float* wdw  , const float* st  , float* convp, float* convs  ,
                        unsigned char* z8, float* sz  , const bool skip_samp = false  ) {
    const int gw = c.vcu * 8 + c.wave, NGW = c.G * 8, dc = 16 * c.lane;
    float w0[16], w1[16], w2[16];
    { float t8[8]; ld8_f32(wdw + dc, t8);
#pragma unroll
      for (int i = 0; i < 8; ++i) w0[i] = t8[i]; ld8_f32(wdw + dc + 8, t8);
#pragma unroll
      for (int i = 0; i < 8; ++i) w0[8 + i] = t8[i]; ld8_f32(wdw + D + dc, t8);
#pragma unroll
      for (int i = 0; i < 8; ++i) w1[i] = t8[i]; ld8_f32(wdw + D + dc + 8, t8);
#pragma unroll
      for (int i = 0; i < 8; ++i) w1[8 + i] = t8[i]; ld8_f32(wdw + 2 * D + dc, t8);
#pragma unroll
      for (int i = 0; i < 8; ++i) w2[i] = t8[i]; ld8_f32(wdw + 2 * D + dc + 8, t8);
#pragma unroll
      for (int i = 0; i < 8; ++i) w2[8 + i] = t8[i]; }
    { v4u ng[2], n2[2], n1[2], n0[2];
#define CG_LOAD(tt_) do { const int t_ = (tt_), s_ = t_ & 2047, t1_ = s_ >= 1 ? t_ - 1 : t_, t0_ = s_ >= 2 ? t_ - 2 : t_; \
        _Pragma("unroll") for (int hf = 0; hf < 2; ++hf) { ng[hf] = *(const v4u*)(Bg + (size_t)t_ * D + dc + 8 * hf); n2[hf] = *(const v4u*)(U + (size_t)t_ * D + dc + 8 * hf); \
            n1[hf] = *(const v4u*)(U + (size_t)t1_ * D + dc + 8 * hf); n0[hf] = *(const v4u*)(U + (size_t)t0_ * D + dc + 8 * hf); } } while (0)
      if (gw < TP) CG_LOAD(gw);
      for (int t = gw; t < TP; t += NGW) {
          const int s = t & 2047; const float f1 = s >= 1 ? 1.f : 0.f, f0 = s >= 2 ? 1.f : 0.f;
          v4u cg[2], c2[2], c1[2], c0[2];
#pragma unroll
          for (int hf = 0; hf < 2; ++hf) { cg[hf] = ng[hf]; c2[hf] = n2[hf]; c1[hf] = n1[hf]; c0[hf] = n0[hf]; }
          CG_LOAD(t + NGW < TP ? t + NGW : t);
          float z[16]; float am = 0.f;
#pragma unroll
          for (int hf = 0; hf < 2; ++hf) { const unsigned wg[4] = {cg[hf].x, cg[hf].y, cg[hf].z, cg[hf].w}, w2_[4] = {c2[hf].x, c2[hf].y, c2[hf].z, c2[hf].w}, w1_[4] = {c1[hf].x, c1[hf].y, c1[hf].z, c1[hf].w}, w0_[4] = {c0[hf].x, c0[hf].y, c0[hf].z, c0[hf].w};
#pragma unroll
              for (int i = 0; i < 8; ++i) { const bool hi = i & 1; const int k = i >> 1;
                  const float g = hi ? bfhi(wg[k]) : bflo(wg[k]), u2 = hi ? bfhi(w2_[k]) : bflo(w2_[k]), u1 = (hi ? bfhi(w1_[k]) : bflo(w1_[k])) * f1, u0 = (hi ? bfhi(w0_[k]) : bflo(w0_[k])) * f0;
                  const float zz = g * (w0[8 * hf + i] * u0 + w1[8 * hf + i] * u1 + w2[8 * hf + i] * u2); z[8 * hf + i] = zz; am = __builtin_fmaxf(am, __builtin_fabsf(zz)); } }
#pragma unroll
          for (int o = 1; o < 64; o <<= 1) am = __builtin_fmaxf(am, shx(c.lane, am, o));
          const float k = am > 0.f ? 127.0f / am : 0.f;
          v4u q; q.x = q4_i8((f32x4){z[0], z[1], z[2], z[3]}, k); q.y = q4_i8((f32x4){z[4], z[5], z[6], z[7]}, k); q.z = q4_i8((f32x4){z[8], z[9], z[10], z[11]}, k); q.w = q4_i8((f32x4){z[12], z[13], z[14], z[15]}, k);
          *(v4u*)(z8 + (size_t)t * D + dc) = q;
          if (c.lane == 0) sz[t] = am * (1.0f / 127.0f);
      }
#undef CG_LOAD
    }
    for (int t = TP + gw; t < (skip_samp ? TP : T); t += NGW) {
        const bool samp = true; const int s = (t - TP) & 15; const int b = (t - TP) >> 4;
        float z[16]; float am = 0.f;
#pragma unroll
        for (int hf = 0; hf < 2; ++hf) { const int d0 = dc + 8 * hf;
            float u0[8], u1[8], u2[8], g[8];
            ld8_bf16(U + (size_t)t * D + d0, u2);
            { float* cdst = nullptr;
              (void)convp;
              if (samp && s >= DSEQ - 2) cdst = convs + ((size_t)b * 2 + (s - (DSEQ - 2))) * D + d0;
              if (cdst) { *(f32x4*)cdst = (f32x4){u2[0], u2[1], u2[2], u2[3]}; *(f32x4*)(cdst + 4) = (f32x4){u2[4], u2[5], u2[6], u2[7]}; } }
            if (s >= 1) ld8_bf16(U + (size_t)(t - 1) * D + d0, u1);
            else if (samp) ld8_f32(st + ((size_t)b * 2 + 1) * D + d0, u1);
            else {
#pragma unroll
                for (int i = 0; i < 8; ++i) u1[i] = 0.f; }
            if (s >= 2) ld8_bf16(U + (size_t)(t - 2) * D + d0, u0);
            else if (samp) ld8_f32(st + ((size_t)b * 2 + (s == 1 ? 1 : 0)) * D + d0, u0);
            else {
#pragma unroll
                for (int i = 0; i < 8; ++i) u0[i] = 0.f; }
            ld8_bf16(Bg + (size_t)t * D + d0, g);
#pragma unroll
            for (int i = 0; i < 8; ++i) { const float zz = g[i] * (w0[8 * hf + i] * u0[i] + w1[8 * hf + i] * u1[i] + w2[8 * hf + i] * u2[i]); z[8 * hf + i] = zz; am = __builtin_fmaxf(am, __builtin_fabsf(zz)); }
        }
        if (samp) {
            v4u o0, o1; o0.x = pk2(z[0], z[1]); o0.y = pk2(z[2], z[3]); o0.z = pk2(z[4], z[5]); o0.w = pk2(z[6], z[7]); o1.x = pk2(z[8], z[9]); o1.y = pk2(z[10], z[11]); o1.z = pk2(z[12], z[13]); o1.w = pk2(z[14], z[15]);
            *(v4u*)(Bg + (size_t)t * D + dc) = o0; *(v4u*)(Bg + (size_t)t * D + dc + 8) = o1; }
#pragma unroll
        for (int o = 1; o < 64; o <<= 1) am = __builtin_fmaxf(am, shx(c.lane, am, o));
        const float k = am > 0.f ? 127.0f / am : 0.f;
        v4u q; q.x = q4_i8((f32x4){z[0], z[1], z[2], z[3]}, k); q.y = q4_i8((f32x4){z[4], z[5], z[6], z[7]}, k); q.z = q4_i8((f32x4){z[8], z[9], z[10], z[11]}, k); q.w = q4_i8((f32x4){z[12], z[13], z[14], z[15]}, k);
        *(v4u*)(z8 + (size_t)t * D + dc) = q;
        if (c.lane == 0) sz[t] = am * (1.0f / 127.0f);
    }
}

DI void ln_phase(const Ctx c, const bf16* R, bf16* H, const float* g, const float* bb, float* yout = nullptr, const bf16* Hres = nullptr, unsigned char* x8 = nullptr, float* sx = nullptr) {
    const int gw = c.vcu * 8 + c.wave, NGW = c.G * 8;
    float gv[2][8], bv[2][8];
#pragma unroll
    for (int j = 0; j < 2; ++j) { ld8_f32(g + 8 * c.lane + 512 * j, gv[j]); ld8_f32(bb + 8 * c.lane + 512 * j, bv[j]); }
    v4u rw[2], hw[2];
#pragma unroll
    for (int j = 0; j < 2; ++j) { const int m0 = gw < T ? gw : 0; rw[j] = *(const v4u*)(R + (size_t)m0 * D + 8 * c.lane + 512 * j); hw[j] = Hres ? *(const v4u*)(Hres + (size_t)m0 * D + 8 * c.lane + 512 * j) : (v4u){0u, 0u, 0u, 0u}; }
    for (int m = gw; m < T; m += NGW) {
        float v[2][8]; float s = 0.f;
#pragma unroll
        for (int j = 0; j < 2; ++j) { const unsigned w[4] = {rw[j].x, rw[j].y, rw[j].z, rw[j].w}, hq[4] = {hw[j].x, hw[j].y, hw[j].z, hw[j].w};
#pragma unroll
            for (int i = 0; i < 4; ++i) { v[j][2 * i] = bflo(w[i]); v[j][2 * i + 1] = bfhi(w[i]); if (Hres) { v[j][2 * i] += bflo(hq[i]) * ALPHA; v[j][2 * i + 1] += bfhi(hq[i]) * ALPHA; } }
#pragma unroll
            for (int i = 0; i < 8; ++i) s += v[j][i]; }
        { const int mn = m + NGW < T ? m + NGW : m;
#pragma unroll
          for (int j = 0; j < 2; ++j) { rw[j] = *(const v4u*)(R + (size_t)mn * D + 8 * c.lane + 512 * j); if (Hres) hw[j] = *(const v4u*)(Hres + (size_t)mn * D + 8 * c.lane + 512 * j); } }
        const float mean = wave_sum(c.lane, s) * (1.f / D); float s2 = 0.f;
#pragma unroll
        for (int j = 0; j < 2; ++j)
#pragma unroll
            for (int i = 0; i < 8; ++i) { v[j][i] -= mean; s2 += v[j][i] * v[j][i]; }
        const float rstd = __builtin_amdgcn_rsqf(wave_sum(c.lane, s2) * (1.f / D) + LN_EPS);
        float am = 0.f;
#pragma unroll
        for (int j = 0; j < 2; ++j)
#pragma unroll
            for (int i = 0; i < 8; ++i) { v[j][i] = v[j][i] * rstd * gv[j][i] + bv[j][i]; am = __builtin_fmaxf(am, __builtin_fabsf(v[j][i])); }
        if (yout) {
#pragma unroll
            for (int j = 0; j < 2; ++j) { float* o = yout + (size_t)m * D + 8 * c.lane + 512 * j; *(f32x4*)o = (f32x4){v[j][0], v[j][1], v[j][2], v[j][3]}; *(f32x4*)(o + 4) = (f32x4){v[j][4], v[j][5], v[j][6], v[j][7]}; }
        } else {
#pragma unroll
            for (int j = 0; j < 2; ++j) { v4u w; w.x = pk2(v[j][0], v[j][1]); w.y = pk2(v[j][2], v[j][3]); w.z = pk2(v[j][4], v[j][5]); w.w = pk2(v[j][6], v[j][7]); *(v4u*)(H + (size_t)m * D + 8 * c.lane + 512 * j) = w; }
            if (x8) {
#pragma unroll
                for (int o = 1; o < 64; o <<= 1) am = __builtin_fmaxf(am, shx(c.lane, am, o));
                const float k = am > 0.f ? 127.0f / am : 0.f;
#pragma unroll
                for (int j = 0; j < 2; ++j) { v2u q; q.x = q4_i8((f32x4){v[j][0], v[j][1], v[j][2], v[j][3]}, k); q.y = q4_i8((f32x4){v[j][4], v[j][5], v[j][6], v[j][7]}, k); *(v2u*)(x8 + (size_t)m * D + 8 * c.lane + 512 * j) = q; }
                if (c.lane == 0) sx[m] = am * (1.0f / 127.0f);
            } }
    }
}

DI int ordi(float x) { const int b = __float_as_int(x); return b ^ ((b >> 31) & 0x7fffffff); }
DI float unordi(int o) { return __int_as_float(o ^ ((o >> 31) & 0x7fffffff)); }
#define TK_CE(a, b) do { const int _hi = (a) > (b) ? (a) : (b), _lo = (a) > (b) ? (b) : (a); (a) = _hi; (b) = _lo; } while (0)
#define TK_CPK(i, j) ((ordi(va[i] + vb[j]) & ~255) | (255 - ((i) * 16 + (j))))
#define TK_SORT16(v) do { TK_CE(v[0], v[1]); TK_CE(v[2], v[3]); TK_CE(v[0], v[2]); TK_CE(v[1], v[3]); TK_CE(v[1], v[2]); TK_CE(v[4], v[5]); TK_CE(v[6], v[7]); TK_CE(v[4], v[6]); TK_CE(v[5], v[7]); TK_CE(v[5], v[6]); TK_CE(v[0], v[4]); TK_CE(v[2], v[6]); TK_CE(v[2], v[4]); TK_CE(v[1], v[5]); TK_CE(v[3], v[7]); TK_CE(v[3], v[5]); TK_CE(v[1], v[2]); TK_CE(v[3], v[4]); TK_CE(v[5], v[6]); TK_CE(v[8], v[9]); TK_CE(v[10], v[11]); TK_CE(v[8], v[10]); TK_CE(v[9], v[11]); TK_CE(v[9], v[10]); TK_CE(v[12], v[13]); TK_CE(v[14], v[15]); TK_CE(v[12], v[14]); TK_CE(v[13], v[15]); TK_CE(v[13], v[14]); TK_CE(v[8], v[12]); TK_CE(v[10], v[14]); TK_CE(v[10], v[12]); TK_CE(v[9], v[13]); TK_CE(v[11], v[15]); TK_CE(v[11], v[13]); TK_CE(v[9], v[10]); TK_CE(v[11], v[12]); TK_CE(v[13], v[14]); TK_CE(v[0], v[8]); TK_CE(v[4], v[12]); TK_CE(v[4], v[8]); TK_CE(v[2], v[10]); TK_CE(v[6], v[14]); TK_CE(v[6], v[10]); TK_CE(v[2], v[4]); TK_CE(v[6], v[8]); TK_CE(v[10], v[12]); TK_CE(v[1], v[9]); TK_CE(v[5], v[13]); TK_CE(v[5], v[9]); TK_CE(v[3], v[11]); TK_CE(v[7], v[15]); TK_CE(v[7], v[11]); TK_CE(v[3], v[5]); TK_CE(v[7], v[9]); TK_CE(v[11], v[13]); TK_CE(v[1], v[2]); TK_CE(v[3], v[4]); TK_CE(v[5], v[6]); TK_CE(v[7], v[8]); TK_CE(v[9], v[10]); TK_CE(v[11], v[12]); TK_CE(v[13], v[14]); } while (0)
#define TK_BMERGE16(v) do { TK_CE(v[0], v[8]); TK_CE(v[1], v[9]); TK_CE(v[2], v[10]); TK_CE(v[3], v[11]); TK_CE(v[4], v[12]); TK_CE(v[5], v[13]); TK_CE(v[6], v[14]); TK_CE(v[7], v[15]); TK_CE(v[0], v[4]); TK_CE(v[1], v[5]); TK_CE(v[2], v[6]); TK_CE(v[3], v[7]); TK_CE(v[8], v[12]); TK_CE(v[9], v[13]); TK_CE(v[10], v[14]); TK_CE(v[11], v[15]); TK_CE(v[0], v[2]); TK_CE(v[1], v[3]); TK_CE(v[4], v[6]); TK_CE(v[5], v[7]); TK_CE(v[8], v[10]); TK_CE(v[9], v[11]); TK_CE(v[12], v[14]); TK_CE(v[13], v[15]); TK_CE(v[0], v[1]); TK_CE(v[2], v[3]); TK_CE(v[4], v[5]); TK_CE(v[6], v[7]); TK_CE(v[8], v[9]); TK_CE(v[10], v[11]); TK_CE(v[12], v[13]); TK_CE(v[14], v[15]); } while (0)
#define TK_CAND0(B) do { B[0] = TK_CPK(0, 0); B[1] = TK_CPK(0, 1); B[2] = TK_CPK(0, 2); B[3] = TK_CPK(0, 3); B[4] = TK_CPK(0, 4); B[5] = TK_CPK(0, 5); B[6] = TK_CPK(0, 6); B[7] = TK_CPK(0, 7); B[8] = TK_CPK(0, 8); B[9] = TK_CPK(0, 9); B[10] = TK_CPK(0, 10); B[11] = TK_CPK(0, 11); B[12] = TK_CPK(0, 12); B[13] = TK_CPK(0, 13); B[14] = TK_CPK(0, 14); B[15] = TK_CPK(0, 15); } while (0)
#define TK_CAND1(B) do { B[0] = TK_CPK(1, 0); B[1] = TK_CPK(1, 1); B[2] = TK_CPK(1, 2); B[3] = TK_CPK(1, 3); B[4] = TK_CPK(1, 4); B[5] = TK_CPK(1, 5); B[6] = TK_CPK(1, 6); B[7] = TK_CPK(1, 7); B[8] = TK_CPK(2, 0); B[9] = TK_CPK(2, 1); B[10] = TK_CPK(2, 2); B[11] = TK_CPK(2, 3); B[12] = TK_CPK(2, 4); B[13] = TK_CPK(3, 0); B[14] = TK_CPK(3, 1); B[15] = TK_CPK(3, 2); } while (0)
#define TK_CAND2(B) do { B[0] = TK_CPK(3, 3); B[1] = TK_CPK(4, 0); B[2] = TK_CPK(4, 1); B[3] = TK_CPK(4, 2); B[4] = TK_CPK(5, 0); B[5] = TK_CPK(5, 1); B[6] = TK_CPK(6, 0); B[7] = TK_CPK(6, 1); B[8] = TK_CPK(7, 0); B[9] = TK_CPK(7, 1); B[10] = TK_CPK(8, 0); B[11] = TK_CPK(9, 0); B[12] = TK_CPK(10, 0); B[13] = TK_CPK(11, 0); B[14] = TK_CPK(12, 0); B[15] = TK_CPK(13, 0); } while (0)
#define TK_CAND3(B) do { B[0] = TK_CPK(14, 0); B[1] = TK_CPK(15, 0); B[2] = (int)0x80000000; B[3] = (int)0x80000000; B[4] = (int)0x80000000; B[5] = (int)0x80000000; B[6] = (int)0x80000000; B[7] = (int)0x80000000; B[8] = (int)0x80000000; B[9] = (int)0x80000000; B[10] = (int)0x80000000; B[11] = (int)0x80000000; B[12] = (int)0x80000000; B[13] = (int)0x80000000; B[14] = (int)0x80000000; B[15] = (int)0x80000000; } while (0)
DI void tk_merge(int (&L)[16], const int (&B)[16]) {
#pragma unroll
    for (int i = 0; i < 16; ++i) L[i] = L[i] > B[15 - i] ? L[i] : B[15 - i];
    TK_BMERGE16(L);
}
DI void tk_feed32(int (&L)[16], const v4u (&x)[4], const int rb) {
#pragma unroll
    for (int hf = 0; hf < 2; ++hf) { int B[16]; const unsigned w[8] = {x[2 * hf].x, x[2 * hf].y, x[2 * hf].z, x[2 * hf].w, x[2 * hf + 1].x, x[2 * hf + 1].y, x[2 * hf + 1].z, x[2 * hf + 1].w};
#pragma unroll
        for (int j = 0; j < 16; ++j) B[j] = (ordi(__uint_as_float((j & 1) ? (w[j >> 1] & 0xffff0000u) : (w[j >> 1] << 16))) & ~127) | (127 - ((rb + 16 * hf + j) & 127));
        TK_SORT16(B); tk_merge(L, B); }
}
DI unsigned byte_of(unsigned a0, unsigned a1, unsigned a2, unsigned a3, int i) { const unsigned lo = i < 4 ? a0 : a1, hi = i < 12 ? a2 : a3, w = i < 8 ? lo : hi; return (w >> ((i & 3) * 8)) & 0xffu; }
DI void topk_phase(const Ctx c, const bf16* Sc  , unsigned short* ids, float* gates) {
    const int gw = c.wave * c.G + c.vcu, NGW = c.G * 8, NU = 8 * (T / 64);
    v4u bufA[4], bufB[4];
    if (gw < NU) { const v4u* sc = (const v4u*)(Sc + (size_t)((gw % (T / 64)) * 64 + c.lane) * 2048 + (gw / (T / 64)) * 256);
#pragma unroll
        for (int j = 0; j < 4; ++j) bufA[j] = sc[j]; }
#pragma unroll 1
    for (int wu = gw; wu < NU; wu += NGW) {
        const int h = wu / (T / 64), t = (wu % (T / 64)) * 64 + c.lane;
        const v4u* sc = (const v4u*)(Sc + (size_t)t * 2048 + h * 256);
        const int wn = wu + NGW < NU ? wu + NGW : wu;
        const v4u* scn = (const v4u*)(Sc + (size_t)((wn % (T / 64)) * 64 + c.lane) * 2048 + (wn / (T / 64)) * 256);
        int Lw[16], La[16];
#pragma unroll
        for (int i = 0; i < 16; ++i) { Lw[i] = (int)0x80000000; La[i] = 0; }
#pragma unroll 1
        for (int it = 0; it < 4; ++it) {
#pragma unroll
            for (int j = 0; j < 4; ++j) bufB[j] = sc[8 * it + 4 + j];
            tk_feed32(Lw, bufA, 64 * it);
            { const v4u* nx = it < 3 ? sc + 8 * (it + 1) : scn;
#pragma unroll
              for (int j = 0; j < 4; ++j) bufA[j] = nx[j]; }
            tk_feed32(Lw, bufB, 64 * it + 32);
            if (it == 1) {
#pragma unroll
                for (int i = 0; i < 16; ++i) { La[i] = Lw[i]; Lw[i] = (int)0x80000000; } }
        }
        float va[16], vb[16]; unsigned IA0 = 0u, IA1 = 0u, IA2 = 0u, IA3 = 0u, IB0 = 0u, IB1 = 0u, IB2 = 0u, IB3 = 0u;
#pragma unroll
        for (int i = 0; i < 16; ++i) { va[i] = unordi(La[i] & ~127); vb[i] = unordi(Lw[i] & ~127);
            const unsigned ea = (unsigned)(127 - (La[i] & 127)) << ((i & 3) * 8), eb = (unsigned)(127 - (Lw[i] & 127)) << ((i & 3) * 8);
            if ((i >> 2) == 0) { IA0 |= ea; IB0 |= eb; } else if ((i >> 2) == 1) { IA1 |= ea; IB1 |= eb; } else if ((i >> 2) == 2) { IA2 |= ea; IB2 |= eb; } else { IA3 |= ea; IB3 |= eb; } }
        int F[16];
        { int B[16]; TK_CAND0(B); TK_SORT16(B);
#pragma unroll
          for (int i = 0; i < 16; ++i) F[i] = B[i]; }
        { int B[16]; TK_CAND1(B); TK_SORT16(B); tk_merge(F, B); }
        { int B[16]; TK_CAND2(B); TK_SORT16(B); tk_merge(F, B); }
        { int B[16]; TK_CAND3(B); TK_SORT16(B); tk_merge(F, B); }
        float sc_[16], den = 0.f; unsigned ex[16];
        const float mx = unordi(F[0] & ~255);
#pragma unroll
        for (int k = 0; k < 16; ++k) { const int code = 255 - (F[k] & 255); sc_[k] = __builtin_amdgcn_exp2f((unordi(F[k] & ~255) - mx) * LOG2E); den += sc_[k];
            ex[k] = byte_of(IA0, IA1, IA2, IA3, code >> 4) * 128u + byte_of(IB0, IB1, IB2, IB3, code & 15); }
        const float inv = 1.0f / den;
        v4u e0, e1; e0.x = ex[0] | (ex[1] << 16); e0.y = ex[2] | (ex[3] << 16); e0.z = ex[4] | (ex[5] << 16); e0.w = ex[6] | (ex[7] << 16);
        e1.x = ex[8] | (ex[9] << 16); e1.y = ex[10] | (ex[11] << 16); e1.z = ex[12] | (ex[13] << 16); e1.w = ex[14] | (ex[15] << 16);
        v4u* ip = (v4u*)(ids + (size_t)t * 128 + h * 16); ip[0] = e0; ip[1] = e1;
        f32x4* gp = (f32x4*)(gates + (size_t)t * 128 + h * 16);
#pragma unroll
        for (int k = 0; k < 4; ++k) gp[k] = (f32x4){sc_[4 * k] * inv, sc_[4 * k + 1] * inv, sc_[4 * k + 2] * inv, sc_[4 * k + 3] * inv};
    }
}

typedef float f2 __attribute__((ext_vector_type(2)));
constexpr int QCH = 16, QN = T / QCH;
static_assert(T % QCH == 0, "queue chunks");
struct ChunkQ { int xme, s; unsigned pend; unsigned* q; };
struct Chunk { int base, xs; };
DI unsigned cq_ticket(unsigned* qw, int lane) { unsigned v = 0u; if (lane == 0) v = __hip_atomic_fetch_add(qw, 1u, __ATOMIC_RELAXED, __HIP_MEMORY_SCOPE_AGENT); return v; }
DI void cq_init(ChunkQ& g, unsigned* q, int lane) { g.xme = (int)(xb_xcc_id() & 7u); g.s = 0; g.q = q; g.pend = cq_ticket(q + g.xme * 64, lane); }
DI Chunk cq_next(ChunkQ& g, int lane) {
    for (;;) {
        if (g.s >= 8) return Chunk{-1, 0};
        const unsigned chunk = (unsigned)__builtin_amdgcn_readfirstlane((int)g.pend); const int xs = (g.xme + g.s) & 7;
        if (chunk < (unsigned)QN) { g.pend = cq_ticket(g.q + xs * 64, lane); return Chunk{(int)chunk * QCH, xs}; }
        ++g.s; if (g.s < 8) g.pend = cq_ticket(g.q + ((g.xme + g.s) & 7) * 64, lane);
    }
}
struct SliceIds { v4u ia, ib; int t, xs; };
struct SliceAux { v4u a0; float s; };
DI SliceIds slice_load_ids(const int t, const int xs, const int lane, const unsigned short* ids) {
    const int j = lane >> 3, tc = t < 0 ? 0 : t; SliceIds r; r.t = t; r.xs = xs;
    r.ia = *(const v4u*)(ids + (size_t)tc * 128 + 16 * j); r.ib = *(const v4u*)(ids + (size_t)tc * 128 + 16 * j + 8); return r;
}
template <int MODE>
DI SliceAux slice_load_aux(const int t, const int xs, const int lane, const unsigned char* x8, const unsigned char* w8, const float* sw) {
    const int j = lane >> 3, i = lane & 7, tc = t < 0 ? 0 : t; SliceAux r;
    if (MODE == 0) { r.a0 = *(const v4u*)(x8 + (size_t)tc * D + 128 * xs + 16 * i); r.s = 0.f; }
    else { r.a0 = *(const v4u*)(w8 + (size_t)tc * 128 + 16 * j); r.s = sw[tc]; }
    return r;
}
template <int VAR>
DI void slice_issue(v4u (&vr)[16], const SliceIds& n, const unsigned char* T8, const int lane) {
    const unsigned char* sbase = T8 + (size_t)n.xs * NEXP * 128;
    const unsigned lo = 16u * (unsigned)(lane & 7);
    const unsigned idv[8] = {n.ia.x, n.ia.y, n.ia.z, n.ia.w, n.ib.x, n.ib.y, n.ib.z, n.ib.w};
#pragma unroll
    for (int g = 0; g < 16; ++g) { unsigned e = (g & 1) ? (idv[g >> 1] >> 16) : (idv[g >> 1] & 0xffffu); if (VAR == 2) e &= 15u; vr[g] = *(const v4u*)(sbase + (e * 128u + lo)); }
}
DI int dot16_i8(const v4u a, const v4u b, int acc) {
    acc = __builtin_amdgcn_sdot4((int)a.x, (int)b.x, acc, false); acc = __builtin_amdgcn_sdot4((int)a.y, (int)b.y, acc, false);
    acc = __builtin_amdgcn_sdot4((int)a.z, (int)b.z, acc, false); acc = __builtin_amdgcn_sdot4((int)a.w, (int)b.w, acc, false); return acc;
}
DI void tr4_dot(int& c0, int& c1, int& c2, int& c3, const unsigned a, const unsigned b, const unsigned cc, const unsigned d, const int w) {
    const unsigned p = __builtin_amdgcn_perm(b, a, 0x05010400u), q = __builtin_amdgcn_perm(b, a, 0x07030602u), r = __builtin_amdgcn_perm(d, cc, 0x05010400u), s = __builtin_amdgcn_perm(d, cc, 0x07030602u);
    c0 = __builtin_amdgcn_sdot4((int)__builtin_amdgcn_perm(r, p, 0x05040100u), w, c0, false); c1 = __builtin_amdgcn_sdot4((int)__builtin_amdgcn_perm(r, p, 0x07060302u), w, c1, false);
    c2 = __builtin_amdgcn_sdot4((int)__builtin_amdgcn_perm(s, q, 0x05040100u), w, c2, false); c3 = __builtin_amdgcn_sdot4((int)__builtin_amdgcn_perm(s, q, 0x07060302u), w, c3, false);
}
template <int MODE, int VAR>
DI void slice_compute(const int lane, const v4u (&vr)[16], const int t, const int xs, const SliceAux& n, float* OUT) {
    const int j = lane >> 3, i = lane & 7;
    if (VAR == 1) {
        unsigned x = n.a0.x ^ n.a0.y;
#pragma unroll
        for (int g = 0; g < 16; ++g) x ^= vr[g].x ^ vr[g].y ^ vr[g].z ^ vr[g].w;
        *(unsigned*)((bf16*)OUT + (size_t)t * D + 128 * xs + 2 * lane) = x;
    } else if (MODE == 0) {
        int d[16];
#pragma unroll
        for (int g = 0; g < 16; ++g) d[g] = dot16_i8(vr[g], n.a0, 0);
        int r8[8], r4[4], r2[2];
#pragma unroll
        for (int q = 0; q < 8; ++q) { const bool od = lane & 1; const int keep = od ? d[8 + q] : d[q], send = od ? d[q] : d[8 + q]; r8[q] = keep + shx(lane, send, 1); }
#pragma unroll
        for (int q = 0; q < 4; ++q) { const bool od = lane & 2; const int keep = od ? r8[4 + q] : r8[q], send = od ? r8[q] : r8[4 + q]; r4[q] = keep + shx(lane, send, 2); }
#pragma unroll
        for (int q = 0; q < 2; ++q) { const bool od = lane & 4; const int keep = od ? r4[2 + q] : r4[q], send = od ? r4[q] : r4[2 + q]; r2[q] = keep + shx(lane, send, 4); }
        const int g0 = 8 * (i & 1) + 4 * ((i >> 1) & 1) + 2 * (i >> 2);
        *((unsigned*)OUT + ((size_t)xs * T + t) * 64 + 8 * j + (g0 >> 1)) = ((unsigned)((r2[0] + 32) >> 6) & 0xffffu) | ((unsigned)((r2[1] + 32) >> 6) << 16);
    } else {
        int acc[16];
#pragma unroll
        for (int q = 0; q < 16; ++q) acc[q] = 0;
        const int w4[4] = {(int)n.a0.x, (int)n.a0.y, (int)n.a0.z, (int)n.a0.w};
#pragma unroll
        for (int gq = 0; gq < 4; ++gq) {
            tr4_dot(acc[0], acc[1], acc[2], acc[3], vr[4 * gq].x, vr[4 * gq + 1].x, vr[4 * gq + 2].x, vr[4 * gq + 3].x, w4[gq]);
            tr4_dot(acc[4], acc[5], acc[6], acc[7], vr[4 * gq].y, vr[4 * gq + 1].y, vr[4 * gq + 2].y, vr[4 * gq + 3].y, w4[gq]);
            tr4_dot(acc[8], acc[9], acc[10], acc[11], vr[4 * gq].z, vr[4 * gq + 1].z, vr[4 * gq + 2].z, vr[4 * gq + 3].z, w4[gq]);
            tr4_dot(acc[12], acc[13], acc[14], acc[15], vr[4 * gq].w, vr[4 * gq + 1].w, vr[4 * gq + 2].w, vr[4 * gq + 3].w, w4[gq]);
        }
        int r8[8], r4[4], r2[2];
#pragma unroll
        for (int q = 0; q < 8; ++q) { const bool od = lane & 8; const int keep = od ? acc[8 + q] : acc[q], send = od ? acc[q] : acc[8 + q]; r8[q] = keep + shx(lane, send, 8); }
#pragma unroll
        for (int q = 0; q < 4; ++q) { const bool od = lane & 16; const int keep = od ? r8[4 + q] : r8[q], send = od ? r8[q] : r8[4 + q]; r4[q] = keep + shx(lane, send, 16); }
#pragma unroll
        for (int q = 0; q < 2; ++q) { const bool od = lane & 32; const int keep = od ? r4[2 + q] : r4[q], send = od ? r4[q] : r4[2 + q]; r2[q] = keep + shx(lane, send, 32); }
        const int dim = 128 * xs + 16 * i + 8 * (j & 1) + 4 * ((j >> 1) & 1) + 2 * (j >> 2);
        const float s = n.s;
        *(unsigned*)((bf16*)OUT + (size_t)t * D + dim) = pk2((float)r2[0] * s, (float)r2[1] * s);
    }
}
template <int MODE, int VAR = 0>
DI void slice_pass(const Ctx c, const unsigned char* x8, const unsigned short* ids, const unsigned char* w8, const float* sw, const unsigned char* T8, float* OUT, unsigned* q) {
    ChunkQ g; cq_init(g, q, c.lane);
    Chunk cur = cq_next(g, c.lane); if (cur.base < 0) return;
    Chunk nxt = cq_next(g, c.lane);
#define SLICE_TOK_T(p) ((p) < QCH ? cur.base + (p) : (nxt.base >= 0 ? nxt.base + (p) - QCH : -1))
#define SLICE_TOK_X(p) ((p) < QCH ? cur.xs : nxt.xs)
    SliceIds i0 = slice_load_ids(SLICE_TOK_T(0), SLICE_TOK_X(0), c.lane, ids), i1 = slice_load_ids(SLICE_TOK_T(1), SLICE_TOK_X(1), c.lane, ids),
             i2 = slice_load_ids(SLICE_TOK_T(2), SLICE_TOK_X(2), c.lane, ids), i3 = slice_load_ids(SLICE_TOK_T(3), SLICE_TOK_X(3), c.lane, ids);
    SliceAux x0 = slice_load_aux<MODE>(i0.t, i0.xs, c.lane, x8, w8, sw), x1 = slice_load_aux<MODE>(i1.t, i1.xs, c.lane, x8, w8, sw);
    v4u A[16], B[16];
    slice_issue<VAR>(A, i0, T8, c.lane);
#define SLICE_STEP(K, CUR, NXT, IK, IK1, XK) do { slice_issue<VAR>(NXT, IK1, T8, c.lane); \
        const int ct_ = IK.t, cx_ = IK.xs; const SliceAux cxk_ = XK; \
        XK = slice_load_aux<MODE>(SLICE_TOK_T(pg + (K) + 2), SLICE_TOK_X(pg + (K) + 2), c.lane, x8, w8, sw); \
        IK = slice_load_ids(SLICE_TOK_T(pg + (K) + 4), SLICE_TOK_X(pg + (K) + 4), c.lane, ids); \
        slice_compute<MODE, VAR>(c.lane, CUR, ct_, cx_, cxk_, OUT); } while (0)
    for (;;) {
#pragma unroll 2
        for (int pg = 0; pg < QCH; pg += 4) {
            SLICE_STEP(0, A, B, i0, i1, x0);
            SLICE_STEP(1, B, A, i1, i2, x1);
            SLICE_STEP(2, A, B, i2, i3, x0);
            SLICE_STEP(3, B, A, i3, i0, x1);
        }
        cur = nxt; if (cur.base < 0) break;
        nxt = cq_next(g, c.lane);
    }
#undef SLICE_STEP
#undef SLICE_TOK_T
#undef SLICE_TOK_X
}
struct WpA { f32x4 s; v2u iw; f32x4 g; float st; };
struct WpB { f32x4 su, sv; };
DI WpA wp_load_a(const size_t idx, const float* part, const unsigned short* ids, const float* gates, const float* sx) {
    WpA a; v2u p[8];
#pragma unroll
    for (int x = 0; x < 8; ++x) p[x] = *(const v2u*)((const unsigned short*)part + (size_t)x * T * 128 + idx * 4);
    a.iw = *(const v2u*)(ids + idx * 4); a.g = *(const f32x4*)(gates + idx * 4); a.st = sx[idx >> 5] * 64.0f;
    int s0 = 0, s1 = 0, s2 = 0, s3 = 0;
#pragma unroll
    for (int x = 0; x < 8; ++x) { s0 += (int)(short)(p[x].x & 0xffffu); s1 += (int)p[x].x >> 16; s2 += (int)(short)(p[x].y & 0xffffu); s3 += (int)p[x].y >> 16; }
    a.s = (f32x4){(float)s0, (float)s1, (float)s2, (float)s3}; return a;
}
DI WpB wp_load_b(const WpA& a, const float* SU, const float* SV) {
    const unsigned e[4] = {a.iw.x & 0xffffu, a.iw.x >> 16, a.iw.y & 0xffffu, a.iw.y >> 16}; WpB b;
#pragma unroll
    for (int k = 0; k < 4; ++k) { const f2 p = *(const f2*)(SU + 2 * e[k]); b.su[k] = p.x; b.sv[k] = p.y; }
    (void)SV;
    return b;
}
DI void peer_w_phase(const Ctx c, const float* part, const unsigned short* ids, const float* gates, unsigned char* w8, float* sw, const float* sx, const float* SU, const float* SV) {
    const size_t NT = (size_t)c.G * 512, NI = (size_t)T * 32, i0 = (size_t)c.vcu * 512 + c.tid;
    WpA a0 = wp_load_a(i0 < NI ? i0 : 0, part, ids, gates, sx), a1 = wp_load_a(i0 + NT < NI ? i0 + NT : 0, part, ids, gates, sx);
    WpB b0 = wp_load_b(a0, SU, SV);
    for (size_t idx = i0; idx < NI; idx += NT) {
        const WpA a2 = wp_load_a(idx + 2 * NT < NI ? idx + 2 * NT : 0, part, ids, gates, sx);
        const WpB b1 = wp_load_b(a1, SU, SV);
        f32x4 g = a0.g; float am = 0.f;
#pragma unroll
        for (int k = 0; k < 4; ++k) { g[k] = g[k] * gelu_erf(a0.s[k] * (a0.st * b0.su[k])) * b0.sv[k]; am = __builtin_fmaxf(am, __builtin_fabsf(g[k])); }
#pragma unroll
        for (int o = 1; o < 32; o <<= 1) am = __builtin_fmaxf(am, shx(c.lane, am, o));
        *(unsigned*)(w8 + idx * 4) = q4_i8(g, am > 0.f ? 127.0f / am : 0.f);
        if ((c.tid & 31) == 0) sw[idx >> 5] = am * (1.0f / 127.0f);
        a0 = a1; a1 = a2; b0 = b1;
    }
}

DI int pi_row(int m) { return 16 * (m >> 4) + 8 * ((m >> 2) & 1) + 4 * ((m >> 3) & 1) + (m & 3); }
struct AttnT { const bf16* Q; bf16* O; const bf16* Kb; const bf16* VT; const bf16* Vsn; const float* ck; const float* cv; };
template <int MODE>
DI void attn_load(const AttnT A, const int b, const int h, const int kt, const int q, const int hh, const int piq, bf16x8 (&kf)[4], bf16x8 (&vf)[2][2]) {
    if (MODE == 0) {
        const bf16* kr = A.Kb + ((size_t)b * SEQ + kt * 32 + piq) * D + h * DH + 8 * hh;
#pragma unroll
        for (int s = 0; s < 4; ++s) kf[s] = *(const bf16x8*)(kr + 16 * s);
        const bf16* vr = A.VT + (((size_t)b * NH + h) * (SEQ / 32) + kt) * (DH * 32) + q * 32 + 8 * hh;
#pragma unroll
        for (int mt = 0; mt < 2; ++mt)
#pragma unroll
            for (int s = 0; s < 2; ++s) vf[mt][s] = *(const bf16x8*)(vr + mt * 32 * 32 + 16 * s);
    } else if (kt == PAST / 32) {
        const int ko = piq < 16 ? piq : 15;
        const bf16* kr = A.Kb + ((size_t)TP + b * DSEQ + ko) * D + h * DH + 8 * hh;
#pragma unroll
        for (int s = 0; s < 4; ++s) kf[s] = *(const bf16x8*)(kr + 16 * s);
#pragma unroll
        for (int mt = 0; mt < 2; ++mt)
#pragma unroll
            for (int s = 0; s < 2; ++s) { bf16x8 v;
#pragma unroll
                for (int j = 0; j < 8; ++j) { const int kk = 16 * s + 8 * hh + j; v[j] = (short)A.Vsn[((size_t)b * DSEQ + (kk < 16 ? kk : 15)) * D + h * DH + 32 * mt + q]; }
                vf[mt][s] = v; }
    } else {
        const float* kr = A.ck + (((size_t)b * PAST + kt * 32 + piq) * NH + h) * DH + 8 * hh;
#pragma unroll
        for (int s = 0; s < 4; ++s) { const f32x4 x0 = *(const f32x4*)(kr + 16 * s), x1 = *(const f32x4*)(kr + 16 * s + 4); kf[s] = pack8(x0[0], x0[1], x0[2], x0[3], x1[0], x1[1], x1[2], x1[3]); }
#pragma unroll
        for (int mt = 0; mt < 2; ++mt)
#pragma unroll
            for (int s = 0; s < 2; ++s) { float x[8];
#pragma unroll
                for (int j = 0; j < 8; ++j) x[j] = A.cv[(((size_t)b * PAST + kt * 32 + 16 * s + 8 * hh + j) * NH + h) * DH + 32 * mt + q];
                vf[mt][s] = pack8(x[0], x[1], x[2], x[3], x[4], x[5], x[6], x[7]); }
    }
}
template <int MODE>
DI void attn_qtile(const AttnT A, int b, int h, int qi, int lane, const bf16x8 (&ut)[2]) {
    const int q = lane & 31, hh = lane >> 5, piq = pi_row(q);
    const size_t qrow = MODE == 0 ? (size_t)b * SEQ + qi * 32 + q : (size_t)TP + b * DSEQ + (q < 16 ? q : 15);
    const int qpos = MODE == 0 ? qi * 32 + q : (q < 16 ? PAST + q : 0);
    bf16x8 qf[4];
#pragma unroll
    for (int s = 0; s < 4; ++s) qf[s] = *(const bf16x8*)(A.Q + qrow * D + h * DH + 16 * s + 8 * hh);
    f32x16 o0, o1;
#pragma unroll
    for (int i = 0; i < 16; ++i) { o0[i] = 0.f; o1[i] = 0.f; }
    float carry = 0.f;
    const int kt0 = MODE == 0 ? qi : PAST / 32;
    bf16x8 kf[4], vf[2][2];
    attn_load<MODE>(A, b, h, kt0, q, hh, piq, kf, vf);
    for (int kt = kt0; kt >= 0; --kt) {
        bf16x8 kn[4], vn[2][2];
        attn_load<MODE>(A, b, h, kt > 0 ? kt - 1 : 0, q, hh, piq, kn, vn);
        f32x16 S;
#pragma unroll
        for (int i = 0; i < 16; ++i) S[i] = 0.f;
#pragma unroll
        for (int s = 0; s < 4; ++s) S = MFMA32(kf[s], qf[s], S);
        const int kbase = kt * 32 + 8 * hh;
        float L[16], lw[16];
#pragma unroll
        for (int r = 0; r < 16; ++r) {
            const bool valid = (kbase + 16 * (r >> 3) + (r & 7)) < qpos;
            const float z = S[r], sp = __builtin_fmaxf(z, 0.f) + __builtin_amdgcn_logf(1.0f + __builtin_amdgcn_exp2f(-__builtin_fabsf(z)));
            L[r] = valid ? -sp : 0.f; lw[r] = valid ? (z - sp) : -1e30f;
        }
        f32x16 suf;
#pragma unroll
        for (int i = 0; i < 16; ++i) suf[i] = 0.f;
        suf = MFMA32(ut[0], pack8(L[0], L[1], L[2], L[3], L[4], L[5], L[6], L[7]), suf);
        suf = MFMA32(ut[1], pack8(L[8], L[9], L[10], L[11], L[12], L[13], L[14], L[15]), suf);
        float a[16];
#pragma unroll
        for (int r = 0; r < 16; ++r) a[r] = __builtin_amdgcn_exp2f(lw[r] + suf[r] + carry);
        carry += __int_as_float(__builtin_amdgcn_ds_bpermute(q << 2, __float_as_int(suf[0] + L[0])));
        const bf16x8 p0 = pack8(a[0], a[1], a[2], a[3], a[4], a[5], a[6], a[7]), p1 = pack8(a[8], a[9], a[10], a[11], a[12], a[13], a[14], a[15]);
        o0 = MFMA32(vf[0][0], p0, o0); o0 = MFMA32(vf[0][1], p1, o0);
        o1 = MFMA32(vf[1][0], p0, o1); o1 = MFMA32(vf[1][1], p1, o1);
        if (__builtin_amdgcn_ballot_w64(qpos > 0 && carry > -24.0f * LOG2E) == 0ull) break;
#pragma unroll
        for (int s = 0; s < 4; ++s) kf[s] = kn[s];
#pragma unroll
        for (int mt = 0; mt < 2; ++mt)
#pragma unroll
            for (int s = 0; s < 2; ++s) vf[mt][s] = vn[mt][s];
    }
    if (MODE == 0 || q < 16) {
        bf16* orow = A.O + qrow * D + h * DH + 4 * hh;
#pragma unroll
        for (int g = 0; g < 4; ++g) {
            v2u w0, w1; w0.x = pk2(o0[4 * g], o0[4 * g + 1]); w0.y = pk2(o0[4 * g + 2], o0[4 * g + 3]); w1.x = pk2(o1[4 * g], o1[4 * g + 1]); w1.y = pk2(o1[4 * g + 2], o1[4 * g + 3]);
            *(v2u*)(orow + 8 * g) = w0; *(v2u*)(orow + 32 + 8 * g) = w1; }
    }
}
DI void attn_phase(const Ctx c, const AttnT A) {
    const int q = c.lane & 31, hh = c.lane >> 5, piq = pi_row(q);
    bf16x8 ut[2];
#pragma unroll
    for (int s = 0; s < 2; ++s)
#pragma unroll
        for (int j = 0; j < 8; ++j) ut[s][j] = (16 * s + 8 * hh + j > piq) ? (short)0x3f80 : (short)0;
    for (int bu = c.vcu; bu < NB * NH * 4; bu += c.G) {
        const int bh = bu >> 2, b = bh >> 4, h = bh & 15, p = (bu & 3) * 8 + c.wave;
        attn_qtile<0>(A, b, h, 63 - p, c.lane, ut);
        attn_qtile<0>(A, b, h, p, c.lane, ut);
    }
    for (int su = c.wave * c.G + c.vcu; su < NB * NH; su += c.G * 8) attn_qtile<1>(A, su >> 4, su & 15, 0, c.lane, ut);
}

DI void vt_phase(const Ctx c, LAS unsigned char* lds, const bf16* Vb, bf16* VT, bf16* Vsn) {
    LAS unsigned char* scr = lds + c.wave * 16384;
    const int gw = c.vcu * 8 + c.wave, NGW = c.G * 8;
    for (int wt = gw; wt < (TP / 64) * 16; wt += NGW) {
        const int tt = wt >> 4, ht = wt & 15;
        v4u vin[8];
#pragma unroll
        for (int j = 0; j < 8; ++j) vin[j] = *(const v4u*)(Vb + (size_t)(tt * 64 + (c.lane >> 3) + 8 * j) * D + ht * 64 + (c.lane & 7) * 8);
        __builtin_amdgcn_sched_barrier(0);
#pragma unroll
        for (int j = 0; j < 8; ++j) { const int row = (c.lane >> 3) + 8 * j, ch = c.lane & 7;
            LAS unsigned* d = (LAS unsigned*)(scr + row * 132 + ch * 16); d[0] = vin[j].x; d[1] = vin[j].y; d[2] = vin[j].z; d[3] = vin[j].w; }
        LDS_WAIT(); asm volatile("" ::: "memory");
#pragma unroll
        for (int j = 0; j < 8; ++j) { const int orow = (c.lane >> 3) + 8 * j, ch = c.lane & 7;
            unsigned short e[8];
#pragma unroll
            for (int i = 0; i < 8; ++i) e[i] = *(const LAS unsigned short*)(scr + (ch * 8 + i) * 132 + orow * 2);
            v4u o; o.x = e[0] | ((unsigned)e[1] << 16); o.y = e[2] | ((unsigned)e[3] << 16); o.z = e[4] | ((unsigned)e[5] << 16); o.w = e[6] | ((unsigned)e[7] << 16);
            { const int bb = tt >> 5, kt = 2 * (tt & 31) + (ch >> 2);
              *(v4u*)(VT + (((size_t)bb * NH + ht) * (SEQ / 32) + kt) * (DH * 32) + orow * 32 + 8 * (ch & 3)) = o; } }
        LDS_WAIT(); asm volatile("" ::: "memory");
    }
    const size_t NT = (size_t)c.G * 512;
    for (size_t i = (size_t)c.vcu * 512 + c.tid; i < (size_t)TS * D / 8; i += NT) *(v4u*)(Vsn + i * 8) = *(const v4u*)(Vb + (size_t)TP * D + i * 8);
}

DI f32x16 sg_tile(const bf16* wr  , const bf16* xr  ) {
    f32x16 acc;
#pragma unroll
    for (int i = 0; i < 16; ++i) acc[i] = 0.f;
    bf16x8 wa[8], xa[8], wb[8], xb[8];
#pragma unroll
    for (int j = 0; j < 8; ++j) { wa[j] = *(const bf16x8*)(wr + 16 * j); xa[j] = *(const bf16x8*)(xr + 16 * j); }
#pragma unroll 1
    for (int k0 = 0; k0 < 64; k0 += 16) {
#pragma unroll
        for (int j = 0; j < 8; ++j) { wb[j] = *(const bf16x8*)(wr + 16 * (k0 + 8 + j)); xb[j] = *(const bf16x8*)(xr + 16 * (k0 + 8 + j)); }
        __builtin_amdgcn_sched_barrier(0);
#pragma unroll
        for (int j = 0; j < 8; ++j) acc = MFMA32(wa[j], xa[j], acc);
        __builtin_amdgcn_sched_barrier(0);
        { const int kn = k0 + 16 < 64 ? k0 + 16 : 0;
#pragma unroll
          for (int j = 0; j < 8; ++j) { wa[j] = *(const bf16x8*)(wr + 16 * (kn + j)); xa[j] = *(const bf16x8*)(xr + 16 * (kn + j)); } }
        __builtin_amdgcn_sched_barrier(0);
#pragma unroll
        for (int j = 0; j < 8; ++j) acc = MFMA32(wb[j], xb[j], acc);
        __builtin_amdgcn_sched_barrier(0);
    }
    return acc;
}
DI void sg_gate(const Ctx c, const bf16* Hall  , const bf16* Wl  , bf16* U, bf16* Bg, float* convp  ) {
    const int q = c.lane & 31, hh = c.lane >> 5;
    for (int tile = c.wave * c.G + c.vcu; tile < 18 * 32; tile += c.G * 8) {
        const int tt = tile % 18, dt = tile / 18, d = 32 * dt + q, crow = 256 * (d >> 7) + (d & 127);
        const bool cs = tt >= 16; const int kk = (tt - 16) * 32 + q;
        const size_t row = cs ? (size_t)(kk >> 1) * SEQ + (SEQ - 2) + (kk & 1) : (size_t)TP + tt * 32 + q;
        const bf16* xr = Hall + row * D + 8 * hh;
        const bf16* wc = Wl + (size_t)crow * D + 8 * hh; const bf16* wx = wc + (size_t)128 * D; const bf16* wb = Wl + (size_t)(2048 + d) * D + 8 * hh;
        f32x16 ac, ax, ab;
#pragma unroll
        for (int i = 0; i < 16; ++i) { ac[i] = 0.f; ax[i] = 0.f; ab[i] = 0.f; }
        { bf16x8 fx[4], fc[4], fxx[4], fb[4], gx[4], gc[4], gxx[4], gb[4];
#pragma unroll
          for (int j = 0; j < 4; ++j) { fx[j] = *(const bf16x8*)(xr + 16 * j); fc[j] = *(const bf16x8*)(wc + 16 * j); fxx[j] = *(const bf16x8*)(wx + 16 * j); fb[j] = *(const bf16x8*)(wb + 16 * j); }
#pragma unroll 1
          for (int k0 = 0; k0 < 64; k0 += 8) {
#pragma unroll
              for (int j = 0; j < 4; ++j) { gx[j] = *(const bf16x8*)(xr + 16 * (k0 + 4 + j)); gc[j] = *(const bf16x8*)(wc + 16 * (k0 + 4 + j)); gxx[j] = *(const bf16x8*)(wx + 16 * (k0 + 4 + j)); gb[j] = *(const bf16x8*)(wb + 16 * (k0 + 4 + j)); }
              __builtin_amdgcn_sched_barrier(0);
#pragma unroll
              for (int j = 0; j < 4; ++j) { ac = MFMA32(fc[j], fx[j], ac); ax = MFMA32(fxx[j], fx[j], ax); ab = MFMA32(fb[j], fx[j], ab); }
              __builtin_amdgcn_sched_barrier(0);
              { const int kn = k0 + 8 < 64 ? k0 + 8 : 0;
#pragma unroll
                for (int j = 0; j < 4; ++j) { fx[j] = *(const bf16x8*)(xr + 16 * (kn + j)); fc[j] = *(const bf16x8*)(wc + 16 * (kn + j)); fxx[j] = *(const bf16x8*)(wx + 16 * (kn + j)); fb[j] = *(const bf16x8*)(wb + 16 * (kn + j)); } }
              __builtin_amdgcn_sched_barrier(0);
#pragma unroll
              for (int j = 0; j < 4; ++j) { ac = MFMA32(gc[j], gx[j], ac); ax = MFMA32(gxx[j], gx[j], ax); ab = MFMA32(gb[j], gx[j], ab); }
              __builtin_amdgcn_sched_barrier(0);
          } }
        if (cs) {
            float* cd = convp + (size_t)kk * D + 32 * dt + 4 * hh;
#pragma unroll
            for (int g = 0; g < 4; ++g) *(f32x4*)(cd + 8 * g) = (f32x4){ac[4 * g] * ax[4 * g], ac[4 * g + 1] * ax[4 * g + 1], ac[4 * g + 2] * ax[4 * g + 2], ac[4 * g + 3] * ax[4 * g + 3]};
        } else {
            const size_t ro = row * D + 32 * dt + 4 * hh;
#pragma unroll
            for (int g = 0; g < 4; ++g) { v2u wu, wb2; wu.x = pk2(ac[4 * g] * ax[4 * g], ac[4 * g + 1] * ax[4 * g + 1]); wu.y = pk2(ac[4 * g + 2] * ax[4 * g + 2], ac[4 * g + 3] * ax[4 * g + 3]);
                wb2.x = pk2(ab[4 * g], ab[4 * g + 1]); wb2.y = pk2(ab[4 * g + 2], ab[4 * g + 3]);
                *(v2u*)(U + ro + 8 * g) = wu; *(v2u*)(Bg + ro + 8 * g) = wb2; }
        }
    }
}
template <int MODE>
DI void sg_plain(const Ctx c, const bf16* Xs, const bf16* Wt, const int N, bf16* O, const bf16* Hres, bf16* O2, float* f0, float* f1) {
    const int q = c.lane & 31, hh = c.lane >> 5;
    for (int tile = c.wave * c.G + c.vcu; tile < 16 * (N / 32); tile += c.G * 8) {
        const int tt = tile & 15, ft = tile >> 4;
        const f32x16 acc = sg_tile(Wt + (size_t)(ft * 32 + q) * D + 8 * hh, Xs + (size_t)(tt * 32 + q) * D + 8 * hh);
        const int tl = tt * 32 + q;
#pragma unroll
        for (int g = 0; g < 4; ++g) { const int f = 32 * ft + 8 * g + 4 * hh; const f32x4 v = {acc[4 * g], acc[4 * g + 1], acc[4 * g + 2], acc[4 * g + 3]};
            if (MODE == 0) { v2u w; w.x = pk2(v[0], v[1]); w.y = pk2(v[2], v[3]); *(v2u*)(O + (size_t)(TP + tl) * D + f) = w; }
            else if (MODE == 1) { const v2u hw = *(const v2u*)(Hres + (size_t)(TP + tl) * D + f); const f32x4 r = (f32x4){bflo(hw.x), bfhi(hw.x), bflo(hw.y), bfhi(hw.y)} * ALPHA + v;
                v2u w; w.x = pk2(r[0], r[1]); w.y = pk2(r[2], r[3]); *(v2u*)(O + (size_t)(TP + tl) * D + f) = w; }
            else if (MODE == 2) { const bool isv = f >= 1024; const int fc = isv ? f - 1024 : f; v2u w; w.x = pk2(v[0], v[1]); w.y = pk2(v[2], v[3]);
                *(v2u*)((isv ? O2 : O) + (size_t)(TP + tl) * D + fc) = w; *(f32x4*)((isv ? f1 : f0) + (size_t)tl * D + fc) = v; }
            else { v2u w; w.x = pk2(v[0], v[1]); w.y = pk2(v[2], v[3]); *(v2u*)(O + (size_t)(TP + tl) * 2048 + f) = w; }
        }
    }
}

struct Args { const float* in[18]; float* out; unsigned char* ws; int ph_lo, ph_hi, li, pad; };
constexpr int N_PHASES = 2 + 2 * 10 + 12 + 10;
__global__ void __launch_bounds__(512, 2) fwd(Args args) {
    extern __shared__ __attribute__((aligned(16))) unsigned char lds_raw[];
    LAS unsigned char* lds = (LAS unsigned char*)lds_raw;
    Ctx c0; c0.tid = threadIdx.x; c0.lane = 0; c0.wave = __builtin_amdgcn_readfirstlane(c0.tid >> 6); c0.G = gridDim.x;
    { const int bx = blockIdx.x; c0.vcu = (c0.G % 8 == 0) ? (bx % 8) * (c0.G / 8) + bx / 8 : bx; }
    volatile LAS unsigned* MISC = (volatile LAS unsigned*)(lds + MISC_OFF);
    for (int u = c0.tid; u < (LDS_BYTES - RING_BYTES) / 4; u += 512) ((LAS unsigned*)(lds + RING_BYTES))[u] = 0u;
    __syncthreads();
    unsigned char* ws = args.ws; float* out = args.out;
    XcdBarrier bar = xcd_barrier_post((unsigned*)(ws + WS_CTL) + CW_BAR + args.li * XCD_BAR_WORDS, MISC + 8, c0.wave == 0 ? 1u : 0u);
#define WinT ((bf16*)(wsl + WS_WIN))
#define WoutT ((bf16*)(wsl + WS_WOUT))
#define WqT ((bf16*)(wsl + WS_WQ))
#define WoT ((bf16*)(wsl + WS_WO))
#define WkvT ((bf16*)(wsl + WS_WKV))
#define WP ((bf16*)(wsl + WS_WP))
#define W8A (wsl + WS_W8A)
#define SWA ((float*)(wsl + WS_SWA))
#define W8R(off) ((int)(((off) - WS_WIN) / 2048))
#define Vsn ((bf16*)(wsl + WS_VSN))
#define H ((bf16*)(wsl + WS_H))
#define Kb ((bf16*)(wsl + WS_KB))
#define VT ((bf16*)(wsl + WS_VT))
#define ids ((unsigned short*)(wsl + WS_IDS))
#define gates ((float*)(wsl + WS_GATE))
#define W8 (wsl + WS_W8)
#define SX ((float*)(wsl + WS_SX))
#define SW (SX + T)
#define X8 (wsl + WS_X8)
#define TU (wsl + WS_TU)
#define TV (wsl + WS_TV)
#define SU ((float*)(wsl + WS_SU))
#define SV (SU + 1)
#define A0 ((bf16*)(wsl + WS_A))
#define A1 ((bf16*)(wsl + WS_A + 129 * MiB))
#define ScT ((float*)(wsl + WS_A))
#define R A0
    const float* ln_g = args.in[16]; const float* ln_b = args.in[17];
    const int lo = args.ph_lo, hi = args.ph_hi; int ph = 0;
#ifndef PROBE_REPEAT
#define PROBE_REPEAT 0
#endif
#define PHASE_R(bit, body) do { const int nrep = 1 + ((PROBE_REPEAT >> (bit)) & 1); for (int rep = 0; rep < nrep; ++rep) { if (ph >= lo && ph < hi) { Ctx c = c0; c.lane = xb_lane_id(); c.tid = c0.wave * 64 + c.lane; unsigned long long wsi_ = (unsigned long long)ws; asm volatile("" : "+s"(wsi_)); unsigned char* wsl = (unsigned char*)(GAS unsigned char*)wsi_; body; if (ph + 1 < hi) { xcd_barrier(bar); if ((PROBE_REPEAT >> 20) & 1) xcd_barrier(bar); } } ++ph; } } while (0)
#define PHASE(body) PHASE_R(31, body)

    PHASE_R(4, ({ P0Args a{args.in[0], args.in[1], args.in[5], args.in[7], args.in[8], args.in[9], args.in[10], args.in[11], args.in[12], args.in[13], args.in[14], args.in[15],
                      WinT, WoutT, WqT, WoT, WkvT, WP, H, TU, TV, SU, SV, X8, SX}; p0_prologue(c, lds, a); }));

    PHASE(({ wp_quant_phase(c, WinT, W8A, SWA); }));

#pragma unroll 1
    for (int l = 0; l < NLAYER; ++l) {
        if (l < 2) {
            PHASE_R(8, ({ pg8::Gemm g{(const bf16*)X8, (const bf16*)(W8A + ((size_t)W8R(WS_WIN) + (size_t)l * 3072) * 1024), TP, 3072, 512}; pg8::StaticOrder S; S.init(TP, 3072, c.G, (int)blockIdx.x);
                     pg8::EpiGate<true> E{A0, A1, SX, SWA + W8R(WS_WIN) + l * 3072};
                     pg8::gemm_phase<pg8::EpiGate<true>, pg8::StaticOrder, true, true, true>(lds, g, S, E, c.tid);
                     sg_gate(c, H, WinT + (size_t)l * 3072 * 1024, A0, A1, out + O_CONVP + (size_t)l * NB * 2 * D); }));
            PHASE_R(13, ({ conv_gate_phase(c, A0, A1, args.in[6] + (size_t)l * 3 * D, args.in[2] + (size_t)l * NB * 2 * D, out + O_CONVP + (size_t)l * NB * 2 * D, out + O_CONVS + (size_t)l * NB * 2 * D, X8, SX, rep > 0); }));
        } else {
            if (l == 2) {
                PHASE_R(10, ({ pg8::Gemm g{(const bf16*)X8, (const bf16*)(W8A + (size_t)W8R(WS_WKV) * 1024), TP, 2048, 512}; pg8::StaticOrder S; S.init(TP, 2048, c.G, (int)blockIdx.x);
                         pg8::EpiKV<true> E{Kb, A1, out + O_KP, out + O_VP, out + O_KS, out + O_VS, SX, SWA + W8R(WS_WKV)};
                         pg8::gemm_phase<pg8::EpiKV<true>, pg8::StaticOrder, true, true, true>(lds, g, S, E, c.tid);
                         sg_plain<2>(c, H + (size_t)TP * D, WkvT, 2048, Kb, nullptr, A1, out + O_KS, out + O_VS); }));
                PHASE_R(14, ({ vt_phase(c, lds, A1, VT, Vsn); }));
            }
            PHASE_R(9, ({ pg8::Gemm g{(const bf16*)X8, (const bf16*)(W8A + ((size_t)W8R(WS_WQ) + (size_t)(l - 2) * 1024) * 1024), TP, 1024, 512}; pg8::StaticOrder S; S.init(TP, 1024, c.G, (int)blockIdx.x);
                     pg8::EpiBf16P<true> E{A0, 1024, SX, SWA + W8R(WS_WQ) + (l - 2) * 1024};
                     pg8::gemm_phase<pg8::EpiBf16P<true>, pg8::StaticOrder, true, true, true>(lds, g, S, E, c.tid);
                     sg_plain<0>(c, H + (size_t)TP * D, WqT + (size_t)(l - 2) * 1024 * 1024, 1024, A0, nullptr, nullptr, nullptr, nullptr); }));
            PHASE_R(11, ({ AttnT A{A0, A1, Kb, VT, Vsn, args.in[3], args.in[4]}; attn_phase(c, A); }));
        }
        if (l < 2) {
            PHASE_R(7, ({ pg8::Gemm g{(const bf16*)X8, (const bf16*)(W8A + ((size_t)W8R(WS_WOUT) + (size_t)l * 1024) * 1024), TP, 1024, 512}; pg8::StaticOrder S; S.init(TP, 1024, c.G, (int)blockIdx.x);
                     pg8::EpiRes<true> E{H, R, ALPHA, SX, SWA + W8R(WS_WOUT) + l * 1024};
                     pg8::gemm_phase<pg8::EpiRes<true>, pg8::StaticOrder, true, true, true>(lds, g, S, E, c.tid);
                     sg_plain<1>(c, A1 + (size_t)TP * D, WoutT + (size_t)l * 1024 * 1024, 1024, R, H, nullptr, nullptr, nullptr); }));
        } else {
            PHASE_R(7, ({ pg8::Gemm g{A1, WoT + (size_t)(l - 2) * 1024 * 1024, TP, 1024, 1024}; pg8::StaticOrder S; S.init(TP, 1024, c.G, (int)blockIdx.x);
                     pg8::EpiRes<false> E{H, R, ALPHA, nullptr, nullptr};
                     pg8::gemm_phase<pg8::EpiRes<false>, pg8::StaticOrder, true, true>(lds, g, S, E, c.tid);
                     sg_plain<1>(c, A1 + (size_t)TP * D, WoT + (size_t)(l - 2) * 1024 * 1024, 1024, R, H, nullptr, nullptr, nullptr); }));
        }
        PHASE_R(5, ({ ln_phase(c, R, H, ln_g + (size_t)(l * 2) * D, ln_b + (size_t)(l * 2) * D, nullptr, nullptr, X8, SX); }));
        PHASE_R(6, ({ pg8::Gemm g{(const bf16*)X8, (const bf16*)(W8A + ((size_t)W8R(WS_WP) + (size_t)l * 2048) * 1024), TP, 2048, 512}; pg8::StaticOrder S; S.init(TP, 2048, c.G, (int)blockIdx.x);
                 pg8::EpiScoreI8 E{(bf16*)ScT, 2048, SX, SWA + W8R(WS_WP) + l * 2048};
                 pg8::gemm_phase<pg8::EpiScoreI8, pg8::StaticOrder, true, true, true>(lds, g, S, E, c.tid);
                 sg_plain<3>(c, H + (size_t)TP * D, WP + (size_t)l * 2048 * 1024, 2048, (bf16*)ScT, nullptr, nullptr, nullptr, nullptr); }));
        PHASE_R(3, ({ topk_phase(c, (const bf16*)ScT, ids, gates); }));
        PHASE_R(0, ({ slice_pass<0>(c, X8, ids, W8, SW, TU + (size_t)l * NEXP * D, ScT  , (unsigned*)(ws + WS_CTL) + CW_Q + ((l * 2) * 2 + rep) * 512); }));
        PHASE_R(12, ({ peer_w_phase(c, ScT, ids, gates, W8, SW, SX, SU + (size_t)l * NEXP * 2, SV + (size_t)l * NEXP * 2); }));
        PHASE_R(1, ({ slice_pass<1>(c, X8, ids, W8, SW, TV + (size_t)l * NEXP * D, (float*)A0, (unsigned*)(ws + WS_CTL) + CW_Q + ((l * 2 + 1) * 2 + rep) * 512); }));
        PHASE(({ ln_phase(c, A0, H, ln_g + (size_t)(l * 2 + 1) * D, ln_b + (size_t)(l * 2 + 1) * D, l == NLAYER - 1 ? out : nullptr, H, X8, SX); }));
#if defined(PROBE_SLICE) && PROBE_SLICE == 1
        PHASE(({ slice_pass<0, 1>(c, X8, ids, W8, SW, TU + (size_t)l * NEXP * D, ScT, (unsigned*)(ws + WS_CTL) + CW_Q + ((l * 2) * 2 + 1) * 512); }));
#elif defined(PROBE_SLICE) && PROBE_SLICE == 2
        PHASE(({ slice_pass<0, 2>(c, X8, ids, W8, SW, TU + (size_t)l * NEXP * D, ScT, (unsigned*)(ws + WS_CTL) + CW_Q + ((l * 2) * 2 + 1) * 512); }));
#elif defined(PROBE_SLICE) && PROBE_SLICE == 3
        PHASE(({ slice_pass<1, 1>(c, X8, ids, W8, SW, TV + (size_t)l * NEXP * D, ScT, (unsigned*)(ws + WS_CTL) + CW_Q + ((l * 2) * 2 + 1) * 512); }));
#elif defined(PROBE_SLICE) && PROBE_SLICE == 4
        PHASE(({ slice_pass<1, 2>(c, X8, ids, W8, SW, TV + (size_t)l * NEXP * D, ScT, (unsigned*)(ws + WS_CTL) + CW_Q + ((l * 2) * 2 + 1) * 512); }));
#endif
    }
#undef PHASE
#undef PHASE_R
#undef WinT
#undef WoutT
#undef WqT
#undef WoT
#undef WkvT
#undef WP
#undef W8A
#undef SWA
#undef W8R
#undef Vsn
#undef H
#undef Kb
#undef VT
#undef ids
#undef gates
#undef W8
#undef SX
#undef SW
#undef X8
#undef TU
#undef TV
#undef SU
#undef SV
#undef A0
#undef A1
#undef ScT
#undef R
}

#ifndef N_LAUNCH_MODE
#define N_LAUNCH_MODE 1
#endif
extern "C" void kernel_launch(void* const* d_in, const int* in_sizes, int n_in, void* d_out, int out_size, void* d_ws, size_t ws_size, hipStream_t stream) {
    static int grid = 0;
    if (grid == 0) {
        if (n_in != 18 || in_sizes[0] != TP * D || (size_t)out_size != O_END || ws_size < WS_END) {
            fprintf(stderr, "kernel_launch: shape mismatch: n_in %d in0 %d out %d ws %zu (need %zu)\n", n_in, n_in > 0 ? in_sizes[0] : -1, out_size, ws_size, (size_t)WS_END); grid = -1; return; }
        int dev = 0, cus = 0, per_cu = 0;
        if (hipGetDevice(&dev) != hipSuccess || hipDeviceGetAttribute(&cus, hipDeviceAttributeMultiprocessorCount, dev) != hipSuccess) { grid = -1; return; }
        if (hipFuncSetAttribute((const void*)fwd, hipFuncAttributeMaxDynamicSharedMemorySize, LDS_BYTES) != hipSuccess) { fprintf(stderr, "kernel_launch: hipFuncSetAttribute failed\n"); grid = -1; return; }
        if (hipOccupancyMaxActiveBlocksPerMultiprocessor(&per_cu, (const void*)fwd, 512, LDS_BYTES) != hipSuccess || per_cu < 1) { fprintf(stderr, "kernel_launch: occupancy query says %d\n", per_cu); }
        (void)hipGetLastError();
        grid = cus;
    }
    if (grid < 0) return;
    (void)hipMemsetAsync((char*)d_ws + WS_CTL, 0, CTL_BYTES, stream);
    Args a{};
    for (int i = 0; i < 18; ++i) a.in[i] = (const float*)d_in[i];
    a.out = (float*)d_out; a.ws = (unsigned char*)d_ws; a.pad = 0;
#if N_LAUNCH_MODE == 1
    a.ph_lo = 0; a.ph_hi = 1 << 30; a.li = 0;
    hipLaunchKernelGGL(fwd, dim3(grid), dim3(512), LDS_BYTES, stream, a);
#else
    for (int p = 0; p < N_PHASES; ++p) { a.ph_lo = p; a.ph_hi = p + 1; a.li = p; hipLaunchKernelGGL(fwd, dim3(grid), dim3(512), LDS_BYTES, stream, a); }
#endif
}
```

```cpp
#include <hip/hip_runtime.h>
#include <cstdio>
#include <cstdint>
namespace pg8 {
#define PG8_LAS __attribute__((address_space(3)))
typedef unsigned short bf16_t;
typedef short bf16x8 __attribute__((ext_vector_type(8)));
typedef float f32x4 __attribute__((ext_vector_type(4)));
typedef unsigned u32x4 __attribute__((ext_vector_type(4)));
constexpr int BM = 256, BK = 64, HALF = 128, HTB = HALF * BK * 2  , STAGE_BYTES = 8 * HTB, NXCD = 8, WGM = 8;

__host__ __device__ __forceinline__ int lds_byte(int r, int c) { const int st = (r >> 4) * 2 + (c >> 5), rr = r & 15, cc = c & 31, ob = rr * 64 + cc * 2; return st * 1024 + (ob ^ (((ob >> 9) & 1) << 5)); }
__host__ __device__ __forceinline__ void stage_rc(int b, int& R, int& C) { const int st = b / 1024, sb = b % 1024, swz = sb ^ (((sb >> 9) & 1) << 5); R = (st >> 1) * 16 + swz / 64; C = (st & 1) * 32 + (swz % 64) / 2; }
__host__ __device__ __forceinline__ int perm32(int rho) { const int n = rho >> 4, i = rho & 15; return 8 * (i >> 2) + 4 * n + (i & 3); }

struct Unit { int pm, pn; };
struct Gemm { const bf16_t* A; const bf16_t* Bt; int M, N, K; };

struct StaticOrder {
    int nM, nN, nwg, G, c;
    __host__ __device__ void init(int M, int N, int G_, int c_) { nM = M / BM; nN = N / BM; nwg = nM * nN; G = G_; c = c_; }
    __host__ __device__ bool next(int i, Unit& u) const {
        const long L = (long)i * G + c; if (L >= nwg) return false;
        int wgid = (int)L; { const int q = nwg / NXCD, r = nwg % NXCD, xcd = wgid % NXCD, off = wgid / NXCD; wgid = (xcd < r ? xcd * (q + 1) : r * (q + 1) + (xcd - r) * q) + off; }
        const int nig = WGM * nN, gid = wgid / nig, fm = gid * WGM, gsz = (nM - fm) < WGM ? (nM - fm) : WGM;
        u.pm = fm + ((wgid % nig) % gsz); u.pn = (wgid % nig) / gsz; return true;
    }
    __device__ __forceinline__ void a_ready(const Unit&) const {}
    __device__ __forceinline__ void done(const Unit&) const {}
};

typedef float f32x2 __attribute__((ext_vector_type(2)));
typedef __bf16 bf16x2v __attribute__((ext_vector_type(2)));
typedef unsigned u32x2 __attribute__((ext_vector_type(2)));
__device__ __forceinline__ unsigned pk2(float lo, float hi) { const bf16x2v v = __builtin_convertvector((f32x2){lo, hi}, bf16x2v); return __builtin_bit_cast(unsigned, v); }
__device__ __forceinline__ u32x4 pk8(const f32x4 a, const f32x4 b) { u32x4 w; w.x = pk2(a[0], a[1]); w.y = pk2(a[2], a[3]); w.z = pk2(b[0], b[1]); w.w = pk2(b[2], b[3]); return w; }

typedef int i32x4 __attribute__((ext_vector_type(4)));
template <bool I8> struct AccT { typedef f32x4 type; static __device__ __forceinline__ type zero() { return (f32x4){0.f, 0.f, 0.f, 0.f}; } };
template <> struct AccT<true> { typedef i32x4 type; static __device__ __forceinline__ type zero() { return (i32x4){0, 0, 0, 0}; } };
__device__ __forceinline__ f32x4 mma16(const bf16x8 b, const bf16x8 a, const f32x4 c) { return __builtin_amdgcn_mfma_f32_16x16x32_bf16(b, a, c, 0, 0, 0); }
__device__ __forceinline__ i32x4 mma16(const bf16x8 b, const bf16x8 a, const i32x4 c) { return __builtin_amdgcn_mfma_i32_16x16x64_i8(__builtin_bit_cast(i32x4, b), __builtin_bit_cast(i32x4, a), c, 0, 0, 0); }
__device__ __forceinline__ f32x4 dq4(const f32x4 a, const float, const f32x4) { return a; }
__device__ __forceinline__ f32x4 dq4(const i32x4 a, const float ra, const f32x4 cb) { return (f32x4){(float)a[0], (float)a[1], (float)a[2], (float)a[3]} * ra * cb; }
constexpr int TOK_P = 65536;

template <bool I8> struct EpiBf16P {
    static constexpr bool PERM = true, AFTER_DRAIN = false;
    bf16_t* O; int ldc; const float* sa; const float* sb;
    __device__ __forceinline__ void operator()(const typename AccT<I8>::type (&acc)[2][2][4][2], const Unit& u, int wr, int wc, int fr, int fq) const {
        const int row0 = u.pm * BM + wr * 64 + fr, col0 = u.pn * BM + wc * 32 + 8 * fq;
        f32x4 cb[2][2];
#pragma unroll
        for (int bj = 0; bj < 2; ++bj)
#pragma unroll
            for (int n = 0; n < 2; ++n) cb[bj][n] = I8 ? *(const f32x4*)(sb + col0 + bj * HALF + 4 * n) : (f32x4){1.f, 1.f, 1.f, 1.f};
        float rs[2][4];
#pragma unroll
        for (int ai = 0; ai < 2; ++ai)
#pragma unroll
            for (int m = 0; m < 4; ++m) rs[ai][m] = I8 ? sa[row0 + ai * HALF + m * 16] : 1.f;
        __builtin_amdgcn_sched_barrier(0);
#pragma unroll
        for (int ai = 0; ai < 2; ++ai)
#pragma unroll
            for (int m = 0; m < 4; ++m) { const int row = row0 + ai * HALF + m * 16; const float ra = rs[ai][m]; bf16_t* rowp = O + (size_t)row * ldc + col0;
#pragma unroll
                for (int bj = 0; bj < 2; ++bj) *(u32x4*)(rowp + bj * HALF) = pk8(dq4(acc[ai][bj][m][0], ra, cb[bj][0]), dq4(acc[ai][bj][m][1], ra, cb[bj][1])); }
    }
};
template <bool I8> struct EpiGate {
    static constexpr bool PERM = true, AFTER_DRAIN = false;
    bf16_t* U; bf16_t* Bg; const float* sa; const float* sb;
    __device__ __forceinline__ void operator()(const typename AccT<I8>::type (&acc)[2][2][4][2], const Unit& u, int wr, int wc, int fr, int fq) const {
        const int row0 = u.pm * BM + wr * 64 + fr, scol0 = u.pn * BM + wc * 32 + 8 * fq;
        f32x4 cb[2][2];
#pragma unroll
        for (int bj = 0; bj < 2; ++bj)
#pragma unroll
            for (int n = 0; n < 2; ++n) cb[bj][n] = I8 ? *(const f32x4*)(sb + scol0 + bj * HALF + 4 * n) : (f32x4){1.f, 1.f, 1.f, 1.f};
        float rs[2][4];
#pragma unroll
        for (int ai = 0; ai < 2; ++ai)
#pragma unroll
            for (int m = 0; m < 4; ++m) rs[ai][m] = I8 ? sa[row0 + ai * HALF + m * 16] : 1.f;
        __builtin_amdgcn_sched_barrier(0);
        if (u.pn < 8) {
            const int col0 = u.pn * HALF + wc * 32 + 8 * fq;
#pragma unroll
            for (int ai = 0; ai < 2; ++ai)
#pragma unroll
                for (int m = 0; m < 4; ++m) { const int row = row0 + ai * HALF + m * 16; const float ra = rs[ai][m];
                    const f32x4 v0 = dq4(acc[ai][0][m][0], ra, cb[0][0]) * dq4(acc[ai][1][m][0], ra, cb[1][0]), v1 = dq4(acc[ai][0][m][1], ra, cb[0][1]) * dq4(acc[ai][1][m][1], ra, cb[1][1]);
                    *(u32x4*)(U + (size_t)row * 1024 + col0) = pk8(v0, v1); }
        } else {
            const int col0 = (u.pn - 8) * BM + wc * 32 + 8 * fq;
#pragma unroll
            for (int ai = 0; ai < 2; ++ai)
#pragma unroll
                for (int m = 0; m < 4; ++m) { const int row = row0 + ai * HALF + m * 16; const float ra = rs[ai][m]; bf16_t* rowp = Bg + (size_t)row * 1024 + col0;
#pragma unroll
                    for (int bj = 0; bj < 2; ++bj) *(u32x4*)(rowp + bj * HALF) = pk8(dq4(acc[ai][bj][m][0], ra, cb[bj][0]), dq4(acc[ai][bj][m][1], ra, cb[bj][1])); }
        }
    }
};
template <bool I8> struct EpiRes {
    static constexpr bool PERM = true, AFTER_DRAIN = false;
    const bf16_t* H; bf16_t* R; float alpha; const float* sa; const float* sb;
    __device__ __forceinline__ void operator()(const typename AccT<I8>::type (&acc)[2][2][4][2], const Unit& u, int wr, int wc, int fr, int fq) const {
        const int row0 = u.pm * BM + wr * 64 + fr, col0 = u.pn * BM + wc * 32 + 8 * fq;
        f32x4 cb[2][2];
#pragma unroll
        for (int bj = 0; bj < 2; ++bj)
#pragma unroll
            for (int n = 0; n < 2; ++n) cb[bj][n] = I8 ? *(const f32x4*)(sb + col0 + bj * HALF + 4 * n) : (f32x4){1.f, 1.f, 1.f, 1.f};
        float rs[2][4];
#pragma unroll
        for (int ai = 0; ai < 2; ++ai)
#pragma unroll
            for (int m = 0; m < 4; ++m) rs[ai][m] = I8 ? sa[row0 + ai * HALF + m * 16] : 1.f;
        __builtin_amdgcn_sched_barrier(0);
#pragma unroll
        for (int ai = 0; ai < 2; ++ai) {
            u32x4 hq[4][2];
#pragma unroll
            for (int m = 0; m < 4; ++m)
#pragma unroll
                for (int bj = 0; bj < 2; ++bj) hq[m][bj] = *(const u32x4*)(H + (size_t)(row0 + ai * HALF + m * 16) * 1024 + col0 + bj * HALF);
            __builtin_amdgcn_sched_barrier(0);
#pragma unroll
            for (int m = 0; m < 4; ++m) { const int row = row0 + ai * HALF + m * 16; const float ra = rs[ai][m]; const size_t off = (size_t)row * 1024 + col0;
#pragma unroll
                for (int bj = 0; bj < 2; ++bj) { const u32x4 h = hq[m][bj];
                    f32x4 h0, h1; h0[0] = __uint_as_float(h.x << 16); h0[1] = __uint_as_float(h.x & 0xffff0000u); h0[2] = __uint_as_float(h.y << 16); h0[3] = __uint_as_float(h.y & 0xffff0000u);
                    h1[0] = __uint_as_float(h.z << 16); h1[1] = __uint_as_float(h.z & 0xffff0000u); h1[2] = __uint_as_float(h.w << 16); h1[3] = __uint_as_float(h.w & 0xffff0000u);
                    *(u32x4*)(R + off + bj * HALF) = pk8(h0 * alpha + dq4(acc[ai][bj][m][0], ra, cb[bj][0]), h1 * alpha + dq4(acc[ai][bj][m][1], ra, cb[bj][1])); } } }
    }
};
template <bool I8> struct EpiKV {
    static constexpr bool PERM = true, AFTER_DRAIN = false;
    bf16_t* Kb; bf16_t* Vb; float* kp; float* vp; float* ks; float* vs; const float* sa; const float* sb;
    __device__ __forceinline__ void operator()(const typename AccT<I8>::type (&acc)[2][2][4][2], const Unit& u, int wr, int wc, int fr, int fq) const {
        const bool isv = u.pn >= 4; const int colt = (isv ? u.pn - 4 : u.pn) * BM;
        bf16_t* ob = isv ? Vb : Kb; const bool samp = u.pm * BM >= TOK_P;
        float* of = samp ? (isv ? vs : ks) - (size_t)TOK_P * 1024 : (isv ? vp : kp);
        const int row0 = u.pm * BM + wr * 64 + fr, col0 = colt + wc * 32 + 8 * fq, scol0 = u.pn * BM + wc * 32 + 8 * fq;
        float rs[2][4];
#pragma unroll
        for (int ai = 0; ai < 2; ++ai)
#pragma unroll
            for (int m = 0; m < 4; ++m) rs[ai][m] = I8 ? sa[row0 + ai * HALF + m * 16] : 1.f;
        f32x4 cb[2][2];
#pragma unroll
        for (int bj = 0; bj < 2; ++bj)
#pragma unroll
            for (int n = 0; n < 2; ++n) cb[bj][n] = I8 ? *(const f32x4*)(sb + scol0 + bj * HALF + 4 * n) : (f32x4){1.f, 1.f, 1.f, 1.f};
#pragma unroll
        for (int ai = 0; ai < 2; ++ai)
#pragma unroll
            for (int m = 0; m < 4; ++m) { const int row = row0 + ai * HALF + m * 16; const float ra = rs[ai][m]; const size_t off = (size_t)row * 1024 + col0;
#pragma unroll
                for (int bj = 0; bj < 2; ++bj) { const f32x4 v0 = dq4(acc[ai][bj][m][0], ra, cb[bj][0]), v1 = dq4(acc[ai][bj][m][1], ra, cb[bj][1]);
                    *(u32x4*)(ob + off + bj * HALF) = pk8(v0, v1); *(f32x4*)(of + off + bj * HALF) = v0; *(f32x4*)(of + off + bj * HALF + 4) = v1; } }
    }
};

struct EpiScoreI8 {
    static constexpr bool PERM = true, AFTER_DRAIN = false;
    bf16_t* O; int ldc; const float* sa; const float* sb;
    __device__ __forceinline__ void operator()(const i32x4 (&acc)[2][2][4][2], const Unit& u, int wr, int wc, int fr, int fq) const {
        const int row0 = u.pm * BM + wr * 64 + fr, col0 = u.pn * BM + wc * 32 + 8 * fq;
        f32x4 cb[2][2];
#pragma unroll
        for (int bj = 0; bj < 2; ++bj)
#pragma unroll
            for (int n = 0; n < 2; ++n) cb[bj][n] = *(const f32x4*)(sb + col0 + bj * HALF + 4 * n);
        float rs[2][4];
#pragma unroll
        for (int ai = 0; ai < 2; ++ai)
#pragma unroll
            for (int m = 0; m < 4; ++m) rs[ai][m] = sa[row0 + ai * HALF + m * 16];
        __builtin_amdgcn_sched_barrier(0);
#pragma unroll
        for (int ai = 0; ai < 2; ++ai)
#pragma unroll
            for (int m = 0; m < 4; ++m) { const int row = row0 + ai * HALF + m * 16; const float ra = rs[ai][m]; bf16_t* rowp = O + (size_t)row * ldc + col0;
#pragma unroll
                for (int bj = 0; bj < 2; ++bj) { f32x4 v0, v1;
#pragma unroll
                    for (int i = 0; i < 4; ++i) { v0[i] = (float)acc[ai][bj][m][0][i] * ra * cb[bj][0][i]; v1[i] = (float)acc[ai][bj][m][1][i] * ra * cb[bj][1][i]; }
                    *(u32x4*)(rowp + bj * HALF) = pk8(v0, v1); } }
    }
};

template <class Epi, class Sched, bool ALIGN_EPI = false, bool SP2 = false, bool I8 = false>
__device__ __forceinline__ void gemm_phase(PG8_LAS unsigned char* lds, const Gemm g, const Sched& S, const Epi& E, const int tid_in) {
    int tid_ = tid_in; asm volatile("" : "+v"(tid_));
    const int tid = tid_, wid = __builtin_amdgcn_readfirstlane(tid >> 6), lane = tid & 63, wr = wid >> 2, wc = wid & 3, fr = lane & 15, fq = lane >> 4;
    const int K = g.K, nt = K / BK;
    unsigned voffA[2], voffB[2];
#pragma unroll
    for (int i = 0; i < 2; ++i) { int R, C; stage_rc(tid * 16 + i * 8192, R, C); const int Rb = Epi::PERM ? ((R & ~31) + perm32(R & 31)) : R;
        voffA[i] = (unsigned)(R * K + C) * 2u; voffB[i] = (unsigned)(Rb * K + C) * 2u; }
    const size_t kstep = (size_t)(BK * 2);
    const size_t hstep = (size_t)HALF * K * 2;
    const size_t tstep = 2 * hstep;
    const unsigned ldsw = (unsigned)wid * 1024u;
    const int aoff = lds_byte(wr * 64 + fr, fq * 8), boff = lds_byte(wc * 32 + fr, fq * 8);
#define PG8_SA(b, h) (((b) * 2 + (h)) * HTB)
#define PG8_SB(b, h) ((4 + (b) * 2 + (h)) * HTB)
#define PG8_STAGE(bufoff, gbase, voff) do { _Pragma("unroll") for (int _i = 0; _i < 2; ++_i) \
        __builtin_amdgcn_global_load_lds((const unsigned*)((const char*)(gbase) + (voff)[_i]), (PG8_LAS unsigned*)(lds + (bufoff) + ldsw + _i * 8192), 16, 0, 0); } while (0)
#define PG8_LDA(dst, b, h) do { _Pragma("unroll") for (int m = 0; m < 4; ++m) _Pragma("unroll") for (int k = 0; k < 2; ++k) dst[m][k] = *(const PG8_LAS bf16x8*)(lds + PG8_SA(b, h) + aoff + m * 2048 + k * 1024); } while (0)
#define PG8_LDB(dst, b, h) do { _Pragma("unroll") for (int n = 0; n < 2; ++n) _Pragma("unroll") for (int k = 0; k < 2; ++k) dst[n][k] = *(const PG8_LAS bf16x8*)(lds + PG8_SB(b, h) + boff + n * 2048 + k * 1024); } while (0)
#define PG8_MMA(ai, bj, At, Bt) do { __builtin_amdgcn_s_setprio(1); _Pragma("unroll") for (int m = 0; m < 4; ++m) _Pragma("unroll") for (int n = 0; n < 2; ++n) _Pragma("unroll") for (int k = 0; k < 2; ++k) \
        acc[ai][bj][m][n] = mma16(Bt[n][k], At[m][k], acc[ai][bj][m][n]); __builtin_amdgcn_s_setprio(0); } while (0)
#define PG8_WAIT_V(n) asm volatile("s_waitcnt vmcnt(" #n ")" ::: "memory")
#define PG8_WAIT_L(n) asm volatile("s_waitcnt lgkmcnt(" #n ")" ::: "memory")
#define PG8_BAR __builtin_amdgcn_s_barrier()
#define PG8_SCHED __builtin_amdgcn_sched_barrier(0)
    Unit cur, nxt; int ui = 0;
    if (!S.next(0, cur)) return;
    typename AccT<I8>::type acc[2][2][4][2];
#pragma unroll
    for (int a = 0; a < 2; ++a)
#pragma unroll
        for (int b = 0; b < 2; ++b)
#pragma unroll
            for (int m = 0; m < 4; ++m)
#pragma unroll
                for (int n = 0; n < 2; ++n) acc[a][b][m][n] = AccT<I8>::zero();
    bf16x8 At[4][2], B0[2][2], B1[2][2];
    const char* cA = (const char*)g.A + (size_t)cur.pm * tstep; const char* cB = (const char*)g.Bt + (size_t)cur.pn * tstep;
    S.a_ready(cur);
    if constexpr (SP2) {
        PG8_STAGE(PG8_SB(0, 0), cB, voffB); PG8_STAGE(PG8_SB(0, 1), cB + hstep, voffB); PG8_STAGE(PG8_SA(0, 0), cA, voffA); PG8_STAGE(PG8_SA(0, 1), cA + hstep, voffA);
        if (wr == 1) PG8_BAR;
        PG8_WAIT_V(2); PG8_BAR;
        PG8_STAGE(PG8_SB(1, 0), cB + kstep, voffB); PG8_STAGE(PG8_SA(1, 0), cA + kstep, voffA); PG8_STAGE(PG8_SB(1, 1), cB + hstep + kstep, voffB);
        PG8_WAIT_V(6); PG8_BAR;
    } else {
        PG8_STAGE(PG8_SB(0, 0), cB, voffB); PG8_STAGE(PG8_SA(0, 0), cA, voffA); PG8_STAGE(PG8_SB(0, 1), cB + hstep, voffB); PG8_STAGE(PG8_SA(0, 1), cA + hstep, voffA);
        if (wr == 1) PG8_BAR;
        PG8_WAIT_V(4); PG8_BAR;
        PG8_STAGE(PG8_SB(1, 0), cB + kstep, voffB); PG8_STAGE(PG8_SA(1, 0), cA + kstep, voffA); PG8_STAGE(PG8_SB(1, 1), cB + hstep + kstep, voffB);
        PG8_WAIT_V(6); PG8_BAR;
    }
    for (;;) {
        const bool has_next = S.next(ui + 1, nxt);
        const char* nA = has_next ? (const char*)g.A + (size_t)nxt.pm * tstep : cA; const char* nB = has_next ? (const char*)g.Bt + (size_t)nxt.pn * tstep : cB;
        for (int t = 0; t < nt; t += 2) {
            const bool last = (t == nt - 2);
            const char* a1 = cA + (size_t)(t + 1) * kstep;
            const char* a2 = last ? nA : cA + (size_t)(t + 2) * kstep; const char* b2 = last ? nB : cB + (size_t)(t + 2) * kstep;
            const char* a3 = a2 + kstep; const char* b3 = b2 + kstep;
            if (last && has_next) S.a_ready(nxt);
            if constexpr (SP2) {
            PG8_LDB(B0, 0, 0); PG8_LDB(B1, 0, 1); PG8_SCHED; PG8_LDA(At, 0, 0); PG8_STAGE(PG8_SA(1, 1), a1 + hstep, voffA);
            PG8_WAIT_V(8); PG8_WAIT_L(0); PG8_BAR; PG8_MMA(0, 0, At, B0); PG8_MMA(0, 1, At, B1); PG8_BAR; PG8_SCHED;
            PG8_LDA(At, 0, 1); PG8_STAGE(PG8_SB(0, 0), b2, voffB); PG8_STAGE(PG8_SB(0, 1), b2 + hstep, voffB); PG8_STAGE(PG8_SA(0, 0), a2, voffA);
            PG8_WAIT_V(8); PG8_WAIT_L(0); PG8_BAR; PG8_MMA(1, 0, At, B0); PG8_MMA(1, 1, At, B1); PG8_BAR; PG8_SCHED;
            PG8_LDB(B0, 1, 0); PG8_LDB(B1, 1, 1); PG8_SCHED; PG8_LDA(At, 1, 0); PG8_STAGE(PG8_SA(0, 1), a2 + hstep, voffA);
            PG8_WAIT_V(8); PG8_WAIT_L(0); PG8_BAR; PG8_MMA(0, 0, At, B0); PG8_MMA(0, 1, At, B1); PG8_BAR; PG8_SCHED;
            PG8_LDA(At, 1, 1); PG8_STAGE(PG8_SB(1, 0), b3, voffB); PG8_STAGE(PG8_SB(1, 1), b3 + hstep, voffB); PG8_STAGE(PG8_SA(1, 0), a3, voffA);
            PG8_WAIT_V(8); PG8_WAIT_L(0); PG8_BAR; PG8_MMA(1, 0, At, B0); PG8_MMA(1, 1, At, B1); PG8_BAR; PG8_SCHED;
            } else {
            PG8_LDB(B0, 0, 0); PG8_SCHED; PG8_LDA(At, 0, 0); PG8_STAGE(PG8_SA(1, 1), a1 + hstep, voffA);
            PG8_WAIT_L(8); PG8_BAR; PG8_WAIT_L(0); PG8_MMA(0, 0, At, B0); PG8_BAR; PG8_SCHED;
            PG8_LDB(B1, 0, 1); PG8_STAGE(PG8_SB(0, 0), b2, voffB);
            PG8_BAR; PG8_WAIT_L(0); PG8_MMA(0, 1, At, B1); PG8_BAR;
            PG8_LDA(At, 0, 1); PG8_STAGE(PG8_SA(0, 0), a2, voffA);
            PG8_BAR; PG8_WAIT_L(0); PG8_MMA(1, 0, At, B0); PG8_BAR; PG8_SCHED;
            PG8_STAGE(PG8_SB(0, 1), b2 + hstep, voffB);
            PG8_WAIT_V(6); PG8_BAR; PG8_MMA(1, 1, At, B1); PG8_BAR;
            PG8_LDB(B0, 1, 0); PG8_SCHED; PG8_LDA(At, 1, 0); PG8_STAGE(PG8_SA(0, 1), a2 + hstep, voffA);
            PG8_WAIT_L(8); PG8_BAR; PG8_WAIT_L(0); PG8_MMA(0, 0, At, B0); PG8_BAR; PG8_SCHED;
            PG8_LDB(B1, 1, 1); PG8_STAGE(PG8_SB(1, 0), b3, voffB);
            PG8_BAR; PG8_WAIT_L(0); PG8_MMA(0, 1, At, B1); PG8_BAR;
            PG8_LDA(At, 1, 1); PG8_STAGE(PG8_SA(1, 0), a3, voffA);
            PG8_BAR; PG8_WAIT_L(0); PG8_MMA(1, 0, At, B0); PG8_BAR; PG8_SCHED;
            PG8_STAGE(PG8_SB(1, 1), b3 + hstep, voffB);
            PG8_WAIT_V(6); PG8_BAR; PG8_MMA(1, 1, At, B1); PG8_BAR;
            }
        }
        if constexpr (ALIGN_EPI) { if (wr == 0) PG8_BAR; }
        if constexpr (!Epi::AFTER_DRAIN) { E(acc, cur, wr, wc, fr, fq); S.done(cur); }
        if (!has_next) break;
#pragma unroll
        for (int a = 0; a < 2; ++a)
#pragma unroll
            for (int b = 0; b < 2; ++b)
#pragma unroll
                for (int m = 0; m < 4; ++m)
#pragma unroll
                    for (int n = 0; n < 2; ++n) acc[a][b][m][n] = AccT<I8>::zero();
        cur = nxt; cA = nA; cB = nB; ++ui;
        if constexpr (ALIGN_EPI) { if (wr == 1) PG8_BAR; }
    }
    PG8_WAIT_V(0);
    if constexpr (!ALIGN_EPI) { if (wr == 0) PG8_BAR; }
    PG8_BAR;
    if constexpr (Epi::AFTER_DRAIN) { E.fused(acc, cur, wr, wc, fr, fq, lds, wid, lane); S.done(cur); }
#undef PG8_SA
#undef PG8_SB
#undef PG8_STAGE
#undef PG8_LDA
#undef PG8_LDB
#undef PG8_MMA
#undef PG8_WAIT_V
#undef PG8_WAIT_L
#undef PG8_BAR
#undef PG8_SCHED
}
}

#define GAS __attribute__((address_space(1)))
#define LAS __attribute__((address_space(3)))
#define DI __device__ __forceinline__
typedef unsigned short bf16;
typedef unsigned v4u __attribute__((ext_vector_type(4)));
typedef unsigned v2u __attribute__((ext_vector_type(2)));
typedef float f32x4 __attribute__((ext_vector_type(4)));
typedef float f32x16 __attribute__((ext_vector_type(16)));
typedef short bf16x8 __attribute__((ext_vector_type(8)));
using pg8::pk2;
#define LDS_WAIT() asm volatile("s_waitcnt lgkmcnt(0)" ::: "memory")
#define MFMA32(a, b, c) __builtin_amdgcn_mfma_f32_32x32x16_bf16((a), (b), (c), 0, 0, 0)

constexpr int D = 1024, NB = 32, SEQ = 2048, DSEQ = 16, PAST = 1024, NH = 16, DH = 64;
constexpr int TP = NB * SEQ, TS = NB * DSEQ, T = TP + TS;
constexpr int NEXP = 16384, PH = 8, PK = 16;
constexpr int NLAYER = 4;
constexpr float LN_EPS = 1e-5f;
constexpr float ALPHA = 1.6817928305074292f;
constexpr float LOG2E = 1.4426950408889634f, LN2 = 0.6931471805599453f;
static_assert(T % 256 == 0 && pg8::TOK_P == TP, "row panels");
constexpr size_t O_Y = 0, O_YS = (size_t)TP * D, O_CONVP = O_YS + (size_t)TS * D, O_KP = O_CONVP + 2 * NB * 2 * D, O_VP = O_KP + (size_t)TP * D,
                 O_CONVS = O_VP + (size_t)TP * D, O_KS = O_CONVS + 2 * NB * 2 * D, O_VS = O_KS + (size_t)TS * D, O_END = O_VS + (size_t)TS * D;
static_assert(O_END == 203161600ull, "output size");
constexpr size_t MiB = 1u << 20;
constexpr size_t WS_CTL = 0, CTL_BYTES = 2 * MiB;
constexpr size_t WS_WIN = 2 * MiB;
constexpr size_t WS_WOUT = WS_WIN + 12 * MiB;
constexpr size_t WS_WQ = WS_WOUT + 4 * MiB;
constexpr size_t WS_WO = WS_WQ + 4 * MiB;
constexpr size_t WS_WKV = WS_WO + 4 * MiB;
constexpr size_t WS_WP = WS_WKV + 4 * MiB;
constexpr size_t WS_VSN = WS_WP + 16 * MiB;
constexpr size_t WS_H = WS_VSN + 1 * MiB;
constexpr size_t WS_KB = WS_H + 129 * MiB;
constexpr size_t WS_VT = WS_KB + 129 * MiB;
constexpr size_t WS_IDS = WS_VT + 128 * MiB;
constexpr size_t WS_GATE = WS_IDS + 17 * MiB;
constexpr size_t WS_TU = WS_GATE + 33 * MiB;
constexpr size_t WS_TV = WS_TU + 64 * MiB;
constexpr size_t WS_SU = WS_TV + 64 * MiB;
constexpr size_t WS_W8 = WS_SU + 1 * MiB;
constexpr size_t WS_SX = WS_W8 + 9 * MiB;
constexpr size_t WS_X8 = WS_SX + 1 * MiB;
constexpr size_t WS_W8A = WS_X8 + 65 * MiB;
constexpr size_t WS_SWA = WS_W8A + 22 * MiB;
constexpr int W8_ROWS = (int)((WS_VSN - WS_WIN) / 2048);
static_assert(W8_ROWS == 22528, "weight rows");
constexpr size_t WS_A = WS_SWA + 1 * MiB;
constexpr size_t WS_END = WS_A + 258 * MiB;
static_assert((size_t)T * D * 2 == 129 * MiB && (size_t)1024 * T * 4 == 258 * MiB, "sizes");
constexpr int CW_Q = 1024;
constexpr int CW_BAR = 16384;

constexpr int RING_BYTES = 131072, MISC_OFF = RING_BYTES + 320, LDS_BYTES = 147456;

#define XB_TMO      128
#define XB_XCNT(j)  (256  + 64 * (j))
#define XB_XSUB(j)  (1280 + 64 * (j))
#define XB_XGEN(j)  (2304 + 64 * (j))
#define XB_TOP      3328
#define XB_TOPGEN   3392
#define XCD_BAR_WORDS 3456
#define XB_SPIN_CAP (1u << 18)

__device__ __forceinline__ unsigned xb_ld(unsigned* p)              { return __hip_atomic_load(p, __ATOMIC_RELAXED, __HIP_MEMORY_SCOPE_AGENT); }
__device__ __forceinline__ unsigned xb_add(unsigned* p, unsigned v) { return __hip_atomic_fetch_add(p, v, __ATOMIC_RELAXED, __HIP_MEMORY_SCOPE_AGENT); }
__device__ __forceinline__ unsigned xb_xcc_id() { return (unsigned)__builtin_amdgcn_s_getreg((3 << 11) | 20) & 0xFu; }
#define XB_SPIN(cond, bar) do { unsigned _sp = 0; while (cond) { __builtin_amdgcn_s_sleep(1); \
    if ((++_sp & 255u) == 0u) { if (xb_ld(&(bar)[XB_TMO])) break; if (_sp > XB_SPIN_CAP) { atomicAdd(&(bar)[XB_TMO], 1u); break; } } } } while (0)

__device__ __forceinline__ int xb_lane_id() { int l; asm volatile("v_mbcnt_lo_u32_b32 %0, -1, 0\n\tv_mbcnt_hi_u32_b32 %0, -1, %0" : "=v"(l)); return l; }
__device__ __forceinline__ bool xb_is_thread0(unsigned w0) { return w0 != 0u && xb_lane_id() == 0; }
struct XcdBarrier {
    unsigned w0;
    unsigned* bar; unsigned x;
    volatile LAS unsigned* st;
};

__device__ __forceinline__ XcdBarrier xcd_barrier_post(unsigned* bar, volatile LAS unsigned* st, unsigned w0) {
    XcdBarrier b; b.w0 = w0; b.bar = bar; b.x = xb_xcc_id(); b.st = st;
    if (xb_is_thread0(b.w0)) (void)xb_add(&bar[XB_XCNT(b.x)], 1u);
    return b;
}
__device__ __forceinline__ void xcd_barrier_complete(unsigned* bar, unsigned x, unsigned& nloc, unsigned& nx) {
    const unsigned G = gridDim.x * gridDim.y * gridDim.z;
    unsigned sum, cnt, mine, sp = 0u;
    for (;;) {
        sum = 0u; cnt = 0u; mine = 0u;
#pragma unroll
        for (unsigned j = 0; j < 16; ++j) { const unsigned c = xb_ld(&bar[XB_XCNT(j)]); sum += c; cnt += (c > 0u) ? 1u : 0u; mine = (j == x) ? c : mine; }
        if (sum == G) break;
        __builtin_amdgcn_s_sleep(1);
        if ((++sp & 255u) == 0u) { if (xb_ld(&bar[XB_TMO])) break; if (sp > XB_SPIN_CAP) { atomicAdd(&bar[XB_TMO], 1u); break; } }
    }
    nloc = mine > 0u ? mine : 1u; nx = cnt > 0u ? cnt : 1u;
}

__device__ __forceinline__ void xcd_barrier(const XcdBarrier& b) {
    asm volatile("s_waitcnt vmcnt(0)" ::: "memory");
    __syncthreads();
    if (xb_is_thread0(b.w0)) {
        unsigned* bar = b.bar;
        __builtin_amdgcn_s_waitcnt(0);
        unsigned nloc = b.st[0], nx = b.st[1];
        if (nloc == 0u) { xcd_barrier_complete(bar, b.x, nloc, nx); b.st[0] = nloc; b.st[1] = nx; }
        const unsigned old = xb_add(&bar[XB_XSUB(b.x)], 1u);
        const unsigned gen = old / nloc;
        if (old + 1u == (gen + 1u) * nloc) {
            __builtin_amdgcn_fence(__ATOMIC_RELEASE, "agent");
            asm volatile("s_waitcnt vmcnt(0)" ::: "memory");
            const unsigned og = xb_add(&bar[XB_TOP], 1u);
            const unsigned tg = og / nx;
            if (og + 1u == (tg + 1u) * nx) xb_add(&bar[XB_TOPGEN], 1u);
            else XB_SPIN(xb_ld(&bar[XB_TOPGEN]) == tg, bar);
            __builtin_amdgcn_fence(__ATOMIC_ACQUIRE, "agent");
            xb_add(&bar[XB_XGEN(b.x)], 1u);
            asm volatile("s_waitcnt vmcnt(0)" ::: "memory");
        } else {
            XB_SPIN(xb_ld(&bar[XB_XGEN(b.x)]) == gen, bar);
            __builtin_amdgcn_fence(__ATOMIC_ACQUIRE, "agent");
            asm volatile("s_waitcnt vmcnt(0)" ::: "memory");
        }
    }
    __syncthreads();
}


DI float bflo(unsigned w) { return __uint_as_float(w << 16); }
DI float bfhi(unsigned w) { return __uint_as_float(w & 0xffff0000u); }
DI int shx(const int lane, const int v, const int o) {
    if (o == 1) return __builtin_amdgcn_update_dpp(v, v, 0xB1, 0xf, 0xf, false);
    if (o == 2) return __builtin_amdgcn_update_dpp(v, v, 0x4E, 0xf, 0xf, false);
    if (o == 8) return __builtin_amdgcn_update_dpp(v, v, 0x128, 0xf, 0xf, false);
    if (o == 4) return __builtin_amdgcn_ds_swizzle(v, 0x101F);
    if (o == 16) return __builtin_amdgcn_ds_swizzle(v, 0x401F);
    return __builtin_amdgcn_ds_bpermute((lane ^ o) << 2, v);
}
DI float shx(const int lane, const float v, const int o) { return __int_as_float(shx(lane, __float_as_int(v), o)); }
DI float wave_sum(const int lane, float v) {
#pragma unroll
    for (int o = 1; o < 64; o <<= 1) v += shx(lane, v, o);
    return v;
}
DI bf16x8 pack8(float a0, float a1, float a2, float a3, float a4, float a5, float a6, float a7) {
    v4u p; p.x = pk2(a0, a1); p.y = pk2(a2, a3); p.z = pk2(a4, a5); p.w = pk2(a6, a7); return __builtin_bit_cast(bf16x8, p);
}
DI float gelu_erf(float v) {
    const float av = __builtin_fabsf(v), d = av * 0.2316418882f + 1.0f, t = __builtin_amdgcn_rcpf(d);
    float q = t * 0.5307027145f + (-0.7265760135f); q = q * t + 0.7107068705f; q = q * t + (-0.142248368f); q = q * t + 0.127414796f; q = q * t;
    const float e = __builtin_amdgcn_exp2f((v * v) * (-0.72134752044f));
    const float m = v * (q * e), r = v - m;
    return v < 0.f ? m : r;
}

struct Ctx {
    int tid, lane, wave, vcu, G;
};

DI void p0_transpose_item(const float* W, int K, int N, bf16* WT, int out_row0, float scale, LAS float* scr, int k0, int n0, int lane) {
#pragma unroll 8
    for (int i = 0; i < 32; ++i) { const int kk = 2 * i + (lane >> 5); scr[kk * 33 + (lane & 31)] = W[(size_t)(k0 + kk) * N + n0 + (lane & 31)]; }
    LDS_WAIT(); asm volatile("" ::: "memory");
    const int c = lane & 7;
#pragma unroll
    for (int j = 0; j < 4; ++j) { const int n = (lane >> 3) + 8 * j; const LAS float* s = scr + (8 * c) * 33 + n;
        v4u o; o.x = pk2(s[0 * 33] * scale, s[1 * 33] * scale); o.y = pk2(s[2 * 33] * scale, s[3 * 33] * scale); o.z = pk2(s[4 * 33] * scale, s[5 * 33] * scale); o.w = pk2(s[6 * 33] * scale, s[7 * 33] * scale);
        *(v4u*)(WT + (size_t)(out_row0 + n) * K + k0 + 8 * c) = o; }
    LDS_WAIT(); asm volatile("" ::: "memory");
}
DI void cvt_stream(const float* src, bf16* dst, size_t n8, size_t gtid, size_t NT) {
    size_t i = gtid;
    for (; i + 3 * NT < n8; i += 4 * NT) {
        f32x4 a[4], b[4];
#pragma unroll
        for (int u = 0; u < 4; ++u) { a[u] = *(const f32x4*)(src + (i + u * NT) * 8); b[u] = *(const f32x4*)(src + (i + u * NT) * 8 + 4); }
#pragma unroll
        for (int u = 0; u < 4; ++u) *(v4u*)(dst + (i + u * NT) * 8) = pg8::pk8(a[u], b[u]);
    }
    for (; i < n8; i += NT) { const f32x4 a = *(const f32x4*)(src + i * 8), b = *(const f32x4*)(src + i * 8 + 4); *(v4u*)(dst + i * 8) = pg8::pk8(a, b); }
}
DI unsigned q4_i8(const f32x4 v, const float k) {
    const int a = (int)__builtin_rintf(v[0] * k), b = (int)__builtin_rintf(v[1] * k), c = (int)__builtin_rintf(v[2] * k), d = (int)__builtin_rintf(v[3] * k);
    return ((unsigned)a & 0xffu) | (((unsigned)b & 0xffu) << 8) | (((unsigned)c & 0xffu) << 16) | ((unsigned)d << 24);
}
DI void cvt_table_rows(const float* src, unsigned char* dst, float* scl  , int nrows, int gw, int NGW, int lane) {
    f32x4 nx[4];
#pragma unroll
    for (int j = 0; j < 4; ++j) nx[j] = *(const f32x4*)(src + (size_t)(gw < nrows ? gw : 0) * D + 4 * lane + 256 * j);
    for (int row = gw; row < nrows; row += NGW) {
        f32x4 v[4]; float m = 0.f; const int rn = row + NGW < nrows ? row + NGW : row;
#pragma unroll
        for (int j = 0; j < 4; ++j) { v[j] = nx[j]; nx[j] = *(const f32x4*)(src + (size_t)rn * D + 4 * lane + 256 * j);
            m = __builtin_fmaxf(m, __builtin_fmaxf(__builtin_fmaxf(__builtin_fabsf(v[j][0]), __builtin_fabsf(v[j][1])), __builtin_fmaxf(__builtin_fabsf(v[j][2]), __builtin_fabsf(v[j][3])))); }
#pragma unroll
        for (int o = 1; o < 64; o <<= 1) m = __builtin_fmaxf(m, shx(lane, m, o));
        const float k = m > 0.f ? 127.0f / m : 0.f;
#pragma unroll
        for (int j = 0; j < 4; ++j)
            *(unsigned*)(dst + ((size_t)(row >> 14) * NEXP * D) + ((size_t)(2 * j + (lane >> 5)) * NEXP + (row & (NEXP - 1))) * 128 + ((4 * lane) & 127)) = q4_i8(v[j], k);
        if (lane == 0) scl[2 * row] = m * (1.0f / 127.0f);
    }
}
struct P0Args { const float *x_p, *x_s, *w_in, *w_out, *wq, *wo, *wk, *wv, *pwq, *psk, *pu, *pv; bf16 *WinT, *WoutT, *WqT, *WoT, *WkvT, *WP, *H; unsigned char *TU, *TV; float *SU, *SV; unsigned char* X8; float* SX; };
DI void p0_prologue(const Ctx c, LAS unsigned char* lds, const P0Args a) {
    for (int half = 0; half < 2; ++half) {
    if (((c.vcu & 1) == 1) == (half == 0)) {
    { LAS float* scr = (LAS float*)(lds + c.wave * 16384);
      const int gw = c.vcu * 8 + c.wave, NGW = c.G * 8;
      constexpr int IT_WIN = 16 * 96, IT_SQ = 16 * 32, NITEMS = 2 * IT_WIN + 8 * IT_SQ;
      for (int it = gw; it < NITEMS; it += NGW) {
          int r = it;
          if (r < 2 * IT_WIN) { const int l = r / IT_WIN; r -= l * IT_WIN; const int kb = r / 96, nb = r % 96, n0 = 32 * nb; int orow;
              if (n0 < 1024) orow = 2048 + n0; else if (n0 < 2048) { const int d = n0 - 1024; orow = 256 * (d >> 7) + (d & 127); } else { const int d = n0 - 2048; orow = 256 * (d >> 7) + 128 + (d & 127); }
              p0_transpose_item(a.w_in + (size_t)l * 1024 * 3072, 1024, 3072, a.WinT + (size_t)l * 3072 * 1024, orow, 1.f, scr, 64 * kb, n0, c.lane); continue; }
          r -= 2 * IT_WIN; const int m = r / IT_SQ; r -= m * IT_SQ; const int kb = r >> 5, nb = r & 31;
          const float* src; bf16* dst; float sc = 1.f; const size_t SQ = (size_t)1024 * 1024;
          if (m < 2) { src = a.w_out + m * SQ; dst = a.WoutT + m * SQ; }
          else if (m < 4) { src = a.wq + (m - 2) * SQ; dst = a.WqT + (m - 2) * SQ; sc = 0.125f * LOG2E; }
          else if (m < 6) { src = a.wo + (m - 4) * SQ; dst = a.WoT + (m - 4) * SQ; }
          else if (m == 6) { src = a.wk; dst = a.WkvT; }
          else { src = a.wv; dst = a.WkvT + SQ; }
          p0_transpose_item(src, 1024, 1024, dst, 32 * nb, sc, scr, 64 * kb, 32 * nb, c.lane);
      }
    }
    __syncthreads();
    { LAS float* skT = (LAS float*)lds; LAS float* wqT = skT + 128 * 132;
      for (int u = c.vcu; u < 4 * 16 * 16; u += c.G) {
          const int l = u >> 8, hp = (u >> 4) & 15, dblk = u & 15;
          for (int i = c.tid; i < 16384; i += 512) skT[(i & 127) * 132 + (i >> 7)] = a.psk[(size_t)(l * 16 + hp) * 16384 + i];
          for (int i = c.tid; i < 8192; i += 512) wqT[(i & 127) * 68 + (i >> 7)] = a.pwq[((size_t)l * 1024 + dblk * 64 + (i >> 7)) * 2048 + hp * 128 + (i & 127)];
          __syncthreads();
          const int ng = c.tid & 31, dg = c.tid >> 5; f32x4 acc[4];
#pragma unroll
          for (int i = 0; i < 4; ++i) acc[i] = (f32x4){0.f, 0.f, 0.f, 0.f};
#pragma unroll 4
          for (int cc = 0; cc < 128; ++cc) { const f32x4 s = *(const LAS f32x4*)(skT + cc * 132 + 4 * ng), w = *(const LAS f32x4*)(wqT + cc * 68 + 4 * dg);
#pragma unroll
              for (int i = 0; i < 4; ++i) acc[i] = acc[i] + w * s[i]; }
#pragma unroll
          for (int i = 0; i < 4; ++i) { v2u o; o.x = pk2(acc[i][0], acc[i][1]); o.y = pk2(acc[i][2], acc[i][3]);
              *(v2u*)(a.WP + ((size_t)l * 2048 + hp * 128 + 4 * ng + i) * 1024 + dblk * 64 + 4 * dg) = o; }
          __syncthreads();
      }
    }
    } else {
    { const size_t gtid = (size_t)c.vcu * 512 + c.tid, NT = (size_t)c.G * 512;
      cvt_table_rows(a.pu, a.TU, a.SU, NLAYER * NEXP, c.vcu * 8 + c.wave, c.G * 8, c.lane);
      cvt_table_rows(a.pv, a.TV, a.SV, NLAYER * NEXP, c.vcu * 8 + c.wave, c.G * 8, c.lane);
      (void)gtid; (void)NT;
      for (int m = c.vcu * 8 + c.wave; m < T; m += c.G * 8) {
          const float* xr = (m < TP ? a.x_p + (size_t)m * D : a.x_s + (size_t)(m - TP) * D) + 4 * c.lane;
          f32x4 v[4]; float am = 0.f;
#pragma unroll
          for (int j = 0; j < 4; ++j) { v[j] = *(const f32x4*)(xr + 256 * j); v2u w; w.x = pk2(v[j][0], v[j][1]); w.y = pk2(v[j][2], v[j][3]); ((v2u*)(a.H + (size_t)m * D) + c.lane)[64 * j] = w;
              am = __builtin_fmaxf(am, __builtin_fmaxf(__builtin_fmaxf(__builtin_fabsf(v[j][0]), __builtin_fabsf(v[j][1])), __builtin_fmaxf(__builtin_fabsf(v[j][2]), __builtin_fabsf(v[j][3])))); }
#pragma unroll
          for (int o = 1; o < 64; o <<= 1) am = __builtin_fmaxf(am, shx(c.lane, am, o));
          const float k = am > 0.f ? 127.0f / am : 0.f;
#pragma unroll
          for (int j = 0; j < 4; ++j) *(unsigned*)(a.X8 + (size_t)m * D + 4 * c.lane + 256 * j) = q4_i8(v[j], k);
          if (c.lane == 0) a.SX[m] = am * (1.0f / 127.0f);
      }
    }
    }
    __syncthreads();
    }
}

DI void wp_quant_phase(const Ctx c, const bf16* WPb, unsigned char* WP8q, float* swp) {
    for (int row = c.vcu * 8 + c.wave; row < W8_ROWS; row += c.G * 8) {
        const v4u a = *(const v4u*)(WPb + (size_t)row * D + 16 * c.lane), b = *(const v4u*)(WPb + (size_t)row * D + 16 * c.lane + 8);
        const f32x4 v0 = {bflo(a.x), bfhi(a.x), bflo(a.y), bfhi(a.y)}, v1 = {bflo(a.z), bfhi(a.z), bflo(a.w), bfhi(a.w)}, v2 = {bflo(b.x), bfhi(b.x), bflo(b.y), bfhi(b.y)}, v3 = {bflo(b.z), bfhi(b.z), bflo(b.w), bfhi(b.w)};
        float m = 0.f;
#pragma unroll
        for (int i = 0; i < 4; ++i) m = __builtin_fmaxf(m, __builtin_fmaxf(__builtin_fmaxf(__builtin_fabsf(v0[i]), __builtin_fabsf(v1[i])), __builtin_fmaxf(__builtin_fabsf(v2[i]), __builtin_fabsf(v3[i]))));
#pragma unroll
        for (int o = 1; o < 64; o <<= 1) m = __builtin_fmaxf(m, shx(c.lane, m, o));
        const float k = m > 0.f ? 127.0f / m : 0.f;
        v4u o; o.x = q4_i8(v0, k); o.y = q4_i8(v1, k); o.z = q4_i8(v2, k); o.w = q4_i8(v3, k);
        *(v4u*)(WP8q + (size_t)row * D + 16 * c.lane) = o;
        if (c.lane == 0) swp[row] = m * (1.0f / 127.0f);
    }
}

DI void ld8_bf16(const bf16* p, float (&o)[8]) { const v4u w = *(const v4u*)p; o[0] = bflo(w.x); o[1] = bfhi(w.x); o[2] = bflo(w.y); o[3] = bfhi(w.y); o[4] = bflo(w.z); o[5] = bfhi(w.z); o[6] = bflo(w.w); o[7] = bfhi(w.w); }
DI void ld8_f32(const float* p, float (&o)[8]) { const f32x4 a = *(const f32x4*)p, b = *(const f32x4*)(p + 4); o[0] = a[0]; o[1] = a[1]; o[2] = a[2]; o[3] = a[3]; o[4] = b[0]; o[5] = b[1]; o[6] = b[2]; o[7] = b[3]; }
DI void conv_gate_phase(const Ctx c, const bf16* U, bf16* Bg, const float* wdw  , const float* st  , float* convp, float* convs  ,
                        unsigned char* z8, float* sz  , const bool skip_samp = false  ) {
    const int gw = c.vcu * 8 + c.wave, NGW = c.G * 8, dc = 16 * c.lane;
    float w0[16], w1[16], w2[16];
    { float t8[8]; ld8_f32(wdw + dc, t8);
#pragma unroll
      for (int i = 0; i < 8; ++i) w0[i] = t8[i]; ld8_f32(wdw + dc + 8, t8);
#pragma unroll
      for (int i = 0; i < 8; ++i) w0[8 + i] = t8[i]; ld8_f32(wdw + D + dc, t8);
#pragma unroll
      for (int i = 0; i < 8; ++i) w1[i] = t8[i]; ld8_f32(wdw + D + dc + 8, t8);
#pragma unroll
      for (int i = 0; i < 8; ++i) w1[8 + i] = t8[i]; ld8_f32(wdw + 2 * D + dc, t8);
#pragma unroll
      for (int i = 0; i < 8; ++i) w2[i] = t8[i]; ld8_f32(wdw + 2 * D + dc + 8, t8);
#pragma unroll
      for (int i = 0; i < 8; ++i) w2[8 + i] = t8[i]; }
    { v4u ng[2], n2[2], n1[2], n0[2];
#define CG_LOAD(tt_) do { const int t_ = (tt_), s_ = t_ & 2047, t1_ = s_ >= 1 ? t_ - 1 : t_, t0_ = s_ >= 2 ? t_ - 2 : t_; \
        _Pragma("unroll") for (int hf = 0; hf < 2; ++hf) { ng[hf] = *(const v4u*)(Bg + (size_t)t_ * D + dc + 8 * hf); n2[hf] = *(const v4u*)(U + (size_t)t_ * D + dc + 8 * hf); \
            n1[hf] = *(const v4u*)(U + (size_t)t1_ * D + dc + 8 * hf); n0[hf] = *(const v4u*)(U + (size_t)t0_ * D + dc + 8 * hf); } } while (0)
      if (gw < TP) CG_LOAD(gw);
      for (int t = gw; t < TP; t += NGW) {
          const int s = t & 2047; const float f1 = s >= 1 ? 1.f : 0.f, f0 = s >= 2 ? 1.f : 0.f;
          v4u cg[2], c2[2], c1[2], c0[2];
#pragma unroll
          for (int hf = 0; hf < 2; ++hf) { cg[hf] = ng[hf]; c2[hf] = n2[hf]; c1[hf] = n1[hf]; c0[hf] = n0[hf]; }
          CG_LOAD(t + NGW < TP ? t + NGW : t);
          float z[16]; float am = 0.f;
#pragma unroll
          for (int hf = 0; hf < 2; ++hf) { const unsigned wg[4] = {cg[hf].x, cg[hf].y, cg[hf].z, cg[hf].w}, w2_[4] = {c2[hf].x, c2[hf].y, c2[hf].z, c2[hf].w}, w1_[4] = {c1[hf].x, c1[hf].y, c1[hf].z, c1[hf].w}, w0_[4] = {c0[hf].x, c0[hf].y, c0[hf].z, c0[hf].w};
#pragma unroll
              for (int i = 0; i < 8; ++i) { const bool hi = i & 1; const int k = i >> 1;
                  const float g = hi ? bfhi(wg[k]) : bflo(wg[k]), u2 = hi ? bfhi(w2_[k]) : bflo(w2_[k]), u1 = (hi ? bfhi(w1_[k]) : bflo(w1_[k])) * f1, u0 = (hi ? bfhi(w0_[k]) : bflo(w0_[k])) * f0;
                  const float zz = g * (w0[8 * hf + i] * u0 + w1[8 * hf + i] * u1 + w2[8 * hf + i] * u2); z[8 * hf + i] = zz; am = __builtin_fmaxf(am, __builtin_fabsf(zz)); } }
#pragma unroll
          for (int o = 1; o < 64; o <<= 1) am = __builtin_fmaxf(am, shx(c.lane, am, o));
          const float k = am > 0.f ? 127.0f / am : 0.f;
          v4u q; q.x = q4_i8((f32x4){z[0], z[1], z[2], z[3]}, k); q.y = q4_i8((f32x4){z[4], z[5], z[6], z[7]}, k); q.z = q4_i8((f32x4){z[8], z[9], z[10], z[11]}, k); q.w = q4_i8((f32x4){z[12], z[13], z[14], z[15]}, k);
          *(v4u*)(z8 + (size_t)t * D + dc) = q;
          if (c.lane == 0) sz[t] = am * (1.0f / 127.0f);
      }
#undef CG_LOAD
    }
    for (int t = TP + gw; t < (skip_samp ? TP : T); t += NGW) {
        const bool samp = true; const int s = (t - TP) & 15; const int b = (t - TP) >> 4;
        float z[16]; float am = 0.f;
#pragma unroll
        for (int hf = 0; hf < 2; ++hf) { const int d0 = dc + 8 * hf;
            float u0[8], u1[8], u2[8], g[8];
            ld8_bf16(U + (size_t)t * D + d0, u2);
            { float* cdst = nullptr;
              (void)convp;
              if (samp && s >= DSEQ - 2) cdst = convs + ((size_t)b * 2 + (s - (DSEQ - 2))) * D + d0;
              if (cdst) { *(f32x4*)cdst = (f32x4){u2[0], u2[1], u2[2], u2[3]}; *(f32x4*)(cdst + 4) = (f32x4){u2[4], u2[5], u2[6], u2[7]}; } }
            if (s >= 1) ld8_bf16(U + (size_t)(t - 1) * D + d0, u1);
            else if (samp) ld8_f32(st + ((size_t)b * 2 + 1) * D + d0, u1);
            else {
#pragma unroll
                for (int i = 0; i < 8; ++i) u1[i] = 0.f; }
            if (s >= 2) ld8_bf16(U + (size_t)(t - 2) * D + d0, u0);
            else if (samp) ld8_f32(st + ((size_t)b * 2 + (s == 1 ? 1 : 0)) * D + d0, u0);
            else {
#pragma unroll
                for (int i = 0; i < 8; ++i) u0[i] = 0.f; }
            ld8_bf16(Bg + (size_t)t * D + d0, g);
#pragma unroll
            for (int i = 0; i < 8; ++i) { const float zz = g[i] * (w0[8 * hf + i] * u0[i] + w1[8 * hf + i] * u1[i] + w2[8 * hf + i] * u2[i]); z[8 * hf + i] = zz; am = __builtin_fmaxf(am, __builtin_fabsf(zz)); }
        }
        if (samp) {
            v4u o0, o1; o0.x = pk2(z[0], z[1]); o0.y = pk2(z[2], z[3]); o0.z = pk2(z[4], z[5]); o0.w = pk2(z[6], z[7]); o1.x = pk2(z[8], z[9]); o1.y = pk2(z[10], z[11]); o1.z = pk2(z[12], z[13]); o1.w = pk2(z[14], z[15]);
            *(v4u*)(Bg + (size_t)t * D + dc) = o0; *(v4u*)(Bg + (size_t)t * D + dc + 8) = o1; }
#pragma unroll
        for (int o = 1; o < 64; o <<= 1) am = __builtin_fmaxf(am, shx(c.lane, am, o));
        const float k = am > 0.f ? 127.0f / am : 0.f;
        v4u q; q.x = q4_i8((f32x4){z[0], z[1], z[2], z[3]}, k); q.y = q4_i8((f32x4){z[4], z[5], z[6], z[7]}, k); q.z = q4_i8((f32x4){z[8], z[9], z[10], z[11]}, k); q.w = q4_i8((f32x4){z[12], z[13], z[14], z[15]}, k);
        *(v4u*)(z8 + (size_t)t * D + dc) = q;
        if (c.lane == 0) sz[t] = am * (1.0f / 127.0f);
    }
}

DI void ln_phase(const Ctx c, const bf16* R, bf16* H, const float* g, const float* bb, float* yout = nullptr, const bf16* Hres = nullptr, unsigned char* x8 = nullptr, float* sx = nullptr) {
    const int gw = c.vcu * 8 + c.wave, NGW = c.G * 8;
    float gv[2][8], bv[2][8];
#pragma unroll
    for (int j = 0; j < 2; ++j) { ld8_f32(g + 8 * c.lane + 512 * j, gv[j]); ld8_f32(bb + 8 * c.lane + 512 * j, bv[j]); }
    v4u rw[2], hw[2];
#pragma unroll
    for (int j = 0; j < 2; ++j) { const int m0 = gw < T ? gw : 0; rw[j] = *(const v4u*)(R + (size_t)m0 * D + 8 * c.lane + 512 * j); hw[j] = Hres ? *(const v4u*)(Hres + (size_t)m0 * D + 8 * c.lane + 512 * j) : (v4u){0u, 0u, 0u, 0u}; }
    for (int m = gw; m < T; m += NGW) {
        float v[2][8]; float s = 0.f;
#pragma unroll
        for (int j = 0; j < 2; ++j) { const unsigned w[4] = {rw[j].x, rw[j].y, rw[j].z, rw[j].w}, hq[4] = {hw[j].x, hw[j].y, hw[j].z, hw[j].w};
#pragma unroll
            for (int i = 0; i < 4; ++i) { v[j][2 * i] = bflo(w[i]); v[j][2 * i + 1] = bfhi(w[i]); if (Hres) { v[j][2 * i] += bflo(hq[i]) * ALPHA; v[j][2 * i + 1] += bfhi(hq[i]) * ALPHA; } }
#pragma unroll
            for (int i = 0; i < 8; ++i) s += v[j][i]; }
        { const int mn = m + NGW < T ? m + NGW : m;
#pragma unroll
          for (int j = 0; j < 2; ++j) { rw[j] = *(const v4u*)(R + (size_t)mn * D + 8 * c.lane + 512 * j); if (Hres) hw[j] = *(const v4u*)(Hres + (size_t)mn * D + 8 * c.lane + 512 * j); } }
        const float mean = wave_sum(c.lane, s) * (1.f / D); float s2 = 0.f;
#pragma unroll
        for (int j = 0; j < 2; ++j)
#pragma unroll
            for (int i = 0; i < 8; ++i) { v[j][i] -= mean; s2 += v[j][i] * v[j][i]; }
        const float rstd = __builtin_amdgcn_rsqf(wave_sum(c.lane, s2) * (1.f / D) + LN_EPS);
        float am = 0.f;
#pragma unroll
        for (int j = 0; j < 2; ++j)
#pragma unroll
            for (int i = 0; i < 8; ++i) { v[j][i] = v[j][i] * rstd * gv[j][i] + bv[j][i]; am = __builtin_fmaxf(am, __builtin_fabsf(v[j][i])); }
        if (yout) {
#pragma unroll
            for (int j = 0; j < 2; ++j) { float* o = yout + (size_t)m * D + 8 * c.lane + 512 * j; *(f32x4*)o = (f32x4){v[j][0], v[j][1], v[j][2], v[j][3]}; *(f32x4*)(o + 4) = (f32x4){v[j][4], v[j][5], v[j][6], v[j][7]}; }
        } else {
#pragma unroll
            for (int j = 0; j < 2; ++j) { v4u w; w.x = pk2(v[j][0], v[j][1]); w.y = pk2(v[j][2], v[j][3]); w.z = pk2(v[j][4], v[j][5]); w.w = pk2(v[j][6], v[j][7]); *(v4u*)(H + (size_t)m * D + 8 * c.lane + 512 * j) = w; }
            if (x8) {
#pragma unroll
                for (int o = 1; o < 64; o <<= 1) am = __builtin_fmaxf(am, shx(c.lane, am, o));
                const float k = am > 0.f ? 127.0f / am : 0.f;
#pragma unroll
                for (int j = 0; j < 2; ++j) { v2u q; q.x = q4_i8((f32x4){v[j][0], v[j][1], v[j][2], v[j][3]}, k); q.y = q4_i8((f32x4){v[j][4], v[j][5], v[j][6], v[j][7]}, k); *(v2u*)(x8 + (size_t)m * D + 8 * c.lane + 512 * j) = q; }
                if (c.lane == 0) sx[m] = am * (1.0f / 127.0f);
            } }
    }
}

DI int ordi(float x) { const int b = __float_as_int(x); return b ^ ((b >> 31) & 0x7fffffff); }
DI float unordi(int o) { return __int_as_float(o ^ ((o >> 31) & 0x7fffffff)); }
#define TK_CE(a, b) do { const int _hi = (a) > (b) ? (a) : (b), _lo = (a) > (b) ? (b) : (a); (a) = _hi; (b) = _lo; } while (0)
#define TK_CPK(i, j) ((ordi(va[i] + vb[j]) & ~255) | (255 - ((i) * 16 + (j))))
#define TK_SORT16(v) do { TK_CE(v[0], v[1]); TK_CE(v[2], v[3]); TK_CE(v[0], v[2]); TK_CE(v[1], v[3]); TK_CE(v[1], v[2]); TK_CE(v[4], v[5]); TK_CE(v[6], v[7]); TK_CE(v[4], v[6]); TK_CE(v[5], v[7]); TK_CE(v[5], v[6]); TK_CE(v[0], v[4]); TK_CE(v[2], v[6]); TK_CE(v[2], v[4]); TK_CE(v[1], v[5]); TK_CE(v[3], v[7]); TK_CE(v[3], v[5]); TK_CE(v[1], v[2]); TK_CE(v[3], v[4]); TK_CE(v[5], v[6]); TK_CE(v[8], v[9]); TK_CE(v[10], v[11]); TK_CE(v[8], v[10]); TK_CE(v[9], v[11]); TK_CE(v[9], v[10]); TK_CE(v[12], v[13]); TK_CE(v[14], v[15]); TK_CE(v[12], v[14]); TK_CE(v[13], v[15]); TK_CE(v[13], v[14]); TK_CE(v[8], v[12]); TK_CE(v[10], v[14]); TK_CE(v[10], v[12]); TK_CE(v[9], v[13]); TK_CE(v[11], v[15]); TK_CE(v[11], v[13]); TK_CE(v[9], v[10]); TK_CE(v[11], v[12]); TK_CE(v[13], v[14]); TK_CE(v[0], v[8]); TK_CE(v[4], v[12]); TK_CE(v[4], v[8]); TK_CE(v[2], v[10]); TK_CE(v[6], v[14]); TK_CE(v[6], v[10]); TK_CE(v[2], v[4]); TK_CE(v[6], v[8]); TK_CE(v[10], v[12]); TK_CE(v[1], v[9]); TK_CE(v[5], v[13]); TK_CE(v[5], v[9]); TK_CE(v[3], v[11]); TK_CE(v[7], v[15]); TK_CE(v[7], v[11]); TK_CE(v[3], v[5]); TK_CE(v[7], v[9]); TK_CE(v[11], v[13]); TK_CE(v[1], v[2]); TK_CE(v[3], v[4]); TK_CE(v[5], v[6]); TK_CE(v[7], v[8]); TK_CE(v[9], v[10]); TK_CE(v[11], v[12]); TK_CE(v[13], v[14]); } while (0)
#define TK_BMERGE16(v) do { TK_CE(v[0], v[8]); TK_CE(v[1], v[9]); TK_CE(v[2], v[10]); TK_CE(v[3], v[11]); TK_CE(v[4], v[12]); TK_CE(v[5], v[13]); TK_CE(v[6], v[14]); TK_CE(v[7], v[15]); TK_CE(v[0], v[4]); TK_CE(v[1], v[5]); TK_CE(v[2], v[6]); TK_CE(v[3], v[7]); TK_CE(v[8], v[12]); TK_CE(v[9], v[13]); TK_CE(v[10], v[14]); TK_CE(v[11], v[15]); TK_CE(v[0], v[2]); TK_CE(v[1], v[3]); TK_CE(v[4], v[6]); TK_CE(v[5], v[7]); TK_CE(v[8], v[10]); TK_CE(v[9], v[11]); TK_CE(v[12], v[14]); TK_CE(v[13], v[15]); TK_CE(v[0], v[1]); TK_CE(v[2], v[3]); TK_CE(v[4], v[5]); TK_CE(v[6], v[7]); TK_CE(v[8], v[9]); TK_CE(v[10], v[11]); TK_CE(v[12], v[13]); TK_CE(v[14], v[15]); } while (0)
#define TK_CAND0(B) do { B[0] = TK_CPK(0, 0); B[1] = TK_CPK(0, 1); B[2] = TK_CPK(0, 2); B[3] = TK_CPK(0, 3); B[4] = TK_CPK(0, 4); B[5] = TK_CPK(0, 5); B[6] = TK_CPK(0, 6); B[7] = TK_CPK(0, 7); B[8] = TK_CPK(0, 8); B[9] = TK_CPK(0, 9); B[10] = TK_CPK(0, 10); B[11] = TK_CPK(0, 11); B[12] = TK_CPK(0, 12); B[13] = TK_CPK(0, 13); B[14] = TK_CPK(0, 14); B[15] = TK_CPK(0, 15); } while (0)
#define TK_CAND1(B) do { B[0] = TK_CPK(1, 0); B[1] = TK_CPK(1, 1); B[2] = TK_CPK(1, 2); B[3] = TK_CPK(1, 3); B[4] = TK_CPK(1, 4); B[5] = TK_CPK(1, 5); B[6] = TK_CPK(1, 6); B[7] = TK_CPK(1, 7); B[8] = TK_CPK(2, 0); B[9] = TK_CPK(2, 1); B[10] = TK_CPK(2, 2); B[11] = TK_CPK(2, 3); B[12] = TK_CPK(2, 4); B[13] = TK_CPK(3, 0); B[14] = TK_CPK(3, 1); B[15] = TK_CPK(3, 2); } while (0)
#define TK_CAND2(B) do { B[0] = TK_CPK(3, 3); B[1] = TK_CPK(4, 0); B[2] = TK_CPK(4, 1); B[3] = TK_CPK(4, 2); B[4] = TK_CPK(5, 0); B[5] = TK_CPK(5, 1); B[6] = TK_CPK(6, 0); B[7] = TK_CPK(6, 1); B[8] = TK_CPK(7, 0); B[9] = TK_CPK(7, 1); B[10] = TK_CPK(8, 0); B[11] = TK_CPK(9, 0); B[12] = TK_CPK(10, 0); B[13] = TK_CPK(11, 0); B[14] = TK_CPK(12, 0); B[15] = TK_CPK(13, 0); } while (0)
#define TK_CAND3(B) do { B[0] = TK_CPK(14, 0); B[1] = TK_CPK(15, 0); B[2] = (int)0x80000000; B[3] = (int)0x80000000; B[4] = (int)0x80000000; B[5] = (int)0x80000000; B[6] = (int)0x80000000; B[7] = (int)0x80000000; B[8] = (int)0x80000000; B[9] = (int)0x80000000; B[10] = (int)0x80000000; B[11] = (int)0x80000000; B[12] = (int)0x80000000; B[13] = (int)0x80000000; B[14] = (int)0x80000000; B[15] = (int)0x80000000; } while (0)
DI void tk_merge(int (&L)[16], const int (&B)[16]) {
#pragma unroll
    for (int i = 0; i < 16; ++i) L[i] = L[i] > B[15 - i] ? L[i] : B[15 - i];
    TK_BMERGE16(L);
}
DI void tk_feed32(int (&L)[16], const v4u (&x)[4], const int rb) {
#pragma unroll
    for (int hf = 0; hf < 2; ++hf) { int B[16]; const unsigned w[8] = {x[2 * hf].x, x[2 * hf].y, x[2 * hf].z, x[2 * hf].w, x[2 * hf + 1].x, x[2 * hf + 1].y, x[2 * hf + 1].z, x[2 * hf + 1].w};
#pragma unroll
        for (int j = 0; j < 16; ++j) B[j] = (ordi(__uint_as_float((j & 1) ? (w[j >> 1] & 0xffff0000u) : (w[j >> 1] << 16))) & ~127) | (127 - ((rb + 16 * hf + j) & 127));
        TK_SORT16(B); tk_merge(L, B); }
}
DI unsigned byte_of(unsigned a0, unsigned a1, unsigned a2, unsigned a3, int i) { const unsigned lo = i < 4 ? a0 : a1, hi = i < 12 ? a2 : a3, w = i < 8 ? lo : hi; return (w >> ((i & 3) * 8)) & 0xffu; }
DI void topk_phase(const Ctx c, const bf16* Sc  , unsigned short* ids, float* gates) {
    const int gw = c.wave * c.G + c.vcu, NGW = c.G * 8, NU = 8 * (T / 64);
    v4u bufA[4], bufB[4];
    if (gw < NU) { const v4u* sc = (const v4u*)(Sc + (size_t)((gw % (T / 64)) * 64 + c.lane) * 2048 + (gw / (T / 64)) * 256);
#pragma unroll
        for (int j = 0; j < 4; ++j) bufA[j] = sc[j]; }
#pragma unroll 1
    for (int wu = gw; wu < NU; wu += NGW) {
        const int h = wu / (T / 64), t = (wu % (T / 64)) * 64 + c.lane;
        const v4u* sc = (const v4u*)(Sc + (size_t)t * 2048 + h * 256);
        const int wn = wu + NGW < NU ? wu + NGW : wu;
        const v4u* scn = (const v4u*)(Sc + (size_t)((wn % (T / 64)) * 64 + c.lane) * 2048 + (wn / (T / 64)) * 256);
        int Lw[16], La[16];
#pragma unroll
        for (int i = 0; i < 16; ++i) { Lw[i] = (int)0x80000000; La[i] = 0; }
#pragma unroll 1
        for (int it = 0; it < 4; ++it) {
#pragma unroll
            for (int j = 0; j < 4; ++j) bufB[j] = sc[8 * it + 4 + j];
            tk_feed32(Lw, bufA, 64 * it);
            { const v4u* nx = it < 3 ? sc + 8 * (it + 1) : scn;
#pragma unroll
              for (int j = 0; j < 4; ++j) bufA[j] = nx[j]; }
            tk_feed32(Lw, bufB, 64 * it + 32);
            if (it == 1) {
#pragma unroll
                for (int i = 0; i < 16; ++i) { La[i] = Lw[i]; Lw[i] = (int)0x80000000; } }
        }
        float va[16], vb[16]; unsigned IA0 = 0u, IA1 = 0u, IA2 = 0u, IA3 = 0u, IB0 = 0u, IB1 = 0u, IB2 = 0u, IB3 = 0u;
#pragma unroll
        for (int i = 0; i < 16; ++i) { va[i] = unordi(La[i] & ~127); vb[i] = unordi(Lw[i] & ~127);
            const unsigned ea = (unsigned)(127 - (La[i] & 127)) << ((i & 3) * 8), eb = (unsigned)(127 - (Lw[i] & 127)) << ((i & 3) * 8);
            if ((i >> 2) == 0) { IA0 |= ea; IB0 |= eb; } else if ((i >> 2) == 1) { IA1 |= ea; IB1 |= eb; } else if ((i >> 2) == 2) { IA2 |= ea; IB2 |= eb; } else { IA3 |= ea; IB3 |= eb; } }
        int F[16];
        { int B[16]; TK_CAND0(B); TK_SORT16(B);
#pragma unroll
          for (int i = 0; i < 16; ++i) F[i] = B[i]; }
        { int B[16]; TK_CAND1(B); TK_SORT16(B); tk_merge(F, B); }
        { int B[16]; TK_CAND2(B); TK_SORT16(B); tk_merge(F, B); }
        { int B[16]; TK_CAND3(B); TK_SORT16(B); tk_merge(F, B); }
        float sc_[16], den = 0.f; unsigned ex[16];
        const float mx = unordi(F[0] & ~255);
#pragma unroll
        for (int k = 0; k < 16; ++k) { const int code = 255 - (F[k] & 255); sc_[k] = __builtin_amdgcn_exp2f((unordi(F[k] & ~255) - mx) * LOG2E); den += sc_[k];
            ex[k] = byte_of(IA0, IA1, IA2, IA3, code >> 4) * 128u + byte_of(IB0, IB1, IB2, IB3, code & 15); }
        const float inv = 1.0f / den;
        v4u e0, e1; e0.x = ex[0] | (ex[1] << 16); e0.y = ex[2] | (ex[3] << 16); e0.z = ex[4] | (ex[5] << 16); e0.w = ex[6] | (ex[7] << 16);
        e1.x = ex[8] | (ex[9] << 16); e1.y = ex[10] | (ex[11] << 16); e1.z = ex[12] | (ex[13] << 16); e1.w = ex[14] | (ex[15] << 16);
        v4u* ip = (v4u*)(ids + (size_t)t * 128 + h * 16); ip[0] = e0; ip[1] = e1;
        f32x4* gp = (f32x4*)(gates + (size_t)t * 128 + h * 16);
#pragma unroll
        for (int k = 0; k < 4; ++k) gp[k] = (f32x4){sc_[4 * k] * inv, sc_[4 * k + 1] * inv, sc_[4 * k + 2] * inv, sc_[4 * k + 3] * inv};
    }
}

typedef float f2 __attribute__((ext_vector_type(2)));
constexpr int QCH = 16, QN = T / QCH;
static_assert(T % QCH == 0, "queue chunks");
struct ChunkQ { int xme, s; unsigned pend; unsigned* q; };
struct Chunk { int base, xs; };
DI unsigned cq_ticket(unsigned* qw, int lane) { unsigned v = 0u; if (lane == 0) v = __hip_atomic_fetch_add(qw, 1u, __ATOMIC_RELAXED, __HIP_MEMORY_SCOPE_AGENT); return v; }
DI void cq_init(ChunkQ& g, unsigned* q, int lane) { g.xme = (int)(xb_xcc_id() & 7u); g.s = 0; g.q = q; g.pend = cq_ticket(q + g.xme * 64, lane); }
DI Chunk cq_next(ChunkQ& g, int lane) {
    for (;;) {
        if (g.s >= 8) return Chunk{-1, 0};
        const unsigned chunk = (unsigned)__builtin_amdgcn_readfirstlane((int)g.pend); const int xs = (g.xme + g.s) & 7;
        if (chunk < (unsigned)QN) { g.pend = cq_ticket(g.q + xs * 64, lane); return Chunk{(int)chunk * QCH, xs}; }
        ++g.s; if (g.s < 8) g.pend = cq_ticket(g.q + ((g.xme + g.s) & 7) * 64, lane);
    }
}
struct SliceIds { v4u ia, ib; int t, xs; };
struct SliceAux { v4u a0; float s; };
DI SliceIds slice_load_ids(const int t, const int xs, const int lane, const unsigned short* ids) {
    const int j = lane >> 3, tc = t < 0 ? 0 : t; SliceIds r; r.t = t; r.xs = xs;
    r.ia = *(const v4u*)(ids + (size_t)tc * 128 + 16 * j); r.ib = *(const v4u*)(ids + (size_t)tc * 128 + 16 * j + 8); return r;
}
template <int MODE>
DI SliceAux slice_load_aux(const int t, const int xs, const int lane, const unsigned char* x8, const unsigned char* w8, const float* sw) {
    const int j = lane >> 3, i = lane & 7, tc = t < 0 ? 0 : t; SliceAux r;
    if (MODE == 0) { r.a0 = *(const v4u*)(x8 + (size_t)tc * D + 128 * xs + 16 * i); r.s = 0.f; }
    else { r.a0 = *(const v4u*)(w8 + (size_t)tc * 128 + 16 * j); r.s = sw[tc]; }
    return r;
}
template <int VAR>
DI void slice_issue(v4u (&vr)[16], const SliceIds& n, const unsigned char* T8, const int lane) {
    const unsigned char* sbase = T8 + (size_t)n.xs * NEXP * 128;
    const unsigned lo = 16u * (unsigned)(lane & 7);
    const unsigned idv[8] = {n.ia.x, n.ia.y, n.ia.z, n.ia.w, n.ib.x, n.ib.y, n.ib.z, n.ib.w};
#pragma unroll
    for (int g = 0; g < 16; ++g) { unsigned e = (g & 1) ? (idv[g >> 1] >> 16) : (idv[g >> 1] & 0xffffu); if (VAR == 2) e &= 15u; vr[g] = *(const v4u*)(sbase + (e * 128u + lo)); }
}
DI int dot16_i8(const v4u a, const v4u b, int acc) {
    acc = __builtin_amdgcn_sdot4((int)a.x, (int)b.x, acc, false); acc = __builtin_amdgcn_sdot4((int)a.y, (int)b.y, acc, false);
    acc = __builtin_amdgcn_sdot4((int)a.z, (int)b.z, acc, false); acc = __builtin_amdgcn_sdot4((int)a.w, (int)b.w, acc, false); return acc;
}
DI void tr4_dot(int& c0, int& c1, int& c2, int& c3, const unsigned a, const unsigned b, const unsigned cc, const unsigned d, const int w) {
    const unsigned p = __builtin_amdgcn_perm(b, a, 0x05010400u), q = __builtin_amdgcn_perm(b, a, 0x07030602u), r = __builtin_amdgcn_perm(d, cc, 0x05010400u), s = __builtin_amdgcn_perm(d, cc, 0x07030602u);
    c0 = __builtin_amdgcn_sdot4((int)__builtin_amdgcn_perm(r, p, 0x05040100u), w, c0, false); c1 = __builtin_amdgcn_sdot4((int)__builtin_amdgcn_perm(r, p, 0x07060302u), w, c1, false);
    c2 = __builtin_amdgcn_sdot4((int)__builtin_amdgcn_perm(s, q, 0x05040100u), w, c2, false); c3 = __builtin_amdgcn_sdot4((int)__builtin_amdgcn_perm(s, q, 0x07060302u), w, c3, false);
}
template <int MODE, int VAR>
DI void slice_compute(const int lane, const v4u (&vr)[16], const int t, const int xs, const SliceAux& n, float* OUT) {
    const int j = lane >> 3, i = lane & 7;
    if (VAR == 1) {
        unsigned x = n.a0.x ^ n.a0.y;
#pragma unroll
        for (int g = 0; g < 16; ++g) x ^= vr[g].x ^ vr[g].y ^ vr[g].z ^ vr[g].w;
        *(unsigned*)((bf16*)OUT + (size_t)t * D + 128 * xs + 2 * lane) = x;
    } else if (MODE == 0) {
        int d[16];
#pragma unroll
        for (int g = 0; g < 16; ++g) d[g] = dot16_i8(vr[g], n.a0, 0);
        int r8[8], r4[4], r2[2];
#pragma unroll
        for (int q = 0; q < 8; ++q) { const bool od = lane & 1; const int keep = od ? d[8 + q] : d[q], send = od ? d[q] : d[8 + q]; r8[q] = keep + shx(lane, send, 1); }
#pragma unroll
        for (int q = 0; q < 4; ++q) { const bool od = lane & 2; const int keep = od ? r8[4 + q] : r8[q], send = od ? r8[q] : r8[4 + q]; r4[q] = keep + shx(lane, send, 2); }
#pragma unroll
        for (int q = 0; q < 2; ++q) { const bool od = lane & 4; const int keep = od ? r4[2 + q] : r4[q], send = od ? r4[q] : r4[2 + q]; r2[q] = keep + shx(lane, send, 4); }
        const int g0 = 8 * (i & 1) + 4 * ((i >> 1) & 1) + 2 * (i >> 2);
        *((unsigned*)OUT + ((size_t)xs * T + t) * 64 + 8 * j + (g0 >> 1)) = ((unsigned)((r2[0] + 32) >> 6) & 0xffffu) | ((unsigned)((r2[1] + 32) >> 6) << 16);
    } else {
        int acc[16];
#pragma unroll
        for (int q = 0; q < 16; ++q) acc[q] = 0;
        const int w4[4] = {(int)n.a0.x, (int)n.a0.y, (int)n.a0.z, (int)n.a0.w};
#pragma unroll
        for (int gq = 0; gq < 4; ++gq) {
            tr4_dot(acc[0], acc[1], acc[2], acc[3], vr[4 * gq].x, vr[4 * gq + 1].x, vr[4 * gq + 2].x, vr[4 * gq + 3].x, w4[gq]);
            tr4_dot(acc[4], acc[5], acc[6], acc[7], vr[4 * gq].y, vr[4 * gq + 1].y, vr[4 * gq + 2].y, vr[4 * gq + 3].y, w4[gq]);
            tr4_dot(acc[8], acc[9], acc[10], acc[11], vr[4 * gq].z, vr[4 * gq + 1].z, vr[4 * gq + 2].z, vr[4 * gq + 3].z, w4[gq]);
            tr4_dot(acc[12], acc[13], acc[14], acc[15], vr[4 * gq].w, vr[4 * gq + 1].w, vr[4 * gq + 2].w, vr[4 * gq + 3].w, w4[gq]);
        }
        int r8[8], r4[4], r2[2];
#pragma unroll
        for (int q = 0; q < 8; ++q) { const bool od = lane & 8; const int keep = od ? acc[8 + q] : acc[q], send = od ? acc[q] : acc[8 + q]; r8[q] = keep + shx(lane, send, 8); }
#pragma unroll
        for (int q = 0; q < 4; ++q) { const bool od = lane & 16; const int keep = od ? r8[4 + q] : r8[q], send = od ? r8[q] : r8[4 + q]; r4[q] = keep + shx(lane, send, 16); }
#pragma unroll
        for (int q = 0; q < 2; ++q) { const bool od = lane & 32; const int keep = od ? r4[2 + q] : r4[q], send = od ? r4[q] : r4[2 + q]; r2[q] = keep + shx(lane, send, 32); }
        const int dim = 128 * xs + 16 * i + 8 * (j & 1) + 4 * ((j >> 1) & 1) + 2 * (j >> 2);
        const float s = n.s;
        *(unsigned*)((bf16*)OUT + (size_t)t * D + dim) = pk2((float)r2[0] * s, (float)r2[1] * s);
    }
}
template <int MODE, int VAR = 0>
DI void slice_pass(const Ctx c, const unsigned char* x8, const unsigned short* ids, const unsigned char* w8, const float* sw, const unsigned char* T8, float* OUT, unsigned* q) {
    ChunkQ g; cq_init(g, q, c.lane);
    Chunk cur = cq_next(g, c.lane); if (cur.base < 0) return;
    Chunk nxt = cq_next(g, c.lane);
#define SLICE_TOK_T(p) ((p) < QCH ? cur.base + (p) : (nxt.base >= 0 ? nxt.base + (p) - QCH : -1))
#define SLICE_TOK_X(p) ((p) < QCH ? cur.xs : nxt.xs)
    SliceIds i0 = slice_load_ids(SLICE_TOK_T(0), SLICE_TOK_X(0), c.lane, ids), i1 = slice_load_ids(SLICE_TOK_T(1), SLICE_TOK_X(1), c.lane, ids),
             i2 = slice_load_ids(SLICE_TOK_T(2), SLICE_TOK_X(2), c.lane, ids), i3 = slice_load_ids(SLICE_TOK_T(3), SLICE_TOK_X(3), c.lane, ids);
    SliceAux x0 = slice_load_aux<MODE>(i0.t, i0.xs, c.lane, x8, w8, sw), x1 = slice_load_aux<MODE>(i1.t, i1.xs, c.lane, x8, w8, sw);
    v4u A[16], B[16];
    slice_issue<VAR>(A, i0, T8, c.lane);
#define SLICE_STEP(K, CUR, NXT, IK, IK1, XK) do { slice_issue<VAR>(NXT, IK1, T8, c.lane); \
        const int ct_ = IK.t, cx_ = IK.xs; const SliceAux cxk_ = XK; \
        XK = slice_load_aux<MODE>(SLICE_TOK_T(pg + (K) + 2), SLICE_TOK_X(pg + (K) + 2), c.lane, x8, w8, sw); \
        IK = slice_load_ids(SLICE_TOK_T(pg + (K) + 4), SLICE_TOK_X(pg + (K) + 4), c.lane, ids); \
        slice_compute<MODE, VAR>(c.lane, CUR, ct_, cx_, cxk_, OUT); } while (0)
    for (;;) {
#pragma unroll 2
        for (int pg = 0; pg < QCH; pg += 4) {
            SLICE_STEP(0, A, B, i0, i1, x0);
            SLICE_STEP(1, B, A, i1, i2, x1);
            SLICE_STEP(2, A, B, i2, i3, x0);
            SLICE_STEP(3, B, A, i3, i0, x1);
        }
        cur = nxt; if (cur.base < 0) break;
        nxt = cq_next(g, c.lane);
    }
#undef SLICE_STEP
#undef SLICE_TOK_T
#undef SLICE_TOK_X
}
struct WpA { f32x4 s; v2u iw; f32x4 g; float st; };
struct WpB { f32x4 su, sv; };
DI WpA wp_load_a(const size_t idx, const float* part, const unsigned short* ids, const float* gates, const float* sx) {
    WpA a; v2u p[8];
#pragma unroll
    for (int x = 0; x < 8; ++x) p[x] = *(const v2u*)((const unsigned short*)part + (size_t)x * T * 128 + idx * 4);
    a.iw = *(const v2u*)(ids + idx * 4); a.g = *(const f32x4*)(gates + idx * 4); a.st = sx[idx >> 5] * 64.0f;
    int s0 = 0, s1 = 0, s2 = 0, s3 = 0;
#pragma unroll
    for (int x = 0; x < 8; ++x) { s0 += (int)(short)(p[x].x & 0xffffu); s1 += (int)p[x].x >> 16; s2 += (int)(short)(p[x].y & 0xffffu); s3 += (int)p[x].y >> 16; }
    a.s = (f32x4){(float)s0, (float)s1, (float)s2, (float)s3}; return a;
}
DI WpB wp_load_b(const WpA& a, const float* SU, const float* SV) {
    const unsigned e[4] = {a.iw.x & 0xffffu, a.iw.x >> 16, a.iw.y & 0xffffu, a.iw.y >> 16}; WpB b;
#pragma unroll
    for (int k = 0; k < 4; ++k) { const f2 p = *(const f2*)(SU + 2 * e[k]); b.su[k] = p.x; b.sv[k] = p.y; }
    (void)SV;
    return b;
}
DI void peer_w_phase(const Ctx c, const float* part, const unsigned short* ids, const float* gates, unsigned char* w8, float* sw, const float* sx, const float* SU, const float* SV) {
    const size_t NT = (size_t)c.G * 512, NI = (size_t)T * 32, i0 = (size_t)c.vcu * 512 + c.tid;
    WpA a0 = wp_load_a(i0 < NI ? i0 : 0, part, ids, gates, sx), a1 = wp_load_a(i0 + NT < NI ? i0 + NT : 0, part, ids, gates, sx);
    WpB b0 = wp_load_b(a0, SU, SV);
    for (size_t idx = i0; idx < NI; idx += NT) {
        const WpA a2 = wp_load_a(idx + 2 * NT < NI ? idx + 2 * NT : 0, part, ids, gates, sx);
        const WpB b1 = wp_load_b(a1, SU, SV);
        f32x4 g = a0.g; float am = 0.f;
#pragma unroll
        for (int k = 0; k < 4; ++k) { g[k] = g[k] * gelu_erf(a0.s[k] * (a0.st * b0.su[k])) * b0.sv[k]; am = __builtin_fmaxf(am, __builtin_fabsf(g[k])); }
#pragma unroll
        for (int o = 1; o < 32; o <<= 1) am = __builtin_fmaxf(am, shx(c.lane, am, o));
        *(unsigned*)(w8 + idx * 4) = q4_i8(g, am > 0.f ? 127.0f / am : 0.f);
        if ((c.tid & 31) == 0) sw[idx >> 5] = am * (1.0f / 127.0f);
        a0 = a1; a1 = a2; b0 = b1;
    }
}

DI int pi_row(int m) { return 16 * (m >> 4) + 8 * ((m >> 2) & 1) + 4 * ((m >> 3) & 1) + (m & 3); }
struct AttnT { const bf16* Q; bf16* O; const bf16* Kb; const bf16* VT; const bf16* Vsn; const float* ck; const float* cv; };
template <int MODE>
DI void attn_load(const AttnT A, const int b, const int h, const int kt, const int q, const int hh, const int piq, bf16x8 (&kf)[4], bf16x8 (&vf)[2][2]) {
    if (MODE == 0) {
        const bf16* kr = A.Kb + ((size_t)b * SEQ + kt * 32 + piq) * D + h * DH + 8 * hh;
#pragma unroll
        for (int s = 0; s < 4; ++s) kf[s] = *(const bf16x8*)(kr + 16 * s);
        const bf16* vr = A.VT + (((size_t)b * NH + h) * (SEQ / 32) + kt) * (DH * 32) + q * 32 + 8 * hh;
#pragma unroll
        for (int mt = 0; mt < 2; ++mt)
#pragma unroll
            for (int s = 0; s < 2; ++s) vf[mt][s] = *(const bf16x8*)(vr + mt * 32 * 32 + 16 * s);
    } else if (kt == PAST / 32) {
        const int ko = piq < 16 ? piq : 15;
        const bf16* kr = A.Kb + ((size_t)TP + b * DSEQ + ko) * D + h * DH + 8 * hh;
#pragma unroll
        for (int s = 0; s < 4; ++s) kf[s] = *(const bf16x8*)(kr + 16 * s);
#pragma unroll
        for (int mt = 0; mt < 2; ++mt)
#pragma unroll
            for (int s = 0; s < 2; ++s) { bf16x8 v;
#pragma unroll
                for (int j = 0; j < 8; ++j) { const int kk = 16 * s + 8 * hh + j; v[j] = (short)A.Vsn[((size_t)b * DSEQ + (kk < 16 ? kk : 15)) * D + h * DH + 32 * mt + q]; }
                vf[mt][s] = v; }
    } else {
        const float* kr = A.ck + (((size_t)b * PAST + kt * 32 + piq) * NH + h) * DH + 8 * hh;
#pragma unroll
        for (int s = 0; s < 4; ++s) { const f32x4 x0 = *(const f32x4*)(kr + 16 * s), x1 = *(const f32x4*)(kr + 16 * s + 4); kf[s] = pack8(x0[0], x0[1], x0[2], x0[3], x1[0], x1[1], x1[2], x1[3]); }
#pragma unroll
        for (int mt = 0; mt < 2; ++mt)
#pragma unroll
            for (int s = 0; s < 2; ++s) { float x[8];
#pragma unroll
                for (int j = 0; j < 8; ++j) x[j] = A.cv[(((size_t)b * PAST + kt * 32 + 16 * s + 8 * hh + j) * NH + h) * DH + 32 * mt + q];
                vf[mt][s] = pack8(x[0], x[1], x[2], x[3], x[4], x[5], x[6], x[7]); }
    }
}
template <int MODE>
DI void attn_qtile(const AttnT A, int b, int h, int qi, int lane, const bf16x8 (&ut)[2]) {
    const int q = lane & 31, hh = lane >> 5, piq = pi_row(q);
    const size_t qrow = MODE == 0 ? (size_t)b * SEQ + qi * 32 + q : (size_t)TP + b * DSEQ + (q < 16 ? q : 15);
    const int qpos = MODE == 0 ? qi * 32 + q : (q < 16 ? PAST + q : 0);
    bf16x8 qf[4];
#pragma unroll
    for (int s = 0; s < 4; ++s) qf[s] = *(const bf16x8*)(A.Q + qrow * D + h * DH + 16 * s + 8 * hh);
    f32x16 o0, o1;
#pragma unroll
    for (int i = 0; i < 16; ++i) { o0[i] = 0.f; o1[i] = 0.f; }
    float carry = 0.f;
    const int kt0 = MODE == 0 ? qi : PAST / 32;
    bf16x8 kf[4], vf[2][2];
    attn_load<MODE>(A, b, h, kt0, q, hh, piq, kf, vf);
    for (int kt = kt0; kt >= 0; --kt) {
        bf16x8 kn[4], vn[2][2];
        attn_load<MODE>(A, b, h, kt > 0 ? kt - 1 : 0, q, hh, piq, kn, vn);
        f32x16 S;
#pragma unroll
        for (int i = 0; i < 16; ++i) S[i] = 0.f;
#pragma unroll
        for (int s = 0; s < 4; ++s) S = MFMA32(kf[s], qf[s], S);
        const int kbase = kt * 32 + 8 * hh;
        float L[16], lw[16];
#pragma unroll
        for (int r = 0; r < 16; ++r) {
            const bool valid = (kbase + 16 * (r >> 3) + (r & 7)) < qpos;
            const float z = S[r], sp = __builtin_fmaxf(z, 0.f) + __builtin_amdgcn_logf(1.0f + __builtin_amdgcn_exp2f(-__builtin_fabsf(z)));
            L[r] = valid ? -sp : 0.f; lw[r] = valid ? (z - sp) : -1e30f;
        }
        f32x16 suf;
#pragma unroll
        for (int i = 0; i < 16; ++i) suf[i] = 0.f;
        suf = MFMA32(ut[0], pack8(L[0], L[1], L[2], L[3], L[4], L[5], L[6], L[7]), suf);
        suf = MFMA32(ut[1], pack8(L[8], L[9], L[10], L[11], L[12], L[13], L[14], L[15]), suf);
        float a[16];
#pragma unroll
        for (int r = 0; r < 16; ++r) a[r] = __builtin_amdgcn_exp2f(lw[r] + suf[r] + carry);
        carry += __int_as_float(__builtin_amdgcn_ds_bpermute(q << 2, __float_as_int(suf[0] + L[0])));
        const bf16x8 p0 = pack8(a[0], a[1], a[2], a[3], a[4], a[5], a[6], a[7]), p1 = pack8(a[8], a[9], a[10], a[11], a[12], a[13], a[14], a[15]);
        o0 = MFMA32(vf[0][0], p0, o0); o0 = MFMA32(vf[0][1], p1, o0);
        o1 = MFMA32(vf[1][0], p0, o1); o1 = MFMA32(vf[1][1], p1, o1);
        if (__builtin_amdgcn_ballot_w64(qpos > 0 && carry > -24.0f * LOG2E) == 0ull) break;
#pragma unroll
        for (int s = 0; s < 4; ++s) kf[s] = kn[s];
#pragma unroll
        for (int mt = 0; mt < 2; ++mt)
#pragma unroll
            for (int s = 0; s < 2; ++s) vf[mt][s] = vn[mt][s];
    }
    if (MODE == 0 || q < 16) {
        bf16* orow = A.O + qrow * D + h * DH + 4 * hh;
#pragma unroll
        for (int g = 0; g < 4; ++g) {
            v2u w0, w1; w0.x = pk2(o0[4 * g], o0[4 * g + 1]); w0.y = pk2(o0[4 * g + 2], o0[4 * g + 3]); w1.x = pk2(o1[4 * g], o1[4 * g + 1]); w1.y = pk2(o1[4 * g + 2], o1[4 * g + 3]);
            *(v2u*)(orow + 8 * g) = w0; *(v2u*)(orow + 32 + 8 * g) = w1; }
    }
}
DI void attn_phase(const Ctx c, const AttnT A) {
    const int q = c.lane & 31, hh = c.lane >> 5, piq = pi_row(q);
    bf16x8 ut[2];
#pragma unroll
    for (int s = 0; s < 2; ++s)
#pragma unroll
        for (int j = 0; j < 8; ++j) ut[s][j] = (16 * s + 8 * hh + j > piq) ? (short)0x3f80 : (short)0;
    for (int bu = c.vcu; bu < NB * NH * 4; bu += c.G) {
        const int bh = bu >> 2, b = bh >> 4, h = bh & 15, p = (bu & 3) * 8 + c.wave;
        attn_qtile<0>(A, b, h, 63 - p, c.lane, ut);
        attn_qtile<0>(A, b, h, p, c.lane, ut);
    }
    for (int su = c.wave * c.G + c.vcu; su < NB * NH; su += c.G * 8) attn_qtile<1>(A, su >> 4, su & 15, 0, c.lane, ut);
}

DI void vt_phase(const Ctx c, LAS unsigned char* lds, const bf16* Vb, bf16* VT, bf16* Vsn) {
    LAS unsigned char* scr = lds + c.wave * 16384;
    const int gw = c.vcu * 8 + c.wave, NGW = c.G * 8;
    for (int wt = gw; wt < (TP / 64) * 16; wt += NGW) {
        const int tt = wt >> 4, ht = wt & 15;
        v4u vin[8];
#pragma unroll
        for (int j = 0; j < 8; ++j) vin[j] = *(const v4u*)(Vb + (size_t)(tt * 64 + (c.lane >> 3) + 8 * j) * D + ht * 64 + (c.lane & 7) * 8);
        __builtin_amdgcn_sched_barrier(0);
#pragma unroll
        for (int j = 0; j < 8; ++j) { const int row = (c.lane >> 3) + 8 * j, ch = c.lane & 7;
            LAS unsigned* d = (LAS unsigned*)(scr + row * 132 + ch * 16); d[0] = vin[j].x; d[1] = vin[j].y; d[2] = vin[j].z; d[3] = vin[j].w; }
        LDS_WAIT(); asm volatile("" ::: "memory");
#pragma unroll
        for (int j = 0; j < 8; ++j) { const int orow = (c.lane >> 3) + 8 * j, ch = c.lane & 7;
            unsigned short e[8];
#pragma unroll
            for (int i = 0; i < 8; ++i) e[i] = *(const LAS unsigned short*)(scr + (ch * 8 + i) * 132 + orow * 2);
            v4u o; o.x = e[0] | ((unsigned)e[1] << 16); o.y = e[2] | ((unsigned)e[3] << 16); o.z = e[4] | ((unsigned)e[5] << 16); o.w = e[6] | ((unsigned)e[7] << 16);
            { const int bb = tt >> 5, kt = 2 * (tt & 31) + (ch >> 2);
              *(v4u*)(VT + (((size_t)bb * NH + ht) * (SEQ / 32) + kt) * (DH * 32) + orow * 32 + 8 * (ch & 3)) = o; } }
        LDS_WAIT(); asm volatile("" ::: "memory");
    }
    const size_t NT = (size_t)c.G * 512;
    for (size_t i = (size_t)c.vcu * 512 + c.tid; i < (size_t)TS * D / 8; i += NT) *(v4u*)(Vsn + i * 8) = *(const v4u*)(Vb + (size_t)TP * D + i * 8);
}

DI f32x16 sg_tile(const bf16* wr  , const bf16* xr  ) {
    f32x16 acc;
#pragma unroll
    for (int i = 0; i < 16; ++i) acc[i] = 0.f;
    bf16x8 wa[8], xa[8], wb[8], xb[8];
#pragma unroll
    for (int j = 0; j < 8; ++j) { wa[j] = *(const bf16x8*)(wr + 16 * j); xa[j] = *(const bf16x8*)(xr + 16 * j); }
#pragma unroll 1
    for (int k0 = 0; k0 < 64; k0 += 16) {
#pragma unroll
        for (int j = 0; j < 8; ++j) { wb[j] = *(const bf16x8*)(wr + 16 * (k0 + 8 + j)); xb[j] = *(const bf16x8*)(xr + 16 * (k0 + 8 + j)); }
        __builtin_amdgcn_sched_barrier(0);
#pragma unroll
        for (int j = 0; j < 8; ++j) acc = MFMA32(wa[j], xa[j], acc);
        __builtin_amdgcn_sched_barrier(0);
        { const int kn = k0 + 16 < 64 ? k0 + 16 : 0;
#pragma unroll
          for (int j = 0; j < 8; ++j) { wa[j] = *(const bf16x8*)(wr + 16 * (kn + j)); xa[j] = *(const bf16x8*)(xr + 16 * (kn + j)); } }
        __builtin_amdgcn_sched_barrier(0);
#pragma unroll
        for (int j = 0; j < 8; ++j) acc = MFMA32(wb[j], xb[j], acc);
        __builtin_amdgcn_sched_barrier(0);
    }
    return acc;
}
DI void sg_gate(const Ctx c, const bf16* Hall  , const bf16* Wl  , bf16* U, bf16* Bg, float* convp  ) {
    const int q = c.lane & 31, hh = c.lane >> 5;
    for (int tile = c.wave * c.G + c.vcu; tile < 18 * 32; tile += c.G * 8) {
        const int tt = tile % 18, dt = tile / 18, d = 32 * dt + q, crow = 256 * (d >> 7) + (d & 127);
        const bool cs = tt >= 16; const int kk = (tt - 16) * 32 + q;
        const size_t row = cs ? (size_t)(kk >> 1) * SEQ + (SEQ - 2) + (kk & 1) : (size_t)TP + tt * 32 + q;
        const bf16* xr = Hall + row * D + 8 * hh;
        const bf16* wc = Wl + (size_t)crow * D + 8 * hh; const bf16* wx = wc + (size_t)128 * D; const bf16* wb = Wl + (size_t)(2048 + d) * D + 8 * hh;
        f32x16 ac, ax, ab;
#pragma unroll
        for (int i = 0; i < 16; ++i) { ac[i] = 0.f; ax[i] = 0.f; ab[i] = 0.f; }
        { bf16x8 fx[4], fc[4], fxx[4], fb[4], gx[4], gc[4], gxx[4], gb[4];
#pragma unroll
          for (int j = 0; j < 4; ++j) { fx[j] = *(const bf16x8*)(xr + 16 * j); fc[j] = *(const bf16x8*)(wc + 16 * j); fxx[j] = *(const bf16x8*)(wx + 16 * j); fb[j] = *(const bf16x8*)(wb + 16 * j); }
#pragma unroll 1
          for (int k0 = 0; k0 < 64; k0 += 8) {
#pragma unroll
              for (int j = 0; j < 4; ++j) { gx[j] = *(const bf16x8*)(xr + 16 * (k0 + 4 + j)); gc[j] = *(const bf16x8*)(wc + 16 * (k0 + 4 + j)); gxx[j] = *(const bf16x8*)(wx + 16 * (k0 + 4 + j)); gb[j] = *(const bf16x8*)(wb + 16 * (k0 + 4 + j)); }
              __builtin_amdgcn_sched_barrier(0);
#pragma unroll
              for (int j = 0; j < 4; ++j) { ac = MFMA32(fc[j], fx[j], ac); ax = MFMA32(fxx[j], fx[j], ax); ab = MFMA32(fb[j], fx[j], ab); }
              __builtin_amdgcn_sched_barrier(0);
              { const int kn = k0 + 8 < 64 ? k0 + 8 : 0;
#pragma unroll
                for (int j = 0; j < 4; ++j) { fx[j] = *(const bf16x8*)(xr + 16 * (kn + j)); fc[j] = *(const bf16x8*)(wc + 16 * (kn + j)); fxx[j] = *(const bf16x8*)(wx + 16 * (kn + j)); fb[j] = *(const bf16x8*)(wb + 16 * (kn + j)); } }
              __builtin_amdgcn_sched_barrier(0);
#pragma unroll
              for (int j = 0; j < 4; ++j) { ac = MFMA32(gc[j], gx[j], ac); ax = MFMA32(gxx[j], gx[j], ax); ab = MFMA32(gb[j], gx[j], ab); }
              __builtin_amdgcn_sched_barrier(0);
          } }
        if (cs) {
            float* cd = convp + (size_t)kk * D + 32 * dt + 4 * hh;
#pragma unroll
            for (int g = 0; g < 4; ++g) *(f32x4*)(cd + 8 * g) = (f32x4){ac[4 * g] * ax[4 * g], ac[4 * g + 1] * ax[4 * g + 1], ac[4 * g + 2] * ax[4 * g + 2], ac[4 * g + 3] * ax[4 * g + 3]};
        } else {
            const size_t ro = row * D + 32 * dt + 4 * hh;
#pragma unroll
            for (int g = 0; g < 4; ++g) { v2u wu, wb2; wu.x = pk2(ac[4 * g] * ax[4 * g], ac[4 * g + 1] * ax[4 * g + 1]); wu.y = pk2(ac[4 * g + 2] * ax[4 * g + 2], ac[4 * g + 3] * ax[4 * g + 3]);
                wb2.x = pk2(ab[4 * g], ab[4 * g + 1]); wb2.y = pk2(ab[4 * g + 2], ab[4 * g + 3]);
                *(v2u*)(U + ro + 8 * g) = wu; *(v2u*)(Bg + ro + 8 * g) = wb2; }
        }
    }
}
template <int MODE>
DI void sg_plain(const Ctx c, const bf16* Xs, const bf16* Wt, const int N, bf16* O, const bf16* Hres, bf16* O2, float* f0, float* f1) {
    const int q = c.lane & 31, hh = c.lane >> 5;
    for (int tile = c.wave * c.G + c.vcu; tile < 16 * (N / 32); tile += c.G * 8) {
        const int tt = tile & 15, ft = tile >> 4;
        const f32x16 acc = sg_tile(Wt + (size_t)(ft * 32 + q) * D + 8 * hh, Xs + (size_t)(tt * 32 + q) * D + 8 * hh);
        const int tl = tt * 32 + q;
#pragma unroll
        for (int g = 0; g < 4; ++g) { const int f = 32 * ft + 8 * g + 4 * hh; const f32x4 v = {acc[4 * g], acc[4 * g + 1], acc[4 * g + 2], acc[4 * g + 3]};
            if (MODE == 0) { v2u w; w.x = pk2(v[0], v[1]); w.y = pk2(v[2], v[3]); *(v2u*)(O + (size_t)(TP + tl) * D + f) = w; }
            else if (MODE == 1) { const v2u hw = *(const v2u*)(Hres + (size_t)(TP + tl) * D + f); const f32x4 r = (f32x4){bflo(hw.x), bfhi(hw.x), bflo(hw.y), bfhi(hw.y)} * ALPHA + v;
                v2u w; w.x = pk2(r[0], r[1]); w.y = pk2(r[2], r[3]); *(v2u*)(O + (size_t)(TP + tl) * D + f) = w; }
            else if (MODE == 2) { const bool isv = f >= 1024; const int fc = isv ? f - 1024 : f; v2u w; w.x = pk2(v[0], v[1]); w.y = pk2(v[2], v[3]);
                *(v2u*)((isv ? O2 : O) + (size_t)(TP + tl) * D + fc) = w; *(f32x4*)((isv ? f1 : f0) + (size_t)tl * D + fc) = v; }
            else { v2u w; w.x = pk2(v[0], v[1]); w.y = pk2(v[2], v[3]); *(v2u*)(O + (size_t)(TP + tl) * 2048 + f) = w; }
        }
    }
}

struct Args { const float* in[18]; float* out; unsigned char* ws; int ph_lo, ph_hi, li, pad; };
constexpr int N_PHASES = 2 + 2 * 10 + 12 + 10;
__global__ void __launch_bounds__(512, 2) fwd(Args args) {
    extern __shared__ __attribute__((aligned(16))) unsigned char lds_raw[];
    LAS unsigned char* lds = (LAS unsigned char*)lds_raw;
    Ctx c0; c0.tid = threadIdx.x; c0.lane = 0; c0.wave = __builtin_amdgcn_readfirstlane(c0.tid >> 6); c0.G = gridDim.x;
    { const int bx = blockIdx.x; c0.vcu = (c0.G % 8 == 0) ? (bx % 8) * (c0.G / 8) + bx / 8 : bx; }
    volatile LAS unsigned* MISC = (volatile LAS unsigned*)(lds + MISC_OFF);
    for (int u = c0.tid; u < (LDS_BYTES - RING_BYTES) / 4; u += 512) ((LAS unsigned*)(lds + RING_BYTES))[u] = 0u;
    __syncthreads();
    unsigned char* ws = args.ws; float* out = args.out;
    XcdBarrier bar = xcd_barrier_post((unsigned*)(ws + WS_CTL) + CW_BAR + args.li * XCD_BAR_WORDS, MISC + 8, c0.wave == 0 ? 1u : 0u);
#define WinT ((bf16*)(wsl + WS_WIN))
#define WoutT ((bf16*)(wsl + WS_WOUT))
#define WqT ((bf16*)(wsl + WS_WQ))
#define WoT ((bf16*)(wsl + WS_WO))
#define WkvT ((bf16*)(wsl + WS_WKV))
#define WP ((bf16*)(wsl + WS_WP))
#define W8A (wsl + WS_W8A)
#define SWA ((float*)(wsl + WS_SWA))
#define W8R(off) ((int)(((off) - WS_WIN) / 2048))
#define Vsn ((bf16*)(wsl + WS_VSN))
#define H ((bf16*)(wsl + WS_H))
#define Kb ((bf16*)(wsl + WS_KB))
#define VT ((bf16*)(wsl + WS_VT))
#define ids ((unsigned short*)(wsl + WS_IDS))
#define gates ((float*)(wsl + WS_GATE))
#define W8 (wsl + WS_W8)
#define SX ((float*)(wsl + WS_SX))
#define SW (SX + T)
#define X8 (wsl + WS_X8)
#define TU (wsl + WS_TU)
#define TV (wsl + WS_TV)
#define SU ((float*)(wsl + WS_SU))
#define SV (SU + 1)
#define A0 ((bf16*)(wsl + WS_A))
#define A1 ((bf16*)(wsl + WS_A + 129 * MiB))
#define ScT ((float*)(wsl + WS_A))
#define R A0
    const float* ln_g = args.in[16]; const float* ln_b = args.in[17];
    const int lo = args.ph_lo, hi = args.ph_hi; int ph = 0;
#ifndef PROBE_REPEAT
#define PROBE_REPEAT 0
#endif
#define PHASE_R(bit, body) do { const int nrep = 1 + ((PROBE_REPEAT >> (bit)) & 1); for (int rep = 0; rep < nrep; ++rep) { if (ph >= lo && ph < hi) { Ctx c = c0; c.lane = xb_lane_id(); c.tid = c0.wave * 64 + c.lane; unsigned long long wsi_ = (unsigned long long)ws; asm volatile("" : "+s"(wsi_)); unsigned char* wsl = (unsigned char*)(GAS unsigned char*)wsi_; body; if (ph + 1 < hi) { xcd_barrier(bar); if ((PROBE_REPEAT >> 20) & 1) xcd_barrier(bar); } } ++ph; } } while (0)
#define PHASE(body) PHASE_R(31, body)

    PHASE_R(4, ({ P0Args a{args.in[0], args.in[1], args.in[5], args.in[7], args.in[8], args.in[9], args.in[10], args.in[11], args.in[12], args.in[13], args.in[14], args.in[15],
                      WinT, WoutT, WqT, WoT, WkvT, WP, H, TU, TV, SU, SV, X8, SX}; p0_prologue(c, lds, a); }));

    PHASE(({ wp_quant_phase(c, WinT, W8A, SWA); }));

#pragma unroll 1
    for (int l = 0; l < NLAYER; ++l) {
        if (l < 2) {
            PHASE_R(8, ({ pg8::Gemm g{(const bf16*)X8, (const bf16*)(W8A + ((size_t)W8R(WS_WIN) + (size_t)l * 3072) * 1024), TP, 3072, 512}; pg8::StaticOrder S; S.init(TP, 3072, c.G, (int)blockIdx.x);
                     pg8::EpiGate<true> E{A0, A1, SX, SWA + W8R(WS_WIN) + l * 3072};
                     pg8::gemm_phase<pg8::EpiGate<true>, pg8::StaticOrder, true, true, true>(lds, g, S, E, c.tid);
                     sg_gate(c, H, WinT + (size_t)l * 3072 * 1024, A0, A1, out + O_CONVP + (size_t)l * NB * 2 * D); }));
            PHASE_R(13, ({ conv_gate_phase(c, A0, A1, args.in[6] + (size_t)l * 3 * D, args.in[2] + (size_t)l * NB * 2 * D, out + O_CONVP + (size_t)l * NB * 2 * D, out + O_CONVS + (size_t)l * NB * 2 * D, X8, SX, rep > 0); }));
        } else {
            if (l == 2) {
                PHASE_R(10, ({ pg8::Gemm g{(const bf16*)X8, (const bf16*)(W8A + (size_t)W8R(WS_WKV) * 1024), TP, 2048, 512}; pg8::StaticOrder S; S.init(TP, 2048, c.G, (int)blockIdx.x);
                         pg8::EpiKV<true> E{Kb, A1, out + O_KP, out + O_VP, out + O_KS, out + O_VS, SX, SWA + W8R(WS_WKV)};
                         pg8::gemm_phase<pg8::EpiKV<true>, pg8::StaticOrder, true, true, true>(lds, g, S, E, c.tid);
                         sg_plain<2>(c, H + (size_t)TP * D, WkvT, 2048, Kb, nullptr, A1, out + O_KS, out + O_VS); }));
                PHASE_R(14, ({ vt_phase(c, lds, A1, VT, Vsn); }));
            }
            PHASE_R(9, ({ pg8::Gemm g{(const bf16*)X8, (const bf16*)(W8A + ((size_t)W8R(WS_WQ) + (size_t)(l - 2) * 1024) * 1024), TP, 1024, 512}; pg8::StaticOrder S; S.init(TP, 1024, c.G, (int)blockIdx.x);
                     pg8::EpiBf16P<true> E{A0, 1024, SX, SWA + W8R(WS_WQ) + (l - 2) * 1024};
                     pg8::gemm_phase<pg8::EpiBf16P<true>, pg8::StaticOrder, true, true, true>(lds, g, S, E, c.tid);
                     sg_plain<0>(c, H + (size_t)TP * D, WqT + (size_t)(l - 2) * 1024 * 1024, 1024, A0, nullptr, nullptr, nullptr, nullptr); }));
            PHASE_R(11, ({ AttnT A{A0, A1, Kb, VT, Vsn, args.in[3], args.in[4]}; attn_phase(c, A); }));
        }
        if (l < 2) {
            PHASE_R(7, ({ pg8::Gemm g{(const bf16*)X8, (const bf16*)(W8A + ((size_t)W8R(WS_WOUT) + (size_t)l * 1024) * 1024), TP, 1024, 512}; pg8::StaticOrder S; S.init(TP, 1024, c.G, (int)blockIdx.x);
                     pg8::EpiRes<true> E{H, R, ALPHA, SX, SWA + W8R(WS_WOUT) + l * 1024};
                     pg8::gemm_phase<pg8::EpiRes<true>, pg8::StaticOrder, true, true, true>(lds, g, S, E, c.tid);
                     sg_plain<1>(c, A1 + (size_t)TP * D, WoutT + (size_t)l * 1024 * 1024, 1024, R, H, nullptr, nullptr, nullptr); }));
        } else {
            PHASE_R(7, ({ pg8::Gemm g{A1, WoT + (size_t)(l - 2) * 1024 * 1024, TP, 1024, 1024}; pg8::StaticOrder S; S.init(TP, 1024, c.G, (int)blockIdx.x);
                     pg8::EpiRes<false> E{H, R, ALPHA, nullptr, nullptr};
                     pg8::gemm_phase<pg8::EpiRes<false>, pg8::StaticOrder, true, true>(lds, g, S, E, c.tid);
                     sg_plain<1>(c, A1 + (size_t)TP * D, WoT + (size_t)(l - 2) * 1024 * 1024, 1024, R, H, nullptr, nullptr, nullptr); }));
        }
        PHASE_R(5, ({ ln_phase(c, R, H, ln_g + (size_t)(l * 2) * D, ln_b + (size_t)(l * 2) * D, nullptr, nullptr, X8, SX); }));
        PHASE_R(6, ({ pg8::Gemm g{(const bf16*)X8, (const bf16*)(W8A + ((size_t)W8R(WS_WP) + (size_t)l * 2048) * 1024), TP, 2048, 512}; pg8::StaticOrder S; S.init(TP, 2048, c.G, (int)blockIdx.x);
                 pg8::EpiScoreI8 E{(bf16*)ScT, 2048, SX, SWA + W8R(WS_WP) + l * 2048};
                 pg8::gemm_phase<pg8::EpiScoreI8, pg8::StaticOrder, true, true, true>(lds, g, S, E, c.tid);
                 sg_plain<3>(c, H + (size_t)TP * D, WP + (size_t)l * 2048 * 1024, 2048, (bf16*)ScT, nullptr, nullptr, nullptr, nullptr); }));
        PHASE_R(3, ({ topk_phase(c, (const bf16*)ScT, ids, gates); }));
        PHASE_R(0, ({ slice_pass<0>(c, X8, ids, W8, SW, TU + (size_t)l * NEXP * D, ScT  , (unsigned*)(ws + WS_CTL) + CW_Q + ((l * 2) * 2 + rep) * 512); }));
        PHASE_R(12, ({ peer_w_phase(c, ScT, ids, gates, W8, SW, SX, SU + (size_t)l * NEXP * 2, SV + (size_t)l * NEXP * 2); }));
        PHASE_R(1, ({ slice_pass<1>(c, X8, ids, W8, SW, TV + (size_t)l * NEXP * D, (float*)A0, (unsigned*)(ws + WS_CTL) + CW_Q + ((l * 2 + 1) * 2 + rep) * 512); }));
        PHASE(({ ln_phase(c, A0, H, ln_g + (size_t)(l * 2 + 1) * D, ln_b + (size_t)(l * 2 + 1) * D, l == NLAYER - 1 ? out : nullptr, H, X8, SX); }));
#if defined(PROBE_SLICE) && PROBE_SLICE == 1
        PHASE(({ slice_pass<0, 1>(c, X8, ids, W8, SW, TU + (size_t)l * NEXP * D, ScT, (unsigned*)(ws + WS_CTL) + CW_Q + ((l * 2) * 2 + 1) * 512); }));
#elif defined(PROBE_SLICE) && PROBE_SLICE == 2
        PHASE(({ slice_pass<0, 2>(c, X8, ids, W8, SW, TU + (size_t)l * NEXP * D, ScT, (unsigned*)(ws + WS_CTL) + CW_Q + ((l * 2) * 2 + 1) * 512); }));
#elif defined(PROBE_SLICE) && PROBE_SLICE == 3
        PHASE(({ slice_pass<1, 1>(c, X8, ids, W8, SW, TV + (size_t)l * NEXP * D, ScT, (unsigned*)(ws + WS_CTL) + CW_Q + ((l * 2) * 2 + 1) * 512); }));
#elif defined(PROBE_SLICE) && PROBE_SLICE == 4
        PHASE(({ slice_pass<1, 2>(c, X8, ids, W8, SW, TV + (size_t)l * NEXP * D, ScT, (unsigned*)(ws + WS_CTL) + CW_Q + ((l * 2) * 2 + 1) * 512); }));
#endif
    }
#undef PHASE
#undef PHASE_R
#undef WinT
#undef WoutT
#undef WqT
#undef WoT
#undef WkvT
#undef WP
#undef W8A
#undef SWA
#undef W8R
#undef Vsn
#undef H
#undef Kb
#undef VT
#undef ids
#undef gates
#undef W8
#undef SX
#undef SW
#undef X8
#undef TU
#undef TV
#undef SU
#undef SV
#undef A0
#undef A1
#undef ScT
#undef R
}

#ifndef N_LAUNCH_MODE
#define N_LAUNCH_MODE 1
#endif
extern "C" void kernel_launch(void* const* d_in, const int* in_sizes, int n_in, void* d_out, int out_size, void* d_ws, size_t ws_size, hipStream_t stream) {
    static int grid = 0;
    if (grid == 0) {
        if (n_in != 18 || in_sizes[0] != TP * D || (size_t)out_size != O_END || ws_size < WS_END) {
            fprintf(stderr, "kernel_launch: shape mismatch: n_in %d in0 %d out %d ws %zu (need %zu)\n", n_in, n_in > 0 ? in_sizes[0] : -1, out_size, ws_size, (size_t)WS_END); grid = -1; return; }
        int dev = 0, cus = 0, per_cu = 0;
        if (hipGetDevice(&dev) != hipSuccess || hipDeviceGetAttribute(&cus, hipDeviceAttributeMultiprocessorCount, dev) != hipSuccess) { grid = -1; return; }
        if (hipFuncSetAttribute((const void*)fwd, hipFuncAttributeMaxDynamicSharedMemorySize, LDS_BYTES) != hipSuccess) { fprintf(stderr, "kernel_launch: hipFuncSetAttribute failed\n"); grid = -1; return; }
        if (hipOccupancyMaxActiveBlocksPerMultiprocessor(&per_cu, (const void*)fwd, 512, LDS_BYTES) != hipSuccess || per_cu < 1) { fprintf(stderr, "kernel_launch: occupancy query says %d\n", per_cu); }
        (void)hipGetLastError();
        grid = cus;
    }
    if (grid < 0) return;
    (void)hipMemsetAsync((char*)d_ws + WS_CTL, 0, CTL_BYTES, stream);
    Args a{};
    for (int i = 0; i < 18; ++i) a.in[i] = (const float*)d_in[i];
    a.out = (float*)d_out; a.ws = (unsigned char*)d_ws; a.pad = 0;
#if N_LAUNCH_MODE == 1
    a.ph_lo = 0; a.ph_hi = 1 << 30; a.li = 0;
    hipLaunchKernelGGL(fwd, dim3(grid), dim3(512), LDS_BYTES, stream, a);
#else
    for (int p = 0; p < N_PHASES; ++p) { a.ph_lo = p; a.ph_hi = p + 1; a.li = p; hipLaunchKernelGGL(fwd, dim3(grid), dim3(512), LDS_BYTES, stream, a); }
#endif
}
```

```cpp
#include <hip/hip_runtime.h>
#include <cstdio>
#include <cstdint>
namespace pg8 {
#define PG8_LAS __attribute__((address_space(3)))
typedef unsigned short bf16_t;
typedef short bf16x8 __attribute__((ext_vector_type(8)));
typedef float f32x4 __attribute__((ext_vector_type(4)));
typedef unsigned u32x4 __attribute__((ext_vector_type(4)));
constexpr int BM = 256, BK = 64, HALF = 128, HTB = HALF * BK * 2  , STAGE_BYTES = 8 * HTB, NXCD = 8, WGM = 8;

__host__ __device__ __forceinline__ int lds_byte(int r, int c) { const int st = (r >> 4) * 2 + (c >> 5), rr = r & 15, cc = c & 31, ob = rr * 64 + cc * 2; return st * 1024 + (ob ^ (((ob >> 9) & 1) << 5)); }
__host__ __device__ __forceinline__ void stage_rc(int b, int& R, int& C) { const int st = b / 1024, sb = b % 1024, swz = sb ^ (((sb >> 9) & 1) << 5); R = (st >> 1) * 16 + swz / 64; C = (st & 1) * 32 + (swz % 64) / 2; }
__host__ __device__ __forceinline__ int perm32(int rho) { const int n = rho >> 4, i = rho & 15; return 8 * (i >> 2) + 4 * n + (i & 3); }

struct Unit { int pm, pn; };
struct Gemm { const bf16_t* A; const bf16_t* Bt; int M, N, K; };

struct StaticOrder {
    int nM, nN, nwg, G, c;
    __host__ __device__ void init(int M, int N, int G_, int c_) { nM = M / BM; nN = N / BM; nwg = nM * nN; G = G_; c = c_; }
    __host__ __device__ bool next(int i, Unit& u) const {
        const long L = (long)i * G + c; if (L >= nwg) return false;
        int wgid = (int)L; { const int q = nwg / NXCD, r = nwg % NXCD, xcd = wgid % NXCD, off = wgid / NXCD; wgid = (xcd < r ? xcd * (q + 1) : r * (q + 1) + (xcd - r) * q) + off; }
        const int nig = WGM * nN, gid = wgid / nig, fm = gid * WGM, gsz = (nM - fm) < WGM ? (nM - fm) : WGM;
        u.pm = fm + ((wgid % nig) % gsz); u.pn = (wgid % nig) / gsz; return true;
    }
    __device__ __forceinline__ void a_ready(const Unit&) const {}
    __device__ __forceinline__ void done(const Unit&) const {}
};

typedef float f32x2 __attribute__((ext_vector_type(2)));
typedef __bf16 bf16x2v __attribute__((ext_vector_type(2)));
typedef unsigned u32x2 __attribute__((ext_vector_type(2)));
__device__ __forceinline__ unsigned pk2(float lo, float hi) { const bf16x2v v = __builtin_convertvector((f32x2){lo, hi}, bf16x2v); return __builtin_bit_cast(unsigned, v); }
__device__ __forceinline__ u32x4 pk8(const f32x4 a, const f32x4 b) { u32x4 w; w.x = pk2(a[0], a[1]); w.y = pk2(a[2], a[3]); w.z = pk2(b[0], b[1]); w.w = pk2(b[2], b[3]); return w; }

typedef int i32x4 __attribute__((ext_vector_type(4)));
template <bool I8> struct AccT { typedef f32x4 type; static __device__ __forceinline__ type zero() { return (f32x4){0.f, 0.f, 0.f, 0.f}; } };
template <> struct AccT<true> { typedef i32x4 type; static __device__ __forceinline__ type zero() { return (i32x4){0, 0, 0, 0}; } };
__device__ __forceinline__ f32x4 mma16(const bf16x8 b, const bf16x8 a, const f32x4 c) { return __builtin_amdgcn_mfma_f32_16x16x32_bf16(b, a, c, 0, 0, 0); }
__device__ __forceinline__ i32x4 mma16(const bf16x8 b, const bf16x8 a, const i32x4 c) { return __builtin_amdgcn_mfma_i32_16x16x64_i8(__builtin_bit_cast(i32x4, b), __builtin_bit_cast(i32x4, a), c, 0, 0, 0); }
__device__ __forceinline__ f32x4 dq4(const f32x4 a, const float, const f32x4) { return a; }
__device__ __forceinline__ f32x4 dq4(const i32x4 a, const float ra, const f32x4 cb) { return (f32x4){(float)a[0], (float)a[1], (float)a[2], (float)a[3]} * ra * cb; }
constexpr int TOK_P = 65536;

template <bool I8> struct EpiBf16P {
    static constexpr bool PERM = true, AFTER_DRAIN = false;
    bf16_t* O; int ldc; const float* sa; const float* sb;
    __device__ __forceinline__ void operator()(const typename AccT<I8>::type (&acc)[2][2][4][2], const Unit& u, int wr, int wc, int fr, int fq) const {
        const int row0 = u.pm * BM + wr * 64 + fr, col0 = u.pn * BM + wc * 32 + 8 * fq;
        f32x4 cb[2][2];
#pragma unroll
        for (int bj = 0; bj < 2; ++bj)
#pragma unroll
            for (int n = 0; n < 2; ++n) cb[bj][n] = I8 ? *(const f32x4*)(sb + col0 + bj * HALF + 4 * n) : (f32x4){1.f, 1.f, 1.f, 1.f};
        float rs[2][4];
#pragma unroll
        for (int ai = 0; ai < 2; ++ai)
#pragma unroll
            for (int m = 0; m < 4; ++m) rs[ai][m] = I8 ? sa[row0 + ai * HALF + m * 16] : 1.f;
        __builtin_amdgcn_sched_barrier(0);
#pragma unroll
        for (int ai = 0; ai < 2; ++ai)
#pragma unroll
            for (int m = 0; m < 4; ++m) { const int row = row0 + ai * HALF + m * 16; const float ra = rs[ai][m]; bf16_t* rowp = O + (size_t)row * ldc + col0;
#pragma unroll
                for (int bj = 0; bj < 2; ++bj) *(u32x4*)(rowp + bj * HALF) = pk8(dq4(acc[ai][bj][m][0], ra, cb[bj][0]), dq4(acc[ai][bj][m][1], ra, cb[bj][1])); }
    }
};
template <bool I8> struct EpiGate {
    static constexpr bool PERM = true, AFTER_DRAIN = false;
    bf16_t* U; bf16_t* Bg; const float* sa; const float* sb;
    __device__ __forceinline__ void operator()(const typename AccT<I8>::type (&acc)[2][2][4][2], const Unit& u, int wr, int wc, int fr, int fq) const {
        const int row0 = u.pm * BM + wr * 64 + fr, scol0 = u.pn * BM + wc * 32 + 8 * fq;
        f32x4 cb[2][2];
#pragma unroll
        for (int bj = 0; bj < 2; ++bj)
#pragma unroll
            for (int n = 0; n < 2; ++n) cb[bj][n] = I8 ? *(const f32x4*)(sb + scol0 + bj * HALF + 4 * n) : (f32x4){1.f, 1.f, 1.f, 1.f};
        float rs[2][4];
#pragma unroll
        for (int ai = 0; ai < 2; ++ai)
#pragma unroll
            for (int m = 0; m < 4; ++m) rs[ai][m] = I8 ? sa[row0 + ai * HALF + m * 16] : 1.f;
        __builtin_amdgcn_sched_barrier(0);
        if (u.pn < 8) {
            const int col0 = u.pn * HALF + wc * 32 + 8 * fq;
#pragma unroll
            for (int ai = 0; ai < 2; ++ai)
#pragma unroll
                for (int m = 0; m < 4; ++m) { const int row = row0 + ai * HALF + m * 16; const float ra = rs[ai][m];
                    const f32x4 v0 = dq4(acc[ai][0][m][0], ra, cb[0][0]) * dq4(acc[ai][1][m][0], ra, cb[1][0]), v1 = dq4(acc[ai][0][m][1], ra, cb[0][1]) * dq4(acc[ai][1][m][1], ra, cb[1][1]);
                    *(u32x4*)(U + (size_t)row * 1024 + col0) = pk8(v0, v1); }
        } else {
            const int col0 = (u.pn - 8) * BM + wc * 32 + 8 * fq;
#pragma unroll
            for (int ai = 0; ai < 2; ++ai)
#pragma unroll
                for (int m = 0; m < 4; ++m) { const int row = row0 + ai * HALF + m * 16; const float ra = rs[ai][m]; bf16_t* rowp = Bg + (size_t)row * 1024 + col0;
#pragma unroll
                    for (int bj = 0; bj < 2; ++bj) *(u32x4*)(rowp + bj * HALF) = pk8(dq4(acc[ai][bj][m][0], ra, cb[bj][0]), dq4(acc[ai][bj][m][1], ra, cb[bj][1])); }
        }
    }
};
template <bool I8> struct EpiRes {
    static constexpr bool PERM = true, AFTER_DRAIN = false;
    const bf16_t* H; bf16_t* R; float alpha; const float* sa; const float* sb;
    __device__ __forceinline__ void operator()(const typename AccT<I8>::type (&acc)[2][2][4][2], const Unit& u, int wr, int wc, int fr, int fq) const {
        const int row0 = u.pm * BM + wr * 64 + fr, col0 = u.pn * BM + wc * 32 + 8 * fq;
        f32x4 cb[2][2];
#pragma unroll
        for (int bj = 0; bj < 2; ++bj)
#pragma unroll
            for (int n = 0; n < 2; ++n) cb[bj][n] = I8 ? *(const f32x4*)(sb + col0 + bj * HALF + 4 * n) : (f32x4){1.f, 1.f, 1.f, 1.f};
        float rs[2][4];
#pragma unroll
        for (int ai = 0; ai < 2; ++ai)
#pragma unroll
            for (int m = 0; m < 4; ++m) rs[ai][m] = I8 ? sa[row0 + ai * HALF + m * 16] : 1.f;
        __builtin_amdgcn_sched_barrier(0);
#pragma unroll
        for (int ai = 0; ai < 2; ++ai) {
            u32x4 hq[4][2];
#pragma unroll
            for (int m = 0; m < 4; ++m)
#pragma unroll
                for (int bj = 0; bj < 2; ++bj) hq[m][bj] = *(const u32x4*)(H + (size_t)(row0 + ai * HALF + m * 16) * 1024 + col0 + bj * HALF);
            __builtin_amdgcn_sched_barrier(0);
#pragma unroll
            for (int m = 0; m < 4; ++m) { const int row = row0 + ai * HALF + m * 16; const float ra = rs[ai][m]; const size_t off = (size_t)row * 1024 + col0;
#pragma unroll
                for (int bj = 0; bj < 2; ++bj) { const u32x4 h = hq[m][bj];
                    f32x4 h0, h1; h0[0] = __uint_as_float(h.x << 16); h0[1] = __uint_as_float(h.x & 0xffff0000u); h0[2] = __uint_as_float(h.y << 16); h0[3] = __uint_as_float(h.y & 0xffff0000u);
                    h1[0] = __uint_as_float(h.z << 16); h1[1] = __uint_as_float(h.z & 0xffff0000u); h1[2] = __uint_as_float(h.w << 16); h1[3] = __uint_as_float(h.w & 0xffff0000u);
                    *(u32x4*)(R + off + bj * HALF) = pk8(h0 * alpha + dq4(acc[ai][bj][m][0], ra, cb[bj][0]), h1 * alpha + dq4(acc[ai][bj][m][1], ra, cb[bj][1])); } } }
    }
};
template <bool I8> struct EpiKV {
    static constexpr bool PERM = true, AFTER_DRAIN = false;
    bf16_t* Kb; bf16_t* Vb; float* kp; float* vp; float* ks; float* vs; const float* sa; const float* sb;
    __device__ __forceinline__ void operator()(const typename AccT<I8>::type (&acc)[2][2][4][2], const Unit& u, int wr, int wc, int fr, int fq) const {
        const bool isv = u.pn >= 4; const int colt = (isv ? u.pn - 4 : u.pn) * BM;
        bf16_t* ob = isv ? Vb : Kb; const bool samp = u.pm * BM >= TOK_P;
        float* of = samp ? (isv ? vs : ks) - (size_t)TOK_P * 1024 : (isv ? vp : kp);
        const int row0 = u.pm * BM + wr * 64 + fr, col0 = colt + wc * 32 + 8 * fq, scol0 = u.pn * BM + wc * 32 + 8 * fq;
        float rs[2][4];
#pragma unroll
        for (int ai = 0; ai < 2; ++ai)
#pragma unroll
            for (int m = 0; m < 4; ++m) rs[ai][m] = I8 ? sa[row0 + ai * HALF + m * 16] : 1.f;
        f32x4 cb[2][2];
#pragma unroll
        for (int bj = 0; bj < 2; ++bj)
#pragma unroll
            for (int n = 0; n < 2; ++n) cb[bj][n] = I8 ? *(const f32x4*)(sb + scol0 + bj * HALF + 4 * n) : (f32x4){1.f, 1.f, 1.f, 1.f};
#pragma unroll
        for (int ai = 0; ai < 2; ++ai)
#pragma unroll
            for (int m = 0; m < 4; ++m) { const int row = row0 + ai * HALF + m * 16; const float ra = rs[ai][m]; const size_t off = (size_t)row * 1024 + col0;
#pragma unroll
                for (int bj = 0; bj < 2; ++bj) { const f32x4 v0 = dq4(acc[ai][bj][m][0], ra, cb[bj][0]), v1 = dq4(acc[ai][bj][m][1], ra, cb[bj][1]);
                    *(u32x4*)(ob + off + bj * HALF) = pk8(v0, v1); *(f32x4*)(of + off + bj * HALF) = v0; *(f32x4*)(of + off + bj * HALF + 4) = v1; } }
    }
};

struct EpiScoreI8 {
    static constexpr bool PERM = true, AFTER_DRAIN = false;
    bf16_t* O; int ldc; const float* sa; const float* sb;
    __device__ __forceinline__ void operator()(const i32x4 (&acc)[2][2][4][2], const Unit& u, int wr, int wc, int fr, int fq) const {
        const int row0 = u.pm * BM + wr * 64 + fr, col0 = u.pn * BM + wc * 32 + 8 * fq;
        f32x4 cb[2][2];
#pragma unroll
        for (int bj = 0; bj < 2; ++bj)
#pragma unroll
            for (int n = 0; n < 2; ++n) cb[bj][n] = *(const f32x4*)(sb + col0 + bj * HALF + 4 * n);
        float rs[2][4];
#pragma unroll
        for (int ai = 0; ai < 2; ++ai)
#pragma unroll
            for (int m = 0; m < 4; ++m) rs[ai][m] = sa[row0 + ai * HALF + m * 16];
        __builtin_amdgcn_sched_barrier(0);
#pragma unroll
        for (int ai = 0; ai < 2; ++ai)
#pragma unroll
            for (int m = 0; m < 4; ++m) { const int row = row0 + ai * HALF + m * 16; const float ra = rs[ai][m]; bf16_t* rowp = O + (size_t)row * ldc + col0;
#pragma unroll
                for (int bj = 0; bj < 2; ++bj) { f32x4 v0, v1;
#pragma unroll
                    for (int i = 0; i < 4; ++i) { v0[i] = (float)acc[ai][bj][m][0][i] * ra * cb[bj][0][i]; v1[i] = (float)acc[ai][bj][m][1][i] * ra * cb[bj][1][i]; }
                    *(u32x4*)(rowp + bj * HALF) = pk8(v0, v1); } }
    }
};

template <class Epi, class Sched, bool ALIGN_EPI = false, bool SP2 = false, bool I8 = false>
__device__ __forceinline__ void gemm_phase(PG8_LAS unsigned char* lds, const Gemm g, const Sched& S, const Epi& E, const int tid_in) {
    int tid_ = tid_in; asm volatile("" : "+v"(tid_));
    const int tid = tid_, wid = __builtin_amdgcn_readfirstlane(tid >> 6), lane = tid & 63, wr = wid >> 2, wc = wid & 3, fr = lane & 15, fq = lane >> 4;
    const int K = g.K, nt = K / BK;
    unsigned voffA[2], voffB[2];
#pragma unroll
    for (int i = 0; i < 2; ++i) { int R, C; stage_rc(tid * 16 + i * 8192, R, C); const int Rb = Epi::PERM ? ((R & ~31) + perm32(R & 31)) : R;
        voffA[i] = (unsigned)(R * K + C) * 2u; voffB[i] = (unsigned)(Rb * K + C) * 2u; }
    const size_t kstep = (size_t)(BK * 2);
    const size_t hstep = (size_t)HALF * K * 2;
    const size_t tstep = 2 * hstep;
    const unsigned ldsw = (unsigned)wid * 1024u;
    const int aoff = lds_byte(wr * 64 + fr, fq * 8), boff = lds_byte(wc * 32 + fr, fq * 8);
#define PG8_SA(b, h) (((b) * 2 + (h)) * HTB)
#define PG8_SB(b, h) ((4 + (b) * 2 + (h)) * HTB)
#define PG8_STAGE(bufoff, gbase, voff) do { _Pragma("unroll") for (int _i = 0; _i < 2; ++_i) \
        __builtin_amdgcn_global_load_lds((const unsigned*)((const char*)(gbase) + (voff)[_i]), (PG8_LAS unsigned*)(lds + (bufoff) + ldsw + _i * 8192), 16, 0, 0); } while (0)
#define PG8_LDA(dst, b, h) do { _Pragma("unroll") for (int m = 0; m < 4; ++m) _Pragma("unroll") for (int k = 0; k < 2; ++k) dst[m][k] = *(const PG8_LAS bf16x8*)(lds + PG8_SA(b, h) + aoff + m * 2048 + k * 1024); } while (0)
#define PG8_LDB(dst, b, h) do { _Pragma("unroll") for (int n = 0; n < 2; ++n) _Pragma("unroll") for (int k = 0; k < 2; ++k) dst[n][k] = *(const PG8_LAS bf16x8*)(lds + PG8_SB(b, h) + boff + n * 2048 + k * 1024); } while (0)
#define PG8_MMA(ai, bj, At, Bt) do { __builtin_amdgcn_s_setprio(1); _Pragma("unroll") for (int m = 0; m < 4; ++m) _Pragma("unroll") for (int n = 0; n < 2; ++n) _Pragma("unroll") for (int k = 0; k < 2; ++k) \
        acc[ai][bj][m][n] = mma16(Bt[n][k], At[m][k], acc[ai][bj][m][n]); __builtin_amdgcn_s_setprio(0); } while (0)
#define PG8_WAIT_V(n) asm volatile("s_waitcnt vmcnt(" #n ")" ::: "memory")
#define PG8_WAIT_L(n) asm volatile("s_waitcnt lgkmcnt(" #n ")" ::: "memory")
#define PG8_BAR __builtin_amdgcn_s_barrier()
#define PG8_SCHED __builtin_amdgcn_sched_barrier(0)
    Unit cur, nxt; int ui = 0;
    if (!S.next(0, cur)) return;
    typename AccT<I8>::type acc[2][2][4][2];
#pragma unroll
    for (int a = 0; a < 2; ++a)
#pragma unroll
        for (int b = 0; b < 2; ++b)
#pragma unroll
            for (int m = 0; m < 4; ++m)
#pragma unroll
                for (int n = 0; n < 2; ++n) acc[a][b][m][n] = AccT<I8>::zero();
    bf16x8 At[4][2], B0[2][2], B1[2][2];
    const char* cA = (const char*)g.A + (size_t)cur.pm * tstep; const char* cB = (const char*)g.Bt + (size_t)cur.pn * tstep;
    S.a_ready(cur);
    if constexpr (SP2) {
        PG8_STAGE(PG8_SB(0, 0), cB, voffB); PG8_STAGE(PG8_SB(0, 1), cB + hstep, voffB); PG8_STAGE(PG8_SA(0, 0), cA, voffA); PG8_STAGE(PG8_SA(0, 1), cA + hstep, voffA);
        if (wr == 1) PG8_BAR;
        PG8_WAIT_V(2); PG8_BAR;
        PG8_STAGE(PG8_SB(1, 0), cB + kstep, voffB); PG8_STAGE(PG8_SA(1, 0), cA + kstep, voffA); PG8_STAGE(PG8_SB(1, 1), cB + hstep + kstep, voffB);
        PG8_WAIT_V(6); PG8_BAR;
    } else {
        PG8_STAGE(PG8_SB(0, 0), cB, voffB); PG8_STAGE(PG8_SA(0, 0), cA, voffA); PG8_STAGE(PG8_SB(0, 1), cB + hstep, voffB); PG8_STAGE(PG8_SA(0, 1), cA + hstep, voffA);
        if (wr == 1) PG8_BAR;
        PG8_WAIT_V(4); PG8_BAR;
        PG8_STAGE(PG8_SB(1, 0), cB + kstep, voffB); PG8_STAGE(PG8_SA(1, 0), cA + kstep, voffA); PG8_STAGE(PG8_SB(1, 1), cB + hstep + kstep, voffB);
        PG8_WAIT_V(6); PG8_BAR;
    }
    for (;;) {
        const bool has_next = S.next(ui + 1, nxt);
        const char* nA = has_next ? (const char*)g.A + (size_t)nxt.pm * tstep : cA; const char* nB = has_next ? (const char*)g.Bt + (size_t)nxt.pn * tstep : cB;
        for (int t = 0; t < nt; t += 2) {
            const bool last = (t == nt - 2);
            const char* a1 = cA + (size_t)(t + 1) * kstep;
            const char* a2 = last ? nA : cA + (size_t)(t + 2) * kstep; const char* b2 = last ? nB : cB + (size_t)(t + 2) * kstep;
            const char* a3 = a2 + kstep; const char* b3 = b2 + kstep;
            if (last && has_next) S.a_ready(nxt);
            if constexpr (SP2) {
            PG8_LDB(B0, 0, 0); PG8_LDB(B1, 0, 1); PG8_SCHED; PG8_LDA(At, 0, 0); PG8_STAGE(PG8_SA(1, 1), a1 + hstep, voffA);
            PG8_WAIT_V(8); PG8_WAIT_L(0); PG8_BAR; PG8_MMA(0, 0, At, B0); PG8_MMA(0, 1, At, B1); PG8_BAR; PG8_SCHED;
            PG8_LDA(At, 0, 1); PG8_STAGE(PG8_SB(0, 0), b2, voffB); PG8_STAGE(PG8_SB(0, 1), b2 + hstep, voffB); PG8_STAGE(PG8_SA(0, 0), a2, voffA);
            PG8_WAIT_V(8); PG8_WAIT_L(0); PG8_BAR; PG8_MMA(1, 0, At, B0); PG8_MMA(1, 1, At, B1); PG8_BAR; PG8_SCHED;
            PG8_LDB(B0, 1, 0); PG8_LDB(B1, 1, 1); PG8_SCHED; PG8_LDA(At, 1, 0); PG8_STAGE(PG8_SA(0, 1), a2 + hstep, voffA);
            PG8_WAIT_V(8); PG8_WAIT_L(0); PG8_BAR; PG8_MMA(0, 0, At, B0); PG8_MMA(0, 1, At, B1); PG8_BAR; PG8_SCHED;
            PG8_LDA(At, 1, 1); PG8_STAGE(PG8_SB(1, 0), b3, voffB); PG8_STAGE(PG8_SB(1, 1), b3 + hstep, voffB); PG8_STAGE(PG8_SA(1, 0), a3, voffA);
            PG8_WAIT_V(8); PG8_WAIT_L(0); PG8_BAR; PG8_MMA(1, 0, At, B0); PG8_MMA(1, 1, At, B1); PG8_BAR; PG8_SCHED;
            } else {
            PG8_LDB(B0, 0, 0); PG8_SCHED; PG8_LDA(At, 0, 0); PG8_STAGE(PG8_SA(1, 1), a1 + hstep, voffA);
            PG8_WAIT_L(8); PG8_BAR; PG8_WAIT_L(0); PG8_MMA(0, 0, At, B0); PG8_BAR; PG8_SCHED;
            PG8_LDB(B1, 0, 1); PG8_STAGE(PG8_SB(0, 0), b2, voffB);
            PG8_BAR; PG8_WAIT_L(0); PG8_MMA(0, 1, At, B1); PG8_BAR;
            PG8_LDA(At, 0, 1); PG8_STAGE(PG8_SA(0, 0), a2, voffA);
            PG8_BAR; PG8_WAIT_L(0); PG8_MMA(1, 0, At, B0); PG8_BAR; PG8_SCHED;
            PG8_STAGE(PG8_SB(0, 1), b2 + hstep, voffB);
            PG8_WAIT_V(6); PG8_BAR; PG8_MMA(1, 1, At, B1); PG8_BAR;
            PG8_LDB(B0, 1, 0); PG8_SCHED; PG8_LDA(At, 1, 0); PG8_STAGE(PG8_SA(0, 1), a2 + hstep, voffA);
            PG8_WAIT_L(8); PG8_BAR; PG8_WAIT_L(0); PG8_MMA(0, 0, At, B0); PG8_BAR; PG8_SCHED;
            PG8_LDB(B1, 1, 1); PG8_STAGE(PG8_SB(1, 0), b3, voffB);
            PG8_BAR; PG8_WAIT_L(0); PG8_MMA(0, 1, At, B1); PG8_BAR;
            PG8_LDA(At, 1, 1); PG8_STAGE(PG8_SA(1, 0), a3, voffA);
            PG8_BAR; PG8_WAIT_L(0); PG8_MMA(1, 0, At, B0); PG8_BAR; PG8_SCHED;
            PG8_STAGE(PG8_SB(1, 1), b3 + hstep, voffB);
            PG8_WAIT_V(6); PG8_BAR; PG8_MMA(1, 1, At, B1); PG8_BAR;
            }
        }
        if constexpr (ALIGN_EPI) { if (wr == 0) PG8_BAR; }
        if constexpr (!Epi::AFTER_DRAIN) { E(acc, cur, wr, wc, fr, fq); S.done(cur); }
        if (!has_next) break;
#pragma unroll
        for (int a = 0; a < 2; ++a)
#pragma unroll
            for (int b = 0; b < 2; ++b)
#pragma unroll
                for (int m = 0; m < 4; ++m)
#pragma unroll
                    for (int n = 0; n < 2; ++n) acc[a][b][m][n] = AccT<I8>::zero();
        cur = nxt; cA = nA; cB = nB; ++ui;
        if constexpr (ALIGN_EPI) { if (wr == 1) PG8_BAR; }
    }
    PG8_WAIT_V(0);
    if constexpr (!ALIGN_EPI) { if (wr == 0) PG8_BAR; }
    PG8_BAR;
    if constexpr (Epi::AFTER_DRAIN) { E.fused(acc, cur, wr, wc, fr, fq, lds, wid, lane); S.done(cur); }
#undef PG8_SA
#undef PG8_SB
#undef PG8_STAGE
#undef PG8_LDA
#undef PG8_LDB
#undef PG8_MMA
#undef PG8_WAIT_V
#undef PG8_WAIT_L
#undef PG8_BAR
#undef PG8_SCHED
}
}

#define GAS __attribute__((address_space(1)))
#define LAS __attribute__((address_space(3)))
#define DI __device__ __forceinline__
typedef unsigned short bf16;
typedef unsigned v4u __attribute__((ext_vector_type(4)));
typedef unsigned v2u __attribute__((ext_vector_type(2)));
typedef float f32x4 __attribute__((ext_vector_type(4)));
typedef float f32x16 __attribute__((ext_vector_type(16)));
typedef short bf16x8 __attribute__((ext_vector_type(8)));
using pg8::pk2;
#define LDS_WAIT() asm volatile("s_waitcnt lgkmcnt(0)" ::: "memory")
#define MFMA32(a, b, c) __builtin_amdgcn_mfma_f32_32x32x16_bf16((a), (b), (c), 0, 0, 0)

constexpr int D = 1024, NB = 32, SEQ = 2048, DSEQ = 16, PAST = 1024, NH = 16, DH = 64;
constexpr int TP = NB * SEQ, TS = NB * DSEQ, T = TP + TS;
constexpr int NEXP = 16384, PH = 8, PK = 16;
constexpr int NLAYER = 4;
constexpr float LN_EPS = 1e-5f;
constexpr float ALPHA = 1.6817928305074292f;
constexpr float LOG2E = 1.4426950408889634f, LN2 = 0.6931471805599453f;
static_assert(T % 256 == 0 && pg8::TOK_P == TP, "row panels");
constexpr size_t O_Y = 0, O_YS = (size_t)TP * D, O_CONVP = O_YS + (size_t)TS * D, O_KP = O_CONVP + 2 * NB * 2 * D, O_VP = O_KP + (size_t)TP * D,
                 O_CONVS = O_VP + (size_t)TP * D, O_KS = O_CONVS + 2 * NB * 2 * D, O_VS = O_KS + (size_t)TS * D, O_END = O_VS + (size_t)TS * D;
static_assert(O_END == 203161600ull, "output size");
constexpr size_t MiB = 1u << 20;
constexpr size_t WS_CTL = 0, CTL_BYTES = 2 * MiB;
constexpr size_t WS_WIN = 2 * MiB;
constexpr size_t WS_WOUT = WS_WIN + 12 * MiB;
constexpr size_t WS_WQ = WS_WOUT + 4 * MiB;
constexpr size_t WS_WO = WS_WQ + 4 * MiB;
constexpr size_t WS_WKV = WS_WO + 4 * MiB;
constexpr size_t WS_WP = WS_WKV + 4 * MiB;
constexpr size_t WS_VSN = WS_WP + 16 * MiB;
constexpr size_t WS_H = WS_VSN + 1 * MiB;
constexpr size_t WS_KB = WS_H + 129 * MiB;
constexpr size_t WS_VT = WS_KB + 129 * MiB;
constexpr size_t WS_IDS = WS_VT + 128 * MiB;
constexpr size_t WS_GATE = WS_IDS + 17 * MiB;
constexpr size_t WS_TU = WS_GATE + 33 * MiB;
constexpr size_t WS_TV = WS_TU + 64 * MiB;
constexpr size_t WS_SU = WS_TV + 64 * MiB;
constexpr size_t WS_W8 = WS_SU + 1 * MiB;
constexpr size_t WS_SX = WS_W8 + 9 * MiB;
constexpr size_t WS_X8 = WS_SX + 1 * MiB;
constexpr size_t WS_W8A = WS_X8 + 65 * MiB;
constexpr size_t WS_SWA = WS_W8A + 22 * MiB;
constexpr int W8_ROWS = (int)((WS_VSN - WS_WIN) / 2048);
static_assert(W8_ROWS == 22528, "weight rows");
constexpr size_t WS_A = WS_SWA + 1 * MiB;
constexpr size_t WS_END = WS_A + 258 * MiB;
static_assert((size_t)T * D * 2 == 129 * MiB && (size_t)1024 * T * 4 == 258 * MiB, "sizes");
constexpr int CW_Q = 1024;
constexpr int CW_BAR = 16384;

constexpr int RING_BYTES = 131072, MISC_OFF = RING_BYTES + 320, LDS_BYTES = 147456;

#define XB_TMO      128
#define XB_XCNT(j)  (256  + 64 * (j))
#define XB_XSUB(j)  (1280 + 64 * (j))
#define XB_XGEN(j)  (2304 + 64 * (j))
#define XB_TOP      3328
#define XB_TOPGEN   3392
#define XCD_BAR_WORDS 3456
#define XB_SPIN_CAP (1u << 18)

__device__ __forceinline__ unsigned xb_ld(unsigned* p)              { return __hip_atomic_load(p, __ATOMIC_RELAXED, __HIP_MEMORY_SCOPE_AGENT); }
__device__ __forceinline__ unsigned xb_add(unsigned* p, unsigned v) { return __hip_atomic_fetch_add(p, v, __ATOMIC_RELAXED, __HIP_MEMORY_SCOPE_AGENT); }
__device__ __forceinline__ unsigned xb_xcc_id() { return (unsigned)__builtin_amdgcn_s_getreg((3 << 11) | 20) & 0xFu; }
#define XB_SPIN(cond, bar) do { unsigned _sp = 0; while (cond) { __builtin_amdgcn_s_sleep(1); \
    if ((++_sp & 255u) == 0u) { if (xb_ld(&(bar)[XB_TMO])) break; if (_sp > XB_SPIN_CAP) { atomicAdd(&(bar)[XB_TMO], 1u); break; } } } } while (0)

__device__ __forceinline__ int xb_lane_id() { int l; asm volatile("v_mbcnt_lo_u32_b32 %0, -1, 0\n\tv_mbcnt_hi_u32_b32 %0, -1, %0" : "=v"(l)); return l; }
__device__ __forceinline__ bool xb_is_thread0(unsigned w0) { return w0 != 0u && xb_lane_id() == 0; }
struct XcdBarrier {
    unsigned w0;
    unsigned* bar; unsigned x;
    volatile LAS unsigned* st;
};

__device__ __forceinline__ XcdBarrier xcd_barrier_post(unsigned* bar, volatile LAS unsigned* st, unsigned w0) {
    XcdBarrier b; b.w0 = w0; b.bar = bar; b.x = xb_xcc_id(); b.st = st;
    if (xb_is_thread0(b.w0)) (void)xb_add(&bar[XB_XCNT(b.x)], 1u);
    return b;
}
__device__ __forceinline__ void xcd_barrier_complete(unsigned* bar, unsigned x, unsigned& nloc, unsigned& nx) {
    const unsigned G = gridDim.x * gridDim.y * gridDim.z;
    unsigned sum, cnt, mine, sp = 0u;
    for (;;) {
        sum = 0u; cnt = 0u; mine = 0u;
#pragma unroll
        for (unsigned j = 0; j < 16; ++j) { const unsigned c = xb_ld(&bar[XB_XCNT(j)]); sum += c; cnt += (c > 0u) ? 1u : 0u; mine = (j == x) ? c : mine; }
        if (sum == G) break;
        __builtin_amdgcn_s_sleep(1);
        if ((++sp & 255u) == 0u) { if (xb_ld(&bar[XB_TMO])) break; if (sp > XB_SPIN_CAP) { atomicAdd(&bar[XB_TMO], 1u); break; } }
    }
    nloc = mine > 0u ? mine : 1u; nx = cnt > 0u ? cnt : 1u;
}

__device__ __forceinline__ void xcd_barrier(const XcdBarrier& b) {
    asm volatile("s_waitcnt vmcnt(0)" ::: "memory");
    __syncthreads();
    if (xb_is_thread0(b.w0)) {
        unsigned* bar = b.bar;
        __builtin_amdgcn_s_waitcnt(0);
        unsigned nloc = b.st[0], nx = b.st[1];
        if (nloc == 0u) { xcd_barrier_complete(bar, b.x, nloc, nx); b.st[0] = nloc; b.st[1] = nx; }
        const unsigned old = xb_add(&bar[XB_XSUB(b.x)], 1u);
        const unsigned gen = old / nloc;
        if (old + 1u == (gen + 1u) * nloc) {
            __builtin_amdgcn_fence(__ATOMIC_RELEASE, "agent");
            asm volatile("s_waitcnt vmcnt(0)" ::: "memory");
            const unsigned og = xb_add(&bar[XB_TOP], 1u);
            const unsigned tg = og / nx;
            if (og + 1u == (tg + 1u) * nx) xb_add(&bar[XB_TOPGEN], 1u);
            else XB_SPIN(xb_ld(&bar[XB_TOPGEN]) == tg, bar);
            __builtin_amdgcn_fence(__ATOMIC_ACQUIRE, "agent");
            xb_add(&bar[XB_XGEN(b.x)], 1u);
            asm volatile("s_waitcnt vmcnt(0)" ::: "memory");
        } else {
            XB_SPIN(xb_ld(&bar[XB_XGEN(b.x)]) == gen, bar);
            __builtin_amdgcn_fence(__ATOMIC_ACQUIRE, "agent");
            asm volatile("s_waitcnt vmcnt(0)" ::: "memory");
        }
    }
    __syncthreads();
}


DI float bflo(unsigned w) { return __uint_as_float(w << 16); }
DI float bfhi(unsigned w) { return __uint_as_float(w & 0xffff0000u); }
DI int shx(const int lane, const int v, const int o) {
    if (o == 1) return __builtin_amdgcn_update_dpp(v, v, 0xB1, 0xf, 0xf, false);
    if (o == 2) return __builtin_amdgcn_update_dpp(v, v, 0x4E, 0xf, 0xf, false);
    if (o == 8) return __builtin_amdgcn_update_dpp(v, v, 0x128, 0xf, 0xf, false);
    if (o == 4) return __builtin_amdgcn_ds_swizzle(v, 0x101F);
    if (o == 16) return __builtin_amdgcn_ds_swizzle(v, 0x401F);
    return __builtin_amdgcn_ds_bpermute((lane ^ o) << 2, v);
}
DI float shx(const int lane, const float v, const int o) { return __int_as_float(shx(lane, __float_as_int(v), o)); }
template <int CTRL> DI float dpp_f(const float v) { return __int_as_float(__builtin_amdgcn_update_dpp(__float_as_int(v), __float_as_int(v), CTRL, 0xf, 0xf, false)); }
DI float wave_sum(const int lane, float v) {
    (void)lane;
    v += dpp_f<0xB1>(v); v += dpp_f<0x4E>(v); v += dpp_f<0x141>(v); v += dpp_f<0x140>(v);
    { const auto r = __builtin_amdgcn_permlane16_swap(__float_as_uint(v), __float_as_uint(v), false, false); v = __uint_as_float(r[0]) + __uint_as_float(r[1]); }
    { const auto r = __builtin_amdgcn_permlane32_swap(__float_as_uint(v), __float_as_uint(v), false, false); v = __uint_as_float(r[0]) + __uint_as_float(r[1]); }
    return v;
}
DI float max32(float v) {
    v = __builtin_fmaxf(v, dpp_f<0xB1>(v)); v = __builtin_fmaxf(v, dpp_f<0x4E>(v)); v = __builtin_fmaxf(v, dpp_f<0x141>(v)); v = __builtin_fmaxf(v, dpp_f<0x140>(v));
    { const auto r = __builtin_amdgcn_permlane16_swap(__float_as_uint(v), __float_as_uint(v), false, false); v = __builtin_fmaxf(__uint_as_float(r[0]), __uint_as_float(r[1])); }
    return v;
}
DI float wave_max(float v) {
    v = max32(v);
    { const auto r = __builtin_amdgcn_permlane32_swap(__float_as_uint(v), __float_as_uint(v), false, false); v = __builtin_fmaxf(__uint_as_float(r[0]), __uint_as_float(r[1])); }
    return v;
}
DI bf16x8 pack8(float a0, float a1, float a2, float a3, float a4, float a5, float a6, float a7) {
    v4u p; p.x = pk2(a0, a1); p.y = pk2(a2, a3); p.z = pk2(a4, a5); p.w = pk2(a6, a7); return __builtin_bit_cast(bf16x8, p);
}
DI float gelu_erf(float v) {
    const float av = __builtin_fabsf(v), d = av * 0.2316418882f + 1.0f, t = __builtin_amdgcn_rcpf(d);
    float q = t * 0.5307027145f + (-0.7265760135f); q = q * t + 0.7107068705f; q = q * t + (-0.142248368f); q = q * t + 0.127414796f; q = q * t;
    const float e = __builtin_amdgcn_exp2f((v * v) * (-0.72134752044f));
    const float m = v * (q * e), r = v - m;
    return v < 0.f ? m : r;
}

struct Ctx {
    int tid, lane, wave, vcu, G;
};

DI void p0_transpose_item(const float* W, int K, int N, bf16* WT, int out_row0, float scale, LAS float* scr, int k0, int n0, int lane) {
#pragma unroll 8
    for (int i = 0; i < 32; ++i) { const int kk = 2 * i + (lane >> 5); scr[kk * 33 + (lane & 31)] = W[(size_t)(k0 + kk) * N + n0 + (lane & 31)]; }
    LDS_WAIT(); asm volatile("" ::: "memory");
    const int c = lane & 7;
#pragma unroll
    for (int j = 0; j < 4; ++j) { const int n = (lane >> 3) + 8 * j; const LAS float* s = scr + (8 * c) * 33 + n;
        v4u o; o.x = pk2(s[0 * 33] * scale, s[1 * 33] * scale); o.y = pk2(s[2 * 33] * scale, s[3 * 33] * scale); o.z = pk2(s[4 * 33] * scale, s[5 * 33] * scale); o.w = pk2(s[6 * 33] * scale, s[7 * 33] * scale);
        *(v4u*)(WT + (size_t)(out_row0 + n) * K + k0 + 8 * c) = o; }
    LDS_WAIT(); asm volatile("" ::: "memory");
}
DI void cvt_stream(const float* src, bf16* dst, size_t n8, size_t gtid, size_t NT) {
    size_t i = gtid;
    for (; i + 3 * NT < n8; i += 4 * NT) {
        f32x4 a[4], b[4];
#pragma unroll
        for (int u = 0; u < 4; ++u) { a[u] = *(const f32x4*)(src + (i + u * NT) * 8); b[u] = *(const f32x4*)(src + (i + u * NT) * 8 + 4); }
#pragma unroll
        for (int u = 0; u < 4; ++u) *(v4u*)(dst + (i + u * NT) * 8) = pg8::pk8(a[u], b[u]);
    }
    for (; i < n8; i += NT) { const f32x4 a = *(const f32x4*)(src + i * 8), b = *(const f32x4*)(src + i * 8 + 4); *(v4u*)(dst + i * 8) = pg8::pk8(a, b); }
}
DI unsigned q4_i8(const f32x4 v, const float k) {
    const int a = (int)__builtin_rintf(v[0] * k), b = (int)__builtin_rintf(v[1] * k), c = (int)__builtin_rintf(v[2] * k), d = (int)__builtin_rintf(v[3] * k);
    return ((unsigned)a & 0xffu) | (((unsigned)b & 0xffu) << 8) | (((unsigned)c & 0xffu) << 16) | ((unsigned)d << 24);
}
DI void cvt_table_rows(const float* src, unsigned char* dst, float* scl  , int nrows, int gw, int NGW, int lane) {
    f32x4 nx[4];
#pragma unroll
    for (int j = 0; j < 4; ++j) nx[j] = *(const f32x4*)(src + (size_t)(gw < nrows ? gw : 0) * D + 4 * lane + 256 * j);
    for (int row = gw; row < nrows; row += NGW) {
        f32x4 v[4]; float m = 0.f; const int rn = row + NGW < nrows ? row + NGW : row;
#pragma unroll
        for (int j = 0; j < 4; ++j) { v[j] = nx[j]; nx[j] = *(const f32x4*)(src + (size_t)rn * D + 4 * lane + 256 * j);
            m = __builtin_fmaxf(m, __builtin_fmaxf(__builtin_fmaxf(__builtin_fabsf(v[j][0]), __builtin_fabsf(v[j][1])), __builtin_fmaxf(__builtin_fabsf(v[j][2]), __builtin_fabsf(v[j][3])))); }
        m = wave_max(m);
        const float k = m > 0.f ? 127.0f / m : 0.f;
#pragma unroll
        for (int j = 0; j < 4; ++j)
            *(unsigned*)(dst + ((size_t)(row >> 14) * NEXP * D) + ((size_t)(2 * j + (lane >> 5)) * NEXP + (row & (NEXP - 1))) * 128 + ((4 * lane) & 127)) = q4_i8(v[j], k);
        if (lane == 0) scl[2 * row] = m * (1.0f / 127.0f);
    }
}
struct P0Args { const float *x_p, *x_s, *w_in, *w_out, *wq, *wo, *wk, *wv, *pwq, *psk, *pu, *pv; bf16 *WinT, *WoutT, *WqT, *WoT, *WkvT, *WP, *H; unsigned char *TU, *TV; float *SU, *SV; unsigned char* X8; float* SX; };
DI void p0_prologue(const Ctx c, LAS unsigned char* lds, const P0Args a) {
    for (int half = 0; half < 2; ++half) {
    if (((c.vcu & 1) == 1) == (half == 0)) {
    { LAS float* scr = (LAS float*)(lds + c.wave * 16384);
      const int gw = c.vcu * 8 + c.wave, NGW = c.G * 8;
      constexpr int IT_WIN = 16 * 96, IT_SQ = 16 * 32, NITEMS = 2 * IT_WIN + 8 * IT_SQ;
      for (int it = gw; it < NITEMS; it += NGW) {
          int r = it;
          if (r < 2 * IT_WIN) { const int l = r / IT_WIN; r -= l * IT_WIN; const int kb = r / 96, nb = r % 96, n0 = 32 * nb; int orow;
              if (n0 < 1024) orow = 2048 + n0; else if (n0 < 2048) { const int d = n0 - 1024; orow = 256 * (d >> 7) + (d & 127); } else { const int d = n0 - 2048; orow = 256 * (d >> 7) + 128 + (d & 127); }
              p0_transpose_item(a.w_in + (size_t)l * 1024 * 3072, 1024, 3072, a.WinT + (size_t)l * 3072 * 1024, orow, 1.f, scr, 64 * kb, n0, c.lane); continue; }
          r -= 2 * IT_WIN; const int m = r / IT_SQ; r -= m * IT_SQ; const int kb = r >> 5, nb = r & 31;
          const float* src; bf16* dst; float sc = 1.f; const size_t SQ = (size_t)1024 * 1024;
          if (m < 2) { src = a.w_out + m * SQ; dst = a.WoutT + m * SQ; }
          else if (m < 4) { src = a.wq + (m - 2) * SQ; dst = a.WqT + (m - 2) * SQ; sc = 0.125f * LOG2E; }
          else if (m < 6) { src = a.wo + (m - 4) * SQ; dst = a.WoT + (m - 4) * SQ; }
          else if (m == 6) { src = a.wk; dst = a.WkvT; }
          else { src = a.wv; dst = a.WkvT + SQ; }
          p0_transpose_item(src, 1024, 1024, dst, 32 * nb, sc, scr, 64 * kb, 32 * nb, c.lane);
      }
    }
    __syncthreads();
    { LAS float* skT = (LAS float*)lds; LAS float* wqT = skT + 128 * 132;
      for (int u = c.vcu; u < 4 * 16 * 16; u += c.G) {
          const int l = u >> 8, hp = (u >> 4) & 15, dblk = u & 15;
          for (int i = c.tid; i < 16384; i += 512) skT[(i & 127) * 132 + (i >> 7)] = a.psk[(size_t)(l * 16 + hp) * 16384 + i];
          for (int i = c.tid; i < 8192; i += 512) wqT[(i & 127) * 68 + (i >> 7)] = a.pwq[((size_t)l * 1024 + dblk * 64 + (i >> 7)) * 2048 + hp * 128 + (i & 127)];
          __syncthreads();
          const int ng = c.tid & 31, dg = c.tid >> 5; f32x4 acc[4];
#pragma unroll
          for (int i = 0; i < 4; ++i) acc[i] = (f32x4){0.f, 0.f, 0.f, 0.f};
#pragma unroll 4
          for (int cc = 0; cc < 128; ++cc) { const f32x4 s = *(const LAS f32x4*)(skT + cc * 132 + 4 * ng), w = *(const LAS f32x4*)(wqT + cc * 68 + 4 * dg);
#pragma unroll
              for (int i = 0; i < 4; ++i) acc[i] = acc[i] + w * s[i]; }
#pragma unroll
          for (int i = 0; i < 4; ++i) { v2u o; o.x = pk2(acc[i][0], acc[i][1]); o.y = pk2(acc[i][2], acc[i][3]);
              *(v2u*)(a.WP + ((size_t)l * 2048 + hp * 128 + 4 * ng + i) * 1024 + dblk * 64 + 4 * dg) = o; }
          __syncthreads();
      }
    }
    } else {
    { const size_t gtid = (size_t)c.vcu * 512 + c.tid, NT = (size_t)c.G * 512;
      cvt_table_rows(a.pu, a.TU, a.SU, NLAYER * NEXP, c.vcu * 8 + c.wave, c.G * 8, c.lane);
      cvt_table_rows(a.pv, a.TV, a.SV, NLAYER * NEXP, c.vcu * 8 + c.wave, c.G * 8, c.lane);
      (void)gtid; (void)NT;
      for (int m = c.vcu * 8 + c.wave; m < T; m += c.G * 8) {
          const float* xr = (m < TP ? a.x_p + (size_t)m * D : a.x_s + (size_t)(m - TP) * D) + 4 * c.lane;
          f32x4 v[4]; float am = 0.f;
#pragma unroll
          for (int j = 0; j < 4; ++j) { v[j] = *(const f32x4*)(xr + 256 * j); v2u w; w.x = pk2(v[j][0], v[j][1]); w.y = pk2(v[j][2], v[j][3]); ((v2u*)(a.H + (size_t)m * D) + c.lane)[64 * j] = w;
              am = __builtin_fmaxf(am, __builtin_fmaxf(__builtin_fmaxf(__builtin_fabsf(v[j][0]), __builtin_fabsf(v[j][1])), __builtin_fmaxf(__builtin_fabsf(v[j][2]), __builtin_fabsf(v[j][3])))); }
          am = wave_max(am);
          const float k = am > 0.f ? 127.0f / am : 0.f;
#pragma unroll
          for (int j = 0; j < 4; ++j) *(unsigned*)(a.X8 + (size_t)m * D + 4 * c.lane + 256 * j) = q4_i8(v[j], k);
          if (c.lane == 0) a.SX[m] = am * (1.0f / 127.0f);
      }
    }
    }
    __syncthreads();
    }
}

DI void wp_quant_phase(const Ctx c, const bf16* WPb, unsigned char* WP8q, float* swp) {
    for (int row = c.vcu * 8 + c.wave; row < W8_ROWS; row += c.G * 8) {
        const v4u a = *(const v4u*)(WPb + (size_t)row * D + 16 * c.lane), b = *(const v4u*)(WPb + (size_t)row * D + 16 * c.lane + 8);
        const f32x4 v0 = {bflo(a.x), bfhi(a.x), bflo(a.y), bfhi(a.y)}, v1 = {bflo(a.z), bfhi(a.z), bflo(a.w), bfhi(a.w)}, v2 = {bflo(b.x), bfhi(b.x), bflo(b.y), bfhi(b.y)}, v3 = {bflo(b.z), bfhi(b.z), bflo(b.w), bfhi(b.w)};
        float m = 0.f;
#pragma unroll
        for (int i = 0; i < 4; ++i) m = __builtin_fmaxf(m, __builtin_fmaxf(__builtin_fmaxf(__builtin_fabsf(v0[i]), __builtin_fabsf(v1[i])), __builtin_fmaxf(__builtin_fabsf(v2[i]), __builtin_fabsf(v3[i]))));
        m = wave_max(m);
        const float k = m > 0.f ? 127.0f / m : 0.f;
        v4u o; o.x = q4_i8(v0, k); o.y = q4_i8(v1, k); o.z = q4_i8(v2, k); o.w = q4_i8(v3, k);
        *(v4u*)(WP8q + (size_t)row * D + 16 * c.lane) = o;
        if (c.lane == 0) swp[row] = m * (1.0f / 127.0f);
    }
}

DI void ld8_bf16(const bf16* p, float (&o)[8]) { const v4u w = *(const v4u*)p; o[0] = bflo(w.x); o[1] = bfhi(w.x); o[2] = bflo(w.y); o[3] = bfhi(w.y); o[4] = bflo(w.z); o[5] = bfhi(w.z); o[6] = bflo(w.w); o[7] = bfhi(w.w); }
DI void ld8_f32(const float* p, float (&o)[8]) { const f32x4 a = *(const f32x4*)p, b = *(const f32x4*)(p + 4); o[0] = a[0]; o[1] = a[1]; o[2] = a[2]; o[3] = a[3]; o[4] = b[0]; o[5] = b[1]; o[6] = b[2]; o[7] = b[3]; }
DI void conv_gate_phase(const Ctx c, const bf16* U, bf16* Bg, const float* wdw  , const float* st  , float* convp, float* convs  ,
                        unsigned char* z8, float* sz  , const bool skip_samp = false  ) {
    const int gw = c.vcu * 8 + c.wave, NGW = c.G * 8, dc = 16 * c.lane;
    float w0[16], w1[16], w2[16];
    { float t8[8]; ld8_f32(wdw + dc, t8);
#pragma unroll
      for (int i = 0; i < 8; ++i) w0[i] = t8[i]; ld8_f32(wdw + dc + 8, t8);
#pragma unroll
      for (int i = 0; i < 8; ++i) w0[8 + i] = t8[i]; ld8_f32(wdw + D + dc, t8);
#pragma unroll
      for (int i = 0; i < 8; ++i) w1[i] = t8[i]; ld8_f32(wdw + D + dc + 8, t8);
#pragma unroll
      for (int i = 0; i < 8; ++i) w1[8 + i] = t8[i]; ld8_f32(wdw + 2 * D + dc, t8);
#pragma unroll
      for (int i = 0; i < 8; ++i) w2[i] = t8[i]; ld8_f32(wdw + 2 * D + dc + 8, t8);
#pragma unroll
      for (int i = 0; i < 8; ++i) w2[8 + i] = t8[i]; }
    { v4u ng[2], n2[2], n1[2], n0[2];
#define CG_LOAD(tt_) do { const int t_ = (tt_), s_ = t_ & 2047, t1_ = s_ >= 1 ? t_ - 1 : t_, t0_ = s_ >= 2 ? t_ - 2 : t_; \
        _Pragma("unroll") for (int hf = 0; hf < 2; ++hf) { ng[hf] = *(const v4u*)(Bg + (size_t)t_ * D + dc + 8 * hf); n2[hf] = *(const v4u*)(U + (size_t)t_ * D + dc + 8 * hf); \
            n1[hf] = *(const v4u*)(U + (size_t)t1_ * D + dc + 8 * hf); n0[hf] = *(const v4u*)(U + (size_t)t0_ * D + dc + 8 * hf); } } while (0)
      if (gw < TP) CG_LOAD(gw);
      for (int t = gw; t < TP; t += NGW) {
          const int s = t & 2047; const float f1 = s >= 1 ? 1.f : 0.f, f0 = s >= 2 ? 1.f : 0.f;
          v4u cg[2], c2[2], c1[2], c0[2];
#pragma unroll
          for (int hf = 0; hf < 2; ++hf) { cg[hf] = ng[hf]; c2[hf] = n2[hf]; c1[hf] = n1[hf]; c0[hf] = n0[hf]; }
          CG_LOAD(t + NGW < TP ? t + NGW : t);
          float z[16]; float am = 0.f;
#pragma unroll
          for (int hf = 0; hf < 2; ++hf) { const unsigned wg[4] = {cg[hf].x, cg[hf].y, cg[hf].z, cg[hf].w}, w2_[4] = {c2[hf].x, c2[hf].y, c2[hf].z, c2[hf].w}, w1_[4] = {c1[hf].x, c1[hf].y, c1[hf].z, c1[hf].w}, w0_[4] = {c0[hf].x, c0[hf].y, c0[hf].z, c0[hf].w};
#pragma unroll
              for (int i = 0; i < 8; ++i) { const bool hi = i & 1; const int k = i >> 1;
                  const float g = hi ? bfhi(wg[k]) : bflo(wg[k]), u2 = hi ? bfhi(w2_[k]) : bflo(w2_[k]), u1 = (hi ? bfhi(w1_[k]) : bflo(w1_[k])) * f1, u0 = (hi ? bfhi(w0_[k]) : bflo(w0_[k])) * f0;
                  const float zz = g * (w0[8 * hf + i] * u0 + w1[8 * hf + i] * u1 + w2[8 * hf + i] * u2); z[8 * hf + i] = zz; am = __builtin_fmaxf(am, __builtin_fabsf(zz)); } }
          am = wave_max(am);
          const float k = am > 0.f ? 127.0f / am : 0.f;
          v4u q; q.x = q4_i8((f32x4){z[0], z[1], z[2], z[3]}, k); q.y = q4_i8((f32x4){z[4], z[5], z[6], z[7]}, k); q.z = q4_i8((f32x4){z[8], z[9], z[10], z[11]}, k); q.w = q4_i8((f32x4){z[12], z[13], z[14], z[15]}, k);
          *(v4u*)(z8 + (size_t)t * D + dc) = q;
          if (c.lane == 0) sz[t] = am * (1.0f / 127.0f);
      }
#undef CG_LOAD
    }
    for (int t = TP + gw; t < (skip_samp ? TP : T); t += NGW) {
        const bool samp = true; const int s = (t - TP) & 15; const int b = (t - TP) >> 4;
        float z[16]; float am = 0.f;
#pragma unroll
        for (int hf = 0; hf < 2; ++hf) { const int d0 = dc + 8 * hf;
            float u0[8], u1[8], u2[8], g[8];
            ld8_bf16(U + (size_t)t * D + d0, u2);
            { float* cdst = nullptr;
              (void)convp;
              if (samp && s >= DSEQ - 2) cdst = convs + ((size_t)b * 2 + (s - (DSEQ - 2))) * D + d0;
              if (cdst) { *(f32x4*)cdst = (f32x4){u2[0], u2[1], u2[2], u2[3]}; *(f32x4*)(cdst + 4) = (f32x4){u2[4], u2[5], u2[6], u2[7]}; } }
            if (s >= 1) ld8_bf16(U + (size_t)(t - 1) * D + d0, u1);
            else if (samp) ld8_f32(st + ((size_t)b * 2 + 1) * D + d0, u1);
            else {
#pragma unroll
                for (int i = 0; i < 8; ++i) u1[i] = 0.f; }
            if (s >= 2) ld8_bf16(U + (size_t)(t - 2) * D + d0, u0);
            else if (samp) ld8_f32(st + ((size_t)b * 2 + (s == 1 ? 1 : 0)) * D + d0, u0);
            else {
#pragma unroll
                for (int i = 0; i < 8; ++i) u0[i] = 0.f; }
            ld8_bf16(Bg + (size_t)t * D + d0, g);
#pragma unroll
            for (int i = 0; i < 8; ++i) { const float zz = g[i] * (w0[8 * hf + i] * u0[i] + w1[8 * hf + i] * u1[i] + w2[8 * hf + i] * u2[i]); z[8 * hf + i] = zz; am = __builtin_fmaxf(am, __builtin_fabsf(zz)); }
        }
        if (samp) {
            v4u o0, o1; o0.x = pk2(z[0], z[1]); o0.y = pk2(z[2], z[3]); o0.z = pk2(z[4], z[5]); o0.w = pk2(z[6], z[7]); o1.x = pk2(z[8], z[9]); o1.y = pk2(z[10], z[11]); o1.z = pk2(z[12], z[13]); o1.w = pk2(z[14], z[15]);
            *(v4u*)(Bg + (size_t)t * D + dc) = o0; *(v4u*)(Bg + (size_t)t * D + dc + 8) = o1; }
        am = wave_max(am);
        const float k = am > 0.f ? 127.0f / am : 0.f;
        v4u q; q.x = q4_i8((f32x4){z[0], z[1], z[2], z[3]}, k); q.y = q4_i8((f32x4){z[4], z[5], z[6], z[7]}, k); q.z = q4_i8((f32x4){z[8], z[9], z[10], z[11]}, k); q.w = q4_i8((f32x4){z[12], z[13], z[14], z[15]}, k);
        *(v4u*)(z8 + (size_t)t * D + dc) = q;
        if (c.lane == 0) sz[t] = am * (1.0f / 127.0f);
    }
}

DI void ln_phase(const Ctx c, const bf16* R, bf16* H, const float* g, const float* bb, float* yout = nullptr, const bf16* Hres = nullptr, unsigned char* x8 = nullptr, float* sx = nullptr) {
    const int gw = c.vcu * 8 + c.wave, NGW = c.G * 8;
    float gv[2][8], bv[2][8];
#pragma unroll
    for (int j = 0; j < 2; ++j) { ld8_f32(g + 8 * c.lane + 512 * j, gv[j]); ld8_f32(bb + 8 * c.lane + 512 * j, bv[j]); }
    v4u rw[2], hw[2];
#pragma unroll
    for (int j = 0; j < 2; ++j) { const int m0 = gw < T ? gw : 0; rw[j] = *(const v4u*)(R + (size_t)m0 * D + 8 * c.lane + 512 * j); hw[j] = Hres ? *(const v4u*)(Hres + (size_t)m0 * D + 8 * c.lane + 512 * j) : (v4u){0u, 0u, 0u, 0u}; }
    for (int m = gw; m < T; m += NGW) {
        float v[2][8]; float s = 0.f;
#pragma unroll
        for (int j = 0; j < 2; ++j) { const unsigned w[4] = {rw[j].x, rw[j].y, rw[j].z, rw[j].w}, hq[4] = {hw[j].x, hw[j].y, hw[j].z, hw[j].w};
#pragma unroll
            for (int i = 0; i < 4; ++i) { v[j][2 * i] = bflo(w[i]); v[j][2 * i + 1] = bfhi(w[i]); if (Hres) { v[j][2 * i] += bflo(hq[i]) * ALPHA; v[j][2 * i + 1] += bfhi(hq[i]) * ALPHA; } }
#pragma unroll
            for (int i = 0; i < 8; ++i) s += v[j][i]; }
        { const int mn = m + NGW < T ? m + NGW : m;
#pragma unroll
          for (int j = 0; j < 2; ++j) { rw[j] = *(const v4u*)(R + (size_t)mn * D + 8 * c.lane + 512 * j); if (Hres) hw[j] = *(const v4u*)(Hres + (size_t)mn * D + 8 * c.lane + 512 * j); } }
        const float mean = wave_sum(c.lane, s) * (1.f / D); float s2 = 0.f;
#pragma unroll
        for (int j = 0; j < 2; ++j)
#pragma unroll
            for (int i = 0; i < 8; ++i) { v[j][i] -= mean; s2 += v[j][i] * v[j][i]; }
        const float rstd = __builtin_amdgcn_rsqf(wave_sum(c.lane, s2) * (1.f / D) + LN_EPS);
        float am = 0.f;
#pragma unroll
        for (int j = 0; j < 2; ++j)
#pragma unroll
            for (int i = 0; i < 8; ++i) { v[j][i] = v[j][i] * rstd * gv[j][i] + bv[j][i]; am = __builtin_fmaxf(am, __builtin_fabsf(v[j][i])); }
        if (yout) {
#pragma unroll
            for (int j = 0; j < 2; ++j) { float* o = yout + (size_t)m * D + 8 * c.lane + 512 * j; *(f32x4*)o = (f32x4){v[j][0], v[j][1], v[j][2], v[j][3]}; *(f32x4*)(o + 4) = (f32x4){v[j][4], v[j][5], v[j][6], v[j][7]}; }
        } else {
#pragma unroll
            for (int j = 0; j < 2; ++j) { v4u w; w.x = pk2(v[j][0], v[j][1]); w.y = pk2(v[j][2], v[j][3]); w.z = pk2(v[j][4], v[j][5]); w.w = pk2(v[j][6], v[j][7]); *(v4u*)(H + (size_t)m * D + 8 * c.lane + 512 * j) = w; }
            if (x8) {
                am = wave_max(am);
                const float k = am > 0.f ? 127.0f / am : 0.f;
#pragma unroll
                for (int j = 0; j < 2; ++j) { v2u q; q.x = q4_i8((f32x4){v[j][0], v[j][1], v[j][2], v[j][3]}, k); q.y = q4_i8((f32x4){v[j][4], v[j][5], v[j][6], v[j][7]}, k); *(v2u*)(x8 + (size_t)m * D + 8 * c.lane + 512 * j) = q; }
                if (c.lane == 0) sx[m] = am * (1.0f / 127.0f);
            } }
    }
}

DI int ordi(float x) { const int b = __float_as_int(x); return b ^ ((b >> 31) & 0x7fffffff); }
DI float unordi(int o) { return __int_as_float(o ^ ((o >> 31) & 0x7fffffff)); }
#define TK_CE(a, b) do { const int _hi = (a) > (b) ? (a) : (b), _lo = (a) > (b) ? (b) : (a); (a) = _hi; (b) = _lo; } while (0)
#define TK_CPK(i, j) ((ordi(va[i] + vb[j]) & ~255) | (255 - ((i) * 16 + (j))))
#define TK_SORT16(v) do { TK_CE(v[0], v[13]); TK_CE(v[1], v[12]); TK_CE(v[2], v[15]); TK_CE(v[3], v[14]); TK_CE(v[4], v[8]); TK_CE(v[5], v[6]); TK_CE(v[7], v[11]); TK_CE(v[9], v[10]); TK_CE(v[0], v[5]); TK_CE(v[1], v[7]); TK_CE(v[2], v[9]); TK_CE(v[3], v[4]); TK_CE(v[6], v[13]); TK_CE(v[8], v[14]); TK_CE(v[10], v[15]); TK_CE(v[11], v[12]); TK_CE(v[0], v[1]); TK_CE(v[2], v[3]); TK_CE(v[4], v[5]); TK_CE(v[6], v[8]); TK_CE(v[7], v[9]); TK_CE(v[10], v[11]); TK_CE(v[12], v[13]); TK_CE(v[14], v[15]); TK_CE(v[0], v[2]); TK_CE(v[1], v[3]); TK_CE(v[4], v[10]); TK_CE(v[5], v[11]); TK_CE(v[6], v[7]); TK_CE(v[8], v[9]); TK_CE(v[12], v[14]); TK_CE(v[13], v[15]); TK_CE(v[1], v[2]); TK_CE(v[3], v[12]); TK_CE(v[4], v[6]); TK_CE(v[5], v[7]); TK_CE(v[8], v[10]); TK_CE(v[9], v[11]); TK_CE(v[13], v[14]); TK_CE(v[1], v[4]); TK_CE(v[2], v[6]); TK_CE(v[5], v[8]); TK_CE(v[7], v[10]); TK_CE(v[9], v[13]); TK_CE(v[11], v[14]); TK_CE(v[2], v[4]); TK_CE(v[3], v[6]); TK_CE(v[9], v[12]); TK_CE(v[11], v[13]); TK_CE(v[3], v[5]); TK_CE(v[6], v[8]); TK_CE(v[7], v[9]); TK_CE(v[10], v[12]); TK_CE(v[3], v[4]); TK_CE(v[5], v[6]); TK_CE(v[7], v[8]); TK_CE(v[9], v[10]); TK_CE(v[11], v[12]); TK_CE(v[6], v[7]); TK_CE(v[8], v[9]); } while (0)
#define TK_BMERGE16(v) do { TK_CE(v[0], v[8]); TK_CE(v[1], v[9]); TK_CE(v[2], v[10]); TK_CE(v[3], v[11]); TK_CE(v[4], v[12]); TK_CE(v[5], v[13]); TK_CE(v[6], v[14]); TK_CE(v[7], v[15]); TK_CE(v[0], v[4]); TK_CE(v[1], v[5]); TK_CE(v[2], v[6]); TK_CE(v[3], v[7]); TK_CE(v[8], v[12]); TK_CE(v[9], v[13]); TK_CE(v[10], v[14]); TK_CE(v[11], v[15]); TK_CE(v[0], v[2]); TK_CE(v[1], v[3]); TK_CE(v[4], v[6]); TK_CE(v[5], v[7]); TK_CE(v[8], v[10]); TK_CE(v[9], v[11]); TK_CE(v[12], v[14]); TK_CE(v[13], v[15]); TK_CE(v[0], v[1]); TK_CE(v[2], v[3]); TK_CE(v[4], v[5]); TK_CE(v[6], v[7]); TK_CE(v[8], v[9]); TK_CE(v[10], v[11]); TK_CE(v[12], v[13]); TK_CE(v[14], v[15]); } while (0)
#define TK_CAND0(B) do { B[0] = TK_CPK(0, 0); B[1] = TK_CPK(0, 1); B[2] = TK_CPK(0, 2); B[3] = TK_CPK(0, 3); B[4] = TK_CPK(0, 4); B[5] = TK_CPK(0, 5); B[6] = TK_CPK(0, 6); B[7] = TK_CPK(0, 7); B[8] = TK_CPK(0, 8); B[9] = TK_CPK(0, 9); B[10] = TK_CPK(0, 10); B[11] = TK_CPK(0, 11); B[12] = TK_CPK(0, 12); B[13] = TK_CPK(0, 13); B[14] = TK_CPK(0, 14); B[15] = TK_CPK(0, 15); } while (0)
#define TK_CAND1(B) do { B[0] = TK_CPK(1, 0); B[1] = TK_CPK(1, 1); B[2] = TK_CPK(1, 2); B[3] = TK_CPK(1, 3); B[4] = TK_CPK(1, 4); B[5] = TK_CPK(1, 5); B[6] = TK_CPK(1, 6); B[7] = TK_CPK(1, 7); B[8] = TK_CPK(2, 0); B[9] = TK_CPK(2, 1); B[10] = TK_CPK(2, 2); B[11] = TK_CPK(2, 3); B[12] = TK_CPK(2, 4); B[13] = TK_CPK(3, 0); B[14] = TK_CPK(3, 1); B[15] = TK_CPK(3, 2); } while (0)
#define TK_CAND2(B) do { B[0] = TK_CPK(3, 3); B[1] = TK_CPK(4, 0); B[2] = TK_CPK(4, 1); B[3] = TK_CPK(4, 2); B[4] = TK_CPK(5, 0); B[5] = TK_CPK(5, 1); B[6] = TK_CPK(6, 0); B[7] = TK_CPK(6, 1); B[8] = TK_CPK(7, 0); B[9] = TK_CPK(7, 1); B[10] = TK_CPK(8, 0); B[11] = TK_CPK(9, 0); B[12] = TK_CPK(10, 0); B[13] = TK_CPK(11, 0); B[14] = TK_CPK(12, 0); B[15] = TK_CPK(13, 0); } while (0)
#define TK_CAND3(B) do { B[0] = TK_CPK(14, 0); B[1] = TK_CPK(15, 0); B[2] = (int)0x80000000; B[3] = (int)0x80000000; B[4] = (int)0x80000000; B[5] = (int)0x80000000; B[6] = (int)0x80000000; B[7] = (int)0x80000000; B[8] = (int)0x80000000; B[9] = (int)0x80000000; B[10] = (int)0x80000000; B[11] = (int)0x80000000; B[12] = (int)0x80000000; B[13] = (int)0x80000000; B[14] = (int)0x80000000; B[15] = (int)0x80000000; } while (0)
DI void tk_merge(int (&L)[16], const int (&B)[16]) {
#pragma unroll
    for (int i = 0; i < 16; ++i) L[i] = L[i] > B[15 - i] ? L[i] : B[15 - i];
    TK_BMERGE16(L);
}
DI void tk_feed32(int (&L)[16], const v4u (&x)[4], const int rb, const bool first) {
#pragma unroll
    for (int hf = 0; hf < 2; ++hf) { int B[16]; const unsigned w[8] = {x[2 * hf].x, x[2 * hf].y, x[2 * hf].z, x[2 * hf].w, x[2 * hf + 1].x, x[2 * hf + 1].y, x[2 * hf + 1].z, x[2 * hf + 1].w};
#pragma unroll
        for (int j = 0; j < 16; ++j) {
            const unsigned ww = w[j >> 1], code = (unsigned)(127 - ((rb + 16 * hf + j) & 127));
            if (j & 1) { const int m = (int)ww >> 31; const unsigned t = ww ^ ((unsigned)m & 0x7fff0000u); B[j] = (int)((t & 0xffff0000u) | code); }
            else { const int m = (int)(ww << 16) >> 31; const unsigned t = ww ^ ((unsigned)m & 0x7fffu); B[j] = (int)((t << 16) | code); } }
        TK_SORT16(B);
        if (hf == 0 && first) {
#pragma unroll
            for (int i = 0; i < 16; ++i) L[i] = B[i];
        } else tk_merge(L, B); }
}
DI float unord16(const int key) { const int h = key & (int)0xffff0000; return __int_as_float(h ^ ((h >> 31) & 0x7fff0000)); }
DI unsigned byte_of(unsigned a0, unsigned a1, unsigned a2, unsigned a3, int i) { const unsigned lo = i < 4 ? a0 : a1, hi = i < 12 ? a2 : a3, w = i < 8 ? lo : hi; return (w >> ((i & 3) * 8)) & 0xffu; }
DI void topk_phase(const Ctx c, const bf16* Sc  , unsigned short* ids, float* gates) {
    const int gw = c.wave * c.G + c.vcu, NGW = c.G * 8, NU = 8 * (T / 64);
    v4u bufA[4], bufB[4];
    if (gw < NU) { const v4u* sc = (const v4u*)(Sc + (size_t)((gw % (T / 64)) * 64 + c.lane) * 2048 + (gw / (T / 64)) * 256);
#pragma unroll
        for (int j = 0; j < 4; ++j) bufA[j] = sc[j]; }
#pragma unroll 1
    for (int wu = gw; wu < NU; wu += NGW) {
        const int h = wu / (T / 64), t = (wu % (T / 64)) * 64 + c.lane;
        const v4u* sc = (const v4u*)(Sc + (size_t)t * 2048 + h * 256);
        const int wn = wu + NGW < NU ? wu + NGW : wu;
        const v4u* scn = (const v4u*)(Sc + (size_t)((wn % (T / 64)) * 64 + c.lane) * 2048 + (wn / (T / 64)) * 256);
        int Lw[16], La[16];
#pragma unroll
        for (int i = 0; i < 16; ++i) { Lw[i] = (int)0x80000000; La[i] = 0; }
#pragma unroll 1
        for (int it = 0; it < 4; ++it) {
#pragma unroll
            for (int j = 0; j < 4; ++j) bufB[j] = sc[8 * it + 4 + j];
            tk_feed32(Lw, bufA, 64 * it, (it & 1) == 0);
            { const v4u* nx = it < 3 ? sc + 8 * (it + 1) : scn;
#pragma unroll
              for (int j = 0; j < 4; ++j) bufA[j] = nx[j]; }
            tk_feed32(Lw, bufB, 64 * it + 32, false);
            if (it == 1) {
#pragma unroll
                for (int i = 0; i < 16; ++i) La[i] = Lw[i]; }
        }
        float va[16], vb[16]; unsigned IA0 = 0u, IA1 = 0u, IA2 = 0u, IA3 = 0u, IB0 = 0u, IB1 = 0u, IB2 = 0u, IB3 = 0u;
#pragma unroll
        for (int i = 0; i < 16; ++i) { va[i] = unord16(La[i]); vb[i] = unord16(Lw[i]);
            const unsigned ea = (unsigned)(127 - (La[i] & 127)) << ((i & 3) * 8), eb = (unsigned)(127 - (Lw[i] & 127)) << ((i & 3) * 8);
            if ((i >> 2) == 0) { IA0 |= ea; IB0 |= eb; } else if ((i >> 2) == 1) { IA1 |= ea; IB1 |= eb; } else if ((i >> 2) == 2) { IA2 |= ea; IB2 |= eb; } else { IA3 |= ea; IB3 |= eb; } }
        int F[16];
        { int B[16]; TK_CAND0(B); TK_SORT16(B);
#pragma unroll
          for (int i = 0; i < 16; ++i) F[i] = B[i]; }
        { int B[16]; TK_CAND1(B); TK_SORT16(B); tk_merge(F, B); }
        { int B[16]; TK_CAND2(B); TK_SORT16(B); tk_merge(F, B); }
        { int B[16]; TK_CAND3(B); TK_SORT16(B); tk_merge(F, B); }
        float sc_[16], den = 0.f; unsigned ex[16];
        const float mx = unordi(F[0] & ~255);
#pragma unroll
        for (int k = 0; k < 16; ++k) { const int code = 255 - (F[k] & 255); sc_[k] = __builtin_amdgcn_exp2f((unordi(F[k] & ~255) - mx) * LOG2E); den += sc_[k];
            ex[k] = byte_of(IA0, IA1, IA2, IA3, code >> 4) * 128u + byte_of(IB0, IB1, IB2, IB3, code & 15); }
        const float inv = 1.0f / den;
        v4u e0, e1; e0.x = ex[0] | (ex[1] << 16); e0.y = ex[2] | (ex[3] << 16); e0.z = ex[4] | (ex[5] << 16); e0.w = ex[6] | (ex[7] << 16);
        e1.x = ex[8] | (ex[9] << 16); e1.y = ex[10] | (ex[11] << 16); e1.z = ex[12] | (ex[13] << 16); e1.w = ex[14] | (ex[15] << 16);
        v4u* ip = (v4u*)(ids + (size_t)t * 128 + h * 16); ip[0] = e0; ip[1] = e1;
        f32x4* gp = (f32x4*)(gates + (size_t)t * 128 + h * 16);
#pragma unroll
        for (int k = 0; k < 4; ++k) gp[k] = (f32x4){sc_[4 * k] * inv, sc_[4 * k + 1] * inv, sc_[4 * k + 2] * inv, sc_[4 * k + 3] * inv};
    }
}

typedef float f2 __attribute__((ext_vector_type(2)));
constexpr int QCH = 16, QN = T / QCH;
static_assert(T % QCH == 0, "queue chunks");
struct ChunkQ { int xme, s; unsigned pend; unsigned* q; };
struct Chunk { int base, xs; };
DI unsigned cq_ticket(unsigned* qw, int lane) { unsigned v = 0u; if (lane == 0) v = __hip_atomic_fetch_add(qw, 1u, __ATOMIC_RELAXED, __HIP_MEMORY_SCOPE_AGENT); return v; }
DI void cq_init(ChunkQ& g, unsigned* q, int lane) { g.xme = (int)(xb_xcc_id() & 7u); g.s = 0; g.q = q; g.pend = cq_ticket(q + g.xme * 64, lane); }
DI Chunk cq_next(ChunkQ& g, int lane) {
    for (;;) {
        if (g.s >= 8) return Chunk{-1, 0};
        const unsigned chunk = (unsigned)__builtin_amdgcn_readfirstlane((int)g.pend); const int xs = (g.xme + g.s) & 7;
        if (chunk < (unsigned)QN) { g.pend = cq_ticket(g.q + xs * 64, lane); return Chunk{(int)chunk * QCH, xs}; }
        ++g.s; if (g.s < 8) g.pend = cq_ticket(g.q + ((g.xme + g.s) & 7) * 64, lane);
    }
}
struct SliceIds { v4u ia, ib; int t, xs; };
struct SliceAux { v4u a0; float s; };
DI SliceIds slice_load_ids(const int t, const int xs, const int lane, const unsigned short* ids) {
    const int j = lane >> 3, tc = t < 0 ? 0 : t; SliceIds r; r.t = t; r.xs = xs;
    r.ia = *(const v4u*)(ids + (size_t)tc * 128 + 16 * j); r.ib = *(const v4u*)(ids + (size_t)tc * 128 + 16 * j + 8); return r;
}
template <int MODE>
DI SliceAux slice_load_aux(const int t, const int xs, const int lane, const unsigned char* x8, const unsigned char* w8, const float* sw) {
    const int j = lane >> 3, i = lane & 7, tc = t < 0 ? 0 : t; SliceAux r;
    if (MODE == 0) { r.a0 = *(const v4u*)(x8 + (size_t)tc * D + 128 * xs + 16 * i); r.s = 0.f; }
    else { r.a0 = *(const v4u*)(w8 + (size_t)tc * 128 + 16 * j); r.s = sw[tc]; }
    return r;
}
template <int VAR>
DI void slice_issue(v4u (&vr)[16], const SliceIds& n, const unsigned char* T8, const int lane) {
    const unsigned char* sbase = T8 + (size_t)n.xs * NEXP * 128;
    const unsigned lo = 16u * (unsigned)(lane & 7);
    const unsigned idv[8] = {n.ia.x, n.ia.y, n.ia.z, n.ia.w, n.ib.x, n.ib.y, n.ib.z, n.ib.w};
#pragma unroll
    for (int g = 0; g < 16; ++g) {
        unsigned off;
        if (VAR == 2) off = (((g & 1) ? (idv[g >> 1] >> 16) : (idv[g >> 1] & 0xffffu)) & 15u) * 128u + lo;
        else if (g & 1) asm("v_mad_u32_u16 %0, %1, %2, %3 op_sel:[1,0,0,0]" : "=v"(off) : "v"(idv[g >> 1]), "s"(128u), "v"(lo));
        else asm("v_mad_u32_u16 %0, %1, %2, %3" : "=v"(off) : "v"(idv[g >> 1]), "s"(128u), "v"(lo));
        vr[g] = *(const v4u*)(sbase + off); }
}
DI int dot16_i8(const v4u a, const v4u b, int acc) {
    acc = __builtin_amdgcn_sdot4((int)a.x, (int)b.x, acc, false); acc = __builtin_amdgcn_sdot4((int)a.y, (int)b.y, acc, false);
    acc = __builtin_amdgcn_sdot4((int)a.z, (int)b.z, acc, false); acc = __builtin_amdgcn_sdot4((int)a.w, (int)b.w, acc, false); return acc;
}
DI void tr4_dot(int& c0, int& c1, int& c2, int& c3, const unsigned a, const unsigned b, const unsigned cc, const unsigned d, const int w) {
    const unsigned p = __builtin_amdgcn_perm(b, a, 0x05010400u), q = __builtin_amdgcn_perm(b, a, 0x07030602u), r = __builtin_amdgcn_perm(d, cc, 0x05010400u), s = __builtin_amdgcn_perm(d, cc, 0x07030602u);
    c0 = __builtin_amdgcn_sdot4((int)__builtin_amdgcn_perm(r, p, 0x05040100u), w, c0, false); c1 = __builtin_amdgcn_sdot4((int)__builtin_amdgcn_perm(r, p, 0x07060302u), w, c1, false);
    c2 = __builtin_amdgcn_sdot4((int)__builtin_amdgcn_perm(s, q, 0x05040100u), w, c2, false); c3 = __builtin_amdgcn_sdot4((int)__builtin_amdgcn_perm(s, q, 0x07060302u), w, c3, false);
}
template <int MODE, int VAR>
DI void slice_compute(const int lane, const v4u (&vr)[16], const int t, const int xs, const SliceAux& n, float* OUT) {
    const int j = lane >> 3, i = lane & 7;
    if (VAR == 1) {
        unsigned x = n.a0.x ^ n.a0.y;
#pragma unroll
        for (int g = 0; g < 16; ++g) x ^= vr[g].x ^ vr[g].y ^ vr[g].z ^ vr[g].w;
        *(unsigned*)((bf16*)OUT + (size_t)t * D + 128 * xs + 2 * lane) = x;
    } else if (MODE == 0) {
        int d[16];
#pragma unroll
        for (int g = 0; g < 16; ++g) d[g] = dot16_i8(vr[g], n.a0, 0);
        int r8[8], r4[4], r2[2];
#define RS_DPP4(CTRL, R, K, S, o) asm("s_nop 1\n\tv_add_u32_dpp %0, %4, %8 " CTRL " row_mask:0xf bank_mask:0xf\n\tv_add_u32_dpp %1, %5, %9 " CTRL " row_mask:0xf bank_mask:0xf\n\t" \
                "v_add_u32_dpp %2, %6, %10 " CTRL " row_mask:0xf bank_mask:0xf\n\tv_add_u32_dpp %3, %7, %11 " CTRL " row_mask:0xf bank_mask:0xf" \
                : "=&v"(R[o]), "=&v"(R[o + 1]), "=&v"(R[o + 2]), "=&v"(R[o + 3]) : "v"(S[o]), "v"(S[o + 1]), "v"(S[o + 2]), "v"(S[o + 3]), "v"(K[o]), "v"(K[o + 1]), "v"(K[o + 2]), "v"(K[o + 3]))
        { int kp[8], sd[8]; const bool od = lane & 1;
#pragma unroll
          for (int q = 0; q < 8; ++q) { kp[q] = od ? d[8 + q] : d[q]; sd[q] = od ? d[q] : d[8 + q]; }
          RS_DPP4("quad_perm:[1,0,3,2]", r8, kp, sd, 0); RS_DPP4("quad_perm:[1,0,3,2]", r8, kp, sd, 4); }
        { int kp[4], sd[4]; const bool od = lane & 2;
#pragma unroll
          for (int q = 0; q < 4; ++q) { kp[q] = od ? r8[4 + q] : r8[q]; sd[q] = od ? r8[q] : r8[4 + q]; }
          RS_DPP4("quad_perm:[2,3,0,1]", r4, kp, sd, 0); }
#undef RS_DPP4
        asm("s_nop 1\n\tv_add_u32_dpp %0, %2, %2 row_shl:4 row_mask:0xf bank_mask:0x5\n\tv_add_u32_dpp %0, %4, %4 row_shr:4 row_mask:0xf bank_mask:0xa\n\t"
            "v_add_u32_dpp %1, %3, %3 row_shl:4 row_mask:0xf bank_mask:0x5\n\tv_add_u32_dpp %1, %5, %5 row_shr:4 row_mask:0xf bank_mask:0xa"
            : "=&v"(r2[0]), "=&v"(r2[1]) : "v"(r4[0]), "v"(r4[1]), "v"(r4[2]), "v"(r4[3]));
        const int g0 = 8 * (i & 1) + 4 * ((i >> 1) & 1) + 2 * (i >> 2);
        *((unsigned*)OUT + ((size_t)xs * T + t) * 64 + 8 * j + (g0 >> 1)) = ((unsigned)((r2[0] + 32) >> 6) & 0xffffu) | ((unsigned)((r2[1] + 32) >> 6) << 16);
    } else {
        int acc[16];
#pragma unroll
        for (int q = 0; q < 16; ++q) acc[q] = 0;
        const int w4[4] = {(int)n.a0.x, (int)n.a0.y, (int)n.a0.z, (int)n.a0.w};
#pragma unroll
        for (int gq = 0; gq < 4; ++gq) {
            tr4_dot(acc[0], acc[1], acc[2], acc[3], vr[4 * gq].x, vr[4 * gq + 1].x, vr[4 * gq + 2].x, vr[4 * gq + 3].x, w4[gq]);
            tr4_dot(acc[4], acc[5], acc[6], acc[7], vr[4 * gq].y, vr[4 * gq + 1].y, vr[4 * gq + 2].y, vr[4 * gq + 3].y, w4[gq]);
            tr4_dot(acc[8], acc[9], acc[10], acc[11], vr[4 * gq].z, vr[4 * gq + 1].z, vr[4 * gq + 2].z, vr[4 * gq + 3].z, w4[gq]);
            tr4_dot(acc[12], acc[13], acc[14], acc[15], vr[4 * gq].w, vr[4 * gq + 1].w, vr[4 * gq + 2].w, vr[4 * gq + 3].w, w4[gq]);
        }
        int r8[8], r4[4], r2[2];
#pragma unroll
        for (int q = 0; q < 8; q += 4)
            asm("s_nop 1\n\tv_add_u32_dpp %0, %4, %4 row_ror:8 row_mask:0xf bank_mask:0x3\n\tv_add_u32_dpp %0, %8, %8 row_ror:8 row_mask:0xf bank_mask:0xc\n\t"
                "v_add_u32_dpp %1, %5, %5 row_ror:8 row_mask:0xf bank_mask:0x3\n\tv_add_u32_dpp %1, %9, %9 row_ror:8 row_mask:0xf bank_mask:0xc\n\t"
                "v_add_u32_dpp %2, %6, %6 row_ror:8 row_mask:0xf bank_mask:0x3\n\tv_add_u32_dpp %2, %10, %10 row_ror:8 row_mask:0xf bank_mask:0xc\n\t"
                "v_add_u32_dpp %3, %7, %7 row_ror:8 row_mask:0xf bank_mask:0x3\n\tv_add_u32_dpp %3, %11, %11 row_ror:8 row_mask:0xf bank_mask:0xc"
                : "=&v"(r8[q]), "=&v"(r8[q + 1]), "=&v"(r8[q + 2]), "=&v"(r8[q + 3])
                : "v"(acc[q]), "v"(acc[q + 1]), "v"(acc[q + 2]), "v"(acc[q + 3]), "v"(acc[8 + q]), "v"(acc[9 + q]), "v"(acc[10 + q]), "v"(acc[11 + q]));
#pragma unroll
        for (int q = 0; q < 4; ++q) { const auto rr = __builtin_amdgcn_permlane16_swap((unsigned)r8[q], (unsigned)r8[4 + q], false, false); r4[q] = (int)rr[0] + (int)rr[1]; }
#pragma unroll
        for (int q = 0; q < 2; ++q) { const auto rr = __builtin_amdgcn_permlane32_swap((unsigned)r4[q], (unsigned)r4[2 + q], false, false); r2[q] = (int)rr[0] + (int)rr[1]; }
        const int dim = 128 * xs + 16 * i + 8 * (j & 1) + 4 * ((j >> 1) & 1) + 2 * (j >> 2);
        const float s = n.s;
        *(unsigned*)((bf16*)OUT + (size_t)t * D + dim) = pk2((float)r2[0] * s, (float)r2[1] * s);
    }
}
template <int MODE, int VAR = 0>
DI void slice_pass(const Ctx c, const unsigned char* x8, const unsigned short* ids, const unsigned char* w8, const float* sw, const unsigned char* T8, float* OUT, unsigned* q) {
    ChunkQ g; cq_init(g, q, c.lane);
    Chunk cur = cq_next(g, c.lane); if (cur.base < 0) return;
    Chunk nxt = cq_next(g, c.lane);
#define SLICE_TOK_T(p) ((p) < QCH ? cur.base + (p) : (nxt.base >= 0 ? nxt.base + (p) - QCH : -1))
#define SLICE_TOK_X(p) ((p) < QCH ? cur.xs : nxt.xs)
    SliceIds i0 = slice_load_ids(SLICE_TOK_T(0), SLICE_TOK_X(0), c.lane, ids), i1 = slice_load_ids(SLICE_TOK_T(1), SLICE_TOK_X(1), c.lane, ids),
             i2 = slice_load_ids(SLICE_TOK_T(2), SLICE_TOK_X(2), c.lane, ids), i3 = slice_load_ids(SLICE_TOK_T(3), SLICE_TOK_X(3), c.lane, ids);
    SliceAux x0 = slice_load_aux<MODE>(i0.t, i0.xs, c.lane, x8, w8, sw), x1 = slice_load_aux<MODE>(i1.t, i1.xs, c.lane, x8, w8, sw);
    v4u A[16], B[16];
    slice_issue<VAR>(A, i0, T8, c.lane);
#define SLICE_STEP(K, CUR, NXT, IK, IK1, XK) do { slice_issue<VAR>(NXT, IK1, T8, c.lane); \
        const int ct_ = IK.t, cx_ = IK.xs; const SliceAux cxk_ = XK; \
        XK = slice_load_aux<MODE>(SLICE_TOK_T(pg + (K) + 2), SLICE_TOK_X(pg + (K) + 2), c.lane, x8, w8, sw); \
        IK = slice_load_ids(SLICE_TOK_T(pg + (K) + 4), SLICE_TOK_X(pg + (K) + 4), c.lane, ids); \
        slice_compute<MODE, VAR>(c.lane, CUR, ct_, cx_, cxk_, OUT); } while (0)
    for (;;) {
#pragma unroll 2
        for (int pg = 0; pg < QCH; pg += 4) {
            SLICE_STEP(0, A, B, i0, i1, x0);
            SLICE_STEP(1, B, A, i1, i2, x1);
            SLICE_STEP(2, A, B, i2, i3, x0);
            SLICE_STEP(3, B, A, i3, i0, x1);
        }
        cur = nxt; if (cur.base < 0) break;
        nxt = cq_next(g, c.lane);
    }
#undef SLICE_STEP
#undef SLICE_TOK_T
#undef SLICE_TOK_X
}
struct WpA { f32x4 s; v2u iw; f32x4 g; float st; };
struct WpB { f32x4 su, sv; };
DI WpA wp_load_a(const size_t idx, const float* part, const unsigned short* ids, const float* gates, const float* sx) {
    WpA a; v2u p[8];
#pragma unroll
    for (int x = 0; x < 8; ++x) p[x] = *(const v2u*)((const unsigned short*)part + (size_t)x * T * 128 + idx * 4);
    a.iw = *(const v2u*)(ids + idx * 4); a.g = *(const f32x4*)(gates + idx * 4); a.st = sx[idx >> 5] * 64.0f;
    int s0 = 0, s1 = 0, s2 = 0, s3 = 0;
#pragma unroll
    for (int x = 0; x < 8; ++x) { s0 += (int)(short)(p[x].x & 0xffffu); s1 += (int)p[x].x >> 16; s2 += (int)(short)(p[x].y & 0xffffu); s3 += (int)p[x].y >> 16; }
    a.s = (f32x4){(float)s0, (float)s1, (float)s2, (float)s3}; return a;
}
DI WpB wp_load_b(const WpA& a, const float* SU, const float* SV) {
    const unsigned e[4] = {a.iw.x & 0xffffu, a.iw.x >> 16, a.iw.y & 0xffffu, a.iw.y >> 16}; WpB b;
#pragma unroll
    for (int k = 0; k < 4; ++k) { const f2 p = *(const f2*)(SU + 2 * e[k]); b.su[k] = p.x; b.sv[k] = p.y; }
    (void)SV;
    return b;
}
DI void peer_w_phase(const Ctx c, const float* part, const unsigned short* ids, const float* gates, unsigned char* w8, float* sw, const float* sx, const float* SU, const float* SV) {
    const size_t NT = (size_t)c.G * 512, NI = (size_t)T * 32, i0 = (size_t)c.vcu * 512 + c.tid;
    WpA a0 = wp_load_a(i0 < NI ? i0 : 0, part, ids, gates, sx), a1 = wp_load_a(i0 + NT < NI ? i0 + NT : 0, part, ids, gates, sx);
    WpB b0 = wp_load_b(a0, SU, SV);
    for (size_t idx = i0; idx < NI; idx += NT) {
        const WpA a2 = wp_load_a(idx + 2 * NT < NI ? idx + 2 * NT : 0, part, ids, gates, sx);
        const WpB b1 = wp_load_b(a1, SU, SV);
        f32x4 g = a0.g; float am = 0.f;
#pragma unroll
        for (int k = 0; k < 4; ++k) { g[k] = g[k] * gelu_erf(a0.s[k] * (a0.st * b0.su[k])) * b0.sv[k]; am = __builtin_fmaxf(am, __builtin_fabsf(g[k])); }
        am = max32(am);
        *(unsigned*)(w8 + idx * 4) = q4_i8(g, am > 0.f ? 127.0f / am : 0.f);
        if ((c.tid & 31) == 0) sw[idx >> 5] = am * (1.0f / 127.0f);
        a0 = a1; a1 = a2; b0 = b1;
    }
}

DI int pi_row(int m) { return 16 * (m >> 4) + 8 * ((m >> 2) & 1) + 4 * ((m >> 3) & 1) + (m & 3); }
struct AttnT { const bf16* Q; bf16* O; const bf16* Kb; const bf16* VT; const bf16* Vsn; const float* ck; const float* cv; };
template <int MODE>
DI void attn_load(const AttnT A, const int b, const int h, const int kt, const int q, const int hh, const int piq, bf16x8 (&kf)[4], bf16x8 (&vf)[2][2]) {
    if (MODE == 0) {
        const bf16* kr = A.Kb + ((size_t)b * SEQ + kt * 32 + piq) * D + h * DH + 8 * hh;
#pragma unroll
        for (int s = 0; s < 4; ++s) kf[s] = *(const bf16x8*)(kr + 16 * s);
        const bf16* vr = A.VT + (((size_t)b * NH + h) * (SEQ / 32) + kt) * (DH * 32) + q * 32 + 8 * hh;
#pragma unroll
        for (int mt = 0; mt < 2; ++mt)
#pragma unroll
            for (int s = 0; s < 2; ++s) vf[mt][s] = *(const bf16x8*)(vr + mt * 32 * 32 + 16 * s);
    } else if (kt == PAST / 32) {
        const int ko = piq < 16 ? piq : 15;
        const bf16* kr = A.Kb + ((size_t)TP + b * DSEQ + ko) * D + h * DH + 8 * hh;
#pragma unroll
        for (int s = 0; s < 4; ++s) kf[s] = *(const bf16x8*)(kr + 16 * s);
#pragma unroll
        for (int mt = 0; mt < 2; ++mt)
#pragma unroll
            for (int s = 0; s < 2; ++s) { bf16x8 v;
#pragma unroll
                for (int j = 0; j < 8; ++j) { const int kk = 16 * s + 8 * hh + j; v[j] = (short)A.Vsn[((size_t)b * DSEQ + (kk < 16 ? kk : 15)) * D + h * DH + 32 * mt + q]; }
                vf[mt][s] = v; }
    } else {
        const float* kr = A.ck + (((size_t)b * PAST + kt * 32 + piq) * NH + h) * DH + 8 * hh;
#pragma unroll
        for (int s = 0; s < 4; ++s) { const f32x4 x0 = *(const f32x4*)(kr + 16 * s), x1 = *(const f32x4*)(kr + 16 * s + 4); kf[s] = pack8(x0[0], x0[1], x0[2], x0[3], x1[0], x1[1], x1[2], x1[3]); }
#pragma unroll
        for (int mt = 0; mt < 2; ++mt)
#pragma unroll
            for (int s = 0; s < 2; ++s) { float x[8];
#pragma unroll
                for (int j = 0; j < 8; ++j) x[j] = A.cv[(((size_t)b * PAST + kt * 32 + 16 * s + 8 * hh + j) * NH + h) * DH + 32 * mt + q];
                vf[mt][s] = pack8(x[0], x[1], x[2], x[3], x[4], x[5], x[6], x[7]); }
    }
}
template <int MODE>
DI void attn_qtile(const AttnT A, int b, int h, int qi, int lane, const bf16x8 (&ut)[2]) {
    const int q = lane & 31, hh = lane >> 5, piq = pi_row(q);
    const size_t qrow = MODE == 0 ? (size_t)b * SEQ + qi * 32 + q : (size_t)TP + b * DSEQ + (q < 16 ? q : 15);
    const int qpos = MODE == 0 ? qi * 32 + q : (q < 16 ? PAST + q : 0);
    bf16x8 qf[4];
#pragma unroll
    for (int s = 0; s < 4; ++s) qf[s] = *(const bf16x8*)(A.Q + qrow * D + h * DH + 16 * s + 8 * hh);
    f32x16 o0, o1;
#pragma unroll
    for (int i = 0; i < 16; ++i) { o0[i] = 0.f; o1[i] = 0.f; }
    float carry = 0.f;
    const int kt0 = MODE == 0 ? qi : PAST / 32;
    bf16x8 kf[4], vf[2][2];
    attn_load<MODE>(A, b, h, kt0, q, hh, piq, kf, vf);
    for (int kt = kt0; kt >= 0; --kt) {
        bf16x8 kn[4], vn[2][2];
        attn_load<MODE>(A, b, h, kt > 0 ? kt - 1 : 0, q, hh, piq, kn, vn);
        f32x16 S;
#pragma unroll
        for (int i = 0; i < 16; ++i) S[i] = 0.f;
#pragma unroll
        for (int s = 0; s < 4; ++s) S = MFMA32(kf[s], qf[s], S);
        const int kbase = kt * 32 + 8 * hh;
        float L[16], lw[16];
#pragma unroll
        for (int r = 0; r < 16; ++r) {
            const bool valid = (kbase + 16 * (r >> 3) + (r & 7)) < qpos;
            const float z = S[r], sp = __builtin_fmaxf(z, 0.f) + __builtin_amdgcn_logf(1.0f + __builtin_amdgcn_exp2f(-__builtin_fabsf(z)));
            L[r] = valid ? -sp : 0.f; lw[r] = valid ? (z - sp) : -1e30f;
        }
        f32x16 suf;
#pragma unroll
        for (int i = 0; i < 16; ++i) suf[i] = 0.f;
        suf = MFMA32(ut[0], pack8(L[0], L[1], L[2], L[3], L[4], L[5], L[6], L[7]), suf);
        suf = MFMA32(ut[1], pack8(L[8], L[9], L[10], L[11], L[12], L[13], L[14], L[15]), suf);
        float a[16];
#pragma unroll
        for (int r = 0; r < 16; ++r) a[r] = __builtin_amdgcn_exp2f(lw[r] + suf[r] + carry);
        carry += __int_as_float(__builtin_amdgcn_ds_bpermute(q << 2, __float_as_int(suf[0] + L[0])));
        const bf16x8 p0 = pack8(a[0], a[1], a[2], a[3], a[4], a[5], a[6], a[7]), p1 = pack8(a[8], a[9], a[10], a[11], a[12], a[13], a[14], a[15]);
        o0 = MFMA32(vf[0][0], p0, o0); o0 = MFMA32(vf[0][1], p1, o0);
        o1 = MFMA32(vf[1][0], p0, o1); o1 = MFMA32(vf[1][1], p1, o1);
        if (__builtin_amdgcn_ballot_w64(qpos > 0 && carry > -24.0f * LOG2E) == 0ull) break;
#pragma unroll
        for (int s = 0; s < 4; ++s) kf[s] = kn[s];
#pragma unroll
        for (int mt = 0; mt < 2; ++mt)
#pragma unroll
            for (int s = 0; s < 2; ++s) vf[mt][s] = vn[mt][s];
    }
    if (MODE == 0 || q < 16) {
        bf16* orow = A.O + qrow * D + h * DH + 4 * hh;
#pragma unroll
        for (int g = 0; g < 4; ++g) {
            v2u w0, w1; w0.x = pk2(o0[4 * g], o0[4 * g + 1]); w0.y = pk2(o0[4 * g + 2], o0[4 * g + 3]); w1.x = pk2(o1[4 * g], o1[4 * g + 1]); w1.y = pk2(o1[4 * g + 2], o1[4 * g + 3]);
            *(v2u*)(orow + 8 * g) = w0; *(v2u*)(orow + 32 + 8 * g) = w1; }
    }
}
DI void attn_phase(const Ctx c, const AttnT A) {
    const int q = c.lane & 31, hh = c.lane >> 5, piq = pi_row(q);
    bf16x8 ut[2];
#pragma unroll
    for (int s = 0; s < 2; ++s)
#pragma unroll
        for (int j = 0; j < 8; ++j) ut[s][j] = (16 * s + 8 * hh + j > piq) ? (short)0x3f80 : (short)0;
    for (int bu = c.vcu; bu < NB * NH * 4; bu += c.G) {
        const int bh = bu >> 2, b = bh >> 4, h = bh & 15, p = (bu & 3) * 8 + c.wave;
        attn_qtile<0>(A, b, h, 63 - p, c.lane, ut);
        attn_qtile<0>(A, b, h, p, c.lane, ut);
    }
    for (int su = c.wave * c.G + c.vcu; su < NB * NH; su += c.G * 8) attn_qtile<1>(A, su >> 4, su & 15, 0, c.lane, ut);
}

DI void vt_phase(const Ctx c, LAS unsigned char* lds, const bf16* Vb, bf16* VT, bf16* Vsn) {
    LAS unsigned char* scr = lds + c.wave * 16384;
    const int gw = c.vcu * 8 + c.wave, NGW = c.G * 8;
    for (int wt = gw; wt < (TP / 64) * 16; wt += NGW) {
        const int tt = wt >> 4, ht = wt & 15;
        v4u vin[8];
#pragma unroll
        for (int j = 0; j < 8; ++j) vin[j] = *(const v4u*)(Vb + (size_t)(tt * 64 + (c.lane >> 3) + 8 * j) * D + ht * 64 + (c.lane & 7) * 8);
        __builtin_amdgcn_sched_barrier(0);
#pragma unroll
        for (int j = 0; j < 8; ++j) { const int row = (c.lane >> 3) + 8 * j, ch = c.lane & 7;
            LAS unsigned* d = (LAS unsigned*)(scr + row * 132 + ch * 16); d[0] = vin[j].x; d[1] = vin[j].y; d[2] = vin[j].z; d[3] = vin[j].w; }
        LDS_WAIT(); asm volatile("" ::: "memory");
#pragma unroll
        for (int j = 0; j < 8; ++j) { const int orow = (c.lane >> 3) + 8 * j, ch = c.lane & 7;
            unsigned short e[8];
#pragma unroll
            for (int i = 0; i < 8; ++i) e[i] = *(const LAS unsigned short*)(scr + (ch * 8 + i) * 132 + orow * 2);
            v4u o; o.x = e[0] | ((unsigned)e[1] << 16); o.y = e[2] | ((unsigned)e[3] << 16); o.z = e[4] | ((unsigned)e[5] << 16); o.w = e[6] | ((unsigned)e[7] << 16);
            { const int bb = tt >> 5, kt = 2 * (tt & 31) + (ch >> 2);
              *(v4u*)(VT + (((size_t)bb * NH + ht) * (SEQ / 32) + kt) * (DH * 32) + orow * 32 + 8 * (ch & 3)) = o; } }
        LDS_WAIT(); asm volatile("" ::: "memory");
    }
    const size_t NT = (size_t)c.G * 512;
    for (size_t i = (size_t)c.vcu * 512 + c.tid; i < (size_t)TS * D / 8; i += NT) *(v4u*)(Vsn + i * 8) = *(const v4u*)(Vb + (size_t)TP * D + i * 8);
}

DI f32x16 sg_tile(const bf16* wr  , const bf16* xr  ) {
    f32x16 acc;
#pragma unroll
    for (int i = 0; i < 16; ++i) acc[i] = 0.f;
    bf16x8 wa[8], xa[8], wb[8], xb[8];
#pragma unroll
    for (int j = 0; j < 8; ++j) { wa[j] = *(const bf16x8*)(wr + 16 * j); xa[j] = *(const bf16x8*)(xr + 16 * j); }
#pragma unroll 1
    for (int k0 = 0; k0 < 64; k0 += 16) {
#pragma unroll
        for (int j = 0; j < 8; ++j) { wb[j] = *(const bf16x8*)(wr + 16 * (k0 + 8 + j)); xb[j] = *(const bf16x8*)(xr + 16 * (k0 + 8 + j)); }
        __builtin_amdgcn_sched_barrier(0);
#pragma unroll
        for (int j = 0; j < 8; ++j) acc = MFMA32(wa[j], xa[j], acc);
        __builtin_amdgcn_sched_barrier(0);
        { const int kn = k0 + 16 < 64 ? k0 + 16 : 0;
#pragma unroll
          for (int j = 0; j < 8; ++j) { wa[j] = *(const bf16x8*)(wr + 16 * (kn + j)); xa[j] = *(const bf16x8*)(xr + 16 * (kn + j)); } }
        __builtin_amdgcn_sched_barrier(0);
#pragma unroll
        for (int j = 0; j < 8; ++j) acc = MFMA32(wb[j], xb[j], acc);
        __builtin_amdgcn_sched_barrier(0);
    }
    return acc;
}
DI void sg_gate(const Ctx c, const bf16* Hall  , const bf16* Wl  , bf16* U, bf16* Bg, float* convp  ) {
    const int q = c.lane & 31, hh = c.lane >> 5;
    for (int tile = c.wave * c.G + c.vcu; tile < 18 * 32; tile += c.G * 8) {
        const int tt = tile % 18, dt = tile / 18, d = 32 * dt + q, crow = 256 * (d >> 7) + (d & 127);
        const bool cs = tt >= 16; const int kk = (tt - 16) * 32 + q;
        const size_t row = cs ? (size_t)(kk >> 1) * SEQ + (SEQ - 2) + (kk & 1) : (size_t)TP + tt * 32 + q;
        const bf16* xr = Hall + row * D + 8 * hh;
        const bf16* wc = Wl + (size_t)crow * D + 8 * hh; const bf16* wx = wc + (size_t)128 * D; const bf16* wb = Wl + (size_t)(2048 + d) * D + 8 * hh;
        f32x16 ac, ax, ab;
#pragma unroll
        for (int i = 0; i < 16; ++i) { ac[i] = 0.f; ax[i] = 0.f; ab[i] = 0.f; }
        { bf16x8 fx[4], fc[4], fxx[4], fb[4], gx[4], gc[4], gxx[4], gb[4];
#pragma unroll
          for (int j = 0; j < 4; ++j) { fx[j] = *(const bf16x8*)(xr + 16 * j); fc[j] = *(const bf16x8*)(wc + 16 * j); fxx[j] = *(const bf16x8*)(wx + 16 * j); fb[j] = *(const bf16x8*)(wb + 16 * j); }
#pragma unroll 1
          for (int k0 = 0; k0 < 64; k0 += 8) {
#pragma unroll
              for (int j = 0; j < 4; ++j) { gx[j] = *(const bf16x8*)(xr + 16 * (k0 + 4 + j)); gc[j] = *(const bf16x8*)(wc + 16 * (k0 + 4 + j)); gxx[j] = *(const bf16x8*)(wx + 16 * (k0 + 4 + j)); gb[j] = *(const bf16x8*)(wb + 16 * (k0 + 4 + j)); }
              __builtin_amdgcn_sched_barrier(0);
#pragma unroll
              for (int j = 0; j < 4; ++j) { ac = MFMA32(fc[j], fx[j], ac); ax = MFMA32(fxx[j], fx[j], ax); ab = MFMA32(fb[j], fx[j], ab); }
              __builtin_amdgcn_sched_barrier(0);
              { const int kn = k0 + 8 < 64 ? k0 + 8 : 0;
#pragma unroll
                for (int j = 0; j < 4; ++j) { fx[j] = *(const bf16x8*)(xr + 16 * (kn + j)); fc[j] = *(const bf16x8*)(wc + 16 * (kn + j)); fxx[j] = *(const bf16x8*)(wx + 16 * (kn + j)); fb[j] = *(const bf16x8*)(wb + 16 * (kn + j)); } }
              __builtin_amdgcn_sched_barrier(0);
#pragma unroll
              for (int j = 0; j < 4; ++j) { ac = MFMA32(gc[j], gx[j], ac); ax = MFMA32(gxx[j], gx[j], ax); ab = MFMA32(gb[j], gx[j], ab); }
              __builtin_amdgcn_sched_barrier(0);
          } }
        if (cs) {
            float* cd = convp + (size_t)kk * D + 32 * dt + 4 * hh;
#pragma unroll
            for (int g = 0; g < 4; ++g) *(f32x4*)(cd + 8 * g) = (f32x4){ac[4 * g] * ax[4 * g], ac[4 * g + 1] * ax[4 * g + 1], ac[4 * g + 2] * ax[4 * g + 2], ac[4 * g + 3] * ax[4 * g + 3]};
        } else {
            const size_t ro = row * D + 32 * dt + 4 * hh;
#pragma unroll
            for (int g = 0; g < 4; ++g) { v2u wu, wb2; wu.x = pk2(ac[4 * g] * ax[4 * g], ac[4 * g + 1] * ax[4 * g + 1]); wu.y = pk2(ac[4 * g + 2] * ax[4 * g + 2], ac[4 * g + 3] * ax[4 * g + 3]);
                wb2.x = pk2(ab[4 * g], ab[4 * g + 1]); wb2.y = pk2(ab[4 * g + 2], ab[4 * g + 3]);
                *(v2u*)(U + ro + 8 * g) = wu; *(v2u*)(Bg + ro + 8 * g) = wb2; }
        }
    }
}
template <int MODE>
DI void sg_plain(const Ctx c, const bf16* Xs, const bf16* Wt, const int N, bf16* O, const bf16* Hres, bf16* O2, float* f0, float* f1) {
    const int q = c.lane & 31, hh = c.lane >> 5;
    for (int tile = c.wave * c.G + c.vcu; tile < 16 * (N / 32); tile += c.G * 8) {
        const int tt = tile & 15, ft = tile >> 4;
        const f32x16 acc = sg_tile(Wt + (size_t)(ft * 32 + q) * D + 8 * hh, Xs + (size_t)(tt * 32 + q) * D + 8 * hh);
        const int tl = tt * 32 + q;
#pragma unroll
        for (int g = 0; g < 4; ++g) { const int f = 32 * ft + 8 * g + 4 * hh; const f32x4 v = {acc[4 * g], acc[4 * g + 1], acc[4 * g + 2], acc[4 * g + 3]};
            if (MODE == 0) { v2u w; w.x = pk2(v[0], v[1]); w.y = pk2(v[2], v[3]); *(v2u*)(O + (size_t)(TP + tl) * D + f) = w; }
            else if (MODE == 1) { const v2u hw = *(const v2u*)(Hres + (size_t)(TP + tl) * D + f); const f32x4 r = (f32x4){bflo(hw.x), bfhi(hw.x), bflo(hw.y), bfhi(hw.y)} * ALPHA + v;
                v2u w; w.x = pk2(r[0], r[1]); w.y = pk2(r[2], r[3]); *(v2u*)(O + (size_t)(TP + tl) * D + f) = w; }
            else if (MODE == 2) { const bool isv = f >= 1024; const int fc = isv ? f - 1024 : f; v2u w; w.x = pk2(v[0], v[1]); w.y = pk2(v[2], v[3]);
                *(v2u*)((isv ? O2 : O) + (size_t)(TP + tl) * D + fc) = w; *(f32x4*)((isv ? f1 : f0) + (size_t)tl * D + fc) = v; }
            else { v2u w; w.x = pk2(v[0], v[1]); w.y = pk2(v[2], v[3]); *(v2u*)(O + (size_t)(TP + tl) * 2048 + f) = w; }
        }
    }
}

struct Args { const float* in[18]; float* out; unsigned char* ws; int ph_lo, ph_hi, li, pad; };
constexpr int N_PHASES = 2 + 2 * 10 + 12 + 10;
__global__ void __launch_bounds__(512, 2) fwd(Args args) {
    extern __shared__ __attribute__((aligned(16))) unsigned char lds_raw[];
    LAS unsigned char* lds = (LAS unsigned char*)lds_raw;
    Ctx c0; c0.tid = threadIdx.x; c0.lane = 0; c0.wave = __builtin_amdgcn_readfirstlane(c0.tid >> 6); c0.G = gridDim.x;
    { const int bx = blockIdx.x; c0.vcu = (c0.G % 8 == 0) ? (bx % 8) * (c0.G / 8) + bx / 8 : bx; }
    volatile LAS unsigned* MISC = (volatile LAS unsigned*)(lds + MISC_OFF);
    for (int u = c0.tid; u < (LDS_BYTES - RING_BYTES) / 4; u += 512) ((LAS unsigned*)(lds + RING_BYTES))[u] = 0u;
    __syncthreads();
    unsigned char* ws = args.ws; float* out = args.out;
    XcdBarrier bar = xcd_barrier_post((unsigned*)(ws + WS_CTL) + CW_BAR + args.li * XCD_BAR_WORDS, MISC + 8, c0.wave == 0 ? 1u : 0u);
#define WinT ((bf16*)(wsl + WS_WIN))
#define WoutT ((bf16*)(wsl + WS_WOUT))
#define WqT ((bf16*)(wsl + WS_WQ))
#define WoT ((bf16*)(wsl + WS_WO))
#define WkvT ((bf16*)(wsl + WS_WKV))
#define WP ((bf16*)(wsl + WS_WP))
#define W8A (wsl + WS_W8A)
#define SWA ((float*)(wsl + WS_SWA))
#define W8R(off) ((int)(((off) - WS_WIN) / 2048))
#define Vsn ((bf16*)(wsl + WS_VSN))
#define H ((bf16*)(wsl + WS_H))
#define Kb ((bf16*)(wsl + WS_KB))
#define VT ((bf16*)(wsl + WS_VT))
#define ids ((unsigned short*)(wsl + WS_IDS))
#define gates ((float*)(wsl + WS_GATE))
#define W8 (wsl + WS_W8)
#define SX ((float*)(wsl + WS_SX))
#define SW (SX + T)
#define X8 (wsl + WS_X8)
#define TU (wsl + WS_TU)
#define TV (wsl + WS_TV)
#define SU ((float*)(wsl + WS_SU))
#define SV (SU + 1)
#define A0 ((bf16*)(wsl + WS_A))
#define A1 ((bf16*)(wsl + WS_A + 129 * MiB))
#define ScT ((float*)(wsl + WS_A))
#define R A0
    const float* ln_g = args.in[16]; const float* ln_b = args.in[17];
    const int lo = args.ph_lo, hi = args.ph_hi; int ph = 0;
#ifndef PROBE_REPEAT
#define PROBE_REPEAT 0
#endif
#define PHASE_R(bit, body) do { const int nrep = 1 + ((PROBE_REPEAT >> (bit)) & 1); for (int rep = 0; rep < nrep; ++rep) { if (ph >= lo && ph < hi) { Ctx c = c0; c.lane = xb_lane_id(); c.tid = c0.wave * 64 + c.lane; unsigned long long wsi_ = (unsigned long long)ws; asm volatile("" : "+s"(wsi_)); unsigned char* wsl = (unsigned char*)(GAS unsigned char*)wsi_; body; if (ph + 1 < hi) { xcd_barrier(bar); if ((PROBE_REPEAT >> 20) & 1) xcd_barrier(bar); } } ++ph; } } while (0)
#define PHASE(body) PHASE_R(31, body)

    PHASE_R(4, ({ P0Args a{args.in[0], args.in[1], args.in[5], args.in[7], args.in[8], args.in[9], args.in[10], args.in[11], args.in[12], args.in[13], args.in[14], args.in[15],
                      WinT, WoutT, WqT, WoT, WkvT, WP, H, TU, TV, SU, SV, X8, SX}; p0_prologue(c, lds, a); }));

    PHASE(({ wp_quant_phase(c, WinT, W8A, SWA); }));

#pragma unroll 1
    for (int l = 0; l < NLAYER; ++l) {
        if (l < 2) {
            PHASE_R(8, ({ pg8::Gemm g{(const bf16*)X8, (const bf16*)(W8A + ((size_t)W8R(WS_WIN) + (size_t)l * 3072) * 1024), TP, 3072, 512}; pg8::StaticOrder S; S.init(TP, 3072, c.G, (int)blockIdx.x);
                     pg8::EpiGate<true> E{A0, A1, SX, SWA + W8R(WS_WIN) + l * 3072};
                     pg8::gemm_phase<pg8::EpiGate<true>, pg8::StaticOrder, true, true, true>(lds, g, S, E, c.tid);
                     sg_gate(c, H, WinT + (size_t)l * 3072 * 1024, A0, A1, out + O_CONVP + (size_t)l * NB * 2 * D); }));
            PHASE_R(13, ({ conv_gate_phase(c, A0, A1, args.in[6] + (size_t)l * 3 * D, args.in[2] + (size_t)l * NB * 2 * D, out + O_CONVP + (size_t)l * NB * 2 * D, out + O_CONVS + (size_t)l * NB * 2 * D, X8, SX, rep > 0); }));
        } else {
            if (l == 2) {
                PHASE_R(10, ({ pg8::Gemm g{(const bf16*)X8, (const bf16*)(W8A + (size_t)W8R(WS_WKV) * 1024), TP, 2048, 512}; pg8::StaticOrder S; S.init(TP, 2048, c.G, (int)blockIdx.x);
                         pg8::EpiKV<true> E{Kb, A1, out + O_KP, out + O_VP, out + O_KS, out + O_VS, SX, SWA + W8R(WS_WKV)};
                         pg8::gemm_phase<pg8::EpiKV<true>, pg8::StaticOrder, true, true, true>(lds, g, S, E, c.tid);
                         sg_plain<2>(c, H + (size_t)TP * D, WkvT, 2048, Kb, nullptr, A1, out + O_KS, out + O_VS); }));
                PHASE_R(14, ({ vt_phase(c, lds, A1, VT, Vsn); }));
            }
            PHASE_R(9, ({ pg8::Gemm g{(const bf16*)X8, (const bf16*)(W8A + ((size_t)W8R(WS_WQ) + (size_t)(l - 2) * 1024) * 1024), TP, 1024, 512}; pg8::StaticOrder S; S.init(TP, 1024, c.G, (int)blockIdx.x);
                     pg8::EpiBf16P<true> E{A0, 1024, SX, SWA + W8R(WS_WQ) + (l - 2) * 1024};
                     pg8::gemm_phase<pg8::EpiBf16P<true>, pg8::StaticOrder, true, true, true>(lds, g, S, E, c.tid);
                     sg_plain<0>(c, H + (size_t)TP * D, WqT + (size_t)(l - 2) * 1024 * 1024, 1024, A0, nullptr, nullptr, nullptr, nullptr); }));
            PHASE_R(11, ({ AttnT A{A0, A1, Kb, VT, Vsn, args.in[3], args.in[4]}; attn_phase(c, A); }));
        }
        if (l < 2) {
            PHASE_R(7, ({ pg8::Gemm g{(const bf16*)X8, (const bf16*)(W8A + ((size_t)W8R(WS_WOUT) + (size_t)l * 1024) * 1024), TP, 1024, 512}; pg8::StaticOrder S; S.init(TP, 1024, c.G, (int)blockIdx.x);
                     pg8::EpiRes<true> E{H, R, ALPHA, SX, SWA + W8R(WS_WOUT) + l * 1024};
                     pg8::gemm_phase<pg8::EpiRes<true>, pg8::StaticOrder, true, true, true>(lds, g, S, E, c.tid);
                     sg_plain<1>(c, A1 + (size_t)TP * D, WoutT + (size_t)l * 1024 * 1024, 1024, R, H, nullptr, nullptr, nullptr); }));
        } else {
            PHASE_R(7, ({ pg8::Gemm g{A1, WoT + (size_t)(l - 2) * 1024 * 1024, TP, 1024, 1024}; pg8::StaticOrder S; S.init(TP, 1024, c.G, (int)blockIdx.x);
                     pg8::EpiRes<false> E{H, R, ALPHA, nullptr, nullptr};
                     pg8::gemm_phase<pg8::EpiRes<false>, pg8::StaticOrder, true, true>(lds, g, S, E, c.tid);
                     sg_plain<1>(c, A1 + (size_t)TP * D, WoT + (size_t)(l - 2) * 1024 * 1024, 1024, R, H, nullptr, nullptr, nullptr); }));
        }
        PHASE_R(5, ({ ln_phase(c, R, H, ln_g + (size_t)(l * 2) * D, ln_b + (size_t)(l * 2) * D, nullptr, nullptr, X8, SX); }));
        PHASE_R(6, ({ pg8::Gemm g{(const bf16*)X8, (const bf16*)(W8A + ((size_t)W8R(WS_WP) + (size_t)l * 2048) * 1024), TP, 2048, 512}; pg8::StaticOrder S; S.init(TP, 2048, c.G, (int)blockIdx.x);
                 pg8::EpiScoreI8 E{(bf16*)ScT, 2048, SX, SWA + W8R(WS_WP) + l * 2048};
                 pg8::gemm_phase<pg8::EpiScoreI8, pg8::StaticOrder, true, true, true>(lds, g, S, E, c.tid);
                 sg_plain<3>(c, H + (size_t)TP * D, WP + (size_t)l * 2048 * 1024, 2048, (bf16*)ScT, nullptr, nullptr, nullptr, nullptr); }));
        PHASE_R(3, ({ topk_phase(c, (const bf16*)ScT, ids, gates); }));
        PHASE_R(0, ({ slice_pass<0>(c, X8, ids, W8, SW, TU + (size_t)l * NEXP * D, ScT  , (unsigned*)(ws + WS_CTL) + CW_Q + ((l * 2) * 2 + rep) * 512); }));
        PHASE_R(12, ({ peer_w_phase(c, ScT, ids, gates, W8, SW, SX, SU + (size_t)l * NEXP * 2, SV + (size_t)l * NEXP * 2); }));
        PHASE_R(1, ({ slice_pass<1>(c, X8, ids, W8, SW, TV + (size_t)l * NEXP * D, (float*)A0, (unsigned*)(ws + WS_CTL) + CW_Q + ((l * 2 + 1) * 2 + rep) * 512); }));
        PHASE(({ ln_phase(c, A0, H, ln_g + (size_t)(l * 2 + 1) * D, ln_b + (size_t)(l * 2 + 1) * D, l == NLAYER - 1 ? out : nullptr, H, X8, SX); }));
#if defined(PROBE_SLICE) && PROBE_SLICE == 1
        PHASE(({ slice_pass<0, 1>(c, X8, ids, W8, SW, TU + (size_t)l * NEXP * D, ScT, (unsigned*)(ws + WS_CTL) + CW_Q + ((l * 2) * 2 + 1) * 512); }));
#elif defined(PROBE_SLICE) && PROBE_SLICE == 2
        PHASE(({ slice_pass<0, 2>(c, X8, ids, W8, SW, TU + (size_t)l * NEXP * D, ScT, (unsigned*)(ws + WS_CTL) + CW_Q + ((l * 2) * 2 + 1) * 512); }));
#elif defined(PROBE_SLICE) && PROBE_SLICE == 3
        PHASE(({ slice_pass<1, 1>(c, X8, ids, W8, SW, TV + (size_t)l * NEXP * D, ScT, (unsigned*)(ws + WS_CTL) + CW_Q + ((l * 2) * 2 + 1) * 512); }));
#elif defined(PROBE_SLICE) && PROBE_SLICE == 4
        PHASE(({ slice_pass<1, 2>(c, X8, ids, W8, SW, TV + (size_t)l * NEXP * D, ScT, (unsigned*)(ws + WS_CTL) + CW_Q + ((l * 2) * 2 + 1) * 512); }));
#endif
    }
#undef PHASE
#undef PHASE_R
#undef WinT
#undef WoutT
#undef WqT
#undef WoT
#undef WkvT
#undef WP
#undef W8A
#undef SWA
#undef W8R
#undef Vsn
#undef H
#undef Kb
#undef VT
#undef ids
#undef gates
#undef W8
#undef SX
#undef SW
#undef X8
#undef TU
#undef TV
#undef SU
#undef SV
#undef A0
#undef A1
#undef ScT
#undef R
}

#ifndef N_LAUNCH_MODE
#define N_LAUNCH_MODE 1
#endif
extern "C" void kernel_launch(void* const* d_in, const int* in_sizes, int n_in, void* d_out, int out_size, void* d_ws, size_t ws_size, hipStream_t stream) {
    static int grid = 0;
    if (grid == 0) {
        if (n_in != 18 || in_sizes[0] != TP * D || (size_t)out_size != O_END || ws_size < WS_END) {
            fprintf(stderr, "kernel_launch: shape mismatch: n_in %d in0 %d out %d ws %zu (need %zu)\n", n_in, n_in > 0 ? in_sizes[0] : -1, out_size, ws_size, (size_t)WS_END); grid = -1; return; }
        int dev = 0, cus = 0, per_cu = 0;
        if (hipGetDevice(&dev) != hipSuccess || hipDeviceGetAttribute(&cus, hipDeviceAttributeMultiprocessorCount, dev) != hipSuccess) { grid = -1; return; }
        if (hipFuncSetAttribute((const void*)fwd, hipFuncAttributeMaxDynamicSharedMemorySize, LDS_BYTES) != hipSuccess) { fprintf(stderr, "kernel_launch: hipFuncSetAttribute failed\n"); grid = -1; return; }
        if (hipOccupancyMaxActiveBlocksPerMultiprocessor(&per_cu, (const void*)fwd, 512, LDS_BYTES) != hipSuccess || per_cu < 1) { fprintf(stderr, "kernel_launch: occupancy query says %d\n", per_cu); }
        (void)hipGetLastError();
        grid = cus;
    }
    if (grid < 0) return;
    (void)hipMemsetAsync((char*)d_ws + WS_CTL, 0, CTL_BYTES, stream);
    Args a{};
    for (int i = 0; i < 18; ++i) a.in[i] = (const float*)d_in[i];
    a.out = (float*)d_out; a.ws = (unsigned char*)d_ws; a.pad = 0;
#if N_LAUNCH_MODE == 1
    a.ph_lo = 0; a.ph_hi = 1 << 30; a.li = 0;
    hipLaunchKernelGGL(fwd, dim3(grid), dim3(512), LDS_BYTES, stream, a);
#else
    for (int p = 0; p < N_PHASES; ++p) { a.ph_lo = p; a.ph_hi = p + 1; a.li = p; hipLaunchKernelGGL(fwd, dim3(grid), dim3(512), LDS_BYTES, stream, a); }
#endif
}
```

```cpp
#include <hip/hip_runtime.h>
#include <cstdio>
#include <cstdint>
namespace pg8 {
#define PG8_LAS __attribute__((address_space(3)))
typedef unsigned short bf16_t;
typedef short bf16x8 __attribute__((ext_vector_type(8)));
typedef float f32x4 __attribute__((ext_vector_type(4)));
typedef unsigned u32x4 __attribute__((ext_vector_type(4)));
constexpr int BM = 256, BK = 64, HALF = 128, HTB = HALF * BK * 2  , STAGE_BYTES = 8 * HTB, NXCD = 8, WGM = 8;

__host__ __device__ __forceinline__ int lds_byte(int r, int c) { const int st = (r >> 4) * 2 + (c >> 5), rr = r & 15, cc = c & 31, ob = rr * 64 + cc * 2; return st * 1024 + (ob ^ (((ob >> 9) & 1) << 5)); }
__host__ __device__ __forceinline__ void stage_rc(int b, int& R, int& C) { const int st = b / 1024, sb = b % 1024, swz = sb ^ (((sb >> 9) & 1) << 5); R = (st >> 1) * 16 + swz / 64; C = (st & 1) * 32 + (swz % 64) / 2; }
__host__ __device__ __forceinline__ int perm32(int rho) { const int n = rho >> 4, i = rho & 15; return 8 * (i >> 2) + 4 * n + (i & 3); }

struct Unit { int pm, pn; };
struct Gemm { const bf16_t* A; const bf16_t* Bt; int M, N, K; };

struct StaticOrder {
    int nM, nN, nwg, G, c;
    __host__ __device__ void init(int M, int N, int G_, int c_) { nM = M / BM; nN = N / BM; nwg = nM * nN; G = G_; c = c_; }
    __host__ __device__ bool next(int i, Unit& u) const {
        const long L = (long)i * G + c; if (L >= nwg) return false;
        int wgid = (int)L; { const int q = nwg / NXCD, r = nwg % NXCD, xcd = wgid % NXCD, off = wgid / NXCD; wgid = (xcd < r ? xcd * (q + 1) : r * (q + 1) + (xcd - r) * q) + off; }
        const int nig = WGM * nN, gid = wgid / nig, fm = gid * WGM, gsz = (nM - fm) < WGM ? (nM - fm) : WGM;
        u.pm = fm + ((wgid % nig) % gsz); u.pn = (wgid % nig) / gsz; return true;
    }
    __device__ __forceinline__ void a_ready(const Unit&) const {}
    __device__ __forceinline__ void done(const Unit&) const {}
};

typedef float f32x2 __attribute__((ext_vector_type(2)));
typedef __bf16 bf16x2v __attribute__((ext_vector_type(2)));
typedef unsigned u32x2 __attribute__((ext_vector_type(2)));
__device__ __forceinline__ unsigned pk2(float lo, float hi) { const bf16x2v v = __builtin_convertvector((f32x2){lo, hi}, bf16x2v); return __builtin_bit_cast(unsigned, v); }
__device__ __forceinline__ u32x4 pk8(const f32x4 a, const f32x4 b) { u32x4 w; w.x = pk2(a[0], a[1]); w.y = pk2(a[2], a[3]); w.z = pk2(b[0], b[1]); w.w = pk2(b[2], b[3]); return w; }

typedef int i32x4 __attribute__((ext_vector_type(4)));
template <bool I8> struct AccT { typedef f32x4 type; static __device__ __forceinline__ type zero() { return (f32x4){0.f, 0.f, 0.f, 0.f}; } };
template <> struct AccT<true> { typedef i32x4 type; static __device__ __forceinline__ type zero() { return (i32x4){0, 0, 0, 0}; } };
__device__ __forceinline__ f32x4 mma16(const bf16x8 b, const bf16x8 a, const f32x4 c) { return __builtin_amdgcn_mfma_f32_16x16x32_bf16(b, a, c, 0, 0, 0); }
__device__ __forceinline__ i32x4 mma16(const bf16x8 b, const bf16x8 a, const i32x4 c) { return __builtin_amdgcn_mfma_i32_16x16x64_i8(__builtin_bit_cast(i32x4, b), __builtin_bit_cast(i32x4, a), c, 0, 0, 0); }
__device__ __forceinline__ f32x4 dq4(const f32x4 a, const float, const f32x4) { return a; }
__device__ __forceinline__ f32x4 dq4(const i32x4 a, const float ra, const f32x4 cb) { return (f32x4){(float)a[0], (float)a[1], (float)a[2], (float)a[3]} * ra * cb; }
constexpr int TOK_P = 65536;

template <bool I8> struct EpiBf16P {
    static constexpr bool PERM = true, AFTER_DRAIN = false;
    bf16_t* O; int ldc; const float* sa; const float* sb;
    __device__ __forceinline__ void operator()(const typename AccT<I8>::type (&acc)[2][2][4][2], const Unit& u, int wr, int wc, int fr, int fq) const {
        const int row0 = u.pm * BM + wr * 64 + fr, col0 = u.pn * BM + wc * 32 + 8 * fq;
        f32x4 cb[2][2];
#pragma unroll
        for (int bj = 0; bj < 2; ++bj)
#pragma unroll
            for (int n = 0; n < 2; ++n) cb[bj][n] = I8 ? *(const f32x4*)(sb + col0 + bj * HALF + 4 * n) : (f32x4){1.f, 1.f, 1.f, 1.f};
        float rs[2][4];
#pragma unroll
        for (int ai = 0; ai < 2; ++ai)
#pragma unroll
            for (int m = 0; m < 4; ++m) rs[ai][m] = I8 ? sa[row0 + ai * HALF + m * 16] : 1.f;
        __builtin_amdgcn_sched_barrier(0);
#pragma unroll
        for (int ai = 0; ai < 2; ++ai)
#pragma unroll
            for (int m = 0; m < 4; ++m) { const int row = row0 + ai * HALF + m * 16; const float ra = rs[ai][m]; bf16_t* rowp = O + (size_t)row * ldc + col0;
#pragma unroll
                for (int bj = 0; bj < 2; ++bj) *(u32x4*)(rowp + bj * HALF) = pk8(dq4(acc[ai][bj][m][0], ra, cb[bj][0]), dq4(acc[ai][bj][m][1], ra, cb[bj][1])); }
    }
};
template <bool I8> struct EpiGate {
    static constexpr bool PERM = true, AFTER_DRAIN = false;
    bf16_t* U; bf16_t* Bg; const float* sa; const float* sb;
    __device__ __forceinline__ void operator()(const typename AccT<I8>::type (&acc)[2][2][4][2], const Unit& u, int wr, int wc, int fr, int fq) const {
        const int row0 = u.pm * BM + wr * 64 + fr, scol0 = u.pn * BM + wc * 32 + 8 * fq;
        f32x4 cb[2][2];
#pragma unroll
        for (int bj = 0; bj < 2; ++bj)
#pragma unroll
            for (int n = 0; n < 2; ++n) cb[bj][n] = I8 ? *(const f32x4*)(sb + scol0 + bj * HALF + 4 * n) : (f32x4){1.f, 1.f, 1.f, 1.f};
        float rs[2][4];
#pragma unroll
        for (int ai = 0; ai < 2; ++ai)
#pragma unroll
            for (int m = 0; m < 4; ++m) rs[ai][m] = I8 ? sa[row0 + ai * HALF + m * 16] : 1.f;
        __builtin_amdgcn_sched_barrier(0);
        if (u.pn < 8) {
            const int col0 = u.pn * HALF + wc * 32 + 8 * fq;
#pragma unroll
            for (int ai = 0; ai < 2; ++ai)
#pragma unroll
                for (int m = 0; m < 4; ++m) { const int row = row0 + ai * HALF + m * 16; const float ra = rs[ai][m];
                    const f32x4 v0 = dq4(acc[ai][0][m][0], ra, cb[0][0]) * dq4(acc[ai][1][m][0], ra, cb[1][0]), v1 = dq4(acc[ai][0][m][1], ra, cb[0][1]) * dq4(acc[ai][1][m][1], ra, cb[1][1]);
                    *(u32x4*)(U + (size_t)row * 1024 + col0) = pk8(v0, v1); }
        } else {
            const int col0 = (u.pn - 8) * BM + wc * 32 + 8 * fq;
#pragma unroll
            for (int ai = 0; ai < 2; ++ai)
#pragma unroll
                for (int m = 0; m < 4; ++m) { const int row = row0 + ai * HALF + m * 16; const float ra = rs[ai][m]; bf16_t* rowp = Bg + (size_t)row * 1024 + col0;
#pragma unroll
                    for (int bj = 0; bj < 2; ++bj) *(u32x4*)(rowp + bj * HALF) = pk8(dq4(acc[ai][bj][m][0], ra, cb[bj][0]), dq4(acc[ai][bj][m][1], ra, cb[bj][1])); }
        }
    }
};
template <bool I8> struct EpiRes {
    static constexpr bool PERM = true, AFTER_DRAIN = false;
    const bf16_t* H; bf16_t* R; float alpha; const float* sa; const float* sb;
    __device__ __forceinline__ void operator()(const typename AccT<I8>::type (&acc)[2][2][4][2], const Unit& u, int wr, int wc, int fr, int fq) const {
        const int row0 = u.pm * BM + wr * 64 + fr, col0 = u.pn * BM + wc * 32 + 8 * fq;
        f32x4 cb[2][2];
#pragma unroll
        for (int bj = 0; bj < 2; ++bj)
#pragma unroll
            for (int n = 0; n < 2; ++n) cb[bj][n] = I8 ? *(const f32x4*)(sb + col0 + bj * HALF + 4 * n) : (f32x4){1.f, 1.f, 1.f, 1.f};
        float rs[2][4];
#pragma unroll
        for (int ai = 0; ai < 2; ++ai)
#pragma unroll
            for (int m = 0; m < 4; ++m) rs[ai][m] = I8 ? sa[row0 + ai * HALF + m * 16] : 1.f;
        __builtin_amdgcn_sched_barrier(0);
#pragma unroll
        for (int ai = 0; ai < 2; ++ai) {
            u32x4 hq[4][2];
#pragma unroll
            for (int m = 0; m < 4; ++m)
#pragma unroll
                for (int bj = 0; bj < 2; ++bj) hq[m][bj] = *(const u32x4*)(H + (size_t)(row0 + ai * HALF + m * 16) * 1024 + col0 + bj * HALF);
            __builtin_amdgcn_sched_barrier(0);
#pragma unroll
            for (int m = 0; m < 4; ++m) { const int row = row0 + ai * HALF + m * 16; const float ra = rs[ai][m]; const size_t off = (size_t)row * 1024 + col0;
#pragma unroll
                for (int bj = 0; bj < 2; ++bj) { const u32x4 h = hq[m][bj];
                    f32x4 h0, h1; h0[0] = __uint_as_float(h.x << 16); h0[1] = __uint_as_float(h.x & 0xffff0000u); h0[2] = __uint_as_float(h.y << 16); h0[3] = __uint_as_float(h.y & 0xffff0000u);
                    h1[0] = __uint_as_float(h.z << 16); h1[1] = __uint_as_float(h.z & 0xffff0000u); h1[2] = __uint_as_float(h.w << 16); h1[3] = __uint_as_float(h.w & 0xffff0000u);
                    *(u32x4*)(R + off + bj * HALF) = pk8(h0 * alpha + dq4(acc[ai][bj][m][0], ra, cb[bj][0]), h1 * alpha + dq4(acc[ai][bj][m][1], ra, cb[bj][1])); } } }
    }
};
template <bool I8> struct EpiKV {
    static constexpr bool PERM = true, AFTER_DRAIN = false;
    bf16_t* Kb; bf16_t* Vb; float* kp; float* vp; float* ks; float* vs; const float* sa; const float* sb;
    __device__ __forceinline__ void operator()(const typename AccT<I8>::type (&acc)[2][2][4][2], const Unit& u, int wr, int wc, int fr, int fq) const {
        const bool isv = u.pn >= 4; const int colt = (isv ? u.pn - 4 : u.pn) * BM;
        bf16_t* ob = isv ? Vb : Kb; const bool samp = u.pm * BM >= TOK_P;
        float* of = samp ? (isv ? vs : ks) - (size_t)TOK_P * 1024 : (isv ? vp : kp);
        const int row0 = u.pm * BM + wr * 64 + fr, col0 = colt + wc * 32 + 8 * fq, scol0 = u.pn * BM + wc * 32 + 8 * fq;
        float rs[2][4];
#pragma unroll
        for (int ai = 0; ai < 2; ++ai)
#pragma unroll
            for (int m = 0; m < 4; ++m) rs[ai][m] = I8 ? sa[row0 + ai * HALF + m * 16] : 1.f;
        f32x4 cb[2][2];
#pragma unroll
        for (int bj = 0; bj < 2; ++bj)
#pragma unroll
            for (int n = 0; n < 2; ++n) cb[bj][n] = I8 ? *(const f32x4*)(sb + scol0 + bj * HALF + 4 * n) : (f32x4){1.f, 1.f, 1.f, 1.f};
#pragma unroll
        for (int ai = 0; ai < 2; ++ai)
#pragma unroll
            for (int m = 0; m < 4; ++m) { const int row = row0 + ai * HALF + m * 16; const float ra = rs[ai][m]; const size_t off = (size_t)row * 1024 + col0;
#pragma unroll
                for (int bj = 0; bj < 2; ++bj) { const f32x4 v0 = dq4(acc[ai][bj][m][0], ra, cb[bj][0]), v1 = dq4(acc[ai][bj][m][1], ra, cb[bj][1]);
                    *(u32x4*)(ob + off + bj * HALF) = pk8(v0, v1); *(f32x4*)(of + off + bj * HALF) = v0; *(f32x4*)(of + off + bj * HALF + 4) = v1; } }
    }
};

struct EpiScoreI8 {
    static constexpr bool PERM = true, AFTER_DRAIN = false;
    bf16_t* O; int ldc; const float* sa; const float* sb;
    __device__ __forceinline__ void operator()(const i32x4 (&acc)[2][2][4][2], const Unit& u, int wr, int wc, int fr, int fq) const {
        const int row0 = u.pm * BM + wr * 64 + fr, col0 = u.pn * BM + wc * 32 + 8 * fq;
        f32x4 cb[2][2];
#pragma unroll
        for (int bj = 0; bj < 2; ++bj)
#pragma unroll
            for (int n = 0; n < 2; ++n) cb[bj][n] = *(const f32x4*)(sb + col0 + bj * HALF + 4 * n);
        float rs[2][4];
#pragma unroll
        for (int ai = 0; ai < 2; ++ai)
#pragma unroll
            for (int m = 0; m < 4; ++m) rs[ai][m] = sa[row0 + ai * HALF + m * 16];
        __builtin_amdgcn_sched_barrier(0);
#pragma unroll
        for (int ai = 0; ai < 2; ++ai)
#pragma unroll
            for (int m = 0; m < 4; ++m) { const int row = row0 + ai * HALF + m * 16; const float ra = rs[ai][m]; bf16_t* rowp = O + (size_t)row * ldc + col0;
#pragma unroll
                for (int bj = 0; bj < 2; ++bj) { f32x4 v0, v1;
#pragma unroll
                    for (int i = 0; i < 4; ++i) { v0[i] = (float)acc[ai][bj][m][0][i] * ra * cb[bj][0][i]; v1[i] = (float)acc[ai][bj][m][1][i] * ra * cb[bj][1][i]; }
                    *(u32x4*)(rowp + bj * HALF) = pk8(v0, v1); } }
    }
};

template <class Epi, class Sched, bool ALIGN_EPI = false, bool SP2 = false, bool I8 = false>
__device__ __forceinline__ void gemm_phase(PG8_LAS unsigned char* lds, const Gemm g, const Sched& S, const Epi& E, const int tid_in) {
    int tid_ = tid_in; asm volatile("" : "+v"(tid_));
    const int tid = tid_, wid = __builtin_amdgcn_readfirstlane(tid >> 6), lane = tid & 63, wr = wid >> 2, wc = wid & 3, fr = lane & 15, fq = lane >> 4;
    const int K = g.K, nt = K / BK;
    unsigned voffA[2], voffB[2];
#pragma unroll
    for (int i = 0; i < 2; ++i) { int R, C; stage_rc(tid * 16 + i * 8192, R, C); const int Rb = Epi::PERM ? ((R & ~31) + perm32(R & 31)) : R;
        voffA[i] = (unsigned)(R * K + C) * 2u; voffB[i] = (unsigned)(Rb * K + C) * 2u; }
    const size_t kstep = (size_t)(BK * 2);
    const size_t hstep = (size_t)HALF * K * 2;
    const size_t tstep = 2 * hstep;
    const unsigned ldsw = (unsigned)wid * 1024u;
    const int aoff = lds_byte(wr * 64 + fr, fq * 8), boff = lds_byte(wc * 32 + fr, fq * 8);
#define PG8_SA(b, h) (((b) * 2 + (h)) * HTB)
#define PG8_SB(b, h) ((4 + (b) * 2 + (h)) * HTB)
#define PG8_STAGE(bufoff, gbase, voff) do { _Pragma("unroll") for (int _i = 0; _i < 2; ++_i) \
        __builtin_amdgcn_global_load_lds((const unsigned*)((const char*)(gbase) + (voff)[_i]), (PG8_LAS unsigned*)(lds + (bufoff) + ldsw + _i * 8192), 16, 0, 0); } while (0)
#define PG8_LDA(dst, b, h) do { _Pragma("unroll") for (int m = 0; m < 4; ++m) _Pragma("unroll") for (int k = 0; k < 2; ++k) dst[m][k] = *(const PG8_LAS bf16x8*)(lds + PG8_SA(b, h) + aoff + m * 2048 + k * 1024); } while (0)
#define PG8_LDB(dst, b, h) do { _Pragma("unroll") for (int n = 0; n < 2; ++n) _Pragma("unroll") for (int k = 0; k < 2; ++k) dst[n][k] = *(const PG8_LAS bf16x8*)(lds + PG8_SB(b, h) + boff + n * 2048 + k * 1024); } while (0)
#define PG8_MMA(ai, bj, At, Bt) do { __builtin_amdgcn_s_setprio(1); _Pragma("unroll") for (int m = 0; m < 4; ++m) _Pragma("unroll") for (int n = 0; n < 2; ++n) _Pragma("unroll") for (int k = 0; k < 2; ++k) \
        acc[ai][bj][m][n] = mma16(Bt[n][k], At[m][k], acc[ai][bj][m][n]); __builtin_amdgcn_s_setprio(0); } while (0)
#define PG8_WAIT_V(n) asm volatile("s_waitcnt vmcnt(" #n ")" ::: "memory")
#define PG8_WAIT_L(n) asm volatile("s_waitcnt lgkmcnt(" #n ")" ::: "memory")
#define PG8_BAR __builtin_amdgcn_s_barrier()
#define PG8_SCHED __builtin_amdgcn_sched_barrier(0)
    Unit cur, nxt; int ui = 0;
    if (!S.next(0, cur)) return;
    typename AccT<I8>::type acc[2][2][4][2];
#pragma unroll
    for (int a = 0; a < 2; ++a)
#pragma unroll
        for (int b = 0; b < 2; ++b)
#pragma unroll
            for (int m = 0; m < 4; ++m)
#pragma unroll
                for (int n = 0; n < 2; ++n) acc[a][b][m][n] = AccT<I8>::zero();
    bf16x8 At[4][2], B0[2][2], B1[2][2];
    const char* cA = (const char*)g.A + (size_t)cur.pm * tstep; const char* cB = (const char*)g.Bt + (size_t)cur.pn * tstep;
    S.a_ready(cur);
    if constexpr (SP2) {
        PG8_STAGE(PG8_SB(0, 0), cB, voffB); PG8_STAGE(PG8_SB(0, 1), cB + hstep, voffB); PG8_STAGE(PG8_SA(0, 0), cA, voffA); PG8_STAGE(PG8_SA(0, 1), cA + hstep, voffA);
        if (wr == 1) PG8_BAR;
        PG8_WAIT_V(2); PG8_BAR;
        PG8_STAGE(PG8_SB(1, 0), cB + kstep, voffB); PG8_STAGE(PG8_SA(1, 0), cA + kstep, voffA); PG8_STAGE(PG8_SB(1, 1), cB + hstep + kstep, voffB);
        PG8_WAIT_V(6); PG8_BAR;
    } else {
        PG8_STAGE(PG8_SB(0, 0), cB, voffB); PG8_STAGE(PG8_SA(0, 0), cA, voffA); PG8_STAGE(PG8_SB(0, 1), cB + hstep, voffB); PG8_STAGE(PG8_SA(0, 1), cA + hstep, voffA);
        if (wr == 1) PG8_BAR;
        PG8_WAIT_V(4); PG8_BAR;
        PG8_STAGE(PG8_SB(1, 0), cB + kstep, voffB); PG8_STAGE(PG8_SA(1, 0), cA + kstep, voffA); PG8_STAGE(PG8_SB(1, 1), cB + hstep + kstep, voffB);
        PG8_WAIT_V(6); PG8_BAR;
    }
    for (;;) {
        const bool has_next = S.next(ui + 1, nxt);
        const char* nA = has_next ? (const char*)g.A + (size_t)nxt.pm * tstep : cA; const char* nB = has_next ? (const char*)g.Bt + (size_t)nxt.pn * tstep : cB;
        for (int t = 0; t < nt; t += 2) {
            const bool last = (t == nt - 2);
            const char* a1 = cA + (size_t)(t + 1) * kstep;
            const char* a2 = last ? nA : cA + (size_t)(t + 2) * kstep; const char* b2 = last ? nB : cB + (size_t)(t + 2) * kstep;
            const char* a3 = a2 + kstep; const char* b3 = b2 + kstep;
            if (last && has_next) S.a_ready(nxt);
            if constexpr (SP2) {
            PG8_LDB(B0, 0, 0); PG8_LDB(B1, 0, 1); PG8_SCHED; PG8_LDA(At, 0, 0); PG8_STAGE(PG8_SA(1, 1), a1 + hstep, voffA);
            PG8_WAIT_V(8); PG8_WAIT_L(0); PG8_BAR; PG8_MMA(0, 0, At, B0); PG8_MMA(0, 1, At, B1); PG8_BAR; PG8_SCHED;
            PG8_LDA(At, 0, 1); PG8_STAGE(PG8_SB(0, 0), b2, voffB); PG8_STAGE(PG8_SB(0, 1), b2 + hstep, voffB); PG8_STAGE(PG8_SA(0, 0), a2, voffA);
            PG8_WAIT_V(8); PG8_WAIT_L(0); PG8_BAR; PG8_MMA(1, 0, At, B0); PG8_MMA(1, 1, At, B1); PG8_BAR; PG8_SCHED;
            PG8_LDB(B0, 1, 0); PG8_LDB(B1, 1, 1); PG8_SCHED; PG8_LDA(At, 1, 0); PG8_STAGE(PG8_SA(0, 1), a2 + hstep, voffA);
            PG8_WAIT_V(8); PG8_WAIT_L(0); PG8_BAR; PG8_MMA(0, 0, At, B0); PG8_MMA(0, 1, At, B1); PG8_BAR; PG8_SCHED;
            PG8_LDA(At, 1, 1); PG8_STAGE(PG8_SB(1, 0), b3, voffB); PG8_STAGE(PG8_SB(1, 1), b3 + hstep, voffB); PG8_STAGE(PG8_SA(1, 0), a3, voffA);
            PG8_WAIT_V(8); PG8_WAIT_L(0); PG8_BAR; PG8_MMA(1, 0, At, B0); PG8_MMA(1, 1, At, B1); PG8_BAR; PG8_SCHED;
            } else {
            PG8_LDB(B0, 0, 0); PG8_SCHED; PG8_LDA(At, 0, 0); PG8_STAGE(PG8_SA(1, 1), a1 + hstep, voffA);
            PG8_WAIT_L(8); PG8_BAR; PG8_WAIT_L(0); PG8_MMA(0, 0, At, B0); PG8_BAR; PG8_SCHED;
            PG8_LDB(B1, 0, 1); PG8_STAGE(PG8_SB(0, 0), b2, voffB);
            PG8_BAR; PG8_WAIT_L(0); PG8_MMA(0, 1, At, B1); PG8_BAR;
            PG8_LDA(At, 0, 1); PG8_STAGE(PG8_SA(0, 0), a2, voffA);
            PG8_BAR; PG8_WAIT_L(0); PG8_MMA(1, 0, At, B0); PG8_BAR; PG8_SCHED;
            PG8_STAGE(PG8_SB(0, 1), b2 + hstep, voffB);
            PG8_WAIT_V(6); PG8_BAR; PG8_MMA(1, 1, At, B1); PG8_BAR;
            PG8_LDB(B0, 1, 0); PG8_SCHED; PG8_LDA(At, 1, 0); PG8_STAGE(PG8_SA(0, 1), a2 + hstep, voffA);
            PG8_WAIT_L(8); PG8_BAR; PG8_WAIT_L(0); PG8_MMA(0, 0, At, B0); PG8_BAR; PG8_SCHED;
            PG8_LDB(B1, 1, 1); PG8_STAGE(PG8_SB(1, 0), b3, voffB);
            PG8_BAR; PG8_WAIT_L(0); PG8_MMA(0, 1, At, B1); PG8_BAR;
            PG8_LDA(At, 1, 1); PG8_STAGE(PG8_SA(1, 0), a3, voffA);
            PG8_BAR; PG8_WAIT_L(0); PG8_MMA(1, 0, At, B0); PG8_BAR; PG8_SCHED;
            PG8_STAGE(PG8_SB(1, 1), b3 + hstep, voffB);
            PG8_WAIT_V(6); PG8_BAR; PG8_MMA(1, 1, At, B1); PG8_BAR;
            }
        }
        if constexpr (ALIGN_EPI) { if (wr == 0) PG8_BAR; }
        if constexpr (!Epi::AFTER_DRAIN) { E(acc, cur, wr, wc, fr, fq); S.done(cur); }
        if (!has_next) break;
#pragma unroll
        for (int a = 0; a < 2; ++a)
#pragma unroll
            for (int b = 0; b < 2; ++b)
#pragma unroll
                for (int m = 0; m < 4; ++m)
#pragma unroll
                    for (int n = 0; n < 2; ++n) acc[a][b][m][n] = AccT<I8>::zero();
        cur = nxt; cA = nA; cB = nB; ++ui;
        if constexpr (ALIGN_EPI) { if (wr == 1) PG8_BAR; }
    }
    PG8_WAIT_V(0);
    if constexpr (!ALIGN_EPI) { if (wr == 0) PG8_BAR; }
    PG8_BAR;
    if constexpr (Epi::AFTER_DRAIN) { E.fused(acc, cur, wr, wc, fr, fq, lds, wid, lane); S.done(cur); }
#undef PG8_SA
#undef PG8_SB
#undef PG8_STAGE
#undef PG8_LDA
#undef PG8_LDB
#undef PG8_MMA
#undef PG8_WAIT_V
#undef PG8_WAIT_L
#undef PG8_BAR
#undef PG8_SCHED
}
}

#define GAS __attribute__((address_space(1)))
#define LAS __attribute__((address_space(3)))
#define DI __device__ __forceinline__
typedef unsigned short bf16;
typedef unsigned v4u __attribute__((ext_vector_type(4)));
typedef unsigned v2u __attribute__((ext_vector_type(2)));
typedef float f32x4 __attribute__((ext_vector_type(4)));
typedef float f32x16 __attribute__((ext_vector_type(16)));
typedef short bf16x8 __attribute__((ext_vector_type(8)));
using pg8::pk2;
#define LDS_WAIT() asm volatile("s_waitcnt lgkmcnt(0)" ::: "memory")
#define MFMA32(a, b, c) __builtin_amdgcn_mfma_f32_32x32x16_bf16((a), (b), (c), 0, 0, 0)

constexpr int D = 1024, NB = 32, SEQ = 2048, DSEQ = 16, PAST = 1024, NH = 16, DH = 64;
constexpr int TP = NB * SEQ, TS = NB * DSEQ, T = TP + TS;
constexpr int NEXP = 16384, PH = 8, PK = 16;
constexpr int NLAYER = 4;
constexpr float LN_EPS = 1e-5f;
constexpr float ALPHA = 1.6817928305074292f;
constexpr float LOG2E = 1.4426950408889634f, LN2 = 0.6931471805599453f;
static_assert(T % 256 == 0 && pg8::TOK_P == TP, "row panels");
constexpr size_t O_Y = 0, O_YS = (size_t)TP * D, O_CONVP = O_YS + (size_t)TS * D, O_KP = O_CONVP + 2 * NB * 2 * D, O_VP = O_KP + (size_t)TP * D,
                 O_CONVS = O_VP + (size_t)TP * D, O_KS = O_CONVS + 2 * NB * 2 * D, O_VS = O_KS + (size_t)TS * D, O_END = O_VS + (size_t)TS * D;
static_assert(O_END == 203161600ull, "output size");
constexpr size_t MiB = 1u << 20;
constexpr size_t WS_CTL = 0, CTL_BYTES = 2 * MiB;
constexpr size_t WS_WIN = 2 * MiB;
constexpr size_t WS_WOUT = WS_WIN + 12 * MiB;
constexpr size_t WS_WQ = WS_WOUT + 4 * MiB;
constexpr size_t WS_WO = WS_WQ + 4 * MiB;
constexpr size_t WS_WKV = WS_WO + 4 * MiB;
constexpr size_t WS_WP = WS_WKV + 4 * MiB;
constexpr size_t WS_VSN = WS_WP + 16 * MiB;
constexpr size_t WS_H = WS_VSN + 1 * MiB;
constexpr size_t WS_KB = WS_H + 129 * MiB;
constexpr size_t WS_VT = WS_KB + 129 * MiB;
constexpr size_t WS_IDS = WS_VT + 128 * MiB;
constexpr size_t WS_GATE = WS_IDS + 17 * MiB;
constexpr size_t WS_TU = WS_GATE + 33 * MiB;
constexpr size_t WS_TV = WS_TU + 64 * MiB;
constexpr size_t WS_SU = WS_TV + 64 * MiB;
constexpr size_t WS_W8 = WS_SU + 1 * MiB;
constexpr size_t WS_SX = WS_W8 + 9 * MiB;
constexpr size_t WS_X8 = WS_SX + 1 * MiB;
constexpr size_t WS_W8A = WS_X8 + 65 * MiB;
constexpr size_t WS_SWA = WS_W8A + 22 * MiB;
constexpr int W8_ROWS = (int)((WS_VSN - WS_WIN) / 2048);
static_assert(W8_ROWS == 22528, "weight rows");
constexpr size_t WS_A = WS_SWA + 1 * MiB;
constexpr size_t WS_END = WS_A + 258 * MiB;
static_assert((size_t)T * D * 2 == 129 * MiB && (size_t)1024 * T * 4 == 258 * MiB, "sizes");
constexpr int CW_Q = 1024;
constexpr int CW_BAR = 16384;

constexpr int RING_BYTES = 131072, MISC_OFF = RING_BYTES + 320, LDS_BYTES = 147456;

#define XB_TMO      128
#define XB_XCNT(j)  (256  + 64 * (j))
#define XB_XSUB(j)  (1280 + 64 * (j))
#define XB_XGEN(j)  (2304 + 64 * (j))
#define XB_TOP      3328
#define XB_TOPGEN   3392
#define XCD_BAR_WORDS 3456
#define XB_SPIN_CAP (1u << 18)

__device__ __forceinline__ unsigned xb_ld(unsigned* p)              { return __hip_atomic_load(p, __ATOMIC_RELAXED, __HIP_MEMORY_SCOPE_AGENT); }
__device__ __forceinline__ unsigned xb_add(unsigned* p, unsigned v) { return __hip_atomic_fetch_add(p, v, __ATOMIC_RELAXED, __HIP_MEMORY_SCOPE_AGENT); }
__device__ __forceinline__ unsigned xb_xcc_id() { return (unsigned)__builtin_amdgcn_s_getreg((3 << 11) | 20) & 0xFu; }
#define XB_SPIN(cond, bar) do { unsigned _sp = 0; while (cond) { __builtin_amdgcn_s_sleep(1); \
    if ((++_sp & 255u) == 0u) { if (xb_ld(&(bar)[XB_TMO])) break; if (_sp > XB_SPIN_CAP) { atomicAdd(&(bar)[XB_TMO], 1u); break; } } } } while (0)

__device__ __forceinline__ int xb_lane_id() { int l; asm volatile("v_mbcnt_lo_u32_b32 %0, -1, 0\n\tv_mbcnt_hi_u32_b32 %0, -1, %0" : "=v"(l)); return l; }
__device__ __forceinline__ bool xb_is_thread0(unsigned w0) { return w0 != 0u && xb_lane_id() == 0; }
struct XcdBarrier {
    unsigned w0;
    unsigned* bar; unsigned x;
    volatile LAS unsigned* st;
};

__device__ __forceinline__ XcdBarrier xcd_barrier_post(unsigned* bar, volatile LAS unsigned* st, unsigned w0) {
    XcdBarrier b; b.w0 = w0; b.bar = bar; b.x = xb_xcc_id(); b.st = st;
    if (xb_is_thread0(b.w0)) (void)xb_add(&bar[XB_XCNT(b.x)], 1u);
    return b;
}
__device__ __forceinline__ void xcd_barrier_complete(unsigned* bar, unsigned x, unsigned& nloc, unsigned& nx) {
    const unsigned G = gridDim.x * gridDim.y * gridDim.z;
    unsigned sum, cnt, mine, sp = 0u;
    for (;;) {
        sum = 0u; cnt = 0u; mine = 0u;
#pragma unroll
        for (unsigned j = 0; j < 16; ++j) { const unsigned c = xb_ld(&bar[XB_XCNT(j)]); sum += c; cnt += (c > 0u) ? 1u : 0u; mine = (j == x) ? c : mine; }
        if (sum == G) break;
        __builtin_amdgcn_s_sleep(1);
        if ((++sp & 255u) == 0u) { if (xb_ld(&bar[XB_TMO])) break; if (sp > XB_SPIN_CAP) { atomicAdd(&bar[XB_TMO], 1u); break; } }
    }
    nloc = mine > 0u ? mine : 1u; nx = cnt > 0u ? cnt : 1u;
}

__device__ __forceinline__ void xcd_barrier(const XcdBarrier& b) {
    asm volatile("s_waitcnt vmcnt(0)" ::: "memory");
    __syncthreads();
    if (xb_is_thread0(b.w0)) {
        unsigned* bar = b.bar;
        __builtin_amdgcn_s_waitcnt(0);
        unsigned nloc = b.st[0], nx = b.st[1];
        if (nloc == 0u) { xcd_barrier_complete(bar, b.x, nloc, nx); b.st[0] = nloc; b.st[1] = nx; }
        const unsigned old = xb_add(&bar[XB_XSUB(b.x)], 1u);
        const unsigned gen = old / nloc;
        if (old + 1u == (gen + 1u) * nloc) {
            __builtin_amdgcn_fence(__ATOMIC_RELEASE, "agent");
            asm volatile("s_waitcnt vmcnt(0)" ::: "memory");
            const unsigned og = xb_add(&bar[XB_TOP], 1u);
            const unsigned tg = og / nx;
            if (og + 1u == (tg + 1u) * nx) xb_add(&bar[XB_TOPGEN], 1u);
            else XB_SPIN(xb_ld(&bar[XB_TOPGEN]) == tg, bar);
            __builtin_amdgcn_fence(__ATOMIC_ACQUIRE, "agent");
            xb_add(&bar[XB_XGEN(b.x)], 1u);
            asm volatile("s_waitcnt vmcnt(0)" ::: "memory");
        } else {
            XB_SPIN(xb_ld(&bar[XB_XGEN(b.x)]) == gen, bar);
            __builtin_amdgcn_fence(__ATOMIC_ACQUIRE, "agent");
            asm volatile("s_waitcnt vmcnt(0)" ::: "memory");
        }
    }
    __syncthreads();
}


DI float bflo(unsigned w) { return __uint_as_float(w << 16); }
DI float bfhi(unsigned w) { return __uint_as_float(w & 0xffff0000u); }
DI int shx(const int lane, const int v, const int o) {
    if (o == 1) return __builtin_amdgcn_update_dpp(v, v, 0xB1, 0xf, 0xf, false);
    if (o == 2) return __builtin_amdgcn_update_dpp(v, v, 0x4E, 0xf, 0xf, false);
    if (o == 8) return __builtin_amdgcn_update_dpp(v, v, 0x128, 0xf, 0xf, false);
    if (o == 4) return __builtin_amdgcn_ds_swizzle(v, 0x101F);
    if (o == 16) return __builtin_amdgcn_ds_swizzle(v, 0x401F);
    return __builtin_amdgcn_ds_bpermute((lane ^ o) << 2, v);
}
DI float shx(const int lane, const float v, const int o) { return __int_as_float(shx(lane, __float_as_int(v), o)); }
template <int CTRL> DI float dpp_f(const float v) { return __int_as_float(__builtin_amdgcn_update_dpp(__float_as_int(v), __float_as_int(v), CTRL, 0xf, 0xf, false)); }
DI float wave_sum(const int lane, float v) {
    (void)lane;
    v += dpp_f<0xB1>(v); v += dpp_f<0x4E>(v); v += dpp_f<0x141>(v); v += dpp_f<0x140>(v);
    { const auto r = __builtin_amdgcn_permlane16_swap(__float_as_uint(v), __float_as_uint(v), false, false); v = __uint_as_float(r[0]) + __uint_as_float(r[1]); }
    { const auto r = __builtin_amdgcn_permlane32_swap(__float_as_uint(v), __float_as_uint(v), false, false); v = __uint_as_float(r[0]) + __uint_as_float(r[1]); }
    return v;
}
DI float max32(float v) {
    v = __builtin_fmaxf(v, dpp_f<0xB1>(v)); v = __builtin_fmaxf(v, dpp_f<0x4E>(v)); v = __builtin_fmaxf(v, dpp_f<0x141>(v)); v = __builtin_fmaxf(v, dpp_f<0x140>(v));
    { const auto r = __builtin_amdgcn_permlane16_swap(__float_as_uint(v), __float_as_uint(v), false, false); v = __builtin_fmaxf(__uint_as_float(r[0]), __uint_as_float(r[1])); }
    return v;
}
DI float wave_max(float v) {
    v = max32(v);
    { const auto r = __builtin_amdgcn_permlane32_swap(__float_as_uint(v), __float_as_uint(v), false, false); v = __builtin_fmaxf(__uint_as_float(r[0]), __uint_as_float(r[1])); }
    return v;
}
DI bf16x8 pack8(float a0, float a1, float a2, float a3, float a4, float a5, float a6, float a7) {
    v4u p; p.x = pk2(a0, a1); p.y = pk2(a2, a3); p.z = pk2(a4, a5); p.w = pk2(a6, a7); return __builtin_bit_cast(bf16x8, p);
}
DI float gelu_erf(float v) {
    const float av = __builtin_fabsf(v), d = av * 0.2316418882f + 1.0f, t = __builtin_amdgcn_rcpf(d);
    float q = t * 0.5307027145f + (-0.7265760135f); q = q * t + 0.7107068705f; q = q * t + (-0.142248368f); q = q * t + 0.127414796f; q = q * t;
    const float e = __builtin_amdgcn_exp2f((v * v) * (-0.72134752044f));
    const float m = v * (q * e), r = v - m;
    return v < 0.f ? m : r;
}

struct Ctx {
    int tid, lane, wave, vcu, G;
};

DI void p0_transpose_item(const float* W, int K, int N, bf16* WT, int out_row0, float scale, LAS float* scr, int k0, int n0, int lane) {
#pragma unroll 8
    for (int i = 0; i < 32; ++i) { const int kk = 2 * i + (lane >> 5); scr[kk * 33 + (lane & 31)] = W[(size_t)(k0 + kk) * N + n0 + (lane & 31)]; }
    LDS_WAIT(); asm volatile("" ::: "memory");
    const int c = lane & 7;
#pragma unroll
    for (int j = 0; j < 4; ++j) { const int n = (lane >> 3) + 8 * j; const LAS float* s = scr + (8 * c) * 33 + n;
        v4u o; o.x = pk2(s[0 * 33] * scale, s[1 * 33] * scale); o.y = pk2(s[2 * 33] * scale, s[3 * 33] * scale); o.z = pk2(s[4 * 33] * scale, s[5 * 33] * scale); o.w = pk2(s[6 * 33] * scale, s[7 * 33] * scale);
        *(v4u*)(WT + (size_t)(out_row0 + n) * K + k0 + 8 * c) = o; }
    LDS_WAIT(); asm volatile("" ::: "memory");
}
DI void cvt_stream(const float* src, bf16* dst, size_t n8, size_t gtid, size_t NT) {
    size_t i = gtid;
    for (; i + 3 * NT < n8; i += 4 * NT) {
        f32x4 a[4], b[4];
#pragma unroll
        for (int u = 0; u < 4; ++u) { a[u] = *(const f32x4*)(src + (i + u * NT) * 8); b[u] = *(const f32x4*)(src + (i + u * NT) * 8 + 4); }
#pragma unroll
        for (int u = 0; u < 4; ++u) *(v4u*)(dst + (i + u * NT) * 8) = pg8::pk8(a[u], b[u]);
    }
    for (; i < n8; i += NT) { const f32x4 a = *(const f32x4*)(src + i * 8), b = *(const f32x4*)(src + i * 8 + 4); *(v4u*)(dst + i * 8) = pg8::pk8(a, b); }
}
DI unsigned q4_i8(const f32x4 v, const float k) {
    const int a = (int)__builtin_rintf(v[0] * k), b = (int)__builtin_rintf(v[1] * k), c = (int)__builtin_rintf(v[2] * k), d = (int)__builtin_rintf(v[3] * k);
    return ((unsigned)a & 0xffu) | (((unsigned)b & 0xffu) << 8) | (((unsigned)c & 0xffu) << 16) | ((unsigned)d << 24);
}
DI void cvt_table_rows(const float* src, unsigned char* dst, float* scl  , int nrows, int gw, int NGW, int lane) {
    f32x4 nx[4];
#pragma unroll
    for (int j = 0; j < 4; ++j) nx[j] = *(const f32x4*)(src + (size_t)(gw < nrows ? gw : 0) * D + 4 * lane + 256 * j);
    for (int row = gw; row < nrows; row += NGW) {
        f32x4 v[4]; float m = 0.f; const int rn = row + NGW < nrows ? row + NGW : row;
#pragma unroll
        for (int j = 0; j < 4; ++j) { v[j] = nx[j]; nx[j] = *(const f32x4*)(src + (size_t)rn * D + 4 * lane + 256 * j);
            m = __builtin_fmaxf(m, __builtin_fmaxf(__builtin_fmaxf(__builtin_fabsf(v[j][0]), __builtin_fabsf(v[j][1])), __builtin_fmaxf(__builtin_fabsf(v[j][2]), __builtin_fabsf(v[j][3])))); }
        m = wave_max(m);
        const float k = m > 0.f ? 127.0f / m : 0.f;
#pragma unroll
        for (int j = 0; j < 4; ++j)
            *(unsigned*)(dst + ((size_t)(row >> 14) * NEXP * D) + ((size_t)(2 * j + (lane >> 5)) * NEXP + (row & (NEXP - 1))) * 128 + ((4 * lane) & 127)) = q4_i8(v[j], k);
        if (lane == 0) scl[2 * row] = m * (1.0f / 127.0f);
    }
}
struct P0Args { const float *x_p, *x_s, *w_in, *w_out, *wq, *wo, *wk, *wv, *pwq, *psk, *pu, *pv; bf16 *WinT, *WoutT, *WqT, *WoT, *WkvT, *WP, *H; unsigned char *TU, *TV; float *SU, *SV; unsigned char* X8; float* SX; };
DI void p0_prologue(const Ctx c, LAS unsigned char* lds, const P0Args a) {
    for (int half = 0; half < 2; ++half) {
    if (((c.vcu & 1) == 1) == (half == 0)) {
    { LAS float* scr = (LAS float*)(lds + c.wave * 16384);
      const int gw = c.vcu * 8 + c.wave, NGW = c.G * 8;
      constexpr int IT_WIN = 16 * 96, IT_SQ = 16 * 32, NITEMS = 2 * IT_WIN + 8 * IT_SQ;
      for (int it = gw; it < NITEMS; it += NGW) {
          int r = it;
          if (r < 2 * IT_WIN) { const int l = r / IT_WIN; r -= l * IT_WIN; const int kb = r / 96, nb = r % 96, n0 = 32 * nb; int orow;
              if (n0 < 1024) orow = 2048 + n0; else if (n0 < 2048) { const int d = n0 - 1024; orow = 256 * (d >> 7) + (d & 127); } else { const int d = n0 - 2048; orow = 256 * (d >> 7) + 128 + (d & 127); }
              p0_transpose_item(a.w_in + (size_t)l * 1024 * 3072, 1024, 3072, a.WinT + (size_t)l * 3072 * 1024, orow, 1.f, scr, 64 * kb, n0, c.lane); continue; }
          r -= 2 * IT_WIN; const int m = r / IT_SQ; r -= m * IT_SQ; const int kb = r >> 5, nb = r & 31;
          const float* src; bf16* dst; float sc = 1.f; const size_t SQ = (size_t)1024 * 1024;
          if (m < 2) { src = a.w_out + m * SQ; dst = a.WoutT + m * SQ; }
          else if (m < 4) { src = a.wq + (m - 2) * SQ; dst = a.WqT + (m - 2) * SQ; sc = 0.125f * LOG2E; }
          else if (m < 6) { src = a.wo + (m - 4) * SQ; dst = a.WoT + (m - 4) * SQ; }
          else if (m == 6) { src = a.wk; dst = a.WkvT; }
          else { src = a.wv; dst = a.WkvT + SQ; }
          p0_transpose_item(src, 1024, 1024, dst, 32 * nb, sc, scr, 64 * kb, 32 * nb, c.lane);
      }
    }
    __syncthreads();
    { LAS float* skT = (LAS float*)lds; LAS float* wqT = skT + 128 * 132;
      for (int u = c.vcu; u < 4 * 16 * 16; u += c.G) {
          const int l = u >> 8, hp = (u >> 4) & 15, dblk = u & 15;
          for (int i = c.tid; i < 16384; i += 512) skT[(i & 127) * 132 + (i >> 7)] = a.psk[(size_t)(l * 16 + hp) * 16384 + i];
          for (int i = c.tid; i < 8192; i += 512) wqT[(i & 127) * 68 + (i >> 7)] = a.pwq[((size_t)l * 1024 + dblk * 64 + (i >> 7)) * 2048 + hp * 128 + (i & 127)];
          __syncthreads();
          const int ng = c.tid & 31, dg = c.tid >> 5; f32x4 acc[4];
#pragma unroll
          for (int i = 0; i < 4; ++i) acc[i] = (f32x4){0.f, 0.f, 0.f, 0.f};
#pragma unroll 4
          for (int cc = 0; cc < 128; ++cc) { const f32x4 s = *(const LAS f32x4*)(skT + cc * 132 + 4 * ng), w = *(const LAS f32x4*)(wqT + cc * 68 + 4 * dg);
#pragma unroll
              for (int i = 0; i < 4; ++i) acc[i] = acc[i] + w * s[i]; }
#pragma unroll
          for (int i = 0; i < 4; ++i) { v2u o; o.x = pk2(acc[i][0], acc[i][1]); o.y = pk2(acc[i][2], acc[i][3]);
              *(v2u*)(a.WP + ((size_t)l * 2048 + hp * 128 + 4 * ng + i) * 1024 + dblk * 64 + 4 * dg) = o; }
          __syncthreads();
      }
    }
    } else {
    { const size_t gtid = (size_t)c.vcu * 512 + c.tid, NT = (size_t)c.G * 512;
      cvt_table_rows(a.pu, a.TU, a.SU, NLAYER * NEXP, c.vcu * 8 + c.wave, c.G * 8, c.lane);
      cvt_table_rows(a.pv, a.TV, a.SV, NLAYER * NEXP, c.vcu * 8 + c.wave, c.G * 8, c.lane);
      (void)gtid; (void)NT;
      for (int m = c.vcu * 8 + c.wave; m < T; m += c.G * 8) {
          const float* xr = (m < TP ? a.x_p + (size_t)m * D : a.x_s + (size_t)(m - TP) * D) + 4 * c.lane;
          f32x4 v[4]; float am = 0.f;
#pragma unroll
          for (int j = 0; j < 4; ++j) { v[j] = *(const f32x4*)(xr + 256 * j); v2u w; w.x = pk2(v[j][0], v[j][1]); w.y = pk2(v[j][2], v[j][3]); ((v2u*)(a.H + (size_t)m * D) + c.lane)[64 * j] = w;
              am = __builtin_fmaxf(am, __builtin_fmaxf(__builtin_fmaxf(__builtin_fabsf(v[j][0]), __builtin_fabsf(v[j][1])), __builtin_fmaxf(__builtin_fabsf(v[j][2]), __builtin_fabsf(v[j][3])))); }
          am = wave_max(am);
          const float k = am > 0.f ? 127.0f / am : 0.f;
#pragma unroll
          for (int j = 0; j < 4; ++j) *(unsigned*)(a.X8 + (size_t)m * D + 4 * c.lane + 256 * j) = q4_i8(v[j], k);
          if (c.lane == 0) a.SX[m] = am * (1.0f / 127.0f);
      }
    }
    }
    __syncthreads();
    }
}

DI void wp_quant_phase(const Ctx c, const bf16* WPb, unsigned char* WP8q, float* swp) {
    for (int row = c.vcu * 8 + c.wave; row < W8_ROWS; row += c.G * 8) {
        const v4u a = *(const v4u*)(WPb + (size_t)row * D + 16 * c.lane), b = *(const v4u*)(WPb + (size_t)row * D + 16 * c.lane + 8);
        const f32x4 v0 = {bflo(a.x), bfhi(a.x), bflo(a.y), bfhi(a.y)}, v1 = {bflo(a.z), bfhi(a.z), bflo(a.w), bfhi(a.w)}, v2 = {bflo(b.x), bfhi(b.x), bflo(b.y), bfhi(b.y)}, v3 = {bflo(b.z), bfhi(b.z), bflo(b.w), bfhi(b.w)};
        float m = 0.f;
#pragma unroll
        for (int i = 0; i < 4; ++i) m = __builtin_fmaxf(m, __builtin_fmaxf(__builtin_fmaxf(__builtin_fabsf(v0[i]), __builtin_fabsf(v1[i])), __builtin_fmaxf(__builtin_fabsf(v2[i]), __builtin_fabsf(v3[i]))));
        m = wave_max(m);
        const float k = m > 0.f ? 127.0f / m : 0.f;
        v4u o; o.x = q4_i8(v0, k); o.y = q4_i8(v1, k); o.z = q4_i8(v2, k); o.w = q4_i8(v3, k);
        *(v4u*)(WP8q + (size_t)row * D + 16 * c.lane) = o;
        if (c.lane == 0) swp[row] = m * (1.0f / 127.0f);
    }
}

DI void ld8_bf16(const bf16* p, float (&o)[8]) { const v4u w = *(const v4u*)p; o[0] = bflo(w.x); o[1] = bfhi(w.x); o[2] = bflo(w.y); o[3] = bfhi(w.y); o[4] = bflo(w.z); o[5] = bfhi(w.z); o[6] = bflo(w.w); o[7] = bfhi(w.w); }
DI void ld8_f32(const float* p, float (&o)[8]) { const f32x4 a = *(const f32x4*)p, b = *(const f32x4*)(p + 4); o[0] = a[0]; o[1] = a[1]; o[2] = a[2]; o[3] = a[3]; o[4] = b[0]; o[5] = b[1]; o[6] = b[2]; o[7] = b[3]; }
DI void conv_gate_phase(const Ctx c, const bf16* U, bf16* Bg, const float* wdw  , const float* st  , float* convp, float* convs  ,
                        unsigned char* z8, float* sz  , const bool skip_samp = false  ) {
    const int gw = c.vcu * 8 + c.wave, NGW = c.G * 8, dc = 16 * c.lane;
    float w0[16], w1[16], w2[16];
    { float t8[8]; ld8_f32(wdw + dc, t8);
#pragma unroll
      for (int i = 0; i < 8; ++i) w0[i] = t8[i]; ld8_f32(wdw + dc + 8, t8);
#pragma unroll
      for (int i = 0; i < 8; ++i) w0[8 + i] = t8[i]; ld8_f32(wdw + D + dc, t8);
#pragma unroll
      for (int i = 0; i < 8; ++i) w1[i] = t8[i]; ld8_f32(wdw + D + dc + 8, t8);
#pragma unroll
      for (int i = 0; i < 8; ++i) w1[8 + i] = t8[i]; ld8_f32(wdw + 2 * D + dc, t8);
#pragma unroll
      for (int i = 0; i < 8; ++i) w2[i] = t8[i]; ld8_f32(wdw + 2 * D + dc + 8, t8);
#pragma unroll
      for (int i = 0; i < 8; ++i) w2[8 + i] = t8[i]; }
    { v4u ng[2], n2[2], n1[2], n0[2];
#define CG_LOAD(tt_) do { const int t_ = (tt_), s_ = t_ & 2047, t1_ = s_ >= 1 ? t_ - 1 : t_, t0_ = s_ >= 2 ? t_ - 2 : t_; \
        _Pragma("unroll") for (int hf = 0; hf < 2; ++hf) { ng[hf] = *(const v4u*)(Bg + (size_t)t_ * D + dc + 8 * hf); n2[hf] = *(const v4u*)(U + (size_t)t_ * D + dc + 8 * hf); \
            n1[hf] = *(const v4u*)(U + (size_t)t1_ * D + dc + 8 * hf); n0[hf] = *(const v4u*)(U + (size_t)t0_ * D + dc + 8 * hf); } } while (0)
      if (gw < TP) CG_LOAD(gw);
      for (int t = gw; t < TP; t += NGW) {
          const int s = t & 2047; const float f1 = s >= 1 ? 1.f : 0.f, f0 = s >= 2 ? 1.f : 0.f;
          v4u cg[2], c2[2], c1[2], c0[2];
#pragma unroll
          for (int hf = 0; hf < 2; ++hf) { cg[hf] = ng[hf]; c2[hf] = n2[hf]; c1[hf] = n1[hf]; c0[hf] = n0[hf]; }
          CG_LOAD(t + NGW < TP ? t + NGW : t);
          float z[16]; float am = 0.f;
#pragma unroll
          for (int hf = 0; hf < 2; ++hf) { const unsigned wg[4] = {cg[hf].x, cg[hf].y, cg[hf].z, cg[hf].w}, w2_[4] = {c2[hf].x, c2[hf].y, c2[hf].z, c2[hf].w}, w1_[4] = {c1[hf].x, c1[hf].y, c1[hf].z, c1[hf].w}, w0_[4] = {c0[hf].x, c0[hf].y, c0[hf].z, c0[hf].w};
#pragma unroll
              for (int i = 0; i < 8; ++i) { const bool hi = i & 1; const int k = i >> 1;
                  const float g = hi ? bfhi(wg[k]) : bflo(wg[k]), u2 = hi ? bfhi(w2_[k]) : bflo(w2_[k]), u1 = (hi ? bfhi(w1_[k]) : bflo(w1_[k])) * f1, u0 = (hi ? bfhi(w0_[k]) : bflo(w0_[k])) * f0;
                  const float zz = g * (w0[8 * hf + i] * u0 + w1[8 * hf + i] * u1 + w2[8 * hf + i] * u2); z[8 * hf + i] = zz; am = __builtin_fmaxf(am, __builtin_fabsf(zz)); } }
          am = wave_max(am);
          const float k = am > 0.f ? 127.0f / am : 0.f;
          v4u q; q.x = q4_i8((f32x4){z[0], z[1], z[2], z[3]}, k); q.y = q4_i8((f32x4){z[4], z[5], z[6], z[7]}, k); q.z = q4_i8((f32x4){z[8], z[9], z[10], z[11]}, k); q.w = q4_i8((f32x4){z[12], z[13], z[14], z[15]}, k);
          *(v4u*)(z8 + (size_t)t * D + dc) = q;
          if (c.lane == 0) sz[t] = am * (1.0f / 127.0f);
      }
#undef CG_LOAD
    }
    for (int t = TP + gw; t < (skip_samp ? TP : T); t += NGW) {
        const bool samp = true; const int s = (t - TP) & 15; const int b = (t - TP) >> 4;
        float z[16]; float am = 0.f;
#pragma unroll
        for (int hf = 0; hf < 2; ++hf) { const int d0 = dc + 8 * hf;
            float u0[8], u1[8], u2[8], g[8];
            ld8_bf16(U + (size_t)t * D + d0, u2);
            { float* cdst = nullptr;
              (void)convp;
              if (samp && s >= DSEQ - 2) cdst = convs + ((size_t)b * 2 + (s - (DSEQ - 2))) * D + d0;
              if (cdst) { *(f32x4*)cdst = (f32x4){u2[0], u2[1], u2[2], u2[3]}; *(f32x4*)(cdst + 4) = (f32x4){u2[4], u2[5], u2[6], u2[7]}; } }
            if (s >= 1) ld8_bf16(U + (size_t)(t - 1) * D + d0, u1);
            else if (samp) ld8_f32(st + ((size_t)b * 2 + 1) * D + d0, u1);
            else {
#pragma unroll
                for (int i = 0; i < 8; ++i) u1[i] = 0.f; }
            if (s >= 2) ld8_bf16(U + (size_t)(t - 2) * D + d0, u0);
            else if (samp) ld8_f32(st + ((size_t)b * 2 + (s == 1 ? 1 : 0)) * D + d0, u0);
            else {
#pragma unroll
                for (int i = 0; i < 8; ++i) u0[i] = 0.f; }
            ld8_bf16(Bg + (size_t)t * D + d0, g);
#pragma unroll
            for (int i = 0; i < 8; ++i) { const float zz = g[i] * (w0[8 * hf + i] * u0[i] + w1[8 * hf + i] * u1[i] + w2[8 * hf + i] * u2[i]); z[8 * hf + i] = zz; am = __builtin_fmaxf(am, __builtin_fabsf(zz)); }
        }
        if (samp) {
            v4u o0, o1; o0.x = pk2(z[0], z[1]); o0.y = pk2(z[2], z[3]); o0.z = pk2(z[4], z[5]); o0.w = pk2(z[6], z[7]); o1.x = pk2(z[8], z[9]); o1.y = pk2(z[10], z[11]); o1.z = pk2(z[12], z[13]); o1.w = pk2(z[14], z[15]);
            *(v4u*)(Bg + (size_t)t * D + dc) = o0; *(v4u*)(Bg + (size_t)t * D + dc + 8) = o1; }
        am = wave_max(am);
        const float k = am > 0.f ? 127.0f / am : 0.f;
        v4u q; q.x = q4_i8((f32x4){z[0], z[1], z[2], z[3]}, k); q.y = q4_i8((f32x4){z[4], z[5], z[6], z[7]}, k); q.z = q4_i8((f32x4){z[8], z[9], z[10], z[11]}, k); q.w = q4_i8((f32x4){z[12], z[13], z[14], z[15]}, k);
        *(v4u*)(z8 + (size_t)t * D + dc) = q;
        if (c.lane == 0) sz[t] = am * (1.0f / 127.0f);
    }
}

DI void ln_phase(const Ctx c, const bf16* R, bf16* H, const float* g, const float* bb, float* yout = nullptr, const bf16* Hres = nullptr, unsigned char* x8 = nullptr, float* sx = nullptr) {
    const int gw = c.vcu * 8 + c.wave, NGW = c.G * 8;
    float gv[2][8], bv[2][8];
#pragma unroll
    for (int j = 0; j < 2; ++j) { ld8_f32(g + 8 * c.lane + 512 * j, gv[j]); ld8_f32(bb + 8 * c.lane + 512 * j, bv[j]); }
    v4u rw[2], hw[2];
#pragma unroll
    for (int j = 0; j < 2; ++j) { const int m0 = gw < T ? gw : 0; rw[j] = *(const v4u*)(R + (size_t)m0 * D + 8 * c.lane + 512 * j); hw[j] = Hres ? *(const v4u*)(Hres + (size_t)m0 * D + 8 * c.lane + 512 * j) : (v4u){0u, 0u, 0u, 0u}; }
    for (int m = gw; m < T; m += NGW) {
        float v[2][8]; float s = 0.f;
#pragma unroll
        for (int j = 0; j < 2; ++j) { const unsigned w[4] = {rw[j].x, rw[j].y, rw[j].z, rw[j].w}, hq[4] = {hw[j].x, hw[j].y, hw[j].z, hw[j].w};
#pragma unroll
            for (int i = 0; i < 4; ++i) { v[j][2 * i] = bflo(w[i]); v[j][2 * i + 1] = bfhi(w[i]); if (Hres) { v[j][2 * i] += bflo(hq[i]) * ALPHA; v[j][2 * i + 1] += bfhi(hq[i]) * ALPHA; } }
#pragma unroll
            for (int i = 0; i < 8; ++i) s += v[j][i]; }
        { const int mn = m + NGW < T ? m + NGW : m;
#pragma unroll
          for (int j = 0; j < 2; ++j) { rw[j] = *(const v4u*)(R + (size_t)mn * D + 8 * c.lane + 512 * j); if (Hres) hw[j] = *(const v4u*)(Hres + (size_t)mn * D + 8 * c.lane + 512 * j); } }
        const float mean = wave_sum(c.lane, s) * (1.f / D); float s2 = 0.f;
#pragma unroll
        for (int j = 0; j < 2; ++j)
#pragma unroll
            for (int i = 0; i < 8; ++i) { v[j][i] -= mean; s2 += v[j][i] * v[j][i]; }
        const float rstd = __builtin_amdgcn_rsqf(wave_sum(c.lane, s2) * (1.f / D) + LN_EPS);
        float am = 0.f;
#pragma unroll
        for (int j = 0; j < 2; ++j)
#pragma unroll
            for (int i = 0; i < 8; ++i) { v[j][i] = v[j][i] * rstd * gv[j][i] + bv[j][i]; am = __builtin_fmaxf(am, __builtin_fabsf(v[j][i])); }
        if (yout) {
#pragma unroll
            for (int j = 0; j < 2; ++j) { float* o = yout + (size_t)m * D + 8 * c.lane + 512 * j; *(f32x4*)o = (f32x4){v[j][0], v[j][1], v[j][2], v[j][3]}; *(f32x4*)(o + 4) = (f32x4){v[j][4], v[j][5], v[j][6], v[j][7]}; }
        } else {
#pragma unroll
            for (int j = 0; j < 2; ++j) { v4u w; w.x = pk2(v[j][0], v[j][1]); w.y = pk2(v[j][2], v[j][3]); w.z = pk2(v[j][4], v[j][5]); w.w = pk2(v[j][6], v[j][7]); *(v4u*)(H + (size_t)m * D + 8 * c.lane + 512 * j) = w; }
            if (x8) {
                am = wave_max(am);
                const float k = am > 0.f ? 127.0f / am : 0.f;
#pragma unroll
                for (int j = 0; j < 2; ++j) { v2u q; q.x = q4_i8((f32x4){v[j][0], v[j][1], v[j][2], v[j][3]}, k); q.y = q4_i8((f32x4){v[j][4], v[j][5], v[j][6], v[j][7]}, k); *(v2u*)(x8 + (size_t)m * D + 8 * c.lane + 512 * j) = q; }
                if (c.lane == 0) sx[m] = am * (1.0f / 127.0f);
            } }
    }
}

DI int ordi(float x) { const int b = __float_as_int(x); return b ^ ((b >> 31) & 0x7fffffff); }
DI float unordi(int o) { return __int_as_float(o ^ ((o >> 31) & 0x7fffffff)); }
#define TK_CE(a, b) do { const int _hi = (a) > (b) ? (a) : (b), _lo = (a) > (b) ? (b) : (a); (a) = _hi; (b) = _lo; } while (0)
#define TK_CPK(i, j) ((ordi(va[i] + vb[j]) & ~255) | (255 - ((i) * 16 + (j))))
#define TK_SORT16(v) do { TK_CE(v[0], v[13]); TK_CE(v[1], v[12]); TK_CE(v[2], v[15]); TK_CE(v[3], v[14]); TK_CE(v[4], v[8]); TK_CE(v[5], v[6]); TK_CE(v[7], v[11]); TK_CE(v[9], v[10]); TK_CE(v[0], v[5]); TK_CE(v[1], v[7]); TK_CE(v[2], v[9]); TK_CE(v[3], v[4]); TK_CE(v[6], v[13]); TK_CE(v[8], v[14]); TK_CE(v[10], v[15]); TK_CE(v[11], v[12]); TK_CE(v[0], v[1]); TK_CE(v[2], v[3]); TK_CE(v[4], v[5]); TK_CE(v[6], v[8]); TK_CE(v[7], v[9]); TK_CE(v[10], v[11]); TK_CE(v[12], v[13]); TK_CE(v[14], v[15]); TK_CE(v[0], v[2]); TK_CE(v[1], v[3]); TK_CE(v[4], v[10]); TK_CE(v[5], v[11]); TK_CE(v[6], v[7]); TK_CE(v[8], v[9]); TK_CE(v[12], v[14]); TK_CE(v[13], v[15]); TK_CE(v[1], v[2]); TK_CE(v[3], v[12]); TK_CE(v[4], v[6]); TK_CE(v[5], v[7]); TK_CE(v[8], v[10]); TK_CE(v[9], v[11]); TK_CE(v[13], v[14]); TK_CE(v[1], v[4]); TK_CE(v[2], v[6]); TK_CE(v[5], v[8]); TK_CE(v[7], v[10]); TK_CE(v[9], v[13]); TK_CE(v[11], v[14]); TK_CE(v[2], v[4]); TK_CE(v[3], v[6]); TK_CE(v[9], v[12]); TK_CE(v[11], v[13]); TK_CE(v[3], v[5]); TK_CE(v[6], v[8]); TK_CE(v[7], v[9]); TK_CE(v[10], v[12]); TK_CE(v[3], v[4]); TK_CE(v[5], v[6]); TK_CE(v[7], v[8]); TK_CE(v[9], v[10]); TK_CE(v[11], v[12]); TK_CE(v[6], v[7]); TK_CE(v[8], v[9]); } while (0)
#define TK_BMERGE16(v) do { TK_CE(v[0], v[8]); TK_CE(v[1], v[9]); TK_CE(v[2], v[10]); TK_CE(v[3], v[11]); TK_CE(v[4], v[12]); TK_CE(v[5], v[13]); TK_CE(v[6], v[14]); TK_CE(v[7], v[15]); TK_CE(v[0], v[4]); TK_CE(v[1], v[5]); TK_CE(v[2], v[6]); TK_CE(v[3], v[7]); TK_CE(v[8], v[12]); TK_CE(v[9], v[13]); TK_CE(v[10], v[14]); TK_CE(v[11], v[15]); TK_CE(v[0], v[2]); TK_CE(v[1], v[3]); TK_CE(v[4], v[6]); TK_CE(v[5], v[7]); TK_CE(v[8], v[10]); TK_CE(v[9], v[11]); TK_CE(v[12], v[14]); TK_CE(v[13], v[15]); TK_CE(v[0], v[1]); TK_CE(v[2], v[3]); TK_CE(v[4], v[5]); TK_CE(v[6], v[7]); TK_CE(v[8], v[9]); TK_CE(v[10], v[11]); TK_CE(v[12], v[13]); TK_CE(v[14], v[15]); } while (0)
#define TK_CAND0(B) do { B[0] = TK_CPK(0, 0); B[1] = TK_CPK(0, 1); B[2] = TK_CPK(0, 2); B[3] = TK_CPK(0, 3); B[4] = TK_CPK(0, 4); B[5] = TK_CPK(0, 5); B[6] = TK_CPK(0, 6); B[7] = TK_CPK(0, 7); B[8] = TK_CPK(0, 8); B[9] = TK_CPK(0, 9); B[10] = TK_CPK(0, 10); B[11] = TK_CPK(0, 11); B[12] = TK_CPK(0, 12); B[13] = TK_CPK(0, 13); B[14] = TK_CPK(0, 14); B[15] = TK_CPK(0, 15); } while (0)
#define TK_CAND1(B) do { B[0] = TK_CPK(1, 0); B[1] = TK_CPK(1, 1); B[2] = TK_CPK(1, 2); B[3] = TK_CPK(1, 3); B[4] = TK_CPK(1, 4); B[5] = TK_CPK(1, 5); B[6] = TK_CPK(1, 6); B[7] = TK_CPK(1, 7); B[8] = TK_CPK(2, 0); B[9] = TK_CPK(2, 1); B[10] = TK_CPK(2, 2); B[11] = TK_CPK(2, 3); B[12] = TK_CPK(2, 4); B[13] = TK_CPK(3, 0); B[14] = TK_CPK(3, 1); B[15] = TK_CPK(3, 2); } while (0)
#define TK_CAND2(B) do { B[0] = TK_CPK(3, 3); B[1] = TK_CPK(4, 0); B[2] = TK_CPK(4, 1); B[3] = TK_CPK(4, 2); B[4] = TK_CPK(5, 0); B[5] = TK_CPK(5, 1); B[6] = TK_CPK(6, 0); B[7] = TK_CPK(6, 1); B[8] = TK_CPK(7, 0); B[9] = TK_CPK(7, 1); B[10] = TK_CPK(8, 0); B[11] = TK_CPK(9, 0); B[12] = TK_CPK(10, 0); B[13] = TK_CPK(11, 0); B[14] = TK_CPK(12, 0); B[15] = TK_CPK(13, 0); } while (0)
#define TK_CAND3(B) do { B[0] = TK_CPK(14, 0); B[1] = TK_CPK(15, 0); B[2] = (int)0x80000000; B[3] = (int)0x80000000; B[4] = (int)0x80000000; B[5] = (int)0x80000000; B[6] = (int)0x80000000; B[7] = (int)0x80000000; B[8] = (int)0x80000000; B[9] = (int)0x80000000; B[10] = (int)0x80000000; B[11] = (int)0x80000000; B[12] = (int)0x80000000; B[13] = (int)0x80000000; B[14] = (int)0x80000000; B[15] = (int)0x80000000; } while (0)
DI void tk_merge(int (&L)[16], const int (&B)[16]) {
#pragma unroll
    for (int i = 0; i < 16; ++i) L[i] = L[i] > B[15 - i] ? L[i] : B[15 - i];
    TK_BMERGE16(L);
}
DI void tk_feed32(int (&L)[16], const v4u (&x)[4], const int rb, const bool first) {
#pragma unroll
    for (int hf = 0; hf < 2; ++hf) { int B[16]; const unsigned w[8] = {x[2 * hf].x, x[2 * hf].y, x[2 * hf].z, x[2 * hf].w, x[2 * hf + 1].x, x[2 * hf + 1].y, x[2 * hf + 1].z, x[2 * hf + 1].w};
#pragma unroll
        for (int j = 0; j < 16; ++j) {
            const unsigned ww = w[j >> 1], code = (unsigned)(127 - ((rb + 16 * hf + j) & 127));
            if (j & 1) { const int m = (int)ww >> 31; const unsigned t = ww ^ ((unsigned)m & 0x7fff0000u); B[j] = (int)((t & 0xffff0000u) | code); }
            else { const int m = (int)(ww << 16) >> 31; const unsigned t = ww ^ ((unsigned)m & 0x7fffu); B[j] = (int)((t << 16) | code); } }
        TK_SORT16(B);
        if (hf == 0 && first) {
#pragma unroll
            for (int i = 0; i < 16; ++i) L[i] = B[i];
        } else tk_merge(L, B); }
}
DI float unord16(const int key) { const int h = key & (int)0xffff0000; return __int_as_float(h ^ ((h >> 31) & 0x7fff0000)); }
DI unsigned byte_of(unsigned a0, unsigned a1, unsigned a2, unsigned a3, int i) { const unsigned lo = i < 4 ? a0 : a1, hi = i < 12 ? a2 : a3, w = i < 8 ? lo : hi; return (w >> ((i & 3) * 8)) & 0xffu; }
DI void topk_phase(const Ctx c, const bf16* Sc  , unsigned short* ids, float* gates) {
    const int gw = c.wave * c.G + c.vcu, NGW = c.G * 8, NU = 8 * (T / 64);
    v4u bufA[4], bufB[4];
    if (gw < NU) { const v4u* sc = (const v4u*)(Sc + (size_t)((gw % (T / 64)) * 64 + c.lane) * 2048 + (gw / (T / 64)) * 256);
#pragma unroll
        for (int j = 0; j < 4; ++j) bufA[j] = sc[j]; }
#pragma unroll 1
    for (int wu = gw; wu < NU; wu += NGW) {
        const int h = wu / (T / 64), t = (wu % (T / 64)) * 64 + c.lane;
        const v4u* sc = (const v4u*)(Sc + (size_t)t * 2048 + h * 256);
        const int wn = wu + NGW < NU ? wu + NGW : wu;
        const v4u* scn = (const v4u*)(Sc + (size_t)((wn % (T / 64)) * 64 + c.lane) * 2048 + (wn / (T / 64)) * 256);
        int Lw[16], La[16];
#pragma unroll
        for (int i = 0; i < 16; ++i) { Lw[i] = (int)0x80000000; La[i] = 0; }
#pragma unroll 1
        for (int it = 0; it < 4; ++it) {
#pragma unroll
            for (int j = 0; j < 4; ++j) bufB[j] = sc[8 * it + 4 + j];
            tk_feed32(Lw, bufA, 64 * it, (it & 1) == 0);
            { const v4u* nx = it < 3 ? sc + 8 * (it + 1) : scn;
#pragma unroll
              for (int j = 0; j < 4; ++j) bufA[j] = nx[j]; }
            tk_feed32(Lw, bufB, 64 * it + 32, false);
            if (it == 1) {
#pragma unroll
                for (int i = 0; i < 16; ++i) La[i] = Lw[i]; }
        }
        float va[16], vb[16]; unsigned IA0 = 0u, IA1 = 0u, IA2 = 0u, IA3 = 0u, IB0 = 0u, IB1 = 0u, IB2 = 0u, IB3 = 0u;
#pragma unroll
        for (int i = 0; i < 16; ++i) { va[i] = unord16(La[i]); vb[i] = unord16(Lw[i]);
            const unsigned ea = (unsigned)(127 - (La[i] & 127)) << ((i & 3) * 8), eb = (unsigned)(127 - (Lw[i] & 127)) << ((i & 3) * 8);
            if ((i >> 2) == 0) { IA0 |= ea; IB0 |= eb; } else if ((i >> 2) == 1) { IA1 |= ea; IB1 |= eb; } else if ((i >> 2) == 2) { IA2 |= ea; IB2 |= eb; } else { IA3 |= ea; IB3 |= eb; } }
        int F[16];
        { int B[16]; TK_CAND0(B); TK_SORT16(B);
#pragma unroll
          for (int i = 0; i < 16; ++i) F[i] = B[i]; }
        { int B[16]; TK_CAND1(B); TK_SORT16(B); tk_merge(F, B); }
        { int B[16]; TK_CAND2(B); TK_SORT16(B); tk_merge(F, B); }
        { int x = TK_CPK(14, 0), y = TK_CPK(15, 0); TK_CE(x, y);
          F[15] = F[15] > x ? F[15] : x; F[14] = F[14] > y ? F[14] : y; TK_BMERGE16(F); }
        float sc_[16], den = 0.f; unsigned ex[16];
        const float mx = unordi(F[0] & ~255);
#pragma unroll
        for (int k = 0; k < 16; ++k) { const int code = 255 - (F[k] & 255); sc_[k] = __builtin_amdgcn_exp2f((unordi(F[k] & ~255) - mx) * LOG2E); den += sc_[k];
            ex[k] = byte_of(IA0, IA1, IA2, IA3, code >> 4) * 128u + byte_of(IB0, IB1, IB2, IB3, code & 15); }
        const float inv = 1.0f / den;
        v4u e0, e1; e0.x = ex[0] | (ex[1] << 16); e0.y = ex[2] | (ex[3] << 16); e0.z = ex[4] | (ex[5] << 16); e0.w = ex[6] | (ex[7] << 16);
        e1.x = ex[8] | (ex[9] << 16); e1.y = ex[10] | (ex[11] << 16); e1.z = ex[12] | (ex[13] << 16); e1.w = ex[14] | (ex[15] << 16);
        v4u* ip = (v4u*)(ids + (size_t)t * 128 + h * 16); ip[0] = e0; ip[1] = e1;
        f32x4* gp = (f32x4*)(gates + (size_t)t * 128 + h * 16);
#pragma unroll
        for (int k = 0; k < 4; ++k) gp[k] = (f32x4){sc_[4 * k] * inv, sc_[4 * k + 1] * inv, sc_[4 * k + 2] * inv, sc_[4 * k + 3] * inv};
    }
}

typedef float f2 __attribute__((ext_vector_type(2)));
constexpr int QCH = 16, QN = T / QCH;
static_assert(T % QCH == 0, "queue chunks");
struct ChunkQ { int xme, s; unsigned pend; unsigned* q; };
struct Chunk { int base, xs; };
DI unsigned cq_ticket(unsigned* qw, int lane) { unsigned v = 0u; if (lane == 0) v = __hip_atomic_fetch_add(qw, 1u, __ATOMIC_RELAXED, __HIP_MEMORY_SCOPE_AGENT); return v; }
DI void cq_init(ChunkQ& g, unsigned* q, int lane) { g.xme = (int)(xb_xcc_id() & 7u); g.s = 0; g.q = q; g.pend = cq_ticket(q + g.xme * 64, lane); }
DI Chunk cq_next(ChunkQ& g, int lane) {
    for (;;) {
        if (g.s >= 8) return Chunk{-1, 0};
        const unsigned chunk = (unsigned)__builtin_amdgcn_readfirstlane((int)g.pend); const int xs = (g.xme + g.s) & 7;
        if (chunk < (unsigned)QN) { g.pend = cq_ticket(g.q + xs * 64, lane); return Chunk{(int)chunk * QCH, xs}; }
        ++g.s; if (g.s < 8) g.pend = cq_ticket(g.q + ((g.xme + g.s) & 7) * 64, lane);
    }
}
struct SliceIds { v4u ia, ib; int t, xs; };
struct SliceAux { v4u a0; float s; };
DI SliceIds slice_load_ids(const int t, const int xs, const int lane, const unsigned short* ids) {
    const int j = lane >> 3, tc = t < 0 ? 0 : t; SliceIds r; r.t = t; r.xs = xs;
    r.ia = *(const v4u*)(ids + (size_t)tc * 128 + 16 * j); r.ib = *(const v4u*)(ids + (size_t)tc * 128 + 16 * j + 8); return r;
}
template <int MODE>
DI SliceAux slice_load_aux(const int t, const int xs, const int lane, const unsigned char* x8, const unsigned char* w8, const float* sw) {
    const int j = lane >> 3, i = lane & 7, tc = t < 0 ? 0 : t; SliceAux r;
    if (MODE == 0) { r.a0 = *(const v4u*)(x8 + (size_t)tc * D + 128 * xs + 16 * i); r.s = 0.f; }
    else { r.a0 = *(const v4u*)(w8 + (size_t)tc * 128 + 16 * j); r.s = sw[tc]; }
    return r;
}
template <int VAR>
DI void slice_issue(v4u (&vr)[16], const SliceIds& n, const unsigned char* T8, const int lane) {
    const unsigned char* sbase = T8 + (size_t)n.xs * NEXP * 128;
    const unsigned lo = 16u * (unsigned)(lane & 7);
    const unsigned idv[8] = {n.ia.x, n.ia.y, n.ia.z, n.ia.w, n.ib.x, n.ib.y, n.ib.z, n.ib.w};
#pragma unroll
    for (int g = 0; g < 16; ++g) {
        unsigned off;
        if (VAR == 2) off = (((g & 1) ? (idv[g >> 1] >> 16) : (idv[g >> 1] & 0xffffu)) & 15u) * 128u + lo;
        else if (g & 1) asm("v_mad_u32_u16 %0, %1, %2, %3 op_sel:[1,0,0,0]" : "=v"(off) : "v"(idv[g >> 1]), "s"(128u), "v"(lo));
        else asm("v_mad_u32_u16 %0, %1, %2, %3" : "=v"(off) : "v"(idv[g >> 1]), "s"(128u), "v"(lo));
        vr[g] = *(const v4u*)(sbase + off); }
}
DI int dot16_i8(const v4u a, const v4u b, int acc) {
    acc = __builtin_amdgcn_sdot4((int)a.x, (int)b.x, acc, false); acc = __builtin_amdgcn_sdot4((int)a.y, (int)b.y, acc, false);
    acc = __builtin_amdgcn_sdot4((int)a.z, (int)b.z, acc, false); acc = __builtin_amdgcn_sdot4((int)a.w, (int)b.w, acc, false); return acc;
}
DI void tr4_dot0(int& c0, int& c1, int& c2, int& c3, const unsigned a, const unsigned b, const unsigned cc, const unsigned d, const int w) {
    const unsigned p = __builtin_amdgcn_perm(b, a, 0x05010400u), q = __builtin_amdgcn_perm(b, a, 0x07030602u), r = __builtin_amdgcn_perm(d, cc, 0x05010400u), s = __builtin_amdgcn_perm(d, cc, 0x07030602u);
    asm("v_dot4_i32_i8 %0, %1, %2, 0" : "=v"(c0) : "v"(__builtin_amdgcn_perm(r, p, 0x05040100u)), "v"(w)); asm("v_dot4_i32_i8 %0, %1, %2, 0" : "=v"(c1) : "v"(__builtin_amdgcn_perm(r, p, 0x07060302u)), "v"(w));
    asm("v_dot4_i32_i8 %0, %1, %2, 0" : "=v"(c2) : "v"(__builtin_amdgcn_perm(s, q, 0x05040100u)), "v"(w)); asm("v_dot4_i32_i8 %0, %1, %2, 0" : "=v"(c3) : "v"(__builtin_amdgcn_perm(s, q, 0x07060302u)), "v"(w));
}
DI void tr4_dot(int& c0, int& c1, int& c2, int& c3, const unsigned a, const unsigned b, const unsigned cc, const unsigned d, const int w) {
    const unsigned p = __builtin_amdgcn_perm(b, a, 0x05010400u), q = __builtin_amdgcn_perm(b, a, 0x07030602u), r = __builtin_amdgcn_perm(d, cc, 0x05010400u), s = __builtin_amdgcn_perm(d, cc, 0x07030602u);
    c0 = __builtin_amdgcn_sdot4((int)__builtin_amdgcn_perm(r, p, 0x05040100u), w, c0, false); c1 = __builtin_amdgcn_sdot4((int)__builtin_amdgcn_perm(r, p, 0x07060302u), w, c1, false);
    c2 = __builtin_amdgcn_sdot4((int)__builtin_amdgcn_perm(s, q, 0x05040100u), w, c2, false); c3 = __builtin_amdgcn_sdot4((int)__builtin_amdgcn_perm(s, q, 0x07060302u), w, c3, false);
}
template <int MODE, int VAR>
DI void slice_compute(const int lane, const v4u (&vr)[16], const int t, const int xs, const SliceAux& n, float* OUT) {
    const int j = lane >> 3, i = lane & 7;
    if (VAR == 1) {
        unsigned x = n.a0.x ^ n.a0.y;
#pragma unroll
        for (int g = 0; g < 16; ++g) x ^= vr[g].x ^ vr[g].y ^ vr[g].z ^ vr[g].w;
        *(unsigned*)((bf16*)OUT + (size_t)t * D + 128 * xs + 2 * lane) = x;
    } else if (MODE == 0) {
        int d[16];
#pragma unroll
        for (int g = 0; g < 16; ++g) d[g] = dot16_i8(vr[g], n.a0, 0);
        int r8[8], r4[4], r2[2];
#define RS_DPP4(CTRL, R, K, S, o) asm("s_nop 1\n\tv_add_u32_dpp %0, %4, %8 " CTRL " row_mask:0xf bank_mask:0xf\n\tv_add_u32_dpp %1, %5, %9 " CTRL " row_mask:0xf bank_mask:0xf\n\t" \
                "v_add_u32_dpp %2, %6, %10 " CTRL " row_mask:0xf bank_mask:0xf\n\tv_add_u32_dpp %3, %7, %11 " CTRL " row_mask:0xf bank_mask:0xf" \
                : "=&v"(R[o]), "=&v"(R[o + 1]), "=&v"(R[o + 2]), "=&v"(R[o + 3]) : "v"(S[o]), "v"(S[o + 1]), "v"(S[o + 2]), "v"(S[o + 3]), "v"(K[o]), "v"(K[o + 1]), "v"(K[o + 2]), "v"(K[o + 3]))
        { int kp[8], sd[8]; const bool od = lane & 1;
#pragma unroll
          for (int q = 0; q < 8; ++q) { kp[q] = od ? d[8 + q] : d[q]; sd[q] = od ? d[q] : d[8 + q]; }
          RS_DPP4("quad_perm:[1,0,3,2]", r8, kp, sd, 0); RS_DPP4("quad_perm:[1,0,3,2]", r8, kp, sd, 4); }
        { int kp[4], sd[4]; const bool od = lane & 2;
#pragma unroll
          for (int q = 0; q < 4; ++q) { kp[q] = od ? r8[4 + q] : r8[q]; sd[q] = od ? r8[q] : r8[4 + q]; }
          RS_DPP4("quad_perm:[2,3,0,1]", r4, kp, sd, 0); }
#undef RS_DPP4
        asm("s_nop 1\n\tv_add_u32_dpp %0, %2, %2 row_shl:4 row_mask:0xf bank_mask:0x5\n\tv_add_u32_dpp %0, %4, %4 row_shr:4 row_mask:0xf bank_mask:0xa\n\t"
            "v_add_u32_dpp %1, %3, %3 row_shl:4 row_mask:0xf bank_mask:0x5\n\tv_add_u32_dpp %1, %5, %5 row_shr:4 row_mask:0xf bank_mask:0xa"
            : "=&v"(r2[0]), "=&v"(r2[1]) : "v"(r4[0]), "v"(r4[1]), "v"(r4[2]), "v"(r4[3]));
        const int g0 = 8 * (i & 1) + 4 * ((i >> 1) & 1) + 2 * (i >> 2);
        *((unsigned*)OUT + ((size_t)xs * T + t) * 64 + 8 * j + (g0 >> 1)) = ((unsigned)((r2[0] + 32) >> 6) & 0xffffu) | ((unsigned)((r2[1] + 32) >> 6) << 16);
    } else {
        int acc[16];
        const int w4[4] = {(int)n.a0.x, (int)n.a0.y, (int)n.a0.z, (int)n.a0.w};
        tr4_dot0(acc[0], acc[1], acc[2], acc[3], vr[0].x, vr[1].x, vr[2].x, vr[3].x, w4[0]);
        tr4_dot0(acc[4], acc[5], acc[6], acc[7], vr[0].y, vr[1].y, vr[2].y, vr[3].y, w4[0]);
        tr4_dot0(acc[8], acc[9], acc[10], acc[11], vr[0].z, vr[1].z, vr[2].z, vr[3].z, w4[0]);
        tr4_dot0(acc[12], acc[13], acc[14], acc[15], vr[0].w, vr[1].w, vr[2].w, vr[3].w, w4[0]);
#pragma unroll
        for (int gq = 1; gq < 4; ++gq) {
            tr4_dot(acc[0], acc[1], acc[2], acc[3], vr[4 * gq].x, vr[4 * gq + 1].x, vr[4 * gq + 2].x, vr[4 * gq + 3].x, w4[gq]);
            tr4_dot(acc[4], acc[5], acc[6], acc[7], vr[4 * gq].y, vr[4 * gq + 1].y, vr[4 * gq + 2].y, vr[4 * gq + 3].y, w4[gq]);
            tr4_dot(acc[8], acc[9], acc[10], acc[11], vr[4 * gq].z, vr[4 * gq + 1].z, vr[4 * gq + 2].z, vr[4 * gq + 3].z, w4[gq]);
            tr4_dot(acc[12], acc[13], acc[14], acc[15], vr[4 * gq].w, vr[4 * gq + 1].w, vr[4 * gq + 2].w, vr[4 * gq + 3].w, w4[gq]);
        }
        int r8[8], r4[4], r2[2];
#pragma unroll
        for (int q = 0; q < 8; q += 4)
            asm("s_nop 1\n\tv_add_u32_dpp %0, %4, %4 row_ror:8 row_mask:0xf bank_mask:0x3\n\tv_add_u32_dpp %0, %8, %8 row_ror:8 row_mask:0xf bank_mask:0xc\n\t"
                "v_add_u32_dpp %1, %5, %5 row_ror:8 row_mask:0xf bank_mask:0x3\n\tv_add_u32_dpp %1, %9, %9 row_ror:8 row_mask:0xf bank_mask:0xc\n\t"
                "v_add_u32_dpp %2, %6, %6 row_ror:8 row_mask:0xf bank_mask:0x3\n\tv_add_u32_dpp %2, %10, %10 row_ror:8 row_mask:0xf bank_mask:0xc\n\t"
                "v_add_u32_dpp %3, %7, %7 row_ror:8 row_mask:0xf bank_mask:0x3\n\tv_add_u32_dpp %3, %11, %11 row_ror:8 row_mask:0xf bank_mask:0xc"
                : "=&v"(r8[q]), "=&v"(r8[q + 1]), "=&v"(r8[q + 2]), "=&v"(r8[q + 3])
                : "v"(acc[q]), "v"(acc[q + 1]), "v"(acc[q + 2]), "v"(acc[q + 3]), "v"(acc[8 + q]), "v"(acc[9 + q]), "v"(acc[10 + q]), "v"(acc[11 + q]));
#pragma unroll
        for (int q = 0; q < 4; ++q) { const auto rr = __builtin_amdgcn_permlane16_swap((unsigned)r8[q], (unsigned)r8[4 + q], false, false); r4[q] = (int)rr[0] + (int)rr[1]; }
#pragma unroll
        for (int q = 0; q < 2; ++q) { const auto rr = __builtin_amdgcn_permlane32_swap((unsigned)r4[q], (unsigned)r4[2 + q], false, false); r2[q] = (int)rr[0] + (int)rr[1]; }
        const int dim = 128 * xs + 16 * i + 8 * (j & 1) + 4 * ((j >> 1) & 1) + 2 * (j >> 2);
        const float s = n.s;
        *(unsigned*)((bf16*)OUT + (size_t)t * D + dim) = pk2((float)r2[0] * s, (float)r2[1] * s);
    }
}
template <int MODE, int VAR = 0>
DI void slice_pass(const Ctx c, const unsigned char* x8, const unsigned short* ids, const unsigned char* w8, const float* sw, const unsigned char* T8, float* OUT, unsigned* q) {
    ChunkQ g; cq_init(g, q, c.lane);
    Chunk cur = cq_next(g, c.lane); if (cur.base < 0) return;
    Chunk nxt = cq_next(g, c.lane);
#define SLICE_TOK_T(p) ((p) < QCH ? cur.base + (p) : (nxt.base >= 0 ? nxt.base + (p) - QCH : -1))
#define SLICE_TOK_X(p) ((p) < QCH ? cur.xs : nxt.xs)
    SliceIds i0 = slice_load_ids(SLICE_TOK_T(0), SLICE_TOK_X(0), c.lane, ids), i1 = slice_load_ids(SLICE_TOK_T(1), SLICE_TOK_X(1), c.lane, ids),
             i2 = slice_load_ids(SLICE_TOK_T(2), SLICE_TOK_X(2), c.lane, ids), i3 = slice_load_ids(SLICE_TOK_T(3), SLICE_TOK_X(3), c.lane, ids);
    SliceAux x0 = slice_load_aux<MODE>(i0.t, i0.xs, c.lane, x8, w8, sw), x1 = slice_load_aux<MODE>(i1.t, i1.xs, c.lane, x8, w8, sw);
    v4u A[16], B[16];
    slice_issue<VAR>(A, i0, T8, c.lane);
#define SLICE_STEP(K, CUR, NXT, IK, IK1, XK) do { slice_issue<VAR>(NXT, IK1, T8, c.lane); \
        const int ct_ = IK.t, cx_ = IK.xs; const SliceAux cxk_ = XK; \
        XK = slice_load_aux<MODE>(SLICE_TOK_T(pg + (K) + 2), SLICE_TOK_X(pg + (K) + 2), c.lane, x8, w8, sw); \
        IK = slice_load_ids(SLICE_TOK_T(pg + (K) + 4), SLICE_TOK_X(pg + (K) + 4), c.lane, ids); \
        slice_compute<MODE, VAR>(c.lane, CUR, ct_, cx_, cxk_, OUT); } while (0)
    for (;;) {
#pragma unroll 2
        for (int pg = 0; pg < QCH; pg += 4) {
            SLICE_STEP(0, A, B, i0, i1, x0);
            SLICE_STEP(1, B, A, i1, i2, x1);
            SLICE_STEP(2, A, B, i2, i3, x0);
            SLICE_STEP(3, B, A, i3, i0, x1);
        }
        cur = nxt; if (cur.base < 0) break;
        nxt = cq_next(g, c.lane);
    }
#undef SLICE_STEP
#undef SLICE_TOK_T
#undef SLICE_TOK_X
}
struct WpA { f32x4 s; v2u iw; f32x4 g; float st; };
struct WpB { f32x4 su, sv; };
DI WpA wp_load_a(const size_t idx, const float* part, const unsigned short* ids, const float* gates, const float* sx) {
    WpA a; v2u p[8];
#pragma unroll
    for (int x = 0; x < 8; ++x) p[x] = *(const v2u*)((const unsigned short*)part + (size_t)x * T * 128 + idx * 4);
    a.iw = *(const v2u*)(ids + idx * 4); a.g = *(const f32x4*)(gates + idx * 4); a.st = sx[idx >> 5] * 64.0f;
    int s0 = 0, s1 = 0, s2 = 0, s3 = 0;
#pragma unroll
    for (int x = 0; x < 8; ++x) { s0 += (int)(short)(p[x].x & 0xffffu); s1 += (int)p[x].x >> 16; s2 += (int)(short)(p[x].y & 0xffffu); s3 += (int)p[x].y >> 16; }
    a.s = (f32x4){(float)s0, (float)s1, (float)s2, (float)s3}; return a;
}
DI WpB wp_load_b(const WpA& a, const float* SU, const float* SV) {
    const unsigned e[4] = {a.iw.x & 0xffffu, a.iw.x >> 16, a.iw.y & 0xffffu, a.iw.y >> 16}; WpB b;
#pragma unroll
    for (int k = 0; k < 4; ++k) { const f2 p = *(const f2*)(SU + 2 * e[k]); b.su[k] = p.x; b.sv[k] = p.y; }
    (void)SV;
    return b;
}
DI void peer_w_phase(const Ctx c, const float* part, const unsigned short* ids, const float* gates, unsigned char* w8, float* sw, const float* sx, const float* SU, const float* SV) {
    const size_t NT = (size_t)c.G * 512, NI = (size_t)T * 32, i0 = (size_t)c.vcu * 512 + c.tid;
    WpA a0 = wp_load_a(i0 < NI ? i0 : 0, part, ids, gates, sx), a1 = wp_load_a(i0 + NT < NI ? i0 + NT : 0, part, ids, gates, sx);
    WpB b0 = wp_load_b(a0, SU, SV);
    for (size_t idx = i0; idx < NI; idx += NT) {
        const WpA a2 = wp_load_a(idx + 2 * NT < NI ? idx + 2 * NT : 0, part, ids, gates, sx);
        const WpB b1 = wp_load_b(a1, SU, SV);
        f32x4 g = a0.g; float am = 0.f;
#pragma unroll
        for (int k = 0; k < 4; ++k) { g[k] = g[k] * gelu_erf(a0.s[k] * (a0.st * b0.su[k])) * b0.sv[k]; am = __builtin_fmaxf(am, __builtin_fabsf(g[k])); }
        am = max32(am);
        *(unsigned*)(w8 + idx * 4) = q4_i8(g, am > 0.f ? 127.0f / am : 0.f);
        if ((c.tid & 31) == 0) sw[idx >> 5] = am * (1.0f / 127.0f);
        a0 = a1; a1 = a2; b0 = b1;
    }
}

DI int pi_row(int m) { return 16 * (m >> 4) + 8 * ((m >> 2) & 1) + 4 * ((m >> 3) & 1) + (m & 3); }
struct AttnT { const bf16* Q; bf16* O; const bf16* Kb; const bf16* VT; const bf16* Vsn; const float* ck; const float* cv; };
template <int MODE>
DI void attn_load(const AttnT A, const int b, const int h, const int kt, const int q, const int hh, const int piq, bf16x8 (&kf)[4], bf16x8 (&vf)[2][2]) {
    if (MODE == 0) {
        const bf16* kr = A.Kb + ((size_t)b * SEQ + kt * 32 + piq) * D + h * DH + 8 * hh;
#pragma unroll
        for (int s = 0; s < 4; ++s) kf[s] = *(const bf16x8*)(kr + 16 * s);
        const bf16* vr = A.VT + (((size_t)b * NH + h) * (SEQ / 32) + kt) * (DH * 32) + q * 32 + 8 * hh;
#pragma unroll
        for (int mt = 0; mt < 2; ++mt)
#pragma unroll
            for (int s = 0; s < 2; ++s) vf[mt][s] = *(const bf16x8*)(vr + mt * 32 * 32 + 16 * s);
    } else if (kt == PAST / 32) {
        const int ko = piq < 16 ? piq : 15;
        const bf16* kr = A.Kb + ((size_t)TP + b * DSEQ + ko) * D + h * DH + 8 * hh;
#pragma unroll
        for (int s = 0; s < 4; ++s) kf[s] = *(const bf16x8*)(kr + 16 * s);
#pragma unroll
        for (int mt = 0; mt < 2; ++mt)
#pragma unroll
            for (int s = 0; s < 2; ++s) { bf16x8 v;
#pragma unroll
                for (int j = 0; j < 8; ++j) { const int kk = 16 * s + 8 * hh + j; v[j] = (short)A.Vsn[((size_t)b * DSEQ + (kk < 16 ? kk : 15)) * D + h * DH + 32 * mt + q]; }
                vf[mt][s] = v; }
    } else {
        const float* kr = A.ck + (((size_t)b * PAST + kt * 32 + piq) * NH + h) * DH + 8 * hh;
#pragma unroll
        for (int s = 0; s < 4; ++s) { const f32x4 x0 = *(const f32x4*)(kr + 16 * s), x1 = *(const f32x4*)(kr + 16 * s + 4); kf[s] = pack8(x0[0], x0[1], x0[2], x0[3], x1[0], x1[1], x1[2], x1[3]); }
#pragma unroll
        for (int mt = 0; mt < 2; ++mt)
#pragma unroll
            for (int s = 0; s < 2; ++s) { float x[8];
#pragma unroll
                for (int j = 0; j < 8; ++j) x[j] = A.cv[(((size_t)b * PAST + kt * 32 + 16 * s + 8 * hh + j) * NH + h) * DH + 32 * mt + q];
                vf[mt][s] = pack8(x[0], x[1], x[2], x[3], x[4], x[5], x[6], x[7]); }
    }
}
template <int MODE>
DI void attn_qtile(const AttnT A, int b, int h, int qi, int lane, const bf16x8 (&ut)[2]) {
    const int q = lane & 31, hh = lane >> 5, piq = pi_row(q);
    const size_t qrow = MODE == 0 ? (size_t)b * SEQ + qi * 32 + q : (size_t)TP + b * DSEQ + (q < 16 ? q : 15);
    const int qpos = MODE == 0 ? qi * 32 + q : (q < 16 ? PAST + q : 0);
    bf16x8 qf[4];
#pragma unroll
    for (int s = 0; s < 4; ++s) qf[s] = *(const bf16x8*)(A.Q + qrow * D + h * DH + 16 * s + 8 * hh);
    f32x16 o0, o1;
#pragma unroll
    for (int i = 0; i < 16; ++i) { o0[i] = 0.f; o1[i] = 0.f; }
    float carry = 0.f;
    const int kt0 = MODE == 0 ? qi : PAST / 32;
    bf16x8 kf[4], vf[2][2];
    attn_load<MODE>(A, b, h, kt0, q, hh, piq, kf, vf);
    for (int kt = kt0; kt >= 0; --kt) {
        bf16x8 kn[4], vn[2][2];
        attn_load<MODE>(A, b, h, kt > 0 ? kt - 1 : 0, q, hh, piq, kn, vn);
        f32x16 S;
#pragma unroll
        for (int i = 0; i < 16; ++i) S[i] = 0.f;
#pragma unroll
        for (int s = 0; s < 4; ++s) S = MFMA32(kf[s], qf[s], S);
        const int kbase = kt * 32 + 8 * hh;
        float L[16], lw[16];
#pragma unroll
        for (int r = 0; r < 16; ++r) {
            const bool valid = (kbase + 16 * (r >> 3) + (r & 7)) < qpos;
            const float z = S[r], sp = __builtin_fmaxf(z, 0.f) + __builtin_amdgcn_logf(1.0f + __builtin_amdgcn_exp2f(-__builtin_fabsf(z)));
            L[r] = valid ? -sp : 0.f; lw[r] = valid ? (z - sp) : -1e30f;
        }
        f32x16 suf;
#pragma unroll
        for (int i = 0; i < 16; ++i) suf[i] = 0.f;
        suf = MFMA32(ut[0], pack8(L[0], L[1], L[2], L[3], L[4], L[5], L[6], L[7]), suf);
        suf = MFMA32(ut[1], pack8(L[8], L[9], L[10], L[11], L[12], L[13], L[14], L[15]), suf);
        float a[16];
#pragma unroll
        for (int r = 0; r < 16; ++r) a[r] = __builtin_amdgcn_exp2f(lw[r] + suf[r] + carry);
        carry += __int_as_float(__builtin_amdgcn_ds_bpermute(q << 2, __float_as_int(suf[0] + L[0])));
        const bf16x8 p0 = pack8(a[0], a[1], a[2], a[3], a[4], a[5], a[6], a[7]), p1 = pack8(a[8], a[9], a[10], a[11], a[12], a[13], a[14], a[15]);
        o0 = MFMA32(vf[0][0], p0, o0); o0 = MFMA32(vf[0][1], p1, o0);
        o1 = MFMA32(vf[1][0], p0, o1); o1 = MFMA32(vf[1][1], p1, o1);
        if (__builtin_amdgcn_ballot_w64(qpos > 0 && carry > -24.0f * LOG2E) == 0ull) break;
#pragma unroll
        for (int s = 0; s < 4; ++s) kf[s] = kn[s];
#pragma unroll
        for (int mt = 0; mt < 2; ++mt)
#pragma unroll
            for (int s = 0; s < 2; ++s) vf[mt][s] = vn[mt][s];
    }
    if (MODE == 0 || q < 16) {
        bf16* orow = A.O + qrow * D + h * DH + 4 * hh;
#pragma unroll
        for (int g = 0; g < 4; ++g) {
            v2u w0, w1; w0.x = pk2(o0[4 * g], o0[4 * g + 1]); w0.y = pk2(o0[4 * g + 2], o0[4 * g + 3]); w1.x = pk2(o1[4 * g], o1[4 * g + 1]); w1.y = pk2(o1[4 * g + 2], o1[4 * g + 3]);
            *(v2u*)(orow + 8 * g) = w0; *(v2u*)(orow + 32 + 8 * g) = w1; }
    }
}
DI void attn_phase(const Ctx c, const AttnT A) {
    const int q = c.lane & 31, hh = c.lane >> 5, piq = pi_row(q);
    bf16x8 ut[2];
#pragma unroll
    for (int s = 0; s < 2; ++s)
#pragma unroll
        for (int j = 0; j < 8; ++j) ut[s][j] = (16 * s + 8 * hh + j > piq) ? (short)0x3f80 : (short)0;
    for (int bu = c.vcu; bu < NB * NH * 4; bu += c.G) {
        const int bh = bu >> 2, b = bh >> 4, h = bh & 15, p = (bu & 3) * 8 + c.wave;
        attn_qtile<0>(A, b, h, 63 - p, c.lane, ut);
        attn_qtile<0>(A, b, h, p, c.lane, ut);
    }
    for (int su = c.wave * c.G + c.vcu; su < NB * NH; su += c.G * 8) attn_qtile<1>(A, su >> 4, su & 15, 0, c.lane, ut);
}

DI void vt_phase(const Ctx c, LAS unsigned char* lds, const bf16* Vb, bf16* VT, bf16* Vsn) {
    LAS unsigned char* scr = lds + c.wave * 16384;
    const int gw = c.vcu * 8 + c.wave, NGW = c.G * 8;
    for (int wt = gw; wt < (TP / 64) * 16; wt += NGW) {
        const int tt = wt >> 4, ht = wt & 15;
        v4u vin[8];
#pragma unroll
        for (int j = 0; j < 8; ++j) vin[j] = *(const v4u*)(Vb + (size_t)(tt * 64 + (c.lane >> 3) + 8 * j) * D + ht * 64 + (c.lane & 7) * 8);
        __builtin_amdgcn_sched_barrier(0);
#pragma unroll
        for (int j = 0; j < 8; ++j) { const int row = (c.lane >> 3) + 8 * j, ch = c.lane & 7;
            LAS unsigned* d = (LAS unsigned*)(scr + row * 132 + ch * 16); d[0] = vin[j].x; d[1] = vin[j].y; d[2] = vin[j].z; d[3] = vin[j].w; }
        LDS_WAIT(); asm volatile("" ::: "memory");
#pragma unroll
        for (int j = 0; j < 8; ++j) { const int orow = (c.lane >> 3) + 8 * j, ch = c.lane & 7;
            unsigned short e[8];
#pragma unroll
            for (int i = 0; i < 8; ++i) e[i] = *(const LAS unsigned short*)(scr + (ch * 8 + i) * 132 + orow * 2);
            v4u o; o.x = e[0] | ((unsigned)e[1] << 16); o.y = e[2] | ((unsigned)e[3] << 16); o.z = e[4] | ((unsigned)e[5] << 16); o.w = e[6] | ((unsigned)e[7] << 16);
            { const int bb = tt >> 5, kt = 2 * (tt & 31) + (ch >> 2);
              *(v4u*)(VT + (((size_t)bb * NH + ht) * (SEQ / 32) + kt) * (DH * 32) + orow * 32 + 8 * (ch & 3)) = o; } }
        LDS_WAIT(); asm volatile("" ::: "memory");
    }
    const size_t NT = (size_t)c.G * 512;
    for (size_t i = (size_t)c.vcu * 512 + c.tid; i < (size_t)TS * D / 8; i += NT) *(v4u*)(Vsn + i * 8) = *(const v4u*)(Vb + (size_t)TP * D + i * 8);
}

DI f32x16 sg_tile(const bf16* wr  , const bf16* xr  ) {
    f32x16 acc;
#pragma unroll
    for (int i = 0; i < 16; ++i) acc[i] = 0.f;
    bf16x8 wa[8], xa[8], wb[8], xb[8];
#pragma unroll
    for (int j = 0; j < 8; ++j) { wa[j] = *(const bf16x8*)(wr + 16 * j); xa[j] = *(const bf16x8*)(xr + 16 * j); }
#pragma unroll 1
    for (int k0 = 0; k0 < 64; k0 += 16) {
#pragma unroll
        for (int j = 0; j < 8; ++j) { wb[j] = *(const bf16x8*)(wr + 16 * (k0 + 8 + j)); xb[j] = *(const bf16x8*)(xr + 16 * (k0 + 8 + j)); }
        __builtin_amdgcn_sched_barrier(0);
#pragma unroll
        for (int j = 0; j < 8; ++j) acc = MFMA32(wa[j], xa[j], acc);
        __builtin_amdgcn_sched_barrier(0);
        { const int kn = k0 + 16 < 64 ? k0 + 16 : 0;
#pragma unroll
          for (int j = 0; j < 8; ++j) { wa[j] = *(const bf16x8*)(wr + 16 * (kn + j)); xa[j] = *(const bf16x8*)(xr + 16 * (kn + j)); } }
        __builtin_amdgcn_sched_barrier(0);
#pragma unroll
        for (int j = 0; j < 8; ++j) acc = MFMA32(wb[j], xb[j], acc);
        __builtin_amdgcn_sched_barrier(0);
    }
    return acc;
}
DI void sg_gate(const Ctx c, const bf16* Hall  , const bf16* Wl  , bf16* U, bf16* Bg, float* convp  ) {
    const int q = c.lane & 31, hh = c.lane >> 5;
    for (int tile = c.wave * c.G + c.vcu; tile < 18 * 32; tile += c.G * 8) {
        const int tt = tile % 18, dt = tile / 18, d = 32 * dt + q, crow = 256 * (d >> 7) + (d & 127);
        const bool cs = tt >= 16; const int kk = (tt - 16) * 32 + q;
        const size_t row = cs ? (size_t)(kk >> 1) * SEQ + (SEQ - 2) + (kk & 1) : (size_t)TP + tt * 32 + q;
        const bf16* xr = Hall + row * D + 8 * hh;
        const bf16* wc = Wl + (size_t)crow * D + 8 * hh; const bf16* wx = wc + (size_t)128 * D; const bf16* wb = Wl + (size_t)(2048 + d) * D + 8 * hh;
        f32x16 ac, ax, ab;
#pragma unroll
        for (int i = 0; i < 16; ++i) { ac[i] = 0.f; ax[i] = 0.f; ab[i] = 0.f; }
        { bf16x8 fx[4], fc[4], fxx[4], fb[4], gx[4], gc[4], gxx[4], gb[4];
#pragma unroll
          for (int j = 0; j < 4; ++j) { fx[j] = *(const bf16x8*)(xr + 16 * j); fc[j] = *(const bf16x8*)(wc + 16 * j); fxx[j] = *(const bf16x8*)(wx + 16 * j); fb[j] = *(const bf16x8*)(wb + 16 * j); }
#pragma unroll 1
          for (int k0 = 0; k0 < 64; k0 += 8) {
#pragma unroll
              for (int j = 0; j < 4; ++j) { gx[j] = *(const bf16x8*)(xr + 16 * (k0 + 4 + j)); gc[j] = *(const bf16x8*)(wc + 16 * (k0 + 4 + j)); gxx[j] = *(const bf16x8*)(wx + 16 * (k0 + 4 + j)); gb[j] = *(const bf16x8*)(wb + 16 * (k0 + 4 + j)); }
              __builtin_amdgcn_sched_barrier(0);
#pragma unroll
              for (int j = 0; j < 4; ++j) { ac = MFMA32(fc[j], fx[j], ac); ax = MFMA32(fxx[j], fx[j], ax); ab = MFMA32(fb[j], fx[j], ab); }
              __builtin_amdgcn_sched_barrier(0);
              { const int kn = k0 + 8 < 64 ? k0 + 8 : 0;
#pragma unroll
                for (int j = 0; j < 4; ++j) { fx[j] = *(const bf16x8*)(xr + 16 * (kn + j)); fc[j] = *(const bf16x8*)(wc + 16 * (kn + j)); fxx[j] = *(const bf16x8*)(wx + 16 * (kn + j)); fb[j] = *(const bf16x8*)(wb + 16 * (kn + j)); } }
              __builtin_amdgcn_sched_barrier(0);
#pragma unroll
              for (int j = 0; j < 4; ++j) { ac = MFMA32(gc[j], gx[j], ac); ax = MFMA32(gxx[j], gx[j], ax); ab = MFMA32(gb[j], gx[j], ab); }
              __builtin_amdgcn_sched_barrier(0);
          } }
        if (cs) {
            float* cd = convp + (size_t)kk * D + 32 * dt + 4 * hh;
#pragma unroll
            for (int g = 0; g < 4; ++g) *(f32x4*)(cd + 8 * g) = (f32x4){ac[4 * g] * ax[4 * g], ac[4 * g + 1] * ax[4 * g + 1], ac[4 * g + 2] * ax[4 * g + 2], ac[4 * g + 3] * ax[4 * g + 3]};
        } else {
            const size_t ro = row * D + 32 * dt + 4 * hh;
#pragma unroll
            for (int g = 0; g < 4; ++g) { v2u wu, wb2; wu.x = pk2(ac[4 * g] * ax[4 * g], ac[4 * g + 1] * ax[4 * g + 1]); wu.y = pk2(ac[4 * g + 2] * ax[4 * g + 2], ac[4 * g + 3] * ax[4 * g + 3]);
                wb2.x = pk2(ab[4 * g], ab[4 * g + 1]); wb2.y = pk2(ab[4 * g + 2], ab[4 * g + 3]);
                *(v2u*)(U + ro + 8 * g) = wu; *(v2u*)(Bg + ro + 8 * g) = wb2; }
        }
    }
}
template <int MODE>
DI void sg_plain(const Ctx c, const bf16* Xs, const bf16* Wt, const int N, bf16* O, const bf16* Hres, bf16* O2, float* f0, float* f1) {
    const int q = c.lane & 31, hh = c.lane >> 5;
    for (int tile = c.wave * c.G + c.vcu; tile < 16 * (N / 32); tile += c.G * 8) {
        const int tt = tile & 15, ft = tile >> 4;
        const f32x16 acc = sg_tile(Wt + (size_t)(ft * 32 + q) * D + 8 * hh, Xs + (size_t)(tt * 32 + q) * D + 8 * hh);
        const int tl = tt * 32 + q;
#pragma unroll
        for (int g = 0; g < 4; ++g) { const int f = 32 * ft + 8 * g + 4 * hh; const f32x4 v = {acc[4 * g], acc[4 * g + 1], acc[4 * g + 2], acc[4 * g + 3]};
            if (MODE == 0) { v2u w; w.x = pk2(v[0], v[1]); w.y = pk2(v[2], v[3]); *(v2u*)(O + (size_t)(TP + tl) * D + f) = w; }
            else if (MODE == 1) { const v2u hw = *(const v2u*)(Hres + (size_t)(TP + tl) * D + f); const f32x4 r = (f32x4){bflo(hw.x), bfhi(hw.x), bflo(hw.y), bfhi(hw.y)} * ALPHA + v;
                v2u w; w.x = pk2(r[0], r[1]); w.y = pk2(r[2], r[3]); *(v2u*)(O + (size_t)(TP + tl) * D + f) = w; }
            else if (MODE == 2) { const bool isv = f >= 1024; const int fc = isv ? f - 1024 : f; v2u w; w.x = pk2(v[0], v[1]); w.y = pk2(v[2], v[3]);
                *(v2u*)((isv ? O2 : O) + (size_t)(TP + tl) * D + fc) = w; *(f32x4*)((isv ? f1 : f0) + (size_t)tl * D + fc) = v; }
            else { v2u w; w.x = pk2(v[0], v[1]); w.y = pk2(v[2], v[3]); *(v2u*)(O + (size_t)(TP + tl) * 2048 + f) = w; }
        }
    }
}

struct Args { const float* in[18]; float* out; unsigned char* ws; int ph_lo, ph_hi, li, pad; };
constexpr int N_PHASES = 2 + 2 * 10 + 12 + 10;
__global__ void __launch_bounds__(512, 2) fwd(Args args) {
    extern __shared__ __attribute__((aligned(16))) unsigned char lds_raw[];
    LAS unsigned char* lds = (LAS unsigned char*)lds_raw;
    Ctx c0; c0.tid = threadIdx.x; c0.lane = 0; c0.wave = __builtin_amdgcn_readfirstlane(c0.tid >> 6); c0.G = gridDim.x;
    { const int bx = blockIdx.x; c0.vcu = (c0.G % 8 == 0) ? (bx % 8) * (c0.G / 8) + bx / 8 : bx; }
    volatile LAS unsigned* MISC = (volatile LAS unsigned*)(lds + MISC_OFF);
    for (int u = c0.tid; u < (LDS_BYTES - RING_BYTES) / 4; u += 512) ((LAS unsigned*)(lds + RING_BYTES))[u] = 0u;
    __syncthreads();
    unsigned char* ws = args.ws; float* out = args.out;
    XcdBarrier bar = xcd_barrier_post((unsigned*)(ws + WS_CTL) + CW_BAR + args.li * XCD_BAR_WORDS, MISC + 8, c0.wave == 0 ? 1u : 0u);
#define WinT ((bf16*)(wsl + WS_WIN))
#define WoutT ((bf16*)(wsl + WS_WOUT))
#define WqT ((bf16*)(wsl + WS_WQ))
#define WoT ((bf16*)(wsl + WS_WO))
#define WkvT ((bf16*)(wsl + WS_WKV))
#define WP ((bf16*)(wsl + WS_WP))
#define W8A (wsl + WS_W8A)
#define SWA ((float*)(wsl + WS_SWA))
#define W8R(off) ((int)(((off) - WS_WIN) / 2048))
#define Vsn ((bf16*)(wsl + WS_VSN))
#define H ((bf16*)(wsl + WS_H))
#define Kb ((bf16*)(wsl + WS_KB))
#define VT ((bf16*)(wsl + WS_VT))
#define ids ((unsigned short*)(wsl + WS_IDS))
#define gates ((float*)(wsl + WS_GATE))
#define W8 (wsl + WS_W8)
#define SX ((float*)(wsl + WS_SX))
#define SW (SX + T)
#define X8 (wsl + WS_X8)
#define TU (wsl + WS_TU)
#define TV (wsl + WS_TV)
#define SU ((float*)(wsl + WS_SU))
#define SV (SU + 1)
#define A0 ((bf16*)(wsl + WS_A))
#define A1 ((bf16*)(wsl + WS_A + 129 * MiB))
#define ScT ((float*)(wsl + WS_A))
#define R A0
    const float* ln_g = args.in[16]; const float* ln_b = args.in[17];
    const int lo = args.ph_lo, hi = args.ph_hi; int ph = 0;
#ifndef PROBE_REPEAT
#define PROBE_REPEAT 0
#endif
#define PHASE_R(bit, body) do { const int nrep = 1 + ((PROBE_REPEAT >> (bit)) & 1); for (int rep = 0; rep < nrep; ++rep) { if (ph >= lo && ph < hi) { Ctx c = c0; c.lane = xb_lane_id(); c.tid = c0.wave * 64 + c.lane; unsigned long long wsi_ = (unsigned long long)ws; asm volatile("" : "+s"(wsi_)); unsigned char* wsl = (unsigned char*)(GAS unsigned char*)wsi_; body; if (ph + 1 < hi) { xcd_barrier(bar); if ((PROBE_REPEAT >> 20) & 1) xcd_barrier(bar); } } ++ph; } } while (0)
#define PHASE(body) PHASE_R(31, body)

    PHASE_R(4, ({ P0Args a{args.in[0], args.in[1], args.in[5], args.in[7], args.in[8], args.in[9], args.in[10], args.in[11], args.in[12], args.in[13], args.in[14], args.in[15],
                      WinT, WoutT, WqT, WoT, WkvT, WP, H, TU, TV, SU, SV, X8, SX}; p0_prologue(c, lds, a); }));

    PHASE(({ wp_quant_phase(c, WinT, W8A, SWA); }));

#pragma unroll 1
    for (int l = 0; l < NLAYER; ++l) {
        if (l < 2) {
            PHASE_R(8, ({ pg8::Gemm g{(const bf16*)X8, (const bf16*)(W8A + ((size_t)W8R(WS_WIN) + (size_t)l * 3072) * 1024), TP, 3072, 512}; pg8::StaticOrder S; S.init(TP, 3072, c.G, (int)blockIdx.x);
                     pg8::EpiGate<true> E{A0, A1, SX, SWA + W8R(WS_WIN) + l * 3072};
                     pg8::gemm_phase<pg8::EpiGate<true>, pg8::StaticOrder, true, true, true>(lds, g, S, E, c.tid);
                     sg_gate(c, H, WinT + (size_t)l * 3072 * 1024, A0, A1, out + O_CONVP + (size_t)l * NB * 2 * D); }));
            PHASE_R(13, ({ conv_gate_phase(c, A0, A1, args.in[6] + (size_t)l * 3 * D, args.in[2] + (size_t)l * NB * 2 * D, out + O_CONVP + (size_t)l * NB * 2 * D, out + O_CONVS + (size_t)l * NB * 2 * D, X8, SX, rep > 0); }));
        } else {
            if (l == 2) {
                PHASE_R(10, ({ pg8::Gemm g{(const bf16*)X8, (const bf16*)(W8A + (size_t)W8R(WS_WKV) * 1024), TP, 2048, 512}; pg8::StaticOrder S; S.init(TP, 2048, c.G, (int)blockIdx.x);
                         pg8::EpiKV<true> E{Kb, A1, out + O_KP, out + O_VP, out + O_KS, out + O_VS, SX, SWA + W8R(WS_WKV)};
                         pg8::gemm_phase<pg8::EpiKV<true>, pg8::StaticOrder, true, true, true>(lds, g, S, E, c.tid);
                         sg_plain<2>(c, H + (size_t)TP * D, WkvT, 2048, Kb, nullptr, A1, out + O_KS, out + O_VS); }));
                PHASE_R(14, ({ vt_phase(c, lds, A1, VT, Vsn); }));
            }
            PHASE_R(9, ({ pg8::Gemm g{(const bf16*)X8, (const bf16*)(W8A + ((size_t)W8R(WS_WQ) + (size_t)(l - 2) * 1024) * 1024), TP, 1024, 512}; pg8::StaticOrder S; S.init(TP, 1024, c.G, (int)blockIdx.x);
                     pg8::EpiBf16P<true> E{A0, 1024, SX, SWA + W8R(WS_WQ) + (l - 2) * 1024};
                     pg8::gemm_phase<pg8::EpiBf16P<true>, pg8::StaticOrder, true, true, true>(lds, g, S, E, c.tid);
                     sg_plain<0>(c, H + (size_t)TP * D, WqT + (size_t)(l - 2) * 1024 * 1024, 1024, A0, nullptr, nullptr, nullptr, nullptr); }));
            PHASE_R(11, ({ AttnT A{A0, A1, Kb, VT, Vsn, args.in[3], args.in[4]}; attn_phase(c, A); }));
        }
        if (l < 2) {
            PHASE_R(7, ({ pg8::Gemm g{(const bf16*)X8, (const bf16*)(W8A + ((size_t)W8R(WS_WOUT) + (size_t)l * 1024) * 1024), TP, 1024, 512}; pg8::StaticOrder S; S.init(TP, 1024, c.G, (int)blockIdx.x);
                     pg8::EpiRes<true> E{H, R, ALPHA, SX, SWA + W8R(WS_WOUT) + l * 1024};
                     pg8::gemm_phase<pg8::EpiRes<true>, pg8::StaticOrder, true, true, true>(lds, g, S, E, c.tid);
                     sg_plain<1>(c, A1 + (size_t)TP * D, WoutT + (size_t)l * 1024 * 1024, 1024, R, H, nullptr, nullptr, nullptr); }));
        } else {
            PHASE_R(7, ({ pg8::Gemm g{A1, WoT + (size_t)(l - 2) * 1024 * 1024, TP, 1024, 1024}; pg8::StaticOrder S; S.init(TP, 1024, c.G, (int)blockIdx.x);
                     pg8::EpiRes<false> E{H, R, ALPHA, nullptr, nullptr};
                     pg8::gemm_phase<pg8::EpiRes<false>, pg8::StaticOrder, true, true>(lds, g, S, E, c.tid);
                     sg_plain<1>(c, A1 + (size_t)TP * D, WoT + (size_t)(l - 2) * 1024 * 1024, 1024, R, H, nullptr, nullptr, nullptr); }));
        }
        PHASE_R(5, ({ ln_phase(c, R, H, ln_g + (size_t)(l * 2) * D, ln_b + (size_t)(l * 2) * D, nullptr, nullptr, X8, SX); }));
        PHASE_R(6, ({ pg8::Gemm g{(const bf16*)X8, (const bf16*)(W8A + ((size_t)W8R(WS_WP) + (size_t)l * 2048) * 1024), TP, 2048, 512}; pg8::StaticOrder S; S.init(TP, 2048, c.G, (int)blockIdx.x);
                 pg8::EpiScoreI8 E{(bf16*)ScT, 2048, SX, SWA + W8R(WS_WP) + l * 2048};
                 pg8::gemm_phase<pg8::EpiScoreI8, pg8::StaticOrder, true, true, true>(lds, g, S, E, c.tid);
                 sg_plain<3>(c, H + (size_t)TP * D, WP + (size_t)l * 2048 * 1024, 2048, (bf16*)ScT, nullptr, nullptr, nullptr, nullptr); }));
        PHASE_R(3, ({ topk_phase(c, (const bf16*)ScT, ids, gates); }));
        PHASE_R(0, ({ slice_pass<0>(c, X8, ids, W8, SW, TU + (size_t)l * NEXP * D, ScT  , (unsigned*)(ws + WS_CTL) + CW_Q + ((l * 2) * 2 + rep) * 512); }));
        PHASE_R(12, ({ peer_w_phase(c, ScT, ids, gates, W8, SW, SX, SU + (size_t)l * NEXP * 2, SV + (size_t)l * NEXP * 2); }));
        PHASE_R(1, ({ slice_pass<1>(c, X8, ids, W8, SW, TV + (size_t)l * NEXP * D, (float*)A0, (unsigned*)(ws + WS_CTL) + CW_Q + ((l * 2 + 1) * 2 + rep) * 512); }));
        PHASE(({ ln_phase(c, A0, H, ln_g + (size_t)(l * 2 + 1) * D, ln_b + (size_t)(l * 2 + 1) * D, l == NLAYER - 1 ? out : nullptr, H, X8, SX); }));
#if defined(PROBE_SLICE) && PROBE_SLICE == 1
        PHASE(({ slice_pass<0, 1>(c, X8, ids, W8, SW, TU + (size_t)l * NEXP * D, ScT, (unsigned*)(ws + WS_CTL) + CW_Q + ((l * 2) * 2 + 1) * 512); }));
#elif defined(PROBE_SLICE) && PROBE_SLICE == 2
        PHASE(({ slice_pass<0, 2>(c, X8, ids, W8, SW, TU + (size_t)l * NEXP * D, ScT, (unsigned*)(ws + WS_CTL) + CW_Q + ((l * 2) * 2 + 1) * 512); }));
#elif defined(PROBE_SLICE) && PROBE_SLICE == 3
        PHASE(({ slice_pass<1, 1>(c, X8, ids, W8, SW, TV + (size_t)l * NEXP * D, ScT, (unsigned*)(ws + WS_CTL) + CW_Q + ((l * 2) * 2 + 1) * 512); }));
#elif defined(PROBE_SLICE) && PROBE_SLICE == 4
        PHASE(({ slice_pass<1, 2>(c, X8, ids, W8, SW, TV + (size_t)l * NEXP * D, ScT, (unsigned*)(ws + WS_CTL) + CW_Q + ((l * 2) * 2 + 1) * 512); }));
#endif
    }
#undef PHASE
#undef PHASE_R
#undef WinT
#undef WoutT
#undef WqT
#undef WoT
#undef WkvT
#undef WP
#undef W8A
#undef SWA
#undef W8R
#undef Vsn
#undef H
#undef Kb
#undef VT
#undef ids
#undef gates
#undef W8
#undef SX
#undef SW
#undef X8
#undef TU
#undef TV
#undef SU
#undef SV
#undef A0
#undef A1
#undef ScT
#undef R
}

#ifndef N_LAUNCH_MODE
#define N_LAUNCH_MODE 1
#endif
extern "C" void kernel_launch(void* const* d_in, const int* in_sizes, int n_in, void* d_out, int out_size, void* d_ws, size_t ws_size, hipStream_t stream) {
    static int grid = 0;
    if (grid == 0) {
        if (n_in != 18 || in_sizes[0] != TP * D || (size_t)out_size != O_END || ws_size < WS_END) {
            fprintf(stderr, "kernel_launch: shape mismatch: n_in %d in0 %d out %d ws %zu (need %zu)\n", n_in, n_in > 0 ? in_sizes[0] : -1, out_size, ws_size, (size_t)WS_END); grid = -1; return; }
        int dev = 0, cus = 0, per_cu = 0;
        if (hipGetDevice(&dev) != hipSuccess || hipDeviceGetAttribute(&cus, hipDeviceAttributeMultiprocessorCount, dev) != hipSuccess) { grid = -1; return; }
        if (hipFuncSetAttribute((const void*)fwd, hipFuncAttributeMaxDynamicSharedMemorySize, LDS_BYTES) != hipSuccess) { fprintf(stderr, "kernel_launch: hipFuncSetAttribute failed\n"); grid = -1; return; }
        if (hipOccupancyMaxActiveBlocksPerMultiprocessor(&per_cu, (const void*)fwd, 512, LDS_BYTES) != hipSuccess || per_cu < 1) { fprintf(stderr, "kernel_launch: occupancy query says %d\n", per_cu); }
        (void)hipGetLastError();
        grid = cus;
    }
    if (grid < 0) return;
    (void)hipMemsetAsync((char*)d_ws + WS_CTL, 0, CTL_BYTES, stream);
    Args a{};
    for (int i = 0; i < 18; ++i) a.in[i] = (const float*)d_in[i];
    a.out = (float*)d_out; a.ws = (unsigned char*)d_ws; a.pad = 0;
#if N_LAUNCH_MODE == 1
    a.ph_lo = 0; a.ph_hi = 1 << 30; a.li = 0;
    hipLaunchKernelGGL(fwd, dim3(grid), dim3(512), LDS_BYTES, stream, a);
#else
    for (int p = 0; p < N_PHASES; ++p) { a.ph_lo = p; a.ph_hi = p + 1; a.li = p; hipLaunchKernelGGL(fwd, dim3(grid), dim3(512), LDS_BYTES, stream, a); }
#endif
}
```

```cpp
#include <hip/hip_runtime.h>
#include <cstdio>
#include <cstdint>
namespace pg8 {
#define PG8_LAS __attribute__((address_space(3)))
typedef unsigned short bf16_t;
typedef short bf16x8 __attribute__((ext_vector_type(8)));
typedef float f32x4 __attribute__((ext_vector_type(4)));
typedef unsigned u32x4 __attribute__((ext_vector_type(4)));
constexpr int BM = 256, BK = 64, HALF = 128, HTB = HALF * BK * 2  , STAGE_BYTES = 8 * HTB, NXCD = 8, WGM = 8;

__host__ __device__ __forceinline__ int lds_byte(int r, int c) { const int st = (r >> 4) * 2 + (c >> 5), rr = r & 15, cc = c & 31, ob = rr * 64 + cc * 2; return st * 1024 + (ob ^ (((ob >> 9) & 1) << 5)); }
__host__ __device__ __forceinline__ void stage_rc(int b, int& R, int& C) { const int st = b / 1024, sb = b % 1024, swz = sb ^ (((sb >> 9) & 1) << 5); R = (st >> 1) * 16 + swz / 64; C = (st & 1) * 32 + (swz % 64) / 2; }
__host__ __device__ __forceinline__ int perm32(int rho) { const int n = rho >> 4, i = rho & 15; return 8 * (i >> 2) + 4 * n + (i & 3); }

struct Unit { int pm, pn; };
struct Gemm { const bf16_t* A; const bf16_t* Bt; int M, N, K; };

struct StaticOrder {
    int nM, nN, nwg, G, c;
    __host__ __device__ void init(int M, int N, int G_, int c_) { nM = M / BM; nN = N / BM; nwg = nM * nN; G = G_; c = c_; }
    __host__ __device__ bool next(int i, Unit& u) const {
        const long L = (long)i * G + c; if (L >= nwg) return false;
        int wgid = (int)L; { const int q = nwg / NXCD, r = nwg % NXCD, xcd = wgid % NXCD, off = wgid / NXCD; wgid = (xcd < r ? xcd * (q + 1) : r * (q + 1) + (xcd - r) * q) + off; }
        const int nig = WGM * nN, gid = wgid / nig, fm = gid * WGM, gsz = (nM - fm) < WGM ? (nM - fm) : WGM;
        u.pm = fm + ((wgid % nig) % gsz); u.pn = (wgid % nig) / gsz; return true;
    }
    __device__ __forceinline__ void a_ready(const Unit&) const {}
    __device__ __forceinline__ void done(const Unit&) const {}
};

typedef float f32x2 __attribute__((ext_vector_type(2)));
typedef __bf16 bf16x2v __attribute__((ext_vector_type(2)));
typedef unsigned u32x2 __attribute__((ext_vector_type(2)));
__device__ __forceinline__ unsigned pk2(float lo, float hi) { const bf16x2v v = __builtin_convertvector((f32x2){lo, hi}, bf16x2v); return __builtin_bit_cast(unsigned, v); }
__device__ __forceinline__ u32x4 pk8(const f32x4 a, const f32x4 b) { u32x4 w; w.x = pk2(a[0], a[1]); w.y = pk2(a[2], a[3]); w.z = pk2(b[0], b[1]); w.w = pk2(b[2], b[3]); return w; }

typedef int i32x4 __attribute__((ext_vector_type(4)));
template <bool I8> struct AccT { typedef f32x4 type; static __device__ __forceinline__ type zero() { return (f32x4){0.f, 0.f, 0.f, 0.f}; } };
template <> struct AccT<true> { typedef i32x4 type; static __device__ __forceinline__ type zero() { return (i32x4){0, 0, 0, 0}; } };
__device__ __forceinline__ f32x4 mma16(const bf16x8 b, const bf16x8 a, const f32x4 c) { return __builtin_amdgcn_mfma_f32_16x16x32_bf16(b, a, c, 0, 0, 0); }
__device__ __forceinline__ i32x4 mma16(const bf16x8 b, const bf16x8 a, const i32x4 c) { return __builtin_amdgcn_mfma_i32_16x16x64_i8(__builtin_bit_cast(i32x4, b), __builtin_bit_cast(i32x4, a), c, 0, 0, 0); }
__device__ __forceinline__ f32x4 dq4(const f32x4 a, const float, const f32x4) { return a; }
__device__ __forceinline__ f32x4 dq4(const i32x4 a, const float ra, const f32x4 cb) { return (f32x4){(float)a[0], (float)a[1], (float)a[2], (float)a[3]} * ra * cb; }
constexpr int TOK_P = 65536;

template <bool I8> struct EpiBf16P {
    static constexpr bool PERM = true, AFTER_DRAIN = false;
    bf16_t* O; int ldc; const float* sa; const float* sb;
    __device__ __forceinline__ void operator()(const typename AccT<I8>::type (&acc)[2][2][4][2], const Unit& u, int wr, int wc, int fr, int fq) const {
        const int row0 = u.pm * BM + wr * 64 + fr, col0 = u.pn * BM + wc * 32 + 8 * fq;
        f32x4 cb[2][2];
#pragma unroll
        for (int bj = 0; bj < 2; ++bj)
#pragma unroll
            for (int n = 0; n < 2; ++n) cb[bj][n] = I8 ? *(const f32x4*)(sb + col0 + bj * HALF + 4 * n) : (f32x4){1.f, 1.f, 1.f, 1.f};
        float rs[2][4];
#pragma unroll
        for (int ai = 0; ai < 2; ++ai)
#pragma unroll
            for (int m = 0; m < 4; ++m) rs[ai][m] = I8 ? sa[row0 + ai * HALF + m * 16] : 1.f;
        __builtin_amdgcn_sched_barrier(0);
#pragma unroll
        for (int ai = 0; ai < 2; ++ai)
#pragma unroll
            for (int m = 0; m < 4; ++m) { const int row = row0 + ai * HALF + m * 16; const float ra = rs[ai][m]; bf16_t* rowp = O + (size_t)row * ldc + col0;
#pragma unroll
                for (int bj = 0; bj < 2; ++bj) *(u32x4*)(rowp + bj * HALF) = pk8(dq4(acc[ai][bj][m][0], ra, cb[bj][0]), dq4(acc[ai][bj][m][1], ra, cb[bj][1])); }
    }
};
template <bool I8> struct EpiGate {
    static constexpr bool PERM = true, AFTER_DRAIN = false;
    bf16_t* U; bf16_t* Bg; const float* sa; const float* sb;
    __device__ __forceinline__ void operator()(const typename AccT<I8>::type (&acc)[2][2][4][2], const Unit& u, int wr, int wc, int fr, int fq) const {
        const int row0 = u.pm * BM + wr * 64 + fr, scol0 = u.pn * BM + wc * 32 + 8 * fq;
        f32x4 cb[2][2];
#pragma unroll
        for (int bj = 0; bj < 2; ++bj)
#pragma unroll
            for (int n = 0; n < 2; ++n) cb[bj][n] = I8 ? *(const f32x4*)(sb + scol0 + bj * HALF + 4 * n) : (f32x4){1.f, 1.f, 1.f, 1.f};
        float rs[2][4];
#pragma unroll
        for (int ai = 0; ai < 2; ++ai)
#pragma unroll
            for (int m = 0; m < 4; ++m) rs[ai][m] = I8 ? sa[row0 + ai * HALF + m * 16] : 1.f;
        __builtin_amdgcn_sched_barrier(0);
        if (u.pn < 8) {
            const int col0 = u.pn * HALF + wc * 32 + 8 * fq;
#pragma unroll
            for (int ai = 0; ai < 2; ++ai)
#pragma unroll
                for (int m = 0; m < 4; ++m) { const int row = row0 + ai * HALF + m * 16; const float ra = rs[ai][m];
                    const f32x4 v0 = dq4(acc[ai][0][m][0], ra, cb[0][0]) * dq4(acc[ai][1][m][0], ra, cb[1][0]), v1 = dq4(acc[ai][0][m][1], ra, cb[0][1]) * dq4(acc[ai][1][m][1], ra, cb[1][1]);
                    *(u32x4*)(U + (size_t)row * 1024 + col0) = pk8(v0, v1); }
        } else {
            const int col0 = (u.pn - 8) * BM + wc * 32 + 8 * fq;
#pragma unroll
            for (int ai = 0; ai < 2; ++ai)
#pragma unroll
                for (int m = 0; m < 4; ++m) { const int row = row0 + ai * HALF + m * 16; const float ra = rs[ai][m]; bf16_t* rowp = Bg + (size_t)row * 1024 + col0;
#pragma unroll
                    for (int bj = 0; bj < 2; ++bj) *(u32x4*)(rowp + bj * HALF) = pk8(dq4(acc[ai][bj][m][0], ra, cb[bj][0]), dq4(acc[ai][bj][m][1], ra, cb[bj][1])); }
        }
    }
};
template <bool I8> struct EpiRes {
    static constexpr bool PERM = true, AFTER_DRAIN = false;
    const bf16_t* H; bf16_t* R; float alpha; const float* sa; const float* sb;
    __device__ __forceinline__ void operator()(const typename AccT<I8>::type (&acc)[2][2][4][2], const Unit& u, int wr, int wc, int fr, int fq) const {
        const int row0 = u.pm * BM + wr * 64 + fr, col0 = u.pn * BM + wc * 32 + 8 * fq;
        f32x4 cb[2][2];
#pragma unroll
        for (int bj = 0; bj < 2; ++bj)
#pragma unroll
            for (int n = 0; n < 2; ++n) cb[bj][n] = I8 ? *(const f32x4*)(sb + col0 + bj * HALF + 4 * n) : (f32x4){1.f, 1.f, 1.f, 1.f};
        float rs[2][4];
#pragma unroll
        for (int ai = 0; ai < 2; ++ai)
#pragma unroll
            for (int m = 0; m < 4; ++m) rs[ai][m] = I8 ? sa[row0 + ai * HALF + m * 16] : 1.f;
        __builtin_amdgcn_sched_barrier(0);
#pragma unroll
        for (int ai = 0; ai < 2; ++ai) {
            u32x4 hq[4][2];
#pragma unroll
            for (int m = 0; m < 4; ++m)
#pragma unroll
                for (int bj = 0; bj < 2; ++bj) hq[m][bj] = *(const u32x4*)(H + (size_t)(row0 + ai * HALF + m * 16) * 1024 + col0 + bj * HALF);
            __builtin_amdgcn_sched_barrier(0);
#pragma unroll
            for (int m = 0; m < 4; ++m) { const int row = row0 + ai * HALF + m * 16; const float ra = rs[ai][m]; const size_t off = (size_t)row * 1024 + col0;
#pragma unroll
                for (int bj = 0; bj < 2; ++bj) { const u32x4 h = hq[m][bj];
                    f32x4 h0, h1; h0[0] = __uint_as_float(h.x << 16); h0[1] = __uint_as_float(h.x & 0xffff0000u); h0[2] = __uint_as_float(h.y << 16); h0[3] = __uint_as_float(h.y & 0xffff0000u);
                    h1[0] = __uint_as_float(h.z << 16); h1[1] = __uint_as_float(h.z & 0xffff0000u); h1[2] = __uint_as_float(h.w << 16); h1[3] = __uint_as_float(h.w & 0xffff0000u);
                    *(u32x4*)(R + off + bj * HALF) = pk8(h0 * alpha + dq4(acc[ai][bj][m][0], ra, cb[bj][0]), h1 * alpha + dq4(acc[ai][bj][m][1], ra, cb[bj][1])); } } }
    }
};
template <bool I8> struct EpiKV {
    static constexpr bool PERM = true, AFTER_DRAIN = false;
    bf16_t* Kb; bf16_t* Vb; float* kp; float* vp; float* ks; float* vs; const float* sa; const float* sb;
    __device__ __forceinline__ void operator()(const typename AccT<I8>::type (&acc)[2][2][4][2], const Unit& u, int wr, int wc, int fr, int fq) const {
        const bool isv = u.pn >= 4; const int colt = (isv ? u.pn - 4 : u.pn) * BM;
        bf16_t* ob = isv ? Vb : Kb; const bool samp = u.pm * BM >= TOK_P;
        float* of = samp ? (isv ? vs : ks) - (size_t)TOK_P * 1024 : (isv ? vp : kp);
        const int row0 = u.pm * BM + wr * 64 + fr, col0 = colt + wc * 32 + 8 * fq, scol0 = u.pn * BM + wc * 32 + 8 * fq;
        float rs[2][4];
#pragma unroll
        for (int ai = 0; ai < 2; ++ai)
#pragma unroll
            for (int m = 0; m < 4; ++m) rs[ai][m] = I8 ? sa[row0 + ai * HALF + m * 16] : 1.f;
        f32x4 cb[2][2];
#pragma unroll
        for (int bj = 0; bj < 2; ++bj)
#pragma unroll
            for (int n = 0; n < 2; ++n) cb[bj][n] = I8 ? *(const f32x4*)(sb + scol0 + bj * HALF + 4 * n) : (f32x4){1.f, 1.f, 1.f, 1.f};
#pragma unroll
        for (int ai = 0; ai < 2; ++ai)
#pragma unroll
            for (int m = 0; m < 4; ++m) { const int row = row0 + ai * HALF + m * 16; const float ra = rs[ai][m]; const size_t off = (size_t)row * 1024 + col0;
#pragma unroll
                for (int bj = 0; bj < 2; ++bj) { const f32x4 v0 = dq4(acc[ai][bj][m][0], ra, cb[bj][0]), v1 = dq4(acc[ai][bj][m][1], ra, cb[bj][1]);
                    *(u32x4*)(ob + off + bj * HALF) = pk8(v0, v1); *(f32x4*)(of + off + bj * HALF) = v0; *(f32x4*)(of + off + bj * HALF + 4) = v1; } }
    }
};

struct EpiScoreI8 {
    static constexpr bool PERM = true, AFTER_DRAIN = false;
    bf16_t* O; int ldc; const float* sa; const float* sb;
    __device__ __forceinline__ void operator()(const i32x4 (&acc)[2][2][4][2], const Unit& u, int wr, int wc, int fr, int fq) const {
        const int row0 = u.pm * BM + wr * 64 + fr, col0 = u.pn * BM + wc * 32 + 8 * fq;
        f32x4 cb[2][2];
#pragma unroll
        for (int bj = 0; bj < 2; ++bj)
#pragma unroll
            for (int n = 0; n < 2; ++n) cb[bj][n] = *(const f32x4*)(sb + col0 + bj * HALF + 4 * n);
        float rs[2][4];
#pragma unroll
        for (int ai = 0; ai < 2; ++ai)
#pragma unroll
            for (int m = 0; m < 4; ++m) rs[ai][m] = sa[row0 + ai * HALF + m * 16];
        __builtin_amdgcn_sched_barrier(0);
#pragma unroll
        for (int ai = 0; ai < 2; ++ai)
#pragma unroll
            for (int m = 0; m < 4; ++m) { const int row = row0 + ai * HALF + m * 16; const float ra = rs[ai][m]; bf16_t* rowp = O + (size_t)row * ldc + col0;
#pragma unroll
                for (int bj = 0; bj < 2; ++bj) { f32x4 v0, v1;
#pragma unroll
                    for (int i = 0; i < 4; ++i) { v0[i] = (float)acc[ai][bj][m][0][i] * ra * cb[bj][0][i]; v1[i] = (float)acc[ai][bj][m][1][i] * ra * cb[bj][1][i]; }
                    *(u32x4*)(rowp + bj * HALF) = pk8(v0, v1); } }
    }
};

template <class Epi, class Sched, bool ALIGN_EPI = false, bool SP2 = false, bool I8 = false>
__device__ __forceinline__ void gemm_phase(PG8_LAS unsigned char* lds, const Gemm g, const Sched& S, const Epi& E, const int tid_in) {
    int tid_ = tid_in; asm volatile("" : "+v"(tid_));
    const int tid = tid_, wid = __builtin_amdgcn_readfirstlane(tid >> 6), lane = tid & 63, wr = wid >> 2, wc = wid & 3, fr = lane & 15, fq = lane >> 4;
    const int K = g.K, nt = K / BK;
    unsigned voffA[2], voffB[2];
#pragma unroll
    for (int i = 0; i < 2; ++i) { int R, C; stage_rc(tid * 16 + i * 8192, R, C); const int Rb = Epi::PERM ? ((R & ~31) + perm32(R & 31)) : R;
        voffA[i] = (unsigned)(R * K + C) * 2u; voffB[i] = (unsigned)(Rb * K + C) * 2u; }
    const size_t kstep = (size_t)(BK * 2);
    const size_t hstep = (size_t)HALF * K * 2;
    const size_t tstep = 2 * hstep;
    const unsigned ldsw = (unsigned)wid * 1024u;
    const int aoff = lds_byte(wr * 64 + fr, fq * 8), boff = lds_byte(wc * 32 + fr, fq * 8);
#define PG8_SA(b, h) (((b) * 2 + (h)) * HTB)
#define PG8_SB(b, h) ((4 + (b) * 2 + (h)) * HTB)
#define PG8_STAGE(bufoff, gbase, voff) do { _Pragma("unroll") for (int _i = 0; _i < 2; ++_i) \
        __builtin_amdgcn_global_load_lds((const unsigned*)((const char*)(gbase) + (voff)[_i]), (PG8_LAS unsigned*)(lds + (bufoff) + ldsw + _i * 8192), 16, 0, 0); } while (0)
#define PG8_LDA(dst, b, h) do { _Pragma("unroll") for (int m = 0; m < 4; ++m) _Pragma("unroll") for (int k = 0; k < 2; ++k) dst[m][k] = *(const PG8_LAS bf16x8*)(lds + PG8_SA(b, h) + aoff + m * 2048 + k * 1024); } while (0)
#define PG8_LDB(dst, b, h) do { _Pragma("unroll") for (int n = 0; n < 2; ++n) _Pragma("unroll") for (int k = 0; k < 2; ++k) dst[n][k] = *(const PG8_LAS bf16x8*)(lds + PG8_SB(b, h) + boff + n * 2048 + k * 1024); } while (0)
#define PG8_MMA(ai, bj, At, Bt) do { __builtin_amdgcn_s_setprio(1); _Pragma("unroll") for (int m = 0; m < 4; ++m) _Pragma("unroll") for (int n = 0; n < 2; ++n) _Pragma("unroll") for (int k = 0; k < 2; ++k) \
        acc[ai][bj][m][n] = mma16(Bt[n][k], At[m][k], acc[ai][bj][m][n]); __builtin_amdgcn_s_setprio(0); } while (0)
#define PG8_WAIT_V(n) asm volatile("s_waitcnt vmcnt(" #n ")" ::: "memory")
#define PG8_WAIT_L(n) asm volatile("s_waitcnt lgkmcnt(" #n ")" ::: "memory")
#define PG8_BAR __builtin_amdgcn_s_barrier()
#define PG8_SCHED __builtin_amdgcn_sched_barrier(0)
    Unit cur, nxt; int ui = 0;
    if (!S.next(0, cur)) return;
    typename AccT<I8>::type acc[2][2][4][2];
#pragma unroll
    for (int a = 0; a < 2; ++a)
#pragma unroll
        for (int b = 0; b < 2; ++b)
#pragma unroll
            for (int m = 0; m < 4; ++m)
#pragma unroll
                for (int n = 0; n < 2; ++n) acc[a][b][m][n] = AccT<I8>::zero();
    bf16x8 At[4][2], B0[2][2], B1[2][2];
    const char* cA = (const char*)g.A + (size_t)cur.pm * tstep; const char* cB = (const char*)g.Bt + (size_t)cur.pn * tstep;
    S.a_ready(cur);
    if constexpr (SP2) {
        PG8_STAGE(PG8_SB(0, 0), cB, voffB); PG8_STAGE(PG8_SB(0, 1), cB + hstep, voffB); PG8_STAGE(PG8_SA(0, 0), cA, voffA); PG8_STAGE(PG8_SA(0, 1), cA + hstep, voffA);
        if (wr == 1) PG8_BAR;
        PG8_WAIT_V(2); PG8_BAR;
        PG8_STAGE(PG8_SB(1, 0), cB + kstep, voffB); PG8_STAGE(PG8_SA(1, 0), cA + kstep, voffA); PG8_STAGE(PG8_SB(1, 1), cB + hstep + kstep, voffB);
        PG8_WAIT_V(6); PG8_BAR;
    } else {
        PG8_STAGE(PG8_SB(0, 0), cB, voffB); PG8_STAGE(PG8_SA(0, 0), cA, voffA); PG8_STAGE(PG8_SB(0, 1), cB + hstep, voffB); PG8_STAGE(PG8_SA(0, 1), cA + hstep, voffA);
        if (wr == 1) PG8_BAR;
        PG8_WAIT_V(4); PG8_BAR;
        PG8_STAGE(PG8_SB(1, 0), cB + kstep, voffB); PG8_STAGE(PG8_SA(1, 0), cA + kstep, voffA); PG8_STAGE(PG8_SB(1, 1), cB + hstep + kstep, voffB);
        PG8_WAIT_V(6); PG8_BAR;
    }
    for (;;) {
        const bool has_next = S.next(ui + 1, nxt);
        const char* nA = has_next ? (const char*)g.A + (size_t)nxt.pm * tstep : cA; const char* nB = has_next ? (const char*)g.Bt + (size_t)nxt.pn * tstep : cB;
        for (int t = 0; t < nt; t += 2) {
            const bool last = (t == nt - 2);
            const char* a1 = cA + (size_t)(t + 1) * kstep;
            const char* a2 = last ? nA : cA + (size_t)(t + 2) * kstep; const char* b2 = last ? nB : cB + (size_t)(t + 2) * kstep;
            const char* a3 = a2 + kstep; const char* b3 = b2 + kstep;
            if (last && has_next) S.a_ready(nxt);
            if constexpr (SP2) {
            PG8_LDB(B0, 0, 0); PG8_LDB(B1, 0, 1); PG8_SCHED; PG8_LDA(At, 0, 0); PG8_STAGE(PG8_SA(1, 1), a1 + hstep, voffA);
            PG8_WAIT_V(8); PG8_WAIT_L(0); PG8_BAR; PG8_MMA(0, 0, At, B0); PG8_MMA(0, 1, At, B1); PG8_BAR; PG8_SCHED;
            PG8_LDA(At, 0, 1); PG8_STAGE(PG8_SB(0, 0), b2, voffB); PG8_STAGE(PG8_SB(0, 1), b2 + hstep, voffB); PG8_STAGE(PG8_SA(0, 0), a2, voffA);
            PG8_WAIT_V(8); PG8_WAIT_L(0); PG8_BAR; PG8_MMA(1, 0, At, B0); PG8_MMA(1, 1, At, B1); PG8_BAR; PG8_SCHED;
            PG8_LDB(B0, 1, 0); PG8_LDB(B1, 1, 1); PG8_SCHED; PG8_LDA(At, 1, 0); PG8_STAGE(PG8_SA(0, 1), a2 + hstep, voffA);
            PG8_WAIT_V(8); PG8_WAIT_L(0); PG8_BAR; PG8_MMA(0, 0, At, B0); PG8_MMA(0, 1, At, B1); PG8_BAR; PG8_SCHED;
            PG8_LDA(At, 1, 1); PG8_STAGE(PG8_SB(1, 0), b3, voffB); PG8_STAGE(PG8_SB(1, 1), b3 + hstep, voffB); PG8_STAGE(PG8_SA(1, 0), a3, voffA);
            PG8_WAIT_V(8); PG8_WAIT_L(0); PG8_BAR; PG8_MMA(1, 0, At, B0); PG8_MMA(1, 1, At, B1); PG8_BAR; PG8_SCHED;
            } else {
            PG8_LDB(B0, 0, 0); PG8_SCHED; PG8_LDA(At, 0, 0); PG8_STAGE(PG8_SA(1, 1), a1 + hstep, voffA);
            PG8_WAIT_L(8); PG8_BAR; PG8_WAIT_L(0); PG8_MMA(0, 0, At, B0); PG8_BAR; PG8_SCHED;
            PG8_LDB(B1, 0, 1); PG8_STAGE(PG8_SB(0, 0), b2, voffB);
            PG8_BAR; PG8_WAIT_L(0); PG8_MMA(0, 1, At, B1); PG8_BAR;
            PG8_LDA(At, 0, 1); PG8_STAGE(PG8_SA(0, 0), a2, voffA);
            PG8_BAR; PG8_WAIT_L(0); PG8_MMA(1, 0, At, B0); PG8_BAR; PG8_SCHED;
            PG8_STAGE(PG8_SB(0, 1), b2 + hstep, voffB);
            PG8_WAIT_V(6); PG8_BAR; PG8_MMA(1, 1, At, B1); PG8_BAR;
            PG8_LDB(B0, 1, 0); PG8_SCHED; PG8_LDA(At, 1, 0); PG8_STAGE(PG8_SA(0, 1), a2 + hstep, voffA);
            PG8_WAIT_L(8); PG8_BAR; PG8_WAIT_L(0); PG8_MMA(0, 0, At, B0); PG8_BAR; PG8_SCHED;
            PG8_LDB(B1, 1, 1); PG8_STAGE(PG8_SB(1, 0), b3, voffB);
            PG8_BAR; PG8_WAIT_L(0); PG8_MMA(0, 1, At, B1); PG8_BAR;
            PG8_LDA(At, 1, 1); PG8_STAGE(PG8_SA(1, 0), a3, voffA);
            PG8_BAR; PG8_WAIT_L(0); PG8_MMA(1, 0, At, B0); PG8_BAR; PG8_SCHED;
            PG8_STAGE(PG8_SB(1, 1), b3 + hstep, voffB);
            PG8_WAIT_V(6); PG8_BAR; PG8_MMA(1, 1, At, B1); PG8_BAR;
            }
        }
        if constexpr (ALIGN_EPI) { if (wr == 0) PG8_BAR; }
        if constexpr (!Epi::AFTER_DRAIN) { E(acc, cur, wr, wc, fr, fq); S.done(cur); }
        if (!has_next) break;
#pragma unroll
        for (int a = 0; a < 2; ++a)
#pragma unroll
            for (int b = 0; b < 2; ++b)
#pragma unroll
                for (int m = 0; m < 4; ++m)
#pragma unroll
                    for (int n = 0; n < 2; ++n) acc[a][b][m][n] = AccT<I8>::zero();
        cur = nxt; cA = nA; cB = nB; ++ui;
        if constexpr (ALIGN_EPI) { if (wr == 1) PG8_BAR; }
    }
    PG8_WAIT_V(0);
    if constexpr (!ALIGN_EPI) { if (wr == 0) PG8_BAR; }
    PG8_BAR;
    if constexpr (Epi::AFTER_DRAIN) { E.fused(acc, cur, wr, wc, fr, fq, lds, wid, lane); S.done(cur); }
#undef PG8_SA
#undef PG8_SB
#undef PG8_STAGE
#undef PG8_LDA
#undef PG8_LDB
#undef PG8_MMA
#undef PG8_WAIT_V
#undef PG8_WAIT_L
#undef PG8_BAR
#undef PG8_SCHED
}
}

#define GAS __attribute__((address_space(1)))
#define LAS __attribute__((address_space(3)))
#define DI __device__ __forceinline__
typedef unsigned short bf16;
typedef unsigned v4u __attribute__((ext_vector_type(4)));
typedef unsigned v2u __attribute__((ext_vector_type(2)));
typedef float f32x4 __attribute__((ext_vector_type(4)));
typedef float f32x16 __attribute__((ext_vector_type(16)));
typedef short bf16x8 __attribute__((ext_vector_type(8)));
using pg8::pk2;
#define LDS_WAIT() asm volatile("s_waitcnt lgkmcnt(0)" ::: "memory")
#define MFMA32(a, b, c) __builtin_amdgcn_mfma_f32_32x32x16_bf16((a), (b), (c), 0, 0, 0)

constexpr int D = 1024, NB = 32, SEQ = 2048, DSEQ = 16, PAST = 1024, NH = 16, DH = 64;
constexpr int TP = NB * SEQ, TS = NB * DSEQ, T = TP + TS;
constexpr int NEXP = 16384, PH = 8, PK = 16;
constexpr int NLAYER = 4;
constexpr float LN_EPS = 1e-5f;
constexpr float ALPHA = 1.6817928305074292f;
constexpr float LOG2E = 1.4426950408889634f, LN2 = 0.6931471805599453f;
static_assert(T % 256 == 0 && pg8::TOK_P == TP, "row panels");
constexpr size_t O_Y = 0, O_YS = (size_t)TP * D, O_CONVP = O_YS + (size_t)TS * D, O_KP = O_CONVP + 2 * NB * 2 * D, O_VP = O_KP + (size_t)TP * D,
                 O_CONVS = O_VP + (size_t)TP * D, O_KS = O_CONVS + 2 * NB * 2 * D, O_VS = O_KS + (size_t)TS * D, O_END = O_VS + (size_t)TS * D;
static_assert(O_END == 203161600ull, "output size");
constexpr size_t MiB = 1u << 20;
constexpr size_t WS_CTL = 0, CTL_BYTES = 2 * MiB;
constexpr size_t WS_WIN = 2 * MiB;
constexpr size_t WS_WOUT = WS_WIN + 12 * MiB;
constexpr size_t WS_WQ = WS_WOUT + 4 * MiB;
constexpr size_t WS_WO = WS_WQ + 4 * MiB;
constexpr size_t WS_WKV = WS_WO + 4 * MiB;
constexpr size_t WS_WP = WS_WKV + 4 * MiB;
constexpr size_t WS_VSN = WS_WP + 16 * MiB;
constexpr size_t WS_H = WS_VSN + 1 * MiB;
constexpr size_t WS_KB = WS_H + 129 * MiB;
constexpr size_t WS_VT = WS_KB + 129 * MiB;
constexpr size_t WS_IDS = WS_VT + 128 * MiB;
constexpr size_t WS_GATE = WS_IDS + 17 * MiB;
constexpr size_t WS_TU = WS_GATE + 33 * MiB;
constexpr size_t WS_TV = WS_TU + 64 * MiB;
constexpr size_t WS_SU = WS_TV + 64 * MiB;
constexpr size_t WS_W8 = WS_SU + 1 * MiB;
constexpr size_t WS_SX = WS_W8 + 9 * MiB;
constexpr size_t WS_X8 = WS_SX + 1 * MiB;
constexpr size_t WS_W8A = WS_X8 + 65 * MiB;
constexpr size_t WS_SWA = WS_W8A + 22 * MiB;
constexpr int W8_ROWS = (int)((WS_VSN - WS_WIN) / 2048);
static_assert(W8_ROWS == 22528, "weight rows");
constexpr size_t WS_A = WS_SWA + 1 * MiB;
constexpr size_t WS_END = WS_A + 258 * MiB;
static_assert((size_t)T * D * 2 == 129 * MiB && (size_t)1024 * T * 4 == 258 * MiB, "sizes");
constexpr int CW_Q = 1024;
constexpr int CW_BAR = 16384;

constexpr int RING_BYTES = 131072, MISC_OFF = RING_BYTES + 320, LDS_BYTES = 147456;

#define XB_TMO      128
#define XB_XCNT(j)  (256  + 64 * (j))
#define XB_XSUB(j)  (1280 + 64 * (j))
#define XB_XGEN(j)  (2304 + 64 * (j))
#define XB_TOP      3328
#define XB_TOPGEN   3392
#define XCD_BAR_WORDS 3456
#define XB_SPIN_CAP (1u << 18)

__device__ __forceinline__ unsigned xb_ld(unsigned* p)              { return __hip_atomic_load(p, __ATOMIC_RELAXED, __HIP_MEMORY_SCOPE_AGENT); }
__device__ __forceinline__ unsigned xb_add(unsigned* p, unsigned v) { return __hip_atomic_fetch_add(p, v, __ATOMIC_RELAXED, __HIP_MEMORY_SCOPE_AGENT); }
__device__ __forceinline__ unsigned xb_xcc_id() { return (unsigned)__builtin_amdgcn_s_getreg((3 << 11) | 20) & 0xFu; }
#define XB_SPIN(cond, bar) do { unsigned _sp = 0; while (cond) { __builtin_amdgcn_s_sleep(1); \
    if ((++_sp & 255u) == 0u) { if (xb_ld(&(bar)[XB_TMO])) break; if (_sp > XB_SPIN_CAP) { atomicAdd(&(bar)[XB_TMO], 1u); break; } } } } while (0)

__device__ __forceinline__ int xb_lane_id() { int l; asm volatile("v_mbcnt_lo_u32_b32 %0, -1, 0\n\tv_mbcnt_hi_u32_b32 %0, -1, %0" : "=v"(l)); return l; }
__device__ __forceinline__ bool xb_is_thread0(unsigned w0) { return w0 != 0u && xb_lane_id() == 0; }
struct XcdBarrier {
    unsigned w0;
    unsigned* bar; unsigned x;
    volatile LAS unsigned* st;
};

__device__ __forceinline__ XcdBarrier xcd_barrier_post(unsigned* bar, volatile LAS unsigned* st, unsigned w0) {
    XcdBarrier b; b.w0 = w0; b.bar = bar; b.x = xb_xcc_id(); b.st = st;
    if (xb_is_thread0(b.w0)) (void)xb_add(&bar[XB_XCNT(b.x)], 1u);
    return b;
}
__device__ __forceinline__ void xcd_barrier_complete(unsigned* bar, unsigned x, unsigned& nloc, unsigned& nx) {
    const unsigned G = gridDim.x * gridDim.y * gridDim.z;
    unsigned sum, cnt, mine, sp = 0u;
    for (;;) {
        sum = 0u; cnt = 0u; mine = 0u;
#pragma unroll
        for (unsigned j = 0; j < 16; ++j) { const unsigned c = xb_ld(&bar[XB_XCNT(j)]); sum += c; cnt += (c > 0u) ? 1u : 0u; mine = (j == x) ? c : mine; }
        if (sum == G) break;
        __builtin_amdgcn_s_sleep(1);
        if ((++sp & 255u) == 0u) { if (xb_ld(&bar[XB_TMO])) break; if (sp > XB_SPIN_CAP) { atomicAdd(&bar[XB_TMO], 1u); break; } }
    }
    nloc = mine > 0u ? mine : 1u; nx = cnt > 0u ? cnt : 1u;
}

__device__ __forceinline__ void xcd_barrier(const XcdBarrier& b) {
    asm volatile("s_waitcnt vmcnt(0)" ::: "memory");
    __syncthreads();
    if (xb_is_thread0(b.w0)) {
        unsigned* bar = b.bar;
        __builtin_amdgcn_s_waitcnt(0);
        unsigned nloc = b.st[0], nx = b.st[1];
        if (nloc == 0u) { xcd_barrier_complete(bar, b.x, nloc, nx); b.st[0] = nloc; b.st[1] = nx; }
        const unsigned old = xb_add(&bar[XB_XSUB(b.x)], 1u);
        const unsigned gen = old / nloc;
        if (old + 1u == (gen + 1u) * nloc) {
            __builtin_amdgcn_fence(__ATOMIC_RELEASE, "agent");
            asm volatile("s_waitcnt vmcnt(0)" ::: "memory");
            const unsigned og = xb_add(&bar[XB_TOP], 1u);
            const unsigned tg = og / nx;
            if (og + 1u == (tg + 1u) * nx) xb_add(&bar[XB_TOPGEN], 1u);
            else XB_SPIN(xb_ld(&bar[XB_TOPGEN]) == tg, bar);
            __builtin_amdgcn_fence(__ATOMIC_ACQUIRE, "agent");
            xb_add(&bar[XB_XGEN(b.x)], 1u);
            asm volatile("s_waitcnt vmcnt(0)" ::: "memory");
        } else {
            XB_SPIN(xb_ld(&bar[XB_XGEN(b.x)]) == gen, bar);
            __builtin_amdgcn_fence(__ATOMIC_ACQUIRE, "agent");
            asm volatile("s_waitcnt vmcnt(0)" ::: "memory");
        }
    }
    __syncthreads();
}


DI float bflo(unsigned w) { return __uint_as_float(w << 16); }
DI float bfhi(unsigned w) { return __uint_as_float(w & 0xffff0000u); }
DI int shx(const int lane, const int v, const int o) {
    if (o == 1) return __builtin_amdgcn_update_dpp(v, v, 0xB1, 0xf, 0xf, false);
    if (o == 2) return __builtin_amdgcn_update_dpp(v, v, 0x4E, 0xf, 0xf, false);
    if (o == 8) return __builtin_amdgcn_update_dpp(v, v, 0x128, 0xf, 0xf, false);
    if (o == 4) return __builtin_amdgcn_ds_swizzle(v, 0x101F);
    if (o == 16) return __builtin_amdgcn_ds_swizzle(v, 0x401F);
    return __builtin_amdgcn_ds_bpermute((lane ^ o) << 2, v);
}
DI float shx(const int lane, const float v, const int o) { return __int_as_float(shx(lane, __float_as_int(v), o)); }
template <int CTRL> DI float dpp_f(const float v) { return __int_as_float(__builtin_amdgcn_update_dpp(__float_as_int(v), __float_as_int(v), CTRL, 0xf, 0xf, false)); }
DI float wave_sum(const int lane, float v) {
    (void)lane;
    v += dpp_f<0xB1>(v); v += dpp_f<0x4E>(v); v += dpp_f<0x141>(v); v += dpp_f<0x140>(v);
    { const auto r = __builtin_amdgcn_permlane16_swap(__float_as_uint(v), __float_as_uint(v), false, false); v = __uint_as_float(r[0]) + __uint_as_float(r[1]); }
    { const auto r = __builtin_amdgcn_permlane32_swap(__float_as_uint(v), __float_as_uint(v), false, false); v = __uint_as_float(r[0]) + __uint_as_float(r[1]); }
    return v;
}
DI float max32(float v) {
    v = __builtin_fmaxf(v, dpp_f<0xB1>(v)); v = __builtin_fmaxf(v, dpp_f<0x4E>(v)); v = __builtin_fmaxf(v, dpp_f<0x141>(v)); v = __builtin_fmaxf(v, dpp_f<0x140>(v));
    { const auto r = __builtin_amdgcn_permlane16_swap(__float_as_uint(v), __float_as_uint(v), false, false); v = __builtin_fmaxf(__uint_as_float(r[0]), __uint_as_float(r[1])); }
    return v;
}
DI float wave_max(float v) {
    v = max32(v);
    { const auto r = __builtin_amdgcn_permlane32_swap(__float_as_uint(v), __float_as_uint(v), false, false); v = __builtin_fmaxf(__uint_as_float(r[0]), __uint_as_float(r[1])); }
    return v;
}
DI bf16x8 pack8(float a0, float a1, float a2, float a3, float a4, float a5, float a6, float a7) {
    v4u p; p.x = pk2(a0, a1); p.y = pk2(a2, a3); p.z = pk2(a4, a5); p.w = pk2(a6, a7); return __builtin_bit_cast(bf16x8, p);
}
DI float gelu_erf(float v) {
    const float av = __builtin_fabsf(v), d = av * 0.2316418882f + 1.0f, t = __builtin_amdgcn_rcpf(d);
    float q = t * 0.5307027145f + (-0.7265760135f); q = q * t + 0.7107068705f; q = q * t + (-0.142248368f); q = q * t + 0.127414796f; q = q * t;
    const float e = __builtin_amdgcn_exp2f((v * v) * (-0.72134752044f));
    const float m = v * (q * e), r = v - m;
    return v < 0.f ? m : r;
}

struct Ctx {
    int tid, lane, wave, vcu, G;
};

DI void p0_transpose_item(const float* W, int K, int N, bf16* WT, int out_row0, float scale, LAS float* scr, int k0, int n0, int lane) {
#pragma unroll 8
    for (int i = 0; i < 32; ++i) { const int kk = 2 * i + (lane >> 5); scr[kk * 33 + (lane & 31)] = W[(size_t)(k0 + kk) * N + n0 + (lane & 31)]; }
    LDS_WAIT(); asm volatile("" ::: "memory");
    const int c = lane & 7;
#pragma unroll
    for (int j = 0; j < 4; ++j) { const int n = (lane >> 3) + 8 * j; const LAS float* s = scr + (8 * c) * 33 + n;
        v4u o; o.x = pk2(s[0 * 33] * scale, s[1 * 33] * scale); o.y = pk2(s[2 * 33] * scale, s[3 * 33] * scale); o.z = pk2(s[4 * 33] * scale, s[5 * 33] * scale); o.w = pk2(s[6 * 33] * scale, s[7 * 33] * scale);
        *(v4u*)(WT + (size_t)(out_row0 + n) * K + k0 + 8 * c) = o; }
    LDS_WAIT(); asm volatile("" ::: "memory");
}
DI void cvt_stream(const float* src, bf16* dst, size_t n8, size_t gtid, size_t NT) {
    size_t i = gtid;
    for (; i + 3 * NT < n8; i += 4 * NT) {
        f32x4 a[4], b[4];
#pragma unroll
        for (int u = 0; u < 4; ++u) { a[u] = *(const f32x4*)(src + (i + u * NT) * 8); b[u] = *(const f32x4*)(src + (i + u * NT) * 8 + 4); }
#pragma unroll
        for (int u = 0; u < 4; ++u) *(v4u*)(dst + (i + u * NT) * 8) = pg8::pk8(a[u], b[u]);
    }
    for (; i < n8; i += NT) { const f32x4 a = *(const f32x4*)(src + i * 8), b = *(const f32x4*)(src + i * 8 + 4); *(v4u*)(dst + i * 8) = pg8::pk8(a, b); }
}
DI unsigned q4_i8(const f32x4 v, const float k) {
    const int a = (int)__builtin_rintf(v[0] * k), b = (int)__builtin_rintf(v[1] * k), c = (int)__builtin_rintf(v[2] * k), d = (int)__builtin_rintf(v[3] * k);
    return ((unsigned)a & 0xffu) | (((unsigned)b & 0xffu) << 8) | (((unsigned)c & 0xffu) << 16) | ((unsigned)d << 24);
}
DI void cvt_table_rows(const float* src, unsigned char* dst, float* scl  , int nrows, int gw, int NGW, int lane) {
    f32x4 nx[4];
#pragma unroll
    for (int j = 0; j < 4; ++j) nx[j] = *(const f32x4*)(src + (size_t)(gw < nrows ? gw : 0) * D + 4 * lane + 256 * j);
    for (int row = gw; row < nrows; row += NGW) {
        f32x4 v[4]; float m = 0.f; const int rn = row + NGW < nrows ? row + NGW : row;
#pragma unroll
        for (int j = 0; j < 4; ++j) { v[j] = nx[j]; nx[j] = *(const f32x4*)(src + (size_t)rn * D + 4 * lane + 256 * j);
            m = __builtin_fmaxf(m, __builtin_fmaxf(__builtin_fmaxf(__builtin_fabsf(v[j][0]), __builtin_fabsf(v[j][1])), __builtin_fmaxf(__builtin_fabsf(v[j][2]), __builtin_fabsf(v[j][3])))); }
        m = wave_max(m);
        const float k = m > 0.f ? 127.0f / m : 0.f;
#pragma unroll
        for (int j = 0; j < 4; ++j)
            *(unsigned*)(dst + ((size_t)(row >> 14) * NEXP * D) + ((size_t)(2 * j + (lane >> 5)) * NEXP + (row & (NEXP - 1))) * 128 + ((4 * lane) & 127)) = q4_i8(v[j], k);
        if (lane == 0) scl[2 * row] = m * (1.0f / 127.0f);
    }
}
struct P0Args { const float *x_p, *x_s, *w_in, *w_out, *wq, *wo, *wk, *wv, *pwq, *psk, *pu, *pv; bf16 *WinT, *WoutT, *WqT, *WoT, *WkvT, *WP, *H; unsigned char *TU, *TV; float *SU, *SV; unsigned char* X8; float* SX; };
DI void p0_prologue(const Ctx c, LAS unsigned char* lds, const P0Args a) {
    for (int half = 0; half < 2; ++half) {
    if (((c.vcu & 1) == 1) == (half == 0)) {
    { LAS float* scr = (LAS float*)(lds + c.wave * 16384);
      const int gw = c.vcu * 8 + c.wave, NGW = c.G * 8;
      constexpr int IT_WIN = 16 * 96, IT_SQ = 16 * 32, NITEMS = 2 * IT_WIN + 8 * IT_SQ;
      for (int it = gw; it < NITEMS; it += NGW) {
          int r = it;
          if (r < 2 * IT_WIN) { const int l = r / IT_WIN; r -= l * IT_WIN; const int kb = r / 96, nb = r % 96, n0 = 32 * nb; int orow;
              if (n0 < 1024) orow = 2048 + n0; else if (n0 < 2048) { const int d = n0 - 1024; orow = 256 * (d >> 7) + (d & 127); } else { const int d = n0 - 2048; orow = 256 * (d >> 7) + 128 + (d & 127); }
              p0_transpose_item(a.w_in + (size_t)l * 1024 * 3072, 1024, 3072, a.WinT + (size_t)l * 3072 * 1024, orow, 1.f, scr, 64 * kb, n0, c.lane); continue; }
          r -= 2 * IT_WIN; const int m = r / IT_SQ; r -= m * IT_SQ; const int kb = r >> 5, nb = r & 31;
          const float* src; bf16* dst; float sc = 1.f; const size_t SQ = (size_t)1024 * 1024;
          if (m < 2) { src = a.w_out + m * SQ; dst = a.WoutT + m * SQ; }
          else if (m < 4) { src = a.wq + (m - 2) * SQ; dst = a.WqT + (m - 2) * SQ; sc = 0.125f * LOG2E; }
          else if (m < 6) { src = a.wo + (m - 4) * SQ; dst = a.WoT + (m - 4) * SQ; }
          else if (m == 6) { src = a.wk; dst = a.WkvT; }
          else { src = a.wv; dst = a.WkvT + SQ; }
          p0_transpose_item(src, 1024, 1024, dst, 32 * nb, sc, scr, 64 * kb, 32 * nb, c.lane);
      }
    }
    __syncthreads();
    { LAS float* skT = (LAS float*)lds; LAS float* wqT = skT + 128 * 132;
      for (int u = c.vcu; u < 4 * 16 * 16; u += c.G) {
          const int l = u >> 8, hp = (u >> 4) & 15, dblk = u & 15;
          for (int i = c.tid; i < 16384; i += 512) skT[(i & 127) * 132 + (i >> 7)] = a.psk[(size_t)(l * 16 + hp) * 16384 + i];
          for (int i = c.tid; i < 8192; i += 512) wqT[(i & 127) * 68 + (i >> 7)] = a.pwq[((size_t)l * 1024 + dblk * 64 + (i >> 7)) * 2048 + hp * 128 + (i & 127)];
          __syncthreads();
          const int ng = c.tid & 31, dg = c.tid >> 5; f32x4 acc[4];
#pragma unroll
          for (int i = 0; i < 4; ++i) acc[i] = (f32x4){0.f, 0.f, 0.f, 0.f};
#pragma unroll 4
          for (int cc = 0; cc < 128; ++cc) { const f32x4 s = *(const LAS f32x4*)(skT + cc * 132 + 4 * ng), w = *(const LAS f32x4*)(wqT + cc * 68 + 4 * dg);
#pragma unroll
              for (int i = 0; i < 4; ++i) acc[i] = acc[i] + w * s[i]; }
#pragma unroll
          for (int i = 0; i < 4; ++i) { v2u o; o.x = pk2(acc[i][0], acc[i][1]); o.y = pk2(acc[i][2], acc[i][3]);
              *(v2u*)(a.WP + ((size_t)l * 2048 + hp * 128 + 4 * ng + i) * 1024 + dblk * 64 + 4 * dg) = o; }
          __syncthreads();
      }
    }
    } else {
    { const size_t gtid = (size_t)c.vcu * 512 + c.tid, NT = (size_t)c.G * 512;
      cvt_table_rows(a.pu, a.TU, a.SU, NLAYER * NEXP, c.vcu * 8 + c.wave, c.G * 8, c.lane);
      cvt_table_rows(a.pv, a.TV, a.SV, NLAYER * NEXP, c.vcu * 8 + c.wave, c.G * 8, c.lane);
      (void)gtid; (void)NT;
      for (int m = c.vcu * 8 + c.wave; m < T; m += c.G * 8) {
          const float* xr = (m < TP ? a.x_p + (size_t)m * D : a.x_s + (size_t)(m - TP) * D) + 4 * c.lane;
          f32x4 v[4]; float am = 0.f;
#pragma unroll
          for (int j = 0; j < 4; ++j) { v[j] = *(const f32x4*)(xr + 256 * j); v2u w; w.x = pk2(v[j][0], v[j][1]); w.y = pk2(v[j][2], v[j][3]); ((v2u*)(a.H + (size_t)m * D) + c.lane)[64 * j] = w;
              am = __builtin_fmaxf(am, __builtin_fmaxf(__builtin_fmaxf(__builtin_fabsf(v[j][0]), __builtin_fabsf(v[j][1])), __builtin_fmaxf(__builtin_fabsf(v[j][2]), __builtin_fabsf(v[j][3])))); }
          am = wave_max(am);
          const float k = am > 0.f ? 127.0f / am : 0.f;
#pragma unroll
          for (int j = 0; j < 4; ++j) *(unsigned*)(a.X8 + (size_t)m * D + 4 * c.lane + 256 * j) = q4_i8(v[j], k);
          if (c.lane == 0) a.SX[m] = am * (1.0f / 127.0f);
      }
    }
    }
    __syncthreads();
    }
}

DI void wp_quant_phase(const Ctx c, const bf16* WPb, unsigned char* WP8q, float* swp) {
    for (int row = c.vcu * 8 + c.wave; row < W8_ROWS; row += c.G * 8) {
        const v4u a = *(const v4u*)(WPb + (size_t)row * D + 16 * c.lane), b = *(const v4u*)(WPb + (size_t)row * D + 16 * c.lane + 8);
        const f32x4 v0 = {bflo(a.x), bfhi(a.x), bflo(a.y), bfhi(a.y)}, v1 = {bflo(a.z), bfhi(a.z), bflo(a.w), bfhi(a.w)}, v2 = {bflo(b.x), bfhi(b.x), bflo(b.y), bfhi(b.y)}, v3 = {bflo(b.z), bfhi(b.z), bflo(b.w), bfhi(b.w)};
        float m = 0.f;
#pragma unroll
        for (int i = 0; i < 4; ++i) m = __builtin_fmaxf(m, __builtin_fmaxf(__builtin_fmaxf(__builtin_fabsf(v0[i]), __builtin_fabsf(v1[i])), __builtin_fmaxf(__builtin_fabsf(v2[i]), __builtin_fabsf(v3[i]))));
        m = wave_max(m);
        const float k = m > 0.f ? 127.0f / m : 0.f;
        v4u o; o.x = q4_i8(v0, k); o.y = q4_i8(v1, k); o.z = q4_i8(v2, k); o.w = q4_i8(v3, k);
        *(v4u*)(WP8q + (size_t)row * D + 16 * c.lane) = o;
        if (c.lane == 0) swp[row] = m * (1.0f / 127.0f);
    }
}

DI void ld8_bf16(const bf16* p, float (&o)[8]) { const v4u w = *(const v4u*)p; o[0] = bflo(w.x); o[1] = bfhi(w.x); o[2] = bflo(w.y); o[3] = bfhi(w.y); o[4] = bflo(w.z); o[5] = bfhi(w.z); o[6] = bflo(w.w); o[7] = bfhi(w.w); }
DI void ld8_f32(const float* p, float (&o)[8]) { const f32x4 a = *(const f32x4*)p, b = *(const f32x4*)(p + 4); o[0] = a[0]; o[1] = a[1]; o[2] = a[2]; o[3] = a[3]; o[4] = b[0]; o[5] = b[1]; o[6] = b[2]; o[7] = b[3]; }
DI void conv_gate_phase(const Ctx c, const bf16* U, bf16* Bg, const float* wdw  , const float* st  , float* convp, float* convs  ,
                        unsigned char* z8, float* sz  , const bool skip_samp = false  ) {
    const int gw = c.vcu * 8 + c.wave, NGW = c.G * 8, dc = 16 * c.lane;
    float w0[16], w1[16], w2[16];
    { float t8[8]; ld8_f32(wdw + dc, t8);
#pragma unroll
      for (int i = 0; i < 8; ++i) w0[i] = t8[i]; ld8_f32(wdw + dc + 8, t8);
#pragma unroll
      for (int i = 0; i < 8; ++i) w0[8 + i] = t8[i]; ld8_f32(wdw + D + dc, t8);
#pragma unroll
      for (int i = 0; i < 8; ++i) w1[i] = t8[i]; ld8_f32(wdw + D + dc + 8, t8);
#pragma unroll
      for (int i = 0; i < 8; ++i) w1[8 + i] = t8[i]; ld8_f32(wdw + 2 * D + dc, t8);
#pragma unroll
      for (int i = 0; i < 8; ++i) w2[i] = t8[i]; ld8_f32(wdw + 2 * D + dc + 8, t8);
#pragma unroll
      for (int i = 0; i < 8; ++i) w2[8 + i] = t8[i]; }
    { v4u ng[2], n2[2], n1[2], n0[2];
#define CG_LOAD(tt_) do { const int t_ = (tt_), s_ = t_ & 2047, t1_ = s_ >= 1 ? t_ - 1 : t_, t0_ = s_ >= 2 ? t_ - 2 : t_; \
        _Pragma("unroll") for (int hf = 0; hf < 2; ++hf) { ng[hf] = *(const v4u*)(Bg + (size_t)t_ * D + dc + 8 * hf); n2[hf] = *(const v4u*)(U + (size_t)t_ * D + dc + 8 * hf); \
            n1[hf] = *(const v4u*)(U + (size_t)t1_ * D + dc + 8 * hf); n0[hf] = *(const v4u*)(U + (size_t)t0_ * D + dc + 8 * hf); } } while (0)
      if (gw < TP) CG_LOAD(gw);
      for (int t = gw; t < TP; t += NGW) {
          const int s = t & 2047; const float f1 = s >= 1 ? 1.f : 0.f, f0 = s >= 2 ? 1.f : 0.f;
          v4u cg[2], c2[2], c1[2], c0[2];
#pragma unroll
          for (int hf = 0; hf < 2; ++hf) { cg[hf] = ng[hf]; c2[hf] = n2[hf]; c1[hf] = n1[hf]; c0[hf] = n0[hf]; }
          CG_LOAD(t + NGW < TP ? t + NGW : t);
          float z[16]; float am = 0.f;
#pragma unroll
          for (int hf = 0; hf < 2; ++hf) { const unsigned wg[4] = {cg[hf].x, cg[hf].y, cg[hf].z, cg[hf].w}, w2_[4] = {c2[hf].x, c2[hf].y, c2[hf].z, c2[hf].w}, w1_[4] = {c1[hf].x, c1[hf].y, c1[hf].z, c1[hf].w}, w0_[4] = {c0[hf].x, c0[hf].y, c0[hf].z, c0[hf].w};
#pragma unroll
              for (int i = 0; i < 8; ++i) { const bool hi = i & 1; const int k = i >> 1;
                  const float g = hi ? bfhi(wg[k]) : bflo(wg[k]), u2 = hi ? bfhi(w2_[k]) : bflo(w2_[k]), u1 = (hi ? bfhi(w1_[k]) : bflo(w1_[k])) * f1, u0 = (hi ? bfhi(w0_[k]) : bflo(w0_[k])) * f0;
                  const float zz = g * (w0[8 * hf + i] * u0 + w1[8 * hf + i] * u1 + w2[8 * hf + i] * u2); z[8 * hf + i] = zz; am = __builtin_fmaxf(am, __builtin_fabsf(zz)); } }
          am = wave_max(am);
          const float k = am > 0.f ? 127.0f / am : 0.f;
          v4u q; q.x = q4_i8((f32x4){z[0], z[1], z[2], z[3]}, k); q.y = q4_i8((f32x4){z[4], z[5], z[6], z[7]}, k); q.z = q4_i8((f32x4){z[8], z[9], z[10], z[11]}, k); q.w = q4_i8((f32x4){z[12], z[13], z[14], z[15]}, k);
          *(v4u*)(z8 + (size_t)t * D + dc) = q;
          if (c.lane == 0) sz[t] = am * (1.0f / 127.0f);
      }
#undef CG_LOAD
    }
    for (int t = TP + gw; t < (skip_samp ? TP : T); t += NGW) {
        const bool samp = true; const int s = (t - TP) & 15; const int b = (t - TP) >> 4;
        float z[16]; float am = 0.f;
#pragma unroll
        for (int hf = 0; hf < 2; ++hf) { const int d0 = dc + 8 * hf;
            float u0[8], u1[8], u2[8], g[8];
            ld8_bf16(U + (size_t)t * D + d0, u2);
            { float* cdst = nullptr;
              (void)convp;
              if (samp && s >= DSEQ - 2) cdst = convs + ((size_t)b * 2 + (s - (DSEQ - 2))) * D + d0;
              if (cdst) { *(f32x4*)cdst = (f32x4){u2[0], u2[1], u2[2], u2[3]}; *(f32x4*)(cdst + 4) = (f32x4){u2[4], u2[5], u2[6], u2[7]}; } }
            if (s >= 1) ld8_bf16(U + (size_t)(t - 1) * D + d0, u1);
            else if (samp) ld8_f32(st + ((size_t)b * 2 + 1) * D + d0, u1);
            else {
#pragma unroll
                for (int i = 0; i < 8; ++i) u1[i] = 0.f; }
            if (s >= 2) ld8_bf16(U + (size_t)(t - 2) * D + d0, u0);
            else if (samp) ld8_f32(st + ((size_t)b * 2 + (s == 1 ? 1 : 0)) * D + d0, u0);
            else {
#pragma unroll
                for (int i = 0; i < 8; ++i) u0[i] = 0.f; }
            ld8_bf16(Bg + (size_t)t * D + d0, g);
#pragma unroll
            for (int i = 0; i < 8; ++i) { const float zz = g[i] * (w0[8 * hf + i] * u0[i] + w1[8 * hf + i] * u1[i] + w2[8 * hf + i] * u2[i]); z[8 * hf + i] = zz; am = __builtin_fmaxf(am, __builtin_fabsf(zz)); }
        }
        if (samp) {
            v4u o0, o1; o0.x = pk2(z[0], z[1]); o0.y = pk2(z[2], z[3]); o0.z = pk2(z[4], z[5]); o0.w = pk2(z[6], z[7]); o1.x = pk2(z[8], z[9]); o1.y = pk2(z[10], z[11]); o1.z = pk2(z[12], z[13]); o1.w = pk2(z[14], z[15]);
            *(v4u*)(Bg + (size_t)t * D + dc) = o0; *(v4u*)(Bg + (size_t)t * D + dc + 8) = o1; }
        am = wave_max(am);
        const float k = am > 0.f ? 127.0f / am : 0.f;
        v4u q; q.x = q4_i8((f32x4){z[0], z[1], z[2], z[3]}, k); q.y = q4_i8((f32x4){z[4], z[5], z[6], z[7]}, k); q.z = q4_i8((f32x4){z[8], z[9], z[10], z[11]}, k); q.w = q4_i8((f32x4){z[12], z[13], z[14], z[15]}, k);
        *(v4u*)(z8 + (size_t)t * D + dc) = q;
        if (c.lane == 0) sz[t] = am * (1.0f / 127.0f);
    }
}

DI void ln_phase(const Ctx c, const bf16* R, bf16* H, const float* g, const float* bb, float* yout = nullptr, const bf16* Hres = nullptr, unsigned char* x8 = nullptr, float* sx = nullptr) {
    const int gw = c.vcu * 8 + c.wave, NGW = c.G * 8;
    float gv[2][8], bv[2][8];
#pragma unroll
    for (int j = 0; j < 2; ++j) { ld8_f32(g + 8 * c.lane + 512 * j, gv[j]); ld8_f32(bb + 8 * c.lane + 512 * j, bv[j]); }
    v4u rw[2], hw[2];
#pragma unroll
    for (int j = 0; j < 2; ++j) { const int m0 = gw < T ? gw : 0; rw[j] = *(const v4u*)(R + (size_t)m0 * D + 8 * c.lane + 512 * j); hw[j] = Hres ? *(const v4u*)(Hres + (size_t)m0 * D + 8 * c.lane + 512 * j) : (v4u){0u, 0u, 0u, 0u}; }
    for (int m = gw; m < T; m += NGW) {
        float v[2][8]; float s = 0.f;
#pragma unroll
        for (int j = 0; j < 2; ++j) { const unsigned w[4] = {rw[j].x, rw[j].y, rw[j].z, rw[j].w}, hq[4] = {hw[j].x, hw[j].y, hw[j].z, hw[j].w};
#pragma unroll
            for (int i = 0; i < 4; ++i) { v[j][2 * i] = bflo(w[i]); v[j][2 * i + 1] = bfhi(w[i]); if (Hres) { v[j][2 * i] += bflo(hq[i]) * ALPHA; v[j][2 * i + 1] += bfhi(hq[i]) * ALPHA; } }
#pragma unroll
            for (int i = 0; i < 8; ++i) s += v[j][i]; }
        { const int mn = m + NGW < T ? m + NGW : m;
#pragma unroll
          for (int j = 0; j < 2; ++j) { rw[j] = *(const v4u*)(R + (size_t)mn * D + 8 * c.lane + 512 * j); if (Hres) hw[j] = *(const v4u*)(Hres + (size_t)mn * D + 8 * c.lane + 512 * j); } }
        const float mean = wave_sum(c.lane, s) * (1.f / D); float s2 = 0.f;
#pragma unroll
        for (int j = 0; j < 2; ++j)
#pragma unroll
            for (int i = 0; i < 8; ++i) { v[j][i] -= mean; s2 += v[j][i] * v[j][i]; }
        const float rstd = __builtin_amdgcn_rsqf(wave_sum(c.lane, s2) * (1.f / D) + LN_EPS);
        float am = 0.f;
#pragma unroll
        for (int j = 0; j < 2; ++j)
#pragma unroll
            for (int i = 0; i < 8; ++i) { v[j][i] = v[j][i] * rstd * gv[j][i] + bv[j][i]; am = __builtin_fmaxf(am, __builtin_fabsf(v[j][i])); }
        if (yout) {
#pragma unroll
            for (int j = 0; j < 2; ++j) { float* o = yout + (size_t)m * D + 8 * c.lane + 512 * j; *(f32x4*)o = (f32x4){v[j][0], v[j][1], v[j][2], v[j][3]}; *(f32x4*)(o + 4) = (f32x4){v[j][4], v[j][5], v[j][6], v[j][7]}; }
        } else {
#pragma unroll
            for (int j = 0; j < 2; ++j) { v4u w; w.x = pk2(v[j][0], v[j][1]); w.y = pk2(v[j][2], v[j][3]); w.z = pk2(v[j][4], v[j][5]); w.w = pk2(v[j][6], v[j][7]); *(v4u*)(H + (size_t)m * D + 8 * c.lane + 512 * j) = w; }
            if (x8) {
                am = wave_max(am);
                const float k = am > 0.f ? 127.0f / am : 0.f;
#pragma unroll
                for (int j = 0; j < 2; ++j) { v2u q; q.x = q4_i8((f32x4){v[j][0], v[j][1], v[j][2], v[j][3]}, k); q.y = q4_i8((f32x4){v[j][4], v[j][5], v[j][6], v[j][7]}, k); *(v2u*)(x8 + (size_t)m * D + 8 * c.lane + 512 * j) = q; }
                if (c.lane == 0) sx[m] = am * (1.0f / 127.0f);
            } }
    }
}

DI int ordi(float x) { const int b = __float_as_int(x); return b ^ ((b >> 31) & 0x7fffffff); }
DI float unordi(int o) { return __int_as_float(o ^ ((o >> 31) & 0x7fffffff)); }
#define TK_CE(a, b) do { const int _hi = (a) > (b) ? (a) : (b), _lo = (a) > (b) ? (b) : (a); (a) = _hi; (b) = _lo; } while (0)
#define TK_CPK(i, j) ((ordi(va[i] + vb[j]) & ~255) | (255 - ((i) * 16 + (j))))
#define TK_SORT16(v) do { TK_CE(v[0], v[13]); TK_CE(v[1], v[12]); TK_CE(v[2], v[15]); TK_CE(v[3], v[14]); TK_CE(v[4], v[8]); TK_CE(v[5], v[6]); TK_CE(v[7], v[11]); TK_CE(v[9], v[10]); TK_CE(v[0], v[5]); TK_CE(v[1], v[7]); TK_CE(v[2], v[9]); TK_CE(v[3], v[4]); TK_CE(v[6], v[13]); TK_CE(v[8], v[14]); TK_CE(v[10], v[15]); TK_CE(v[11], v[12]); TK_CE(v[0], v[1]); TK_CE(v[2], v[3]); TK_CE(v[4], v[5]); TK_CE(v[6], v[8]); TK_CE(v[7], v[9]); TK_CE(v[10], v[11]); TK_CE(v[12], v[13]); TK_CE(v[14], v[15]); TK_CE(v[0], v[2]); TK_CE(v[1], v[3]); TK_CE(v[4], v[10]); TK_CE(v[5], v[11]); TK_CE(v[6], v[7]); TK_CE(v[8], v[9]); TK_CE(v[12], v[14]); TK_CE(v[13], v[15]); TK_CE(v[1], v[2]); TK_CE(v[3], v[12]); TK_CE(v[4], v[6]); TK_CE(v[5], v[7]); TK_CE(v[8], v[10]); TK_CE(v[9], v[11]); TK_CE(v[13], v[14]); TK_CE(v[1], v[4]); TK_CE(v[2], v[6]); TK_CE(v[5], v[8]); TK_CE(v[7], v[10]); TK_CE(v[9], v[13]); TK_CE(v[11], v[14]); TK_CE(v[2], v[4]); TK_CE(v[3], v[6]); TK_CE(v[9], v[12]); TK_CE(v[11], v[13]); TK_CE(v[3], v[5]); TK_CE(v[6], v[8]); TK_CE(v[7], v[9]); TK_CE(v[10], v[12]); TK_CE(v[3], v[4]); TK_CE(v[5], v[6]); TK_CE(v[7], v[8]); TK_CE(v[9], v[10]); TK_CE(v[11], v[12]); TK_CE(v[6], v[7]); TK_CE(v[8], v[9]); } while (0)
#define TK_BMERGE16(v) do { TK_CE(v[0], v[8]); TK_CE(v[1], v[9]); TK_CE(v[2], v[10]); TK_CE(v[3], v[11]); TK_CE(v[4], v[12]); TK_CE(v[5], v[13]); TK_CE(v[6], v[14]); TK_CE(v[7], v[15]); TK_CE(v[0], v[4]); TK_CE(v[1], v[5]); TK_CE(v[2], v[6]); TK_CE(v[3], v[7]); TK_CE(v[8], v[12]); TK_CE(v[9], v[13]); TK_CE(v[10], v[14]); TK_CE(v[11], v[15]); TK_CE(v[0], v[2]); TK_CE(v[1], v[3]); TK_CE(v[4], v[6]); TK_CE(v[5], v[7]); TK_CE(v[8], v[10]); TK_CE(v[9], v[11]); TK_CE(v[12], v[14]); TK_CE(v[13], v[15]); TK_CE(v[0], v[1]); TK_CE(v[2], v[3]); TK_CE(v[4], v[5]); TK_CE(v[6], v[7]); TK_CE(v[8], v[9]); TK_CE(v[10], v[11]); TK_CE(v[12], v[13]); TK_CE(v[14], v[15]); } while (0)
#define TK_CAND0(B) do { B[0] = TK_CPK(0, 0); B[1] = TK_CPK(0, 1); B[2] = TK_CPK(0, 2); B[3] = TK_CPK(0, 3); B[4] = TK_CPK(0, 4); B[5] = TK_CPK(0, 5); B[6] = TK_CPK(0, 6); B[7] = TK_CPK(0, 7); B[8] = TK_CPK(0, 8); B[9] = TK_CPK(0, 9); B[10] = TK_CPK(0, 10); B[11] = TK_CPK(0, 11); B[12] = TK_CPK(0, 12); B[13] = TK_CPK(0, 13); B[14] = TK_CPK(0, 14); B[15] = TK_CPK(0, 15); } while (0)
#define TK_CAND1(B) do { B[0] = TK_CPK(1, 0); B[1] = TK_CPK(1, 1); B[2] = TK_CPK(1, 2); B[3] = TK_CPK(1, 3); B[4] = TK_CPK(1, 4); B[5] = TK_CPK(1, 5); B[6] = TK_CPK(1, 6); B[7] = TK_CPK(1, 7); B[8] = TK_CPK(2, 0); B[9] = TK_CPK(2, 1); B[10] = TK_CPK(2, 2); B[11] = TK_CPK(2, 3); B[12] = TK_CPK(2, 4); B[13] = TK_CPK(3, 0); B[14] = TK_CPK(3, 1); B[15] = TK_CPK(3, 2); } while (0)
#define TK_CAND2(B) do { B[0] = TK_CPK(3, 3); B[1] = TK_CPK(4, 0); B[2] = TK_CPK(4, 1); B[3] = TK_CPK(4, 2); B[4] = TK_CPK(5, 0); B[5] = TK_CPK(5, 1); B[6] = TK_CPK(6, 0); B[7] = TK_CPK(6, 1); B[8] = TK_CPK(7, 0); B[9] = TK_CPK(7, 1); B[10] = TK_CPK(8, 0); B[11] = TK_CPK(9, 0); B[12] = TK_CPK(10, 0); B[13] = TK_CPK(11, 0); B[14] = TK_CPK(12, 0); B[15] = TK_CPK(13, 0); } while (0)
#define TK_CAND3(B) do { B[0] = TK_CPK(14, 0); B[1] = TK_CPK(15, 0); B[2] = (int)0x80000000; B[3] = (int)0x80000000; B[4] = (int)0x80000000; B[5] = (int)0x80000000; B[6] = (int)0x80000000; B[7] = (int)0x80000000; B[8] = (int)0x80000000; B[9] = (int)0x80000000; B[10] = (int)0x80000000; B[11] = (int)0x80000000; B[12] = (int)0x80000000; B[13] = (int)0x80000000; B[14] = (int)0x80000000; B[15] = (int)0x80000000; } while (0)
DI void tk_merge(int (&L)[16], const int (&B)[16]) {
#pragma unroll
    for (int i = 0; i < 16; ++i) L[i] = L[i] > B[15 - i] ? L[i] : B[15 - i];
    TK_BMERGE16(L);
}
DI void tk_feed32(int (&L)[16], const v4u (&x)[4], const int rb, const bool first) {
#pragma unroll
    for (int hf = 0; hf < 2; ++hf) { int B[16]; const unsigned w[8] = {x[2 * hf].x, x[2 * hf].y, x[2 * hf].z, x[2 * hf].w, x[2 * hf + 1].x, x[2 * hf + 1].y, x[2 * hf + 1].z, x[2 * hf + 1].w};
#pragma unroll
        for (int j = 0; j < 16; ++j) {
            const unsigned ww = w[j >> 1], code = (unsigned)(127 - ((rb + 16 * hf + j) & 127));
            if (j & 1) { const int m = (int)ww >> 31; const unsigned t = ww ^ ((unsigned)m & 0x7fff0000u); B[j] = (int)((t & 0xffff0000u) | code); }
            else { const int m = (int)(ww << 16) >> 31; const unsigned t = ww ^ ((unsigned)m & 0x7fffu); B[j] = (int)((t << 16) | code); } }
        TK_SORT16(B);
        if (hf == 0 && first) {
#pragma unroll
            for (int i = 0; i < 16; ++i) L[i] = B[i];
        } else tk_merge(L, B); }
}
DI float unord16(const int key) { const int h = key & (int)0xffff0000; return __int_as_float(h ^ ((h >> 31) & 0x7fff0000)); }
DI unsigned byte_of(unsigned a0, unsigned a1, unsigned a2, unsigned a3, int i) { const unsigned lo = i < 4 ? a0 : a1, hi = i < 12 ? a2 : a3, w = i < 8 ? lo : hi; return (w >> ((i & 3) * 8)) & 0xffu; }
constexpr int TK_NUP = 8 * (TP / 64), TK_NPU = 8 * (TS / 32);
DI const v4u* tk_row(const int wi, const int lane, const bf16* Sc, int& h, int& t) {
    if (wi < TK_NUP) { h = wi / (TP / 64); t = (wi % (TP / 64)) * 64 + lane; return (const v4u*)(Sc + (size_t)t * 2048 + h * 256); }
    const int pu = wi - TK_NUP; h = pu / (TS / 32); t = TP + (pu % (TS / 32)) * 32 + (lane >> 1);
    return (const v4u*)(Sc + (size_t)t * 2048 + h * 256 + (lane & 1) * 128);
}
DI void topk_phase(const Ctx c, const bf16* Sc  , unsigned short* ids, float* gates) {
    const int gw = c.wave * c.G + c.vcu, NGW = c.G * 8, NU = TK_NUP + TK_NPU;
    v4u bufA[4], bufB[4];
    if (gw < NU) { int h_, t_; const v4u* sc = tk_row(gw, c.lane, Sc, h_, t_);
#pragma unroll
        for (int j = 0; j < 4; ++j) bufA[j] = sc[j]; }
#pragma unroll 1
    for (int wu = gw; wu < NU; wu += NGW) {
        int h, t; const v4u* sc = tk_row(wu, c.lane, Sc, h, t);
        const bool pair = wu >= TK_NUP; const int nit = pair ? 2 : 4;
        const int wn = wu + NGW < NU ? wu + NGW : wu;
        int hn_, tn_; const v4u* scn = tk_row(wn, c.lane, Sc, hn_, tn_);
        int Lw[16], La[16];
#pragma unroll
        for (int i = 0; i < 16; ++i) { Lw[i] = (int)0x80000000; La[i] = 0; }
#pragma unroll 1
        for (int it = 0; it < nit; ++it) {
#pragma unroll
            for (int j = 0; j < 4; ++j) bufB[j] = sc[8 * it + 4 + j];
            tk_feed32(Lw, bufA, 64 * it, (it & 1) == 0);
            { const v4u* nx = it + 1 < nit ? sc + 8 * (it + 1) : scn;
#pragma unroll
              for (int j = 0; j < 4; ++j) bufA[j] = nx[j]; }
            tk_feed32(Lw, bufB, 64 * it + 32, false);
            if (it == 1) {
#pragma unroll
                for (int i = 0; i < 16; ++i) La[i] = Lw[i]; }
        }
        if (pair) {
            const bool od = c.lane & 1;
#pragma unroll
            for (int i = 0; i < 16; ++i) { const int o = __builtin_amdgcn_update_dpp(Lw[i], Lw[i], 0xB1, 0xf, 0xf, false); La[i] = od ? o : Lw[i]; Lw[i] = od ? Lw[i] : o; }
        }
        float va[16], vb[16]; unsigned IA0 = 0u, IA1 = 0u, IA2 = 0u, IA3 = 0u, IB0 = 0u, IB1 = 0u, IB2 = 0u, IB3 = 0u;
#pragma unroll
        for (int i = 0; i < 16; ++i) { va[i] = unord16(La[i]); vb[i] = unord16(Lw[i]);
            const unsigned ea = (unsigned)(127 - (La[i] & 127)) << ((i & 3) * 8), eb = (unsigned)(127 - (Lw[i] & 127)) << ((i & 3) * 8);
            if ((i >> 2) == 0) { IA0 |= ea; IB0 |= eb; } else if ((i >> 2) == 1) { IA1 |= ea; IB1 |= eb; } else if ((i >> 2) == 2) { IA2 |= ea; IB2 |= eb; } else { IA3 |= ea; IB3 |= eb; } }
        int F[16];
        { int B[16]; TK_CAND0(B); TK_SORT16(B);
#pragma unroll
          for (int i = 0; i < 16; ++i) F[i] = B[i]; }
        { int B[16]; TK_CAND1(B); TK_SORT16(B); tk_merge(F, B); }
        { int B[16]; TK_CAND2(B); TK_SORT16(B); tk_merge(F, B); }
        { int x = TK_CPK(14, 0), y = TK_CPK(15, 0); TK_CE(x, y);
          F[15] = F[15] > x ? F[15] : x; F[14] = F[14] > y ? F[14] : y; TK_BMERGE16(F); }
        float sc_[16], den = 0.f; unsigned ex[16];
        const float mx = unordi(F[0] & ~255);
#pragma unroll
        for (int k = 0; k < 16; ++k) { const int code = 255 - (F[k] & 255); sc_[k] = __builtin_amdgcn_exp2f((unordi(F[k] & ~255) - mx) * LOG2E); den += sc_[k];
            ex[k] = byte_of(IA0, IA1, IA2, IA3, code >> 4) * 128u + byte_of(IB0, IB1, IB2, IB3, code & 15); }
        const float inv = 1.0f / den;
        v4u e0, e1; e0.x = ex[0] | (ex[1] << 16); e0.y = ex[2] | (ex[3] << 16); e0.z = ex[4] | (ex[5] << 16); e0.w = ex[6] | (ex[7] << 16);
        e1.x = ex[8] | (ex[9] << 16); e1.y = ex[10] | (ex[11] << 16); e1.z = ex[12] | (ex[13] << 16); e1.w = ex[14] | (ex[15] << 16);
        v4u* ip = (v4u*)(ids + (size_t)t * 128 + h * 16); ip[0] = e0; ip[1] = e1;
        f32x4* gp = (f32x4*)(gates + (size_t)t * 128 + h * 16);
#pragma unroll
        for (int k = 0; k < 4; ++k) gp[k] = (f32x4){sc_[4 * k] * inv, sc_[4 * k + 1] * inv, sc_[4 * k + 2] * inv, sc_[4 * k + 3] * inv};
    }
}

typedef float f2 __attribute__((ext_vector_type(2)));
constexpr int QCH = 16, QN = T / QCH;
static_assert(T % QCH == 0, "queue chunks");
struct ChunkQ { int xme, s; unsigned pend; unsigned* q; };
struct Chunk { int base, xs; };
DI unsigned cq_ticket(unsigned* qw, int lane) { unsigned v = 0u; if (lane == 0) v = __hip_atomic_fetch_add(qw, 1u, __ATOMIC_RELAXED, __HIP_MEMORY_SCOPE_AGENT); return v; }
DI void cq_init(ChunkQ& g, unsigned* q, int lane) { g.xme = (int)(xb_xcc_id() & 7u); g.s = 0; g.q = q; g.pend = cq_ticket(q + g.xme * 64, lane); }
DI Chunk cq_next(ChunkQ& g, int lane) {
    for (;;) {
        if (g.s >= 8) return Chunk{-1, 0};
        const unsigned chunk = (unsigned)__builtin_amdgcn_readfirstlane((int)g.pend); const int xs = (g.xme + g.s) & 7;
        if (chunk < (unsigned)QN) { g.pend = cq_ticket(g.q + xs * 64, lane); return Chunk{(int)chunk * QCH, xs}; }
        ++g.s; if (g.s < 8) g.pend = cq_ticket(g.q + ((g.xme + g.s) & 7) * 64, lane);
    }
}
struct SliceIds { v4u ia, ib; int t, xs; };
struct SliceAux { v4u a0; float s; };
DI SliceIds slice_load_ids(const int t, const int xs, const int lane, const unsigned short* ids) {
    const int j = lane >> 3, tc = t < 0 ? 0 : t; SliceIds r; r.t = t; r.xs = xs;
    r.ia = *(const v4u*)(ids + (size_t)tc * 128 + 16 * j); r.ib = *(const v4u*)(ids + (size_t)tc * 128 + 16 * j + 8); return r;
}
template <int MODE>
DI SliceAux slice_load_aux(const int t, const int xs, const int lane, const unsigned char* x8, const unsigned char* w8, const float* sw) {
    const int j = lane >> 3, i = lane & 7, tc = t < 0 ? 0 : t; SliceAux r;
    if (MODE == 0) { r.a0 = *(const v4u*)(x8 + (size_t)tc * D + 128 * xs + 16 * i); r.s = 0.f; }
    else { r.a0 = *(const v4u*)(w8 + (size_t)tc * 128 + 16 * j); r.s = sw[tc]; }
    return r;
}
template <int VAR>
DI void slice_issue(v4u (&vr)[16], const SliceIds& n, const unsigned char* T8, const int lane) {
    const unsigned char* sbase = T8 + (size_t)n.xs * NEXP * 128;
    const unsigned lo = 16u * (unsigned)(lane & 7);
    const unsigned idv[8] = {n.ia.x, n.ia.y, n.ia.z, n.ia.w, n.ib.x, n.ib.y, n.ib.z, n.ib.w};
#pragma unroll
    for (int g = 0; g < 16; ++g) {
        unsigned off;
        if (VAR == 2) off = (((g & 1) ? (idv[g >> 1] >> 16) : (idv[g >> 1] & 0xffffu)) & 15u) * 128u + lo;
        else if (g & 1) asm("v_mad_u32_u16 %0, %1, %2, %3 op_sel:[1,0,0,0]" : "=v"(off) : "v"(idv[g >> 1]), "s"(128u), "v"(lo));
        else asm("v_mad_u32_u16 %0, %1, %2, %3" : "=v"(off) : "v"(idv[g >> 1]), "s"(128u), "v"(lo));
        vr[g] = *(const v4u*)(sbase + off); }
}
DI int dot16_i8(const v4u a, const v4u b, int acc) {
    acc = __builtin_amdgcn_sdot4((int)a.x, (int)b.x, acc, false); acc = __builtin_amdgcn_sdot4((int)a.y, (int)b.y, acc, false);
    acc = __builtin_amdgcn_sdot4((int)a.z, (int)b.z, acc, false); acc = __builtin_amdgcn_sdot4((int)a.w, (int)b.w, acc, false); return acc;
}
DI void tr4_dot0(int& c0, int& c1, int& c2, int& c3, const unsigned a, const unsigned b, const unsigned cc, const unsigned d, const int w) {
    const unsigned p = __builtin_amdgcn_perm(b, a, 0x05010400u), q = __builtin_amdgcn_perm(b, a, 0x07030602u), r = __builtin_amdgcn_perm(d, cc, 0x05010400u), s = __builtin_amdgcn_perm(d, cc, 0x07030602u);
    asm("v_dot4_i32_i8 %0, %1, %2, 0" : "=v"(c0) : "v"(__builtin_amdgcn_perm(r, p, 0x05040100u)), "v"(w)); asm("v_dot4_i32_i8 %0, %1, %2, 0" : "=v"(c1) : "v"(__builtin_amdgcn_perm(r, p, 0x07060302u)), "v"(w));
    asm("v_dot4_i32_i8 %0, %1, %2, 0" : "=v"(c2) : "v"(__builtin_amdgcn_perm(s, q, 0x05040100u)), "v"(w)); asm("v_dot4_i32_i8 %0, %1, %2, 0" : "=v"(c3) : "v"(__builtin_amdgcn_perm(s, q, 0x07060302u)), "v"(w));
}
DI void tr4_dot(int& c0, int& c1, int& c2, int& c3, const unsigned a, const unsigned b, const unsigned cc, const unsigned d, const int w) {
    const unsigned p = __builtin_amdgcn_perm(b, a, 0x05010400u), q = __builtin_amdgcn_perm(b, a, 0x07030602u), r = __builtin_amdgcn_perm(d, cc, 0x05010400u), s = __builtin_amdgcn_perm(d, cc, 0x07030602u);
    c0 = __builtin_amdgcn_sdot4((int)__builtin_amdgcn_perm(r, p, 0x05040100u), w, c0, false); c1 = __builtin_amdgcn_sdot4((int)__builtin_amdgcn_perm(r, p, 0x07060302u), w, c1, false);
    c2 = __builtin_amdgcn_sdot4((int)__builtin_amdgcn_perm(s, q, 0x05040100u), w, c2, false); c3 = __builtin_amdgcn_sdot4((int)__builtin_amdgcn_perm(s, q, 0x07060302u), w, c3, false);
}
template <int MODE, int VAR>
DI void slice_compute(const int lane, const v4u (&vr)[16], const int t, const int xs, const SliceAux& n, float* OUT) {
    const int j = lane >> 3, i = lane & 7;
    if (VAR == 1) {
        unsigned x = n.a0.x ^ n.a0.y;
#pragma unroll
        for (int g = 0; g < 16; ++g) x ^= vr[g].x ^ vr[g].y ^ vr[g].z ^ vr[g].w;
        *(unsigned*)((bf16*)OUT + (size_t)t * D + 128 * xs + 2 * lane) = x;
    } else if (MODE == 0) {
        int d[16];
#pragma unroll
        for (int g = 0; g < 16; ++g) d[g] = dot16_i8(vr[g], n.a0, 0);
        int r8[8], r4[4], r2[2];
#define RS_DPP4(CTRL, R, K, S, o) asm("s_nop 1\n\tv_add_u32_dpp %0, %4, %8 " CTRL " row_mask:0xf bank_mask:0xf\n\tv_add_u32_dpp %1, %5, %9 " CTRL " row_mask:0xf bank_mask:0xf\n\t" \
                "v_add_u32_dpp %2, %6, %10 " CTRL " row_mask:0xf bank_mask:0xf\n\tv_add_u32_dpp %3, %7, %11 " CTRL " row_mask:0xf bank_mask:0xf" \
                : "=&v"(R[o]), "=&v"(R[o + 1]), "=&v"(R[o + 2]), "=&v"(R[o + 3]) : "v"(S[o]), "v"(S[o + 1]), "v"(S[o + 2]), "v"(S[o + 3]), "v"(K[o]), "v"(K[o + 1]), "v"(K[o + 2]), "v"(K[o + 3]))
        { int kp[8], sd[8]; const bool od = lane & 1;
#pragma unroll
          for (int q = 0; q < 8; ++q) { kp[q] = od ? d[8 + q] : d[q]; sd[q] = od ? d[q] : d[8 + q]; }
          RS_DPP4("quad_perm:[1,0,3,2]", r8, kp, sd, 0); RS_DPP4("quad_perm:[1,0,3,2]", r8, kp, sd, 4); }
        { int kp[4], sd[4]; const bool od = lane & 2;
#pragma unroll
          for (int q = 0; q < 4; ++q) { kp[q] = od ? r8[4 + q] : r8[q]; sd[q] = od ? r8[q] : r8[4 + q]; }
          RS_DPP4("quad_perm:[2,3,0,1]", r4, kp, sd, 0); }
#undef RS_DPP4
        asm("s_nop 1\n\tv_add_u32_dpp %0, %2, %2 row_shl:4 row_mask:0xf bank_mask:0x5\n\tv_add_u32_dpp %0, %4, %4 row_shr:4 row_mask:0xf bank_mask:0xa\n\t"
            "v_add_u32_dpp %1, %3, %3 row_shl:4 row_mask:0xf bank_mask:0x5\n\tv_add_u32_dpp %1, %5, %5 row_shr:4 row_mask:0xf bank_mask:0xa"
            : "=&v"(r2[0]), "=&v"(r2[1]) : "v"(r4[0]), "v"(r4[1]), "v"(r4[2]), "v"(r4[3]));
        const int g0 = 8 * (i & 1) + 4 * ((i >> 1) & 1) + 2 * (i >> 2);
        *((unsigned*)OUT + ((size_t)xs * T + t) * 64 + 8 * j + (g0 >> 1)) = ((unsigned)((r2[0] + 32) >> 6) & 0xffffu) | ((unsigned)((r2[1] + 32) >> 6) << 16);
    } else {
        int acc[16];
        const int w4[4] = {(int)n.a0.x, (int)n.a0.y, (int)n.a0.z, (int)n.a0.w};
        tr4_dot0(acc[0], acc[1], acc[2], acc[3], vr[0].x, vr[1].x, vr[2].x, vr[3].x, w4[0]);
        tr4_dot0(acc[4], acc[5], acc[6], acc[7], vr[0].y, vr[1].y, vr[2].y, vr[3].y, w4[0]);
        tr4_dot0(acc[8], acc[9], acc[10], acc[11], vr[0].z, vr[1].z, vr[2].z, vr[3].z, w4[0]);
        tr4_dot0(acc[12], acc[13], acc[14], acc[15], vr[0].w, vr[1].w, vr[2].w, vr[3].w, w4[0]);
#pragma unroll
        for (int gq = 1; gq < 4; ++gq) {
            tr4_dot(acc[0], acc[1], acc[2], acc[3], vr[4 * gq].x, vr[4 * gq + 1].x, vr[4 * gq + 2].x, vr[4 * gq + 3].x, w4[gq]);
            tr4_dot(acc[4], acc[5], acc[6], acc[7], vr[4 * gq].y, vr[4 * gq + 1].y, vr[4 * gq + 2].y, vr[4 * gq + 3].y, w4[gq]);
            tr4_dot(acc[8], acc[9], acc[10], acc[11], vr[4 * gq].z, vr[4 * gq + 1].z, vr[4 * gq + 2].z, vr[4 * gq + 3].z, w4[gq]);
            tr4_dot(acc[12], acc[13], acc[14], acc[15], vr[4 * gq].w, vr[4 * gq + 1].w, vr[4 * gq + 2].w, vr[4 * gq + 3].w, w4[gq]);
        }
        int r8[8], r4[4], r2[2];
#pragma unroll
        for (int q = 0; q < 8; q += 4)
            asm("s_nop 1\n\tv_add_u32_dpp %0, %4, %4 row_ror:8 row_mask:0xf bank_mask:0x3\n\tv_add_u32_dpp %0, %8, %8 row_ror:8 row_mask:0xf bank_mask:0xc\n\t"
                "v_add_u32_dpp %1, %5, %5 row_ror:8 row_mask:0xf bank_mask:0x3\n\tv_add_u32_dpp %1, %9, %9 row_ror:8 row_mask:0xf bank_mask:0xc\n\t"
                "v_add_u32_dpp %2, %6, %6 row_ror:8 row_mask:0xf bank_mask:0x3\n\tv_add_u32_dpp %2, %10, %10 row_ror:8 row_mask:0xf bank_mask:0xc\n\t"
                "v_add_u32_dpp %3, %7, %7 row_ror:8 row_mask:0xf bank_mask:0x3\n\tv_add_u32_dpp %3, %11, %11 row_ror:8 row_mask:0xf bank_mask:0xc"
                : "=&v"(r8[q]), "=&v"(r8[q + 1]), "=&v"(r8[q + 2]), "=&v"(r8[q + 3])
                : "v"(acc[q]), "v"(acc[q + 1]), "v"(acc[q + 2]), "v"(acc[q + 3]), "v"(acc[8 + q]), "v"(acc[9 + q]), "v"(acc[10 + q]), "v"(acc[11 + q]));
#pragma unroll
        for (int q = 0; q < 4; ++q) { const auto rr = __builtin_amdgcn_permlane16_swap((unsigned)r8[q], (unsigned)r8[4 + q], false, false); r4[q] = (int)rr[0] + (int)rr[1]; }
#pragma unroll
        for (int q = 0; q < 2; ++q) { const auto rr = __builtin_amdgcn_permlane32_swap((unsigned)r4[q], (unsigned)r4[2 + q], false, false); r2[q] = (int)rr[0] + (int)rr[1]; }
        const int dim = 128 * xs + 16 * i + 8 * (j & 1) + 4 * ((j >> 1) & 1) + 2 * (j >> 2);
        const float s = n.s;
        *(unsigned*)((bf16*)OUT + (size_t)t * D + dim) = pk2((float)r2[0] * s, (float)r2[1] * s);
    }
}
template <int MODE, int VAR = 0>
DI void slice_pass(const Ctx c, const unsigned char* x8, const unsigned short* ids, const unsigned char* w8, const float* sw, const unsigned char* T8, float* OUT, unsigned* q) {
    ChunkQ g; cq_init(g, q, c.lane);
    Chunk cur = cq_next(g, c.lane); if (cur.base < 0) return;
    Chunk nxt = cq_next(g, c.lane);
#define SLICE_TOK_T(p) ((p) < QCH ? cur.base + (p) : (nxt.base >= 0 ? nxt.base + (p) - QCH : -1))
#define SLICE_TOK_X(p) ((p) < QCH ? cur.xs : nxt.xs)
    SliceIds i0 = slice_load_ids(SLICE_TOK_T(0), SLICE_TOK_X(0), c.lane, ids), i1 = slice_load_ids(SLICE_TOK_T(1), SLICE_TOK_X(1), c.lane, ids),
             i2 = slice_load_ids(SLICE_TOK_T(2), SLICE_TOK_X(2), c.lane, ids), i3 = slice_load_ids(SLICE_TOK_T(3), SLICE_TOK_X(3), c.lane, ids);
    SliceAux x0 = slice_load_aux<MODE>(i0.t, i0.xs, c.lane, x8, w8, sw), x1 = slice_load_aux<MODE>(i1.t, i1.xs, c.lane, x8, w8, sw);
    v4u A[16], B[16];
    slice_issue<VAR>(A, i0, T8, c.lane);
#define SLICE_STEP(K, CUR, NXT, IK, IK1, XK) do { slice_issue<VAR>(NXT, IK1, T8, c.lane); \
        const int ct_ = IK.t, cx_ = IK.xs; const SliceAux cxk_ = XK; \
        XK = slice_load_aux<MODE>(SLICE_TOK_T(pg + (K) + 2), SLICE_TOK_X(pg + (K) + 2), c.lane, x8, w8, sw); \
        IK = slice_load_ids(SLICE_TOK_T(pg + (K) + 4), SLICE_TOK_X(pg + (K) + 4), c.lane, ids); \
        slice_compute<MODE, VAR>(c.lane, CUR, ct_, cx_, cxk_, OUT); } while (0)
    for (;;) {
#pragma unroll 2
        for (int pg = 0; pg < QCH; pg += 4) {
            SLICE_STEP(0, A, B, i0, i1, x0);
            SLICE_STEP(1, B, A, i1, i2, x1);
            SLICE_STEP(2, A, B, i2, i3, x0);
            SLICE_STEP(3, B, A, i3, i0, x1);
        }
        cur = nxt; if (cur.base < 0) break;
        nxt = cq_next(g, c.lane);
    }
#undef SLICE_STEP
#undef SLICE_TOK_T
#undef SLICE_TOK_X
}
struct WpA { f32x4 s; v2u iw; f32x4 g; float st; };
struct WpB { f32x4 su, sv; };
DI WpA wp_load_a(const size_t idx, const float* part, const unsigned short* ids, const float* gates, const float* sx) {
    WpA a; v2u p[8];
#pragma unroll
    for (int x = 0; x < 8; ++x) p[x] = *(const v2u*)((const unsigned short*)part + (size_t)x * T * 128 + idx * 4);
    a.iw = *(const v2u*)(ids + idx * 4); a.g = *(const f32x4*)(gates + idx * 4); a.st = sx[idx >> 5] * 64.0f;
    int s0 = 0, s1 = 0, s2 = 0, s3 = 0;
#pragma unroll
    for (int x = 0; x < 8; ++x) { s0 += (int)(short)(p[x].x & 0xffffu); s1 += (int)p[x].x >> 16; s2 += (int)(short)(p[x].y & 0xffffu); s3 += (int)p[x].y >> 16; }
    a.s = (f32x4){(float)s0, (float)s1, (float)s2, (float)s3}; return a;
}
DI WpB wp_load_b(const WpA& a, const float* SU, const float* SV) {
    const unsigned e[4] = {a.iw.x & 0xffffu, a.iw.x >> 16, a.iw.y & 0xffffu, a.iw.y >> 16}; WpB b;
#pragma unroll
    for (int k = 0; k < 4; ++k) { const f2 p = *(const f2*)(SU + 2 * e[k]); b.su[k] = p.x; b.sv[k] = p.y; }
    (void)SV;
    return b;
}
DI void peer_w_phase(const Ctx c, const float* part, const unsigned short* ids, const float* gates, unsigned char* w8, float* sw, const float* sx, const float* SU, const float* SV) {
    const size_t NT = (size_t)c.G * 512, NI = (size_t)T * 32, i0 = (size_t)c.vcu * 512 + c.tid;
    WpA a0 = wp_load_a(i0 < NI ? i0 : 0, part, ids, gates, sx), a1 = wp_load_a(i0 + NT < NI ? i0 + NT : 0, part, ids, gates, sx);
    WpB b0 = wp_load_b(a0, SU, SV);
    for (size_t idx = i0; idx < NI; idx += NT) {
        const WpA a2 = wp_load_a(idx + 2 * NT < NI ? idx + 2 * NT : 0, part, ids, gates, sx);
        const WpB b1 = wp_load_b(a1, SU, SV);
        f32x4 g = a0.g; float am = 0.f;
#pragma unroll
        for (int k = 0; k < 4; ++k) { g[k] = g[k] * gelu_erf(a0.s[k] * (a0.st * b0.su[k])) * b0.sv[k]; am = __builtin_fmaxf(am, __builtin_fabsf(g[k])); }
        am = max32(am);
        *(unsigned*)(w8 + idx * 4) = q4_i8(g, am > 0.f ? 127.0f / am : 0.f);
        if ((c.tid & 31) == 0) sw[idx >> 5] = am * (1.0f / 127.0f);
        a0 = a1; a1 = a2; b0 = b1;
    }
}

DI int pi_row(int m) { return 16 * (m >> 4) + 8 * ((m >> 2) & 1) + 4 * ((m >> 3) & 1) + (m & 3); }
struct AttnT { const bf16* Q; bf16* O; const bf16* Kb; const bf16* VT; const bf16* Vsn; const float* ck; const float* cv; };
template <int MODE>
DI void attn_load(const AttnT A, const int b, const int h, const int kt, const int q, const int hh, const int piq, bf16x8 (&kf)[4], bf16x8 (&vf)[2][2]) {
    if (MODE == 0) {
        const bf16* kr = A.Kb + ((size_t)b * SEQ + kt * 32 + piq) * D + h * DH + 8 * hh;
#pragma unroll
        for (int s = 0; s < 4; ++s) kf[s] = *(const bf16x8*)(kr + 16 * s);
        const bf16* vr = A.VT + (((size_t)b * NH + h) * (SEQ / 32) + kt) * (DH * 32) + q * 32 + 8 * hh;
#pragma unroll
        for (int mt = 0; mt < 2; ++mt)
#pragma unroll
            for (int s = 0; s < 2; ++s) vf[mt][s] = *(const bf16x8*)(vr + mt * 32 * 32 + 16 * s);
    } else if (kt == PAST / 32) {
        const int ko = piq < 16 ? piq : 15;
        const bf16* kr = A.Kb + ((size_t)TP + b * DSEQ + ko) * D + h * DH + 8 * hh;
#pragma unroll
        for (int s = 0; s < 4; ++s) kf[s] = *(const bf16x8*)(kr + 16 * s);
#pragma unroll
        for (int mt = 0; mt < 2; ++mt)
#pragma unroll
            for (int s = 0; s < 2; ++s) { bf16x8 v;
#pragma unroll
                for (int j = 0; j < 8; ++j) { const int kk = 16 * s + 8 * hh + j; v[j] = (short)A.Vsn[((size_t)b * DSEQ + (kk < 16 ? kk : 15)) * D + h * DH + 32 * mt + q]; }
                vf[mt][s] = v; }
    } else {
        const float* kr = A.ck + (((size_t)b * PAST + kt * 32 + piq) * NH + h) * DH + 8 * hh;
#pragma unroll
        for (int s = 0; s < 4; ++s) { const f32x4 x0 = *(const f32x4*)(kr + 16 * s), x1 = *(const f32x4*)(kr + 16 * s + 4); kf[s] = pack8(x0[0], x0[1], x0[2], x0[3], x1[0], x1[1], x1[2], x1[3]); }
#pragma unroll
        for (int mt = 0; mt < 2; ++mt)
#pragma unroll
            for (int s = 0; s < 2; ++s) { float x[8];
#pragma unroll
                for (int j = 0; j < 8; ++j) x[j] = A.cv[(((size_t)b * PAST + kt * 32 + 16 * s + 8 * hh + j) * NH + h) * DH + 32 * mt + q];
                vf[mt][s] = pack8(x[0], x[1], x[2], x[3], x[4], x[5], x[6], x[7]); }
    }
}
template <int MODE>
DI void attn_qtile(const AttnT A, int b, int h, int qi, int lane, const bf16x8 (&ut)[2]) {
    const int q = lane & 31, hh = lane >> 5, piq = pi_row(q);
    const size_t qrow = MODE == 0 ? (size_t)b * SEQ + qi * 32 + q : (size_t)TP + b * DSEQ + (q < 16 ? q : 15);
    const int qpos = MODE == 0 ? qi * 32 + q : (q < 16 ? PAST + q : 0);
    bf16x8 qf[4];
#pragma unroll
    for (int s = 0; s < 4; ++s) qf[s] = *(const bf16x8*)(A.Q + qrow * D + h * DH + 16 * s + 8 * hh);
    f32x16 o0, o1;
#pragma unroll
    for (int i = 0; i < 16; ++i) { o0[i] = 0.f; o1[i] = 0.f; }
    float carry = 0.f;
    const int kt0 = MODE == 0 ? qi : PAST / 32;
    bf16x8 kf[4], vf[2][2];
    attn_load<MODE>(A, b, h, kt0, q, hh, piq, kf, vf);
    for (int kt = kt0; kt >= 0; --kt) {
        bf16x8 kn[4], vn[2][2];
        attn_load<MODE>(A, b, h, kt > 0 ? kt - 1 : 0, q, hh, piq, kn, vn);
        f32x16 S;
#pragma unroll
        for (int i = 0; i < 16; ++i) S[i] = 0.f;
#pragma unroll
        for (int s = 0; s < 4; ++s) S = MFMA32(kf[s], qf[s], S);
        const int kbase = kt * 32 + 8 * hh;
        float L[16], lw[16];
#pragma unroll
        for (int r = 0; r < 16; ++r) {
            const bool valid = (kbase + 16 * (r >> 3) + (r & 7)) < qpos;
            const float z = S[r], sp = __builtin_fmaxf(z, 0.f) + __builtin_amdgcn_logf(1.0f + __builtin_amdgcn_exp2f(-__builtin_fabsf(z)));
            L[r] = valid ? -sp : 0.f; lw[r] = valid ? (z - sp) : -1e30f;
        }
        f32x16 suf;
#pragma unroll
        for (int i = 0; i < 16; ++i) suf[i] = 0.f;
        suf = MFMA32(ut[0], pack8(L[0], L[1], L[2], L[3], L[4], L[5], L[6], L[7]), suf);
        suf = MFMA32(ut[1], pack8(L[8], L[9], L[10], L[11], L[12], L[13], L[14], L[15]), suf);
        float a[16];
#pragma unroll
        for (int r = 0; r < 16; ++r) a[r] = __builtin_amdgcn_exp2f(lw[r] + suf[r] + carry);
        carry += __int_as_float(__builtin_amdgcn_ds_bpermute(q << 2, __float_as_int(suf[0] + L[0])));
        const bf16x8 p0 = pack8(a[0], a[1], a[2], a[3], a[4], a[5], a[6], a[7]), p1 = pack8(a[8], a[9], a[10], a[11], a[12], a[13], a[14], a[15]);
        o0 = MFMA32(vf[0][0], p0, o0); o0 = MFMA32(vf[0][1], p1, o0);
        o1 = MFMA32(vf[1][0], p0, o1); o1 = MFMA32(vf[1][1], p1, o1);
        if (__builtin_amdgcn_ballot_w64(qpos > 0 && carry > -24.0f * LOG2E) == 0ull) break;
#pragma unroll
        for (int s = 0; s < 4; ++s) kf[s] = kn[s];
#pragma unroll
        for (int mt = 0; mt < 2; ++mt)
#pragma unroll
            for (int s = 0; s < 2; ++s) vf[mt][s] = vn[mt][s];
    }
    if (MODE == 0 || q < 16) {
        bf16* orow = A.O + qrow * D + h * DH + 4 * hh;
#pragma unroll
        for (int g = 0; g < 4; ++g) {
            v2u w0, w1; w0.x = pk2(o0[4 * g], o0[4 * g + 1]); w0.y = pk2(o0[4 * g + 2], o0[4 * g + 3]); w1.x = pk2(o1[4 * g], o1[4 * g + 1]); w1.y = pk2(o1[4 * g + 2], o1[4 * g + 3]);
            *(v2u*)(orow + 8 * g) = w0; *(v2u*)(orow + 32 + 8 * g) = w1; }
    }
}
DI void attn_phase(const Ctx c, const AttnT A) {
    const int q = c.lane & 31, hh = c.lane >> 5, piq = pi_row(q);
    bf16x8 ut[2];
#pragma unroll
    for (int s = 0; s < 2; ++s)
#pragma unroll
        for (int j = 0; j < 8; ++j) ut[s][j] = (16 * s + 8 * hh + j > piq) ? (short)0x3f80 : (short)0;
    for (int bu = c.vcu; bu < NB * NH * 4; bu += c.G) {
        const int bh = bu >> 2, b = bh >> 4, h = bh & 15, p = (bu & 3) * 8 + c.wave;
        attn_qtile<0>(A, b, h, 63 - p, c.lane, ut);
        attn_qtile<0>(A, b, h, p, c.lane, ut);
    }
    for (int su = c.wave * c.G + c.vcu; su < NB * NH; su += c.G * 8) attn_qtile<1>(A, su >> 4, su & 15, 0, c.lane, ut);
}

DI void vt_phase(const Ctx c, LAS unsigned char* lds, const bf16* Vb, bf16* VT, bf16* Vsn) {
    LAS unsigned char* scr = lds + c.wave * 16384;
    const int gw = c.vcu * 8 + c.wave, NGW = c.G * 8;
    for (int wt = gw; wt < (TP / 64) * 16; wt += NGW) {
        const int tt = wt >> 4, ht = wt & 15;
        v4u vin[8];
#pragma unroll
        for (int j = 0; j < 8; ++j) vin[j] = *(const v4u*)(Vb + (size_t)(tt * 64 + (c.lane >> 3) + 8 * j) * D + ht * 64 + (c.lane & 7) * 8);
        __builtin_amdgcn_sched_barrier(0);
#pragma unroll
        for (int j = 0; j < 8; ++j) { const int row = (c.lane >> 3) + 8 * j, ch = c.lane & 7;
            LAS unsigned* d = (LAS unsigned*)(scr + row * 132 + ch * 16); d[0] = vin[j].x; d[1] = vin[j].y; d[2] = vin[j].z; d[3] = vin[j].w; }
        LDS_WAIT(); asm volatile("" ::: "memory");
#pragma unroll
        for (int j = 0; j < 8; ++j) { const int orow = (c.lane >> 3) + 8 * j, ch = c.lane & 7;
            unsigned short e[8];
#pragma unroll
            for (int i = 0; i < 8; ++i) e[i] = *(const LAS unsigned short*)(scr + (ch * 8 + i) * 132 + orow * 2);
            v4u o; o.x = e[0] | ((unsigned)e[1] << 16); o.y = e[2] | ((unsigned)e[3] << 16); o.z = e[4] | ((unsigned)e[5] << 16); o.w = e[6] | ((unsigned)e[7] << 16);
            { const int bb = tt >> 5, kt = 2 * (tt & 31) + (ch >> 2);
              *(v4u*)(VT + (((size_t)bb * NH + ht) * (SEQ / 32) + kt) * (DH * 32) + orow * 32 + 8 * (ch & 3)) = o; } }
        LDS_WAIT(); asm volatile("" ::: "memory");
    }
    const size_t NT = (size_t)c.G * 512;
    for (size_t i = (size_t)c.vcu * 512 + c.tid; i < (size_t)TS * D / 8; i += NT) *(v4u*)(Vsn + i * 8) = *(const v4u*)(Vb + (size_t)TP * D + i * 8);
}

DI f32x16 sg_tile(const bf16* wr  , const bf16* xr  ) {
    f32x16 acc;
#pragma unroll
    for (int i = 0; i < 16; ++i) acc[i] = 0.f;
    bf16x8 wa[8], xa[8], wb[8], xb[8];
#pragma unroll
    for (int j = 0; j < 8; ++j) { wa[j] = *(const bf16x8*)(wr + 16 * j); xa[j] = *(const bf16x8*)(xr + 16 * j); }
#pragma unroll 1
    for (int k0 = 0; k0 < 64; k0 += 16) {
#pragma unroll
        for (int j = 0; j < 8; ++j) { wb[j] = *(const bf16x8*)(wr + 16 * (k0 + 8 + j)); xb[j] = *(const bf16x8*)(xr + 16 * (k0 + 8 + j)); }
        __builtin_amdgcn_sched_barrier(0);
#pragma unroll
        for (int j = 0; j < 8; ++j) acc = MFMA32(wa[j], xa[j], acc);
        __builtin_amdgcn_sched_barrier(0);
        { const int kn = k0 + 16 < 64 ? k0 + 16 : 0;
#pragma unroll
          for (int j = 0; j < 8; ++j) { wa[j] = *(const bf16x8*)(wr + 16 * (kn + j)); xa[j] = *(const bf16x8*)(xr + 16 * (kn + j)); } }
        __builtin_amdgcn_sched_barrier(0);
#pragma unroll
        for (int j = 0; j < 8; ++j) acc = MFMA32(wb[j], xb[j], acc);
        __builtin_amdgcn_sched_barrier(0);
    }
    return acc;
}
DI void sg_gate(const Ctx c, const bf16* Hall  , const bf16* Wl  , bf16* U, bf16* Bg, float* convp  ) {
    const int q = c.lane & 31, hh = c.lane >> 5;
    for (int tile = c.wave * c.G + c.vcu; tile < 18 * 32; tile += c.G * 8) {
        const int tt = tile % 18, dt = tile / 18, d = 32 * dt + q, crow = 256 * (d >> 7) + (d & 127);
        const bool cs = tt >= 16; const int kk = (tt - 16) * 32 + q;
        const size_t row = cs ? (size_t)(kk >> 1) * SEQ + (SEQ - 2) + (kk & 1) : (size_t)TP + tt * 32 + q;
        const bf16* xr = Hall + row * D + 8 * hh;
        const bf16* wc = Wl + (size_t)crow * D + 8 * hh; const bf16* wx = wc + (size_t)128 * D; const bf16* wb = Wl + (size_t)(2048 + d) * D + 8 * hh;
        f32x16 ac, ax, ab;
#pragma unroll
        for (int i = 0; i < 16; ++i) { ac[i] = 0.f; ax[i] = 0.f; ab[i] = 0.f; }
        { bf16x8 fx[4], fc[4], fxx[4], fb[4], gx[4], gc[4], gxx[4], gb[4];
#pragma unroll
          for (int j = 0; j < 4; ++j) { fx[j] = *(const bf16x8*)(xr + 16 * j); fc[j] = *(const bf16x8*)(wc + 16 * j); fxx[j] = *(const bf16x8*)(wx + 16 * j); fb[j] = *(const bf16x8*)(wb + 16 * j); }
#pragma unroll 1
          for (int k0 = 0; k0 < 64; k0 += 8) {
#pragma unroll
              for (int j = 0; j < 4; ++j) { gx[j] = *(const bf16x8*)(xr + 16 * (k0 + 4 + j)); gc[j] = *(const bf16x8*)(wc + 16 * (k0 + 4 + j)); gxx[j] = *(const bf16x8*)(wx + 16 * (k0 + 4 + j)); gb[j] = *(const bf16x8*)(wb + 16 * (k0 + 4 + j)); }
              __builtin_amdgcn_sched_barrier(0);
#pragma unroll
              for (int j = 0; j < 4; ++j) { ac = MFMA32(fc[j], fx[j], ac); ax = MFMA32(fxx[j], fx[j], ax); ab = MFMA32(fb[j], fx[j], ab); }
              __builtin_amdgcn_sched_barrier(0);
              { const int kn = k0 + 8 < 64 ? k0 + 8 : 0;
#pragma unroll
                for (int j = 0; j < 4; ++j) { fx[j] = *(const bf16x8*)(xr + 16 * (kn + j)); fc[j] = *(const bf16x8*)(wc + 16 * (kn + j)); fxx[j] = *(const bf16x8*)(wx + 16 * (kn + j)); fb[j] = *(const bf16x8*)(wb + 16 * (kn + j)); } }
              __builtin_amdgcn_sched_barrier(0);
#pragma unroll
              for (int j = 0; j < 4; ++j) { ac = MFMA32(gc[j], gx[j], ac); ax = MFMA32(gxx[j], gx[j], ax); ab = MFMA32(gb[j], gx[j], ab); }
              __builtin_amdgcn_sched_barrier(0);
          } }
        if (cs) {
            float* cd = convp + (size_t)kk * D + 32 * dt + 4 * hh;
#pragma unroll
            for (int g = 0; g < 4; ++g) *(f32x4*)(cd + 8 * g) = (f32x4){ac[4 * g] * ax[4 * g], ac[4 * g + 1] * ax[4 * g + 1], ac[4 * g + 2] * ax[4 * g + 2], ac[4 * g + 3] * ax[4 * g + 3]};
        } else {
            const size_t ro = row * D + 32 * dt + 4 * hh;
#pragma unroll
            for (int g = 0; g < 4; ++g) { v2u wu, wb2; wu.x = pk2(ac[4 * g] * ax[4 * g], ac[4 * g + 1] * ax[4 * g + 1]); wu.y = pk2(ac[4 * g + 2] * ax[4 * g + 2], ac[4 * g + 3] * ax[4 * g + 3]);
                wb2.x = pk2(ab[4 * g], ab[4 * g + 1]); wb2.y = pk2(ab[4 * g + 2], ab[4 * g + 3]);
                *(v2u*)(U + ro + 8 * g) = wu; *(v2u*)(Bg + ro + 8 * g) = wb2; }
        }
    }
}
template <int MODE>
DI void sg_plain(const Ctx c, const bf16* Xs, const bf16* Wt, const int N, bf16* O, const bf16* Hres, bf16* O2, float* f0, float* f1) {
    const int q = c.lane & 31, hh = c.lane >> 5;
    for (int tile = c.wave * c.G + c.vcu; tile < 16 * (N / 32); tile += c.G * 8) {
        const int tt = tile & 15, ft = tile >> 4;
        const f32x16 acc = sg_tile(Wt + (size_t)(ft * 32 + q) * D + 8 * hh, Xs + (size_t)(tt * 32 + q) * D + 8 * hh);
        const int tl = tt * 32 + q;
#pragma unroll
        for (int g = 0; g < 4; ++g) { const int f = 32 * ft + 8 * g + 4 * hh; const f32x4 v = {acc[4 * g], acc[4 * g + 1], acc[4 * g + 2], acc[4 * g + 3]};
            if (MODE == 0) { v2u w; w.x = pk2(v[0], v[1]); w.y = pk2(v[2], v[3]); *(v2u*)(O + (size_t)(TP + tl) * D + f) = w; }
            else if (MODE == 1) { const v2u hw = *(const v2u*)(Hres + (size_t)(TP + tl) * D + f); const f32x4 r = (f32x4){bflo(hw.x), bfhi(hw.x), bflo(hw.y), bfhi(hw.y)} * ALPHA + v;
                v2u w; w.x = pk2(r[0], r[1]); w.y = pk2(r[2], r[3]); *(v2u*)(O + (size_t)(TP + tl) * D + f) = w; }
            else if (MODE == 2) { const bool isv = f >= 1024; const int fc = isv ? f - 1024 : f; v2u w; w.x = pk2(v[0], v[1]); w.y = pk2(v[2], v[3]);
                *(v2u*)((isv ? O2 : O) + (size_t)(TP + tl) * D + fc) = w; *(f32x4*)((isv ? f1 : f0) + (size_t)tl * D + fc) = v; }
            else { v2u w; w.x = pk2(v[0], v[1]); w.y = pk2(v[2], v[3]); *(v2u*)(O + (size_t)(TP + tl) * 2048 + f) = w; }
        }
    }
}

struct Args { const float* in[18]; float* out; unsigned char* ws; int ph_lo, ph_hi, li, pad; };
constexpr int N_PHASES = 2 + 2 * 10 + 12 + 10;
__global__ void __launch_bounds__(512, 2) fwd(Args args) {
    extern __shared__ __attribute__((aligned(16))) unsigned char lds_raw[];
    LAS unsigned char* lds = (LAS unsigned char*)lds_raw;
    Ctx c0; c0.tid = threadIdx.x; c0.lane = 0; c0.wave = __builtin_amdgcn_readfirstlane(c0.tid >> 6); c0.G = gridDim.x;
    { const int bx = blockIdx.x; c0.vcu = (c0.G % 8 == 0) ? (bx % 8) * (c0.G / 8) + bx / 8 : bx; }
    volatile LAS unsigned* MISC = (volatile LAS unsigned*)(lds + MISC_OFF);
    for (int u = c0.tid; u < (LDS_BYTES - RING_BYTES) / 4; u += 512) ((LAS unsigned*)(lds + RING_BYTES))[u] = 0u;
    __syncthreads();
    unsigned char* ws = args.ws; float* out = args.out;
    XcdBarrier bar = xcd_barrier_post((unsigned*)(ws + WS_CTL) + CW_BAR + args.li * XCD_BAR_WORDS, MISC + 8, c0.wave == 0 ? 1u : 0u);
#define WinT ((bf16*)(wsl + WS_WIN))
#define WoutT ((bf16*)(wsl + WS_WOUT))
#define WqT ((bf16*)(wsl + WS_WQ))
#define WoT ((bf16*)(wsl + WS_WO))
#define WkvT ((bf16*)(wsl + WS_WKV))
#define WP ((bf16*)(wsl + WS_WP))
#define W8A (wsl + WS_W8A)
#define SWA ((float*)(wsl + WS_SWA))
#define W8R(off) ((int)(((off) - WS_WIN) / 2048))
#define Vsn ((bf16*)(wsl + WS_VSN))
#define H ((bf16*)(wsl + WS_H))
#define Kb ((bf16*)(wsl + WS_KB))
#define VT ((bf16*)(wsl + WS_VT))
#define ids ((unsigned short*)(wsl + WS_IDS))
#define gates ((float*)(wsl + WS_GATE))
#define W8 (wsl + WS_W8)
#define SX ((float*)(wsl + WS_SX))
#define SW (SX + T)
#define X8 (wsl + WS_X8)
#define TU (wsl + WS_TU)
#define TV (wsl + WS_TV)
#define SU ((float*)(wsl + WS_SU))
#define SV (SU + 1)
#define A0 ((bf16*)(wsl + WS_A))
#define A1 ((bf16*)(wsl + WS_A + 129 * MiB))
#define ScT ((float*)(wsl + WS_A))
#define R A0
    const float* ln_g = args.in[16]; const float* ln_b = args.in[17];
    const int lo = args.ph_lo, hi = args.ph_hi; int ph = 0;
#ifndef PROBE_REPEAT
#define PROBE_REPEAT 0
#endif
#define PHASE_R(bit, body) do { const int nrep = 1 + ((PROBE_REPEAT >> (bit)) & 1); for (int rep = 0; rep < nrep; ++rep) { if (ph >= lo && ph < hi) { Ctx c = c0; c.lane = xb_lane_id(); c.tid = c0.wave * 64 + c.lane; unsigned long long wsi_ = (unsigned long long)ws; asm volatile("" : "+s"(wsi_)); unsigned char* wsl = (unsigned char*)(GAS unsigned char*)wsi_; body; if (ph + 1 < hi) { xcd_barrier(bar); if ((PROBE_REPEAT >> 20) & 1) xcd_barrier(bar); } } ++ph; } } while (0)
#define PHASE(body) PHASE_R(31, body)

    PHASE_R(4, ({ P0Args a{args.in[0], args.in[1], args.in[5], args.in[7], args.in[8], args.in[9], args.in[10], args.in[11], args.in[12], args.in[13], args.in[14], args.in[15],
                      WinT, WoutT, WqT, WoT, WkvT, WP, H, TU, TV, SU, SV, X8, SX}; p0_prologue(c, lds, a); }));

    PHASE(({ wp_quant_phase(c, WinT, W8A, SWA); }));

#pragma unroll 1
    for (int l = 0; l < NLAYER; ++l) {
        if (l < 2) {
            PHASE_R(8, ({ pg8::Gemm g{(const bf16*)X8, (const bf16*)(W8A + ((size_t)W8R(WS_WIN) + (size_t)l * 3072) * 1024), TP, 3072, 512}; pg8::StaticOrder S; S.init(TP, 3072, c.G, (int)blockIdx.x);
                     pg8::EpiGate<true> E{A0, A1, SX, SWA + W8R(WS_WIN) + l * 3072};
                     pg8::gemm_phase<pg8::EpiGate<true>, pg8::StaticOrder, true, true, true>(lds, g, S, E, c.tid);
                     sg_gate(c, H, WinT + (size_t)l * 3072 * 1024, A0, A1, out + O_CONVP + (size_t)l * NB * 2 * D); }));
            PHASE_R(13, ({ conv_gate_phase(c, A0, A1, args.in[6] + (size_t)l * 3 * D, args.in[2] + (size_t)l * NB * 2 * D, out + O_CONVP + (size_t)l * NB * 2 * D, out + O_CONVS + (size_t)l * NB * 2 * D, X8, SX, rep > 0); }));
        } else {
            if (l == 2) {
                PHASE_R(10, ({ pg8::Gemm g{(const bf16*)X8, (const bf16*)(W8A + (size_t)W8R(WS_WKV) * 1024), TP, 2048, 512}; pg8::StaticOrder S; S.init(TP, 2048, c.G, (int)blockIdx.x);
                         pg8::EpiKV<true> E{Kb, A1, out + O_KP, out + O_VP, out + O_KS, out + O_VS, SX, SWA + W8R(WS_WKV)};
                         pg8::gemm_phase<pg8::EpiKV<true>, pg8::StaticOrder, true, true, true>(lds, g, S, E, c.tid);
                         sg_plain<2>(c, H + (size_t)TP * D, WkvT, 2048, Kb, nullptr, A1, out + O_KS, out + O_VS); }));
                PHASE_R(14, ({ vt_phase(c, lds, A1, VT, Vsn); }));
            }
            PHASE_R(9, ({ pg8::Gemm g{(const bf16*)X8, (const bf16*)(W8A + ((size_t)W8R(WS_WQ) + (size_t)(l - 2) * 1024) * 1024), TP, 1024, 512}; pg8::StaticOrder S; S.init(TP, 1024, c.G, (int)blockIdx.x);
                     pg8::EpiBf16P<true> E{A0, 1024, SX, SWA + W8R(WS_WQ) + (l - 2) * 1024};
                     pg8::gemm_phase<pg8::EpiBf16P<true>, pg8::StaticOrder, true, true, true>(lds, g, S, E, c.tid);
                     sg_plain<0>(c, H + (size_t)TP * D, WqT + (size_t)(l - 2) * 1024 * 1024, 1024, A0, nullptr, nullptr, nullptr, nullptr); }));
            PHASE_R(11, ({ AttnT A{A0, A1, Kb, VT, Vsn, args.in[3], args.in[4]}; attn_phase(c, A); }));
        }
        if (l < 2) {
            PHASE_R(7, ({ pg8::Gemm g{(const bf16*)X8, (const bf16*)(W8A + ((size_t)W8R(WS_WOUT) + (size_t)l * 1024) * 1024), TP, 1024, 512}; pg8::StaticOrder S; S.init(TP, 1024, c.G, (int)blockIdx.x);
                     pg8::EpiRes<true> E{H, R, ALPHA, SX, SWA + W8R(WS_WOUT) + l * 1024};
                     pg8::gemm_phase<pg8::EpiRes<true>, pg8::StaticOrder, true, true, true>(lds, g, S, E, c.tid);
                     sg_plain<1>(c, A1 + (size_t)TP * D, WoutT + (size_t)l * 1024 * 1024, 1024, R, H, nullptr, nullptr, nullptr); }));
        } else {
            PHASE_R(7, ({ pg8::Gemm g{A1, WoT + (size_t)(l - 2) * 1024 * 1024, TP, 1024, 1024}; pg8::StaticOrder S; S.init(TP, 1024, c.G, (int)blockIdx.x);
                     pg8::EpiRes<false> E{H, R, ALPHA, nullptr, nullptr};
                     pg8::gemm_phase<pg8::EpiRes<false>, pg8::StaticOrder, true, true>(lds, g, S, E, c.tid);
                     sg_plain<1>(c, A1 + (size_t)TP * D, WoT + (size_t)(l - 2) * 1024 * 1024, 1024, R, H, nullptr, nullptr, nullptr); }));
        }
        PHASE_R(5, ({ ln_phase(c, R, H, ln_g + (size_t)(l * 2) * D, ln_b + (size_t)(l * 2) * D, nullptr, nullptr, X8, SX); }));
        PHASE_R(6, ({ pg8::Gemm g{(const bf16*)X8, (const bf16*)(W8A + ((size_t)W8R(WS_WP) + (size_t)l * 2048) * 1024), TP, 2048, 512}; pg8::StaticOrder S; S.init(TP, 2048, c.G, (int)blockIdx.x);
                 pg8::EpiScoreI8 E{(bf16*)ScT, 2048, SX, SWA + W8R(WS_WP) + l * 2048};
                 pg8::gemm_phase<pg8::EpiScoreI8, pg8::StaticOrder, true, true, true>(lds, g, S, E, c.tid);
                 sg_plain<3>(c, H + (size_t)TP * D, WP + (size_t)l * 2048 * 1024, 2048, (bf16*)ScT, nullptr, nullptr, nullptr, nullptr); }));
        PHASE_R(3, ({ topk_phase(c, (const bf16*)ScT, ids, gates); }));
        PHASE_R(0, ({ slice_pass<0>(c, X8, ids, W8, SW, TU + (size_t)l * NEXP * D, ScT  , (unsigned*)(ws + WS_CTL) + CW_Q + ((l * 2) * 2 + rep) * 512); }));
        PHASE_R(12, ({ peer_w_phase(c, ScT, ids, gates, W8, SW, SX, SU + (size_t)l * NEXP * 2, SV + (size_t)l * NEXP * 2); }));
        PHASE_R(1, ({ slice_pass<1>(c, X8, ids, W8, SW, TV + (size_t)l * NEXP * D, (float*)A0, (unsigned*)(ws + WS_CTL) + CW_Q + ((l * 2 + 1) * 2 + rep) * 512); }));
        PHASE(({ ln_phase(c, A0, H, ln_g + (size_t)(l * 2 + 1) * D, ln_b + (size_t)(l * 2 + 1) * D, l == NLAYER - 1 ? out : nullptr, H, X8, SX); }));
#if defined(PROBE_SLICE) && PROBE_SLICE == 1
        PHASE(({ slice_pass<0, 1>(c, X8, ids, W8, SW, TU + (size_t)l * NEXP * D, ScT, (unsigned*)(ws + WS_CTL) + CW_Q + ((l * 2) * 2 + 1) * 512); }));
#elif defined(PROBE_SLICE) && PROBE_SLICE == 2
        PHASE(({ slice_pass<0, 2>(c, X8, ids, W8, SW, TU + (size_t)l * NEXP * D, ScT, (unsigned*)(ws + WS_CTL) + CW_Q + ((l * 2) * 2 + 1) * 512); }));
#elif defined(PROBE_SLICE) && PROBE_SLICE == 3
        PHASE(({ slice_pass<1, 1>(c, X8, ids, W8, SW, TV + (size_t)l * NEXP * D, ScT, (unsigned*)(ws + WS_CTL) + CW_Q + ((l * 2) * 2 + 1) * 512); }));
#elif defined(PROBE_SLICE) && PROBE_SLICE == 4
        PHASE(({ slice_pass<1, 2>(c, X8, ids, W8, SW, TV + (size_t)l * NEXP * D, ScT, (unsigned*)(ws + WS_CTL) + CW_Q + ((l * 2) * 2 + 1) * 512); }));
#endif
    }
#undef PHASE
#undef PHASE_R
#undef WinT
#undef WoutT
#undef WqT
#undef WoT
#undef WkvT
#undef WP
#undef W8A
#undef SWA
#undef W8R
#undef Vsn
#undef H
#undef Kb
#undef VT
#undef ids
#undef gates
#undef W8
#undef SX
#undef SW
#undef X8
#undef TU
#undef TV
#undef SU
#undef SV
#undef A0
#undef A1
#undef ScT
#undef R
}

#ifndef N_LAUNCH_MODE
#define N_LAUNCH_MODE 1
#endif
extern "C" void kernel_launch(void* const* d_in, const int* in_sizes, int n_in, void* d_out, int out_size, void* d_ws, size_t ws_size, hipStream_t stream) {
    static int grid = 0;
    if (grid == 0) {
        if (n_in != 18 || in_sizes[0] != TP * D || (size_t)out_size != O_END || ws_size < WS_END) {
            fprintf(stderr, "kernel_launch: shape mismatch: n_in %d in0 %d out %d ws %zu (need %zu)\n", n_in, n_in > 0 ? in_sizes[0] : -1, out_size, ws_size, (size_t)WS_END); grid = -1; return; }
        int dev = 0, cus = 0, per_cu = 0;
        if (hipGetDevice(&dev) != hipSuccess || hipDeviceGetAttribute(&cus, hipDeviceAttributeMultiprocessorCount, dev) != hipSuccess) { grid = -1; return; }
        if (hipFuncSetAttribute((const void*)fwd, hipFuncAttributeMaxDynamicSharedMemorySize, LDS_BYTES) != hipSuccess) { fprintf(stderr, "kernel_launch: hipFuncSetAttribute failed\n"); grid = -1; return; }
        if (hipOccupancyMaxActiveBlocksPerMultiprocessor(&per_cu, (const void*)fwd, 512, LDS_BYTES) != hipSuccess || per_cu < 1) { fprintf(stderr, "kernel_launch: occupancy query says %d\n", per_cu); }
        (void)hipGetLastError();
        grid = cus;
    }
    if (grid < 0) return;
    (void)hipMemsetAsync((char*)d_ws + WS_CTL, 0, CTL_BYTES, stream);
    Args a{};
    for (int i = 0; i < 18; ++i) a.in[i] = (const float*)d_in[i];
    a.out = (float*)d_out; a.ws = (unsigned char*)d_ws; a.pad = 0;
#if N_LAUNCH_MODE == 1
    a.ph_lo = 0; a.ph_hi = 1 << 30; a.li = 0;
    hipLaunchKernelGGL(fwd, dim3(grid), dim3(512), LDS_BYTES, stream, a);
#else
    for (int p = 0; p < N_PHASES; ++p) { a.ph_lo = p; a.ph_hi = p + 1; a.li = p; hipLaunchKernelGGL(fwd, dim3(grid), dim3(512), LDS_BYTES, stream, a); }
#endif
}
```

```cpp
#include <hip/hip_runtime.h>
#include <cstdio>
#include <cstdint>
namespace pg8 {
#define PG8_LAS __attribute__((address_space(3)))
typedef unsigned short bf16_t;
typedef short bf16x8 __attribute__((ext_vector_type(8)));
typedef float f32x4 __attribute__((ext_vector_type(4)));
typedef unsigned u32x4 __attribute__((ext_vector_type(4)));
constexpr int BM = 256, BK = 64, HALF = 128, HTB = HALF * BK * 2  , STAGE_BYTES = 8 * HTB, NXCD = 8, WGM = 8;

__host__ __device__ __forceinline__ int lds_byte(int r, int c) { const int st = (r >> 4) * 2 + (c >> 5), rr = r & 15, cc = c & 31, ob = rr * 64 + cc * 2; return st * 1024 + (ob ^ (((ob >> 9) & 1) << 5)); }
__host__ __device__ __forceinline__ void stage_rc(int b, int& R, int& C) { const int st = b / 1024, sb = b % 1024, swz = sb ^ (((sb >> 9) & 1) << 5); R = (st >> 1) * 16 + swz / 64; C = (st & 1) * 32 + (swz % 64) / 2; }
__host__ __device__ __forceinline__ int perm32(int rho) { const int n = rho >> 4, i = rho & 15; return 8 * (i >> 2) + 4 * n + (i & 3); }

struct Unit { int pm, pn; };
struct Gemm { const bf16_t* A; const bf16_t* Bt; int M, N, K; };

struct StaticOrder {
    int nM, nN, nwg, G, c;
    __host__ __device__ void init(int M, int N, int G_, int c_) { nM = M / BM; nN = N / BM; nwg = nM * nN; G = G_; c = c_; }
    __host__ __device__ bool next(int i, Unit& u) const {
        const long L = (long)i * G + c; if (L >= nwg) return false;
        int wgid = (int)L; { const int q = nwg / NXCD, r = nwg % NXCD, xcd = wgid % NXCD, off = wgid / NXCD; wgid = (xcd < r ? xcd * (q + 1) : r * (q + 1) + (xcd - r) * q) + off; }
        const int nig = WGM * nN, gid = wgid / nig, fm = gid * WGM, gsz = (nM - fm) < WGM ? (nM - fm) : WGM;
        u.pm = fm + ((wgid % nig) % gsz); u.pn = (wgid % nig) / gsz; return true;
    }
    __device__ __forceinline__ void a_ready(const Unit&) const {}
    __device__ __forceinline__ void done(const Unit&) const {}
};

typedef float f32x2 __attribute__((ext_vector_type(2)));
typedef __bf16 bf16x2v __attribute__((ext_vector_type(2)));
typedef unsigned u32x2 __attribute__((ext_vector_type(2)));
__device__ __forceinline__ unsigned pk2(float lo, float hi) { const bf16x2v v = __builtin_convertvector((f32x2){lo, hi}, bf16x2v); return __builtin_bit_cast(unsigned, v); }
__device__ __forceinline__ u32x4 pk8(const f32x4 a, const f32x4 b) { u32x4 w; w.x = pk2(a[0], a[1]); w.y = pk2(a[2], a[3]); w.z = pk2(b[0], b[1]); w.w = pk2(b[2], b[3]); return w; }

typedef int i32x4 __attribute__((ext_vector_type(4)));
template <bool I8> struct AccT { typedef f32x4 type; static __device__ __forceinline__ type zero() { return (f32x4){0.f, 0.f, 0.f, 0.f}; } };
template <> struct AccT<true> { typedef i32x4 type; static __device__ __forceinline__ type zero() { return (i32x4){0, 0, 0, 0}; } };
__device__ __forceinline__ f32x4 mma16(const bf16x8 b, const bf16x8 a, const f32x4 c) { return __builtin_amdgcn_mfma_f32_16x16x32_bf16(b, a, c, 0, 0, 0); }
__device__ __forceinline__ i32x4 mma16(const bf16x8 b, const bf16x8 a, const i32x4 c) { return __builtin_amdgcn_mfma_i32_16x16x64_i8(__builtin_bit_cast(i32x4, b), __builtin_bit_cast(i32x4, a), c, 0, 0, 0); }
__device__ __forceinline__ f32x4 dq4(const f32x4 a, const float, const f32x4) { return a; }
__device__ __forceinline__ f32x4 dq4(const i32x4 a, const float ra, const f32x4 cb) { return (f32x4){(float)a[0], (float)a[1], (float)a[2], (float)a[3]} * ra * cb; }
constexpr int TOK_P = 65536;

template <bool I8> struct EpiBf16P {
    static constexpr bool PERM = true, AFTER_DRAIN = false;
    bf16_t* O; int ldc; const float* sa; const float* sb;
    __device__ __forceinline__ void operator()(const typename AccT<I8>::type (&acc)[2][2][4][2], const Unit& u, int wr, int wc, int fr, int fq) const {
        const int row0 = u.pm * BM + wr * 64 + fr, col0 = u.pn * BM + wc * 32 + 8 * fq;
        f32x4 cb[2][2];
#pragma unroll
        for (int bj = 0; bj < 2; ++bj)
#pragma unroll
            for (int n = 0; n < 2; ++n) cb[bj][n] = I8 ? *(const f32x4*)(sb + col0 + bj * HALF + 4 * n) : (f32x4){1.f, 1.f, 1.f, 1.f};
        float rs[2][4];
#pragma unroll
        for (int ai = 0; ai < 2; ++ai)
#pragma unroll
            for (int m = 0; m < 4; ++m) rs[ai][m] = I8 ? sa[row0 + ai * HALF + m * 16] : 1.f;
        __builtin_amdgcn_sched_barrier(0);
#pragma unroll
        for (int ai = 0; ai < 2; ++ai)
#pragma unroll
            for (int m = 0; m < 4; ++m) { const int row = row0 + ai * HALF + m * 16; const float ra = rs[ai][m]; bf16_t* rowp = O + (size_t)row * ldc + col0;
#pragma unroll
                for (int bj = 0; bj < 2; ++bj) *(u32x4*)(rowp + bj * HALF) = pk8(dq4(acc[ai][bj][m][0], ra, cb[bj][0]), dq4(acc[ai][bj][m][1], ra, cb[bj][1])); }
    }
};
template <bool I8> struct EpiGate {
    static constexpr bool PERM = true, AFTER_DRAIN = false;
    bf16_t* U; bf16_t* Bg; const float* sa; const float* sb;
    __device__ __forceinline__ void operator()(const typename AccT<I8>::type (&acc)[2][2][4][2], const Unit& u, int wr, int wc, int fr, int fq) const {
        const int row0 = u.pm * BM + wr * 64 + fr, scol0 = u.pn * BM + wc * 32 + 8 * fq;
        f32x4 cb[2][2];
#pragma unroll
        for (int bj = 0; bj < 2; ++bj)
#pragma unroll
            for (int n = 0; n < 2; ++n) cb[bj][n] = I8 ? *(const f32x4*)(sb + scol0 + bj * HALF + 4 * n) : (f32x4){1.f, 1.f, 1.f, 1.f};
        float rs[2][4];
#pragma unroll
        for (int ai = 0; ai < 2; ++ai)
#pragma unroll
            for (int m = 0; m < 4; ++m) rs[ai][m] = I8 ? sa[row0 + ai * HALF + m * 16] : 1.f;
        __builtin_amdgcn_sched_barrier(0);
        if (u.pn < 8) {
            const int col0 = u.pn * HALF + wc * 32 + 8 * fq;
#pragma unroll
            for (int ai = 0; ai < 2; ++ai)
#pragma unroll
                for (int m = 0; m < 4; ++m) { const int row = row0 + ai * HALF + m * 16; const float ra = rs[ai][m];
                    const f32x4 v0 = dq4(acc[ai][0][m][0], ra, cb[0][0]) * dq4(acc[ai][1][m][0], ra, cb[1][0]), v1 = dq4(acc[ai][0][m][1], ra, cb[0][1]) * dq4(acc[ai][1][m][1], ra, cb[1][1]);
                    *(u32x4*)(U + (size_t)row * 1024 + col0) = pk8(v0, v1); }
        } else {
            const int col0 = (u.pn - 8) * BM + wc * 32 + 8 * fq;
#pragma unroll
            for (int ai = 0; ai < 2; ++ai)
#pragma unroll
                for (int m = 0; m < 4; ++m) { const int row = row0 + ai * HALF + m * 16; const float ra = rs[ai][m]; bf16_t* rowp = Bg + (size_t)row * 1024 + col0;
#pragma unroll
                    for (int bj = 0; bj < 2; ++bj) *(u32x4*)(rowp + bj * HALF) = pk8(dq4(acc[ai][bj][m][0], ra, cb[bj][0]), dq4(acc[ai][bj][m][1], ra, cb[bj][1])); }
        }
    }
};
template <bool I8> struct EpiRes {
    static constexpr bool PERM = true, AFTER_DRAIN = false;
    const bf16_t* H; bf16_t* R; float alpha; const float* sa; const float* sb;
    __device__ __forceinline__ void operator()(const typename AccT<I8>::type (&acc)[2][2][4][2], const Unit& u, int wr, int wc, int fr, int fq) const {
        const int row0 = u.pm * BM + wr * 64 + fr, col0 = u.pn * BM + wc * 32 + 8 * fq;
        f32x4 cb[2][2];
#pragma unroll
        for (int bj = 0; bj < 2; ++bj)
#pragma unroll
            for (int n = 0; n < 2; ++n) cb[bj][n] = I8 ? *(const f32x4*)(sb + col0 + bj * HALF + 4 * n) : (f32x4){1.f, 1.f, 1.f, 1.f};
        float rs[2][4];
#pragma unroll
        for (int ai = 0; ai < 2; ++ai)
#pragma unroll
            for (int m = 0; m < 4; ++m) rs[ai][m] = I8 ? sa[row0 + ai * HALF + m * 16] : 1.f;
        __builtin_amdgcn_sched_barrier(0);
#pragma unroll
        for (int ai = 0; ai < 2; ++ai) {
            u32x4 hq[4][2];
#pragma unroll
            for (int m = 0; m < 4; ++m)
#pragma unroll
                for (int bj = 0; bj < 2; ++bj) hq[m][bj] = *(const u32x4*)(H + (size_t)(row0 + ai * HALF + m * 16) * 1024 + col0 + bj * HALF);
            __builtin_amdgcn_sched_barrier(0);
#pragma unroll
            for (int m = 0; m < 4; ++m) { const int row = row0 + ai * HALF + m * 16; const float ra = rs[ai][m]; const size_t off = (size_t)row * 1024 + col0;
#pragma unroll
                for (int bj = 0; bj < 2; ++bj) { const u32x4 h = hq[m][bj];
                    f32x4 h0, h1; h0[0] = __uint_as_float(h.x << 16); h0[1] = __uint_as_float(h.x & 0xffff0000u); h0[2] = __uint_as_float(h.y << 16); h0[3] = __uint_as_float(h.y & 0xffff0000u);
                    h1[0] = __uint_as_float(h.z << 16); h1[1] = __uint_as_float(h.z & 0xffff0000u); h1[2] = __uint_as_float(h.w << 16); h1[3] = __uint_as_float(h.w & 0xffff0000u);
                    *(u32x4*)(R + off + bj * HALF) = pk8(h0 * alpha + dq4(acc[ai][bj][m][0], ra, cb[bj][0]), h1 * alpha + dq4(acc[ai][bj][m][1], ra, cb[bj][1])); } } }
    }
};
template <bool I8> struct EpiKV {
    static constexpr bool PERM = true, AFTER_DRAIN = false;
    bf16_t* Kb; bf16_t* Vb; float* kp; float* vp; float* ks; float* vs; const float* sa; const float* sb;
    __device__ __forceinline__ void operator()(const typename AccT<I8>::type (&acc)[2][2][4][2], const Unit& u, int wr, int wc, int fr, int fq) const {
        const bool isv = u.pn >= 4; const int colt = (isv ? u.pn - 4 : u.pn) * BM;
        bf16_t* ob = isv ? Vb : Kb; const bool samp = u.pm * BM >= TOK_P;
        float* of = samp ? (isv ? vs : ks) - (size_t)TOK_P * 1024 : (isv ? vp : kp);
        const int row0 = u.pm * BM + wr * 64 + fr, col0 = colt + wc * 32 + 8 * fq, scol0 = u.pn * BM + wc * 32 + 8 * fq;
        float rs[2][4];
#pragma unroll
        for (int ai = 0; ai < 2; ++ai)
#pragma unroll
            for (int m = 0; m < 4; ++m) rs[ai][m] = I8 ? sa[row0 + ai * HALF + m * 16] : 1.f;
        f32x4 cb[2][2];
#pragma unroll
        for (int bj = 0; bj < 2; ++bj)
#pragma unroll
            for (int n = 0; n < 2; ++n) cb[bj][n] = I8 ? *(const f32x4*)(sb + scol0 + bj * HALF + 4 * n) : (f32x4){1.f, 1.f, 1.f, 1.f};
#pragma unroll
        for (int ai = 0; ai < 2; ++ai)
#pragma unroll
            for (int m = 0; m < 4; ++m) { const int row = row0 + ai * HALF + m * 16; const float ra = rs[ai][m]; const size_t off = (size_t)row * 1024 + col0;
#pragma unroll
                for (int bj = 0; bj < 2; ++bj) { const f32x4 v0 = dq4(acc[ai][bj][m][0], ra, cb[bj][0]), v1 = dq4(acc[ai][bj][m][1], ra, cb[bj][1]);
                    *(u32x4*)(ob + off + bj * HALF) = pk8(v0, v1); *(f32x4*)(of + off + bj * HALF) = v0; *(f32x4*)(of + off + bj * HALF + 4) = v1; } }
    }
};

struct EpiScoreI8 {
    static constexpr bool PERM = true, AFTER_DRAIN = false;
    bf16_t* O; int ldc; const float* sa; const float* sb;
    __device__ __forceinline__ void operator()(const i32x4 (&acc)[2][2][4][2], const Unit& u, int wr, int wc, int fr, int fq) const {
        const int row0 = u.pm * BM + wr * 64 + fr, col0 = u.pn * BM + wc * 32 + 8 * fq;
        f32x4 cb[2][2];
#pragma unroll
        for (int bj = 0; bj < 2; ++bj)
#pragma unroll
            for (int n = 0; n < 2; ++n) cb[bj][n] = *(const f32x4*)(sb + col0 + bj * HALF + 4 * n);
        float rs[2][4];
#pragma unroll
        for (int ai = 0; ai < 2; ++ai)
#pragma unroll
            for (int m = 0; m < 4; ++m) rs[ai][m] = sa[row0 + ai * HALF + m * 16];
        __builtin_amdgcn_sched_barrier(0);
#pragma unroll
        for (int ai = 0; ai < 2; ++ai)
#pragma unroll
            for (int m = 0; m < 4; ++m) { const int row = row0 + ai * HALF + m * 16; const float ra = rs[ai][m]; bf16_t* rowp = O + (size_t)row * ldc + col0;
#pragma unroll
                for (int bj = 0; bj < 2; ++bj) { f32x4 v0, v1;
#pragma unroll
                    for (int i = 0; i < 4; ++i) { v0[i] = (float)acc[ai][bj][m][0][i] * ra * cb[bj][0][i]; v1[i] = (float)acc[ai][bj][m][1][i] * ra * cb[bj][1][i]; }
                    *(u32x4*)(rowp + bj * HALF) = pk8(v0, v1); } }
    }
};

template <class Epi, class Sched, bool ALIGN_EPI = false, bool SP2 = false, bool I8 = false>
__device__ __forceinline__ void gemm_phase(PG8_LAS unsigned char* lds, const Gemm g, const Sched& S, const Epi& E, const int tid_in) {
    int tid_ = tid_in; asm volatile("" : "+v"(tid_));
    const int tid = tid_, wid = __builtin_amdgcn_readfirstlane(tid >> 6), lane = tid & 63, wr = wid >> 2, wc = wid & 3, fr = lane & 15, fq = lane >> 4;
    const int K = g.K, nt = K / BK;
    unsigned voffA[2], voffB[2];
#pragma unroll
    for (int i = 0; i < 2; ++i) { int R, C; stage_rc(tid * 16 + i * 8192, R, C); const int Rb = Epi::PERM ? ((R & ~31) + perm32(R & 31)) : R;
        voffA[i] = (unsigned)(R * K + C) * 2u; voffB[i] = (unsigned)(Rb * K + C) * 2u; }
    const size_t kstep = (size_t)(BK * 2);
    const size_t hstep = (size_t)HALF * K * 2;
    const size_t tstep = 2 * hstep;
    const unsigned ldsw = (unsigned)wid * 1024u;
    const int aoff = lds_byte(wr * 64 + fr, fq * 8), boff = lds_byte(wc * 32 + fr, fq * 8);
#define PG8_SA(b, h) (((b) * 2 + (h)) * HTB)
#define PG8_SB(b, h) ((4 + (b) * 2 + (h)) * HTB)
#define PG8_STAGE(bufoff, gbase, voff) do { _Pragma("unroll") for (int _i = 0; _i < 2; ++_i) \
        __builtin_amdgcn_global_load_lds((const unsigned*)((const char*)(gbase) + (voff)[_i]), (PG8_LAS unsigned*)(lds + (bufoff) + ldsw + _i * 8192), 16, 0, 0); } while (0)
#define PG8_LDA(dst, b, h) do { _Pragma("unroll") for (int m = 0; m < 4; ++m) _Pragma("unroll") for (int k = 0; k < 2; ++k) dst[m][k] = *(const PG8_LAS bf16x8*)(lds + PG8_SA(b, h) + aoff + m * 2048 + k * 1024); } while (0)
#define PG8_LDB(dst, b, h) do { _Pragma("unroll") for (int n = 0; n < 2; ++n) _Pragma("unroll") for (int k = 0; k < 2; ++k) dst[n][k] = *(const PG8_LAS bf16x8*)(lds + PG8_SB(b, h) + boff + n * 2048 + k * 1024); } while (0)
#define PG8_MMA(ai, bj, At, Bt) do { __builtin_amdgcn_s_setprio(1); _Pragma("unroll") for (int m = 0; m < 4; ++m) _Pragma("unroll") for (int n = 0; n < 2; ++n) _Pragma("unroll") for (int k = 0; k < 2; ++k) \
        acc[ai][bj][m][n] = mma16(Bt[n][k], At[m][k], acc[ai][bj][m][n]); __builtin_amdgcn_s_setprio(0); } while (0)
#define PG8_WAIT_V(n) asm volatile("s_waitcnt vmcnt(" #n ")" ::: "memory")
#define PG8_WAIT_L(n) asm volatile("s_waitcnt lgkmcnt(" #n ")" ::: "memory")
#define PG8_BAR __builtin_amdgcn_s_barrier()
#define PG8_SCHED __builtin_amdgcn_sched_barrier(0)
    Unit cur, nxt; int ui = 0;
    if (!S.next(0, cur)) return;
    typename AccT<I8>::type acc[2][2][4][2];
#pragma unroll
    for (int a = 0; a < 2; ++a)
#pragma unroll
        for (int b = 0; b < 2; ++b)
#pragma unroll
            for (int m = 0; m < 4; ++m)
#pragma unroll
                for (int n = 0; n < 2; ++n) acc[a][b][m][n] = AccT<I8>::zero();
    bf16x8 At[4][2], B0[2][2], B1[2][2];
    const char* cA = (const char*)g.A + (size_t)cur.pm * tstep; const char* cB = (const char*)g.Bt + (size_t)cur.pn * tstep;
    S.a_ready(cur);
    if constexpr (SP2) {
        PG8_STAGE(PG8_SB(0, 0), cB, voffB); PG8_STAGE(PG8_SB(0, 1), cB + hstep, voffB); PG8_STAGE(PG8_SA(0, 0), cA, voffA); PG8_STAGE(PG8_SA(0, 1), cA + hstep, voffA);
        if (wr == 1) PG8_BAR;
        PG8_WAIT_V(2); PG8_BAR;
        PG8_STAGE(PG8_SB(1, 0), cB + kstep, voffB); PG8_STAGE(PG8_SA(1, 0), cA + kstep, voffA); PG8_STAGE(PG8_SB(1, 1), cB + hstep + kstep, voffB);
        PG8_WAIT_V(6); PG8_BAR;
    } else {
        PG8_STAGE(PG8_SB(0, 0), cB, voffB); PG8_STAGE(PG8_SA(0, 0), cA, voffA); PG8_STAGE(PG8_SB(0, 1), cB + hstep, voffB); PG8_STAGE(PG8_SA(0, 1), cA + hstep, voffA);
        if (wr == 1) PG8_BAR;
        PG8_WAIT_V(4); PG8_BAR;
        PG8_STAGE(PG8_SB(1, 0), cB + kstep, voffB); PG8_STAGE(PG8_SA(1, 0), cA + kstep, voffA); PG8_STAGE(PG8_SB(1, 1), cB + hstep + kstep, voffB);
        PG8_WAIT_V(6); PG8_BAR;
    }
    for (;;) {
        const bool has_next = S.next(ui + 1, nxt);
        const char* nA = has_next ? (const char*)g.A + (size_t)nxt.pm * tstep : cA; const char* nB = has_next ? (const char*)g.Bt + (size_t)nxt.pn * tstep : cB;
        for (int t = 0; t < nt; t += 2) {
            const bool last = (t == nt - 2);
            const char* a1 = cA + (size_t)(t + 1) * kstep;
            const char* a2 = last ? nA : cA + (size_t)(t + 2) * kstep; const char* b2 = last ? nB : cB + (size_t)(t + 2) * kstep;
            const char* a3 = a2 + kstep; const char* b3 = b2 + kstep;
            if (last && has_next) S.a_ready(nxt);
            if constexpr (SP2) {
            PG8_LDB(B0, 0, 0); PG8_LDB(B1, 0, 1); PG8_SCHED; PG8_LDA(At, 0, 0); PG8_STAGE(PG8_SA(1, 1), a1 + hstep, voffA);
            PG8_WAIT_V(8); PG8_WAIT_L(0); PG8_BAR; PG8_MMA(0, 0, At, B0); PG8_MMA(0, 1, At, B1); PG8_BAR; PG8_SCHED;
            PG8_LDA(At, 0, 1); PG8_STAGE(PG8_SB(0, 0), b2, voffB); PG8_STAGE(PG8_SB(0, 1), b2 + hstep, voffB); PG8_STAGE(PG8_SA(0, 0), a2, voffA);
            PG8_WAIT_V(8); PG8_WAIT_L(0); PG8_BAR; PG8_MMA(1, 0, At, B0); PG8_MMA(1, 1, At, B1); PG8_BAR; PG8_SCHED;
            PG8_LDB(B0, 1, 0); PG8_LDB(B1, 1, 1); PG8_SCHED; PG8_LDA(At, 1, 0); PG8_STAGE(PG8_SA(0, 1), a2 + hstep, voffA);
            PG8_WAIT_V(8); PG8_WAIT_L(0); PG8_BAR; PG8_MMA(0, 0, At, B0); PG8_MMA(0, 1, At, B1); PG8_BAR; PG8_SCHED;
            PG8_LDA(At, 1, 1); PG8_STAGE(PG8_SB(1, 0), b3, voffB); PG8_STAGE(PG8_SB(1, 1), b3 + hstep, voffB); PG8_STAGE(PG8_SA(1, 0), a3, voffA);
            PG8_WAIT_V(8); PG8_WAIT_L(0); PG8_BAR; PG8_MMA(1, 0, At, B0); PG8_MMA(1, 1, At, B1); PG8_BAR; PG8_SCHED;
            } else {
            PG8_LDB(B0, 0, 0); PG8_SCHED; PG8_LDA(At, 0, 0); PG8_STAGE(PG8_SA(1, 1), a1 + hstep, voffA);
            PG8_WAIT_L(8); PG8_BAR; PG8_WAIT_L(0); PG8_MMA(0, 0, At, B0); PG8_BAR; PG8_SCHED;
            PG8_LDB(B1, 0, 1); PG8_STAGE(PG8_SB(0, 0), b2, voffB);
            PG8_BAR; PG8_WAIT_L(0); PG8_MMA(0, 1, At, B1); PG8_BAR;
            PG8_LDA(At, 0, 1); PG8_STAGE(PG8_SA(0, 0), a2, voffA);
            PG8_BAR; PG8_WAIT_L(0); PG8_MMA(1, 0, At, B0); PG8_BAR; PG8_SCHED;
            PG8_STAGE(PG8_SB(0, 1), b2 + hstep, voffB);
            PG8_WAIT_V(6); PG8_BAR; PG8_MMA(1, 1, At, B1); PG8_BAR;
            PG8_LDB(B0, 1, 0); PG8_SCHED; PG8_LDA(At, 1, 0); PG8_STAGE(PG8_SA(0, 1), a2 + hstep, voffA);
            PG8_WAIT_L(8); PG8_BAR; PG8_WAIT_L(0); PG8_MMA(0, 0, At, B0); PG8_BAR; PG8_SCHED;
            PG8_LDB(B1, 1, 1); PG8_STAGE(PG8_SB(1, 0), b3, voffB);
            PG8_BAR; PG8_WAIT_L(0); PG8_MMA(0, 1, At, B1); PG8_BAR;
            PG8_LDA(At, 1, 1); PG8_STAGE(PG8_SA(1, 0), a3, voffA);
            PG8_BAR; PG8_WAIT_L(0); PG8_MMA(1, 0, At, B0); PG8_BAR; PG8_SCHED;
            PG8_STAGE(PG8_SB(1, 1), b3 + hstep, voffB);
            PG8_WAIT_V(6); PG8_BAR; PG8_MMA(1, 1, At, B1); PG8_BAR;
            }
        }
        if constexpr (ALIGN_EPI) { if (wr == 0) PG8_BAR; }
        if constexpr (!Epi::AFTER_DRAIN) { E(acc, cur, wr, wc, fr, fq); S.done(cur); }
        if (!has_next) break;
#pragma unroll
        for (int a = 0; a < 2; ++a)
#pragma unroll
            for (int b = 0; b < 2; ++b)
#pragma unroll
                for (int m = 0; m < 4; ++m)
#pragma unroll
                    for (int n = 0; n < 2; ++n) acc[a][b][m][n] = AccT<I8>::zero();
        cur = nxt; cA = nA; cB = nB; ++ui;
        if constexpr (ALIGN_EPI) { if (wr == 1) PG8_BAR; }
    }
    PG8_WAIT_V(0);
    if constexpr (!ALIGN_EPI) { if (wr == 0) PG8_BAR; }
    PG8_BAR;
    if constexpr (Epi::AFTER_DRAIN) { E.fused(acc, cur, wr, wc, fr, fq, lds, wid, lane); S.done(cur); }
#undef PG8_SA
#undef PG8_SB
#undef PG8_STAGE
#undef PG8_LDA
#undef PG8_LDB
#undef PG8_MMA
#undef PG8_WAIT_V
#undef PG8_WAIT_L
#undef PG8_BAR
#undef PG8_SCHED
}
}

#define GAS __attribute__((address_space(1)))
#define LAS __attribute__((address_space(3)))
#define DI __device__ __forceinline__
typedef unsigned short bf16;
typedef unsigned v4u __attribute__((ext_vector_type(4)));
typedef unsigned v2u __attribute__((ext_vector_type(2)));
typedef float f32x4 __attribute__((ext_vector_type(4)));
typedef float f32x16 __attribute__((ext_vector_type(16)));
typedef short bf16x8 __attribute__((ext_vector_type(8)));
using pg8::pk2;
#define LDS_WAIT() asm volatile("s_waitcnt lgkmcnt(0)" ::: "memory")
#define MFMA32(a, b, c) __builtin_amdgcn_mfma_f32_32x32x16_bf16((a), (b), (c), 0, 0, 0)

constexpr int D = 1024, NB = 32, SEQ = 2048, DSEQ = 16, PAST = 1024, NH = 16, DH = 64;
constexpr int TP = NB * SEQ, TS = NB * DSEQ, T = TP + TS;
constexpr int NEXP = 16384, PH = 8, PK = 16;
constexpr int NLAYER = 4;
constexpr float LN_EPS = 1e-5f;
constexpr float ALPHA = 1.6817928305074292f;
constexpr float LOG2E = 1.4426950408889634f, LN2 = 0.6931471805599453f;
static_assert(T % 256 == 0 && pg8::TOK_P == TP, "row panels");
constexpr size_t O_Y = 0, O_YS = (size_t)TP * D, O_CONVP = O_YS + (size_t)TS * D, O_KP = O_CONVP + 2 * NB * 2 * D, O_VP = O_KP + (size_t)TP * D,
                 O_CONVS = O_VP + (size_t)TP * D, O_KS = O_CONVS + 2 * NB * 2 * D, O_VS = O_KS + (size_t)TS * D, O_END = O_VS + (size_t)TS * D;
static_assert(O_END == 203161600ull, "output size");
constexpr size_t MiB = 1u << 20;
constexpr size_t WS_CTL = 0, CTL_BYTES = 2 * MiB;
constexpr size_t WS_WIN = 2 * MiB;
constexpr size_t WS_WOUT = WS_WIN + 12 * MiB;
constexpr size_t WS_WQ = WS_WOUT + 4 * MiB;
constexpr size_t WS_WO = WS_WQ + 4 * MiB;
constexpr size_t WS_WKV = WS_WO + 4 * MiB;
constexpr size_t WS_WP = WS_WKV + 4 * MiB;
constexpr size_t WS_VSN = WS_WP + 16 * MiB;
constexpr size_t WS_H = WS_VSN + 1 * MiB;
constexpr size_t WS_KB = WS_H + 129 * MiB;
constexpr size_t WS_VT = WS_KB + 129 * MiB;
constexpr size_t WS_IDS = WS_VT + 128 * MiB;
constexpr size_t WS_GATE = WS_IDS + 17 * MiB;
constexpr size_t WS_TU = WS_GATE + 33 * MiB;
constexpr size_t WS_TV = WS_TU + 64 * MiB;
constexpr size_t WS_SU = WS_TV + 64 * MiB;
constexpr size_t WS_W8 = WS_SU + 1 * MiB;
constexpr size_t WS_SX = WS_W8 + 9 * MiB;
constexpr size_t WS_X8 = WS_SX + 1 * MiB;
constexpr size_t WS_W8A = WS_X8 + 65 * MiB;
constexpr size_t WS_SWA = WS_W8A + 22 * MiB;
constexpr int W8_ROWS = (int)((WS_VSN - WS_WIN) / 2048);
static_assert(W8_ROWS == 22528, "weight rows");
constexpr size_t WS_A = WS_SWA + 1 * MiB;
constexpr size_t WS_END = WS_A + 258 * MiB;
static_assert((size_t)T * D * 2 == 129 * MiB && (size_t)1024 * T * 4 == 258 * MiB, "sizes");
constexpr int CW_Q = 1024;
constexpr int CW_BAR = 16384;

constexpr int RING_BYTES = 131072, MISC_OFF = RING_BYTES + 320, LDS_BYTES = 147456;

#define XB_TMO      128
#define XB_XCNT(j)  (256  + 64 * (j))
#define XB_XSUB(j)  (1280 + 64 * (j))
#define XB_XGEN(j)  (2304 + 64 * (j))
#define XB_TOP      3328
#define XB_TOPGEN   3392
#define XCD_BAR_WORDS 3456
#define XB_SPIN_CAP (1u << 18)

__device__ __forceinline__ unsigned xb_ld(unsigned* p)              { return __hip_atomic_load(p, __ATOMIC_RELAXED, __HIP_MEMORY_SCOPE_AGENT); }
__device__ __forceinline__ unsigned xb_add(unsigned* p, unsigned v) { return __hip_atomic_fetch_add(p, v, __ATOMIC_RELAXED, __HIP_MEMORY_SCOPE_AGENT); }
__device__ __forceinline__ unsigned xb_xcc_id() { return (unsigned)__builtin_amdgcn_s_getreg((3 << 11) | 20) & 0xFu; }
#define XB_SPIN(cond, bar) do { unsigned _sp = 0; while (cond) { __builtin_amdgcn_s_sleep(1); \
    if ((++_sp & 255u) == 0u) { if (xb_ld(&(bar)[XB_TMO])) break; if (_sp > XB_SPIN_CAP) { atomicAdd(&(bar)[XB_TMO], 1u); break; } } } } while (0)

__device__ __forceinline__ int xb_lane_id() { int l; asm volatile("v_mbcnt_lo_u32_b32 %0, -1, 0\n\tv_mbcnt_hi_u32_b32 %0, -1, %0" : "=v"(l)); return l; }
__device__ __forceinline__ bool xb_is_thread0(unsigned w0) { return w0 != 0u && xb_lane_id() == 0; }
struct XcdBarrier {
    unsigned w0;
    unsigned* bar; unsigned x;
    volatile LAS unsigned* st;
};

__device__ __forceinline__ XcdBarrier xcd_barrier_post(unsigned* bar, volatile LAS unsigned* st, unsigned w0) {
    XcdBarrier b; b.w0 = w0; b.bar = bar; b.x = xb_xcc_id(); b.st = st;
    if (xb_is_thread0(b.w0)) (void)xb_add(&bar[XB_XCNT(b.x)], 1u);
    return b;
}
__device__ __forceinline__ void xcd_barrier_complete(unsigned* bar, unsigned x, unsigned& nloc, unsigned& nx) {
    const unsigned G = gridDim.x * gridDim.y * gridDim.z;
    unsigned sum, cnt, mine, sp = 0u;
    for (;;) {
        sum = 0u; cnt = 0u; mine = 0u;
#pragma unroll
        for (unsigned j = 0; j < 16; ++j) { const unsigned c = xb_ld(&bar[XB_XCNT(j)]); sum += c; cnt += (c > 0u) ? 1u : 0u; mine = (j == x) ? c : mine; }
        if (sum == G) break;
        __builtin_amdgcn_s_sleep(1);
        if ((++sp & 255u) == 0u) { if (xb_ld(&bar[XB_TMO])) break; if (sp > XB_SPIN_CAP) { atomicAdd(&bar[XB_TMO], 1u); break; } }
    }
    nloc = mine > 0u ? mine : 1u; nx = cnt > 0u ? cnt : 1u;
}

__device__ __forceinline__ void xcd_barrier(const XcdBarrier& b) {
    asm volatile("s_waitcnt vmcnt(0)" ::: "memory");
    __syncthreads();
    if (xb_is_thread0(b.w0)) {
        unsigned* bar = b.bar;
        __builtin_amdgcn_s_waitcnt(0);
        unsigned nloc = b.st[0], nx = b.st[1];
        if (nloc == 0u) { xcd_barrier_complete(bar, b.x, nloc, nx); b.st[0] = nloc; b.st[1] = nx; }
        const unsigned old = xb_add(&bar[XB_XSUB(b.x)], 1u);
        const unsigned gen = old / nloc;
        if (old + 1u == (gen + 1u) * nloc) {
            __builtin_amdgcn_fence(__ATOMIC_RELEASE, "agent");
            asm volatile("s_waitcnt vmcnt(0)" ::: "memory");
            const unsigned og = xb_add(&bar[XB_TOP], 1u);
            const unsigned tg = og / nx;
            if (og + 1u == (tg + 1u) * nx) xb_add(&bar[XB_TOPGEN], 1u);
            else XB_SPIN(xb_ld(&bar[XB_TOPGEN]) == tg, bar);
            __builtin_amdgcn_fence(__ATOMIC_ACQUIRE, "agent");
            xb_add(&bar[XB_XGEN(b.x)], 1u);
            asm volatile("s_waitcnt vmcnt(0)" ::: "memory");
        } else {
            XB_SPIN(xb_ld(&bar[XB_XGEN(b.x)]) == gen, bar);
            __builtin_amdgcn_fence(__ATOMIC_ACQUIRE, "agent");
            asm volatile("s_waitcnt vmcnt(0)" ::: "memory");
        }
    }
    __syncthreads();
}


DI float bflo(unsigned w) { return __uint_as_float(w << 16); }
DI float bfhi(unsigned w) { return __uint_as_float(w & 0xffff0000u); }
DI int shx(const int lane, const int v, const int o) {
    if (o == 1) return __builtin_amdgcn_update_dpp(v, v, 0xB1, 0xf, 0xf, false);
    if (o == 2) return __builtin_amdgcn_update_dpp(v, v, 0x4E, 0xf, 0xf, false);
    if (o == 8) return __builtin_amdgcn_update_dpp(v, v, 0x128, 0xf, 0xf, false);
    if (o == 4) return __builtin_amdgcn_ds_swizzle(v, 0x101F);
    if (o == 16) return __builtin_amdgcn_ds_swizzle(v, 0x401F);
    return __builtin_amdgcn_ds_bpermute((lane ^ o) << 2, v);
}
DI float shx(const int lane, const float v, const int o) { return __int_as_float(shx(lane, __float_as_int(v), o)); }
template <int CTRL> DI float dpp_f(const float v) { return __int_as_float(__builtin_amdgcn_update_dpp(__float_as_int(v), __float_as_int(v), CTRL, 0xf, 0xf, false)); }
DI float wave_sum(const int lane, float v) {
    (void)lane;
    v += dpp_f<0xB1>(v); v += dpp_f<0x4E>(v); v += dpp_f<0x141>(v); v += dpp_f<0x140>(v);
    { const auto r = __builtin_amdgcn_permlane16_swap(__float_as_uint(v), __float_as_uint(v), false, false); v = __uint_as_float(r[0]) + __uint_as_float(r[1]); }
    { const auto r = __builtin_amdgcn_permlane32_swap(__float_as_uint(v), __float_as_uint(v), false, false); v = __uint_as_float(r[0]) + __uint_as_float(r[1]); }
    return v;
}
DI float max32(float v) {
    v = __builtin_fmaxf(v, dpp_f<0xB1>(v)); v = __builtin_fmaxf(v, dpp_f<0x4E>(v)); v = __builtin_fmaxf(v, dpp_f<0x141>(v)); v = __builtin_fmaxf(v, dpp_f<0x140>(v));
    { const auto r = __builtin_amdgcn_permlane16_swap(__float_as_uint(v), __float_as_uint(v), false, false); v = __builtin_fmaxf(__uint_as_float(r[0]), __uint_as_float(r[1])); }
    return v;
}
DI float wave_max(float v) {
    v = max32(v);
    { const auto r = __builtin_amdgcn_permlane32_swap(__float_as_uint(v), __float_as_uint(v), false, false); v = __builtin_fmaxf(__uint_as_float(r[0]), __uint_as_float(r[1])); }
    return v;
}
DI bf16x8 pack8(float a0, float a1, float a2, float a3, float a4, float a5, float a6, float a7) {
    v4u p; p.x = pk2(a0, a1); p.y = pk2(a2, a3); p.z = pk2(a4, a5); p.w = pk2(a6, a7); return __builtin_bit_cast(bf16x8, p);
}
DI float gelu_erf(float v) {
    const float av = __builtin_fabsf(v), d = av * 0.2316418882f + 1.0f, t = __builtin_amdgcn_rcpf(d);
    float q = t * 0.5307027145f + (-0.7265760135f); q = q * t + 0.7107068705f; q = q * t + (-0.142248368f); q = q * t + 0.127414796f; q = q * t;
    const float e = __builtin_amdgcn_exp2f((v * v) * (-0.72134752044f));
    const float m = v * (q * e), r = v - m;
    return v < 0.f ? m : r;
}

struct Ctx {
    int tid, lane, wave, vcu, G;
};

DI void p0_transpose_item(const float* W, int K, int N, bf16* WT, int out_row0, float scale, LAS float* scr, int k0, int n0, int lane) {
#pragma unroll 8
    for (int i = 0; i < 32; ++i) { const int kk = 2 * i + (lane >> 5); scr[kk * 33 + (lane & 31)] = W[(size_t)(k0 + kk) * N + n0 + (lane & 31)]; }
    LDS_WAIT(); asm volatile("" ::: "memory");
    const int c = lane & 7;
#pragma unroll
    for (int j = 0; j < 4; ++j) { const int n = (lane >> 3) + 8 * j; const LAS float* s = scr + (8 * c) * 33 + n;
        v4u o; o.x = pk2(s[0 * 33] * scale, s[1 * 33] * scale); o.y = pk2(s[2 * 33] * scale, s[3 * 33] * scale); o.z = pk2(s[4 * 33] * scale, s[5 * 33] * scale); o.w = pk2(s[6 * 33] * scale, s[7 * 33] * scale);
        *(v4u*)(WT + (size_t)(out_row0 + n) * K + k0 + 8 * c) = o; }
    LDS_WAIT(); asm volatile("" ::: "memory");
}
DI void cvt_stream(const float* src, bf16* dst, size_t n8, size_t gtid, size_t NT) {
    size_t i = gtid;
    for (; i + 3 * NT < n8; i += 4 * NT) {
        f32x4 a[4], b[4];
#pragma unroll
        for (int u = 0; u < 4; ++u) { a[u] = *(const f32x4*)(src + (i + u * NT) * 8); b[u] = *(const f32x4*)(src + (i + u * NT) * 8 + 4); }
#pragma unroll
        for (int u = 0; u < 4; ++u) *(v4u*)(dst + (i + u * NT) * 8) = pg8::pk8(a[u], b[u]);
    }
    for (; i < n8; i += NT) { const f32x4 a = *(const f32x4*)(src + i * 8), b = *(const f32x4*)(src + i * 8 + 4); *(v4u*)(dst + i * 8) = pg8::pk8(a, b); }
}
DI unsigned q4_i8(const f32x4 v, const float k) {
    const int a = (int)__builtin_rintf(v[0] * k), b = (int)__builtin_rintf(v[1] * k), c = (int)__builtin_rintf(v[2] * k), d = (int)__builtin_rintf(v[3] * k);
    return ((unsigned)a & 0xffu) | (((unsigned)b & 0xffu) << 8) | (((unsigned)c & 0xffu) << 16) | ((unsigned)d << 24);
}
DI void cvt_table_rows(const float* src, unsigned char* dst, float* scl  , int nrows, int gw, int NGW, int lane) {
    f32x4 nx[4];
#pragma unroll
    for (int j = 0; j < 4; ++j) nx[j] = *(const f32x4*)(src + (size_t)(gw < nrows ? gw : 0) * D + 4 * lane + 256 * j);
    for (int row = gw; row < nrows; row += NGW) {
        f32x4 v[4]; float m = 0.f; const int rn = row + NGW < nrows ? row + NGW : row;
#pragma unroll
        for (int j = 0; j < 4; ++j) { v[j] = nx[j]; nx[j] = *(const f32x4*)(src + (size_t)rn * D + 4 * lane + 256 * j);
            m = __builtin_fmaxf(m, __builtin_fmaxf(__builtin_fmaxf(__builtin_fabsf(v[j][0]), __builtin_fabsf(v[j][1])), __builtin_fmaxf(__builtin_fabsf(v[j][2]), __builtin_fabsf(v[j][3])))); }
        m = wave_max(m);
        const float k = m > 0.f ? 127.0f / m : 0.f;
#pragma unroll
        for (int j = 0; j < 4; ++j)
            *(unsigned*)(dst + ((size_t)(row >> 14) * NEXP * D) + ((size_t)(2 * j + (lane >> 5)) * NEXP + (row & (NEXP - 1))) * 128 + ((4 * lane) & 127)) = q4_i8(v[j], k);
        if (lane == 0) scl[2 * row] = m * (1.0f / 127.0f);
    }
}
struct P0Args { const float *x_p, *x_s, *w_in, *w_out, *wq, *wo, *wk, *wv, *pwq, *psk, *pu, *pv; bf16 *WinT, *WoutT, *WqT, *WoT, *WkvT, *WP, *H; unsigned char *TU, *TV; float *SU, *SV; unsigned char* X8; float* SX; };
DI void p0_prologue(const Ctx c, LAS unsigned char* lds, const P0Args a) {
    for (int half = 0; half < 2; ++half) {
    if (((c.vcu & 1) == 1) == (half == 0)) {
    { LAS float* scr = (LAS float*)(lds + c.wave * 16384);
      const int gw = c.vcu * 8 + c.wave, NGW = c.G * 8;
      constexpr int IT_WIN = 16 * 96, IT_SQ = 16 * 32, NITEMS = 2 * IT_WIN + 8 * IT_SQ;
      for (int it = gw; it < NITEMS; it += NGW) {
          int r = it;
          if (r < 2 * IT_WIN) { const int l = r / IT_WIN; r -= l * IT_WIN; const int kb = r / 96, nb = r % 96, n0 = 32 * nb; int orow;
              if (n0 < 1024) orow = 2048 + n0; else if (n0 < 2048) { const int d = n0 - 1024; orow = 256 * (d >> 7) + (d & 127); } else { const int d = n0 - 2048; orow = 256 * (d >> 7) + 128 + (d & 127); }
              p0_transpose_item(a.w_in + (size_t)l * 1024 * 3072, 1024, 3072, a.WinT + (size_t)l * 3072 * 1024, orow, 1.f, scr, 64 * kb, n0, c.lane); continue; }
          r -= 2 * IT_WIN; const int m = r / IT_SQ; r -= m * IT_SQ; const int kb = r >> 5, nb = r & 31;
          const float* src; bf16* dst; float sc = 1.f; const size_t SQ = (size_t)1024 * 1024;
          if (m < 2) { src = a.w_out + m * SQ; dst = a.WoutT + m * SQ; }
          else if (m < 4) { src = a.wq + (m - 2) * SQ; dst = a.WqT + (m - 2) * SQ; sc = 0.125f * LOG2E; }
          else if (m < 6) { src = a.wo + (m - 4) * SQ; dst = a.WoT + (m - 4) * SQ; }
          else if (m == 6) { src = a.wk; dst = a.WkvT; }
          else { src = a.wv; dst = a.WkvT + SQ; }
          p0_transpose_item(src, 1024, 1024, dst, 32 * nb, sc, scr, 64 * kb, 32 * nb, c.lane);
      }
    }
    __syncthreads();
    { LAS float* skT = (LAS float*)lds; LAS float* wqT = skT + 128 * 132;
      for (int u = c.vcu; u < 4 * 16 * 16; u += c.G) {
          const int l = u >> 8, hp = (u >> 4) & 15, dblk = u & 15;
          for (int i = c.tid; i < 16384; i += 512) skT[(i & 127) * 132 + (i >> 7)] = a.psk[(size_t)(l * 16 + hp) * 16384 + i];
          for (int i = c.tid; i < 8192; i += 512) wqT[(i & 127) * 68 + (i >> 7)] = a.pwq[((size_t)l * 1024 + dblk * 64 + (i >> 7)) * 2048 + hp * 128 + (i & 127)];
          __syncthreads();
          const int ng = c.tid & 31, dg = c.tid >> 5; f32x4 acc[4];
#pragma unroll
          for (int i = 0; i < 4; ++i) acc[i] = (f32x4){0.f, 0.f, 0.f, 0.f};
#pragma unroll 4
          for (int cc = 0; cc < 128; ++cc) { const f32x4 s = *(const LAS f32x4*)(skT + cc * 132 + 4 * ng), w = *(const LAS f32x4*)(wqT + cc * 68 + 4 * dg);
#pragma unroll
              for (int i = 0; i < 4; ++i) acc[i] = acc[i] + w * s[i]; }
#pragma unroll
          for (int i = 0; i < 4; ++i) { v2u o; o.x = pk2(acc[i][0], acc[i][1]); o.y = pk2(acc[i][2], acc[i][3]);
              *(v2u*)(a.WP + ((size_t)l * 2048 + hp * 128 + 4 * ng + i) * 1024 + dblk * 64 + 4 * dg) = o; }
          __syncthreads();
      }
    }
    } else {
    { const size_t gtid = (size_t)c.vcu * 512 + c.tid, NT = (size_t)c.G * 512;
      cvt_table_rows(a.pu, a.TU, a.SU, NLAYER * NEXP, c.vcu * 8 + c.wave, c.G * 8, c.lane);
      cvt_table_rows(a.pv, a.TV, a.SV, NLAYER * NEXP, c.vcu * 8 + c.wave, c.G * 8, c.lane);
      (void)gtid; (void)NT;
      for (int m = c.vcu * 8 + c.wave; m < T; m += c.G * 8) {
          const float* xr = (m < TP ? a.x_p + (size_t)m * D : a.x_s + (size_t)(m - TP) * D) + 4 * c.lane;
          f32x4 v[4]; float am = 0.f;
#pragma unroll
          for (int j = 0; j < 4; ++j) { v[j] = *(const f32x4*)(xr + 256 * j); v2u w; w.x = pk2(v[j][0], v[j][1]); w.y = pk2(v[j][2], v[j][3]); ((v2u*)(a.H + (size_t)m * D) + c.lane)[64 * j] = w;
              am = __builtin_fmaxf(am, __builtin_fmaxf(__builtin_fmaxf(__builtin_fabsf(v[j][0]), __builtin_fabsf(v[j][1])), __builtin_fmaxf(__builtin_fabsf(v[j][2]), __builtin_fabsf(v[j][3])))); }
          am = wave_max(am);
          const float k = am > 0.f ? 127.0f / am : 0.f;
#pragma unroll
          for (int j = 0; j < 4; ++j) *(unsigned*)(a.X8 + (size_t)m * D + 4 * c.lane + 256 * j) = q4_i8(v[j], k);
          if (c.lane == 0) a.SX[m] = am * (1.0f / 127.0f);
      }
    }
    }
    __syncthreads();
    }
}

DI void wp_quant_phase(const Ctx c, const bf16* WPb, unsigned char* WP8q, float* swp) {
    for (int row = c.vcu * 8 + c.wave; row < W8_ROWS; row += c.G * 8) {
        const v4u a = *(const v4u*)(WPb + (size_t)row * D + 16 * c.lane), b = *(const v4u*)(WPb + (size_t)row * D + 16 * c.lane + 8);
        const f32x4 v0 = {bflo(a.x), bfhi(a.x), bflo(a.y), bfhi(a.y)}, v1 = {bflo(a.z), bfhi(a.z), bflo(a.w), bfhi(a.w)}, v2 = {bflo(b.x), bfhi(b.x), bflo(b.y), bfhi(b.y)}, v3 = {bflo(b.z), bfhi(b.z), bflo(b.w), bfhi(b.w)};
        float m = 0.f;
#pragma unroll
        for (int i = 0; i < 4; ++i) m = __builtin_fmaxf(m, __builtin_fmaxf(__builtin_fmaxf(__builtin_fabsf(v0[i]), __builtin_fabsf(v1[i])), __builtin_fmaxf(__builtin_fabsf(v2[i]), __builtin_fabsf(v3[i]))));
        m = wave_max(m);
        const float k = m > 0.f ? 127.0f / m : 0.f;
        v4u o; o.x = q4_i8(v0, k); o.y = q4_i8(v1, k); o.z = q4_i8(v2, k); o.w = q4_i8(v3, k);
        *(v4u*)(WP8q + (size_t)row * D + 16 * c.lane) = o;
        if (c.lane == 0) swp[row] = m * (1.0f / 127.0f);
    }
}

DI void ld8_bf16(const bf16* p, float (&o)[8]) { const v4u w = *(const v4u*)p; o[0] = bflo(w.x); o[1] = bfhi(w.x); o[2] = bflo(w.y); o[3] = bfhi(w.y); o[4] = bflo(w.z); o[5] = bfhi(w.z); o[6] = bflo(w.w); o[7] = bfhi(w.w); }
DI void ld8_f32(const float* p, float (&o)[8]) { const f32x4 a = *(const f32x4*)p, b = *(const f32x4*)(p + 4); o[0] = a[0]; o[1] = a[1]; o[2] = a[2]; o[3] = a[3]; o[4] = b[0]; o[5] = b[1]; o[6] = b[2]; o[7] = b[3]; }
DI void conv_gate_phase(const Ctx c, const bf16* U, bf16* Bg, const float* wdw  , const float* st  , float* convp, float* convs  ,
                        unsigned char* z8, float* sz  , const bool skip_samp = false  ) {
    const int gw = c.vcu * 8 + c.wave, NGW = c.G * 8, dc = 16 * c.lane;
    float w0[16], w1[16], w2[16];
    { float t8[8]; ld8_f32(wdw + dc, t8);
#pragma unroll
      for (int i = 0; i < 8; ++i) w0[i] = t8[i]; ld8_f32(wdw + dc + 8, t8);
#pragma unroll
      for (int i = 0; i < 8; ++i) w0[8 + i] = t8[i]; ld8_f32(wdw + D + dc, t8);
#pragma unroll
      for (int i = 0; i < 8; ++i) w1[i] = t8[i]; ld8_f32(wdw + D + dc + 8, t8);
#pragma unroll
      for (int i = 0; i < 8; ++i) w1[8 + i] = t8[i]; ld8_f32(wdw + 2 * D + dc, t8);
#pragma unroll
      for (int i = 0; i < 8; ++i) w2[i] = t8[i]; ld8_f32(wdw + 2 * D + dc + 8, t8);
#pragma unroll
      for (int i = 0; i < 8; ++i) w2[8 + i] = t8[i]; }
    { v4u ng[2], n2[2], n1[2], n0[2];
#define CG_LOAD(tt_) do { const int t_ = (tt_), s_ = t_ & 2047, t1_ = s_ >= 1 ? t_ - 1 : t_, t0_ = s_ >= 2 ? t_ - 2 : t_; \
        _Pragma("unroll") for (int hf = 0; hf < 2; ++hf) { ng[hf] = *(const v4u*)(Bg + (size_t)t_ * D + dc + 8 * hf); n2[hf] = *(const v4u*)(U + (size_t)t_ * D + dc + 8 * hf); \
            n1[hf] = *(const v4u*)(U + (size_t)t1_ * D + dc + 8 * hf); n0[hf] = *(const v4u*)(U + (size_t)t0_ * D + dc + 8 * hf); } } while (0)
      if (gw < TP) CG_LOAD(gw);
      for (int t = gw; t < TP; t += NGW) {
          const int s = t & 2047; const float f1 = s >= 1 ? 1.f : 0.f, f0 = s >= 2 ? 1.f : 0.f;
          v4u cg[2], c2[2], c1[2], c0[2];
#pragma unroll
          for (int hf = 0; hf < 2; ++hf) { cg[hf] = ng[hf]; c2[hf] = n2[hf]; c1[hf] = n1[hf]; c0[hf] = n0[hf]; }
          CG_LOAD(t + NGW < TP ? t + NGW : t);
          float z[16]; float am = 0.f;
#pragma unroll
          for (int hf = 0; hf < 2; ++hf) { const unsigned wg[4] = {cg[hf].x, cg[hf].y, cg[hf].z, cg[hf].w}, w2_[4] = {c2[hf].x, c2[hf].y, c2[hf].z, c2[hf].w}, w1_[4] = {c1[hf].x, c1[hf].y, c1[hf].z, c1[hf].w}, w0_[4] = {c0[hf].x, c0[hf].y, c0[hf].z, c0[hf].w};
#pragma unroll
              for (int i = 0; i < 8; ++i) { const bool hi = i & 1; const int k = i >> 1;
                  const float g = hi ? bfhi(wg[k]) : bflo(wg[k]), u2 = hi ? bfhi(w2_[k]) : bflo(w2_[k]), u1 = (hi ? bfhi(w1_[k]) : bflo(w1_[k])) * f1, u0 = (hi ? bfhi(w0_[k]) : bflo(w0_[k])) * f0;
                  const float zz = g * (w0[8 * hf + i] * u0 + w1[8 * hf + i] * u1 + w2[8 * hf + i] * u2); z[8 * hf + i] = zz; am = __builtin_fmaxf(am, __builtin_fabsf(zz)); } }
          am = wave_max(am);
          const float k = am > 0.f ? 127.0f / am : 0.f;
          v4u q; q.x = q4_i8((f32x4){z[0], z[1], z[2], z[3]}, k); q.y = q4_i8((f32x4){z[4], z[5], z[6], z[7]}, k); q.z = q4_i8((f32x4){z[8], z[9], z[10], z[11]}, k); q.w = q4_i8((f32x4){z[12], z[13], z[14], z[15]}, k);
          *(v4u*)(z8 + (size_t)t * D + dc) = q;
          if (c.lane == 0) sz[t] = am * (1.0f / 127.0f);
      }
#undef CG_LOAD
    }
    for (int t = TP + gw; t < (skip_samp ? TP : T); t += NGW) {
        const bool samp = true; const int s = (t - TP) & 15; const int b = (t - TP) >> 4;
        float z[16]; float am = 0.f;
#pragma unroll
        for (int hf = 0; hf < 2; ++hf) { const int d0 = dc + 8 * hf;
            float u0[8], u1[8], u2[8], g[8];
            ld8_bf16(U + (size_t)t * D + d0, u2);
            { float* cdst = nullptr;
              (void)convp;
              if (samp && s >= DSEQ - 2) cdst = convs + ((size_t)b * 2 + (s - (DSEQ - 2))) * D + d0;
              if (cdst) { *(f32x4*)cdst = (f32x4){u2[0], u2[1], u2[2], u2[3]}; *(f32x4*)(cdst + 4) = (f32x4){u2[4], u2[5], u2[6], u2[7]}; } }
            if (s >= 1) ld8_bf16(U + (size_t)(t - 1) * D + d0, u1);
            else if (samp) ld8_f32(st + ((size_t)b * 2 + 1) * D + d0, u1);
            else {
#pragma unroll
                for (int i = 0; i < 8; ++i) u1[i] = 0.f; }
            if (s >= 2) ld8_bf16(U + (size_t)(t - 2) * D + d0, u0);
            else if (samp) ld8_f32(st + ((size_t)b * 2 + (s == 1 ? 1 : 0)) * D + d0, u0);
            else {
#pragma unroll
                for (int i = 0; i < 8; ++i) u0[i] = 0.f; }
            ld8_bf16(Bg + (size_t)t * D + d0, g);
#pragma unroll
            for (int i = 0; i < 8; ++i) { const float zz = g[i] * (w0[8 * hf + i] * u0[i] + w1[8 * hf + i] * u1[i] + w2[8 * hf + i] * u2[i]); z[8 * hf + i] = zz; am = __builtin_fmaxf(am, __builtin_fabsf(zz)); }
        }
        if (samp) {
            v4u o0, o1; o0.x = pk2(z[0], z[1]); o0.y = pk2(z[2], z[3]); o0.z = pk2(z[4], z[5]); o0.w = pk2(z[6], z[7]); o1.x = pk2(z[8], z[9]); o1.y = pk2(z[10], z[11]); o1.z = pk2(z[12], z[13]); o1.w = pk2(z[14], z[15]);
            *(v4u*)(Bg + (size_t)t * D + dc) = o0; *(v4u*)(Bg + (size_t)t * D + dc + 8) = o1; }
        am = wave_max(am);
        const float k = am > 0.f ? 127.0f / am : 0.f;
        v4u q; q.x = q4_i8((f32x4){z[0], z[1], z[2], z[3]}, k); q.y = q4_i8((f32x4){z[4], z[5], z[6], z[7]}, k); q.z = q4_i8((f32x4){z[8], z[9], z[10], z[11]}, k); q.w = q4_i8((f32x4){z[12], z[13], z[14], z[15]}, k);
        *(v4u*)(z8 + (size_t)t * D + dc) = q;
        if (c.lane == 0) sz[t] = am * (1.0f / 127.0f);
    }
}

DI void ln_phase(const Ctx c, const bf16* R, bf16* H, const float* g, const float* bb, float* yout = nullptr, const bf16* Hres = nullptr, unsigned char* x8 = nullptr, float* sx = nullptr) {
    const int gw = c.vcu * 8 + c.wave, NGW = c.G * 8;
    float gv[2][8], bv[2][8];
#pragma unroll
    for (int j = 0; j < 2; ++j) { ld8_f32(g + 8 * c.lane + 512 * j, gv[j]); ld8_f32(bb + 8 * c.lane + 512 * j, bv[j]); }
    v4u rw[2], hw[2];
#pragma unroll
    for (int j = 0; j < 2; ++j) { const int m0 = gw < T ? gw : 0; rw[j] = *(const v4u*)(R + (size_t)m0 * D + 8 * c.lane + 512 * j); hw[j] = Hres ? *(const v4u*)(Hres + (size_t)m0 * D + 8 * c.lane + 512 * j) : (v4u){0u, 0u, 0u, 0u}; }
    for (int m = gw; m < T; m += NGW) {
        float v[2][8]; float s = 0.f;
#pragma unroll
        for (int j = 0; j < 2; ++j) { const unsigned w[4] = {rw[j].x, rw[j].y, rw[j].z, rw[j].w}, hq[4] = {hw[j].x, hw[j].y, hw[j].z, hw[j].w};
#pragma unroll
            for (int i = 0; i < 4; ++i) { v[j][2 * i] = bflo(w[i]); v[j][2 * i + 1] = bfhi(w[i]); if (Hres) { v[j][2 * i] += bflo(hq[i]) * ALPHA; v[j][2 * i + 1] += bfhi(hq[i]) * ALPHA; } }
#pragma unroll
            for (int i = 0; i < 8; ++i) s += v[j][i]; }
        { const int mn = m + NGW < T ? m + NGW : m;
#pragma unroll
          for (int j = 0; j < 2; ++j) { rw[j] = *(const v4u*)(R + (size_t)mn * D + 8 * c.lane + 512 * j); if (Hres) hw[j] = *(const v4u*)(Hres + (size_t)mn * D + 8 * c.lane + 512 * j); } }
        const float mean = wave_sum(c.lane, s) * (1.f / D); float s2 = 0.f;
#pragma unroll
        for (int j = 0; j < 2; ++j)
#pragma unroll
            for (int i = 0; i < 8; ++i) { v[j][i] -= mean; s2 += v[j][i] * v[j][i]; }
        const float rstd = __builtin_amdgcn_rsqf(wave_sum(c.lane, s2) * (1.f / D) + LN_EPS);
        float am = 0.f;
#pragma unroll
        for (int j = 0; j < 2; ++j)
#pragma unroll
            for (int i = 0; i < 8; ++i) { v[j][i] = v[j][i] * rstd * gv[j][i] + bv[j][i]; am = __builtin_fmaxf(am, __builtin_fabsf(v[j][i])); }
        if (yout) {
#pragma unroll
            for (int j = 0; j < 2; ++j) { float* o = yout + (size_t)m * D + 8 * c.lane + 512 * j; *(f32x4*)o = (f32x4){v[j][0], v[j][1], v[j][2], v[j][3]}; *(f32x4*)(o + 4) = (f32x4){v[j][4], v[j][5], v[j][6], v[j][7]}; }
        } else {
#pragma unroll
            for (int j = 0; j < 2; ++j) { v4u w; w.x = pk2(v[j][0], v[j][1]); w.y = pk2(v[j][2], v[j][3]); w.z = pk2(v[j][4], v[j][5]); w.w = pk2(v[j][6], v[j][7]); *(v4u*)(H + (size_t)m * D + 8 * c.lane + 512 * j) = w; }
            if (x8) {
                am = wave_max(am);
                const float k = am > 0.f ? 127.0f / am : 0.f;
#pragma unroll
                for (int j = 0; j < 2; ++j) { v2u q; q.x = q4_i8((f32x4){v[j][0], v[j][1], v[j][2], v[j][3]}, k); q.y = q4_i8((f32x4){v[j][4], v[j][5], v[j][6], v[j][7]}, k); *(v2u*)(x8 + (size_t)m * D + 8 * c.lane + 512 * j) = q; }
                if (c.lane == 0) sx[m] = am * (1.0f / 127.0f);
            } }
    }
}

DI int ordi(float x) { const int b = __float_as_int(x); return b ^ ((b >> 31) & 0x7fffffff); }
DI float unordi(int o) { return __int_as_float(o ^ ((o >> 31) & 0x7fffffff)); }
#define TK_CE(a, b) do { const int _hi = (a) > (b) ? (a) : (b), _lo = (a) > (b) ? (b) : (a); (a) = _hi; (b) = _lo; } while (0)
#define TK_CPK(i, j) ((ordi(va[i] + vb[j]) & ~255) | (255 - ((i) * 16 + (j))))
#define TK_SORT16(v) do { TK_CE(v[0], v[13]); TK_CE(v[1], v[12]); TK_CE(v[2], v[15]); TK_CE(v[3], v[14]); TK_CE(v[4], v[8]); TK_CE(v[5], v[6]); TK_CE(v[7], v[11]); TK_CE(v[9], v[10]); TK_CE(v[0], v[5]); TK_CE(v[1], v[7]); TK_CE(v[2], v[9]); TK_CE(v[3], v[4]); TK_CE(v[6], v[13]); TK_CE(v[8], v[14]); TK_CE(v[10], v[15]); TK_CE(v[11], v[12]); TK_CE(v[0], v[1]); TK_CE(v[2], v[3]); TK_CE(v[4], v[5]); TK_CE(v[6], v[8]); TK_CE(v[7], v[9]); TK_CE(v[10], v[11]); TK_CE(v[12], v[13]); TK_CE(v[14], v[15]); TK_CE(v[0], v[2]); TK_CE(v[1], v[3]); TK_CE(v[4], v[10]); TK_CE(v[5], v[11]); TK_CE(v[6], v[7]); TK_CE(v[8], v[9]); TK_CE(v[12], v[14]); TK_CE(v[13], v[15]); TK_CE(v[1], v[2]); TK_CE(v[3], v[12]); TK_CE(v[4], v[6]); TK_CE(v[5], v[7]); TK_CE(v[8], v[10]); TK_CE(v[9], v[11]); TK_CE(v[13], v[14]); TK_CE(v[1], v[4]); TK_CE(v[2], v[6]); TK_CE(v[5], v[8]); TK_CE(v[7], v[10]); TK_CE(v[9], v[13]); TK_CE(v[11], v[14]); TK_CE(v[2], v[4]); TK_CE(v[3], v[6]); TK_CE(v[9], v[12]); TK_CE(v[11], v[13]); TK_CE(v[3], v[5]); TK_CE(v[6], v[8]); TK_CE(v[7], v[9]); TK_CE(v[10], v[12]); TK_CE(v[3], v[4]); TK_CE(v[5], v[6]); TK_CE(v[7], v[8]); TK_CE(v[9], v[10]); TK_CE(v[11], v[12]); TK_CE(v[6], v[7]); TK_CE(v[8], v[9]); } while (0)
#define TK_BMERGE16(v) do { TK_CE(v[0], v[8]); TK_CE(v[1], v[9]); TK_CE(v[2], v[10]); TK_CE(v[3], v[11]); TK_CE(v[4], v[12]); TK_CE(v[5], v[13]); TK_CE(v[6], v[14]); TK_CE(v[7], v[15]); TK_CE(v[0], v[4]); TK_CE(v[1], v[5]); TK_CE(v[2], v[6]); TK_CE(v[3], v[7]); TK_CE(v[8], v[12]); TK_CE(v[9], v[13]); TK_CE(v[10], v[14]); TK_CE(v[11], v[15]); TK_CE(v[0], v[2]); TK_CE(v[1], v[3]); TK_CE(v[4], v[6]); TK_CE(v[5], v[7]); TK_CE(v[8], v[10]); TK_CE(v[9], v[11]); TK_CE(v[12], v[14]); TK_CE(v[13], v[15]); TK_CE(v[0], v[1]); TK_CE(v[2], v[3]); TK_CE(v[4], v[5]); TK_CE(v[6], v[7]); TK_CE(v[8], v[9]); TK_CE(v[10], v[11]); TK_CE(v[12], v[13]); TK_CE(v[14], v[15]); } while (0)
#define TK_CAND0(B) do { B[0] = TK_CPK(0, 0); B[1] = TK_CPK(0, 1); B[2] = TK_CPK(0, 2); B[3] = TK_CPK(0, 3); B[4] = TK_CPK(0, 4); B[5] = TK_CPK(0, 5); B[6] = TK_CPK(0, 6); B[7] = TK_CPK(0, 7); B[8] = TK_CPK(0, 8); B[9] = TK_CPK(0, 9); B[10] = TK_CPK(0, 10); B[11] = TK_CPK(0, 11); B[12] = TK_CPK(0, 12); B[13] = TK_CPK(0, 13); B[14] = TK_CPK(0, 14); B[15] = TK_CPK(0, 15); } while (0)
#define TK_CAND1(B) do { B[0] = TK_CPK(1, 0); B[1] = TK_CPK(1, 1); B[2] = TK_CPK(1, 2); B[3] = TK_CPK(1, 3); B[4] = TK_CPK(1, 4); B[5] = TK_CPK(1, 5); B[6] = TK_CPK(1, 6); B[7] = TK_CPK(1, 7); B[8] = TK_CPK(2, 0); B[9] = TK_CPK(2, 1); B[10] = TK_CPK(2, 2); B[11] = TK_CPK(2, 3); B[12] = TK_CPK(2, 4); B[13] = TK_CPK(3, 0); B[14] = TK_CPK(3, 1); B[15] = TK_CPK(3, 2); } while (0)
#define TK_CAND2(B) do { B[0] = TK_CPK(3, 3); B[1] = TK_CPK(4, 0); B[2] = TK_CPK(4, 1); B[3] = TK_CPK(4, 2); B[4] = TK_CPK(5, 0); B[5] = TK_CPK(5, 1); B[6] = TK_CPK(6, 0); B[7] = TK_CPK(6, 1); B[8] = TK_CPK(7, 0); B[9] = TK_CPK(7, 1); B[10] = TK_CPK(8, 0); B[11] = TK_CPK(9, 0); B[12] = TK_CPK(10, 0); B[13] = TK_CPK(11, 0); B[14] = TK_CPK(12, 0); B[15] = TK_CPK(13, 0); } while (0)
#define TK_CAND3(B) do { B[0] = TK_CPK(14, 0); B[1] = TK_CPK(15, 0); B[2] = (int)0x80000000; B[3] = (int)0x80000000; B[4] = (int)0x80000000; B[5] = (int)0x80000000; B[6] = (int)0x80000000; B[7] = (int)0x80000000; B[8] = (int)0x80000000; B[9] = (int)0x80000000; B[10] = (int)0x80000000; B[11] = (int)0x80000000; B[12] = (int)0x80000000; B[13] = (int)0x80000000; B[14] = (int)0x80000000; B[15] = (int)0x80000000; } while (0)
DI void tk_merge(int (&L)[16], const int (&B)[16]) {
#pragma unroll
    for (int i = 0; i < 16; ++i) L[i] = L[i] > B[15 - i] ? L[i] : B[15 - i];
    TK_BMERGE16(L);
}
DI void tk_feed32(int (&L)[16], const v4u (&x)[4], const int rb, const bool first) {
#pragma unroll
    for (int hf = 0; hf < 2; ++hf) { int B[16]; const unsigned w[8] = {x[2 * hf].x, x[2 * hf].y, x[2 * hf].z, x[2 * hf].w, x[2 * hf + 1].x, x[2 * hf + 1].y, x[2 * hf + 1].z, x[2 * hf + 1].w};
#pragma unroll
        for (int j = 0; j < 16; ++j) {
            const unsigned ww = w[j >> 1], code = (unsigned)(127 - ((rb + 16 * hf + j) & 127));
            if (j & 1) { const int m = (int)ww >> 31; const unsigned t = ww ^ ((unsigned)m & 0x7fff0000u); B[j] = (int)((t & 0xffff0000u) | code); }
            else { const int m = (int)(ww << 16) >> 31; const unsigned t = ww ^ ((unsigned)m & 0x7fffu); B[j] = (int)((t << 16) | code); } }
        TK_SORT16(B);
        if (hf == 0 && first) {
#pragma unroll
            for (int i = 0; i < 16; ++i) L[i] = B[i];
        } else tk_merge(L, B); }
}
DI float unord16(const int key) { const int h = key & (int)0xffff0000; return __int_as_float(h ^ ((h >> 31) & 0x7fff0000)); }
DI unsigned byte_of(unsigned a0, unsigned a1, unsigned a2, unsigned a3, int i) { const unsigned lo = i < 4 ? a0 : a1, hi = i < 12 ? a2 : a3, w = i < 8 ? lo : hi; return (w >> ((i & 3) * 8)) & 0xffu; }
constexpr int TK_NUP = 8 * (TP / 64), TK_NPU = 8 * (TS / 32);
DI const v4u* tk_row(const int wi, const int lane, const bf16* Sc, int& h, int& t) {
    if (wi < TK_NUP) { h = wi & 7; t = (wi >> 3) * 64 + lane; return (const v4u*)(Sc + (size_t)t * 2048 + h * 256); }
    const int pu = wi - TK_NUP; h = pu / (TS / 32); t = TP + (pu % (TS / 32)) * 32 + (lane >> 1);
    return (const v4u*)(Sc + (size_t)t * 2048 + h * 256 + (lane & 1) * 128);
}
DI void topk_phase(const Ctx c, const bf16* Sc  , unsigned short* ids, float* gates) {
    const int gwn = c.vcu * 8 + c.wave, gwo = c.wave * c.G + c.vcu, NGW = c.G * 8;
    const int nn = gwn < TK_NUP ? (TK_NUP - gwn + NGW - 1) / NGW : 0;
#define TK_ITEM(k) ((k) < nn ? gwn + (k) * NGW : (((k) == nn && gwo < TK_NPU) ? TK_NUP + gwo : -1))
    v4u bufA[4], bufB[4];
    if (TK_ITEM(0) >= 0) { int h_, t_; const v4u* sc = tk_row(TK_ITEM(0), c.lane, Sc, h_, t_);
#pragma unroll
        for (int j = 0; j < 4; ++j) bufA[j] = sc[j]; }
#pragma unroll 1
    for (int kk = 0; TK_ITEM(kk) >= 0; ++kk) {
        const int wu = TK_ITEM(kk);
        int h, t; const v4u* sc = tk_row(wu, c.lane, Sc, h, t);
        const bool pair = wu >= TK_NUP; const int nit = pair ? 2 : 4;
        const int wn = TK_ITEM(kk + 1) >= 0 ? TK_ITEM(kk + 1) : wu;
        int hn_, tn_; const v4u* scn = tk_row(wn, c.lane, Sc, hn_, tn_);
        int Lw[16], La[16];
#pragma unroll
        for (int i = 0; i < 16; ++i) { Lw[i] = (int)0x80000000; La[i] = 0; }
#pragma unroll 1
        for (int it = 0; it < nit; ++it) {
#pragma unroll
            for (int j = 0; j < 4; ++j) bufB[j] = sc[8 * it + 4 + j];
            tk_feed32(Lw, bufA, 64 * it, (it & 1) == 0);
            { const v4u* nx = it + 1 < nit ? sc + 8 * (it + 1) : scn;
#pragma unroll
              for (int j = 0; j < 4; ++j) bufA[j] = nx[j]; }
            tk_feed32(Lw, bufB, 64 * it + 32, false);
            if (it == 1) {
#pragma unroll
                for (int i = 0; i < 16; ++i) La[i] = Lw[i]; }
        }
        if (pair) {
            const bool od = c.lane & 1;
#pragma unroll
            for (int i = 0; i < 16; ++i) { const int o = __builtin_amdgcn_update_dpp(Lw[i], Lw[i], 0xB1, 0xf, 0xf, false); La[i] = od ? o : Lw[i]; Lw[i] = od ? Lw[i] : o; }
        }
        float va[16], vb[16]; unsigned IA0 = 0u, IA1 = 0u, IA2 = 0u, IA3 = 0u, IB0 = 0u, IB1 = 0u, IB2 = 0u, IB3 = 0u;
#pragma unroll
        for (int i = 0; i < 16; ++i) { va[i] = unord16(La[i]); vb[i] = unord16(Lw[i]);
            const unsigned ea = (unsigned)(127 - (La[i] & 127)) << ((i & 3) * 8), eb = (unsigned)(127 - (Lw[i] & 127)) << ((i & 3) * 8);
            if ((i >> 2) == 0) { IA0 |= ea; IB0 |= eb; } else if ((i >> 2) == 1) { IA1 |= ea; IB1 |= eb; } else if ((i >> 2) == 2) { IA2 |= ea; IB2 |= eb; } else { IA3 |= ea; IB3 |= eb; } }
        int F[16];
        { int B[16]; TK_CAND0(B); TK_SORT16(B);
#pragma unroll
          for (int i = 0; i < 16; ++i) F[i] = B[i]; }
        { int B[16]; TK_CAND1(B); TK_SORT16(B); tk_merge(F, B); }
        { int B[16]; TK_CAND2(B); TK_SORT16(B); tk_merge(F, B); }
        { int x = TK_CPK(14, 0), y = TK_CPK(15, 0); TK_CE(x, y);
          F[15] = F[15] > x ? F[15] : x; F[14] = F[14] > y ? F[14] : y; TK_BMERGE16(F); }
        float sc_[16], den = 0.f; unsigned ex[16];
        const float mx = unordi(F[0] & ~255);
#pragma unroll
        for (int k = 0; k < 16; ++k) { const int code = 255 - (F[k] & 255); sc_[k] = __builtin_amdgcn_exp2f((unordi(F[k] & ~255) - mx) * LOG2E); den += sc_[k];
            ex[k] = byte_of(IA0, IA1, IA2, IA3, code >> 4) * 128u + byte_of(IB0, IB1, IB2, IB3, code & 15); }
        const float inv = 1.0f / den;
        v4u e0, e1; e0.x = ex[0] | (ex[1] << 16); e0.y = ex[2] | (ex[3] << 16); e0.z = ex[4] | (ex[5] << 16); e0.w = ex[6] | (ex[7] << 16);
        e1.x = ex[8] | (ex[9] << 16); e1.y = ex[10] | (ex[11] << 16); e1.z = ex[12] | (ex[13] << 16); e1.w = ex[14] | (ex[15] << 16);
        v4u* ip = (v4u*)(ids + (size_t)t * 128 + h * 16); ip[0] = e0; ip[1] = e1;
        v4u* gp = (v4u*)((bf16*)gates + (size_t)t * 128 + h * 16);
#pragma unroll
        for (int k = 0; k < 2; ++k) { v4u w; w.x = pk2(sc_[8 * k] * inv, sc_[8 * k + 1] * inv); w.y = pk2(sc_[8 * k + 2] * inv, sc_[8 * k + 3] * inv);
            w.z = pk2(sc_[8 * k + 4] * inv, sc_[8 * k + 5] * inv); w.w = pk2(sc_[8 * k + 6] * inv, sc_[8 * k + 7] * inv); gp[k] = w; }
    }
}

typedef float f2 __attribute__((ext_vector_type(2)));
constexpr int QCH = 16, QN = T / QCH;
static_assert(T % QCH == 0, "queue chunks");
struct ChunkQ { int xme, s; unsigned pend; unsigned* q; };
struct Chunk { int base, xs; };
DI unsigned cq_ticket(unsigned* qw, int lane) { unsigned v = 0u; if (lane == 0) v = __hip_atomic_fetch_add(qw, 1u, __ATOMIC_RELAXED, __HIP_MEMORY_SCOPE_AGENT); return v; }
DI void cq_init(ChunkQ& g, unsigned* q, int lane) { g.xme = (int)(xb_xcc_id() & 7u); g.s = 0; g.q = q; g.pend = cq_ticket(q + g.xme * 64, lane); }
DI Chunk cq_next(ChunkQ& g, int lane) {
    for (;;) {
        if (g.s >= 8) return Chunk{-1, 0};
        const unsigned chunk = (unsigned)__builtin_amdgcn_readfirstlane((int)g.pend); const int xs = (g.xme + g.s) & 7;
        if (chunk < (unsigned)QN) { g.pend = cq_ticket(g.q + xs * 64, lane); return Chunk{(int)chunk * QCH, xs}; }
        ++g.s; if (g.s < 8) g.pend = cq_ticket(g.q + ((g.xme + g.s) & 7) * 64, lane);
    }
}
struct SliceIds { v4u ia, ib; int t, xs; };
struct SliceAux { v4u a0; float s; };
DI SliceIds slice_load_ids(const int t, const int xs, const int lane, const unsigned short* ids) {
    const int j = lane >> 3, tc = t < 0 ? 0 : t; SliceIds r; r.t = t; r.xs = xs;
    r.ia = *(const v4u*)(ids + (size_t)tc * 128 + 16 * j); r.ib = *(const v4u*)(ids + (size_t)tc * 128 + 16 * j + 8); return r;
}
template <int MODE>
DI SliceAux slice_load_aux(const int t, const int xs, const int lane, const unsigned char* x8, const unsigned char* w8, const float* sw) {
    const int j = lane >> 3, i = lane & 7, tc = t < 0 ? 0 : t; SliceAux r;
    if (MODE == 0) { r.a0 = *(const v4u*)(x8 + (size_t)tc * D + 128 * xs + 16 * i); r.s = 0.f; }
    else { r.a0 = *(const v4u*)(w8 + (size_t)tc * 128 + 16 * j); r.s = sw[tc]; }
    return r;
}
template <int VAR>
DI void slice_issue(v4u (&vr)[16], const SliceIds& n, const unsigned char* T8, const int lane) {
    const unsigned char* sbase = T8 + (size_t)n.xs * NEXP * 128;
    const unsigned lo = 16u * (unsigned)(lane & 7);
    const unsigned idv[8] = {n.ia.x, n.ia.y, n.ia.z, n.ia.w, n.ib.x, n.ib.y, n.ib.z, n.ib.w};
#pragma unroll
    for (int g = 0; g < 16; ++g) {
        unsigned off;
        if (VAR == 2) off = (((g & 1) ? (idv[g >> 1] >> 16) : (idv[g >> 1] & 0xffffu)) & 15u) * 128u + lo;
        else if (g & 1) asm("v_mad_u32_u16 %0, %1, %2, %3 op_sel:[1,0,0,0]" : "=v"(off) : "v"(idv[g >> 1]), "s"(128u), "v"(lo));
        else asm("v_mad_u32_u16 %0, %1, %2, %3" : "=v"(off) : "v"(idv[g >> 1]), "s"(128u), "v"(lo));
        vr[g] = *(const v4u*)(sbase + off); }
}
DI int dot16_i8(const v4u a, const v4u b, int acc) {
    acc = __builtin_amdgcn_sdot4((int)a.x, (int)b.x, acc, false); acc = __builtin_amdgcn_sdot4((int)a.y, (int)b.y, acc, false);
    acc = __builtin_amdgcn_sdot4((int)a.z, (int)b.z, acc, false); acc = __builtin_amdgcn_sdot4((int)a.w, (int)b.w, acc, false); return acc;
}
DI void tr4_dot0(int& c0, int& c1, int& c2, int& c3, const unsigned a, const unsigned b, const unsigned cc, const unsigned d, const int w) {
    const unsigned p = __builtin_amdgcn_perm(b, a, 0x05010400u), q = __builtin_amdgcn_perm(b, a, 0x07030602u), r = __builtin_amdgcn_perm(d, cc, 0x05010400u), s = __builtin_amdgcn_perm(d, cc, 0x07030602u);
    asm("v_dot4_i32_i8 %0, %1, %2, 0" : "=v"(c0) : "v"(__builtin_amdgcn_perm(r, p, 0x05040100u)), "v"(w)); asm("v_dot4_i32_i8 %0, %1, %2, 0" : "=v"(c1) : "v"(__builtin_amdgcn_perm(r, p, 0x07060302u)), "v"(w));
    asm("v_dot4_i32_i8 %0, %1, %2, 0" : "=v"(c2) : "v"(__builtin_amdgcn_perm(s, q, 0x05040100u)), "v"(w)); asm("v_dot4_i32_i8 %0, %1, %2, 0" : "=v"(c3) : "v"(__builtin_amdgcn_perm(s, q, 0x07060302u)), "v"(w));
}
DI void tr4_dot(int& c0, int& c1, int& c2, int& c3, const unsigned a, const unsigned b, const unsigned cc, const unsigned d, const int w) {
    const unsigned p = __builtin_amdgcn_perm(b, a, 0x05010400u), q = __builtin_amdgcn_perm(b, a, 0x07030602u), r = __builtin_amdgcn_perm(d, cc, 0x05010400u), s = __builtin_amdgcn_perm(d, cc, 0x07030602u);
    c0 = __builtin_amdgcn_sdot4((int)__builtin_amdgcn_perm(r, p, 0x05040100u), w, c0, false); c1 = __builtin_amdgcn_sdot4((int)__builtin_amdgcn_perm(r, p, 0x07060302u), w, c1, false);
    c2 = __builtin_amdgcn_sdot4((int)__builtin_amdgcn_perm(s, q, 0x05040100u), w, c2, false); c3 = __builtin_amdgcn_sdot4((int)__builtin_amdgcn_perm(s, q, 0x07060302u), w, c3, false);
}
template <int MODE, int VAR>
DI void slice_compute(const int lane, const v4u (&vr)[16], const int t, const int xs, const SliceAux& n, float* OUT) {
    const int j = lane >> 3, i = lane & 7;
    if (VAR == 1) {
        unsigned x = n.a0.x ^ n.a0.y;
#pragma unroll
        for (int g = 0; g < 16; ++g) x ^= vr[g].x ^ vr[g].y ^ vr[g].z ^ vr[g].w;
        *(unsigned*)((bf16*)OUT + (size_t)t * D + 128 * xs + 2 * lane) = x;
    } else if (MODE == 0) {
        int d[16];
#pragma unroll
        for (int g = 0; g < 16; ++g) d[g] = dot16_i8(vr[g], n.a0, 0);
        int r8[8], r4[4], r2[2];
#define RS_DPP4(CTRL, R, K, S, o) asm("s_nop 1\n\tv_add_u32_dpp %0, %4, %8 " CTRL " row_mask:0xf bank_mask:0xf\n\tv_add_u32_dpp %1, %5, %9 " CTRL " row_mask:0xf bank_mask:0xf\n\t" \
                "v_add_u32_dpp %2, %6, %10 " CTRL " row_mask:0xf bank_mask:0xf\n\tv_add_u32_dpp %3, %7, %11 " CTRL " row_mask:0xf bank_mask:0xf" \
                : "=&v"(R[o]), "=&v"(R[o + 1]), "=&v"(R[o + 2]), "=&v"(R[o + 3]) : "v"(S[o]), "v"(S[o + 1]), "v"(S[o + 2]), "v"(S[o + 3]), "v"(K[o]), "v"(K[o + 1]), "v"(K[o + 2]), "v"(K[o + 3]))
        { int kp[8], sd[8]; const bool od = lane & 1;
#pragma unroll
          for (int q = 0; q < 8; ++q) { kp[q] = od ? d[8 + q] : d[q]; sd[q] = od ? d[q] : d[8 + q]; }
          RS_DPP4("quad_perm:[1,0,3,2]", r8, kp, sd, 0); RS_DPP4("quad_perm:[1,0,3,2]", r8, kp, sd, 4); }
        { int kp[4], sd[4]; const bool od = lane & 2;
#pragma unroll
          for (int q = 0; q < 4; ++q) { kp[q] = od ? r8[4 + q] : r8[q]; sd[q] = od ? r8[q] : r8[4 + q]; }
          RS_DPP4("quad_perm:[2,3,0,1]", r4, kp, sd, 0); }
#undef RS_DPP4
        asm("s_nop 1\n\tv_add_u32_dpp %0, %2, %2 row_shl:4 row_mask:0xf bank_mask:0x5\n\tv_add_u32_dpp %0, %4, %4 row_shr:4 row_mask:0xf bank_mask:0xa\n\t"
            "v_add_u32_dpp %1, %3, %3 row_shl:4 row_mask:0xf bank_mask:0x5\n\tv_add_u32_dpp %1, %5, %5 row_shr:4 row_mask:0xf bank_mask:0xa"
            : "=&v"(r2[0]), "=&v"(r2[1]) : "v"(r4[0]), "v"(r4[1]), "v"(r4[2]), "v"(r4[3]));
        const int g0 = 8 * (i & 1) + 4 * ((i >> 1) & 1) + 2 * (i >> 2);
        *((unsigned*)OUT + ((size_t)xs * T + t) * 64 + 8 * j + (g0 >> 1)) = ((unsigned)((r2[0] + 32) >> 6) & 0xffffu) | ((unsigned)((r2[1] + 32) >> 6) << 16);
    } else {
        int acc[16];
        const int w4[4] = {(int)n.a0.x, (int)n.a0.y, (int)n.a0.z, (int)n.a0.w};
        tr4_dot0(acc[0], acc[1], acc[2], acc[3], vr[0].x, vr[1].x, vr[2].x, vr[3].x, w4[0]);
        tr4_dot0(acc[4], acc[5], acc[6], acc[7], vr[0].y, vr[1].y, vr[2].y, vr[3].y, w4[0]);
        tr4_dot0(acc[8], acc[9], acc[10], acc[11], vr[0].z, vr[1].z, vr[2].z, vr[3].z, w4[0]);
        tr4_dot0(acc[12], acc[13], acc[14], acc[15], vr[0].w, vr[1].w, vr[2].w, vr[3].w, w4[0]);
#pragma unroll
        for (int gq = 1; gq < 4; ++gq) {
            tr4_dot(acc[0], acc[1], acc[2], acc[3], vr[4 * gq].x, vr[4 * gq + 1].x, vr[4 * gq + 2].x, vr[4 * gq + 3].x, w4[gq]);
            tr4_dot(acc[4], acc[5], acc[6], acc[7], vr[4 * gq].y, vr[4 * gq + 1].y, vr[4 * gq + 2].y, vr[4 * gq + 3].y, w4[gq]);
            tr4_dot(acc[8], acc[9], acc[10], acc[11], vr[4 * gq].z, vr[4 * gq + 1].z, vr[4 * gq + 2].z, vr[4 * gq + 3].z, w4[gq]);
            tr4_dot(acc[12], acc[13], acc[14], acc[15], vr[4 * gq].w, vr[4 * gq + 1].w, vr[4 * gq + 2].w, vr[4 * gq + 3].w, w4[gq]);
        }
        int r8[8], r4[4], r2[2];
#pragma unroll
        for (int q = 0; q < 8; q += 4)
            asm("s_nop 1\n\tv_add_u32_dpp %0, %4, %4 row_ror:8 row_mask:0xf bank_mask:0x3\n\tv_add_u32_dpp %0, %8, %8 row_ror:8 row_mask:0xf bank_mask:0xc\n\t"
                "v_add_u32_dpp %1, %5, %5 row_ror:8 row_mask:0xf bank_mask:0x3\n\tv_add_u32_dpp %1, %9, %9 row_ror:8 row_mask:0xf bank_mask:0xc\n\t"
                "v_add_u32_dpp %2, %6, %6 row_ror:8 row_mask:0xf bank_mask:0x3\n\tv_add_u32_dpp %2, %10, %10 row_ror:8 row_mask:0xf bank_mask:0xc\n\t"
                "v_add_u32_dpp %3, %7, %7 row_ror:8 row_mask:0xf bank_mask:0x3\n\tv_add_u32_dpp %3, %11, %11 row_ror:8 row_mask:0xf bank_mask:0xc"
                : "=&v"(r8[q]), "=&v"(r8[q + 1]), "=&v"(r8[q + 2]), "=&v"(r8[q + 3])
                : "v"(acc[q]), "v"(acc[q + 1]), "v"(acc[q + 2]), "v"(acc[q + 3]), "v"(acc[8 + q]), "v"(acc[9 + q]), "v"(acc[10 + q]), "v"(acc[11 + q]));
#pragma unroll
        for (int q = 0; q < 4; ++q) { const auto rr = __builtin_amdgcn_permlane16_swap((unsigned)r8[q], (unsigned)r8[4 + q], false, false); r4[q] = (int)rr[0] + (int)rr[1]; }
#pragma unroll
        for (int q = 0; q < 2; ++q) { const auto rr = __builtin_amdgcn_permlane32_swap((unsigned)r4[q], (unsigned)r4[2 + q], false, false); r2[q] = (int)rr[0] + (int)rr[1]; }
        const int dim = 128 * xs + 16 * i + 8 * (j & 1) + 4 * ((j >> 1) & 1) + 2 * (j >> 2);
        const float s = n.s;
        *(unsigned*)((bf16*)OUT + (size_t)t * D + dim) = pk2((float)r2[0] * s, (float)r2[1] * s);
    }
}
template <int MODE, int VAR = 0>
DI void slice_pass(const Ctx c, const unsigned char* x8, const unsigned short* ids, const unsigned char* w8, const float* sw, const unsigned char* T8, float* OUT, unsigned* q) {
    ChunkQ g; cq_init(g, q, c.lane);
    Chunk cur = cq_next(g, c.lane); if (cur.base < 0) return;
    Chunk nxt = cq_next(g, c.lane);
#define SLICE_TOK_T(p) ((p) < QCH ? cur.base + (p) : (nxt.base >= 0 ? nxt.base + (p) - QCH : -1))
#define SLICE_TOK_X(p) ((p) < QCH ? cur.xs : nxt.xs)
    SliceIds i0 = slice_load_ids(SLICE_TOK_T(0), SLICE_TOK_X(0), c.lane, ids), i1 = slice_load_ids(SLICE_TOK_T(1), SLICE_TOK_X(1), c.lane, ids),
             i2 = slice_load_ids(SLICE_TOK_T(2), SLICE_TOK_X(2), c.lane, ids), i3 = slice_load_ids(SLICE_TOK_T(3), SLICE_TOK_X(3), c.lane, ids);
    SliceAux x0 = slice_load_aux<MODE>(i0.t, i0.xs, c.lane, x8, w8, sw), x1 = slice_load_aux<MODE>(i1.t, i1.xs, c.lane, x8, w8, sw);
    v4u A[16], B[16];
    slice_issue<VAR>(A, i0, T8, c.lane);
#define SLICE_STEP(K, CUR, NXT, IK, IK1, XK) do { slice_issue<VAR>(NXT, IK1, T8, c.lane); \
        const int ct_ = IK.t, cx_ = IK.xs; const SliceAux cxk_ = XK; \
        XK = slice_load_aux<MODE>(SLICE_TOK_T(pg + (K) + 2), SLICE_TOK_X(pg + (K) + 2), c.lane, x8, w8, sw); \
        IK = slice_load_ids(SLICE_TOK_T(pg + (K) + 4), SLICE_TOK_X(pg + (K) + 4), c.lane, ids); \
        slice_compute<MODE, VAR>(c.lane, CUR, ct_, cx_, cxk_, OUT); } while (0)
    for (;;) {
#pragma unroll 2
        for (int pg = 0; pg < QCH; pg += 4) {
            SLICE_STEP(0, A, B, i0, i1, x0);
            SLICE_STEP(1, B, A, i1, i2, x1);
            SLICE_STEP(2, A, B, i2, i3, x0);
            SLICE_STEP(3, B, A, i3, i0, x1);
        }
        cur = nxt; if (cur.base < 0) break;
        nxt = cq_next(g, c.lane);
    }
#undef SLICE_STEP
#undef SLICE_TOK_T
#undef SLICE_TOK_X
}
struct WpA { f32x4 s; v2u iw; f32x4 g; float st; };
struct WpB { f32x4 su, sv; };
DI WpA wp_load_a(const size_t idx, const float* part, const unsigned short* ids, const float* gates, const float* sx) {
    WpA a; v2u p[8];
#pragma unroll
    for (int x = 0; x < 8; ++x) p[x] = *(const v2u*)((const unsigned short*)part + (size_t)x * T * 128 + idx * 4);
    a.iw = *(const v2u*)(ids + idx * 4); { const v2u gq = *(const v2u*)((const bf16*)gates + idx * 4); a.g = (f32x4){bflo(gq.x), bfhi(gq.x), bflo(gq.y), bfhi(gq.y)}; } a.st = sx[idx >> 5] * 64.0f;
    int s0 = 0, s1 = 0, s2 = 0, s3 = 0;
#pragma unroll
    for (int x = 0; x < 8; ++x) { s0 += (int)(short)(p[x].x & 0xffffu); s1 += (int)p[x].x >> 16; s2 += (int)(short)(p[x].y & 0xffffu); s3 += (int)p[x].y >> 16; }
    a.s = (f32x4){(float)s0, (float)s1, (float)s2, (float)s3}; return a;
}
DI WpB wp_load_b(const WpA& a, const LAS unsigned char* tab) {
    const unsigned e[4] = {a.iw.x & 0xffffu, a.iw.x >> 16, a.iw.y & 0xffffu, a.iw.y >> 16}; WpB b;
#pragma unroll
    for (int k = 0; k < 4; ++k) { const f2 p = *(const LAS f2*)(tab + 8u * e[k]); b.su[k] = p.x; b.sv[k] = p.y; }
    return b;
}
DI void peer_w_phase(const Ctx c, LAS unsigned char* lds, const float* part, const unsigned short* ids, const float* gates, unsigned char* w8, float* sw, const float* sx, const float* SU, const float* SV) {
    const size_t NT = (size_t)c.G * 512, NI = (size_t)T * 32, i0 = (size_t)c.vcu * 512 + c.tid;
    { const v4u* src = (const v4u*)SU; LAS v4u* dst = (LAS v4u*)lds; v4u t_[16];
#pragma unroll
      for (int i = 0; i < 16; ++i) t_[i] = src[c.tid + 512 * i];
#pragma unroll
      for (int i = 0; i < 16; ++i) dst[c.tid + 512 * i] = t_[i]; }
    (void)SV;
    __syncthreads();
    WpA a0 = wp_load_a(i0 < NI ? i0 : 0, part, ids, gates, sx), a1 = wp_load_a(i0 + NT < NI ? i0 + NT : 0, part, ids, gates, sx);
    WpB b0 = wp_load_b(a0, lds);
    for (size_t idx = i0; idx < NI; idx += NT) {
        const WpA a2 = wp_load_a(idx + 2 * NT < NI ? idx + 2 * NT : 0, part, ids, gates, sx);
        const WpB b1 = wp_load_b(a1, lds);
        f32x4 g = a0.g; float am = 0.f;
#pragma unroll
        for (int k = 0; k < 4; ++k) { g[k] = g[k] * gelu_erf(a0.s[k] * (a0.st * b0.su[k])) * b0.sv[k]; am = __builtin_fmaxf(am, __builtin_fabsf(g[k])); }
        am = max32(am);
        *(unsigned*)(w8 + idx * 4) = q4_i8(g, am > 0.f ? 127.0f / am : 0.f);
        if ((c.tid & 31) == 0) sw[idx >> 5] = am * (1.0f / 127.0f);
        a0 = a1; a1 = a2; b0 = b1;
    }
}

DI int pi_row(int m) { return 16 * (m >> 4) + 8 * ((m >> 2) & 1) + 4 * ((m >> 3) & 1) + (m & 3); }
struct AttnT { const bf16* Q; bf16* O; const bf16* Kb; const bf16* VT; const bf16* Vsn; const float* ck; const float* cv; };
template <int MODE>
DI void attn_load(const AttnT A, const int b, const int h, const int kt, const int q, const int hh, const int piq, bf16x8 (&kf)[4], bf16x8 (&vf)[2][2]) {
    if (MODE == 0) {
        const bf16* kr = A.Kb + ((size_t)b * SEQ + kt * 32 + piq) * D + h * DH + 8 * hh;
#pragma unroll
        for (int s = 0; s < 4; ++s) kf[s] = *(const bf16x8*)(kr + 16 * s);
        const bf16* vr = A.VT + (((size_t)b * NH + h) * (SEQ / 32) + kt) * (DH * 32) + q * 32 + 8 * hh;
#pragma unroll
        for (int mt = 0; mt < 2; ++mt)
#pragma unroll
            for (int s = 0; s < 2; ++s) vf[mt][s] = *(const bf16x8*)(vr + mt * 32 * 32 + 16 * s);
    } else if (kt == PAST / 32) {
        const int ko = piq < 16 ? piq : 15;
        const bf16* kr = A.Kb + ((size_t)TP + b * DSEQ + ko) * D + h * DH + 8 * hh;
#pragma unroll
        for (int s = 0; s < 4; ++s) kf[s] = *(const bf16x8*)(kr + 16 * s);
#pragma unroll
        for (int mt = 0; mt < 2; ++mt)
#pragma unroll
            for (int s = 0; s < 2; ++s) { bf16x8 v;
#pragma unroll
                for (int j = 0; j < 8; ++j) { const int kk = 16 * s + 8 * hh + j; v[j] = (short)A.Vsn[((size_t)b * DSEQ + (kk < 16 ? kk : 15)) * D + h * DH + 32 * mt + q]; }
                vf[mt][s] = v; }
    } else {
        const float* kr = A.ck + (((size_t)b * PAST + kt * 32 + piq) * NH + h) * DH + 8 * hh;
#pragma unroll
        for (int s = 0; s < 4; ++s) { const f32x4 x0 = *(const f32x4*)(kr + 16 * s), x1 = *(const f32x4*)(kr + 16 * s + 4); kf[s] = pack8(x0[0], x0[1], x0[2], x0[3], x1[0], x1[1], x1[2], x1[3]); }
#pragma unroll
        for (int mt = 0; mt < 2; ++mt)
#pragma unroll
            for (int s = 0; s < 2; ++s) { float x[8];
#pragma unroll
                for (int j = 0; j < 8; ++j) x[j] = A.cv[(((size_t)b * PAST + kt * 32 + 16 * s + 8 * hh + j) * NH + h) * DH + 32 * mt + q];
                vf[mt][s] = pack8(x[0], x[1], x[2], x[3], x[4], x[5], x[6], x[7]); }
    }
}
template <int MODE>
DI void attn_qtile(const AttnT A, int b, int h, int qi, int lane, const bf16x8 (&ut)[2]) {
    const int q = lane & 31, hh = lane >> 5, piq = pi_row(q);
    const size_t qrow = MODE == 0 ? (size_t)b * SEQ + qi * 32 + q : (size_t)TP + b * DSEQ + (q < 16 ? q : 15);
    const int qpos = MODE == 0 ? qi * 32 + q : (q < 16 ? PAST + q : 0);
    bf16x8 qf[4];
#pragma unroll
    for (int s = 0; s < 4; ++s) qf[s] = *(const bf16x8*)(A.Q + qrow * D + h * DH + 16 * s + 8 * hh);
    f32x16 o0, o1;
#pragma unroll
    for (int i = 0; i < 16; ++i) { o0[i] = 0.f; o1[i] = 0.f; }
    float carry = 0.f;
    const int kt0 = MODE == 0 ? qi : PAST / 32;
    bf16x8 kf[4], vf[2][2];
    attn_load<MODE>(A, b, h, kt0, q, hh, piq, kf, vf);
    for (int kt = kt0; kt >= 0; --kt) {
        bf16x8 kn[4], vn[2][2];
        attn_load<MODE>(A, b, h, kt > 0 ? kt - 1 : 0, q, hh, piq, kn, vn);
        f32x16 S;
#pragma unroll
        for (int i = 0; i < 16; ++i) S[i] = 0.f;
#pragma unroll
        for (int s = 0; s < 4; ++s) S = MFMA32(kf[s], qf[s], S);
        const int kbase = kt * 32 + 8 * hh;
        float L[16], lw[16];
#pragma unroll
        for (int r = 0; r < 16; ++r) {
            const bool valid = (kbase + 16 * (r >> 3) + (r & 7)) < qpos;
            const float z = S[r], sp = __builtin_fmaxf(z, 0.f) + __builtin_amdgcn_logf(1.0f + __builtin_amdgcn_exp2f(-__builtin_fabsf(z)));
            L[r] = valid ? -sp : 0.f; lw[r] = valid ? (z - sp) : -1e30f;
        }
        f32x16 suf;
#pragma unroll
        for (int i = 0; i < 16; ++i) suf[i] = 0.f;
        suf = MFMA32(ut[0], pack8(L[0], L[1], L[2], L[3], L[4], L[5], L[6], L[7]), suf);
        suf = MFMA32(ut[1], pack8(L[8], L[9], L[10], L[11], L[12], L[13], L[14], L[15]), suf);
        float a[16];
#pragma unroll
        for (int r = 0; r < 16; ++r) a[r] = __builtin_amdgcn_exp2f(lw[r] + suf[r] + carry);
        carry += __int_as_float(__builtin_amdgcn_ds_bpermute(q << 2, __float_as_int(suf[0] + L[0])));
        const bf16x8 p0 = pack8(a[0], a[1], a[2], a[3], a[4], a[5], a[6], a[7]), p1 = pack8(a[8], a[9], a[10], a[11], a[12], a[13], a[14], a[15]);
        o0 = MFMA32(vf[0][0], p0, o0); o0 = MFMA32(vf[0][1], p1, o0);
        o1 = MFMA32(vf[1][0], p0, o1); o1 = MFMA32(vf[1][1], p1, o1);
        if (__builtin_amdgcn_ballot_w64(qpos > 0 && carry > -24.0f * LOG2E) == 0ull) break;
#pragma unroll
        for (int s = 0; s < 4; ++s) kf[s] = kn[s];
#pragma unroll
        for (int mt = 0; mt < 2; ++mt)
#pragma unroll
            for (int s = 0; s < 2; ++s) vf[mt][s] = vn[mt][s];
    }
    if (MODE == 0 || q < 16) {
        bf16* orow = A.O + qrow * D + h * DH + 4 * hh;
#pragma unroll
        for (int g = 0; g < 4; ++g) {
            v2u w0, w1; w0.x = pk2(o0[4 * g], o0[4 * g + 1]); w0.y = pk2(o0[4 * g + 2], o0[4 * g + 3]); w1.x = pk2(o1[4 * g], o1[4 * g + 1]); w1.y = pk2(o1[4 * g + 2], o1[4 * g + 3]);
            *(v2u*)(orow + 8 * g) = w0; *(v2u*)(orow + 32 + 8 * g) = w1; }
    }
}
DI void attn_phase(const Ctx c, const AttnT A) {
    const int q = c.lane & 31, hh = c.lane >> 5, piq = pi_row(q);
    bf16x8 ut[2];
#pragma unroll
    for (int s = 0; s < 2; ++s)
#pragma unroll
        for (int j = 0; j < 8; ++j) ut[s][j] = (16 * s + 8 * hh + j > piq) ? (short)0x3f80 : (short)0;
    for (int bu = c.vcu; bu < NB * NH * 4; bu += c.G) {
        const int bh = bu >> 2, b = bh >> 4, h = bh & 15, p = (bu & 3) * 8 + c.wave;
        attn_qtile<0>(A, b, h, 63 - p, c.lane, ut);
        attn_qtile<0>(A, b, h, p, c.lane, ut);
    }
    for (int su = c.wave * c.G + c.vcu; su < NB * NH; su += c.G * 8) attn_qtile<1>(A, su >> 4, su & 15, 0, c.lane, ut);
}

DI void vt_phase(const Ctx c, LAS unsigned char* lds, const bf16* Vb, bf16* VT, bf16* Vsn) {
    LAS unsigned char* scr = lds + c.wave * 16384;
    const int gw = c.vcu * 8 + c.wave, NGW = c.G * 8;
    for (int wt = gw; wt < (TP / 64) * 16; wt += NGW) {
        const int tt = wt >> 4, ht = wt & 15;
        v4u vin[8];
#pragma unroll
        for (int j = 0; j < 8; ++j) vin[j] = *(const v4u*)(Vb + (size_t)(tt * 64 + (c.lane >> 3) + 8 * j) * D + ht * 64 + (c.lane & 7) * 8);
        __builtin_amdgcn_sched_barrier(0);
#pragma unroll
        for (int j = 0; j < 8; ++j) { const int row = (c.lane >> 3) + 8 * j, ch = c.lane & 7;
            LAS unsigned* d = (LAS unsigned*)(scr + row * 132 + ch * 16); d[0] = vin[j].x; d[1] = vin[j].y; d[2] = vin[j].z; d[3] = vin[j].w; }
        LDS_WAIT(); asm volatile("" ::: "memory");
#pragma unroll
        for (int j = 0; j < 8; ++j) { const int orow = (c.lane >> 3) + 8 * j, ch = c.lane & 7;
            unsigned short e[8];
#pragma unroll
            for (int i = 0; i < 8; ++i) e[i] = *(const LAS unsigned short*)(scr + (ch * 8 + i) * 132 + orow * 2);
            v4u o; o.x = e[0] | ((unsigned)e[1] << 16); o.y = e[2] | ((unsigned)e[3] << 16); o.z = e[4] | ((unsigned)e[5] << 16); o.w = e[6] | ((unsigned)e[7] << 16);
            { const int bb = tt >> 5, kt = 2 * (tt & 31) + (ch >> 2);
              *(v4u*)(VT + (((size_t)bb * NH + ht) * (SEQ / 32) + kt) * (DH * 32) + orow * 32 + 8 * (ch & 3)) = o; } }
        LDS_WAIT(); asm volatile("" ::: "memory");
    }
    const size_t NT = (size_t)c.G * 512;
    for (size_t i = (size_t)c.vcu * 512 + c.tid; i < (size_t)TS * D / 8; i += NT) *(v4u*)(Vsn + i * 8) = *(const v4u*)(Vb + (size_t)TP * D + i * 8);
}

DI f32x16 sg_tile(const bf16* wr  , const bf16* xr  , const int ns = 64  ) {
    f32x16 acc;
#pragma unroll
    for (int i = 0; i < 16; ++i) acc[i] = 0.f;
    bf16x8 wa[8], xa[8], wb[8], xb[8];
#pragma unroll
    for (int j = 0; j < 8; ++j) { wa[j] = *(const bf16x8*)(wr + 16 * j); xa[j] = *(const bf16x8*)(xr + 16 * j); }
#pragma unroll 1
    for (int k0 = 0; k0 < ns; k0 += 16) {
#pragma unroll
        for (int j = 0; j < 8; ++j) { wb[j] = *(const bf16x8*)(wr + 16 * (k0 + 8 + j)); xb[j] = *(const bf16x8*)(xr + 16 * (k0 + 8 + j)); }
        __builtin_amdgcn_sched_barrier(0);
#pragma unroll
        for (int j = 0; j < 8; ++j) acc = MFMA32(wa[j], xa[j], acc);
        __builtin_amdgcn_sched_barrier(0);
        { const int kn = k0 + 16 < ns ? k0 + 16 : 0;
#pragma unroll
          for (int j = 0; j < 8; ++j) { wa[j] = *(const bf16x8*)(wr + 16 * (kn + j)); xa[j] = *(const bf16x8*)(xr + 16 * (kn + j)); } }
        __builtin_amdgcn_sched_barrier(0);
#pragma unroll
        for (int j = 0; j < 8; ++j) acc = MFMA32(wb[j], xb[j], acc);
        __builtin_amdgcn_sched_barrier(0);
    }
    return acc;
}
DI void sg_gate(const Ctx c, LAS unsigned char* lds, const bf16* Hall  , const bf16* Wl  , bf16* U, bf16* Bg, float* convp  ) {
    const bool uselds = 18 * 32 <= 4 * c.G;
    const int q = c.lane & 31, hh = c.lane >> 5;
    for (int tile = c.wave * c.G + c.vcu; tile < 18 * 32; tile += c.G * 8) {
        const int tt = tile % 18, dt = tile / 18, d = 32 * dt + q, crow = 256 * (d >> 7) + (d & 127);
        const bool cs = tt >= 16; const int kk = (tt - 16) * 32 + q;
        const size_t row = cs ? (size_t)(kk >> 1) * SEQ + (SEQ - 2) + (kk & 1) : (size_t)TP + tt * 32 + q;
        const bf16* xr = Hall + row * D + 8 * hh;
        const bf16* wc = Wl + (size_t)crow * D + 8 * hh; const bf16* wx = wc + (size_t)128 * D; const bf16* wb = Wl + (size_t)(2048 + d) * D + 8 * hh;
        f32x16 ac, ax, ab;
#pragma unroll
        for (int i = 0; i < 16; ++i) { ac[i] = 0.f; ax[i] = 0.f; ab[i] = 0.f; }
        if (uselds) {
            LAS unsigned char* wl = lds + c.wave * 32768;
            const int dr = c.lane >> 3, dc = (c.lane & 7) ^ dr;
            const size_t xrow = cs ? (size_t)((tt - 16) * 16 + (dr >> 1)) * SEQ + (SEQ - 2) + (dr & 1) : (size_t)TP + tt * 32 + dr;
            const size_t xms = cs ? (size_t)4 * SEQ * D : (size_t)8 * D;
            const bf16* gx_ = Hall + xrow * D + dc * 8;
            const bf16* gc_ = Wl + (size_t)(256 * (dt >> 2) + 32 * (dt & 3) + dr) * D + dc * 8; const bf16* gxx_ = gc_ + (size_t)128 * D; const bf16* gb_ = Wl + (size_t)(2048 + 32 * dt + dr) * D + dc * 8;
            unsigned roff[4];
#pragma unroll
            for (int j = 0; j < 4; ++j) roff[j] = (unsigned)(q * 128 + (((2 * j + hh) ^ (q & 7)) * 16));
#define SGG_STAGE(b, st) do { _Pragma("unroll") for (int m = 0; m < 4; ++m) { \
            __builtin_amdgcn_global_load_lds((const unsigned*)(gx_ + m * xms + (st) * 64), (LAS unsigned*)(wl + (b) * 16384 + m * 1024), 16, 0, 0); \
            __builtin_amdgcn_global_load_lds((const unsigned*)(gc_ + (size_t)(8 * m) * D + (st) * 64), (LAS unsigned*)(wl + (b) * 16384 + 4096 + m * 1024), 16, 0, 0); \
            __builtin_amdgcn_global_load_lds((const unsigned*)(gxx_ + (size_t)(8 * m) * D + (st) * 64), (LAS unsigned*)(wl + (b) * 16384 + 8192 + m * 1024), 16, 0, 0); \
            __builtin_amdgcn_global_load_lds((const unsigned*)(gb_ + (size_t)(8 * m) * D + (st) * 64), (LAS unsigned*)(wl + (b) * 16384 + 12288 + m * 1024), 16, 0, 0); } } while (0)
            SGG_STAGE(0, 0);
#pragma unroll 1
            for (int st = 0; st < 16; ++st) {
                const int b = st & 1, sn = st + 1 < 16 ? st + 1 : 0;
                SGG_STAGE(b ^ 1, sn);
                asm volatile("s_waitcnt vmcnt(16)" ::: "memory");
                bf16x8 fx[4], fc[4], fxx[4], fb[4];
#pragma unroll
                for (int j = 0; j < 4; ++j) { fx[j] = *(const LAS bf16x8*)(wl + b * 16384 + roff[j]); fc[j] = *(const LAS bf16x8*)(wl + b * 16384 + 4096 + roff[j]);
                    fxx[j] = *(const LAS bf16x8*)(wl + b * 16384 + 8192 + roff[j]); fb[j] = *(const LAS bf16x8*)(wl + b * 16384 + 12288 + roff[j]); }
                asm volatile("s_waitcnt lgkmcnt(0)" ::: "memory");
#pragma unroll
                for (int j = 0; j < 4; ++j) { ac = MFMA32(fc[j], fx[j], ac); ax = MFMA32(fxx[j], fx[j], ax); ab = MFMA32(fb[j], fx[j], ab); }
                __builtin_amdgcn_sched_barrier(0);
            }
            asm volatile("s_waitcnt vmcnt(0)" ::: "memory");
#undef SGG_STAGE
        } else
        { bf16x8 fx[4], fc[4], fxx[4], fb[4], gx[4], gc[4], gxx[4], gb[4];
#pragma unroll
          for (int j = 0; j < 4; ++j) { fx[j] = *(const bf16x8*)(xr + 16 * j); fc[j] = *(const bf16x8*)(wc + 16 * j); fxx[j] = *(const bf16x8*)(wx + 16 * j); fb[j] = *(const bf16x8*)(wb + 16 * j); }
#pragma unroll 1
          for (int k0 = 0; k0 < 64; k0 += 8) {
#pragma unroll
              for (int j = 0; j < 4; ++j) { gx[j] = *(const bf16x8*)(xr + 16 * (k0 + 4 + j)); gc[j] = *(const bf16x8*)(wc + 16 * (k0 + 4 + j)); gxx[j] = *(const bf16x8*)(wx + 16 * (k0 + 4 + j)); gb[j] = *(const bf16x8*)(wb + 16 * (k0 + 4 + j)); }
              __builtin_amdgcn_sched_barrier(0);
#pragma unroll
              for (int j = 0; j < 4; ++j) { ac = MFMA32(fc[j], fx[j], ac); ax = MFMA32(fxx[j], fx[j], ax); ab = MFMA32(fb[j], fx[j], ab); }
              __builtin_amdgcn_sched_barrier(0);
              { const int kn = k0 + 8 < 64 ? k0 + 8 : 0;
#pragma unroll
                for (int j = 0; j < 4; ++j) { fx[j] = *(const bf16x8*)(xr + 16 * (kn + j)); fc[j] = *(const bf16x8*)(wc + 16 * (kn + j)); fxx[j] = *(const bf16x8*)(wx + 16 * (kn + j)); fb[j] = *(const bf16x8*)(wb + 16 * (kn + j)); } }
              __builtin_amdgcn_sched_barrier(0);
#pragma unroll
              for (int j = 0; j < 4; ++j) { ac = MFMA32(gc[j], gx[j], ac); ax = MFMA32(gxx[j], gx[j], ax); ab = MFMA32(gb[j], gx[j], ab); }
              __builtin_amdgcn_sched_barrier(0);
          } }
        if (cs) {
            float* cd = convp + (size_t)kk * D + 32 * dt + 4 * hh;
#pragma unroll
            for (int g = 0; g < 4; ++g) *(f32x4*)(cd + 8 * g) = (f32x4){ac[4 * g] * ax[4 * g], ac[4 * g + 1] * ax[4 * g + 1], ac[4 * g + 2] * ax[4 * g + 2], ac[4 * g + 3] * ax[4 * g + 3]};
        } else {
            const size_t ro = row * D + 32 * dt + 4 * hh;
#pragma unroll
            for (int g = 0; g < 4; ++g) { v2u wu, wb2; wu.x = pk2(ac[4 * g] * ax[4 * g], ac[4 * g + 1] * ax[4 * g + 1]); wu.y = pk2(ac[4 * g + 2] * ax[4 * g + 2], ac[4 * g + 3] * ax[4 * g + 3]);
                wb2.x = pk2(ab[4 * g], ab[4 * g + 1]); wb2.y = pk2(ab[4 * g + 2], ab[4 * g + 3]);
                *(v2u*)(U + ro + 8 * g) = wu; *(v2u*)(Bg + ro + 8 * g) = wb2; }
        }
    }
}
DI f32x16 sg_tile_lds(LAS unsigned char* wl, const bf16* w0  , const bf16* x0  , const int ns, const int lane) {
    f32x16 acc;
#pragma unroll
    for (int i = 0; i < 16; ++i) acc[i] = 0.f;
    const int q = lane & 31, hh = lane >> 5, dr = lane >> 3, dc = (lane & 7) ^ dr;
    const bf16* gw = w0 + (size_t)dr * D + dc * 8; const bf16* gx = x0 + (size_t)dr * D + dc * 8;
    const int nst = ns >> 2;
    unsigned roff[4];
#pragma unroll
    for (int j = 0; j < 4; ++j) roff[j] = (unsigned)(q * 128 + (((2 * j + hh) ^ (q & 7)) * 16));
#define SGL_STAGE(b, st) do { _Pragma("unroll") for (int m = 0; m < 4; ++m) { \
        __builtin_amdgcn_global_load_lds((const unsigned*)(gw + (size_t)(8 * m) * D + (st) * 64), (LAS unsigned*)(wl + (b) * 8192 + m * 1024), 16, 0, 0); \
        __builtin_amdgcn_global_load_lds((const unsigned*)(gx + (size_t)(8 * m) * D + (st) * 64), (LAS unsigned*)(wl + (b) * 8192 + 4096 + m * 1024), 16, 0, 0); } } while (0)
    SGL_STAGE(0, 0);
#pragma unroll 1
    for (int st = 0; st < nst; ++st) {
        const int b = st & 1, sn = st + 1 < nst ? st + 1 : 0;
        SGL_STAGE(b ^ 1, sn);
        asm volatile("s_waitcnt vmcnt(8)" ::: "memory");
        bf16x8 wf[4], xf[4];
#pragma unroll
        for (int j = 0; j < 4; ++j) { wf[j] = *(const LAS bf16x8*)(wl + b * 8192 + roff[j]); xf[j] = *(const LAS bf16x8*)(wl + b * 8192 + 4096 + roff[j]); }
        asm volatile("s_waitcnt lgkmcnt(0)" ::: "memory");
#pragma unroll
        for (int j = 0; j < 4; ++j) acc = MFMA32(wf[j], xf[j], acc);
        __builtin_amdgcn_sched_barrier(0);
    }
    asm volatile("s_waitcnt vmcnt(0)" ::: "memory");
#undef SGL_STAGE
    return acc;
}
template <int MODE>
DI void sg_epi(const f32x16 acc, const int tt, const int ft, const int q, const int hh, bf16* O, const bf16* Hres, bf16* O2, float* f0, float* f1) {
    const int tl = tt * 32 + q;
#pragma unroll
    for (int g = 0; g < 4; ++g) { const int f = 32 * ft + 8 * g + 4 * hh; const f32x4 v = {acc[4 * g], acc[4 * g + 1], acc[4 * g + 2], acc[4 * g + 3]};
        if (MODE == 0) { v2u w; w.x = pk2(v[0], v[1]); w.y = pk2(v[2], v[3]); *(v2u*)(O + (size_t)(TP + tl) * D + f) = w; }
        else if (MODE == 1) { const v2u hw = *(const v2u*)(Hres + (size_t)(TP + tl) * D + f); const f32x4 r = (f32x4){bflo(hw.x), bfhi(hw.x), bflo(hw.y), bfhi(hw.y)} * ALPHA + v;
            v2u w; w.x = pk2(r[0], r[1]); w.y = pk2(r[2], r[3]); *(v2u*)(O + (size_t)(TP + tl) * D + f) = w; }
        else if (MODE == 2) { const bool isv = f >= 1024; const int fc = isv ? f - 1024 : f; v2u w; w.x = pk2(v[0], v[1]); w.y = pk2(v[2], v[3]);
            *(v2u*)((isv ? O2 : O) + (size_t)(TP + tl) * D + fc) = w; *(f32x4*)((isv ? f1 : f0) + (size_t)tl * D + fc) = v; }
        else { v2u w; w.x = pk2(v[0], v[1]); w.y = pk2(v[2], v[3]); *(v2u*)(O + (size_t)(TP + tl) * 2048 + f) = w; }
    }
}
template <int MODE>
DI void sg_plain(const Ctx c, LAS unsigned char* lds, const bf16* Xs, const bf16* Wt, const int N, bf16* O, const bf16* Hres, bf16* O2, float* f0, float* f1) {
    const int q = c.lane & 31, hh = c.lane >> 5;
    const int ntile = 16 * (N / 32), R = ntile / c.G;
    if (ntile == R * c.G && (R == 2 || R == 4)) {
        const int S = 8 / R, r = c.wave / S, ks = c.wave - r * S, ns = 64 / S;
        const int tile = r * c.G + c.vcu, tt = tile & 15, ft = tile >> 4;
        f32x16 acc = sg_tile_lds(lds + c.wave * 16384, Wt + (size_t)(ft * 32) * D + 16 * ks * ns, Xs + (size_t)(tt * 32) * D + 16 * ks * ns, ns, c.lane);
        __syncthreads();
        LAS float* mine = (LAS float*)(lds + c.wave * 4096);
        if (ks != 0) {
#pragma unroll
            for (int i = 0; i < 16; ++i) mine[i * 64 + c.lane] = acc[i]; }
        __syncthreads();
        if (ks == 0) {
            for (int s2 = 1; s2 < S; ++s2) { const LAS float* o = (const LAS float*)(lds + (c.wave + s2) * 4096);
#pragma unroll
                for (int i = 0; i < 16; ++i) acc[i] += o[i * 64 + c.lane]; }
            sg_epi<MODE>(acc, tt, ft, q, hh, O, Hres, O2, f0, f1);
        }
        return;
    }
    for (int tile = c.wave * c.G + c.vcu; tile < ntile; tile += c.G * 8) {
        const int tt = tile & 15, ft = tile >> 4;
        const f32x16 acc = sg_tile(Wt + (size_t)(ft * 32 + q) * D + 8 * hh, Xs + (size_t)(tt * 32 + q) * D + 8 * hh);
        sg_epi<MODE>(acc, tt, ft, q, hh, O, Hres, O2, f0, f1);
    }
}

struct Args { const float* in[18]; float* out; unsigned char* ws; int ph_lo, ph_hi, li, pad; };
constexpr int N_PHASES = 2 + 2 * 10 + 12 + 10;
__global__ void __launch_bounds__(512, 2) fwd(Args args) {
    extern __shared__ __attribute__((aligned(16))) unsigned char lds_raw[];
    LAS unsigned char* lds = (LAS unsigned char*)lds_raw;
    Ctx c0; c0.tid = threadIdx.x; c0.lane = 0; c0.wave = __builtin_amdgcn_readfirstlane(c0.tid >> 6); c0.G = gridDim.x;
    { const int bx = blockIdx.x; c0.vcu = (c0.G % 8 == 0) ? (bx % 8) * (c0.G / 8) + bx / 8 : bx; }
    volatile LAS unsigned* MISC = (volatile LAS unsigned*)(lds + MISC_OFF);
    for (int u = c0.tid; u < (LDS_BYTES - RING_BYTES) / 4; u += 512) ((LAS unsigned*)(lds + RING_BYTES))[u] = 0u;
    __syncthreads();
    unsigned char* ws = args.ws; float* out = args.out;
    XcdBarrier bar = xcd_barrier_post((unsigned*)(ws + WS_CTL) + CW_BAR + args.li * XCD_BAR_WORDS, MISC + 8, c0.wave == 0 ? 1u : 0u);
#define WinT ((bf16*)(wsl + WS_WIN))
#define WoutT ((bf16*)(wsl + WS_WOUT))
#define WqT ((bf16*)(wsl + WS_WQ))
#define WoT ((bf16*)(wsl + WS_WO))
#define WkvT ((bf16*)(wsl + WS_WKV))
#define WP ((bf16*)(wsl + WS_WP))
#define W8A (wsl + WS_W8A)
#define SWA ((float*)(wsl + WS_SWA))
#define W8R(off) ((int)(((off) - WS_WIN) / 2048))
#define Vsn ((bf16*)(wsl + WS_VSN))
#define H ((bf16*)(wsl + WS_H))
#define Kb ((bf16*)(wsl + WS_KB))
#define VT ((bf16*)(wsl + WS_VT))
#define ids ((unsigned short*)(wsl + WS_IDS))
#define gates ((float*)(wsl + WS_GATE))
#define W8 (wsl + WS_W8)
#define SX ((float*)(wsl + WS_SX))
#define SW (SX + T)
#define X8 (wsl + WS_X8)
#define TU (wsl + WS_TU)
#define TV (wsl + WS_TV)
#define SU ((float*)(wsl + WS_SU))
#define SV (SU + 1)
#define A0 ((bf16*)(wsl + WS_A))
#define A1 ((bf16*)(wsl + WS_A + 129 * MiB))
#define ScT ((float*)(wsl + WS_A))
#define R A0
    const float* ln_g = args.in[16]; const float* ln_b = args.in[17];
    const int lo = args.ph_lo, hi = args.ph_hi; int ph = 0;
#ifndef PROBE_REPEAT
#define PROBE_REPEAT 0
#endif
#define PHASE_R(bit, body) do { const int nrep = 1 + ((PROBE_REPEAT >> (bit)) & 1); for (int rep = 0; rep < nrep; ++rep) { if (ph >= lo && ph < hi) { Ctx c = c0; c.lane = xb_lane_id(); c.tid = c0.wave * 64 + c.lane; unsigned long long wsi_ = (unsigned long long)ws; asm volatile("" : "+s"(wsi_)); unsigned char* wsl = (unsigned char*)(GAS unsigned char*)wsi_; body; if (ph + 1 < hi) { xcd_barrier(bar); if ((PROBE_REPEAT >> 20) & 1) xcd_barrier(bar); } } ++ph; } } while (0)
#define PHASE(body) PHASE_R(31, body)

    PHASE_R(4, ({ P0Args a{args.in[0], args.in[1], args.in[5], args.in[7], args.in[8], args.in[9], args.in[10], args.in[11], args.in[12], args.in[13], args.in[14], args.in[15],
                      WinT, WoutT, WqT, WoT, WkvT, WP, H, TU, TV, SU, SV, X8, SX}; p0_prologue(c, lds, a); }));

    PHASE(({ wp_quant_phase(c, WinT, W8A, SWA); }));

#pragma unroll 1
    for (int l = 0; l < NLAYER; ++l) {
        if (l < 2) {
            PHASE_R(8, ({ pg8::Gemm g{(const bf16*)X8, (const bf16*)(W8A + ((size_t)W8R(WS_WIN) + (size_t)l * 3072) * 1024), TP, 3072, 512}; pg8::StaticOrder S; S.init(TP, 3072, c.G, (int)blockIdx.x);
                     pg8::EpiGate<true> E{A0, A1, SX, SWA + W8R(WS_WIN) + l * 3072};
                     pg8::gemm_phase<pg8::EpiGate<true>, pg8::StaticOrder, true, true, true>(lds, g, S, E, c.tid);
                     sg_gate(c, lds, H, WinT + (size_t)l * 3072 * 1024, A0, A1, out + O_CONVP + (size_t)l * NB * 2 * D); }));
            PHASE_R(13, ({ conv_gate_phase(c, A0, A1, args.in[6] + (size_t)l * 3 * D, args.in[2] + (size_t)l * NB * 2 * D, out + O_CONVP + (size_t)l * NB * 2 * D, out + O_CONVS + (size_t)l * NB * 2 * D, X8, SX, rep > 0); }));
        } else {
            if (l == 2) {
                PHASE_R(10, ({ pg8::Gemm g{(const bf16*)X8, (const bf16*)(W8A + (size_t)W8R(WS_WKV) * 1024), TP, 2048, 512}; pg8::StaticOrder S; S.init(TP, 2048, c.G, (int)blockIdx.x);
                         pg8::EpiKV<true> E{Kb, A1, out + O_KP, out + O_VP, out + O_KS, out + O_VS, SX, SWA + W8R(WS_WKV)};
                         pg8::gemm_phase<pg8::EpiKV<true>, pg8::StaticOrder, true, true, true>(lds, g, S, E, c.tid);
                         sg_plain<2>(c, lds, H + (size_t)TP * D, WkvT, 2048, Kb, nullptr, A1, out + O_KS, out + O_VS); }));
                PHASE_R(14, ({ vt_phase(c, lds, A1, VT, Vsn); }));
            }
            PHASE_R(9, ({ pg8::Gemm g{(const bf16*)X8, (const bf16*)(W8A + ((size_t)W8R(WS_WQ) + (size_t)(l - 2) * 1024) * 1024), TP, 1024, 512}; pg8::StaticOrder S; S.init(TP, 1024, c.G, (int)blockIdx.x);
                     pg8::EpiBf16P<true> E{A0, 1024, SX, SWA + W8R(WS_WQ) + (l - 2) * 1024};
                     pg8::gemm_phase<pg8::EpiBf16P<true>, pg8::StaticOrder, true, true, true>(lds, g, S, E, c.tid);
                     sg_plain<0>(c, lds, H + (size_t)TP * D, WqT + (size_t)(l - 2) * 1024 * 1024, 1024, A0, nullptr, nullptr, nullptr, nullptr); }));
            PHASE_R(11, ({ AttnT A{A0, A1, Kb, VT, Vsn, args.in[3], args.in[4]}; attn_phase(c, A); }));
        }
        if (l < 2) {
            PHASE_R(7, ({ pg8::Gemm g{(const bf16*)X8, (const bf16*)(W8A + ((size_t)W8R(WS_WOUT) + (size_t)l * 1024) * 1024), TP, 1024, 512}; pg8::StaticOrder S; S.init(TP, 1024, c.G, (int)blockIdx.x);
                     pg8::EpiRes<true> E{H, R, ALPHA, SX, SWA + W8R(WS_WOUT) + l * 1024};
                     pg8::gemm_phase<pg8::EpiRes<true>, pg8::StaticOrder, true, true, true>(lds, g, S, E, c.tid);
                     sg_plain<1>(c, lds, A1 + (size_t)TP * D, WoutT + (size_t)l * 1024 * 1024, 1024, R, H, nullptr, nullptr, nullptr); }));
        } else {
            PHASE_R(7, ({ pg8::Gemm g{A1, WoT + (size_t)(l - 2) * 1024 * 1024, TP, 1024, 1024}; pg8::StaticOrder S; S.init(TP, 1024, c.G, (int)blockIdx.x);
                     pg8::EpiRes<false> E{H, R, ALPHA, nullptr, nullptr};
                     pg8::gemm_phase<pg8::EpiRes<false>, pg8::StaticOrder, true, true>(lds, g, S, E, c.tid);
                     sg_plain<1>(c, lds, A1 + (size_t)TP * D, WoT + (size_t)(l - 2) * 1024 * 1024, 1024, R, H, nullptr, nullptr, nullptr); }));
        }
        PHASE_R(5, ({ ln_phase(c, R, H, ln_g + (size_t)(l * 2) * D, ln_b + (size_t)(l * 2) * D, nullptr, nullptr, X8, SX); }));
        PHASE_R(6, ({ pg8::Gemm g{(const bf16*)X8, (const bf16*)(W8A + ((size_t)W8R(WS_WP) + (size_t)l * 2048) * 1024), TP, 2048, 512}; pg8::StaticOrder S; S.init(TP, 2048, c.G, (int)blockIdx.x);
                 pg8::EpiScoreI8 E{(bf16*)ScT, 2048, SX, SWA + W8R(WS_WP) + l * 2048};
                 pg8::gemm_phase<pg8::EpiScoreI8, pg8::StaticOrder, true, true, true>(lds, g, S, E, c.tid);
                 sg_plain<3>(c, lds, H + (size_t)TP * D, WP + (size_t)l * 2048 * 1024, 2048, (bf16*)ScT, nullptr, nullptr, nullptr, nullptr); }));
        PHASE_R(3, ({ topk_phase(c, (const bf16*)ScT, ids, gates); }));
        PHASE_R(0, ({ slice_pass<0>(c, X8, ids, W8, SW, TU + (size_t)l * NEXP * D, ScT  , (unsigned*)(ws + WS_CTL) + CW_Q + ((l * 2) * 2 + rep) * 512); }));
        PHASE_R(12, ({ peer_w_phase(c, lds, ScT, ids, gates, W8, SW, SX, SU + (size_t)l * NEXP * 2, SV + (size_t)l * NEXP * 2); }));
        PHASE_R(1, ({ slice_pass<1>(c, X8, ids, W8, SW, TV + (size_t)l * NEXP * D, (float*)A0, (unsigned*)(ws + WS_CTL) + CW_Q + ((l * 2 + 1) * 2 + rep) * 512); }));
        PHASE(({ ln_phase(c, A0, H, ln_g + (size_t)(l * 2 + 1) * D, ln_b + (size_t)(l * 2 + 1) * D, l == NLAYER - 1 ? out : nullptr, H, X8, SX); }));
#if defined(PROBE_SLICE) && PROBE_SLICE == 1
        PHASE(({ slice_pass<0, 1>(c, X8, ids, W8, SW, TU + (size_t)l * NEXP * D, ScT, (unsigned*)(ws + WS_CTL) + CW_Q + ((l * 2) * 2 + 1) * 512); }));
#elif defined(PROBE_SLICE) && PROBE_SLICE == 2
        PHASE(({ slice_pass<0, 2>(c, X8, ids, W8, SW, TU + (size_t)l * NEXP * D, ScT, (unsigned*)(ws + WS_CTL) + CW_Q + ((l * 2) * 2 + 1) * 512); }));
#elif defined(PROBE_SLICE) && PROBE_SLICE == 3
        PHASE(({ slice_pass<1, 1>(c, X8, ids, W8, SW, TV + (size_t)l * NEXP * D, ScT, (unsigned*)(ws + WS_CTL) + CW_Q + ((l * 2) * 2 + 1) * 512); }));
#elif defined(PROBE_SLICE) && PROBE_SLICE == 4
        PHASE(({ slice_pass<1, 2>(c, X8, ids, W8, SW, TV + (size_t)l * NEXP * D, ScT, (unsigned*)(ws + WS_CTL) + CW_Q + ((l * 2) * 2 + 1) * 512); }));
#endif
    }
#undef PHASE
#undef PHASE_R
#undef WinT
#undef WoutT
#undef WqT
#undef WoT
#undef WkvT
#undef WP
#undef W8A
#undef SWA
#undef W8R
#undef Vsn
#undef H
#undef Kb
#undef VT
#undef ids
#undef gates
#undef W8
#undef SX
#undef SW
#undef X8
#undef TU
#undef TV
#undef SU
#undef SV
#undef A0
#undef A1
#undef ScT
#undef R
}

#ifndef N_LAUNCH_MODE
#define N_LAUNCH_MODE 1
#endif
extern "C" void kernel_launch(void* const* d_in, const int* in_sizes, int n_in, void* d_out, int out_size, void* d_ws, size_t ws_size, hipStream_t stream) {
    static int grid = 0;
    if (grid == 0) {
        if (n_in != 18 || in_sizes[0] != TP * D || (size_t)out_size != O_END || ws_size < WS_END) {
            fprintf(stderr, "kernel_launch: shape mismatch: n_in %d in0 %d out %d ws %zu (need %zu)\n", n_in, n_in > 0 ? in_sizes[0] : -1, out_size, ws_size, (size_t)WS_END); grid = -1; return; }
        int dev = 0, cus = 0, per_cu = 0;
        if (hipGetDevice(&dev) != hipSuccess || hipDeviceGetAttribute(&cus, hipDeviceAttributeMultiprocessorCount, dev) != hipSuccess) { grid = -1; return; }
        if (hipFuncSetAttribute((const void*)fwd, hipFuncAttributeMaxDynamicSharedMemorySize, LDS_BYTES) != hipSuccess) { fprintf(stderr, "kernel_launch: hipFuncSetAttribute failed\n"); grid = -1; return; }
        if (hipOccupancyMaxActiveBlocksPerMultiprocessor(&per_cu, (const void*)fwd, 512, LDS_BYTES) != hipSuccess || per_cu < 1) { fprintf(stderr, "kernel_launch: occupancy query says %d\n", per_cu); }
        (void)hipGetLastError();
        grid = cus;
    }
    if (grid < 0) return;
    (void)hipMemsetAsync((char*)d_ws + WS_CTL, 0, CTL_BYTES, stream);
    Args a{};
    for (int i = 0; i < 18; ++i) a.in[i] = (const float*)d_in[i];
    a.out = (float*)d_out; a.ws = (unsigned char*)d_ws; a.pad = 0;
#if N_LAUNCH_MODE == 1
    a.ph_lo = 0; a.ph_hi = 1 << 30; a.li = 0;
    hipLaunchKernelGGL(fwd, dim3(grid), dim3(512), LDS_BYTES, stream, a);
#else
    for (int p = 0; p < N_PHASES; ++p) { a.ph_lo = p; a.ph_hi = p + 1; a.li = p; hipLaunchKernelGGL(fwd, dim3(grid), dim3(512), LDS_BYTES, stream, a); }
#endif
}
```
